# Optimizing an MI355X kernel written in HIP

```python
import jax, jax.numpy as jnp
from jax import lax
import numpy as np

D_MODEL = 1024
BATCH = 1
SEQ = 16384
DEPTH = 4

PLE_DIM = 256
SC_WIDTH = 512
SC_CONV = 3
GLA_HEADS = 4
GLA_DK = 64
GLA_DV = 128
GLA_GATE_RANK = 16
GLA_TAU = 16.0
GLA_CHUNK = 64
MLA_HEADS = 4
MLA_NOPE = 128
MLA_ROPE = 64
MLA_V = 128
MLA_Q_RANK = 256
MLA_KV_RANK = 128
ROPE_THETA = 10000.0
Q_BLOCK = 128
N_GROUPS = 8
EXPERTS_PER_GROUP = 8
N_EXPERTS = N_GROUPS * EXPERTS_PER_GROUP
TOP_K = 2
EXPERT_HIDDEN = 256
MOE_BLOCK = 128
DN_ALPHA = (2 * DEPTH) ** 0.25
DN_BETA = (8 * DEPTH) ** -0.25
LN_EPS = 1e-5
RMS_EPS = 1e-6

GLA_QK = GLA_HEADS * GLA_DK
GLA_VW = GLA_HEADS * GLA_DV
MLA_QK = MLA_NOPE + MLA_ROPE
MLA_VW = MLA_HEADS * MLA_V
IN_SPLIT_SIZES = (SC_WIDTH, SC_WIDTH, SC_WIDTH,
                  GLA_QK, GLA_QK, GLA_VW, GLA_GATE_RANK, GLA_VW,
                  MLA_Q_RANK, MLA_KV_RANK, MLA_ROPE,
                  D_MODEL, D_MODEL, D_MODEL)
IN_WIDTH = 3 * SC_WIDTH + 2 * GLA_QK + 2 * GLA_VW + GLA_GATE_RANK + MLA_Q_RANK + MLA_KV_RANK + MLA_ROPE + 3 * D_MODEL
BR_WIDTH = SC_WIDTH + GLA_VW + MLA_VW

kernel_name = "hybrid_conv_gla_mla_hmoe_deepnorm"


def _split_points():
    pts, acc = [], 0
    for s in IN_SPLIT_SIZES[:-1]:
        acc += s
        pts.append(acc)
    return pts


def layer_norm(x, g, b):
    xf = x.astype(jnp.float32)
    mu = jnp.mean(xf, axis=-1, keepdims=True)
    xc = xf - mu
    var = jnp.mean(xc * xc, axis=-1, keepdims=True)
    return (xc * lax.rsqrt(var + LN_EPS) * g + b).astype(x.dtype)


def rms_norm(x, g):
    xf = x.astype(jnp.float32)
    return (xf * lax.rsqrt(jnp.mean(xf * xf, axis=-1, keepdims=True) + RMS_EPS) * g).astype(x.dtype)


def rope_tables(positions, dim):
    inv = 1.0 / (ROPE_THETA ** (jnp.arange(0, dim, 2, dtype=jnp.float32) / dim))
    ang = positions.astype(jnp.float32)[..., None] * inv
    return jnp.cos(ang), jnp.sin(ang)


def apply_rope(x, cos, sin):
    xf = x.astype(jnp.float32)
    x1, x2 = jnp.split(xf, 2, axis=-1)
    c, s = cos[:, :, None, :], sin[:, :, None, :]
    return jnp.concatenate([x1 * c - x2 * s, x1 * s + x2 * c], axis=-1).astype(x.dtype)


def short_gated_conv(b_gate, c_gate, xv, w_conv):
    u = c_gate * xv
    y = lax.conv_general_dilated(u, w_conv[:, None, :].astype(u.dtype), window_strides=(1,),
                                 padding=[(SC_CONV - 1, 0)],
                                 dimension_numbers=('NWC', 'WIO', 'NWC'),
                                 feature_group_count=u.shape[-1])
    return b_gate * y


def gla_chunked(q, k, v, log_a, r, norm_g):
    B, S, _ = q.shape
    C, N, H = GLA_CHUNK, S // GLA_CHUNK, GLA_HEADS
    f32 = jnp.float32
    qf = q.astype(f32).reshape(B, N, C, H, GLA_DK) * (GLA_DK ** -0.5)
    kf = k.astype(f32).reshape(B, N, C, H, GLA_DK)
    vf = v.astype(f32).reshape(B, N, C, H, GLA_DV)
    g = log_a.astype(f32).reshape(B, N, C, H, GLA_DK)
    b = jnp.cumsum(g, axis=2)
    b_last = b[:, :, -1]
    q_e = qf * jnp.exp(b)
    k_e = kf * jnp.exp(-b)
    k_t = kf * jnp.exp(b_last[:, :, None] - b)
    causal = jnp.tril(jnp.ones((C, C), dtype=bool))
    a = jnp.einsum('bnihd,bnjhd->bnhij', q_e, k_e)
    a = jnp.where(causal, a, 0.0)
    o_intra = jnp.einsum('bnhij,bnjhe->bnihe', a, vf)
    kv = jnp.einsum('bnjhd,bnjhe->bnhde', k_t, vf)
    decay = jnp.exp(b_last)

    def step(state, inp):
        kv_n, d_n = inp
        return d_n[..., None] * state + kv_n, state

    _, s_prev = lax.scan(step, jnp.zeros((B, H, GLA_DK, GLA_DV), f32),
                         (jnp.moveaxis(kv, 1, 0), jnp.moveaxis(decay, 1, 0)))
    s_prev = jnp.moveaxis(s_prev, 0, 1)
    o_inter = jnp.einsum('bnihd,bnhde->bnihe', q_e, s_prev)
    o = (o_intra + o_inter).reshape(B, S, H, GLA_DV)
    o = rms_norm(o, norm_g) * jax.nn.silu(r.astype(f32).reshape(B, S, H, GLA_DV))
    return o.reshape(B, S, GLA_VW).astype(v.dtype)


def causal_block_attention(q, k, v):
    B, S, H, Dh = q.shape
    nqb = S // Q_BLOCK
    scale = Dh ** -0.5
    qb = jnp.moveaxis(q.reshape(B, nqb, Q_BLOCK, H, Dh), 1, 0)
    k_pos = jnp.arange(S)

    def one_block(args):
        q_blk, blk = args
        s = jnp.einsum('bqhd,bkhd->bhqk', q_blk, k, preferred_element_type=jnp.float32) * scale
        q_pos = blk * Q_BLOCK + jnp.arange(Q_BLOCK)
        s = jnp.where(k_pos[None, :] <= q_pos[:, None], s, -jnp.inf)
        pr = jax.nn.softmax(s, axis=-1)
        return jnp.einsum('bhqk,bkhd->bqhd', pr.astype(v.dtype), v)

    out = lax.map(one_block, (qb, jnp.arange(nqb)))
    return jnp.moveaxis(out, 0, 1).reshape(B, S, H, v.shape[-1])


def mla(c_q, c_kv, k_rope_raw, q_norm_g, kv_norm_g, w_uq, w_ukv, cos, sin):
    B, S, _ = c_q.shape
    H = MLA_HEADS
    q = (rms_norm(c_q, q_norm_g) @ w_uq).reshape(B, S, H, MLA_QK)
    q_nope, q_rope = q[..., :MLA_NOPE], q[..., MLA_NOPE:]
    kv = (rms_norm(c_kv, kv_norm_g) @ w_ukv).reshape(B, S, H, MLA_NOPE + MLA_V)
    k_nope, v = kv[..., :MLA_NOPE], kv[..., MLA_NOPE:]
    q_rope = apply_rope(q_rope, cos, sin)
    k_rope = apply_rope(k_rope_raw[:, :, None, :], cos, sin)
    q = jnp.concatenate([q_nope, q_rope], axis=-1)
    k = jnp.concatenate([k_nope, jnp.broadcast_to(k_rope, (B, S, H, MLA_ROPE))], axis=-1)
    return causal_block_attention(q, k, v).reshape(B, S, MLA_VW)


def hier_moe(x, w_grp, b_grp, w_exp, b_exp, w_gate, w_up, w_down):
    B, S, D = x.shape
    T = B * S
    xt = x.reshape(T, D)
    grp_logits = (xt @ w_grp).astype(jnp.float32) + b_grp
    grp_prob = jax.nn.softmax(grp_logits, axis=-1)
    g_top = jnp.argmax(grp_logits, axis=-1)
    p_g = jnp.take_along_axis(grp_prob, g_top[:, None], axis=1)[:, 0]
    exp_logits = jnp.einsum('td,dge->tge', xt, w_exp).astype(jnp.float32) + b_exp
    sel = jnp.take_along_axis(exp_logits, g_top[:, None, None], axis=1)[:, 0]
    top_vals, top_idx = lax.top_k(sel, TOP_K)
    weights = p_g[:, None] * jax.nn.softmax(top_vals, axis=-1)
    expert_id = g_top[:, None] * EXPERTS_PER_GROUP + top_idx

    A = T * TOP_K
    flat_e = expert_id.reshape(A).astype(jnp.int32)
    order = jnp.argsort(flat_e)
    sorted_e = flat_e[order]
    counts = jnp.zeros((N_EXPERTS,), jnp.int32).at[flat_e].add(1)
    padded = (counts + MOE_BLOCK - 1) // MOE_BLOCK * MOE_BLOCK
    pad_end = jnp.cumsum(padded)
    pad_start = pad_end - padded
    start = jnp.cumsum(counts) - counts
    dest = pad_start[sorted_e] + jnp.arange(A, dtype=jnp.int32) - start[sorted_e]
    nb = -(-A // MOE_BLOCK) + N_EXPERTS
    row_token = jnp.full((nb * MOE_BLOCK,), T, jnp.int32).at[dest].set((order // TOP_K).astype(jnp.int32))
    block_expert = jnp.minimum(jnp.searchsorted(pad_end, jnp.arange(nb) * MOE_BLOCK, side='right'),
                               N_EXPERTS - 1)
    x_pad = jnp.concatenate([xt, jnp.zeros((1, D), xt.dtype)], axis=0)

    def run_block(args):
        tok, e = args
        xb = x_pad[tok]
        h = jax.nn.silu(xb @ w_gate[e]) * (xb @ w_up[e])
        return h @ w_down[e]

    y_rows = lax.map(run_block, (row_token.reshape(nb, MOE_BLOCK), block_expert))
    y_rows = y_rows.reshape(nb * MOE_BLOCK, D)
    y_assign = jnp.zeros((A, D), y_rows.dtype).at[order].set(y_rows[dest])
    y = jnp.sum(y_assign.reshape(T, TOP_K, D).astype(jnp.float32) * weights[..., None], axis=1)
    return y.reshape(B, S, D).astype(x.dtype)


def setup_inputs(seed: int = 0) -> dict:
    key = jax.random.key(seed)
    ks = iter(jax.random.split(key, 32))
    f32 = jnp.float32

    def nrm(shape, fan_in, scale=1.0):
        return jax.random.normal(next(ks), shape, f32) * (scale * fan_in ** -0.5)

    def gain(shape):
        return 1.0 + 0.02 * jax.random.normal(next(ks), shape, f32)

    def bias(shape):
        return 0.01 * jax.random.normal(next(ks), shape, f32)

    L = DEPTH
    return {
        "x": jax.random.normal(next(ks), (BATCH, SEQ, D_MODEL), f32),
        "p": jax.random.normal(next(ks), (DEPTH, BATCH, SEQ, PLE_DIM), f32),
        "positions": jnp.broadcast_to(jnp.arange(SEQ, dtype=jnp.int32)[None, :], (BATCH, SEQ)),
        "ln0_g": gain((D_MODEL,)),
        "ln0_b": bias((D_MODEL,)),
        "w_in": nrm((L, D_MODEL, IN_WIDTH), D_MODEL),
        "w_conv": nrm((L, SC_CONV, SC_WIDTH), SC_CONV),
        "w_gla_gate": nrm((L, GLA_GATE_RANK, GLA_QK), GLA_GATE_RANK),
        "b_gla_gate": bias((L, GLA_QK)),
        "gla_norm_g": gain((L, GLA_DV)),
        "mla_q_norm_g": gain((L, MLA_Q_RANK)),
        "mla_kv_norm_g": gain((L, MLA_KV_RANK)),
        "w_uq": nrm((L, MLA_Q_RANK, MLA_HEADS * MLA_QK), MLA_Q_RANK),
        "w_ukv": nrm((L, MLA_KV_RANK, MLA_HEADS * (MLA_NOPE + MLA_V)), MLA_KV_RANK),
        "w_br": nrm((L, BR_WIDTH, D_MODEL), SC_WIDTH, DN_BETA),
        "w_o": nrm((L, D_MODEL, D_MODEL), D_MODEL, DN_BETA),
        "ln1_g": gain((L, D_MODEL)),
        "ln1_b": bias((L, D_MODEL)),
        "w_grp": nrm((L, D_MODEL, N_GROUPS), D_MODEL),
        "b_grp": bias((L, N_GROUPS)),
        "w_exp": nrm((L, D_MODEL, N_GROUPS, EXPERTS_PER_GROUP), D_MODEL),
        "b_exp": bias((L, N_GROUPS, EXPERTS_PER_GROUP)),
        "w_gate": nrm((L, N_EXPERTS, D_MODEL, EXPERT_HIDDEN), D_MODEL),
        "w_up": nrm((L, N_EXPERTS, D_MODEL, EXPERT_HIDDEN), D_MODEL, DN_BETA),
        "w_down": nrm((L, N_EXPERTS, EXPERT_HIDDEN, D_MODEL), EXPERT_HIDDEN, DN_BETA),
        "ln2_g": gain((L, D_MODEL)),
        "ln2_b": bias((L, D_MODEL)),
        "w_ple_gate": nrm((L, D_MODEL, D_MODEL), D_MODEL),
        "b_ple_gate": bias((L, D_MODEL)),
        "w_ple_up": nrm((L, PLE_DIM, D_MODEL), PLE_DIM, DN_BETA),
        "ln3_g": gain((L, D_MODEL)),
        "ln3_b": bias((L, D_MODEL)),
    }


def reference(x, p, positions, ln0_g, ln0_b, w_in, w_conv, w_gla_gate, b_gla_gate, gla_norm_g,
              mla_q_norm_g, mla_kv_norm_g, w_uq, w_ukv, w_br, w_o, ln1_g, ln1_b,
              w_grp, b_grp, w_exp, b_exp, w_gate, w_up, w_down, ln2_g, ln2_b,
              w_ple_gate, b_ple_gate, w_ple_up, ln3_g, ln3_b):
    cos, sin = rope_tables(positions, MLA_ROPE)
    split_pts = _split_points()
    x = layer_norm(x, ln0_g, ln0_b)
    for i in range(DEPTH):
        h = x @ w_in[i]
        (a_b, a_c, a_x, gq, gk, gv, g_lr, g_r, c_q, c_kv, k_rope,
         gt_a, gt_b, gt_c) = jnp.split(h, split_pts, axis=-1)
        y_a = short_gated_conv(a_b, a_c, a_x, w_conv[i])
        log_a = jax.nn.log_sigmoid((g_lr @ w_gla_gate[i]).astype(jnp.float32) + b_gla_gate[i]) / GLA_TAU
        y_b = gla_chunked(gq, gk, gv, log_a, g_r, gla_norm_g[i])
        y_c = mla(c_q, c_kv, k_rope, mla_q_norm_g[i], mla_kv_norm_g[i],
                  w_uq[i], w_ukv[i], cos, sin)
        wb = w_br[i]
        merged = (jax.nn.sigmoid(gt_a) * (y_a @ wb[:SC_WIDTH])
                  + jax.nn.sigmoid(gt_b) * (y_b @ wb[SC_WIDTH:SC_WIDTH + GLA_VW])
                  + jax.nn.sigmoid(gt_c) * (y_c @ wb[SC_WIDTH + GLA_VW:]))
        x = layer_norm(DN_ALPHA * x + merged @ w_o[i], ln1_g[i], ln1_b[i])
        y_m = hier_moe(x, w_grp[i], b_grp[i], w_exp[i], b_exp[i], w_gate[i], w_up[i], w_down[i])
        x = layer_norm(DN_ALPHA * x + y_m, ln2_g[i], ln2_b[i])
        ple = jax.nn.sigmoid(x @ w_ple_gate[i] + b_ple_gate[i]) * (p[i] @ w_ple_up[i])
        x = layer_norm(DN_ALPHA * x + ple, ln3_g[i], ln3_b[i])
    return x
```

```cpp
#include <hip/hip_runtime.h>
#include <hip/hip_bf16.h>
#include <stdint.h>

constexpr int T = 16384, D = 1024, DEPTH = 4, PLE = 256;
constexpr int NE = 64, EH = 256;
constexpr int INW = 6608;
constexpr int O_GV = 2048;
constexpr float DN_ALPHA = 1.681792830507429f;
constexpr int LCAP = 32768;
#define LAS __attribute__((address_space(3)))
typedef unsigned short bf16_t;
typedef short bf16x8 __attribute__((ext_vector_type(8)));
typedef float f32x4 __attribute__((ext_vector_type(4)));
typedef float f32x16 __attribute__((ext_vector_type(16)));
typedef unsigned u32x4 __attribute__((ext_vector_type(4)));
typedef unsigned u32x2 __attribute__((ext_vector_type(2)));
constexpr int NBLK = 256, NTHR = 512;
constexpr int STAGE_BYTES = 131072, LDS_BYTES = 147456 + 512, XBW_OFF = 147456 + 256;
constexpr int HW = 6144;
constexpr int H_AB = 0, H_AC = 512, H_AX = 1024, H_GQ = 1536, H_GK = 1792, H_GR = 2048, H_CQ = 2560, H_CKV = 2816, H_KR = 2944, H_GLR = 3008, H_GTA = 3072, H_GTB = 4096, H_GTC = 5120;

__device__ __forceinline__ unsigned cvt_pk_bf16(float lo, float hi) { unsigned r; asm volatile("v_cvt_pk_bf16_f32 %0, %1, %2" : "=v"(r) : "v"(lo), "v"(hi)); return r; }
constexpr int WTAB_OFF = 147456;
__device__ __forceinline__ int tid_now() {
    const unsigned hw = (unsigned)__builtin_amdgcn_s_getreg((5 << 11) | 4) & 63u;
    extern __shared__ __attribute__((aligned(16))) unsigned char smem_tid[];
    const int w = __builtin_amdgcn_readfirstlane(*(volatile LAS int*)((LAS unsigned char*)smem_tid + WTAB_OFF + 4 * hw));
    int l = (int)__builtin_amdgcn_mbcnt_hi(~0u, __builtin_amdgcn_mbcnt_lo(~0u, 0u));
    asm volatile("" : "+v"(l));
    return w * 64 + l; }
__device__ __forceinline__ void tid_setup() {
    const unsigned hw = (unsigned)__builtin_amdgcn_s_getreg((5 << 11) | 4) & 63u;
    extern __shared__ __attribute__((aligned(16))) unsigned char smem_tid[];
    if ((threadIdx.x & 63) == 0) *(volatile LAS int*)((LAS unsigned char*)smem_tid + WTAB_OFF + 4 * hw) = (int)(threadIdx.x >> 6);
    __syncthreads(); }
__device__ __forceinline__ int sgpr_now(int v) { asm volatile("" : "+s"(v)); return v; }
__device__ __forceinline__ float bf2f(bf16_t b) { return __uint_as_float(((unsigned)b) << 16); }
__device__ __forceinline__ float bflo(unsigned w) { return __uint_as_float(w << 16); }
__device__ __forceinline__ float bfhi(unsigned w) { return __uint_as_float(w & 0xffff0000u); }

namespace ge {
constexpr int BM = 256, BK = 64, HALF = 128, HTB = HALF * BK * 2;
__device__ __forceinline__ int lds_byte(int r, int c) { const int st = (r >> 4) * 2 + (c >> 5), rr = r & 15, cc = c & 31, ob = rr * 64 + cc * 2; return st * 1024 + (ob ^ (((ob >> 9) & 1) << 5)); }
__device__ __forceinline__ void stage_rc(int b, int& R, int& C) { const int st = b / 1024, sb = b % 1024, swz = sb ^ (((sb >> 9) & 1) << 5); R = (st >> 1) * 16 + swz / 64; C = (st & 1) * 32 + (swz % 64) / 2; }
__device__ __forceinline__ int perm32(int rho) { const int n = rho >> 4, i = rho & 15; return 8 * (i >> 2) + 4 * n + (i & 3); }
struct Unit { int pm, pn, g; };
typedef f32x4 Acc[2][2][4][2];

template <class Epi, class Sched, bool GATHER>
__device__ __forceinline__ void gemm_stream(LAS unsigned char* lds, const int K, const int lda, const int ldb, const Sched& S, const Epi& E) {
    const int tid = tid_now(), wid = __builtin_amdgcn_readfirstlane(tid >> 6), lane = tid & 63, wr = wid >> 2, wc = wid & 3, fr = lane & 15, fq = lane >> 4;
    const int nt = K / BK;
    Unit cur, nxt; int ui = 0;
    if (!S.next(0, cur)) return;
    unsigned voffA[2][2], nvoffA[2][2], voffB[2][2];
#pragma unroll
    for (int i = 0; i < 2; ++i) { int R, C; stage_rc(tid * 16 + i * 8192, R, C); const int Rb = (R & ~31) + perm32(R & 31);
        voffB[0][i] = (unsigned)(Rb * ldb + C) * 2u; voffB[1][i] = (unsigned)((Rb + 128) * ldb + C) * 2u;
        if constexpr (GATHER) { voffA[0][i] = (unsigned)(S.arow(cur, R) * lda + C) * 2u; voffA[1][i] = (unsigned)(S.arow(cur, R + 128) * lda + C) * 2u; }
        else { voffA[0][i] = (unsigned)(R * lda + C) * 2u; voffA[1][i] = (unsigned)((R + 128) * lda + C) * 2u; }
        nvoffA[0][i] = voffA[0][i]; nvoffA[1][i] = voffA[1][i]; }
    const size_t kstep = (size_t)(BK * 2);
    const unsigned ldsw = (unsigned)wid * 1024u;
    const int aoff = lds_byte(wr * 64 + fr, fq * 8), boff = lds_byte(wc * 32 + fr, fq * 8);
#define GE_SA(b, h) (((b) * 2 + (h)) * HTB)
#define GE_SB(b, h) ((4 + (b) * 2 + (h)) * HTB)
#define GE_STAGE(bufoff, gbase, voff) do { _Pragma("unroll") for (int _i = 0; _i < 2; ++_i) \
        __builtin_amdgcn_global_load_lds((const unsigned*)((const char*)(gbase) + (voff)[_i]), (LAS unsigned*)(lds + (bufoff) + ldsw + _i * 8192), 16, 0, 0); } while (0)
#define GE_LDA(dst, b, h) do { _Pragma("unroll") for (int m = 0; m < 4; ++m) _Pragma("unroll") for (int k = 0; k < 2; ++k) dst[m][k] = *(const LAS bf16x8*)(lds + GE_SA(b, h) + aoff + m * 2048 + k * 1024); } while (0)
#define GE_LDB(dst, b, h) do { _Pragma("unroll") for (int n = 0; n < 2; ++n) _Pragma("unroll") for (int k = 0; k < 2; ++k) dst[n][k] = *(const LAS bf16x8*)(lds + GE_SB(b, h) + boff + n * 2048 + k * 1024); } while (0)
#define GE_MMA(ai, bj, At, Bt) do { __builtin_amdgcn_s_setprio(1); _Pragma("unroll") for (int m = 0; m < 4; ++m) _Pragma("unroll") for (int n = 0; n < 2; ++n) _Pragma("unroll") for (int k = 0; k < 2; ++k) \
        acc[ai][bj][m][n] = __builtin_amdgcn_mfma_f32_16x16x32_bf16(Bt[n][k], At[m][k], acc[ai][bj][m][n], 0, 0, 0); __builtin_amdgcn_s_setprio(0); } while (0)
#define GE_WAIT_V(n) asm volatile("s_waitcnt vmcnt(" #n ")" ::: "memory")
#define GE_WAIT_L(n) asm volatile("s_waitcnt lgkmcnt(" #n ")" ::: "memory")
#define GE_BAR __builtin_amdgcn_s_barrier()
#define GE_SCHED __builtin_amdgcn_sched_barrier(0)
    Acc acc;
#pragma unroll
    for (int a = 0; a < 2; ++a)
#pragma unroll
        for (int b = 0; b < 2; ++b)
#pragma unroll
            for (int m = 0; m < 4; ++m)
#pragma unroll
                for (int n = 0; n < 2; ++n) acc[a][b][m][n] = (f32x4){0.f, 0.f, 0.f, 0.f};
    bf16x8 At[4][2], B0[2][2], B1[2][2];
    const char* cA = S.aptr(cur); const char* cB = S.bptr(cur);
    GE_STAGE(GE_SB(0, 0), cB, voffB[0]); GE_STAGE(GE_SA(0, 0), cA, voffA[0]); GE_STAGE(GE_SB(0, 1), cB, voffB[1]); GE_STAGE(GE_SA(0, 1), cA, voffA[1]);
    if (wr == 1) GE_BAR;
    GE_WAIT_V(4); GE_BAR;
    GE_STAGE(GE_SB(1, 0), cB + kstep, voffB[0]); GE_STAGE(GE_SA(1, 0), cA + kstep, voffA[0]); GE_STAGE(GE_SB(1, 1), cB + kstep, voffB[1]);
    GE_WAIT_V(6); GE_BAR;
    for (;;) {
        const bool has_next = S.next(ui + 1, nxt);
        const char* nA = has_next ? S.aptr(nxt) : cA; const char* nB = has_next ? S.bptr(nxt) : cB;
#pragma unroll 1
        for (int t = 0; t < nt; t += 2) {
            const bool last = (t == nt - 2);
            const char* a1 = cA + (size_t)(t + 1) * kstep;
            const char* a2 = last ? nA : cA + (size_t)(t + 2) * kstep; const char* b2 = last ? nB : cB + (size_t)(t + 2) * kstep;
            const char* a3 = a2 + kstep; const char* b3 = b2 + kstep;
            if constexpr (GATHER) { if (last && has_next) {
#pragma unroll
                for (int i = 0; i < 2; ++i) { int R, C; stage_rc(tid * 16 + i * 8192, R, C);
                    nvoffA[0][i] = (unsigned)(S.arow(nxt, R) * lda + C) * 2u; nvoffA[1][i] = (unsigned)(S.arow(nxt, R + 128) * lda + C) * 2u; } } }
            unsigned va2[2][2];
#pragma unroll
            for (int h = 0; h < 2; ++h)
#pragma unroll
                for (int i = 0; i < 2; ++i) va2[h][i] = (GATHER && last) ? nvoffA[h][i] : voffA[h][i];
            GE_LDB(B0, 0, 0); GE_SCHED; GE_LDA(At, 0, 0); GE_STAGE(GE_SA(1, 1), a1, voffA[1]);
            GE_WAIT_L(8); GE_BAR; GE_WAIT_L(0); GE_MMA(0, 0, At, B0); GE_BAR; GE_SCHED;
            GE_LDB(B1, 0, 1); GE_STAGE(GE_SB(0, 0), b2, voffB[0]);
            GE_BAR; GE_WAIT_L(0); GE_MMA(0, 1, At, B1); GE_BAR;
            GE_LDA(At, 0, 1); GE_STAGE(GE_SA(0, 0), a2, va2[0]);
            GE_BAR; GE_WAIT_L(0); GE_MMA(1, 0, At, B0); GE_BAR; GE_SCHED;
            GE_STAGE(GE_SB(0, 1), b2, voffB[1]);
            GE_WAIT_V(6); GE_BAR; GE_MMA(1, 1, At, B1); GE_BAR;
            GE_LDB(B0, 1, 0); GE_SCHED; GE_LDA(At, 1, 0); GE_STAGE(GE_SA(0, 1), a2, va2[1]);
            GE_WAIT_L(8); GE_BAR; GE_WAIT_L(0); GE_MMA(0, 0, At, B0); GE_BAR; GE_SCHED;
            GE_LDB(B1, 1, 1); GE_STAGE(GE_SB(1, 0), b3, voffB[0]);
            GE_BAR; GE_WAIT_L(0); GE_MMA(0, 1, At, B1); GE_BAR;
            GE_LDA(At, 1, 1); GE_STAGE(GE_SA(1, 0), a3, va2[0]);
            GE_BAR; GE_WAIT_L(0); GE_MMA(1, 0, At, B0); GE_BAR; GE_SCHED;
            GE_STAGE(GE_SB(1, 1), b3, voffB[1]);
            GE_WAIT_V(6); GE_BAR; GE_MMA(1, 1, At, B1); GE_BAR;
        }
        { int tz = tid; asm volatile("" : "+v"(tz));
          const int wid2 = tz >> 6, lane2 = tz & 63; E(acc, cur, wid2 >> 2, wid2 & 3, lane2 & 15, lane2 >> 4); }
        if (!has_next) break;
#pragma unroll
        for (int a = 0; a < 2; ++a)
#pragma unroll
            for (int b = 0; b < 2; ++b)
#pragma unroll
                for (int m = 0; m < 4; ++m)
#pragma unroll
                    for (int n = 0; n < 2; ++n) acc[a][b][m][n] = (f32x4){0.f, 0.f, 0.f, 0.f};
        cur = nxt; cA = nA; cB = nB; ++ui;
        if (GATHER) {
#pragma unroll
            for (int h = 0; h < 2; ++h)
#pragma unroll
                for (int i = 0; i < 2; ++i) voffA[h][i] = nvoffA[h][i]; }
    }
    GE_WAIT_V(0);
    if (wr == 0) GE_BAR;
    GE_BAR;
#undef GE_SA
#undef GE_SB
#undef GE_STAGE
#undef GE_LDA
#undef GE_LDB
#undef GE_MMA
#undef GE_WAIT_V
#undef GE_WAIT_L
#undef GE_BAR
#undef GE_SCHED
}
__device__ __forceinline__ void tile_order(int L, int nM, int nN, int& pm, int& pn) {
    const int nwg = nM * nN; int wgid = L;
    { const int q = nwg / 8, r = nwg % 8, xcd = wgid % 8, off = wgid / 8; wgid = (xcd < r ? xcd * (q + 1) : r * (q + 1) + (xcd - r) * q) + off; }
    const int nig = 8 * nN, gid = wgid / nig, fm = gid * 8, gsz = (nM - fm) < 8 ? (nM - fm) : 8;
    pm = fm + ((wgid % nig) % gsz); pn = (wgid % nig) / gsz;
}
}
struct MapInMain { __device__ __forceinline__ int operator()(int s) const {
    if (s < 2048) return s;
    if (s < 2560) return 2576 + (s - 2048);
    if (s < 2816) return 3088 + (s - 2560);
    if (s < 2944) return 3344 + (s - 2816);
    if (s < 3008) return 3472 + (s - 2944);
    if (s < 3024) return 2560 + (s - 3008);
    if (s < 3072) return -1;
    return 3536 + (s - 3072); } };
struct MapOff { int off; __device__ __forceinline__ int operator()(int s) const { return off + s; } };struct MegaP {
    const float* w_in; bf16_t* Wb_in; bf16_t* Wb_gv; const bf16_t* Xb; bf16_t* Hp; bf16_t* GVt; float* ssq_q; float* ssq_kv;
};
struct SchedIn {
    const char* Xb; const char* Wm; const char* Wg; int c, G;
    __device__ __forceinline__ bool next(int i, ge::Unit& u) const {
        const int L = i * G + c; if (L >= 1664) return false;
        if (L < 1536) { u.g = 0; ge::tile_order(L, 64, 24, u.pm, u.pn); } else { u.g = 1; const int l = L - 1536; u.pm = l & 1; u.pn = l >> 1; }
        return true; }
    __device__ __forceinline__ const char* aptr(const ge::Unit& u) const { return u.g == 0 ? Xb + (size_t)u.pm * 256 * D * 2 : Wg + (size_t)u.pm * 256 * D * 2; }
    __device__ __forceinline__ const char* bptr(const ge::Unit& u) const { return u.g == 0 ? Wm + (size_t)u.pn * 256 * D * 2 : Xb + (size_t)u.pn * 256 * D * 2; }
};
struct EpiIn {
    bf16_t* Hp; bf16_t* GVt; float* ssq_q; float* ssq_kv;
    __device__ __forceinline__ void operator()(const ge::Acc& acc, const ge::Unit& u, int wr, int wc, int fr, int fq) const {
        if (u.g == 0) {
            const int row0 = u.pm * 256 + wr * 64 + fr, col0 = u.pn * 256 + wc * 32 + 8 * fq;
            const bool sg = u.pn >= 12;
#pragma unroll
            for (int ai = 0; ai < 2; ++ai)
#pragma unroll
                for (int m = 0; m < 4; ++m) { const int row = row0 + ai * 128 + m * 16; bf16_t* rp = Hp + (size_t)row * HW + col0;
                    float sq0 = 0.f, sq1 = 0.f;
#pragma unroll
                    for (int bj = 0; bj < 2; ++bj) { f32x4 v0 = acc[ai][bj][m][0], v1 = acc[ai][bj][m][1];
                        if (sg) {
#pragma unroll
                            for (int j = 0; j < 4; ++j) { v0[j] = 1.f / (1.f + __expf(-v0[j])); v1[j] = 1.f / (1.f + __expf(-v1[j])); } }
                        const float s = v0[0] * v0[0] + v0[1] * v0[1] + v0[2] * v0[2] + v0[3] * v0[3] + v1[0] * v1[0] + v1[1] * v1[1] + v1[2] * v1[2] + v1[3] * v1[3];
                        if (bj == 0) sq0 = s; else sq1 = s;
                        u32x4 o = {cvt_pk_bf16(v0[0], v0[1]), cvt_pk_bf16(v0[2], v0[3]), cvt_pk_bf16(v1[0], v1[1]), cvt_pk_bf16(v1[2], v1[3])};
                        *(u32x4*)(rp + bj * 128) = o; }
                    if (u.pn == 10 || u.pn == 11) {
                        float s = (u.pn == 10) ? (sq0 + sq1) : sq0;
                        s += __shfl_xor(s, 16); s += __shfl_xor(s, 32);
                        if (fq == 0) { float* dst = (u.pn == 10 ? ssq_q : ssq_kv); dst[(size_t)wc * T + row] = s; } } }
        } else {
#pragma unroll
            for (int ai = 0; ai < 2; ++ai)
#pragma unroll
                for (int m = 0; m < 4; ++m) { const int r = u.pm * 256 + ai * 128 + wr * 64 + m * 16 + fr, h = r >> 7, e = r & 127;
#pragma unroll
                    for (int bj = 0; bj < 2; ++bj) { const int t0 = u.pn * 256 + bj * 128 + wc * 32 + 8 * fq;
                        const int chunk = t0 >> 6, p0 = (t0 & 48) + ((t0 & 8) >> 1);
                        bf16_t* base = GVt + ((size_t)(chunk * 4 + h) * 128 + e) * 64;
                        const f32x4 v0 = acc[ai][bj][m][0], v1 = acc[ai][bj][m][1];
                        u32x2 o0 = {cvt_pk_bf16(v0[0], v0[1]), cvt_pk_bf16(v0[2], v0[3])}, o1 = {cvt_pk_bf16(v1[0], v1[1]), cvt_pk_bf16(v1[2], v1[3])};
                        *(u32x2*)(base + p0) = o0; *(u32x2*)(base + p0 + 8) = o1; } }
        }
    }
};
constexpr float QSCALE = 0.07216878364870322f * 1.4426950408889634f;
struct MapQ { __device__ __forceinline__ int operator()(int s) const {
    if (s < 512) return (s >> 7) * 192 + (s & 127);
    const int s2 = s - 512, bj = s2 >> 7, w = s2 & 127; return (w >> 5) * 192 + 128 + bj * 32 + (w & 31); } };
struct MapKV { int voff; __device__ __forceinline__ int operator()(int s) const { return (s >> 7) * 256 + voff + (s & 127); } };

struct MlaP {
    const float* w_uq; const float* w_ukv; const float* qn_g; const float* kvn_g;
    bf16_t* Wb_uq; bf16_t* Wb_uk; bf16_t* Wb_uv;
    const bf16_t* Hp; const float* ssq_q; const float* ssq_kv; const float* cs; const float* sn;
    bf16_t* Qb; bf16_t* KnImg; bf16_t* VtImg; bf16_t* KrImg; float* Opart; float* MLpart; float* Yc;
};
__device__ __forceinline__ float rstd4(const float* ssq, int row, float invw) {
    const float s = (ssq[row] + ssq[T + row]) + (ssq[2 * T + row] + ssq[3 * T + row]); return rsqrtf(s * invw + 1e-6f); }

template <int mode> struct SchedMla { const char* A; const char* B; int c, G;
    __device__ __forceinline__ bool next(int i, ge::Unit& u) const {
        const int L = i * G + c; u.g = mode;
        if (mode == 0) { if (L >= 192) return false; u.pm = L / 3; u.pn = L % 3; }
        else if (mode == 1) { if (L >= 128) return false; u.pm = L >> 1; u.pn = L & 1; }
        else { if (L >= 128) return false; u.pm = L & 1; u.pn = L >> 1; }
        return true; }
    __device__ __forceinline__ const char* aptr(const ge::Unit& u) const { return mode == 2 ? A + (size_t)u.pm * 256 * 256 * 2 : A + (size_t)u.pm * 256 * HW * 2; }
    __device__ __forceinline__ const char* bptr(const ge::Unit& u) const { return mode == 2 ? B + (size_t)u.pn * 256 * HW * 2 : B + (size_t)u.pn * 256 * 256 * 2; }
};
template <int MODE> struct EpiMla { MlaP p;
    __device__ __forceinline__ void operator()(const ge::Acc& acc, const ge::Unit& u, int wr, int wc, int fr, int fq) const {
        if constexpr (MODE == 0) {
#pragma unroll
            for (int ai = 0; ai < 2; ++ai)
#pragma unroll
                for (int m = 0; m < 4; ++m) { asm volatile("" ::: "memory"); const int t = u.pm * 256 + ai * 128 + wr * 64 + m * 16 + fr; const float rs = rstd4(p.ssq_q, t, 1.f / 256.f) * QSCALE;
                    if (u.pn < 2) {
#pragma unroll
                        for (int bj = 0; bj < 2; ++bj) { const int c0 = u.pn * 256 + bj * 128 + wc * 32 + 8 * fq, head = c0 >> 7, dim = c0 & 127;
                            const f32x4 v0 = acc[ai][bj][m][0] * rs, v1 = acc[ai][bj][m][1] * rs;
                            u32x4 o = {cvt_pk_bf16(v0[0], v0[1]), cvt_pk_bf16(v0[2], v0[3]), cvt_pk_bf16(v1[0], v1[1]), cvt_pk_bf16(v1[2], v1[3])};
                            *(u32x4*)(p.Qb + (size_t)t * 768 + head * 192 + dim) = o; }
                    } else { const int head = wc, i0 = 8 * fq;
                        float o1[8], o2[8];
#pragma unroll
                        for (int n = 0; n < 2; ++n) { const f32x4 c4 = *(const f32x4*)(p.cs + (size_t)t * 32 + i0 + 4 * n), s4 = *(const f32x4*)(p.sn + (size_t)t * 32 + i0 + 4 * n);
#pragma unroll
                            for (int j = 0; j < 4; ++j) { const float x1 = acc[ai][0][m][n][j] * rs, x2 = acc[ai][1][m][n][j] * rs; o1[4 * n + j] = x1 * c4[j] - x2 * s4[j]; o2[4 * n + j] = x1 * s4[j] + x2 * c4[j]; } }
                        u32x4 a = {cvt_pk_bf16(o1[0], o1[1]), cvt_pk_bf16(o1[2], o1[3]), cvt_pk_bf16(o1[4], o1[5]), cvt_pk_bf16(o1[6], o1[7])};
                        u32x4 b = {cvt_pk_bf16(o2[0], o2[1]), cvt_pk_bf16(o2[2], o2[3]), cvt_pk_bf16(o2[4], o2[5]), cvt_pk_bf16(o2[6], o2[7])};
                        *(u32x4*)(p.Qb + (size_t)t * 768 + head * 192 + 128 + i0) = a; *(u32x4*)(p.Qb + (size_t)t * 768 + head * 192 + 160 + i0) = b; } }
        } else if constexpr (MODE == 1) {
#pragma unroll
            for (int ai = 0; ai < 2; ++ai)
#pragma unroll
                for (int m = 0; m < 4; ++m) { asm volatile("" ::: "memory"); const int t = u.pm * 256 + ai * 128 + wr * 64 + m * 16 + fr; const float rs = rstd4(p.ssq_kv, t, 1.f / 128.f);
                    const int tile = t >> 6, key = t & 63;
#pragma unroll
                    for (int bj = 0; bj < 2; ++bj) { const int c0 = u.pn * 256 + bj * 128 + wc * 32 + 8 * fq, head = c0 >> 7, chunk = (c0 & 127) >> 3;
                        const f32x4 v0 = acc[ai][bj][m][0] * rs, v1 = acc[ai][bj][m][1] * rs;
                        u32x4 o = {cvt_pk_bf16(v0[0], v0[1]), cvt_pk_bf16(v0[2], v0[3]), cvt_pk_bf16(v1[0], v1[1]), cvt_pk_bf16(v1[2], v1[3])};
                        *(u32x4*)((char*)p.KnImg + ((size_t)(head * 256 + tile) * 16384) + key * 256 + ((chunk ^ (key & 15)) << 4)) = o; } }
        } else {
#pragma unroll
            for (int bj = 0; bj < 2; ++bj) { const int t0 = u.pn * 256 + bj * 128 + wc * 32 + 8 * fq;
                float rs[8];
#pragma unroll
                for (int j = 0; j < 8; ++j) rs[j] = rstd4(p.ssq_kv, t0 + j, 1.f / 128.f);
                const int tile = t0 >> 6, p0 = (t0 & 48) + ((t0 & 8) >> 1);
#pragma unroll
                for (int ai = 0; ai < 2; ++ai)
#pragma unroll
                    for (int m = 0; m < 4; ++m) { asm volatile("" ::: "memory"); const int r = u.pm * 256 + ai * 128 + wr * 64 + m * 16 + fr, head = r >> 7, d = r & 127;
                        char* base = (char*)p.VtImg + ((size_t)(head * 256 + tile) * 16384) + d * 128;
                        const f32x4 v0 = acc[ai][bj][m][0], v1 = acc[ai][bj][m][1];
                        u32x2 o0 = {cvt_pk_bf16(v0[0] * rs[0], v0[1] * rs[1]), cvt_pk_bf16(v0[2] * rs[2], v0[3] * rs[3])};
                        u32x2 o1 = {cvt_pk_bf16(v1[0] * rs[4], v1[1] * rs[5]), cvt_pk_bf16(v1[2] * rs[6], v1[3] * rs[7])};
                        const int sw = (d >> 1) & 7, pa = p0, pb = p0 + 8;
                        *(u32x2*)(base + (((pa >> 3) ^ sw) << 4) + (pa & 7) * 2) = o0;
                        *(u32x2*)(base + (((pb >> 3) ^ sw) << 4) + (pb & 7) * 2) = o1; } }
        }
    }
};
__device__ __forceinline__ void kr_phase(const MlaP& p, int gtid, int gthreads) {
    for (int idx = gtid; idx < T * 4; idx += gthreads) { const int t = idx >> 2, c = idx & 3, i0 = 8 * c;
        const u32x4 a = *(const u32x4*)(p.Hp + (size_t)t * HW + H_KR + i0), b = *(const u32x4*)(p.Hp + (size_t)t * HW + H_KR + 32 + i0);
        float o1[8], o2[8];
#pragma unroll
        for (int n = 0; n < 2; ++n) { const f32x4 c4 = *(const f32x4*)(p.cs + (size_t)t * 32 + i0 + 4 * n), s4 = *(const f32x4*)(p.sn + (size_t)t * 32 + i0 + 4 * n);
#pragma unroll
            for (int j = 0; j < 4; ++j) { const int e = 4 * n + j; const unsigned wa = a[e >> 1], wb = b[e >> 1];
                const float x1 = (e & 1) ? bfhi(wa) : bflo(wa), x2 = (e & 1) ? bfhi(wb) : bflo(wb);
                o1[e] = x1 * c4[j] - x2 * s4[j]; o2[e] = x1 * s4[j] + x2 * c4[j]; } }
        u32x4 oa = {cvt_pk_bf16(o1[0], o1[1]), cvt_pk_bf16(o1[2], o1[3]), cvt_pk_bf16(o1[4], o1[5]), cvt_pk_bf16(o1[6], o1[7])};
        u32x4 ob = {cvt_pk_bf16(o2[0], o2[1]), cvt_pk_bf16(o2[2], o2[3]), cvt_pk_bf16(o2[4], o2[5]), cvt_pk_bf16(o2[6], o2[7])};
        const int tile = t >> 6, key = t & 63, sw = (key >> 1) & 7;
        char* base = (char*)p.KrImg + (size_t)tile * 8192 + key * 128;
        *(u32x4*)(base + ((c ^ sw) << 4)) = oa; *(u32x4*)(base + (((c + 4) ^ sw) << 4)) = ob; }
}
constexpr int ATT_STEPS = 130;
__device__ __forceinline__ void attn_item(LAS unsigned char* lds, const MlaP& p, int head, int b, int j0, int j1, int slot) {
    const int tid = tid_now(), wid = __builtin_amdgcn_readfirstlane(tid >> 6), lane = tid & 63, q = lane & 31, hh = lane >> 5;
    const int trow = b * 256 + wid * 32 + q;
    bf16x8 qf[12];
    { const bf16_t* qp = p.Qb + (size_t)trow * 768 + head * 192 + 8 * hh;
#pragma unroll
      for (int s = 0; s < 12; ++s) qf[s] = *(const bf16x8*)(qp + 16 * s); }
    f32x16 O[4];
#pragma unroll
    for (int d = 0; d < 4; ++d)
#pragma unroll
        for (int r = 0; r < 16; ++r) O[d][r] = 0.f;
    float m_run = -1e30f, l_run = 0.f;
    const char* knb = (const char*)p.KnImg + (size_t)head * 256 * 16384; const char* vtb = (const char*)p.VtImg + (size_t)head * 256 * 16384; const char* krb = (const char*)p.KrImg;
    const unsigned lo = (unsigned)lane * 16u;
#define AT_ISSUE(j, bi) do { const unsigned _bo = (unsigned)(bi) * 40960u; \
        __builtin_amdgcn_global_load_lds((const unsigned*)(knb + (size_t)(j) * 16384 + (wid * 2) * 1024 + lo), (LAS unsigned*)(lds + _bo + (wid * 2) * 1024), 16, 0, 0); \
        __builtin_amdgcn_global_load_lds((const unsigned*)(knb + (size_t)(j) * 16384 + (wid * 2 + 1) * 1024 + lo), (LAS unsigned*)(lds + _bo + (wid * 2 + 1) * 1024), 16, 0, 0); \
        __builtin_amdgcn_global_load_lds((const unsigned*)(krb + (size_t)(j) * 8192 + wid * 1024 + lo), (LAS unsigned*)(lds + _bo + 16384 + wid * 1024), 16, 0, 0); \
        __builtin_amdgcn_global_load_lds((const unsigned*)(vtb + (size_t)(j) * 16384 + (wid * 2) * 1024 + lo), (LAS unsigned*)(lds + _bo + 24576 + (wid * 2) * 1024), 16, 0, 0); \
        __builtin_amdgcn_global_load_lds((const unsigned*)(vtb + (size_t)(j) * 16384 + (wid * 2 + 1) * 1024 + lo), (LAS unsigned*)(lds + _bo + 24576 + (wid * 2 + 1) * 1024), 16, 0, 0); } while (0)
    const int kn_off0 = q * 256, kn_sw = q & 15, kr_off0 = q * 128, kr_sw = (q >> 1) & 7;
    const int vt_sw = (q >> 1) & 7;
    AT_ISSUE(j0, 0);
    for (int j = j0; j < j1; ++j) {
        const int cur = (j - j0) & 1;
        if (j + 1 < j1) { AT_ISSUE(j + 1, cur ^ 1); asm volatile("s_waitcnt vmcnt(5)" ::: "memory"); }
        else { asm volatile("s_waitcnt vmcnt(0)" ::: "memory"); }
        __builtin_amdgcn_s_barrier(); asm volatile("" ::: "memory");
        const int jj = j - 4 * b;
        if (!(jj >= 0 && 64 * jj > 32 * wid + 31)) {
            LAS unsigned char* bb = lds + cur * 40960;
            f32x16 S0, S1;
#pragma unroll
            for (int r = 0; r < 16; ++r) { S0[r] = 0.f; S1[r] = 0.f; }
#pragma unroll
            for (int s = 0; s < 8; ++s) {
                const bf16x8 k0 = *(const LAS bf16x8*)(bb + kn_off0 + (((2 * s + hh) ^ kn_sw) << 4));
                const bf16x8 k1 = *(const LAS bf16x8*)(bb + 8192 + kn_off0 + (((2 * s + hh) ^ kn_sw) << 4));
                S0 = __builtin_amdgcn_mfma_f32_32x32x16_bf16(k0, qf[s], S0, 0, 0, 0);
                S1 = __builtin_amdgcn_mfma_f32_32x32x16_bf16(k1, qf[s], S1, 0, 0, 0); }
#pragma unroll
            for (int s = 0; s < 4; ++s) {
                const bf16x8 k0 = *(const LAS bf16x8*)(bb + 16384 + kr_off0 + (((2 * s + hh) ^ kr_sw) << 4));
                const bf16x8 k1 = *(const LAS bf16x8*)(bb + 16384 + 4096 + kr_off0 + (((2 * s + hh) ^ kr_sw) << 4));
                S0 = __builtin_amdgcn_mfma_f32_32x32x16_bf16(k0, qf[8 + s], S0, 0, 0, 0);
                S1 = __builtin_amdgcn_mfma_f32_32x32x16_bf16(k1, qf[8 + s], S1, 0, 0, 0); }
            if (jj >= 0) {
                const int dq = wid * 32 + q - 64 * jj - 4 * hh;
                const float NEG = -__builtin_inff();
#pragma unroll
                for (int r = 0; r < 16; ++r) { const int c = (r & 3) + 8 * (r >> 2);
                    if (c > dq) S0[r] = NEG;
                    if (c + 32 > dq) S1[r] = NEG; } }
            float mx = S0[0];
#pragma unroll
            for (int r = 1; r < 16; ++r) mx = fmaxf(mx, S0[r]);
#pragma unroll
            for (int r = 0; r < 16; ++r) mx = fmaxf(mx, S1[r]);
            { auto rr = __builtin_amdgcn_permlane32_swap(__float_as_uint(mx), __float_as_uint(mx), false, false); mx = fmaxf(__uint_as_float(rr[0]), __uint_as_float(rr[1])); }
            const float mn = fmaxf(m_run, mx), alpha = __builtin_amdgcn_exp2f(m_run - mn);
            m_run = mn;
            float sum = 0.f;
#pragma unroll
            for (int r = 0; r < 16; ++r) { S0[r] = __builtin_amdgcn_exp2f(S0[r] - mn); S1[r] = __builtin_amdgcn_exp2f(S1[r] - mn); sum += S0[r] + S1[r]; }
            l_run = l_run * alpha + sum;
            bf16x8 pf[4];
#pragma unroll
            for (int h2 = 0; h2 < 2; ++h2) {
                u32x4 a = {cvt_pk_bf16(S0[8 * h2 + 0], S0[8 * h2 + 1]), cvt_pk_bf16(S0[8 * h2 + 2], S0[8 * h2 + 3]), cvt_pk_bf16(S0[8 * h2 + 4], S0[8 * h2 + 5]), cvt_pk_bf16(S0[8 * h2 + 6], S0[8 * h2 + 7])};
                u32x4 c = {cvt_pk_bf16(S1[8 * h2 + 0], S1[8 * h2 + 1]), cvt_pk_bf16(S1[8 * h2 + 2], S1[8 * h2 + 3]), cvt_pk_bf16(S1[8 * h2 + 4], S1[8 * h2 + 5]), cvt_pk_bf16(S1[8 * h2 + 6], S1[8 * h2 + 7])};
                pf[h2] = *(bf16x8*)&a; pf[2 + h2] = *(bf16x8*)&c; }
#pragma unroll
            for (int d = 0; d < 4; ++d) {
#pragma unroll
                for (int r = 0; r < 16; ++r) O[d][r] *= alpha;
#pragma unroll
                for (int s2 = 0; s2 < 4; ++s2) {
                    const bf16x8 vf = *(const LAS bf16x8*)(bb + 24576 + (d * 32 + q) * 128 + (((2 * s2 + hh) ^ vt_sw) << 4));
                    O[d] = __builtin_amdgcn_mfma_f32_32x32x16_bf16(vf, pf[s2], O[d], 0, 0, 0); } }
        }
        asm volatile("" ::: "memory"); __builtin_amdgcn_s_barrier(); asm volatile("" ::: "memory");
    }
#undef AT_ISSUE
    { auto rr = __builtin_amdgcn_permlane32_swap(__float_as_uint(l_run), __float_as_uint(l_run), false, false); l_run = __uint_as_float(rr[0]) + __uint_as_float(rr[1]); }
    float* op = p.Opart + ((size_t)slot * 256 + wid * 32 + q) * 128 + 4 * hh;
#pragma unroll
    for (int d = 0; d < 4; ++d)
#pragma unroll
        for (int g = 0; g < 4; ++g) { f32x4 v = {O[d][4 * g], O[d][4 * g + 1], O[d][4 * g + 2], O[d][4 * g + 3]}; *(f32x4*)(op + d * 32 + g * 8) = v; }
    if (hh == 0) { float* ml = p.MLpart + ((size_t)slot * 256 + wid * 32 + q) * 2; ml[0] = m_run; ml[1] = l_run; }
}
__device__ __forceinline__ void attn_phase(LAS unsigned char* lds, const MlaP& p, int c) {
    int L = ATT_STEPS * c; const int Lend = L + ATT_STEPS;
    while (L < Lend) {
        const int head = L / 8320, rem = L - head * 8320;
        int b = (int)((sqrtf(1.f + 2.f * (float)rem) - 1.f) * 0.5f);
        while (2 * b * (b + 1) > rem) --b;
        while (2 * (b + 1) * (b + 2) <= rem) ++b;
        const int j0 = rem - 2 * b * (b + 1), nt = 4 * (b + 1);
        const int j1 = min(nt, j0 + (Lend - L));
        attn_item(lds, p, head, b, j0, j1, head * 64 + b + c);
        L += j1 - j0;
    }
}
struct GlaP {
    const bf16_t* Hp; const bf16_t* GVt; const float* wg; const float* bg; const float* ng; const float* wconv;
    bf16_t* QE; float* OI; float* kvT; float* decay; bf16_t* spT; bf16_t* Yab; bf16_t* Ybb; bf16_t* Ycb;
    const float* Opart; const float* MLpart;
};
__device__ __forceinline__ int pos16(int i) { return (i & 48) | ((i & 4) << 1) | ((i & 8) >> 1) | (i & 3); }
__device__ __forceinline__ void gla_g1(LAS unsigned char* lds, const GlaP& p, int c, int G) {
    const int tid = tid_now(), wid = __builtin_amdgcn_readfirstlane(tid >> 6), lane = tid & 63, l31 = lane & 31, hh = lane >> 5;
    LAS float* bsm = (LAS float*)lds; LAS float* gtot = (LAS float*)(lds + 17408); LAS float* blast = (LAS float*)(lds + 19456);
    LAS unsigned char* qeL = lds + 20480; LAS unsigned char* keL = lds + 28672; LAS unsigned char* ktL = lds + 36864;
    const int eb = wid & 3, hb = wid >> 2;
    for (int u = c; u < 1024; u += G) {
        const int n = u >> 2, h = u & 3;
        bf16x8 vf[4];
        { const bf16_t* vp = p.GVt + ((size_t)u * 128 + eb * 32 + l31) * 64 + 8 * hh;
#pragma unroll
          for (int s4 = 0; s4 < 4; ++s4) vf[s4] = *(const bf16x8*)(vp + 16 * s4); }
        { const int d = tid & 63, g = tid >> 6;
          float w[16];
#pragma unroll
          for (int r = 0; r < 16; ++r) w[r] = p.wg[r * 256 + h * 64 + d];
          const float bias = p.bg[h * 64 + d];
          float cs[8]; float run = 0.f;
#pragma unroll
          for (int k = 0; k < 8; ++k) { const int i = 8 * g + k;
              const u32x4 g0 = *(const u32x4*)(p.Hp + (size_t)(64 * n + i) * HW + H_GLR), g1 = *(const u32x4*)(p.Hp + (size_t)(64 * n + i) * HW + H_GLR + 8);
              float la = bias;
#pragma unroll
              for (int r = 0; r < 4; ++r) { la += bflo(g0[r]) * w[2 * r] + bfhi(g0[r]) * w[2 * r + 1]; la += bflo(g1[r]) * w[8 + 2 * r] + bfhi(g1[r]) * w[8 + 2 * r + 1]; }
              const float ls = (fminf(la, 0.f) - log1pf(expf(-fabsf(la)))) * (1.f / 16.f);
              run += ls; cs[k] = run; }
          gtot[g * 64 + d] = run;
          __syncthreads();
          float pre = 0.f, tot = 0.f;
#pragma unroll
          for (int gg = 0; gg < 8; ++gg) { const float v = gtot[gg * 64 + d]; tot += v; if (gg < g) pre += v; }
#pragma unroll
          for (int k = 0; k < 8; ++k) bsm[(8 * g + k) * 68 + d] = pre + cs[k];
          if (g == 0) { blast[d] = tot; p.decay[(size_t)u * 64 + d] = expf(tot); } }
        __syncthreads();
        { const int i = tid >> 3, cc = tid & 7, d0 = 8 * cc; const size_t t = (size_t)64 * n + i;
          const u32x4 qv = *(const u32x4*)(p.Hp + t * HW + H_GQ + h * 64 + d0), kv = *(const u32x4*)(p.Hp + t * HW + H_GK + h * 64 + d0);
          float b[8], bl[8];
          { const f32x4 b0 = *(const LAS f32x4*)(bsm + i * 68 + d0), b1 = *(const LAS f32x4*)(bsm + i * 68 + d0 + 4), l0 = *(const LAS f32x4*)(blast + d0), l1 = *(const LAS f32x4*)(blast + d0 + 4);
#pragma unroll
            for (int j = 0; j < 4; ++j) { b[j] = b0[j]; b[4 + j] = b1[j]; bl[j] = l0[j]; bl[4 + j] = l1[j]; } }
          float qe[8], ke[8], kt[8];
#pragma unroll
          for (int j = 0; j < 8; ++j) { const float qq = (j & 1) ? bfhi(qv[j >> 1]) : bflo(qv[j >> 1]), kk = (j & 1) ? bfhi(kv[j >> 1]) : bflo(kv[j >> 1]);
              qe[j] = qq * 0.125f * expf(b[j]); ke[j] = kk * expf(-b[j]); kt[j] = kk * expf(bl[j] - b[j]); }
          const u32x4 qo = {cvt_pk_bf16(qe[0], qe[1]), cvt_pk_bf16(qe[2], qe[3]), cvt_pk_bf16(qe[4], qe[5]), cvt_pk_bf16(qe[6], qe[7])};
          const u32x4 ko = {cvt_pk_bf16(ke[0], ke[1]), cvt_pk_bf16(ke[2], ke[3]), cvt_pk_bf16(ke[4], ke[5]), cvt_pk_bf16(ke[6], ke[7])};
          const int sw = (i >> 1) & 7;
          *(LAS u32x4*)(qeL + i * 128 + ((cc ^ sw) << 4)) = qo; *(LAS u32x4*)(keL + i * 128 + ((cc ^ sw) << 4)) = ko;
          *(u32x4*)(p.QE + t * 256 + h * 64 + d0) = qo;
          const int pi = pos16(i);
#pragma unroll
          for (int j = 0; j < 8; ++j) { const int d = d0 + j; const unsigned pk = cvt_pk_bf16(kt[j], 0.f);
              *(LAS unsigned short*)(ktL + d * 128 + (((pi >> 3) ^ ((d >> 1) & 7)) << 4) + (pi & 7) * 2) = (unsigned short)pk; } }
        __syncthreads();
        { f32x16 OT, KV;
#pragma unroll
          for (int r = 0; r < 16; ++r) { OT[r] = 0.f; KV[r] = 0.f; }
          const int sw = (l31 >> 1) & 7;
#pragma unroll
          for (int jb = 0; jb < 2; ++jb) {
              if (jb <= hb) {
                  f32x16 Sc;
#pragma unroll
                  for (int r = 0; r < 16; ++r) Sc[r] = 0.f;
#pragma unroll
                  for (int s = 0; s < 4; ++s) {
                      const bf16x8 ka = *(const LAS bf16x8*)(keL + (32 * jb + l31) * 128 + (((2 * s + hh) ^ sw) << 4));
                      const bf16x8 qb = *(const LAS bf16x8*)(qeL + (32 * hb + l31) * 128 + (((2 * s + hh) ^ sw) << 4));
                      Sc = __builtin_amdgcn_mfma_f32_32x32x16_bf16(ka, qb, Sc, 0, 0, 0); }
                  if (jb == hb) {
#pragma unroll
                      for (int r = 0; r < 16; ++r) { const int j = (r & 3) + 8 * (r >> 2) + 4 * hh; if (j > l31) Sc[r] = 0.f; } }
#pragma unroll
                  for (int h2 = 0; h2 < 2; ++h2) {
                      u32x4 a = {cvt_pk_bf16(Sc[8 * h2 + 0], Sc[8 * h2 + 1]), cvt_pk_bf16(Sc[8 * h2 + 2], Sc[8 * h2 + 3]), cvt_pk_bf16(Sc[8 * h2 + 4], Sc[8 * h2 + 5]), cvt_pk_bf16(Sc[8 * h2 + 6], Sc[8 * h2 + 7])};
                      OT = __builtin_amdgcn_mfma_f32_32x32x16_bf16(vf[2 * jb + h2], *(bf16x8*)&a, OT, 0, 0, 0); } } }
#pragma unroll
          for (int s4 = 0; s4 < 4; ++s4) {
              const bf16x8 kb = *(const LAS bf16x8*)(ktL + (32 * hb + l31) * 128 + (((2 * s4 + hh) ^ sw) << 4));
              KV = __builtin_amdgcn_mfma_f32_32x32x16_bf16(vf[s4], kb, KV, 0, 0, 0); }
          float* oi = p.OI + ((size_t)u * 8 + wid) * 1024 + lane;
#pragma unroll
          for (int r = 0; r < 16; ++r) oi[r * 64] = OT[r];
          float* kp = p.kvT + (size_t)u * 8192 + 32 * hb + l31;
#pragma unroll
          for (int r = 0; r < 16; ++r) { const int e = 32 * eb + (r & 3) + 8 * (r >> 2) + 4 * hh; kp[e * 64] = KV[r]; } }
        __syncthreads();
    }
}
__device__ __forceinline__ void gla_g2(const GlaP& p, int c) {
    if (tid_now() >= 128) return;
    const int idx = c * 128 + tid_now(), h = idx >> 13, ed = idx & 8191, d = idx & 63;
    float st = 0.f;
    for (int n0 = 0; n0 < 256; n0 += 8) {
        float kv[8], dc[8];
#pragma unroll
        for (int k = 0; k < 8; ++k) { const size_t u = (size_t)(n0 + k) * 4 + h; kv[k] = p.kvT[u * 8192 + ed]; dc[k] = p.decay[u * 64 + d]; }
#pragma unroll
        for (int k = 0; k < 8; ++k) { const size_t u = (size_t)(n0 + k) * 4 + h; p.spT[u * 8192 + ed] = (bf16_t)(cvt_pk_bf16(st, 0.f) & 0xffffu); st = fmaf(dc[k], st, kv[k]); }
    }
}
__device__ __forceinline__ void gla_g3(LAS unsigned char* lds, const GlaP& p, int c, int G) {
    const int tid = tid_now(), wid = __builtin_amdgcn_readfirstlane(tid >> 6), lane = tid & 63, l31 = lane & 31, hh = lane >> 5;
    LAS float* red = (LAS float*)lds;
    const int eb = wid & 3, ib = wid >> 2;
    for (int u = c; u < 1024; u += G) {
        const int n = u >> 2, h = u & 3;
        f32x16 O;
        { const float* oi = p.OI + ((size_t)u * 8 + wid) * 1024 + lane;
#pragma unroll
          for (int r = 0; r < 16; ++r) O[r] = oi[r * 64]; }
        const size_t t = (size_t)64 * n + 32 * ib + l31;
        { const bf16_t* sp = p.spT + ((size_t)u * 128 + 32 * eb + l31) * 64 + 8 * hh; const bf16_t* qp = p.QE + t * 256 + h * 64 + 8 * hh;
#pragma unroll
          for (int s = 0; s < 4; ++s) { const bf16x8 a = *(const bf16x8*)(sp + 16 * s), b = *(const bf16x8*)(qp + 16 * s); O = __builtin_amdgcn_mfma_f32_32x32x16_bf16(a, b, O, 0, 0, 0); } }
        float ss = 0.f;
#pragma unroll
        for (int r = 0; r < 16; ++r) ss += O[r] * O[r];
        { auto rr = __builtin_amdgcn_permlane32_swap(__float_as_uint(ss), __float_as_uint(ss), false, false); ss = __uint_as_float(rr[0]) + __uint_as_float(rr[1]); }
        __syncthreads();
        if (hh == 0) red[eb * 64 + 32 * ib + l31] = ss;
        __syncthreads();
        const int ti = 32 * ib + l31;
        const float tot = (red[ti] + red[64 + ti]) + (red[128 + ti] + red[192 + ti]);
        const float rs = rsqrtf(tot * (1.f / 128.f) + 1e-6f);
#pragma unroll
        for (int g = 0; g < 4; ++g) { const int e0 = 32 * eb + 8 * g + 4 * hh;
            const u32x2 rv = *(const u32x2*)(p.Hp + t * HW + H_GR + h * 128 + e0); const f32x4 gn = *(const f32x4*)(p.ng + e0);
            float y[4];
#pragma unroll
            for (int j = 0; j < 4; ++j) { const float r_ = (j & 1) ? bfhi(rv[j >> 1]) : bflo(rv[j >> 1]); y[j] = O[4 * g + j] * rs * gn[j] * (r_ / (1.f + __expf(-r_))); }
            u32x2 o = {cvt_pk_bf16(y[0], y[1]), cvt_pk_bf16(y[2], y[3])};
            *(u32x2*)(p.Ybb + t * 512 + h * 128 + e0) = o; }
    }
}
__device__ __forceinline__ void conv_phase(const GlaP& p, int gtid, int gthreads) {
    for (int idx = gtid; idx < T * 64; idx += gthreads) { const int t = idx >> 6, c0 = (idx & 63) * 8;
        float y[8];
#pragma unroll
        for (int j = 0; j < 8; ++j) y[j] = 0.f;
#pragma unroll
        for (int k = 0; k < 3; ++k) { const int tt = t - 2 + k; if (tt >= 0) {
            const u32x4 a = *(const u32x4*)(p.Hp + (size_t)tt * HW + H_AC + c0), x = *(const u32x4*)(p.Hp + (size_t)tt * HW + H_AX + c0);
            const f32x4 w0 = *(const f32x4*)(p.wconv + k * 512 + c0), w1 = *(const f32x4*)(p.wconv + k * 512 + c0 + 4);
#pragma unroll
            for (int j = 0; j < 4; ++j) { y[2 * j] += (j < 2 ? w0[2 * j] : w1[2 * j - 4]) * (bflo(a[j]) * bflo(x[j])); y[2 * j + 1] += (j < 2 ? w0[2 * j + 1] : w1[2 * j - 3]) * (bfhi(a[j]) * bfhi(x[j])); } } }
        const u32x4 b = *(const u32x4*)(p.Hp + (size_t)t * HW + H_AB + c0);
        u32x4 o;
#pragma unroll
        for (int j = 0; j < 4; ++j) o[j] = cvt_pk_bf16(bflo(b[j]) * y[2 * j], bfhi(b[j]) * y[2 * j + 1]);
        *(u32x4*)(p.Yab + (size_t)t * 512 + c0) = o; }
}
__device__ __forceinline__ void attn_combine_bf16(const GlaP& p, int gtid, int gthreads) {
    for (int idx = gtid; idx < 256 * 256 * 32; idx += gthreads) {
        const int dq = idx & 31, row = (idx >> 5) & 255, g = idx >> 13, head = g >> 6, b = g & 63;
        const int Ls = head * 8320 + 2 * b * (b + 1), Le = Ls + 4 * (b + 1);
        const int c0 = Ls / ATT_STEPS, c1 = (Le - 1) / ATT_STEPS;
        float M = -1e30f;
        for (int c = c0; c <= c1; ++c) M = fmaxf(M, p.MLpart[((size_t)(g + c) * 256 + row) * 2]);
        f32x4 acc = {0.f, 0.f, 0.f, 0.f}; float l = 0.f;
        for (int c = c0; c <= c1; ++c) { const size_t sl = (size_t)(g + c) * 256 + row; const float w = __builtin_amdgcn_exp2f(p.MLpart[sl * 2] - M);
            l += w * p.MLpart[sl * 2 + 1]; const f32x4 o = *(const f32x4*)(p.Opart + sl * 128 + dq * 4); acc += o * w; }
        const float il = 1.f / l;
        u32x2 o = {cvt_pk_bf16(acc[0] * il, acc[1] * il), cvt_pk_bf16(acc[2] * il, acc[3] * il)};
        *(u32x2*)(p.Ycb + (size_t)(b * 256 + row) * 512 + head * 128 + dq * 4) = o;
    }
}
struct P {
    const float *x, *pin; const int* pos;
    const float *ln0_g, *ln0_b, *w_in, *w_conv, *w_gg, *b_gg, *gla_ng, *qn_g, *kvn_g, *w_uq, *w_ukv, *w_br, *w_o, *ln1_g, *ln1_b, *w_grp, *b_grp, *w_exp, *b_exp,
                *w_gate, *w_up, *w_down, *ln2_g, *ln2_b, *w_pg, *b_pg, *w_pu, *ln3_g, *ln3_b;
    float* out;
    float *X, *Z, *cs, *sn, *ssq_q, *ssq_kv, *OI, *kvT, *decay, *MLpart, *ew;
    bf16_t *Xb, *Hp, *GVt, *Qb, *KnImg, *VtImg, *KrImg, *QE, *spT, *Yab, *Ybb, *Ycb, *Mgb, *Hbuf, *Ys, *Ub, *Pb;
    bf16_t *Wb_in, *Wb_gv, *Wb_uq, *Wb_uk, *Wb_uv, *Wb_br, *Wb_o, *Wb_gu, *Wb_d, *Wb_pg, *Wb_pu;
    int *cnt, *lists; unsigned* bar;
};
__device__ __forceinline__ MegaP mk_mega(const P& p) { MegaP m; m.w_in = p.w_in; m.Wb_in = p.Wb_in; m.Wb_gv = p.Wb_gv; m.Xb = p.Xb; m.Hp = p.Hp; m.GVt = p.GVt; m.ssq_q = p.ssq_q; m.ssq_kv = p.ssq_kv; return m; }
__device__ __forceinline__ MlaP mk_mla(const P& p) { MlaP q; q.w_uq = p.w_uq; q.w_ukv = p.w_ukv; q.qn_g = p.qn_g; q.kvn_g = p.kvn_g; q.Wb_uq = p.Wb_uq; q.Wb_uk = p.Wb_uk; q.Wb_uv = p.Wb_uv; q.Hp = p.Hp;
    q.ssq_q = p.ssq_q; q.ssq_kv = p.ssq_kv; q.cs = p.cs; q.sn = p.sn; q.Qb = p.Qb; q.KnImg = p.KnImg; q.VtImg = p.VtImg; q.KrImg = p.KrImg; q.Opart = p.Z; q.MLpart = p.MLpart; q.Yc = nullptr; return q; }
__device__ __forceinline__ GlaP mk_gla(const P& p, int layer) { GlaP g; g.Hp = p.Hp; g.GVt = p.GVt; g.wg = p.w_gg + layer * 16 * 256; g.bg = p.b_gg + layer * 256; g.ng = p.gla_ng + layer * 128; g.wconv = p.w_conv + layer * 3 * 512;
    g.QE = p.QE; g.OI = p.OI; g.kvT = p.kvT; g.decay = p.decay; g.spT = p.spT; g.Yab = p.Yab; g.Ybb = p.Ybb; g.Ycb = p.Ycb; g.Opart = p.Z; g.MLpart = p.MLpart; return g; }

template <class Map, class OMap>
__device__ __forceinline__ void convert_tile(const float* __restrict__ W, int ldw, int Ksrc, bf16_t* __restrict__ Bt, int ldbt, int n0, int k0, const Map& map, const OMap& omap, const float* __restrict__ rs, float* tile) {
    const int tid = tid_now();
    __syncthreads();
    { const int i = tid & 63, j = tid >> 6; const int col = map(n0 + i);
#pragma unroll
      for (int r = 0; r < 8; ++r) { const int k = k0 + j * 8 + r; float v = 0.f;
          if (col >= 0 && k < Ksrc) { v = W[(size_t)k * ldw + col]; if (rs) v *= rs[k]; }
          tile[(j * 8 + r) * 65 + i] = v; } }
    __syncthreads();
    { const int kk = (tid & 31) * 2, nn = tid >> 5;
#pragma unroll
      for (int r = 0; r < 4; ++r) { const int n = nn + 16 * r;
          *(unsigned*)(Bt + (size_t)omap(n0 + n) * ldbt + k0 + kk) = cvt_pk_bf16(tile[kk * 65 + n], tile[(kk + 1) * 65 + n]); } }
}
struct MapId { __device__ __forceinline__ int operator()(int s) const { return s; } };
struct OMapGU { int up; __device__ __forceinline__ int operator()(int n) const { return (n >> 7) * 256 + up * 128 + (n & 127); } };
__device__ __forceinline__ void ph_convert(LAS unsigned char* ldsl, const P& p, int layer) {
    float* tile = (float*)(unsigned char*)ldsl;
    const int c = blockIdx.x, G = gridDim.x;
    constexpr int S0 = 1536, S1 = S0 + 128, S2 = S1 + 48, S3 = S2 + 32, S4 = S3 + 32, S5 = S4 + 384, S6 = S5 + 256, S7 = S6 + 256, S8 = S7 + 64, S9 = S8 + 4096, S10 = S9 + 4096, S11 = S10 + 4096;
    for (int t = c; t < S11; t += G) {
        if (t < S0) { const int nk = 16; convert_tile(p.w_in + (size_t)layer * D * INW, INW, D, p.Wb_in, D, (t / nk) * 64, (t % nk) * 64, MapInMain{}, MapId{}, nullptr, tile); }
        else if (t < S1) { const int u = t - S0, nk = 16; convert_tile(p.w_in + (size_t)layer * D * INW, INW, D, p.Wb_gv, D, (u / nk) * 64, (u % nk) * 64, MapOff{O_GV}, MapId{}, nullptr, tile); }
        else if (t < S2) { const int u = t - S1, nk = 4; convert_tile(p.w_uq + (size_t)layer * 256 * 768, 768, 256, p.Wb_uq, 256, (u / nk) * 64, (u % nk) * 64, MapQ{}, MapId{}, p.qn_g + layer * 256, tile); }
        else if (t < S3) { const int u = t - S2, nk = 4; convert_tile(p.w_ukv + (size_t)layer * 128 * 1024, 1024, 128, p.Wb_uk, 256, (u / nk) * 64, (u % nk) * 64, MapKV{0}, MapId{}, p.kvn_g + layer * 128, tile); }
        else if (t < S4) { const int u = t - S3, nk = 4; convert_tile(p.w_ukv + (size_t)layer * 128 * 1024, 1024, 128, p.Wb_uv, 256, (u / nk) * 64, (u % nk) * 64, MapKV{128}, MapId{}, p.kvn_g + layer * 128, tile); }
        else if (t < S5) { const int u = t - S4, br = u / 128, v = u % 128, nk = 8;
            convert_tile(p.w_br + (size_t)layer * 1536 * D + (size_t)br * 512 * D, D, 512, p.Wb_br + (size_t)br * 1024 * 512, 512, (v / nk) * 64, (v % nk) * 64, MapId{}, MapId{}, nullptr, tile); }
        else if (t < S6) { const int u = t - S5, nk = 16; convert_tile(p.w_o + (size_t)layer * D * D, D, D, p.Wb_o, D, (u / nk) * 64, (u % nk) * 64, MapId{}, MapId{}, nullptr, tile); }
        else if (t < S7) { const int u = t - S6, nk = 16; convert_tile(p.w_pg + (size_t)layer * D * D, D, D, p.Wb_pg, D, (u / nk) * 64, (u % nk) * 64, MapId{}, MapId{}, nullptr, tile); }
        else if (t < S8) { const int u = t - S7, nk = 4; convert_tile(p.w_pu + (size_t)layer * PLE * D, D, PLE, p.Wb_pu, PLE, (u / nk) * 64, (u % nk) * 64, MapId{}, MapId{}, nullptr, tile); }
        else if (t < S9) { const int u = t - S8, e = u >> 6, v = u & 63, nk = 16;
            convert_tile(p.w_gate + ((size_t)layer * NE + e) * D * EH, EH, D, p.Wb_gu + (size_t)e * 512 * D, D, (v / nk) * 64, (v % nk) * 64, MapId{}, OMapGU{0}, nullptr, tile); }
        else if (t < S10) { const int u = t - S9, e = u >> 6, v = u & 63, nk = 16;
            convert_tile(p.w_up + ((size_t)layer * NE + e) * D * EH, EH, D, p.Wb_gu + (size_t)e * 512 * D, D, (v / nk) * 64, (v % nk) * 64, MapId{}, OMapGU{1}, nullptr, tile); }
        else { const int u = t - S10, e = u >> 6, v = u & 63, nk = 4;
            convert_tile(p.w_down + ((size_t)layer * NE + e) * EH * D, D, EH, p.Wb_d + (size_t)e * D * EH, EH, (v / nk) * 64, (v % nk) * 64, MapId{}, MapId{}, nullptr, tile); }
    }
    __syncthreads();
}

__device__ __forceinline__ float wsum(float v) {
#pragma unroll
    for (int o = 32; o > 0; o >>= 1) v += __shfl_xor(v, o);
    return v; }
template <int MODE>
__device__ __forceinline__ void ph_rows(const P& p, int layer) {
    const int lane = tid_now() & 63, gw = blockIdx.x * 8 + (tid_now() >> 6), nw = gridDim.x * 8;
    const float* gp = MODE == 0 ? p.ln0_g : MODE == 1 ? p.ln1_g + layer * D : MODE == 2 ? p.ln2_g + layer * D : p.ln3_g + layer * D;
    const float* bp = MODE == 0 ? p.ln0_b : MODE == 1 ? p.ln1_b + layer * D : MODE == 2 ? p.ln2_b + layer * D : p.ln3_b + layer * D;
    f32x4 gg[4], bb[4];
#pragma unroll
    for (int i = 0; i < 4; ++i) { gg[i] = *(const f32x4*)(gp + 256 * i + 4 * lane); bb[i] = *(const f32x4*)(bp + 256 * i + 4 * lane); }
    const float* in = MODE == 0 ? p.x : MODE == 2 ? p.X : p.Z;
    float* outf = (MODE == 3 && layer == DEPTH - 1) ? p.out : p.X;
    for (int row = gw; row < T; row += nw) {
        f32x4 v[4];
#pragma unroll
        for (int i = 0; i < 4; ++i) v[i] = *(const f32x4*)(in + (size_t)row * D + 256 * i + 4 * lane);
        if constexpr (MODE == 2) { const float w0 = p.ew[2 * row], w1 = p.ew[2 * row + 1];
#pragma unroll
            for (int i = 0; i < 4; ++i) { const u32x2 y0 = *(const u32x2*)(p.Ys + (size_t)(2 * row) * D + 256 * i + 4 * lane), y1 = *(const u32x2*)(p.Ys + (size_t)(2 * row + 1) * D + 256 * i + 4 * lane);
                v[i][0] = DN_ALPHA * v[i][0] + (w0 * bflo(y0[0]) + w1 * bflo(y1[0])); v[i][1] = DN_ALPHA * v[i][1] + (w0 * bfhi(y0[0]) + w1 * bfhi(y1[0]));
                v[i][2] = DN_ALPHA * v[i][2] + (w0 * bflo(y0[1]) + w1 * bflo(y1[1])); v[i][3] = DN_ALPHA * v[i][3] + (w0 * bfhi(y0[1]) + w1 * bfhi(y1[1])); } }
        float s = 0.f;
#pragma unroll
        for (int i = 0; i < 4; ++i) s += (v[i][0] + v[i][1]) + (v[i][2] + v[i][3]);
        const float mu = wsum(s) * (1.f / D);
        float q = 0.f;
#pragma unroll
        for (int i = 0; i < 4; ++i) { v[i] = v[i] - mu; q += (v[i][0] * v[i][0] + v[i][1] * v[i][1]) + (v[i][2] * v[i][2] + v[i][3] * v[i][3]); }
        const float rs = rsqrtf(wsum(q) * (1.f / D) + 1e-5f);
#pragma unroll
        for (int i = 0; i < 4; ++i) { v[i] = v[i] * rs * gg[i] + bb[i];
            *(f32x4*)(outf + (size_t)row * D + 256 * i + 4 * lane) = v[i];
            u32x2 o = {cvt_pk_bf16(v[i][0], v[i][1]), cvt_pk_bf16(v[i][2], v[i][3])};
            *(u32x2*)(p.Xb + (size_t)row * D + 256 * i + 4 * lane) = o; }
        if constexpr (MODE == 1) {
            const float* wg = p.w_grp + (size_t)layer * D * 8; const float* we = p.w_exp + (size_t)layer * D * 64;
            float gl[8];
#pragma unroll
            for (int g = 0; g < 8; ++g) gl[g] = 0.f;
#pragma unroll
            for (int i = 0; i < 4; ++i)
#pragma unroll
                for (int j = 0; j < 4; ++j) { const int k = 256 * i + 4 * lane + j; const f32x4 a = *(const f32x4*)(wg + k * 8), b = *(const f32x4*)(wg + k * 8 + 4); const float xv = v[i][j];
                    gl[0] = fmaf(xv, a[0], gl[0]); gl[1] = fmaf(xv, a[1], gl[1]); gl[2] = fmaf(xv, a[2], gl[2]); gl[3] = fmaf(xv, a[3], gl[3]);
                    gl[4] = fmaf(xv, b[0], gl[4]); gl[5] = fmaf(xv, b[1], gl[5]); gl[6] = fmaf(xv, b[2], gl[6]); gl[7] = fmaf(xv, b[3], gl[7]); }
            float mx = -INFINITY; int gt = 0;
#pragma unroll
            for (int g = 0; g < 8; ++g) { gl[g] = wsum(gl[g]) + p.b_grp[layer * 8 + g]; if (gl[g] > mx) { mx = gl[g]; gt = g; } }
            gt = __builtin_amdgcn_readfirstlane(gt);
            float sum = 0.f;
#pragma unroll
            for (int g = 0; g < 8; ++g) sum += expf(gl[g] - mx);
            const float pg = 1.f / sum;
            float el[8];
#pragma unroll
            for (int e = 0; e < 8; ++e) el[e] = 0.f;
#pragma unroll
            for (int i = 0; i < 4; ++i)
#pragma unroll
                for (int j = 0; j < 4; ++j) { const int k = 256 * i + 4 * lane + j; const f32x4 a = *(const f32x4*)(we + k * 64 + gt * 8), b = *(const f32x4*)(we + k * 64 + gt * 8 + 4); const float xv = v[i][j];
                    el[0] = fmaf(xv, a[0], el[0]); el[1] = fmaf(xv, a[1], el[1]); el[2] = fmaf(xv, a[2], el[2]); el[3] = fmaf(xv, a[3], el[3]);
                    el[4] = fmaf(xv, b[0], el[4]); el[5] = fmaf(xv, b[1], el[5]); el[6] = fmaf(xv, b[2], el[6]); el[7] = fmaf(xv, b[3], el[7]); }
            float v1 = -INFINITY, v2 = -INFINITY; int i1 = 0, i2 = 0;
#pragma unroll
            for (int e = 0; e < 8; ++e) { const float vv = wsum(el[e]) + p.b_exp[layer * 64 + gt * 8 + e];
                if (vv > v1) { v2 = v1; i2 = i1; v1 = vv; i1 = e; } else if (vv > v2) { v2 = vv; i2 = e; } }
            if (lane == 0) { const float e2 = expf(v2 - v1), w1 = pg / (1.f + e2), w2 = pg * e2 / (1.f + e2);
                const int ea = gt * 8 + i1, eb = gt * 8 + i2; int* cn = p.cnt + layer * 64;
                p.ew[2 * row] = w1; p.ew[2 * row + 1] = w2;
                const int pa = atomicAdd(&cn[ea], 1); p.lists[ea * LCAP + pa] = 2 * row;
                const int pb = atomicAdd(&cn[eb], 1); p.lists[eb * LCAP + pb] = 2 * row + 1; }
        }
    }
}
__device__ __forceinline__ void ph_prologue(const P& p) {
    const int gtid = blockIdx.x * NTHR + tid_now(), gth = gridDim.x * NTHR;
    for (int idx = gtid; idx < T * 32; idx += gth) { const int t = idx >> 5, i = idx & 31;
        const float inv = (float)(1.0 / pow(10000.0, (double)(2 * i) / 64.0)); const float ang = (float)p.pos[t] * inv;
        p.cs[idx] = (float)cos((double)ang); p.sn[idx] = (float)sin((double)ang); }
    for (size_t i = gtid; i < (size_t)DEPTH * T * PLE / 4; i += gth) { const f32x4 v = ((const f32x4*)p.pin)[i]; u32x2 o = {cvt_pk_bf16(v[0], v[1]), cvt_pk_bf16(v[2], v[3])}; ((u32x2*)p.Pb)[i] = o; }
    ph_rows<0>(p, 0);
}

struct SchedBr { const char* Ya; const char* Yb; const char* Yc; const char* W; int c, G;
    __device__ __forceinline__ bool next(int i, ge::Unit& u) const { const int tile = (i / 3) * G + c; if (tile >= 256) return false; u.g = i % 3; ge::tile_order(tile, 64, 4, u.pm, u.pn); return true; }
    __device__ __forceinline__ const char* aptr(const ge::Unit& u) const { return (u.g == 0 ? Ya : u.g == 1 ? Yb : Yc) + (size_t)u.pm * 256 * 512 * 2; }
    __device__ __forceinline__ const char* bptr(const ge::Unit& u) const { return W + ((size_t)u.g * 1024 + u.pn * 256) * 512 * 2; } };
struct EpiBr { const bf16_t* Hp; float* Mt; bf16_t* Mgb;
    __device__ __forceinline__ void operator()(const ge::Acc& acc, const ge::Unit& u, int wr, int wc, int fr, int fq) const {
        const int row0 = u.pm * 256 + wr * 64 + fr, col0 = u.pn * 256 + wc * 32 + 8 * fq;
#pragma unroll
        for (int ai = 0; ai < 2; ++ai)
#pragma unroll
            for (int m = 0; m < 4; ++m) { asm volatile("" ::: "memory"); const int row = row0 + ai * 128 + m * 16;
#pragma unroll
                for (int bj = 0; bj < 2; ++bj) { const int col = col0 + bj * 128;
                    const u32x4 gt = *(const u32x4*)(Hp + (size_t)row * HW + H_GTA + u.g * 1024 + col);
                    f32x4 v0 = acc[ai][bj][m][0], v1 = acc[ai][bj][m][1];
                    v0[0] *= bflo(gt[0]); v0[1] *= bfhi(gt[0]); v0[2] *= bflo(gt[1]); v0[3] *= bfhi(gt[1]); v1[0] *= bflo(gt[2]); v1[1] *= bfhi(gt[2]); v1[2] *= bflo(gt[3]); v1[3] *= bfhi(gt[3]);
                    float* mp = Mt + (size_t)row * D + col;
                    if (u.g > 0) { v0 += *(const f32x4*)mp; v1 += *(const f32x4*)(mp + 4); }
                    if (u.g < 2) { *(f32x4*)mp = v0; *(f32x4*)(mp + 4) = v1; }
                    else { u32x4 o = {cvt_pk_bf16(v0[0], v0[1]), cvt_pk_bf16(v0[2], v0[3]), cvt_pk_bf16(v1[0], v1[1]), cvt_pk_bf16(v1[2], v1[3])}; *(u32x4*)(Mgb + (size_t)row * D + col) = o; } } }
    } };
struct SchedT4 { const char* A; const char* B; int lda2, ldb2, c, G;
    __device__ __forceinline__ bool next(int i, ge::Unit& u) const { const int L = i * G + c; if (L >= 256) return false; u.g = 0; ge::tile_order(L, 64, 4, u.pm, u.pn); return true; }
    __device__ __forceinline__ const char* aptr(const ge::Unit& u) const { return A + (size_t)u.pm * lda2; }
    __device__ __forceinline__ const char* bptr(const ge::Unit& u) const { return B + (size_t)u.pn * ldb2; } };
struct EpiRes { const float* X; float* Z;
    __device__ __forceinline__ void operator()(const ge::Acc& acc, const ge::Unit& u, int wr, int wc, int fr, int fq) const {
        const int row0 = u.pm * 256 + wr * 64 + fr, col0 = u.pn * 256 + wc * 32 + 8 * fq;
#pragma unroll
        for (int ai = 0; ai < 2; ++ai)
#pragma unroll
            for (int m = 0; m < 4; ++m) { asm volatile("" ::: "memory"); const size_t o = (size_t)(row0 + ai * 128 + m * 16) * D + col0;
#pragma unroll
                for (int bj = 0; bj < 2; ++bj) { const f32x4 x0 = *(const f32x4*)(X + o + bj * 128), x1 = *(const f32x4*)(X + o + bj * 128 + 4);
                    *(f32x4*)(Z + o + bj * 128) = x0 * DN_ALPHA + acc[ai][bj][m][0]; *(f32x4*)(Z + o + bj * 128 + 4) = x1 * DN_ALPHA + acc[ai][bj][m][1]; } }
    } };
struct EpiU { bf16_t* Ub;
    __device__ __forceinline__ void operator()(const ge::Acc& acc, const ge::Unit& u, int wr, int wc, int fr, int fq) const {
        const int row0 = u.pm * 256 + wr * 64 + fr, col0 = u.pn * 256 + wc * 32 + 8 * fq;
#pragma unroll
        for (int ai = 0; ai < 2; ++ai)
#pragma unroll
            for (int m = 0; m < 4; ++m) { const size_t o = (size_t)(row0 + ai * 128 + m * 16) * D + col0;
#pragma unroll
                for (int bj = 0; bj < 2; ++bj) { const f32x4 v0 = acc[ai][bj][m][0], v1 = acc[ai][bj][m][1];
                    u32x4 w = {cvt_pk_bf16(v0[0], v0[1]), cvt_pk_bf16(v0[2], v0[3]), cvt_pk_bf16(v1[0], v1[1]), cvt_pk_bf16(v1[2], v1[3])}; *(u32x4*)(Ub + o + bj * 128) = w; } }
    } };
struct EpiPle { const float* X; float* Z; const bf16_t* Ub; const float* bias;
    __device__ __forceinline__ void operator()(const ge::Acc& acc, const ge::Unit& u, int wr, int wc, int fr, int fq) const {
        const int row0 = u.pm * 256 + wr * 64 + fr, col0 = u.pn * 256 + wc * 32 + 8 * fq;
        f32x4 bv[2][2];
#pragma unroll
        for (int bj = 0; bj < 2; ++bj) { bv[bj][0] = *(const f32x4*)(bias + col0 + bj * 128); bv[bj][1] = *(const f32x4*)(bias + col0 + bj * 128 + 4); }
#pragma unroll
        for (int ai = 0; ai < 2; ++ai)
#pragma unroll
            for (int m = 0; m < 4; ++m) { asm volatile("" ::: "memory"); const size_t o = (size_t)(row0 + ai * 128 + m * 16) * D + col0;
#pragma unroll
                for (int bj = 0; bj < 2; ++bj) { const f32x4 x0 = *(const f32x4*)(X + o + bj * 128), x1 = *(const f32x4*)(X + o + bj * 128 + 4); const u32x4 uu = *(const u32x4*)(Ub + o + bj * 128);
                    f32x4 g0 = acc[ai][bj][m][0] + bv[bj][0], g1 = acc[ai][bj][m][1] + bv[bj][1];
#pragma unroll
                    for (int j = 0; j < 4; ++j) { g0[j] = 1.f / (1.f + __expf(-g0[j])); g1[j] = 1.f / (1.f + __expf(-g1[j])); }
                    f32x4 u0 = {bflo(uu[0]), bfhi(uu[0]), bflo(uu[1]), bfhi(uu[1])}, u1 = {bflo(uu[2]), bfhi(uu[2]), bflo(uu[3]), bfhi(uu[3])};
                    *(f32x4*)(Z + o + bj * 128) = x0 * DN_ALPHA + g0 * u0; *(f32x4*)(Z + o + bj * 128 + 4) = x1 * DN_ALPHA + g1 * u1; } }
    } };

__device__ __forceinline__ void moe_table(LAS unsigned char* lds, const int* cnt) {
    LAS int* te = (LAS int*)(lds + 131072); LAS int* tr = te + 256; LAS int* cl = tr + 256; LAS int* nt = cl + 64;
    __syncthreads();
    if (tid_now() < 64) cl[tid_now()] = cnt[tid_now()];
    __syncthreads();
    if (tid_now() == 0) { int n = 0; for (int e = 0; e < NE; ++e) for (int r = 0; r < cl[e]; r += 256) { te[n] = e; tr[n] = r; ++n; } nt[0] = n; }
    __syncthreads();
}
struct SchedM1 { const char* Xb; const char* W; const int* lists; LAS int* te; int c, G;
    __device__ __forceinline__ bool next(int i, ge::Unit& u) const { const int L = i * G + c; if (L >= 2 * te[576]) return false; u.pm = L >> 1; u.pn = L & 1; u.g = te[u.pm]; return true; }
    __device__ __forceinline__ int arow(const ge::Unit& u, int r) const { const int n = te[512 + u.g], idx = min(te[256 + u.pm] + r, n - 1); return lists[u.g * LCAP + idx] >> 1; }
    __device__ __forceinline__ const char* aptr(const ge::Unit&) const { return Xb; }
    __device__ __forceinline__ const char* bptr(const ge::Unit& u) const { return W + ((size_t)u.g * 512 + u.pn * 256) * D * 2; } };
struct EpiM1 { bf16_t* Hbuf;
    __device__ __forceinline__ void operator()(const ge::Acc& acc, const ge::Unit& u, int wr, int wc, int fr, int fq) const {
#pragma unroll
        for (int ai = 0; ai < 2; ++ai)
#pragma unroll
            for (int m = 0; m < 4; ++m) { const int row = ai * 128 + wr * 64 + m * 16 + fr;
                float h[8];
#pragma unroll
                for (int n = 0; n < 2; ++n)
#pragma unroll
                    for (int j = 0; j < 4; ++j) { const float g = acc[ai][0][m][n][j], uu = acc[ai][1][m][n][j]; h[4 * n + j] = g / (1.f + __expf(-g)) * uu; }
                u32x4 o = {cvt_pk_bf16(h[0], h[1]), cvt_pk_bf16(h[2], h[3]), cvt_pk_bf16(h[4], h[5]), cvt_pk_bf16(h[6], h[7])};
                *(u32x4*)(Hbuf + ((size_t)u.pm * 256 + row) * EH + u.pn * 128 + wc * 32 + 8 * fq) = o; }
    } };
struct SchedM2 { const char* Hb; const char* W; LAS int* te; int c, G;
    __device__ __forceinline__ bool next(int i, ge::Unit& u) const { const int L = i * G + c; if (L >= 4 * te[576]) return false; u.pm = L >> 2; u.pn = L & 3; u.g = te[u.pm]; return true; }
    __device__ __forceinline__ const char* aptr(const ge::Unit& u) const { return Hb + (size_t)u.pm * 256 * EH * 2; }
    __device__ __forceinline__ const char* bptr(const ge::Unit& u) const { return W + ((size_t)u.g * D + u.pn * 256) * EH * 2; } };
struct EpiM2 { bf16_t* Ys; const int* lists; LAS int* te;
    __device__ __forceinline__ void operator()(const ge::Acc& acc, const ge::Unit& u, int wr, int wc, int fr, int fq) const {
        const int r0 = te[256 + u.pm], n = te[512 + u.g];
#pragma unroll
        for (int ai = 0; ai < 2; ++ai)
#pragma unroll
            for (int m = 0; m < 4; ++m) { const int row = r0 + ai * 128 + wr * 64 + m * 16 + fr;
                if (row < n) { const int a = lists[u.g * LCAP + row];
#pragma unroll
                    for (int bj = 0; bj < 2; ++bj) { const f32x4 v0 = acc[ai][bj][m][0], v1 = acc[ai][bj][m][1];
                        u32x4 o = {cvt_pk_bf16(v0[0], v0[1]), cvt_pk_bf16(v0[2], v0[3]), cvt_pk_bf16(v1[0], v1[1]), cvt_pk_bf16(v1[2], v1[3])};
                        *(u32x4*)(Ys + (size_t)a * D + u.pn * 256 + bj * 128 + wc * 32 + 8 * fq) = o; } } }
    } };

#define XB_TMO      128
#define XB_XCNT(j)  (256  + 64 * (j))
#define XB_XSUB(j)  (1280 + 64 * (j))
#define XB_XGEN(j)  (2304 + 64 * (j))
#define XB_TOP      3328
#define XB_TOPGEN   3392
#define XCD_BAR_WORDS 3456
#define XB_SPIN_CAP (1u << 18)

__device__ __forceinline__ unsigned xb_ld(unsigned* p)              { return __hip_atomic_load(p, __ATOMIC_RELAXED, __HIP_MEMORY_SCOPE_AGENT); }
__device__ __forceinline__ unsigned xb_add(unsigned* p, unsigned v) { return __hip_atomic_fetch_add(p, v, __ATOMIC_RELAXED, __HIP_MEMORY_SCOPE_AGENT); }
__device__ __forceinline__ unsigned xb_xcc_id() { return (unsigned)__builtin_amdgcn_s_getreg((3 << 11) | 20) & 0xFu; }
#define XB_SPIN(cond, bar) do { unsigned _sp = 0; while (cond) { __builtin_amdgcn_s_sleep(1); \
    if ((++_sp & 255u) == 0u) { if (xb_ld(&(bar)[XB_TMO])) break; if (_sp > XB_SPIN_CAP) { atomicAdd(&(bar)[XB_TMO], 1u); break; } } } } while (0)

struct XcdBarrier {
    unsigned* bar; unsigned x;
    volatile LAS unsigned* st;
};

__device__ __forceinline__ XcdBarrier xcd_barrier_post(unsigned* bar, volatile LAS unsigned* st) {
    XcdBarrier b; b.bar = bar; b.x = xb_xcc_id(); b.st = st;
    if (threadIdx.x == 0) (void)xb_add(&bar[XB_XCNT(b.x)], 1u);
    return b;
}
__device__ __forceinline__ void xcd_barrier_complete(unsigned* bar, unsigned x, unsigned& nloc, unsigned& nx) {
    const unsigned G = gridDim.x * gridDim.y * gridDim.z;
    unsigned sum, cnt, mine, sp = 0u;
    for (;;) {
        sum = 0u; cnt = 0u; mine = 0u;
#pragma unroll
        for (unsigned j = 0; j < 16; ++j) { const unsigned c = xb_ld(&bar[XB_XCNT(j)]); sum += c; cnt += (c > 0u) ? 1u : 0u; mine = (j == x) ? c : mine; }
        if (sum == G) break;
        __builtin_amdgcn_s_sleep(1);
        if ((++sp & 255u) == 0u) { if (xb_ld(&bar[XB_TMO])) break; if (sp > XB_SPIN_CAP) { atomicAdd(&bar[XB_TMO], 1u); break; } }
    }
    nloc = mine > 0u ? mine : 1u; nx = cnt > 0u ? cnt : 1u;
}

__device__ __forceinline__ void xcd_barrier(const XcdBarrier& b) {
    asm volatile("s_waitcnt vmcnt(0)" ::: "memory");
    __syncthreads();
    if (threadIdx.x == 0) {
        unsigned* bar = b.bar;
        __builtin_amdgcn_s_waitcnt(0);
        unsigned nloc = b.st[0], nx = b.st[1];
        if (nloc == 0u) { xcd_barrier_complete(bar, b.x, nloc, nx); b.st[0] = nloc; b.st[1] = nx; }
        const unsigned old = xb_add(&bar[XB_XSUB(b.x)], 1u);
        const unsigned gen = old / nloc;
        if (old + 1u == (gen + 1u) * nloc) {
            __builtin_amdgcn_fence(__ATOMIC_RELEASE, "agent");
            asm volatile("s_waitcnt vmcnt(0)" ::: "memory");
            const unsigned og = xb_add(&bar[XB_TOP], 1u);
            const unsigned tg = og / nx;
            if (og + 1u == (tg + 1u) * nx) xb_add(&bar[XB_TOPGEN], 1u);
            else XB_SPIN(xb_ld(&bar[XB_TOPGEN]) == tg, bar);
            __builtin_amdgcn_fence(__ATOMIC_ACQUIRE, "agent");
            xb_add(&bar[XB_XGEN(b.x)], 1u);
            asm volatile("s_waitcnt vmcnt(0)" ::: "memory");
        } else {
            XB_SPIN(xb_ld(&bar[XB_XGEN(b.x)]) == gen, bar);
            __builtin_amdgcn_fence(__ATOMIC_ACQUIRE, "agent");
            asm volatile("s_waitcnt vmcnt(0)" ::: "memory");
        }
    }
    __syncthreads();
}

enum { PH_PRO = 0, PH_CONV, PH_IN, PH_PREP_Q, PH_PREP_K, PH_PREP_V, PH_PREP_G, PH_ATT, PH_FIN, PH_BR, PH_WO, PH_LN1, PH_M1, PH_M2, PH_LN2, PH_PLE, PH_LN3 };
template <int PH> __global__ __launch_bounds__(NTHR, 2) void k_ph(P p, int layer) {
    extern __shared__ __attribute__((aligned(16))) unsigned char smem[];
    LAS unsigned char* lds = (LAS unsigned char*)smem;
    tid_setup();
    const int c = blockIdx.x, G = gridDim.x;
    if constexpr (PH == PH_PRO) ph_prologue(p);
    if constexpr (PH == PH_CONV) ph_convert(lds, p, layer);
    if constexpr (PH == PH_IN) { const MegaP m = mk_mega(p); SchedIn S{(const char*)m.Xb, (const char*)m.Wb_in, (const char*)m.Wb_gv, c, G}; EpiIn E{m.Hp, m.GVt, m.ssq_q, m.ssq_kv}; ge::gemm_stream<EpiIn, SchedIn, false>(lds, D, D, D, S, E); }
    if constexpr (PH == PH_PREP_Q) { const MlaP q = mk_mla(p); SchedMla<0> S{(const char*)(q.Hp + H_CQ), (const char*)q.Wb_uq, c, G}; EpiMla<0> E{q}; ge::gemm_stream<EpiMla<0>, SchedMla<0>, false>(lds, 256, HW, 256, S, E); }
    if constexpr (PH == PH_PREP_K) { const MlaP q = mk_mla(p); SchedMla<1> S{(const char*)(q.Hp + H_CKV), (const char*)q.Wb_uk, (c + 64) % G, G}; EpiMla<1> E{q}; ge::gemm_stream<EpiMla<1>, SchedMla<1>, false>(lds, 256, HW, 256, S, E); }
    if constexpr (PH == PH_PREP_V) { const MlaP q = mk_mla(p); SchedMla<2> S{(const char*)q.Wb_uv, (const char*)(q.Hp + H_CKV), (c + 192) % G, G}; EpiMla<2> E{q}; ge::gemm_stream<EpiMla<2>, SchedMla<2>, false>(lds, 256, 256, HW, S, E); }
    if constexpr (PH == PH_PREP_G) { const MlaP q = mk_mla(p); kr_phase(q, c * NTHR + tid_now(), G * NTHR); const GlaP g = mk_gla(p, layer); gla_g1(lds, g, c, G); }
    if constexpr (PH == PH_ATT) { const GlaP g = mk_gla(p, layer); gla_g2(g, c); __syncthreads(); const MlaP q = mk_mla(p); attn_phase(lds, q, c); }
    if constexpr (PH == PH_FIN) { const GlaP g = mk_gla(p, layer); gla_g3(lds, g, c, G); conv_phase(g, c * NTHR + tid_now(), G * NTHR); attn_combine_bf16(g, c * NTHR + tid_now(), G * NTHR); }
    if constexpr (PH == PH_BR) { SchedBr S{(const char*)p.Yab, (const char*)p.Ybb, (const char*)p.Ycb, (const char*)p.Wb_br, c, G}; EpiBr E{p.Hp, p.Z, p.Mgb}; ge::gemm_stream<EpiBr, SchedBr, false>(lds, 512, 512, 512, S, E); }
    if constexpr (PH == PH_WO) { SchedT4 S{(const char*)p.Mgb, (const char*)p.Wb_o, 256 * D * 2, 256 * D * 2, c, G}; EpiRes E{p.X, p.Z}; ge::gemm_stream<EpiRes, SchedT4, false>(lds, D, D, D, S, E); }
    if constexpr (PH == PH_LN1) ph_rows<1>(p, layer);
    if constexpr (PH == PH_M1) { moe_table(lds, p.cnt + layer * 64); LAS int* te = (LAS int*)(lds + 131072);
        SchedM1 S{(const char*)p.Xb, (const char*)p.Wb_gu, p.lists, te, c, G}; EpiM1 E{p.Hbuf}; ge::gemm_stream<EpiM1, SchedM1, true>(lds, D, D, D, S, E); }
    if constexpr (PH == PH_M2) { moe_table(lds, p.cnt + layer * 64); LAS int* te = (LAS int*)(lds + 131072);
        SchedM2 S{(const char*)p.Hbuf, (const char*)p.Wb_d, te, c, G}; EpiM2 E{p.Ys, p.lists, te}; ge::gemm_stream<EpiM2, SchedM2, false>(lds, EH, EH, EH, S, E); }
    if constexpr (PH == PH_LN2) ph_rows<2>(p, layer);
    if constexpr (PH == PH_PLE) {
        { SchedT4 S{(const char*)(p.Pb + (size_t)layer * T * PLE), (const char*)p.Wb_pu, 256 * PLE * 2, 256 * PLE * 2, c, G}; EpiU E{p.Ub}; ge::gemm_stream<EpiU, SchedT4, false>(lds, PLE, PLE, PLE, S, E); }
        { SchedT4 S{(const char*)p.Xb, (const char*)p.Wb_pg, 256 * D * 2, 256 * D * 2, c, G}; EpiPle E{p.X, p.Z, p.Ub, p.b_pg + layer * D}; ge::gemm_stream<EpiPle, SchedT4, false>(lds, D, D, D, S, E); } }
    if constexpr (PH == PH_LN3) ph_rows<3>(p, layer);
}


typedef const P __attribute__((address_space(4))) CP;
__device__ __forceinline__ P load_params() { CP* q = (CP*)__builtin_amdgcn_kernarg_segment_ptr(); asm volatile("" : "+s"(q)); return *(const P*)q; }
#define GRID_BAR() do { XcdBarrier b_; b_.bar = load_params().bar; b_.x = xb_xcc_id(); b_.st = xbw; xcd_barrier(b_); } while (0)
__global__ __launch_bounds__(NTHR, 2) void k_mega(P p_arg) {
    extern __shared__ __attribute__((aligned(16))) unsigned char smem[];
    LAS unsigned char* lds = (LAS unsigned char*)smem;
    const int G = NBLK;
#define c sgpr_now((int)blockIdx.x)
    volatile LAS unsigned* xbw = (volatile LAS unsigned*)(lds + XBW_OFF);
    tid_setup();
    if (tid_now() < 4) xbw[tid_now()] = 0u;
    __syncthreads();
    (void)xcd_barrier_post(p_arg.bar, xbw);
    { const P p = load_params(); ph_prologue(p); }
    { const P p = load_params(); ph_convert(lds, p, 0); }
    GRID_BAR();
    for (int layer = 0; layer < DEPTH; ++layer) {
        { const P p = load_params(); const MegaP m = mk_mega(p); SchedIn S{(const char*)m.Xb, (const char*)m.Wb_in, (const char*)m.Wb_gv, c, G}; EpiIn E{m.Hp, m.GVt, m.ssq_q, m.ssq_kv}; ge::gemm_stream<EpiIn, SchedIn, false>(lds, D, D, D, S, E); }
        GRID_BAR();
        { const P p = load_params(); const MlaP q = mk_mla(p);
          { SchedMla<0> S{(const char*)(q.Hp + H_CQ), (const char*)q.Wb_uq, c, G}; EpiMla<0> E{q}; ge::gemm_stream<EpiMla<0>, SchedMla<0>, false>(lds, 256, HW, 256, S, E); }
          { SchedMla<1> S{(const char*)(q.Hp + H_CKV), (const char*)q.Wb_uk, (c + 64) % G, G}; EpiMla<1> E{q}; ge::gemm_stream<EpiMla<1>, SchedMla<1>, false>(lds, 256, HW, 256, S, E); }
          { SchedMla<2> S{(const char*)q.Wb_uv, (const char*)(q.Hp + H_CKV), (c + 192) % G, G}; EpiMla<2> E{q}; ge::gemm_stream<EpiMla<2>, SchedMla<2>, false>(lds, 256, 256, HW, S, E); }
          kr_phase(q, c * NTHR + tid_now(), G * NTHR);
          const GlaP g = mk_gla(p, layer); gla_g1(lds, g, c, G); }
        GRID_BAR();
        { const P p = load_params(); const GlaP g = mk_gla(p, layer); gla_g2(g, c); __syncthreads(); const MlaP q = mk_mla(p); attn_phase(lds, q, c); }
        GRID_BAR();
        { const P p = load_params(); const GlaP g = mk_gla(p, layer); gla_g3(lds, g, c, G); conv_phase(g, c * NTHR + tid_now(), G * NTHR); attn_combine_bf16(g, c * NTHR + tid_now(), G * NTHR); }
        GRID_BAR();
        { const P p = load_params(); SchedBr S{(const char*)p.Yab, (const char*)p.Ybb, (const char*)p.Ycb, (const char*)p.Wb_br, c, G}; EpiBr E{p.Hp, p.Z, p.Mgb}; ge::gemm_stream<EpiBr, SchedBr, false>(lds, 512, 512, 512, S, E); }
        GRID_BAR();
        { const P p = load_params(); SchedT4 S{(const char*)p.Mgb, (const char*)p.Wb_o, 256 * D * 2, 256 * D * 2, c, G}; EpiRes E{p.X, p.Z}; ge::gemm_stream<EpiRes, SchedT4, false>(lds, D, D, D, S, E); }
        GRID_BAR();
        { const P p = load_params(); ph_rows<1>(p, layer); }
        GRID_BAR();
        { const P p = load_params(); moe_table(lds, p.cnt + layer * 64); LAS int* te = (LAS int*)(lds + 131072);
          SchedM1 S{(const char*)p.Xb, (const char*)p.Wb_gu, p.lists, te, c, G}; EpiM1 E{p.Hbuf}; ge::gemm_stream<EpiM1, SchedM1, true>(lds, D, D, D, S, E); }
        GRID_BAR();
        { const P p = load_params(); LAS int* te = (LAS int*)(lds + 131072);
          SchedM2 S{(const char*)p.Hbuf, (const char*)p.Wb_d, te, c, G}; EpiM2 E{p.Ys, p.lists, te}; ge::gemm_stream<EpiM2, SchedM2, false>(lds, EH, EH, EH, S, E); }
        GRID_BAR();
        { const P p = load_params(); ph_rows<2>(p, layer); }
        GRID_BAR();
        { const P p = load_params(); SchedT4 S{(const char*)(p.Pb + (size_t)layer * T * PLE), (const char*)p.Wb_pu, 256 * PLE * 2, 256 * PLE * 2, c, G}; EpiU E{p.Ub}; ge::gemm_stream<EpiU, SchedT4, false>(lds, PLE, PLE, PLE, S, E); }
        { const P p = load_params(); SchedT4 S{(const char*)p.Xb, (const char*)p.Wb_pg, 256 * D * 2, 256 * D * 2, c, G}; EpiPle E{p.X, p.Z, p.Ub, p.b_pg + layer * D}; ge::gemm_stream<EpiPle, SchedT4, false>(lds, D, D, D, S, E); }
        GRID_BAR();
        { const P p = load_params(); ph_rows<3>(p, layer); }
        if (layer + 1 < DEPTH) { { const P p = load_params(); ph_convert(lds, p, layer + 1); } GRID_BAR(); }
    }
#undef c
}

template <int PH> static void launch_ph(const P& p, int layer, hipStream_t st) {
    static bool set = false;
    if (!set) { (void)hipFuncSetAttribute((const void*)k_ph<PH>, hipFuncAttributeMaxDynamicSharedMemorySize, LDS_BYTES); set = true; }
    hipLaunchKernelGGL((k_ph<PH>), dim3(NBLK), dim3(NTHR), LDS_BYTES, st, p, layer);
}
extern "C" void kernel_launch(void* const* d_in, const int* in_sizes, int n_in, void* d_out, int out_size, void* d_ws, size_t ws_size, hipStream_t st) {
    (void)in_sizes; (void)n_in; (void)out_size;
    P p{};
    p.x = (const float*)d_in[0]; p.pin = (const float*)d_in[1]; p.pos = (const int*)d_in[2]; p.ln0_g = (const float*)d_in[3]; p.ln0_b = (const float*)d_in[4];
    p.w_in = (const float*)d_in[5]; p.w_conv = (const float*)d_in[6]; p.w_gg = (const float*)d_in[7]; p.b_gg = (const float*)d_in[8]; p.gla_ng = (const float*)d_in[9];
    p.qn_g = (const float*)d_in[10]; p.kvn_g = (const float*)d_in[11]; p.w_uq = (const float*)d_in[12]; p.w_ukv = (const float*)d_in[13]; p.w_br = (const float*)d_in[14]; p.w_o = (const float*)d_in[15];
    p.ln1_g = (const float*)d_in[16]; p.ln1_b = (const float*)d_in[17]; p.w_grp = (const float*)d_in[18]; p.b_grp = (const float*)d_in[19]; p.w_exp = (const float*)d_in[20]; p.b_exp = (const float*)d_in[21];
    p.w_gate = (const float*)d_in[22]; p.w_up = (const float*)d_in[23]; p.w_down = (const float*)d_in[24]; p.ln2_g = (const float*)d_in[25]; p.ln2_b = (const float*)d_in[26];
    p.w_pg = (const float*)d_in[27]; p.b_pg = (const float*)d_in[28]; p.w_pu = (const float*)d_in[29]; p.ln3_g = (const float*)d_in[30]; p.ln3_b = (const float*)d_in[31];
    p.out = (float*)d_out;
    char* w = (char*)d_ws; size_t off = 0;
    auto alloc = [&](size_t bytes) { void* r = w + off; off += (bytes + 255) & ~(size_t)255; return r; };
    p.bar = (unsigned*)alloc(16384); p.cnt = (int*)alloc(DEPTH * 64 * 4);
    const size_t zero_bytes = off;
    p.X = (float*)alloc((size_t)T * D * 4); p.Z = (float*)alloc((size_t)T * D * 4); p.Xb = (bf16_t*)alloc((size_t)T * D * 2);
    p.cs = (float*)alloc((size_t)T * 32 * 4); p.sn = (float*)alloc((size_t)T * 32 * 4); p.ssq_q = (float*)alloc((size_t)4 * T * 4); p.ssq_kv = (float*)alloc((size_t)4 * T * 4);
    p.Hp = (bf16_t*)alloc((size_t)T * HW * 2); p.GVt = (bf16_t*)alloc((size_t)T * 512 * 2);
    p.Qb = (bf16_t*)alloc((size_t)T * 768 * 2); p.KnImg = (bf16_t*)alloc((size_t)T * 512 * 2); p.VtImg = (bf16_t*)alloc((size_t)T * 512 * 2); p.KrImg = (bf16_t*)alloc((size_t)T * 64 * 2);
    p.MLpart = (float*)alloc((size_t)512 * 256 * 2 * 4);
    p.QE = (bf16_t*)alloc((size_t)T * 256 * 2); p.OI = (float*)alloc((size_t)T * 512 * 4); p.kvT = (float*)alloc((size_t)1024 * 8192 * 4); p.decay = (float*)alloc((size_t)1024 * 64 * 4); p.spT = (bf16_t*)alloc((size_t)1024 * 8192 * 2);
    p.Yab = (bf16_t*)alloc((size_t)T * 512 * 2); p.Ybb = (bf16_t*)alloc((size_t)T * 512 * 2); p.Ycb = (bf16_t*)alloc((size_t)T * 512 * 2); p.Mgb = (bf16_t*)alloc((size_t)T * D * 2);
    p.ew = (float*)alloc((size_t)T * 2 * 4); p.lists = (int*)alloc((size_t)NE * LCAP * 4);
    p.Hbuf = (bf16_t*)alloc((size_t)192 * 256 * EH * 2); p.Ys = (bf16_t*)alloc((size_t)2 * T * D * 2); p.Ub = (bf16_t*)alloc((size_t)T * D * 2); p.Pb = (bf16_t*)alloc((size_t)DEPTH * T * PLE * 2);
    p.Wb_in = (bf16_t*)alloc((size_t)HW * D * 2); p.Wb_gv = (bf16_t*)alloc((size_t)512 * D * 2); p.Wb_uq = (bf16_t*)alloc((size_t)768 * 256 * 2); p.Wb_uk = (bf16_t*)alloc((size_t)512 * 256 * 2); p.Wb_uv = (bf16_t*)alloc((size_t)512 * 256 * 2);
    p.Wb_br = (bf16_t*)alloc((size_t)3 * D * 512 * 2); p.Wb_o = (bf16_t*)alloc((size_t)D * D * 2); p.Wb_gu = (bf16_t*)alloc((size_t)NE * 512 * D * 2); p.Wb_d = (bf16_t*)alloc((size_t)NE * D * EH * 2);
    p.Wb_pg = (bf16_t*)alloc((size_t)D * D * 2); p.Wb_pu = (bf16_t*)alloc((size_t)D * PLE * 2);
    if (off > ws_size) return;
    (void)hipMemsetAsync(d_ws, 0, zero_bytes, st);
#if defined(MULTI_LAUNCH)
    launch_ph<PH_PRO>(p, 0, st);
    for (int i = 0; i < DEPTH; ++i) {
        launch_ph<PH_CONV>(p, i, st); launch_ph<PH_IN>(p, i, st);
        launch_ph<PH_PREP_Q>(p, i, st); launch_ph<PH_PREP_K>(p, i, st); launch_ph<PH_PREP_V>(p, i, st); launch_ph<PH_PREP_G>(p, i, st);
        launch_ph<PH_ATT>(p, i, st); launch_ph<PH_FIN>(p, i, st); launch_ph<PH_BR>(p, i, st); launch_ph<PH_WO>(p, i, st); launch_ph<PH_LN1>(p, i, st);
        launch_ph<PH_M1>(p, i, st); launch_ph<PH_M2>(p, i, st); launch_ph<PH_LN2>(p, i, st); launch_ph<PH_PLE>(p, i, st); launch_ph<PH_LN3>(p, i, st);
    }
#else
    static bool set = false;
    if (!set) { (void)hipFuncSetAttribute((const void*)k_mega, hipFuncAttributeMaxDynamicSharedMemorySize, LDS_BYTES); set = true; }
    hipLaunchKernelGGL(k_mega, dim3(NBLK), dim3(NTHR), LDS_BYTES, st, p);
#endif
}
```

```cpp
#include <hip/hip_runtime.h>
#include <hip/hip_bf16.h>
#include <stdint.h>

constexpr int T = 16384, D = 1024, DEPTH = 4, PLE = 256;
constexpr int NE = 64, EH = 256;
constexpr int INW = 6608;
constexpr int O_GV = 2048;
constexpr float DN_ALPHA = 1.681792830507429f;
constexpr int LCAP = 32768;
#define LAS __attribute__((address_space(3)))
typedef unsigned short bf16_t;
typedef short bf16x8 __attribute__((ext_vector_type(8)));
typedef float f32x4 __attribute__((ext_vector_type(4)));
typedef float f32x16 __attribute__((ext_vector_type(16)));
typedef unsigned u32x4 __attribute__((ext_vector_type(4)));
typedef unsigned u32x2 __attribute__((ext_vector_type(2)));
constexpr int NBLK = 256, NTHR = 512;
constexpr int STAGE_BYTES = 131072, LDS_BYTES = 147456 + 512, XBW_OFF = 147456 + 256;
constexpr int HW = 6144;
constexpr int H_AB = 0, H_AC = 512, H_AX = 1024, H_GQ = 1536, H_GK = 1792, H_GR = 2048, H_CQ = 2560, H_CKV = 2816, H_KR = 2944, H_GLR = 3008, H_GTA = 3072, H_GTB = 4096, H_GTC = 5120;

__device__ __forceinline__ unsigned cvt_pk_bf16(float lo, float hi) { unsigned r; asm volatile("v_cvt_pk_bf16_f32 %0, %1, %2" : "=v"(r) : "v"(lo), "v"(hi)); return r; }
constexpr int WTAB_OFF = 147456;
__device__ __forceinline__ int tid_now() {
    const unsigned hw = (unsigned)__builtin_amdgcn_s_getreg((5 << 11) | 4) & 63u;
    extern __shared__ __attribute__((aligned(16))) unsigned char smem_tid[];
    const int w = __builtin_amdgcn_readfirstlane(*(volatile LAS int*)((LAS unsigned char*)smem_tid + WTAB_OFF + 4 * hw));
    int l = (int)__builtin_amdgcn_mbcnt_hi(~0u, __builtin_amdgcn_mbcnt_lo(~0u, 0u));
    asm volatile("" : "+v"(l));
    return w * 64 + l; }
__device__ __forceinline__ void tid_setup() {
    const unsigned hw = (unsigned)__builtin_amdgcn_s_getreg((5 << 11) | 4) & 63u;
    extern __shared__ __attribute__((aligned(16))) unsigned char smem_tid[];
    if ((threadIdx.x & 63) == 0) *(volatile LAS int*)((LAS unsigned char*)smem_tid + WTAB_OFF + 4 * hw) = (int)(threadIdx.x >> 6);
    __syncthreads(); }
__device__ __forceinline__ int sgpr_now(int v) { asm volatile("" : "+s"(v)); return v; }
__device__ __forceinline__ float bf2f(bf16_t b) { return __uint_as_float(((unsigned)b) << 16); }
__device__ __forceinline__ float bflo(unsigned w) { return __uint_as_float(w << 16); }
__device__ __forceinline__ float bfhi(unsigned w) { return __uint_as_float(w & 0xffff0000u); }

namespace ge {
constexpr int BM = 256, BK = 64, HALF = 128, HTB = HALF * BK * 2;
__device__ __forceinline__ int lds_byte(int r, int c) { const int st = (r >> 4) * 2 + (c >> 5), rr = r & 15, cc = c & 31, ob = rr * 64 + cc * 2; return st * 1024 + (ob ^ (((ob >> 9) & 1) << 5)); }
__device__ __forceinline__ void stage_rc(int b, int& R, int& C) { const int st = b / 1024, sb = b % 1024, swz = sb ^ (((sb >> 9) & 1) << 5); R = (st >> 1) * 16 + swz / 64; C = (st & 1) * 32 + (swz % 64) / 2; }
__device__ __forceinline__ int perm32(int rho) { const int n = rho >> 4, i = rho & 15; return 8 * (i >> 2) + 4 * n + (i & 3); }
struct Unit { int pm, pn, g; };
typedef f32x4 Acc[2][2][4][2];

template <class Epi, class Sched, bool GATHER>
__device__ __forceinline__ void gemm_stream(LAS unsigned char* lds, const int K, const int lda, const int ldb, const Sched& S, const Epi& E) {
    const int tid = tid_now(), wid = __builtin_amdgcn_readfirstlane(tid >> 6), lane = tid & 63, wr = wid >> 2, wc = wid & 3, fr = lane & 15, fq = lane >> 4;
    const int nt = K / BK;
    Unit cur, nxt; int ui = 0;
    if (!S.next(0, cur)) return;
    unsigned voffA[2][2], nvoffA[2][2], voffB[2][2];
#pragma unroll
    for (int i = 0; i < 2; ++i) { int R, C; stage_rc(tid * 16 + i * 8192, R, C); const int Rb = (R & ~31) + perm32(R & 31);
        voffB[0][i] = (unsigned)(Rb * ldb + C) * 2u; voffB[1][i] = (unsigned)((Rb + 128) * ldb + C) * 2u;
        if constexpr (GATHER) { voffA[0][i] = (unsigned)(S.arow(cur, R) * lda + C) * 2u; voffA[1][i] = (unsigned)(S.arow(cur, R + 128) * lda + C) * 2u; }
        else { voffA[0][i] = (unsigned)(R * lda + C) * 2u; voffA[1][i] = (unsigned)((R + 128) * lda + C) * 2u; }
        nvoffA[0][i] = voffA[0][i]; nvoffA[1][i] = voffA[1][i]; }
    const size_t kstep = (size_t)(BK * 2);
    const unsigned ldsw = (unsigned)wid * 1024u;
    const int aoff = lds_byte(wr * 64 + fr, fq * 8), boff = lds_byte(wc * 32 + fr, fq * 8);
#define GE_SA(b, h) (((b) * 2 + (h)) * HTB)
#define GE_SB(b, h) ((4 + (b) * 2 + (h)) * HTB)
#define GE_STAGE(bufoff, gbase, voff) do { _Pragma("unroll") for (int _i = 0; _i < 2; ++_i) \
        __builtin_amdgcn_global_load_lds((const unsigned*)((const char*)(gbase) + (voff)[_i]), (LAS unsigned*)(lds + (bufoff) + ldsw + _i * 8192), 16, 0, 0); } while (0)
#define GE_LDA(dst, b, h) do { _Pragma("unroll") for (int m = 0; m < 4; ++m) _Pragma("unroll") for (int k = 0; k < 2; ++k) dst[m][k] = *(const LAS bf16x8*)(lds + GE_SA(b, h) + aoff + m * 2048 + k * 1024); } while (0)
#define GE_LDB(dst, b, h) do { _Pragma("unroll") for (int n = 0; n < 2; ++n) _Pragma("unroll") for (int k = 0; k < 2; ++k) dst[n][k] = *(const LAS bf16x8*)(lds + GE_SB(b, h) + boff + n * 2048 + k * 1024); } while (0)
#define GE_MMA(ai, bj, At, Bt) do { __builtin_amdgcn_s_setprio(1); _Pragma("unroll") for (int m = 0; m < 4; ++m) _Pragma("unroll") for (int n = 0; n < 2; ++n) _Pragma("unroll") for (int k = 0; k < 2; ++k) \
        acc[ai][bj][m][n] = __builtin_amdgcn_mfma_f32_16x16x32_bf16(Bt[n][k], At[m][k], acc[ai][bj][m][n], 0, 0, 0); __builtin_amdgcn_s_setprio(0); } while (0)
#define GE_WAIT_V(n) asm volatile("s_waitcnt vmcnt(" #n ")" ::: "memory")
#define GE_WAIT_L(n) asm volatile("s_waitcnt lgkmcnt(" #n ")" ::: "memory")
#define GE_BAR __builtin_amdgcn_s_barrier()
#define GE_SCHED __builtin_amdgcn_sched_barrier(0)
    Acc acc;
#pragma unroll
    for (int a = 0; a < 2; ++a)
#pragma unroll
        for (int b = 0; b < 2; ++b)
#pragma unroll
            for (int m = 0; m < 4; ++m)
#pragma unroll
                for (int n = 0; n < 2; ++n) acc[a][b][m][n] = (f32x4){0.f, 0.f, 0.f, 0.f};
    bf16x8 At[4][2], B0[2][2], B1[2][2];
    const char* cA = S.aptr(cur); const char* cB = S.bptr(cur);
    GE_STAGE(GE_SB(0, 0), cB, voffB[0]); GE_STAGE(GE_SA(0, 0), cA, voffA[0]); GE_STAGE(GE_SB(0, 1), cB, voffB[1]); GE_STAGE(GE_SA(0, 1), cA, voffA[1]);
    if (wr == 1) GE_BAR;
    GE_WAIT_V(4); GE_BAR;
    GE_STAGE(GE_SB(1, 0), cB + kstep, voffB[0]); GE_STAGE(GE_SA(1, 0), cA + kstep, voffA[0]); GE_STAGE(GE_SB(1, 1), cB + kstep, voffB[1]);
    GE_WAIT_V(6); GE_BAR;
    for (;;) {
        const bool has_next = S.next(ui + 1, nxt);
        const char* nA = has_next ? S.aptr(nxt) : cA; const char* nB = has_next ? S.bptr(nxt) : cB;
#pragma unroll 1
        for (int t = 0; t < nt; t += 2) {
            const bool last = (t == nt - 2);
            const char* a1 = cA + (size_t)(t + 1) * kstep;
            const char* a2 = last ? nA : cA + (size_t)(t + 2) * kstep; const char* b2 = last ? nB : cB + (size_t)(t + 2) * kstep;
            const char* a3 = a2 + kstep; const char* b3 = b2 + kstep;
            if constexpr (GATHER) { if (last && has_next) {
#pragma unroll
                for (int i = 0; i < 2; ++i) { int R, C; stage_rc(tid * 16 + i * 8192, R, C);
                    nvoffA[0][i] = (unsigned)(S.arow(nxt, R) * lda + C) * 2u; nvoffA[1][i] = (unsigned)(S.arow(nxt, R + 128) * lda + C) * 2u; } } }
            unsigned va2[2][2];
#pragma unroll
            for (int h = 0; h < 2; ++h)
#pragma unroll
                for (int i = 0; i < 2; ++i) va2[h][i] = (GATHER && last) ? nvoffA[h][i] : voffA[h][i];
            GE_LDB(B0, 0, 0); GE_SCHED; GE_LDA(At, 0, 0); GE_STAGE(GE_SA(1, 1), a1, voffA[1]);
            GE_WAIT_L(8); GE_BAR; GE_WAIT_L(0); GE_MMA(0, 0, At, B0); GE_BAR; GE_SCHED;
            GE_LDB(B1, 0, 1); GE_STAGE(GE_SB(0, 0), b2, voffB[0]);
            GE_BAR; GE_WAIT_L(0); GE_MMA(0, 1, At, B1); GE_BAR;
            GE_LDA(At, 0, 1); GE_STAGE(GE_SA(0, 0), a2, va2[0]);
            GE_BAR; GE_WAIT_L(0); GE_MMA(1, 0, At, B0); GE_BAR; GE_SCHED;
            GE_STAGE(GE_SB(0, 1), b2, voffB[1]);
            GE_WAIT_V(6); GE_BAR; GE_MMA(1, 1, At, B1); GE_BAR;
            GE_LDB(B0, 1, 0); GE_SCHED; GE_LDA(At, 1, 0); GE_STAGE(GE_SA(0, 1), a2, va2[1]);
            GE_WAIT_L(8); GE_BAR; GE_WAIT_L(0); GE_MMA(0, 0, At, B0); GE_BAR; GE_SCHED;
            GE_LDB(B1, 1, 1); GE_STAGE(GE_SB(1, 0), b3, voffB[0]);
            GE_BAR; GE_WAIT_L(0); GE_MMA(0, 1, At, B1); GE_BAR;
            GE_LDA(At, 1, 1); GE_STAGE(GE_SA(1, 0), a3, va2[0]);
            GE_BAR; GE_WAIT_L(0); GE_MMA(1, 0, At, B0); GE_BAR; GE_SCHED;
            GE_STAGE(GE_SB(1, 1), b3, voffB[1]);
            GE_WAIT_V(6); GE_BAR; GE_MMA(1, 1, At, B1); GE_BAR;
        }
        { int tz = tid; asm volatile("" : "+v"(tz));
          const int wid2 = tz >> 6, lane2 = tz & 63; E(acc, cur, wid2 >> 2, wid2 & 3, lane2 & 15, lane2 >> 4); }
        if (!has_next) break;
#pragma unroll
        for (int a = 0; a < 2; ++a)
#pragma unroll
            for (int b = 0; b < 2; ++b)
#pragma unroll
                for (int m = 0; m < 4; ++m)
#pragma unroll
                    for (int n = 0; n < 2; ++n) acc[a][b][m][n] = (f32x4){0.f, 0.f, 0.f, 0.f};
        cur = nxt; cA = nA; cB = nB; ++ui;
        if (GATHER) {
#pragma unroll
            for (int h = 0; h < 2; ++h)
#pragma unroll
                for (int i = 0; i < 2; ++i) voffA[h][i] = nvoffA[h][i]; }
    }
    GE_WAIT_V(0);
    if (wr == 0) GE_BAR;
    GE_BAR;
#undef GE_SA
#undef GE_SB
#undef GE_STAGE
#undef GE_LDA
#undef GE_LDB
#undef GE_MMA
#undef GE_WAIT_V
#undef GE_WAIT_L
#undef GE_BAR
#undef GE_SCHED
}
__device__ __forceinline__ void tile_order(int L, int nM, int nN, int& pm, int& pn) {
    const int nwg = nM * nN; int wgid = L;
    { const int q = nwg / 8, r = nwg % 8, xcd = wgid % 8, off = wgid / 8; wgid = (xcd < r ? xcd * (q + 1) : r * (q + 1) + (xcd - r) * q) + off; }
    const int nig = 8 * nN, gid = wgid / nig, fm = gid * 8, gsz = (nM - fm) < 8 ? (nM - fm) : 8;
    pm = fm + ((wgid % nig) % gsz); pn = (wgid % nig) / gsz;
}
}
struct MapInMain { __device__ __forceinline__ int operator()(int s) const {
    if (s < 2048) return s;
    if (s < 2560) return 2576 + (s - 2048);
    if (s < 2816) return 3088 + (s - 2560);
    if (s < 2944) return 3344 + (s - 2816);
    if (s < 3008) return 3472 + (s - 2944);
    if (s < 3024) return 2560 + (s - 3008);
    if (s < 3072) return -1;
    return 3536 + (s - 3072); } };
struct MapOff { int off; __device__ __forceinline__ int operator()(int s) const { return off + s; } };struct MegaP {
    const float* w_in; bf16_t* Wb_in; bf16_t* Wb_gv; const bf16_t* Xb; bf16_t* Hp; bf16_t* GVt; float* ssq_q; float* ssq_kv;
};
struct SchedIn {
    const char* Xb; const char* Wm; const char* Wg; int c, G, gv;
    __device__ __forceinline__ bool next(int i, ge::Unit& u) const {
        const int L = i * G + c;
        if (gv) { if (L >= 128) return false; u.g = 0; u.pm = L >> 1; u.pn = 8 + (L & 1); return true; }
        if (L >= 1536) return false;
        if (L < 1408) { u.g = 0; ge::tile_order(L, 64, 22, u.pm, u.pn); if (u.pn >= 8) u.pn += 2; } else { u.g = 1; const int l = L - 1408; u.pm = l & 1; u.pn = l >> 1; }
        return true; }
    __device__ __forceinline__ const char* aptr(const ge::Unit& u) const { return u.g == 0 ? Xb + (size_t)u.pm * 256 * D * 2 : Wg + (size_t)u.pm * 256 * D * 2; }
    __device__ __forceinline__ const char* bptr(const ge::Unit& u) const { return u.g == 0 ? Wm + (size_t)u.pn * 256 * D * 2 : Xb + (size_t)u.pn * 256 * D * 2; }
};
template <int GV> struct EpiIn {
    bf16_t* Hp; bf16_t* GVt; float* ssq_q; float* ssq_kv;
    __device__ __forceinline__ void operator()(const ge::Acc& acc, const ge::Unit& u, int wr, int wc, int fr, int fq) const {
        if (GV == 0 || (GV == 2 && u.g == 0)) {
            const int row0 = u.pm * 256 + wr * 64 + fr, col0 = u.pn * 256 + wc * 32 + 8 * fq;
            const bool sg = u.pn >= 12;
#pragma unroll
            for (int ai = 0; ai < 2; ++ai)
#pragma unroll
                for (int m = 0; m < 4; ++m) { const int row = row0 + ai * 128 + m * 16; bf16_t* rp = Hp + (size_t)row * HW + col0;
                    float sq0 = 0.f, sq1 = 0.f;
#pragma unroll
                    for (int bj = 0; bj < 2; ++bj) { f32x4 v0 = acc[ai][bj][m][0], v1 = acc[ai][bj][m][1];
                        if (sg) {
#pragma unroll
                            for (int j = 0; j < 4; ++j) { v0[j] = 1.f / (1.f + __expf(-v0[j])); v1[j] = 1.f / (1.f + __expf(-v1[j])); } }
                        const float s = v0[0] * v0[0] + v0[1] * v0[1] + v0[2] * v0[2] + v0[3] * v0[3] + v1[0] * v1[0] + v1[1] * v1[1] + v1[2] * v1[2] + v1[3] * v1[3];
                        if (bj == 0) sq0 = s; else sq1 = s;
                        u32x4 o = {cvt_pk_bf16(v0[0], v0[1]), cvt_pk_bf16(v0[2], v0[3]), cvt_pk_bf16(v1[0], v1[1]), cvt_pk_bf16(v1[2], v1[3])};
                        *(u32x4*)(rp + bj * 128) = o; }
                    if (u.pn == 10 || u.pn == 11) {
                        float s = (u.pn == 10) ? (sq0 + sq1) : sq0;
                        s += __shfl_xor(s, 16); s += __shfl_xor(s, 32);
                        if (fq == 0) { float* dst = (u.pn == 10 ? ssq_q : ssq_kv); dst[(size_t)wc * T + row] = s; } } }
        } else {
#pragma unroll
            for (int ai = 0; ai < 2; ++ai)
#pragma unroll
                for (int m = 0; m < 4; ++m) { const int r = u.pm * 256 + ai * 128 + wr * 64 + m * 16 + fr, h = r >> 7, e = r & 127;
#pragma unroll
                    for (int bj = 0; bj < 2; ++bj) { const int t0 = u.pn * 256 + bj * 128 + wc * 32 + 8 * fq;
                        const int chunk = t0 >> 6, p0 = (t0 & 48) + ((t0 & 8) >> 1);
                        bf16_t* base = GVt + ((size_t)(chunk * 4 + h) * 128 + e) * 64;
                        const f32x4 v0 = acc[ai][bj][m][0], v1 = acc[ai][bj][m][1];
                        u32x2 o0 = {cvt_pk_bf16(v0[0], v0[1]), cvt_pk_bf16(v0[2], v0[3])}, o1 = {cvt_pk_bf16(v1[0], v1[1]), cvt_pk_bf16(v1[2], v1[3])};
                        *(u32x2*)(base + p0) = o0; *(u32x2*)(base + p0 + 8) = o1; } }
        }
    }
};
constexpr float QSCALE = 0.07216878364870322f * 1.4426950408889634f;
struct MapQ { __device__ __forceinline__ int operator()(int s) const {
    if (s < 512) return (s >> 7) * 192 + (s & 127);
    const int s2 = s - 512, bj = s2 >> 7, w = s2 & 127; return (w >> 5) * 192 + 128 + bj * 32 + (w & 31); } };
struct MapKV { int voff; __device__ __forceinline__ int operator()(int s) const { return (s >> 7) * 256 + voff + (s & 127); } };

struct MlaP {
    const float* w_uq; const float* w_ukv; const float* qn_g; const float* kvn_g;
    bf16_t* Wb_uq; bf16_t* Wb_uk; bf16_t* Wb_uv;
    const bf16_t* Hp; const float* ssq_q; const float* ssq_kv; const float* cs; const float* sn;
    bf16_t* Qb; bf16_t* KnImg; bf16_t* VtImg; bf16_t* KrImg; float* Opart; float* MLpart; float* Yc;
};
__device__ __forceinline__ float rstd4(const float* ssq, int row, float invw) {
    const float s = (ssq[row] + ssq[T + row]) + (ssq[2 * T + row] + ssq[3 * T + row]); return rsqrtf(s * invw + 1e-6f); }

template <int mode> struct SchedMla { const char* A; const char* B; int c, G;
    __device__ __forceinline__ bool next(int i, ge::Unit& u) const {
        const int L = i * G + c; u.g = mode;
        if (mode == 0) { if (L >= 192) return false; u.pm = L / 3; u.pn = L % 3; }
        else if (mode == 1) { if (L >= 128) return false; u.pm = L >> 1; u.pn = L & 1; }
        else { if (L >= 128) return false; u.pm = L & 1; u.pn = L >> 1; }
        return true; }
    __device__ __forceinline__ const char* aptr(const ge::Unit& u) const { return mode == 2 ? A + (size_t)u.pm * 256 * 256 * 2 : A + (size_t)u.pm * 256 * HW * 2; }
    __device__ __forceinline__ const char* bptr(const ge::Unit& u) const { return mode == 2 ? B + (size_t)u.pn * 256 * HW * 2 : B + (size_t)u.pn * 256 * 256 * 2; }
};
template <int MODE> struct EpiMla { MlaP p;
    __device__ __forceinline__ void operator()(const ge::Acc& acc, const ge::Unit& u, int wr, int wc, int fr, int fq) const {
        if constexpr (MODE == 0) {
#pragma unroll
            for (int ai = 0; ai < 2; ++ai)
#pragma unroll
                for (int m = 0; m < 4; ++m) { asm volatile("" ::: "memory"); const int t = u.pm * 256 + ai * 128 + wr * 64 + m * 16 + fr; const float rs = rstd4(p.ssq_q, t, 1.f / 256.f) * QSCALE;
                    if (u.pn < 2) {
#pragma unroll
                        for (int bj = 0; bj < 2; ++bj) { const int c0 = u.pn * 256 + bj * 128 + wc * 32 + 8 * fq, head = c0 >> 7, dim = c0 & 127;
                            const f32x4 v0 = acc[ai][bj][m][0] * rs, v1 = acc[ai][bj][m][1] * rs;
                            u32x4 o = {cvt_pk_bf16(v0[0], v0[1]), cvt_pk_bf16(v0[2], v0[3]), cvt_pk_bf16(v1[0], v1[1]), cvt_pk_bf16(v1[2], v1[3])};
                            *(u32x4*)(p.Qb + (size_t)t * 768 + head * 192 + dim) = o; }
                    } else { const int head = wc, i0 = 8 * fq;
                        float o1[8], o2[8];
#pragma unroll
                        for (int n = 0; n < 2; ++n) { const f32x4 c4 = *(const f32x4*)(p.cs + (size_t)t * 32 + i0 + 4 * n), s4 = *(const f32x4*)(p.sn + (size_t)t * 32 + i0 + 4 * n);
#pragma unroll
                            for (int j = 0; j < 4; ++j) { const float x1 = acc[ai][0][m][n][j] * rs, x2 = acc[ai][1][m][n][j] * rs; o1[4 * n + j] = x1 * c4[j] - x2 * s4[j]; o2[4 * n + j] = x1 * s4[j] + x2 * c4[j]; } }
                        u32x4 a = {cvt_pk_bf16(o1[0], o1[1]), cvt_pk_bf16(o1[2], o1[3]), cvt_pk_bf16(o1[4], o1[5]), cvt_pk_bf16(o1[6], o1[7])};
                        u32x4 b = {cvt_pk_bf16(o2[0], o2[1]), cvt_pk_bf16(o2[2], o2[3]), cvt_pk_bf16(o2[4], o2[5]), cvt_pk_bf16(o2[6], o2[7])};
                        *(u32x4*)(p.Qb + (size_t)t * 768 + head * 192 + 128 + i0) = a; *(u32x4*)(p.Qb + (size_t)t * 768 + head * 192 + 160 + i0) = b; } }
        } else if constexpr (MODE == 1) {
#pragma unroll
            for (int ai = 0; ai < 2; ++ai)
#pragma unroll
                for (int m = 0; m < 4; ++m) { asm volatile("" ::: "memory"); const int t = u.pm * 256 + ai * 128 + wr * 64 + m * 16 + fr; const float rs = rstd4(p.ssq_kv, t, 1.f / 128.f);
                    const int tile = t >> 6, key = t & 63;
#pragma unroll
                    for (int bj = 0; bj < 2; ++bj) { const int c0 = u.pn * 256 + bj * 128 + wc * 32 + 8 * fq, head = c0 >> 7, chunk = (c0 & 127) >> 3;
                        const f32x4 v0 = acc[ai][bj][m][0] * rs, v1 = acc[ai][bj][m][1] * rs;
                        u32x4 o = {cvt_pk_bf16(v0[0], v0[1]), cvt_pk_bf16(v0[2], v0[3]), cvt_pk_bf16(v1[0], v1[1]), cvt_pk_bf16(v1[2], v1[3])};
                        *(u32x4*)((char*)p.KnImg + ((size_t)(head * 256 + tile) * 16384) + key * 256 + ((chunk ^ (key & 15)) << 4)) = o; } }
        } else {
#pragma unroll
            for (int bj = 0; bj < 2; ++bj) { const int t0 = u.pn * 256 + bj * 128 + wc * 32 + 8 * fq;
                float rs[8];
#pragma unroll
                for (int j = 0; j < 8; ++j) rs[j] = rstd4(p.ssq_kv, t0 + j, 1.f / 128.f);
                const int tile = t0 >> 6, p0 = (t0 & 48) + ((t0 & 8) >> 1);
#pragma unroll
                for (int ai = 0; ai < 2; ++ai)
#pragma unroll
                    for (int m = 0; m < 4; ++m) { asm volatile("" ::: "memory"); const int r = u.pm * 256 + ai * 128 + wr * 64 + m * 16 + fr, head = r >> 7, d = r & 127;
                        char* base = (char*)p.VtImg + ((size_t)(head * 256 + tile) * 16384) + d * 128;
                        const f32x4 v0 = acc[ai][bj][m][0], v1 = acc[ai][bj][m][1];
                        u32x2 o0 = {cvt_pk_bf16(v0[0] * rs[0], v0[1] * rs[1]), cvt_pk_bf16(v0[2] * rs[2], v0[3] * rs[3])};
                        u32x2 o1 = {cvt_pk_bf16(v1[0] * rs[4], v1[1] * rs[5]), cvt_pk_bf16(v1[2] * rs[6], v1[3] * rs[7])};
                        const int sw = (d >> 1) & 7, pa = p0, pb = p0 + 8;
                        *(u32x2*)(base + (((pa >> 3) ^ sw) << 4) + (pa & 7) * 2) = o0;
                        *(u32x2*)(base + (((pb >> 3) ^ sw) << 4) + (pb & 7) * 2) = o1; } }
        }
    }
};
__device__ __forceinline__ void kr_phase(const MlaP& p, int gtid, int gthreads) {
    for (int idx = gtid; idx < T * 4; idx += gthreads) { const int t = idx >> 2, c = idx & 3, i0 = 8 * c;
        const u32x4 a = *(const u32x4*)(p.Hp + (size_t)t * HW + H_KR + i0), b = *(const u32x4*)(p.Hp + (size_t)t * HW + H_KR + 32 + i0);
        float o1[8], o2[8];
#pragma unroll
        for (int n = 0; n < 2; ++n) { const f32x4 c4 = *(const f32x4*)(p.cs + (size_t)t * 32 + i0 + 4 * n), s4 = *(const f32x4*)(p.sn + (size_t)t * 32 + i0 + 4 * n);
#pragma unroll
            for (int j = 0; j < 4; ++j) { const int e = 4 * n + j; const unsigned wa = a[e >> 1], wb = b[e >> 1];
                const float x1 = (e & 1) ? bfhi(wa) : bflo(wa), x2 = (e & 1) ? bfhi(wb) : bflo(wb);
                o1[e] = x1 * c4[j] - x2 * s4[j]; o2[e] = x1 * s4[j] + x2 * c4[j]; } }
        u32x4 oa = {cvt_pk_bf16(o1[0], o1[1]), cvt_pk_bf16(o1[2], o1[3]), cvt_pk_bf16(o1[4], o1[5]), cvt_pk_bf16(o1[6], o1[7])};
        u32x4 ob = {cvt_pk_bf16(o2[0], o2[1]), cvt_pk_bf16(o2[2], o2[3]), cvt_pk_bf16(o2[4], o2[5]), cvt_pk_bf16(o2[6], o2[7])};
        const int tile = t >> 6, key = t & 63, sw = (key >> 1) & 7;
        char* base = (char*)p.KrImg + (size_t)tile * 8192 + key * 128;
        *(u32x4*)(base + ((c ^ sw) << 4)) = oa; *(u32x4*)(base + (((c + 4) ^ sw) << 4)) = ob; }
}
constexpr int ATT_STEPS = 130;
__device__ __forceinline__ void attn_item(LAS unsigned char* lds, const MlaP& p, int head, int b, int j0, int j1, int slot) {
    const int tid = tid_now(), wid = __builtin_amdgcn_readfirstlane(tid >> 6), lane = tid & 63, q = lane & 31, hh = lane >> 5;
    const int trow = b * 256 + wid * 32 + q;
    bf16x8 qf[12];
    { const bf16_t* qp = p.Qb + (size_t)trow * 768 + head * 192 + 8 * hh;
#pragma unroll
      for (int s = 0; s < 12; ++s) qf[s] = *(const bf16x8*)(qp + 16 * s); }
    f32x16 O[4];
#pragma unroll
    for (int d = 0; d < 4; ++d)
#pragma unroll
        for (int r = 0; r < 16; ++r) O[d][r] = 0.f;
    float m_run = -1e30f, l_run = 0.f;
    const char* knb = (const char*)p.KnImg + (size_t)head * 256 * 16384; const char* vtb = (const char*)p.VtImg + (size_t)head * 256 * 16384; const char* krb = (const char*)p.KrImg;
    const unsigned lo = (unsigned)lane * 16u;
#define AT_ISSUE(j, bi) do { const unsigned _bo = (unsigned)(bi) * 40960u; \
        __builtin_amdgcn_global_load_lds((const unsigned*)(knb + (size_t)(j) * 16384 + (wid * 2) * 1024 + lo), (LAS unsigned*)(lds + _bo + (wid * 2) * 1024), 16, 0, 0); \
        __builtin_amdgcn_global_load_lds((const unsigned*)(knb + (size_t)(j) * 16384 + (wid * 2 + 1) * 1024 + lo), (LAS unsigned*)(lds + _bo + (wid * 2 + 1) * 1024), 16, 0, 0); \
        __builtin_amdgcn_global_load_lds((const unsigned*)(krb + (size_t)(j) * 8192 + wid * 1024 + lo), (LAS unsigned*)(lds + _bo + 16384 + wid * 1024), 16, 0, 0); \
        __builtin_amdgcn_global_load_lds((const unsigned*)(vtb + (size_t)(j) * 16384 + (wid * 2) * 1024 + lo), (LAS unsigned*)(lds + _bo + 24576 + (wid * 2) * 1024), 16, 0, 0); \
        __builtin_amdgcn_global_load_lds((const unsigned*)(vtb + (size_t)(j) * 16384 + (wid * 2 + 1) * 1024 + lo), (LAS unsigned*)(lds + _bo + 24576 + (wid * 2 + 1) * 1024), 16, 0, 0); } while (0)
    const int kn_off0 = q * 256, kn_sw = q & 15, kr_off0 = q * 128, kr_sw = (q >> 1) & 7;
    const int vt_sw = (q >> 1) & 7;
    AT_ISSUE(j0, 0);
    for (int j = j0; j < j1; ++j) {
        const int cur = (j - j0) & 1;
        if (j + 1 < j1) { AT_ISSUE(j + 1, cur ^ 1); asm volatile("s_waitcnt vmcnt(5)" ::: "memory"); }
        else { asm volatile("s_waitcnt vmcnt(0)" ::: "memory"); }
        __builtin_amdgcn_s_barrier(); asm volatile("" ::: "memory");
        const int jj = j - 4 * b;
        if (!(jj >= 0 && 64 * jj > 32 * wid + 31)) {
            LAS unsigned char* bb = lds + cur * 40960;
            f32x16 S0, S1;
#pragma unroll
            for (int r = 0; r < 16; ++r) { S0[r] = 0.f; S1[r] = 0.f; }
#pragma unroll
            for (int s = 0; s < 8; ++s) {
                const bf16x8 k0 = *(const LAS bf16x8*)(bb + kn_off0 + (((2 * s + hh) ^ kn_sw) << 4));
                const bf16x8 k1 = *(const LAS bf16x8*)(bb + 8192 + kn_off0 + (((2 * s + hh) ^ kn_sw) << 4));
                S0 = __builtin_amdgcn_mfma_f32_32x32x16_bf16(k0, qf[s], S0, 0, 0, 0);
                S1 = __builtin_amdgcn_mfma_f32_32x32x16_bf16(k1, qf[s], S1, 0, 0, 0); }
#pragma unroll
            for (int s = 0; s < 4; ++s) {
                const bf16x8 k0 = *(const LAS bf16x8*)(bb + 16384 + kr_off0 + (((2 * s + hh) ^ kr_sw) << 4));
                const bf16x8 k1 = *(const LAS bf16x8*)(bb + 16384 + 4096 + kr_off0 + (((2 * s + hh) ^ kr_sw) << 4));
                S0 = __builtin_amdgcn_mfma_f32_32x32x16_bf16(k0, qf[8 + s], S0, 0, 0, 0);
                S1 = __builtin_amdgcn_mfma_f32_32x32x16_bf16(k1, qf[8 + s], S1, 0, 0, 0); }
            if (jj >= 0) {
                const int dq = wid * 32 + q - 64 * jj - 4 * hh;
                const float NEG = -__builtin_inff();
#pragma unroll
                for (int r = 0; r < 16; ++r) { const int c = (r & 3) + 8 * (r >> 2);
                    if (c > dq) S0[r] = NEG;
                    if (c + 32 > dq) S1[r] = NEG; } }
            float mx = S0[0];
#pragma unroll
            for (int r = 1; r < 16; ++r) mx = fmaxf(mx, S0[r]);
#pragma unroll
            for (int r = 0; r < 16; ++r) mx = fmaxf(mx, S1[r]);
            { auto rr = __builtin_amdgcn_permlane32_swap(__float_as_uint(mx), __float_as_uint(mx), false, false); mx = fmaxf(__uint_as_float(rr[0]), __uint_as_float(rr[1])); }
            const float mn = fmaxf(m_run, mx), alpha = __builtin_amdgcn_exp2f(m_run - mn);
            m_run = mn;
            float sum = 0.f;
#pragma unroll
            for (int r = 0; r < 16; ++r) { S0[r] = __builtin_amdgcn_exp2f(S0[r] - mn); S1[r] = __builtin_amdgcn_exp2f(S1[r] - mn); sum += S0[r] + S1[r]; }
            l_run = l_run * alpha + sum;
            bf16x8 pf[4];
#pragma unroll
            for (int h2 = 0; h2 < 2; ++h2) {
                u32x4 a = {cvt_pk_bf16(S0[8 * h2 + 0], S0[8 * h2 + 1]), cvt_pk_bf16(S0[8 * h2 + 2], S0[8 * h2 + 3]), cvt_pk_bf16(S0[8 * h2 + 4], S0[8 * h2 + 5]), cvt_pk_bf16(S0[8 * h2 + 6], S0[8 * h2 + 7])};
                u32x4 c = {cvt_pk_bf16(S1[8 * h2 + 0], S1[8 * h2 + 1]), cvt_pk_bf16(S1[8 * h2 + 2], S1[8 * h2 + 3]), cvt_pk_bf16(S1[8 * h2 + 4], S1[8 * h2 + 5]), cvt_pk_bf16(S1[8 * h2 + 6], S1[8 * h2 + 7])};
                pf[h2] = *(bf16x8*)&a; pf[2 + h2] = *(bf16x8*)&c; }
#pragma unroll
            for (int d = 0; d < 4; ++d) {
#pragma unroll
                for (int r = 0; r < 16; ++r) O[d][r] *= alpha;
#pragma unroll
                for (int s2 = 0; s2 < 4; ++s2) {
                    const bf16x8 vf = *(const LAS bf16x8*)(bb + 24576 + (d * 32 + q) * 128 + (((2 * s2 + hh) ^ vt_sw) << 4));
                    O[d] = __builtin_amdgcn_mfma_f32_32x32x16_bf16(vf, pf[s2], O[d], 0, 0, 0); } }
        }
        asm volatile("" ::: "memory"); __builtin_amdgcn_s_barrier(); asm volatile("" ::: "memory");
    }
#undef AT_ISSUE
    { auto rr = __builtin_amdgcn_permlane32_swap(__float_as_uint(l_run), __float_as_uint(l_run), false, false); l_run = __uint_as_float(rr[0]) + __uint_as_float(rr[1]); }
    float* op = p.Opart + ((size_t)slot * 256 + wid * 32 + q) * 128 + 4 * hh;
#pragma unroll
    for (int d = 0; d < 4; ++d)
#pragma unroll
        for (int g = 0; g < 4; ++g) { f32x4 v = {O[d][4 * g], O[d][4 * g + 1], O[d][4 * g + 2], O[d][4 * g + 3]}; *(f32x4*)(op + d * 32 + g * 8) = v; }
    if (hh == 0) { float* ml = p.MLpart + ((size_t)slot * 256 + wid * 32 + q) * 2; ml[0] = m_run; ml[1] = l_run; }
}
__device__ __forceinline__ void attn_phase(LAS unsigned char* lds, const MlaP& p, int c) {
    int L = ATT_STEPS * c; const int Lend = L + ATT_STEPS;
    while (L < Lend) {
        const int head = L / 8320, rem = L - head * 8320;
        int b = (int)((sqrtf(1.f + 2.f * (float)rem) - 1.f) * 0.5f);
        while (2 * b * (b + 1) > rem) --b;
        while (2 * (b + 1) * (b + 2) <= rem) ++b;
        const int j0 = rem - 2 * b * (b + 1), nt = 4 * (b + 1);
        const int j1 = min(nt, j0 + (Lend - L));
        attn_item(lds, p, head, b, j0, j1, head * 64 + b + c);
        L += j1 - j0;
    }
}
struct GlaP {
    const bf16_t* Hp; const bf16_t* GVt; const float* wg; const float* bg; const float* ng; const float* wconv;
    bf16_t* QE; float* OI; float* kvT; float* decay; bf16_t* spT; bf16_t* Yab; bf16_t* Ybb; bf16_t* Ycb;
    const float* Opart; const float* MLpart;
};
__device__ __forceinline__ int pos16(int i) { return (i & 48) | ((i & 4) << 1) | ((i & 8) >> 1) | (i & 3); }
__device__ __forceinline__ void gla_g1(LAS unsigned char* lds, const GlaP& p, int c, int G) {
    const int tid = tid_now(), wid = __builtin_amdgcn_readfirstlane(tid >> 6), lane = tid & 63, l31 = lane & 31, hh = lane >> 5;
    LAS float* bsm = (LAS float*)lds; LAS float* gtot = (LAS float*)(lds + 17408); LAS float* blast = (LAS float*)(lds + 19456);
    LAS unsigned char* qeL = lds + 20480; LAS unsigned char* keL = lds + 28672; LAS unsigned char* ktL = lds + 36864;
    const int eb = wid & 3, hb = wid >> 2;
    for (int u = c; u < 1024; u += G) {
        const int n = u >> 2, h = u & 3;
        bf16x8 vf[4];
        { const bf16_t* vp = p.GVt + ((size_t)u * 128 + eb * 32 + l31) * 64 + 8 * hh;
#pragma unroll
          for (int s4 = 0; s4 < 4; ++s4) vf[s4] = *(const bf16x8*)(vp + 16 * s4); }
        { const int d = tid & 63, g = tid >> 6;
          float w[16];
#pragma unroll
          for (int r = 0; r < 16; ++r) w[r] = p.wg[r * 256 + h * 64 + d];
          const float bias = p.bg[h * 64 + d];
          float cs[8]; float run = 0.f;
#pragma unroll
          for (int k = 0; k < 8; ++k) { const int i = 8 * g + k;
              const u32x4 g0 = *(const u32x4*)(p.Hp + (size_t)(64 * n + i) * HW + H_GLR), g1 = *(const u32x4*)(p.Hp + (size_t)(64 * n + i) * HW + H_GLR + 8);
              float la = bias;
#pragma unroll
              for (int r = 0; r < 4; ++r) { la += bflo(g0[r]) * w[2 * r] + bfhi(g0[r]) * w[2 * r + 1]; la += bflo(g1[r]) * w[8 + 2 * r] + bfhi(g1[r]) * w[8 + 2 * r + 1]; }
              const float ls = (fminf(la, 0.f) - log1pf(expf(-fabsf(la)))) * (1.f / 16.f);
              run += ls; cs[k] = run; }
          gtot[g * 64 + d] = run;
          __syncthreads();
          float pre = 0.f, tot = 0.f;
#pragma unroll
          for (int gg = 0; gg < 8; ++gg) { const float v = gtot[gg * 64 + d]; tot += v; if (gg < g) pre += v; }
#pragma unroll
          for (int k = 0; k < 8; ++k) bsm[(8 * g + k) * 68 + d] = pre + cs[k];
          if (g == 0) { blast[d] = tot; p.decay[(size_t)u * 64 + d] = expf(tot); } }
        __syncthreads();
        { const int i = tid >> 3, cc = tid & 7, d0 = 8 * cc; const size_t t = (size_t)64 * n + i;
          const u32x4 qv = *(const u32x4*)(p.Hp + t * HW + H_GQ + h * 64 + d0), kv = *(const u32x4*)(p.Hp + t * HW + H_GK + h * 64 + d0);
          float b[8], bl[8];
          { const f32x4 b0 = *(const LAS f32x4*)(bsm + i * 68 + d0), b1 = *(const LAS f32x4*)(bsm + i * 68 + d0 + 4), l0 = *(const LAS f32x4*)(blast + d0), l1 = *(const LAS f32x4*)(blast + d0 + 4);
#pragma unroll
            for (int j = 0; j < 4; ++j) { b[j] = b0[j]; b[4 + j] = b1[j]; bl[j] = l0[j]; bl[4 + j] = l1[j]; } }
          float qe[8], ke[8], kt[8];
#pragma unroll
          for (int j = 0; j < 8; ++j) { const float qq = (j & 1) ? bfhi(qv[j >> 1]) : bflo(qv[j >> 1]), kk = (j & 1) ? bfhi(kv[j >> 1]) : bflo(kv[j >> 1]);
              qe[j] = qq * 0.125f * expf(b[j]); ke[j] = kk * expf(-b[j]); kt[j] = kk * expf(bl[j] - b[j]); }
          const u32x4 qo = {cvt_pk_bf16(qe[0], qe[1]), cvt_pk_bf16(qe[2], qe[3]), cvt_pk_bf16(qe[4], qe[5]), cvt_pk_bf16(qe[6], qe[7])};
          const u32x4 ko = {cvt_pk_bf16(ke[0], ke[1]), cvt_pk_bf16(ke[2], ke[3]), cvt_pk_bf16(ke[4], ke[5]), cvt_pk_bf16(ke[6], ke[7])};
          const int sw = (i >> 1) & 7;
          *(LAS u32x4*)(qeL + i * 128 + ((cc ^ sw) << 4)) = qo; *(LAS u32x4*)(keL + i * 128 + ((cc ^ sw) << 4)) = ko;
          *(u32x4*)(p.QE + t * 256 + h * 64 + d0) = qo;
          const int pi = pos16(i);
#pragma unroll
          for (int j = 0; j < 8; ++j) { const int d = d0 + j; const unsigned pk = cvt_pk_bf16(kt[j], 0.f);
              *(LAS unsigned short*)(ktL + d * 128 + (((pi >> 3) ^ ((d >> 1) & 7)) << 4) + (pi & 7) * 2) = (unsigned short)pk; } }
        __syncthreads();
        { f32x16 OT, KV;
#pragma unroll
          for (int r = 0; r < 16; ++r) { OT[r] = 0.f; KV[r] = 0.f; }
          const int sw = (l31 >> 1) & 7;
#pragma unroll
          for (int jb = 0; jb < 2; ++jb) {
              if (jb <= hb) {
                  f32x16 Sc;
#pragma unroll
                  for (int r = 0; r < 16; ++r) Sc[r] = 0.f;
#pragma unroll
                  for (int s = 0; s < 4; ++s) {
                      const bf16x8 ka = *(const LAS bf16x8*)(keL + (32 * jb + l31) * 128 + (((2 * s + hh) ^ sw) << 4));
                      const bf16x8 qb = *(const LAS bf16x8*)(qeL + (32 * hb + l31) * 128 + (((2 * s + hh) ^ sw) << 4));
                      Sc = __builtin_amdgcn_mfma_f32_32x32x16_bf16(ka, qb, Sc, 0, 0, 0); }
                  if (jb == hb) {
#pragma unroll
                      for (int r = 0; r < 16; ++r) { const int j = (r & 3) + 8 * (r >> 2) + 4 * hh; if (j > l31) Sc[r] = 0.f; } }
#pragma unroll
                  for (int h2 = 0; h2 < 2; ++h2) {
                      u32x4 a = {cvt_pk_bf16(Sc[8 * h2 + 0], Sc[8 * h2 + 1]), cvt_pk_bf16(Sc[8 * h2 + 2], Sc[8 * h2 + 3]), cvt_pk_bf16(Sc[8 * h2 + 4], Sc[8 * h2 + 5]), cvt_pk_bf16(Sc[8 * h2 + 6], Sc[8 * h2 + 7])};
                      OT = __builtin_amdgcn_mfma_f32_32x32x16_bf16(vf[2 * jb + h2], *(bf16x8*)&a, OT, 0, 0, 0); } } }
#pragma unroll
          for (int s4 = 0; s4 < 4; ++s4) {
              const bf16x8 kb = *(const LAS bf16x8*)(ktL + (32 * hb + l31) * 128 + (((2 * s4 + hh) ^ sw) << 4));
              KV = __builtin_amdgcn_mfma_f32_32x32x16_bf16(vf[s4], kb, KV, 0, 0, 0); }
          float* oi = p.OI + ((size_t)u * 8 + wid) * 1024 + lane;
#pragma unroll
          for (int r = 0; r < 16; ++r) oi[r * 64] = OT[r];
          float* kp = p.kvT + (size_t)u * 8192 + 32 * hb + l31;
#pragma unroll
          for (int r = 0; r < 16; ++r) { const int e = 32 * eb + (r & 3) + 8 * (r >> 2) + 4 * hh; kp[e * 64] = KV[r]; } }
        __syncthreads();
    }
}
__device__ __forceinline__ void gla_g2(const GlaP& p, int c) {
    if (tid_now() >= 128) return;
    const int idx = c * 128 + tid_now(), h = idx >> 13, ed = idx & 8191, d = idx & 63;
    float st = 0.f;
    for (int n0 = 0; n0 < 256; n0 += 8) {
        float kv[8], dc[8];
#pragma unroll
        for (int k = 0; k < 8; ++k) { const size_t u = (size_t)(n0 + k) * 4 + h; kv[k] = p.kvT[u * 8192 + ed]; dc[k] = p.decay[u * 64 + d]; }
#pragma unroll
        for (int k = 0; k < 8; ++k) { const size_t u = (size_t)(n0 + k) * 4 + h; p.spT[u * 8192 + ed] = (bf16_t)(cvt_pk_bf16(st, 0.f) & 0xffffu); st = fmaf(dc[k], st, kv[k]); }
    }
}
__device__ __forceinline__ void gla_g3(LAS unsigned char* lds, const GlaP& p, int c, int G) {
    const int tid = tid_now(), wid = __builtin_amdgcn_readfirstlane(tid >> 6), lane = tid & 63, l31 = lane & 31, hh = lane >> 5;
    LAS float* red = (LAS float*)lds;
    const int eb = wid & 3, ib = wid >> 2;
    for (int u = c; u < 1024; u += G) {
        const int n = u >> 2, h = u & 3;
        f32x16 O;
        { const float* oi = p.OI + ((size_t)u * 8 + wid) * 1024 + lane;
#pragma unroll
          for (int r = 0; r < 16; ++r) O[r] = oi[r * 64]; }
        const size_t t = (size_t)64 * n + 32 * ib + l31;
        { const bf16_t* sp = p.spT + ((size_t)u * 128 + 32 * eb + l31) * 64 + 8 * hh; const bf16_t* qp = p.QE + t * 256 + h * 64 + 8 * hh;
#pragma unroll
          for (int s = 0; s < 4; ++s) { const bf16x8 a = *(const bf16x8*)(sp + 16 * s), b = *(const bf16x8*)(qp + 16 * s); O = __builtin_amdgcn_mfma_f32_32x32x16_bf16(a, b, O, 0, 0, 0); } }
        float ss = 0.f;
#pragma unroll
        for (int r = 0; r < 16; ++r) ss += O[r] * O[r];
        { auto rr = __builtin_amdgcn_permlane32_swap(__float_as_uint(ss), __float_as_uint(ss), false, false); ss = __uint_as_float(rr[0]) + __uint_as_float(rr[1]); }
        __syncthreads();
        if (hh == 0) red[eb * 64 + 32 * ib + l31] = ss;
        __syncthreads();
        const int ti = 32 * ib + l31;
        const float tot = (red[ti] + red[64 + ti]) + (red[128 + ti] + red[192 + ti]);
        const float rs = rsqrtf(tot * (1.f / 128.f) + 1e-6f);
#pragma unroll
        for (int g = 0; g < 4; ++g) { const int e0 = 32 * eb + 8 * g + 4 * hh;
            const u32x2 rv = *(const u32x2*)(p.Hp + t * HW + H_GR + h * 128 + e0); const f32x4 gn = *(const f32x4*)(p.ng + e0);
            float y[4];
#pragma unroll
            for (int j = 0; j < 4; ++j) { const float r_ = (j & 1) ? bfhi(rv[j >> 1]) : bflo(rv[j >> 1]); y[j] = O[4 * g + j] * rs * gn[j] * (r_ / (1.f + __expf(-r_))); }
            u32x2 o = {cvt_pk_bf16(y[0], y[1]), cvt_pk_bf16(y[2], y[3])};
            *(u32x2*)(p.Ybb + t * 512 + h * 128 + e0) = o; }
    }
}
__device__ __forceinline__ void conv_phase(const GlaP& p, int gtid, int gthreads) {
    for (int idx = gtid; idx < T * 64; idx += gthreads) { const int t = idx >> 6, c0 = (idx & 63) * 8;
        float y[8];
#pragma unroll
        for (int j = 0; j < 8; ++j) y[j] = 0.f;
#pragma unroll
        for (int k = 0; k < 3; ++k) { const int tt = t - 2 + k; if (tt >= 0) {
            const u32x4 a = *(const u32x4*)(p.Hp + (size_t)tt * HW + H_AC + c0), x = *(const u32x4*)(p.Hp + (size_t)tt * HW + H_AX + c0);
            const f32x4 w0 = *(const f32x4*)(p.wconv + k * 512 + c0), w1 = *(const f32x4*)(p.wconv + k * 512 + c0 + 4);
#pragma unroll
            for (int j = 0; j < 4; ++j) { y[2 * j] += (j < 2 ? w0[2 * j] : w1[2 * j - 4]) * (bflo(a[j]) * bflo(x[j])); y[2 * j + 1] += (j < 2 ? w0[2 * j + 1] : w1[2 * j - 3]) * (bfhi(a[j]) * bfhi(x[j])); } } }
        const u32x4 b = *(const u32x4*)(p.Hp + (size_t)t * HW + H_AB + c0);
        u32x4 o;
#pragma unroll
        for (int j = 0; j < 4; ++j) o[j] = cvt_pk_bf16(bflo(b[j]) * y[2 * j], bfhi(b[j]) * y[2 * j + 1]);
        *(u32x4*)(p.Yab + (size_t)t * 512 + c0) = o; }
}
__device__ __forceinline__ void attn_combine_bf16(const GlaP& p, int gtid, int gthreads) {
    for (int idx = gtid; idx < 256 * 256 * 32; idx += gthreads) {
        const int dq = idx & 31, row = (idx >> 5) & 255, g = idx >> 13, head = g >> 6, b = g & 63;
        const int Ls = head * 8320 + 2 * b * (b + 1), Le = Ls + 4 * (b + 1);
        const int c0 = Ls / ATT_STEPS, c1 = (Le - 1) / ATT_STEPS;
        float M = -1e30f;
        for (int c = c0; c <= c1; ++c) M = fmaxf(M, p.MLpart[((size_t)(g + c) * 256 + row) * 2]);
        f32x4 acc = {0.f, 0.f, 0.f, 0.f}; float l = 0.f;
        for (int c = c0; c <= c1; ++c) { const size_t sl = (size_t)(g + c) * 256 + row; const float w = __builtin_amdgcn_exp2f(p.MLpart[sl * 2] - M);
            l += w * p.MLpart[sl * 2 + 1]; const f32x4 o = *(const f32x4*)(p.Opart + sl * 128 + dq * 4); acc += o * w; }
        const float il = 1.f / l;
        u32x2 o = {cvt_pk_bf16(acc[0] * il, acc[1] * il), cvt_pk_bf16(acc[2] * il, acc[3] * il)};
        *(u32x2*)(p.Ycb + (size_t)(b * 256 + row) * 512 + head * 128 + dq * 4) = o;
    }
}
struct P {
    const float *x, *pin; const int* pos;
    const float *ln0_g, *ln0_b, *w_in, *w_conv, *w_gg, *b_gg, *gla_ng, *qn_g, *kvn_g, *w_uq, *w_ukv, *w_br, *w_o, *ln1_g, *ln1_b, *w_grp, *b_grp, *w_exp, *b_exp,
                *w_gate, *w_up, *w_down, *ln2_g, *ln2_b, *w_pg, *b_pg, *w_pu, *ln3_g, *ln3_b;
    float* out;
    float *X, *Z, *cs, *sn, *ssq_q, *ssq_kv, *OI, *kvT, *decay, *MLpart, *ew;
    bf16_t *Xb, *Hp, *GVt, *Qb, *KnImg, *VtImg, *KrImg, *QE, *spT, *Yab, *Ybb, *Ycb, *Mgb, *Hbuf, *Ys, *Ub, *Pb;
    bf16_t *Wb_in, *Wb_gv, *Wb_uq, *Wb_uk, *Wb_uv, *Wb_br, *Wb_o, *Wb_gu, *Wb_d, *Wb_pg, *Wb_pu;
    int *cnt, *lists; unsigned* bar;
};
__device__ __forceinline__ MegaP mk_mega(const P& p) { MegaP m; m.w_in = p.w_in; m.Wb_in = p.Wb_in; m.Wb_gv = p.Wb_gv; m.Xb = p.Xb; m.Hp = p.Hp; m.GVt = p.GVt; m.ssq_q = p.ssq_q; m.ssq_kv = p.ssq_kv; return m; }
__device__ __forceinline__ MlaP mk_mla(const P& p) { MlaP q; q.w_uq = p.w_uq; q.w_ukv = p.w_ukv; q.qn_g = p.qn_g; q.kvn_g = p.kvn_g; q.Wb_uq = p.Wb_uq; q.Wb_uk = p.Wb_uk; q.Wb_uv = p.Wb_uv; q.Hp = p.Hp;
    q.ssq_q = p.ssq_q; q.ssq_kv = p.ssq_kv; q.cs = p.cs; q.sn = p.sn; q.Qb = p.Qb; q.KnImg = p.KnImg; q.VtImg = p.VtImg; q.KrImg = p.KrImg; q.Opart = p.Z; q.MLpart = p.MLpart; q.Yc = nullptr; return q; }
__device__ __forceinline__ GlaP mk_gla(const P& p, int layer) { GlaP g; g.Hp = p.Hp; g.GVt = p.GVt; g.wg = p.w_gg + layer * 16 * 256; g.bg = p.b_gg + layer * 256; g.ng = p.gla_ng + layer * 128; g.wconv = p.w_conv + layer * 3 * 512;
    g.QE = p.QE; g.OI = p.OI; g.kvT = p.kvT; g.decay = p.decay; g.spT = p.spT; g.Yab = p.Yab; g.Ybb = p.Ybb; g.Ycb = p.Ycb; g.Opart = p.Z; g.MLpart = p.MLpart; return g; }

struct CvJob { const float* W; bf16_t* Bt; const float* rs; int ldw, Ksrc, ldbt, n0, k0, kind, aux; };
struct MapId { __device__ __forceinline__ int operator()(int s) const { return s; } };
__device__ __forceinline__ int cv_map(int kind, int aux, int n) {
    if (kind == 0) return MapInMain{}(n);
    if (kind == 1) return aux + n;
    if (kind == 2) return MapQ{}(n);
    if (kind == 3) return MapKV{aux}(n);
    return n; }
__device__ __forceinline__ int cv_omap(int kind, int aux, int n) { return kind == 4 ? (n >> 7) * 256 + aux * 128 + (n & 127) : n; }
__device__ __forceinline__ bool cv_job(const P& p, int layer, int t, CvJob& j) {
    constexpr int S0 = 384, S1 = S0 + 32, S2 = S1 + 12, S3 = S2 + 8, S4 = S3 + 8, S5 = S4 + 96, S6 = S5 + 64, S7 = S6 + 64, S8 = S7 + 16, S9 = S8 + 1024, S10 = S9 + 1024, S11 = S10 + 1024;
    if (t >= S11) return false;
    j.rs = nullptr; j.aux = 0; j.kind = 5;
    if (t < S0) { j.W = p.w_in + (size_t)layer * D * INW; j.ldw = INW; j.Ksrc = D; j.Bt = p.Wb_in; j.ldbt = D; j.n0 = (t >> 2) * 64; j.k0 = (t & 3) * 256; j.kind = 0; }
    else if (t < S1) { const int u = t - S0; j.W = p.w_in + (size_t)layer * D * INW; j.ldw = INW; j.Ksrc = D; j.Bt = p.Wb_gv; j.ldbt = D; j.n0 = (u >> 2) * 64; j.k0 = (u & 3) * 256; j.kind = 1; j.aux = O_GV; }
    else if (t < S2) { const int u = t - S1; j.W = p.w_uq + (size_t)layer * 256 * 768; j.ldw = 768; j.Ksrc = 256; j.Bt = p.Wb_uq; j.ldbt = 256; j.n0 = u * 64; j.k0 = 0; j.kind = 2; j.rs = p.qn_g + layer * 256; }
    else if (t < S3) { const int u = t - S2; j.W = p.w_ukv + (size_t)layer * 128 * 1024; j.ldw = 1024; j.Ksrc = 128; j.Bt = p.Wb_uk; j.ldbt = 256; j.n0 = u * 64; j.k0 = 0; j.kind = 3; j.aux = 0; j.rs = p.kvn_g + layer * 128; }
    else if (t < S4) { const int u = t - S3; j.W = p.w_ukv + (size_t)layer * 128 * 1024; j.ldw = 1024; j.Ksrc = 128; j.Bt = p.Wb_uv; j.ldbt = 256; j.n0 = u * 64; j.k0 = 0; j.kind = 3; j.aux = 128; j.rs = p.kvn_g + layer * 128; }
    else if (t < S5) { const int u = t - S4, br = u >> 5, v = u & 31; j.W = p.w_br + (size_t)layer * 1536 * D + (size_t)br * 512 * D; j.ldw = D; j.Ksrc = 512; j.Bt = p.Wb_br + (size_t)br * 1024 * 512; j.ldbt = 512; j.n0 = (v >> 1) * 64; j.k0 = (v & 1) * 256; }
    else if (t < S6) { const int u = t - S5; j.W = p.w_o + (size_t)layer * D * D; j.ldw = D; j.Ksrc = D; j.Bt = p.Wb_o; j.ldbt = D; j.n0 = (u >> 2) * 64; j.k0 = (u & 3) * 256; }
    else if (t < S7) { const int u = t - S6; j.W = p.w_pg + (size_t)layer * D * D; j.ldw = D; j.Ksrc = D; j.Bt = p.Wb_pg; j.ldbt = D; j.n0 = (u >> 2) * 64; j.k0 = (u & 3) * 256; }
    else if (t < S8) { const int u = t - S7; j.W = p.w_pu + (size_t)layer * PLE * D; j.ldw = D; j.Ksrc = PLE; j.Bt = p.Wb_pu; j.ldbt = PLE; j.n0 = u * 64; j.k0 = 0; }
    else if (t < S9) { const int u = t - S8, e = u >> 4, v = u & 15; j.W = p.w_gate + ((size_t)layer * NE + e) * D * EH; j.ldw = EH; j.Ksrc = D; j.Bt = p.Wb_gu + (size_t)e * 512 * D; j.ldbt = D; j.n0 = (v >> 2) * 64; j.k0 = (v & 3) * 256; j.kind = 4; j.aux = 0; }
    else if (t < S10) { const int u = t - S9, e = u >> 4, v = u & 15; j.W = p.w_up + ((size_t)layer * NE + e) * D * EH; j.ldw = EH; j.Ksrc = D; j.Bt = p.Wb_gu + (size_t)e * 512 * D; j.ldbt = D; j.n0 = (v >> 2) * 64; j.k0 = (v & 3) * 256; j.kind = 4; j.aux = 1; }
    else { const int u = t - S10, e = u >> 4, v = u & 15; j.W = p.w_down + ((size_t)layer * NE + e) * EH * D; j.ldw = D; j.Ksrc = EH; j.Bt = p.Wb_d + (size_t)e * D * EH; j.ldbt = EH; j.n0 = v * 64; j.k0 = 0; }
    return true; }
__device__ __forceinline__ void cv_load(const CvJob& j, int tid, f32x4 (&v)[8]) {
    const int n4 = tid & 15, kr = tid >> 4; const int col = cv_map(j.kind, j.aux, j.n0 + 4 * n4);
#pragma unroll
    for (int r = 0; r < 8; ++r) { const int k = j.k0 + kr + 32 * r; v[r] = (f32x4){0.f, 0.f, 0.f, 0.f};
        if (col >= 0 && k < j.Ksrc) { v[r] = *(const f32x4*)(j.W + (size_t)k * j.ldw + col); if (j.rs) v[r] = v[r] * j.rs[k]; } }
}
__device__ __forceinline__ void ph_convert(LAS unsigned char* ldsl, const P& p, int layer) {
    LAS float* tile = (LAS float*)ldsl;
    const int tid = tid_now(), c = sgpr_now((int)blockIdx.x), G = gridDim.x;
    CvJob cur, nxt; f32x4 v[8], w[8];
    bool have = cv_job(p, layer, c, cur);
    if (have) cv_load(cur, tid, v);
    for (int t = c; have; t += G) {
        const bool hn = cv_job(p, layer, t + G, nxt);
        if (hn) cv_load(nxt, tid, w);
        __syncthreads();
        { const int n4 = tid & 15, kr = tid >> 4;
#pragma unroll
          for (int r = 0; r < 8; ++r) { LAS float* d = tile + (kr + 32 * r) * 65 + 4 * n4; d[0] = v[r][0]; d[1] = v[r][1]; d[2] = v[r][2]; d[3] = v[r][3]; } }
        __syncthreads();
        { const int kk = (tid & 127) * 2, nn = tid >> 7;
#pragma unroll
          for (int r = 0; r < 16; ++r) { const int n = nn + 4 * r;
              *(unsigned*)(cur.Bt + (size_t)cv_omap(cur.kind, cur.aux, cur.n0 + n) * cur.ldbt + cur.k0 + kk) = cvt_pk_bf16(tile[kk * 65 + n], tile[(kk + 1) * 65 + n]); } }
        have = hn; cur = nxt;
#pragma unroll
        for (int r = 0; r < 8; ++r) v[r] = w[r];
    }
    __syncthreads();
}

__device__ __forceinline__ float wsum(float v) {
#pragma unroll
    for (int o = 32; o > 0; o >>= 1) v += __shfl_xor(v, o);
    return v; }
template <int MODE>
__device__ __forceinline__ void ph_rows(const P& p, int layer) {
    const int lane = tid_now() & 63, gw = blockIdx.x * 8 + (tid_now() >> 6), nw = gridDim.x * 8;
    const float* gp = MODE == 0 ? p.ln0_g : MODE == 1 ? p.ln1_g + layer * D : MODE == 2 ? p.ln2_g + layer * D : p.ln3_g + layer * D;
    const float* bp = MODE == 0 ? p.ln0_b : MODE == 1 ? p.ln1_b + layer * D : MODE == 2 ? p.ln2_b + layer * D : p.ln3_b + layer * D;
    f32x4 gg[4], bb[4];
#pragma unroll
    for (int i = 0; i < 4; ++i) { gg[i] = *(const f32x4*)(gp + 256 * i + 4 * lane); bb[i] = *(const f32x4*)(bp + 256 * i + 4 * lane); }
    const float* in = MODE == 0 ? p.x : MODE == 2 ? p.X : p.Z;
    float* outf = (MODE == 3 && layer == DEPTH - 1) ? p.out : p.X;
    for (int row = gw; row < T; row += nw) {
        f32x4 v[4];
#pragma unroll
        for (int i = 0; i < 4; ++i) v[i] = *(const f32x4*)(in + (size_t)row * D + 256 * i + 4 * lane);
        if constexpr (MODE == 2) { const float w0 = p.ew[2 * row], w1 = p.ew[2 * row + 1];
#pragma unroll
            for (int i = 0; i < 4; ++i) { const u32x2 y0 = *(const u32x2*)(p.Ys + (size_t)(2 * row) * D + 256 * i + 4 * lane), y1 = *(const u32x2*)(p.Ys + (size_t)(2 * row + 1) * D + 256 * i + 4 * lane);
                v[i][0] = DN_ALPHA * v[i][0] + (w0 * bflo(y0[0]) + w1 * bflo(y1[0])); v[i][1] = DN_ALPHA * v[i][1] + (w0 * bfhi(y0[0]) + w1 * bfhi(y1[0]));
                v[i][2] = DN_ALPHA * v[i][2] + (w0 * bflo(y0[1]) + w1 * bflo(y1[1])); v[i][3] = DN_ALPHA * v[i][3] + (w0 * bfhi(y0[1]) + w1 * bfhi(y1[1])); } }
        float s = 0.f;
#pragma unroll
        for (int i = 0; i < 4; ++i) s += (v[i][0] + v[i][1]) + (v[i][2] + v[i][3]);
        const float mu = wsum(s) * (1.f / D);
        float q = 0.f;
#pragma unroll
        for (int i = 0; i < 4; ++i) { v[i] = v[i] - mu; q += (v[i][0] * v[i][0] + v[i][1] * v[i][1]) + (v[i][2] * v[i][2] + v[i][3] * v[i][3]); }
        const float rs = rsqrtf(wsum(q) * (1.f / D) + 1e-5f);
#pragma unroll
        for (int i = 0; i < 4; ++i) { v[i] = v[i] * rs * gg[i] + bb[i];
            *(f32x4*)(outf + (size_t)row * D + 256 * i + 4 * lane) = v[i];
            u32x2 o = {cvt_pk_bf16(v[i][0], v[i][1]), cvt_pk_bf16(v[i][2], v[i][3])};
            *(u32x2*)(p.Xb + (size_t)row * D + 256 * i + 4 * lane) = o; }
        if constexpr (MODE == 1) {
            const float* wg = p.w_grp + (size_t)layer * D * 8; const float* we = p.w_exp + (size_t)layer * D * 64;
            float gl[8];
#pragma unroll
            for (int g = 0; g < 8; ++g) gl[g] = 0.f;
#pragma unroll
            for (int i = 0; i < 4; ++i)
#pragma unroll
                for (int j = 0; j < 4; ++j) { const int k = 256 * i + 4 * lane + j; const f32x4 a = *(const f32x4*)(wg + k * 8), b = *(const f32x4*)(wg + k * 8 + 4); const float xv = v[i][j];
                    gl[0] = fmaf(xv, a[0], gl[0]); gl[1] = fmaf(xv, a[1], gl[1]); gl[2] = fmaf(xv, a[2], gl[2]); gl[3] = fmaf(xv, a[3], gl[3]);
                    gl[4] = fmaf(xv, b[0], gl[4]); gl[5] = fmaf(xv, b[1], gl[5]); gl[6] = fmaf(xv, b[2], gl[6]); gl[7] = fmaf(xv, b[3], gl[7]); }
            float mx = -INFINITY; int gt = 0;
#pragma unroll
            for (int g = 0; g < 8; ++g) { gl[g] = wsum(gl[g]) + p.b_grp[layer * 8 + g]; if (gl[g] > mx) { mx = gl[g]; gt = g; } }
            gt = __builtin_amdgcn_readfirstlane(gt);
            float sum = 0.f;
#pragma unroll
            for (int g = 0; g < 8; ++g) sum += expf(gl[g] - mx);
            const float pg = 1.f / sum;
            float el[8];
#pragma unroll
            for (int e = 0; e < 8; ++e) el[e] = 0.f;
#pragma unroll
            for (int i = 0; i < 4; ++i)
#pragma unroll
                for (int j = 0; j < 4; ++j) { const int k = 256 * i + 4 * lane + j; const f32x4 a = *(const f32x4*)(we + k * 64 + gt * 8), b = *(const f32x4*)(we + k * 64 + gt * 8 + 4); const float xv = v[i][j];
                    el[0] = fmaf(xv, a[0], el[0]); el[1] = fmaf(xv, a[1], el[1]); el[2] = fmaf(xv, a[2], el[2]); el[3] = fmaf(xv, a[3], el[3]);
                    el[4] = fmaf(xv, b[0], el[4]); el[5] = fmaf(xv, b[1], el[5]); el[6] = fmaf(xv, b[2], el[6]); el[7] = fmaf(xv, b[3], el[7]); }
            float v1 = -INFINITY, v2 = -INFINITY; int i1 = 0, i2 = 0;
#pragma unroll
            for (int e = 0; e < 8; ++e) { const float vv = wsum(el[e]) + p.b_exp[layer * 64 + gt * 8 + e];
                if (vv > v1) { v2 = v1; i2 = i1; v1 = vv; i1 = e; } else if (vv > v2) { v2 = vv; i2 = e; } }
            if (lane == 0) { const float e2 = expf(v2 - v1), w1 = pg / (1.f + e2), w2 = pg * e2 / (1.f + e2);
                const int ea = gt * 8 + i1, eb = gt * 8 + i2; int* cn = p.cnt + layer * 64;
                p.ew[2 * row] = w1; p.ew[2 * row + 1] = w2;
                const int pa = atomicAdd(&cn[ea], 1); p.lists[ea * LCAP + pa] = 2 * row;
                const int pb = atomicAdd(&cn[eb], 1); p.lists[eb * LCAP + pb] = 2 * row + 1; }
        }
    }
}

__device__ __forceinline__ void wsum8(float (&x)[8], int lane) {
    float y[4], z[2], w;
#pragma unroll
    for (int k = 0; k < 4; ++k) { const bool hi = lane & 32; const float snd = hi ? x[k] : x[k + 4], keep = hi ? x[k + 4] : x[k]; y[k] = keep + __shfl_xor(snd, 32); }
#pragma unroll
    for (int k = 0; k < 2; ++k) { const bool hi = lane & 16; const float snd = hi ? y[k] : y[k + 2], keep = hi ? y[k + 2] : y[k]; z[k] = keep + __shfl_xor(snd, 16); }
    { const bool hi = lane & 8; const float snd = hi ? z[0] : z[1], keep = hi ? z[1] : z[0]; w = keep + __shfl_xor(snd, 8); }
    w += __shfl_xor(w, 4); w += __shfl_xor(w, 2); w += __shfl_xor(w, 1);
#pragma unroll
    for (int k = 0; k < 8; ++k) x[k] = __int_as_float(__builtin_amdgcn_readlane(__float_as_int(w), (k >> 2) * 32 + ((k >> 1) & 1) * 16 + (k & 1) * 8));
}
__device__ __forceinline__ void ph_ln1_router(const P& p, int layer) {
    constexpr int RR = 2;
    const int tid = tid_now(), lane0 = tid & 63, gw = sgpr_now((int)blockIdx.x) * 8 + (tid >> 6), nw = gridDim.x * 8;
    const float* gp = p.ln1_g + layer * D; const float* bp = p.ln1_b + layer * D;
    const float* wg = p.w_grp + (size_t)layer * D * 8; const float* we = p.w_exp + (size_t)layer * D * 64;
    for (int row0 = gw * RR; row0 < T; row0 += nw * RR) {
        int lane = lane0; asm volatile("" : "+v"(lane));
        f32x4 v[RR][4];
#pragma unroll
        for (int r = 0; r < RR; ++r)
#pragma unroll
            for (int i = 0; i < 4; ++i) v[r][i] = *(const f32x4*)(p.Z + (size_t)(row0 + r) * D + 256 * i + 4 * lane);
#pragma unroll
        for (int r = 0; r < RR; ++r) {
            float s = 0.f;
#pragma unroll
            for (int i = 0; i < 4; ++i) s += (v[r][i][0] + v[r][i][1]) + (v[r][i][2] + v[r][i][3]);
            const float mu = wsum(s) * (1.f / D);
            float q = 0.f;
#pragma unroll
            for (int i = 0; i < 4; ++i) { v[r][i] = v[r][i] - mu; q += (v[r][i][0] * v[r][i][0] + v[r][i][1] * v[r][i][1]) + (v[r][i][2] * v[r][i][2] + v[r][i][3] * v[r][i][3]); }
            const float rs = rsqrtf(wsum(q) * (1.f / D) + 1e-5f);
#pragma unroll
            for (int i = 0; i < 4; ++i) { const f32x4 gg = *(const f32x4*)(gp + 256 * i + 4 * lane), bb = *(const f32x4*)(bp + 256 * i + 4 * lane);
                v[r][i] = v[r][i] * rs * gg + bb;
                *(f32x4*)(p.X + (size_t)(row0 + r) * D + 256 * i + 4 * lane) = v[r][i];
                u32x2 o = {cvt_pk_bf16(v[r][i][0], v[r][i][1]), cvt_pk_bf16(v[r][i][2], v[r][i][3])};
                *(u32x2*)(p.Xb + (size_t)(row0 + r) * D + 256 * i + 4 * lane) = o; } }
        float gl[RR][8];
#pragma unroll
        for (int r = 0; r < RR; ++r)
#pragma unroll
            for (int g = 0; g < 8; ++g) gl[r][g] = 0.f;
#pragma unroll
        for (int i = 0; i < 4; ++i) { asm volatile("" : "+v"(lane) :: "memory");
#pragma unroll
            for (int j = 0; j < 4; ++j) { const int k = 256 * i + 4 * lane + j; const f32x4 a = *(const f32x4*)(wg + k * 8), b = *(const f32x4*)(wg + k * 8 + 4);
#pragma unroll
                for (int r = 0; r < RR; ++r) { const float xv = v[r][i][j];
                    gl[r][0] = fmaf(xv, a[0], gl[r][0]); gl[r][1] = fmaf(xv, a[1], gl[r][1]); gl[r][2] = fmaf(xv, a[2], gl[r][2]); gl[r][3] = fmaf(xv, a[3], gl[r][3]);
                    gl[r][4] = fmaf(xv, b[0], gl[r][4]); gl[r][5] = fmaf(xv, b[1], gl[r][5]); gl[r][6] = fmaf(xv, b[2], gl[r][6]); gl[r][7] = fmaf(xv, b[3], gl[r][7]); } } }
        int gt[RR]; float pg[RR];
#pragma unroll
        for (int r = 0; r < RR; ++r) { wsum8(gl[r], lane);
            float mx = -INFINITY; int gi = 0;
#pragma unroll
            for (int g = 0; g < 8; ++g) { gl[r][g] += p.b_grp[layer * 8 + g]; if (gl[r][g] > mx) { mx = gl[r][g]; gi = g; } }
            float sum = 0.f;
#pragma unroll
            for (int g = 0; g < 8; ++g) sum += expf(gl[r][g] - mx);
            gt[r] = __builtin_amdgcn_readfirstlane(gi); pg[r] = 1.f / sum; }
        float el[RR][8];
#pragma unroll
        for (int r = 0; r < RR; ++r) {
#pragma unroll
            for (int e = 0; e < 8; ++e) el[r][e] = 0.f;
#pragma unroll
            for (int i = 0; i < 4; ++i) { asm volatile("" : "+v"(lane) :: "memory");
#pragma unroll
                for (int j = 0; j < 4; ++j) { const int k = 256 * i + 4 * lane + j; const f32x4 a = *(const f32x4*)(we + k * 64 + gt[r] * 8), b = *(const f32x4*)(we + k * 64 + gt[r] * 8 + 4); const float xv = v[r][i][j];
                    el[r][0] = fmaf(xv, a[0], el[r][0]); el[r][1] = fmaf(xv, a[1], el[r][1]); el[r][2] = fmaf(xv, a[2], el[r][2]); el[r][3] = fmaf(xv, a[3], el[r][3]);
                    el[r][4] = fmaf(xv, b[0], el[r][4]); el[r][5] = fmaf(xv, b[1], el[r][5]); el[r][6] = fmaf(xv, b[2], el[r][6]); el[r][7] = fmaf(xv, b[3], el[r][7]); } } }
#pragma unroll
        for (int r = 0; r < RR; ++r) { wsum8(el[r], lane);
            float v1 = -INFINITY, v2 = -INFINITY; int i1 = 0, i2 = 0;
#pragma unroll
            for (int e = 0; e < 8; ++e) { const float vv = el[r][e] + p.b_exp[layer * 64 + gt[r] * 8 + e];
                if (vv > v1) { v2 = v1; i2 = i1; v1 = vv; i1 = e; } else if (vv > v2) { v2 = vv; i2 = e; } }
            if (lane == 0) { const int row = row0 + r; const float e2 = expf(v2 - v1), w1 = pg[r] / (1.f + e2), w2 = pg[r] * e2 / (1.f + e2);
                const int ea = gt[r] * 8 + i1, eb = gt[r] * 8 + i2; int* cn = p.cnt + layer * 64;
                p.ew[2 * row] = w1; p.ew[2 * row + 1] = w2;
                const int pa = atomicAdd(&cn[ea], 1); p.lists[ea * LCAP + pa] = 2 * row;
                const int pb = atomicAdd(&cn[eb], 1); p.lists[eb * LCAP + pb] = 2 * row + 1; } }
    }
}
__device__ __forceinline__ void ph_prologue(const P& p) {
    const int gtid = blockIdx.x * NTHR + tid_now(), gth = gridDim.x * NTHR;
    for (int idx = gtid; idx < T * 32; idx += gth) { const int t = idx >> 5, i = idx & 31;
        const float inv = (float)(1.0 / pow(10000.0, (double)(2 * i) / 64.0)); const float ang = (float)p.pos[t] * inv;
        p.cs[idx] = (float)cos((double)ang); p.sn[idx] = (float)sin((double)ang); }
    for (size_t i = gtid; i < (size_t)DEPTH * T * PLE / 4; i += gth) { const f32x4 v = ((const f32x4*)p.pin)[i]; u32x2 o = {cvt_pk_bf16(v[0], v[1]), cvt_pk_bf16(v[2], v[3])}; ((u32x2*)p.Pb)[i] = o; }
    ph_rows<0>(p, 0);
}

struct SchedBr { const char* Ya; const char* Yb; const char* Yc; const char* W; int c, G;
    __device__ __forceinline__ bool next(int i, ge::Unit& u) const { const int tile = (i / 3) * G + c; if (tile >= 256) return false; u.g = i % 3; ge::tile_order(tile, 64, 4, u.pm, u.pn); return true; }
    __device__ __forceinline__ const char* aptr(const ge::Unit& u) const { return (u.g == 0 ? Ya : u.g == 1 ? Yb : Yc) + (size_t)u.pm * 256 * 512 * 2; }
    __device__ __forceinline__ const char* bptr(const ge::Unit& u) const { return W + ((size_t)u.g * 1024 + u.pn * 256) * 512 * 2; } };
struct EpiBr { const bf16_t* Hp; float* Mt; bf16_t* Mgb;
    __device__ __forceinline__ void operator()(const ge::Acc& acc, const ge::Unit& u, int wr, int wc, int fr, int fq) const {
        const int row0 = u.pm * 256 + wr * 64 + fr, col0 = u.pn * 256 + wc * 32 + 8 * fq;
#pragma unroll
        for (int ai = 0; ai < 2; ++ai)
#pragma unroll
            for (int m = 0; m < 4; ++m) { asm volatile("" ::: "memory"); const int row = row0 + ai * 128 + m * 16;
#pragma unroll
                for (int bj = 0; bj < 2; ++bj) { const int col = col0 + bj * 128;
                    const u32x4 gt = *(const u32x4*)(Hp + (size_t)row * HW + H_GTA + u.g * 1024 + col);
                    f32x4 v0 = acc[ai][bj][m][0], v1 = acc[ai][bj][m][1];
                    v0[0] *= bflo(gt[0]); v0[1] *= bfhi(gt[0]); v0[2] *= bflo(gt[1]); v0[3] *= bfhi(gt[1]); v1[0] *= bflo(gt[2]); v1[1] *= bfhi(gt[2]); v1[2] *= bflo(gt[3]); v1[3] *= bfhi(gt[3]);
                    float* mp = Mt + (size_t)row * D + col;
                    if (u.g > 0) { v0 += *(const f32x4*)mp; v1 += *(const f32x4*)(mp + 4); }
                    if (u.g < 2) { *(f32x4*)mp = v0; *(f32x4*)(mp + 4) = v1; }
                    else { u32x4 o = {cvt_pk_bf16(v0[0], v0[1]), cvt_pk_bf16(v0[2], v0[3]), cvt_pk_bf16(v1[0], v1[1]), cvt_pk_bf16(v1[2], v1[3])}; *(u32x4*)(Mgb + (size_t)row * D + col) = o; } } }
    } };
struct SchedT4 { const char* A; const char* B; int lda2, ldb2, c, G;
    __device__ __forceinline__ bool next(int i, ge::Unit& u) const { const int L = i * G + c; if (L >= 256) return false; u.g = 0; ge::tile_order(L, 64, 4, u.pm, u.pn); return true; }
    __device__ __forceinline__ const char* aptr(const ge::Unit& u) const { return A + (size_t)u.pm * lda2; }
    __device__ __forceinline__ const char* bptr(const ge::Unit& u) const { return B + (size_t)u.pn * ldb2; } };
struct EpiRes { const float* X; float* Z;
    __device__ __forceinline__ void operator()(const ge::Acc& acc, const ge::Unit& u, int wr, int wc, int fr, int fq) const {
        const int row0 = u.pm * 256 + wr * 64 + fr, col0 = u.pn * 256 + wc * 32 + 8 * fq;
#pragma unroll
        for (int ai = 0; ai < 2; ++ai)
#pragma unroll
            for (int m = 0; m < 4; ++m) { asm volatile("" ::: "memory"); const size_t o = (size_t)(row0 + ai * 128 + m * 16) * D + col0;
#pragma unroll
                for (int bj = 0; bj < 2; ++bj) { const f32x4 x0 = *(const f32x4*)(X + o + bj * 128), x1 = *(const f32x4*)(X + o + bj * 128 + 4);
                    *(f32x4*)(Z + o + bj * 128) = x0 * DN_ALPHA + acc[ai][bj][m][0]; *(f32x4*)(Z + o + bj * 128 + 4) = x1 * DN_ALPHA + acc[ai][bj][m][1]; } }
    } };
struct EpiU { bf16_t* Ub;
    __device__ __forceinline__ void operator()(const ge::Acc& acc, const ge::Unit& u, int wr, int wc, int fr, int fq) const {
        const int row0 = u.pm * 256 + wr * 64 + fr, col0 = u.pn * 256 + wc * 32 + 8 * fq;
#pragma unroll
        for (int ai = 0; ai < 2; ++ai)
#pragma unroll
            for (int m = 0; m < 4; ++m) { const size_t o = (size_t)(row0 + ai * 128 + m * 16) * D + col0;
#pragma unroll
                for (int bj = 0; bj < 2; ++bj) { const f32x4 v0 = acc[ai][bj][m][0], v1 = acc[ai][bj][m][1];
                    u32x4 w = {cvt_pk_bf16(v0[0], v0[1]), cvt_pk_bf16(v0[2], v0[3]), cvt_pk_bf16(v1[0], v1[1]), cvt_pk_bf16(v1[2], v1[3])}; *(u32x4*)(Ub + o + bj * 128) = w; } }
    } };
struct EpiPle { const float* X; float* Z; const bf16_t* Ub; const float* bias;
    __device__ __forceinline__ void operator()(const ge::Acc& acc, const ge::Unit& u, int wr, int wc, int fr, int fq) const {
        const int row0 = u.pm * 256 + wr * 64 + fr, col0 = u.pn * 256 + wc * 32 + 8 * fq;
        f32x4 bv[2][2];
#pragma unroll
        for (int bj = 0; bj < 2; ++bj) { bv[bj][0] = *(const f32x4*)(bias + col0 + bj * 128); bv[bj][1] = *(const f32x4*)(bias + col0 + bj * 128 + 4); }
#pragma unroll
        for (int ai = 0; ai < 2; ++ai)
#pragma unroll
            for (int m = 0; m < 4; ++m) { asm volatile("" ::: "memory"); const size_t o = (size_t)(row0 + ai * 128 + m * 16) * D + col0;
#pragma unroll
                for (int bj = 0; bj < 2; ++bj) { const f32x4 x0 = *(const f32x4*)(X + o + bj * 128), x1 = *(const f32x4*)(X + o + bj * 128 + 4); const u32x4 uu = *(const u32x4*)(Ub + o + bj * 128);
                    f32x4 g0 = acc[ai][bj][m][0] + bv[bj][0], g1 = acc[ai][bj][m][1] + bv[bj][1];
#pragma unroll
                    for (int j = 0; j < 4; ++j) { g0[j] = 1.f / (1.f + __expf(-g0[j])); g1[j] = 1.f / (1.f + __expf(-g1[j])); }
                    f32x4 u0 = {bflo(uu[0]), bfhi(uu[0]), bflo(uu[1]), bfhi(uu[1])}, u1 = {bflo(uu[2]), bfhi(uu[2]), bflo(uu[3]), bfhi(uu[3])};
                    *(f32x4*)(Z + o + bj * 128) = x0 * DN_ALPHA + g0 * u0; *(f32x4*)(Z + o + bj * 128 + 4) = x1 * DN_ALPHA + g1 * u1; } }
    } };

__device__ __forceinline__ void moe_table(LAS unsigned char* lds, const int* cnt) {
    LAS int* te = (LAS int*)(lds + 131072); LAS int* tr = te + 256; LAS int* cl = tr + 256; LAS int* nt = cl + 64;
    __syncthreads();
    if (tid_now() < 64) cl[tid_now()] = cnt[tid_now()];
    __syncthreads();
    if (tid_now() == 0) { int n = 0; for (int e = 0; e < NE; ++e) for (int r = 0; r < cl[e]; r += 256) { te[n] = e; tr[n] = r; ++n; } nt[0] = n; }
    __syncthreads();
}
struct SchedM1 { const char* Xb; const char* W; const int* lists; LAS int* te; int c, G;
    __device__ __forceinline__ bool next(int i, ge::Unit& u) const { const int L = i * G + c; if (L >= 2 * te[576]) return false; u.pm = L >> 1; u.pn = L & 1; u.g = te[u.pm]; return true; }
    __device__ __forceinline__ int arow(const ge::Unit& u, int r) const { const int n = te[512 + u.g], idx = min(te[256 + u.pm] + r, n - 1); return lists[u.g * LCAP + idx] >> 1; }
    __device__ __forceinline__ const char* aptr(const ge::Unit&) const { return Xb; }
    __device__ __forceinline__ const char* bptr(const ge::Unit& u) const { return W + ((size_t)u.g * 512 + u.pn * 256) * D * 2; } };
struct EpiM1 { bf16_t* Hbuf;
    __device__ __forceinline__ void operator()(const ge::Acc& acc, const ge::Unit& u, int wr, int wc, int fr, int fq) const {
#pragma unroll
        for (int ai = 0; ai < 2; ++ai)
#pragma unroll
            for (int m = 0; m < 4; ++m) { const int row = ai * 128 + wr * 64 + m * 16 + fr;
                float h[8];
#pragma unroll
                for (int n = 0; n < 2; ++n)
#pragma unroll
                    for (int j = 0; j < 4; ++j) { const float g = acc[ai][0][m][n][j], uu = acc[ai][1][m][n][j]; h[4 * n + j] = g / (1.f + __expf(-g)) * uu; }
                u32x4 o = {cvt_pk_bf16(h[0], h[1]), cvt_pk_bf16(h[2], h[3]), cvt_pk_bf16(h[4], h[5]), cvt_pk_bf16(h[6], h[7])};
                *(u32x4*)(Hbuf + ((size_t)u.pm * 256 + row) * EH + u.pn * 128 + wc * 32 + 8 * fq) = o; }
    } };
struct SchedM2 { const char* Hb; const char* W; LAS int* te; int c, G;
    __device__ __forceinline__ bool next(int i, ge::Unit& u) const { const int L = i * G + c; if (L >= 4 * te[576]) return false; u.pm = L >> 2; u.pn = L & 3; u.g = te[u.pm]; return true; }
    __device__ __forceinline__ const char* aptr(const ge::Unit& u) const { return Hb + (size_t)u.pm * 256 * EH * 2; }
    __device__ __forceinline__ const char* bptr(const ge::Unit& u) const { return W + ((size_t)u.g * D + u.pn * 256) * EH * 2; } };
struct EpiM2 { bf16_t* Ys; const int* lists; LAS int* te;
    __device__ __forceinline__ void operator()(const ge::Acc& acc, const ge::Unit& u, int wr, int wc, int fr, int fq) const {
        const int r0 = te[256 + u.pm], n = te[512 + u.g];
#pragma unroll
        for (int ai = 0; ai < 2; ++ai)
#pragma unroll
            for (int m = 0; m < 4; ++m) { const int row = r0 + ai * 128 + wr * 64 + m * 16 + fr;
                if (row < n) { const int a = lists[u.g * LCAP + row];
#pragma unroll
                    for (int bj = 0; bj < 2; ++bj) { const f32x4 v0 = acc[ai][bj][m][0], v1 = acc[ai][bj][m][1];
                        u32x4 o = {cvt_pk_bf16(v0[0], v0[1]), cvt_pk_bf16(v0[2], v0[3]), cvt_pk_bf16(v1[0], v1[1]), cvt_pk_bf16(v1[2], v1[3])};
                        *(u32x4*)(Ys + (size_t)a * D + u.pn * 256 + bj * 128 + wc * 32 + 8 * fq) = o; } } }
    } };

#define XB_TMO      128
#define XB_XCNT(j)  (256  + 64 * (j))
#define XB_XSUB(j)  (1280 + 64 * (j))
#define XB_XGEN(j)  (2304 + 64 * (j))
#define XB_TOP      3328
#define XB_TOPGEN   3392
#define XCD_BAR_WORDS 3456
#define XB_SPIN_CAP (1u << 18)

__device__ __forceinline__ unsigned xb_ld(unsigned* p)              { return __hip_atomic_load(p, __ATOMIC_RELAXED, __HIP_MEMORY_SCOPE_AGENT); }
__device__ __forceinline__ unsigned xb_add(unsigned* p, unsigned v) { return __hip_atomic_fetch_add(p, v, __ATOMIC_RELAXED, __HIP_MEMORY_SCOPE_AGENT); }
__device__ __forceinline__ unsigned xb_xcc_id() { return (unsigned)__builtin_amdgcn_s_getreg((3 << 11) | 20) & 0xFu; }
#define XB_SPIN(cond, bar) do { unsigned _sp = 0; while (cond) { __builtin_amdgcn_s_sleep(1); \
    if ((++_sp & 255u) == 0u) { if (xb_ld(&(bar)[XB_TMO])) break; if (_sp > XB_SPIN_CAP) { atomicAdd(&(bar)[XB_TMO], 1u); break; } } } } while (0)

struct XcdBarrier {
    unsigned* bar; unsigned x;
    volatile LAS unsigned* st;
};

__device__ __forceinline__ XcdBarrier xcd_barrier_post(unsigned* bar, volatile LAS unsigned* st) {
    XcdBarrier b; b.bar = bar; b.x = xb_xcc_id(); b.st = st;
    if (threadIdx.x == 0) (void)xb_add(&bar[XB_XCNT(b.x)], 1u);
    return b;
}
__device__ __forceinline__ void xcd_barrier_complete(unsigned* bar, unsigned x, unsigned& nloc, unsigned& nx) {
    const unsigned G = gridDim.x * gridDim.y * gridDim.z;
    unsigned sum, cnt, mine, sp = 0u;
    for (;;) {
        sum = 0u; cnt = 0u; mine = 0u;
#pragma unroll
        for (unsigned j = 0; j < 16; ++j) { const unsigned c = xb_ld(&bar[XB_XCNT(j)]); sum += c; cnt += (c > 0u) ? 1u : 0u; mine = (j == x) ? c : mine; }
        if (sum == G) break;
        __builtin_amdgcn_s_sleep(1);
        if ((++sp & 255u) == 0u) { if (xb_ld(&bar[XB_TMO])) break; if (sp > XB_SPIN_CAP) { atomicAdd(&bar[XB_TMO], 1u); break; } }
    }
    nloc = mine > 0u ? mine : 1u; nx = cnt > 0u ? cnt : 1u;
}

__device__ __forceinline__ void xcd_barrier(const XcdBarrier& b) {
    asm volatile("s_waitcnt vmcnt(0)" ::: "memory");
    __syncthreads();
    if (threadIdx.x == 0) {
        unsigned* bar = b.bar;
        __builtin_amdgcn_s_waitcnt(0);
        unsigned nloc = b.st[0], nx = b.st[1];
        if (nloc == 0u) { xcd_barrier_complete(bar, b.x, nloc, nx); b.st[0] = nloc; b.st[1] = nx; }
        const unsigned old = xb_add(&bar[XB_XSUB(b.x)], 1u);
        const unsigned gen = old / nloc;
        if (old + 1u == (gen + 1u) * nloc) {
            __builtin_amdgcn_fence(__ATOMIC_RELEASE, "agent");
            asm volatile("s_waitcnt vmcnt(0)" ::: "memory");
            const unsigned og = xb_add(&bar[XB_TOP], 1u);
            const unsigned tg = og / nx;
            if (og + 1u == (tg + 1u) * nx) xb_add(&bar[XB_TOPGEN], 1u);
            else XB_SPIN(xb_ld(&bar[XB_TOPGEN]) == tg, bar);
            __builtin_amdgcn_fence(__ATOMIC_ACQUIRE, "agent");
            xb_add(&bar[XB_XGEN(b.x)], 1u);
            asm volatile("s_waitcnt vmcnt(0)" ::: "memory");
        } else {
            XB_SPIN(xb_ld(&bar[XB_XGEN(b.x)]) == gen, bar);
            __builtin_amdgcn_fence(__ATOMIC_ACQUIRE, "agent");
            asm volatile("s_waitcnt vmcnt(0)" ::: "memory");
        }
    }
    __syncthreads();
}

enum { PH_PRO = 0, PH_CONV, PH_IN, PH_PREP_Q, PH_PREP_K, PH_PREP_V, PH_PREP_G, PH_ATT, PH_FIN, PH_BR, PH_WO, PH_LN1, PH_M1, PH_M2, PH_LN2, PH_PLE, PH_LN3 };
template <int PH> __global__ __launch_bounds__(NTHR, 2) void k_ph(P p, int layer) {
    extern __shared__ __attribute__((aligned(16))) unsigned char smem[];
    LAS unsigned char* lds = (LAS unsigned char*)smem;
    tid_setup();
    const int c = blockIdx.x, G = gridDim.x;
    if constexpr (PH == PH_PRO) ph_prologue(p);
    if constexpr (PH == PH_CONV) ph_convert(lds, p, layer);
    if constexpr (PH == PH_IN) { const MegaP m = mk_mega(p); SchedIn S{(const char*)m.Xb, (const char*)m.Wb_in, (const char*)m.Wb_gv, c, G, 0}; EpiIn<2> E{m.Hp, m.GVt, m.ssq_q, m.ssq_kv}; ge::gemm_stream<EpiIn<2>, SchedIn, false>(lds, D, D, D, S, E); }
    if constexpr (PH == PH_PREP_Q) { const MlaP q = mk_mla(p); SchedMla<0> S{(const char*)(q.Hp + H_CQ), (const char*)q.Wb_uq, c, G}; EpiMla<0> E{q}; ge::gemm_stream<EpiMla<0>, SchedMla<0>, false>(lds, 256, HW, 256, S, E); }
    if constexpr (PH == PH_PREP_K) { const MlaP q = mk_mla(p); SchedMla<1> S{(const char*)(q.Hp + H_CKV), (const char*)q.Wb_uk, (c + 64) % G, G}; EpiMla<1> E{q}; ge::gemm_stream<EpiMla<1>, SchedMla<1>, false>(lds, 256, HW, 256, S, E); }
    if constexpr (PH == PH_PREP_V) { const MlaP q = mk_mla(p); SchedMla<2> S{(const char*)q.Wb_uv, (const char*)(q.Hp + H_CKV), (c + 192) % G, G}; EpiMla<2> E{q}; ge::gemm_stream<EpiMla<2>, SchedMla<2>, false>(lds, 256, 256, HW, S, E); }
    if constexpr (PH == PH_PREP_G) { { const MegaP m = mk_mega(p); SchedIn S{(const char*)m.Xb, (const char*)m.Wb_in, (const char*)m.Wb_gv, (c + 128) % G, G, 1}; EpiIn<0> E{m.Hp, m.GVt, m.ssq_q, m.ssq_kv}; ge::gemm_stream<EpiIn<0>, SchedIn, false>(lds, D, D, D, S, E); } const MlaP q = mk_mla(p); kr_phase(q, c * NTHR + tid_now(), G * NTHR); const GlaP g = mk_gla(p, layer); gla_g1(lds, g, c, G); }
    if constexpr (PH == PH_ATT) { const GlaP g = mk_gla(p, layer); gla_g2(g, c); __syncthreads(); const MlaP q = mk_mla(p); attn_phase(lds, q, c); }
    if constexpr (PH == PH_FIN) { const GlaP g = mk_gla(p, layer); gla_g3(lds, g, c, G); conv_phase(g, c * NTHR + tid_now(), G * NTHR); attn_combine_bf16(g, c * NTHR + tid_now(), G * NTHR); }
    if constexpr (PH == PH_BR) { SchedBr S{(const char*)p.Yab, (const char*)p.Ybb, (const char*)p.Ycb, (const char*)p.Wb_br, c, G}; EpiBr E{p.Hp, p.Z, p.Mgb}; ge::gemm_stream<EpiBr, SchedBr, false>(lds, 512, 512, 512, S, E); }
    if constexpr (PH == PH_WO) { SchedT4 S{(const char*)p.Mgb, (const char*)p.Wb_o, 256 * D * 2, 256 * D * 2, c, G}; EpiRes E{p.X, p.Z}; ge::gemm_stream<EpiRes, SchedT4, false>(lds, D, D, D, S, E); }
    if constexpr (PH == PH_LN1) ph_ln1_router(p, layer);
    if constexpr (PH == PH_M1) { moe_table(lds, p.cnt + layer * 64); LAS int* te = (LAS int*)(lds + 131072);
        SchedM1 S{(const char*)p.Xb, (const char*)p.Wb_gu, p.lists, te, c, G}; EpiM1 E{p.Hbuf}; ge::gemm_stream<EpiM1, SchedM1, true>(lds, D, D, D, S, E); }
    if constexpr (PH == PH_M2) { moe_table(lds, p.cnt + layer * 64); LAS int* te = (LAS int*)(lds + 131072);
        SchedM2 S{(const char*)p.Hbuf, (const char*)p.Wb_d, te, c, G}; EpiM2 E{p.Ys, p.lists, te}; ge::gemm_stream<EpiM2, SchedM2, false>(lds, EH, EH, EH, S, E); }
    if constexpr (PH == PH_LN2) ph_rows<2>(p, layer);
    if constexpr (PH == PH_PLE) {
        { SchedT4 S{(const char*)(p.Pb + (size_t)layer * T * PLE), (const char*)p.Wb_pu, 256 * PLE * 2, 256 * PLE * 2, c, G}; EpiU E{p.Ub}; ge::gemm_stream<EpiU, SchedT4, false>(lds, PLE, PLE, PLE, S, E); }
        { SchedT4 S{(const char*)p.Xb, (const char*)p.Wb_pg, 256 * D * 2, 256 * D * 2, c, G}; EpiPle E{p.X, p.Z, p.Ub, p.b_pg + layer * D}; ge::gemm_stream<EpiPle, SchedT4, false>(lds, D, D, D, S, E); } }
    if constexpr (PH == PH_LN3) ph_rows<3>(p, layer);
}


typedef const P __attribute__((address_space(4))) CP;
__device__ __forceinline__ P load_params() { CP* q = (CP*)__builtin_amdgcn_kernarg_segment_ptr(); asm volatile("" : "+s"(q)); return *(const P*)q; }
#define GRID_BAR() do { XcdBarrier b_; b_.bar = load_params().bar; b_.x = xb_xcc_id(); b_.st = xbw; xcd_barrier(b_); } while (0)
__global__ __launch_bounds__(NTHR, 2) void k_mega(P p_arg) {
    extern __shared__ __attribute__((aligned(16))) unsigned char smem[];
    LAS unsigned char* lds = (LAS unsigned char*)smem;
    const int G = NBLK;
#define c sgpr_now((int)blockIdx.x)
    volatile LAS unsigned* xbw = (volatile LAS unsigned*)(lds + XBW_OFF);
    tid_setup();
    if (tid_now() < 4) xbw[tid_now()] = 0u;
    __syncthreads();
    (void)xcd_barrier_post(p_arg.bar, xbw);
    { const P p = load_params(); ph_prologue(p); }
    { const P p = load_params(); ph_convert(lds, p, 0); }
    GRID_BAR();
    for (int layer = 0; layer < DEPTH; ++layer) {
        { const P p = load_params(); const MegaP m = mk_mega(p); SchedIn S{(const char*)m.Xb, (const char*)m.Wb_in, (const char*)m.Wb_gv, c, G, 0}; EpiIn<2> E{m.Hp, m.GVt, m.ssq_q, m.ssq_kv}; ge::gemm_stream<EpiIn<2>, SchedIn, false>(lds, D, D, D, S, E); }
        GRID_BAR();
        { const P p = load_params(); const MlaP q = mk_mla(p);
          { SchedMla<0> S{(const char*)(q.Hp + H_CQ), (const char*)q.Wb_uq, c, G}; EpiMla<0> E{q}; ge::gemm_stream<EpiMla<0>, SchedMla<0>, false>(lds, 256, HW, 256, S, E); }
          { SchedMla<1> S{(const char*)(q.Hp + H_CKV), (const char*)q.Wb_uk, (c + 64) % G, G}; EpiMla<1> E{q}; ge::gemm_stream<EpiMla<1>, SchedMla<1>, false>(lds, 256, HW, 256, S, E); }
          { SchedMla<2> S{(const char*)q.Wb_uv, (const char*)(q.Hp + H_CKV), (c + 192) % G, G}; EpiMla<2> E{q}; ge::gemm_stream<EpiMla<2>, SchedMla<2>, false>(lds, 256, 256, HW, S, E); }
          { const MegaP m = mk_mega(p); SchedIn S{(const char*)m.Xb, (const char*)m.Wb_in, (const char*)m.Wb_gv, (c + 128) % G, G, 1}; EpiIn<0> E{m.Hp, m.GVt, m.ssq_q, m.ssq_kv}; ge::gemm_stream<EpiIn<0>, SchedIn, false>(lds, D, D, D, S, E); }
          kr_phase(q, c * NTHR + tid_now(), G * NTHR);
          const GlaP g = mk_gla(p, layer); gla_g1(lds, g, c, G); }
        GRID_BAR();
        { const P p = load_params(); const GlaP g = mk_gla(p, layer); gla_g2(g, c); __syncthreads(); const MlaP q = mk_mla(p); attn_phase(lds, q, c); }
        GRID_BAR();
        { const P p = load_params(); const GlaP g = mk_gla(p, layer); gla_g3(lds, g, c, G); conv_phase(g, c * NTHR + tid_now(), G * NTHR); attn_combine_bf16(g, c * NTHR + tid_now(), G * NTHR); }
        GRID_BAR();
        { const P p = load_params(); SchedBr S{(const char*)p.Yab, (const char*)p.Ybb, (const char*)p.Ycb, (const char*)p.Wb_br, c, G}; EpiBr E{p.Hp, p.Z, p.Mgb}; ge::gemm_stream<EpiBr, SchedBr, false>(lds, 512, 512, 512, S, E); }
        GRID_BAR();
        { const P p = load_params(); SchedT4 S{(const char*)p.Mgb, (const char*)p.Wb_o, 256 * D * 2, 256 * D * 2, c, G}; EpiRes E{p.X, p.Z}; ge::gemm_stream<EpiRes, SchedT4, false>(lds, D, D, D, S, E); }
        GRID_BAR();
        { const P p = load_params(); ph_ln1_router(p, layer); }
        GRID_BAR();
        { const P p = load_params(); moe_table(lds, p.cnt + layer * 64); LAS int* te = (LAS int*)(lds + 131072);
          SchedM1 S{(const char*)p.Xb, (const char*)p.Wb_gu, p.lists, te, c, G}; EpiM1 E{p.Hbuf}; ge::gemm_stream<EpiM1, SchedM1, true>(lds, D, D, D, S, E); }
        GRID_BAR();
        { const P p = load_params(); LAS int* te = (LAS int*)(lds + 131072);
          SchedM2 S{(const char*)p.Hbuf, (const char*)p.Wb_d, te, c, G}; EpiM2 E{p.Ys, p.lists, te}; ge::gemm_stream<EpiM2, SchedM2, false>(lds, EH, EH, EH, S, E); }
        GRID_BAR();
        { const P p = load_params(); ph_rows<2>(p, layer); }
        GRID_BAR();
        { const P p = load_params(); SchedT4 S{(const char*)(p.Pb + (size_t)layer * T * PLE), (const char*)p.Wb_pu, 256 * PLE * 2, 256 * PLE * 2, c, G}; EpiU E{p.Ub}; ge::gemm_stream<EpiU, SchedT4, false>(lds, PLE, PLE, PLE, S, E); }
        { const P p = load_params(); SchedT4 S{(const char*)p.Xb, (const char*)p.Wb_pg, 256 * D * 2, 256 * D * 2, c, G}; EpiPle E{p.X, p.Z, p.Ub, p.b_pg + layer * D}; ge::gemm_stream<EpiPle, SchedT4, false>(lds, D, D, D, S, E); }
        GRID_BAR();
        { const P p = load_params(); ph_rows<3>(p, layer); }
        if (layer + 1 < DEPTH) { { const P p = load_params(); ph_convert(lds, p, layer + 1); } GRID_BAR(); }
    }
#undef c
}

template <int PH> static void launch_ph(const P& p, int layer, hipStream_t st) {
    static bool set = false;
    if (!set) { (void)hipFuncSetAttribute((const void*)k_ph<PH>, hipFuncAttributeMaxDynamicSharedMemorySize, LDS_BYTES); set = true; }
    hipLaunchKernelGGL((k_ph<PH>), dim3(NBLK), dim3(NTHR), LDS_BYTES, st, p, layer);
}
extern "C" void kernel_launch(void* const* d_in, const int* in_sizes, int n_in, void* d_out, int out_size, void* d_ws, size_t ws_size, hipStream_t st) {
    (void)in_sizes; (void)n_in; (void)out_size;
    P p{};
    p.x = (const float*)d_in[0]; p.pin = (const float*)d_in[1]; p.pos = (const int*)d_in[2]; p.ln0_g = (const float*)d_in[3]; p.ln0_b = (const float*)d_in[4];
    p.w_in = (const float*)d_in[5]; p.w_conv = (const float*)d_in[6]; p.w_gg = (const float*)d_in[7]; p.b_gg = (const float*)d_in[8]; p.gla_ng = (const float*)d_in[9];
    p.qn_g = (const float*)d_in[10]; p.kvn_g = (const float*)d_in[11]; p.w_uq = (const float*)d_in[12]; p.w_ukv = (const float*)d_in[13]; p.w_br = (const float*)d_in[14]; p.w_o = (const float*)d_in[15];
    p.ln1_g = (const float*)d_in[16]; p.ln1_b = (const float*)d_in[17]; p.w_grp = (const float*)d_in[18]; p.b_grp = (const float*)d_in[19]; p.w_exp = (const float*)d_in[20]; p.b_exp = (const float*)d_in[21];
    p.w_gate = (const float*)d_in[22]; p.w_up = (const float*)d_in[23]; p.w_down = (const float*)d_in[24]; p.ln2_g = (const float*)d_in[25]; p.ln2_b = (const float*)d_in[26];
    p.w_pg = (const float*)d_in[27]; p.b_pg = (const float*)d_in[28]; p.w_pu = (const float*)d_in[29]; p.ln3_g = (const float*)d_in[30]; p.ln3_b = (const float*)d_in[31];
    p.out = (float*)d_out;
    char* w = (char*)d_ws; size_t off = 0;
    auto alloc = [&](size_t bytes) { void* r = w + off; off += (bytes + 255) & ~(size_t)255; return r; };
    p.bar = (unsigned*)alloc(16384); p.cnt = (int*)alloc(DEPTH * 64 * 4);
    const size_t zero_bytes = off;
    p.X = (float*)alloc((size_t)T * D * 4); p.Z = (float*)alloc((size_t)T * D * 4); p.Xb = (bf16_t*)alloc((size_t)T * D * 2);
    p.cs = (float*)alloc((size_t)T * 32 * 4); p.sn = (float*)alloc((size_t)T * 32 * 4); p.ssq_q = (float*)alloc((size_t)4 * T * 4); p.ssq_kv = (float*)alloc((size_t)4 * T * 4);
    p.Hp = (bf16_t*)alloc((size_t)T * HW * 2); p.GVt = (bf16_t*)alloc((size_t)T * 512 * 2);
    p.Qb = (bf16_t*)alloc((size_t)T * 768 * 2); p.KnImg = (bf16_t*)alloc((size_t)T * 512 * 2); p.VtImg = (bf16_t*)alloc((size_t)T * 512 * 2); p.KrImg = (bf16_t*)alloc((size_t)T * 64 * 2);
    p.MLpart = (float*)alloc((size_t)512 * 256 * 2 * 4);
    p.QE = (bf16_t*)alloc((size_t)T * 256 * 2); p.OI = (float*)alloc((size_t)T * 512 * 4); p.kvT = (float*)alloc((size_t)1024 * 8192 * 4); p.decay = (float*)alloc((size_t)1024 * 64 * 4); p.spT = (bf16_t*)alloc((size_t)1024 * 8192 * 2);
    p.Yab = (bf16_t*)alloc((size_t)T * 512 * 2); p.Ybb = (bf16_t*)alloc((size_t)T * 512 * 2); p.Ycb = (bf16_t*)alloc((size_t)T * 512 * 2); p.Mgb = (bf16_t*)alloc((size_t)T * D * 2);
    p.ew = (float*)alloc((size_t)T * 2 * 4); p.lists = (int*)alloc((size_t)NE * LCAP * 4);
    p.Hbuf = (bf16_t*)alloc((size_t)192 * 256 * EH * 2); p.Ys = (bf16_t*)alloc((size_t)2 * T * D * 2); p.Ub = (bf16_t*)alloc((size_t)T * D * 2); p.Pb = (bf16_t*)alloc((size_t)DEPTH * T * PLE * 2);
    p.Wb_in = (bf16_t*)alloc((size_t)HW * D * 2); p.Wb_gv = (bf16_t*)alloc((size_t)512 * D * 2); p.Wb_uq = (bf16_t*)alloc((size_t)768 * 256 * 2); p.Wb_uk = (bf16_t*)alloc((size_t)512 * 256 * 2); p.Wb_uv = (bf16_t*)alloc((size_t)512 * 256 * 2);
    p.Wb_br = (bf16_t*)alloc((size_t)3 * D * 512 * 2); p.Wb_o = (bf16_t*)alloc((size_t)D * D * 2); p.Wb_gu = (bf16_t*)alloc((size_t)NE * 512 * D * 2); p.Wb_d = (bf16_t*)alloc((size_t)NE * D * EH * 2);
    p.Wb_pg = (bf16_t*)alloc((size_t)D * D * 2); p.Wb_pu = (bf16_t*)alloc((size_t)D * PLE * 2);
    if (off > ws_size) return;
    (void)hipMemsetAsync(d_ws, 0, zero_bytes, st);
#if defined(MULTI_LAUNCH)
    launch_ph<PH_PRO>(p, 0, st);
    for (int i = 0; i < DEPTH; ++i) {
        launch_ph<PH_CONV>(p, i, st); launch_ph<PH_IN>(p, i, st);
        launch_ph<PH_PREP_Q>(p, i, st); launch_ph<PH_PREP_K>(p, i, st); launch_ph<PH_PREP_V>(p, i, st); launch_ph<PH_PREP_G>(p, i, st);
        launch_ph<PH_ATT>(p, i, st); launch_ph<PH_FIN>(p, i, st); launch_ph<PH_BR>(p, i, st); launch_ph<PH_WO>(p, i, st); launch_ph<PH_LN1>(p, i, st);
        launch_ph<PH_M1>(p, i, st); launch_ph<PH_M2>(p, i, st); launch_ph<PH_LN2>(p, i, st); launch_ph<PH_PLE>(p, i, st); launch_ph<PH_LN3>(p, i, st);
    }
#else
    static bool set = false;
    if (!set) { (void)hipFuncSetAttribute((const void*)k_mega, hipFuncAttributeMaxDynamicSharedMemorySize, LDS_BYTES); set = true; }
    hipLaunchKernelGGL(k_mega, dim3(NBLK), dim3(NTHR), LDS_BYTES, st, p);
#endif
}
```

```cpp
#include <hip/hip_runtime.h>
#include <hip/hip_bf16.h>
#include <stdint.h>

constexpr int T = 16384, D = 1024, DEPTH = 4, PLE = 256;
constexpr int NE = 64, EH = 256;
constexpr int INW = 6608;
constexpr int O_GV = 2048;
constexpr float DN_ALPHA = 1.681792830507429f;
constexpr int LCAP = 32768;
#define LAS __attribute__((address_space(3)))
typedef unsigned short bf16_t;
typedef short bf16x8 __attribute__((ext_vector_type(8)));
typedef float f32x4 __attribute__((ext_vector_type(4)));
typedef float f32x16 __attribute__((ext_vector_type(16)));
typedef unsigned u32x4 __attribute__((ext_vector_type(4)));
typedef unsigned u32x2 __attribute__((ext_vector_type(2)));
constexpr int NBLK = 256, NTHR = 512;
constexpr int STAGE_BYTES = 131072, LDS_BYTES = 147456 + 512, XBW_OFF = 147456 + 256;
constexpr int HW = 6144;
constexpr int H_AB = 0, H_AC = 512, H_AX = 1024, H_GQ = 1536, H_GK = 1792, H_GR = 2048, H_CQ = 2560, H_CKV = 2816, H_KR = 2944, H_GLR = 3008, H_GTA = 3072, H_GTB = 4096, H_GTC = 5120;

__device__ __forceinline__ unsigned cvt_pk_bf16(float lo, float hi) { unsigned r; asm volatile("v_cvt_pk_bf16_f32 %0, %1, %2" : "=v"(r) : "v"(lo), "v"(hi)); return r; }
constexpr int WTAB_OFF = 147456;
__device__ __forceinline__ int tid_now() {
    const unsigned hw = (unsigned)__builtin_amdgcn_s_getreg((5 << 11) | 4) & 63u;
    extern __shared__ __attribute__((aligned(16))) unsigned char smem_tid[];
    const int w = __builtin_amdgcn_readfirstlane(*(volatile LAS int*)((LAS unsigned char*)smem_tid + WTAB_OFF + 4 * hw));
    int l = (int)__builtin_amdgcn_mbcnt_hi(~0u, __builtin_amdgcn_mbcnt_lo(~0u, 0u));
    asm volatile("" : "+v"(l));
    return w * 64 + l; }
__device__ __forceinline__ void tid_setup() {
    const unsigned hw = (unsigned)__builtin_amdgcn_s_getreg((5 << 11) | 4) & 63u;
    extern __shared__ __attribute__((aligned(16))) unsigned char smem_tid[];
    if ((threadIdx.x & 63) == 0) *(volatile LAS int*)((LAS unsigned char*)smem_tid + WTAB_OFF + 4 * hw) = (int)(threadIdx.x >> 6);
    __syncthreads(); }
__device__ __forceinline__ int sgpr_now(int v) { asm volatile("" : "+s"(v)); return v; }
__device__ __forceinline__ float shx(float v, int mask, int lane) { return __int_as_float(__builtin_amdgcn_ds_bpermute((lane ^ mask) << 2, __float_as_int(v))); }
__device__ __forceinline__ float bf2f(bf16_t b) { return __uint_as_float(((unsigned)b) << 16); }
__device__ __forceinline__ float bflo(unsigned w) { return __uint_as_float(w << 16); }
__device__ __forceinline__ float bfhi(unsigned w) { return __uint_as_float(w & 0xffff0000u); }

namespace ge {
constexpr int BM = 256, BK = 64, HALF = 128, HTB = HALF * BK * 2;
__device__ __forceinline__ int lds_byte(int r, int c) { const int st = (r >> 4) * 2 + (c >> 5), rr = r & 15, cc = c & 31, ob = rr * 64 + cc * 2; return st * 1024 + (ob ^ (((ob >> 9) & 1) << 5)); }
__device__ __forceinline__ void stage_rc(int b, int& R, int& C) { const int st = b / 1024, sb = b % 1024, swz = sb ^ (((sb >> 9) & 1) << 5); R = (st >> 1) * 16 + swz / 64; C = (st & 1) * 32 + (swz % 64) / 2; }
__device__ __forceinline__ int perm32(int rho) { const int n = rho >> 4, i = rho & 15; return 8 * (i >> 2) + 4 * n + (i & 3); }
struct Unit { int pm, pn, g; };
typedef f32x4 Acc[2][2][4][2];
struct NoCarry { __device__ __forceinline__ bool carry(const struct Unit&) const { return false; } };

template <class Epi, class Sched, bool GATHER>
__device__ __forceinline__ void gemm_stream(LAS unsigned char* lds, const int K, const int lda, const int ldb, const Sched& S, const Epi& E) {
    const int tid = tid_now(), wid = __builtin_amdgcn_readfirstlane(tid >> 6), lane = tid & 63, wr = wid >> 2, wc = wid & 3, fr = lane & 15, fq = lane >> 4;
    const int nt = K / BK;
    Unit cur, nxt; int ui = 0;
    if (!S.next(0, cur)) return;
    unsigned voffA[2][2], nvoffA[2][2], voffB[2][2];
#pragma unroll
    for (int i = 0; i < 2; ++i) { int R, C; stage_rc(tid * 16 + i * 8192, R, C); const int Rb = (R & ~31) + perm32(R & 31);
        voffB[0][i] = (unsigned)(Rb * ldb + C) * 2u; voffB[1][i] = (unsigned)((Rb + 128) * ldb + C) * 2u;
        if constexpr (GATHER) { voffA[0][i] = (unsigned)(S.arow(cur, R) * lda + C) * 2u; voffA[1][i] = (unsigned)(S.arow(cur, R + 128) * lda + C) * 2u; }
        else { voffA[0][i] = (unsigned)(R * lda + C) * 2u; voffA[1][i] = (unsigned)((R + 128) * lda + C) * 2u; }
        nvoffA[0][i] = voffA[0][i]; nvoffA[1][i] = voffA[1][i]; }
    const size_t kstep = (size_t)(BK * 2);
    const unsigned ldsw = (unsigned)wid * 1024u;
    const int aoff = lds_byte(wr * 64 + fr, fq * 8), boff = lds_byte(wc * 32 + fr, fq * 8);
#define GE_SA(b, h) (((b) * 2 + (h)) * HTB)
#define GE_SB(b, h) ((4 + (b) * 2 + (h)) * HTB)
#define GE_STAGE(bufoff, gbase, voff) do { _Pragma("unroll") for (int _i = 0; _i < 2; ++_i) \
        __builtin_amdgcn_global_load_lds((const unsigned*)((const char*)(gbase) + (voff)[_i]), (LAS unsigned*)(lds + (bufoff) + ldsw + _i * 8192), 16, 0, 0); } while (0)
#define GE_LDA(dst, b, h) do { _Pragma("unroll") for (int m = 0; m < 4; ++m) _Pragma("unroll") for (int k = 0; k < 2; ++k) dst[m][k] = *(const LAS bf16x8*)(lds + GE_SA(b, h) + aoff + m * 2048 + k * 1024); } while (0)
#define GE_LDB(dst, b, h) do { _Pragma("unroll") for (int n = 0; n < 2; ++n) _Pragma("unroll") for (int k = 0; k < 2; ++k) dst[n][k] = *(const LAS bf16x8*)(lds + GE_SB(b, h) + boff + n * 2048 + k * 1024); } while (0)
#define GE_MMA(ai, bj, At, Bt) do { __builtin_amdgcn_s_setprio(1); _Pragma("unroll") for (int m = 0; m < 4; ++m) _Pragma("unroll") for (int n = 0; n < 2; ++n) _Pragma("unroll") for (int k = 0; k < 2; ++k) \
        acc[ai][bj][m][n] = __builtin_amdgcn_mfma_f32_16x16x32_bf16(Bt[n][k], At[m][k], acc[ai][bj][m][n], 0, 0, 0); __builtin_amdgcn_s_setprio(0); } while (0)
#define GE_WAIT_V(n) asm volatile("s_waitcnt vmcnt(" #n ")" ::: "memory")
#define GE_WAIT_L(n) asm volatile("s_waitcnt lgkmcnt(" #n ")" ::: "memory")
#define GE_BAR __builtin_amdgcn_s_barrier()
#define GE_SCHED __builtin_amdgcn_sched_barrier(0)
    Acc acc;
#pragma unroll
    for (int a = 0; a < 2; ++a)
#pragma unroll
        for (int b = 0; b < 2; ++b)
#pragma unroll
            for (int m = 0; m < 4; ++m)
#pragma unroll
                for (int n = 0; n < 2; ++n) acc[a][b][m][n] = (f32x4){0.f, 0.f, 0.f, 0.f};
    bf16x8 At[4][2], B0[2][2], B1[2][2];
    const char* cA = S.aptr(cur); const char* cB = S.bptr(cur);
    GE_STAGE(GE_SB(0, 0), cB, voffB[0]); GE_STAGE(GE_SA(0, 0), cA, voffA[0]); GE_STAGE(GE_SB(0, 1), cB, voffB[1]); GE_STAGE(GE_SA(0, 1), cA, voffA[1]);
    if (wr == 1) GE_BAR;
    GE_WAIT_V(4); GE_BAR;
    GE_STAGE(GE_SB(1, 0), cB + kstep, voffB[0]); GE_STAGE(GE_SA(1, 0), cA + kstep, voffA[0]); GE_STAGE(GE_SB(1, 1), cB + kstep, voffB[1]);
    GE_WAIT_V(6); GE_BAR;
    for (;;) {
        const bool has_next = S.next(ui + 1, nxt);
        const char* nA = has_next ? S.aptr(nxt) : cA; const char* nB = has_next ? S.bptr(nxt) : cB;
#pragma unroll 1
        for (int t = 0; t < nt; t += 2) {
            const bool last = (t == nt - 2);
            const char* a1 = cA + (size_t)(t + 1) * kstep;
            const char* a2 = last ? nA : cA + (size_t)(t + 2) * kstep; const char* b2 = last ? nB : cB + (size_t)(t + 2) * kstep;
            const char* a3 = a2 + kstep; const char* b3 = b2 + kstep;
            if constexpr (GATHER) { if (last && has_next) {
#pragma unroll
                for (int i = 0; i < 2; ++i) { int R, C; stage_rc(tid * 16 + i * 8192, R, C);
                    nvoffA[0][i] = (unsigned)(S.arow(nxt, R) * lda + C) * 2u; nvoffA[1][i] = (unsigned)(S.arow(nxt, R + 128) * lda + C) * 2u; } } }
            unsigned va2[2][2];
#pragma unroll
            for (int h = 0; h < 2; ++h)
#pragma unroll
                for (int i = 0; i < 2; ++i) va2[h][i] = (GATHER && last) ? nvoffA[h][i] : voffA[h][i];
            GE_LDB(B0, 0, 0); GE_SCHED; GE_LDA(At, 0, 0); GE_STAGE(GE_SA(1, 1), a1, voffA[1]);
            GE_WAIT_L(8); GE_BAR; GE_WAIT_L(0); GE_MMA(0, 0, At, B0); GE_BAR; GE_SCHED;
            GE_LDB(B1, 0, 1); GE_STAGE(GE_SB(0, 0), b2, voffB[0]);
            GE_BAR; GE_WAIT_L(0); GE_MMA(0, 1, At, B1); GE_BAR;
            GE_LDA(At, 0, 1); GE_STAGE(GE_SA(0, 0), a2, va2[0]);
            GE_BAR; GE_WAIT_L(0); GE_MMA(1, 0, At, B0); GE_BAR; GE_SCHED;
            GE_STAGE(GE_SB(0, 1), b2, voffB[1]);
            GE_WAIT_V(6); GE_BAR; GE_MMA(1, 1, At, B1); GE_BAR;
            GE_LDB(B0, 1, 0); GE_SCHED; GE_LDA(At, 1, 0); GE_STAGE(GE_SA(0, 1), a2, va2[1]);
            GE_WAIT_L(8); GE_BAR; GE_WAIT_L(0); GE_MMA(0, 0, At, B0); GE_BAR; GE_SCHED;
            GE_LDB(B1, 1, 1); GE_STAGE(GE_SB(1, 0), b3, voffB[0]);
            GE_BAR; GE_WAIT_L(0); GE_MMA(0, 1, At, B1); GE_BAR;
            GE_LDA(At, 1, 1); GE_STAGE(GE_SA(1, 0), a3, va2[0]);
            GE_BAR; GE_WAIT_L(0); GE_MMA(1, 0, At, B0); GE_BAR; GE_SCHED;
            GE_STAGE(GE_SB(1, 1), b3, voffB[1]);
            GE_WAIT_V(6); GE_BAR; GE_MMA(1, 1, At, B1); GE_BAR;
        }
        { int tz = tid; asm volatile("" : "+v"(tz));
          const int wid2 = tz >> 6, lane2 = tz & 63; E(acc, cur, wid2 >> 2, wid2 & 3, lane2 & 15, lane2 >> 4); }
        if (!has_next) break;
        if (!S.carry(cur)) {
#pragma unroll
        for (int a = 0; a < 2; ++a)
#pragma unroll
            for (int b = 0; b < 2; ++b)
#pragma unroll
                for (int m = 0; m < 4; ++m)
#pragma unroll
                    for (int n = 0; n < 2; ++n) acc[a][b][m][n] = (f32x4){0.f, 0.f, 0.f, 0.f}; }
        cur = nxt; cA = nA; cB = nB; ++ui;
        if (GATHER) {
#pragma unroll
            for (int h = 0; h < 2; ++h)
#pragma unroll
                for (int i = 0; i < 2; ++i) voffA[h][i] = nvoffA[h][i]; }
    }
    GE_WAIT_V(0);
    if (wr == 0) GE_BAR;
    GE_BAR;
#undef GE_SA
#undef GE_SB
#undef GE_STAGE
#undef GE_LDA
#undef GE_LDB
#undef GE_MMA
#undef GE_WAIT_V
#undef GE_WAIT_L
#undef GE_BAR
#undef GE_SCHED
}
__device__ __forceinline__ void tile_order(int L, int nM, int nN, int& pm, int& pn) {
    const int nwg = nM * nN; int wgid = L;
    { const int q = nwg / 8, r = nwg % 8, xcd = wgid % 8, off = wgid / 8; wgid = (xcd < r ? xcd * (q + 1) : r * (q + 1) + (xcd - r) * q) + off; }
    const int nig = 8 * nN, gid = wgid / nig, fm = gid * 8, gsz = (nM - fm) < 8 ? (nM - fm) : 8;
    pm = fm + ((wgid % nig) % gsz); pn = (wgid % nig) / gsz;
}
}
struct MapInMain { __device__ __forceinline__ int operator()(int s) const {
    if (s < 2048) return s;
    if (s < 2560) return 2576 + (s - 2048);
    if (s < 2816) return 3088 + (s - 2560);
    if (s < 2944) return 3344 + (s - 2816);
    if (s < 3008) return 3472 + (s - 2944);
    if (s < 3024) return 2560 + (s - 3008);
    if (s < 3072) return -1;
    return 3536 + (s - 3072); } };
struct MapOff { int off; __device__ __forceinline__ int operator()(int s) const { return off + s; } };struct MegaP {
    const float* w_in; bf16_t* Wb_in; bf16_t* Wb_gv; const bf16_t* Xb; bf16_t* Hp; bf16_t* GVt; float* ssq_q; float* ssq_kv;
};
struct SchedIn : ge::NoCarry {
    const char* Xb; const char* Wm; const char* Wg; int c, G, gv;
    __device__ __forceinline__ bool next(int i, ge::Unit& u) const {
        const int L = i * G + c;
        if (gv) { if (L >= 128) return false; u.g = 0; u.pm = L >> 1; u.pn = 8 + (L & 1); return true; }
        if (L >= 1536) return false;
        if (L < 1408) { u.g = 0; ge::tile_order(L, 64, 22, u.pm, u.pn); if (u.pn >= 8) u.pn += 2; } else { u.g = 1; const int l = L - 1408; u.pm = l & 1; u.pn = l >> 1; }
        return true; }
    __device__ __forceinline__ const char* aptr(const ge::Unit& u) const { return u.g == 0 ? Xb + (size_t)u.pm * 256 * D * 2 : Wg + (size_t)u.pm * 256 * D * 2; }
    __device__ __forceinline__ const char* bptr(const ge::Unit& u) const { return u.g == 0 ? Wm + (size_t)u.pn * 256 * D * 2 : Xb + (size_t)u.pn * 256 * D * 2; }
};
template <int GV> struct EpiIn {
    bf16_t* Hp; bf16_t* GVt; float* ssq_q; float* ssq_kv;
    __device__ __forceinline__ void operator()(ge::Acc& acc, const ge::Unit& u, int wr, int wc, int fr, int fq) const {
        if (GV == 0 || (GV == 2 && u.g == 0)) {
            const int row0 = u.pm * 256 + wr * 64 + fr, col0 = u.pn * 256 + wc * 32 + 8 * fq;
            const bool sg = u.pn >= 12;
#pragma unroll
            for (int ai = 0; ai < 2; ++ai)
#pragma unroll
                for (int m = 0; m < 4; ++m) { const int row = row0 + ai * 128 + m * 16; bf16_t* rp = Hp + (size_t)row * HW + col0;
                    float sq0 = 0.f, sq1 = 0.f;
#pragma unroll
                    for (int bj = 0; bj < 2; ++bj) { f32x4 v0 = acc[ai][bj][m][0], v1 = acc[ai][bj][m][1];
                        if (sg) {
#pragma unroll
                            for (int j = 0; j < 4; ++j) { v0[j] = 1.f / (1.f + __expf(-v0[j])); v1[j] = 1.f / (1.f + __expf(-v1[j])); } }
                        const float s = v0[0] * v0[0] + v0[1] * v0[1] + v0[2] * v0[2] + v0[3] * v0[3] + v1[0] * v1[0] + v1[1] * v1[1] + v1[2] * v1[2] + v1[3] * v1[3];
                        if (bj == 0) sq0 = s; else sq1 = s;
                        u32x4 o = {cvt_pk_bf16(v0[0], v0[1]), cvt_pk_bf16(v0[2], v0[3]), cvt_pk_bf16(v1[0], v1[1]), cvt_pk_bf16(v1[2], v1[3])};
                        *(u32x4*)(rp + bj * 128) = o; }
                    if (u.pn == 10 || u.pn == 11) {
                        float s = (u.pn == 10) ? (sq0 + sq1) : sq0;
                        { const int ln = fq * 16 + fr; s += shx(s, 16, ln); s += shx(s, 32, ln); }
                        if (fq == 0) { float* dst = (u.pn == 10 ? ssq_q : ssq_kv); dst[(size_t)wc * T + row] = s; } } }
        } else {
#pragma unroll
            for (int ai = 0; ai < 2; ++ai)
#pragma unroll
                for (int m = 0; m < 4; ++m) { const int r = u.pm * 256 + ai * 128 + wr * 64 + m * 16 + fr, h = r >> 7, e = r & 127;
#pragma unroll
                    for (int bj = 0; bj < 2; ++bj) { const int t0 = u.pn * 256 + bj * 128 + wc * 32 + 8 * fq;
                        const int chunk = t0 >> 6, p0 = (t0 & 48) + ((t0 & 8) >> 1);
                        bf16_t* base = GVt + ((size_t)(chunk * 4 + h) * 128 + e) * 64;
                        const f32x4 v0 = acc[ai][bj][m][0], v1 = acc[ai][bj][m][1];
                        u32x2 o0 = {cvt_pk_bf16(v0[0], v0[1]), cvt_pk_bf16(v0[2], v0[3])}, o1 = {cvt_pk_bf16(v1[0], v1[1]), cvt_pk_bf16(v1[2], v1[3])};
                        *(u32x2*)(base + p0) = o0; *(u32x2*)(base + p0 + 8) = o1; } }
        }
    }
};
constexpr float QSCALE = 0.07216878364870322f * 1.4426950408889634f;
struct MapQ { __device__ __forceinline__ int operator()(int s) const {
    if (s < 512) return (s >> 7) * 192 + (s & 127);
    const int s2 = s - 512, bj = s2 >> 7, w = s2 & 127; return (w >> 5) * 192 + 128 + bj * 32 + (w & 31); } };
struct MapKV { int voff; __device__ __forceinline__ int operator()(int s) const { return (s >> 7) * 256 + voff + (s & 127); } };

struct MlaP {
    const float* w_uq; const float* w_ukv; const float* qn_g; const float* kvn_g;
    bf16_t* Wb_uq; bf16_t* Wb_uk; bf16_t* Wb_uv;
    const bf16_t* Hp; const float* ssq_q; const float* ssq_kv; const float* cs; const float* sn;
    bf16_t* Qb; bf16_t* KnImg; bf16_t* VtImg; bf16_t* KrImg; float* Opart; float* MLpart; float* Yc;
};
__device__ __forceinline__ float rstd4(const float* ssq, int row, float invw) {
    const float s = (ssq[row] + ssq[T + row]) + (ssq[2 * T + row] + ssq[3 * T + row]); return rsqrtf(s * invw + 1e-6f); }

template <int mode> struct SchedMla : ge::NoCarry { const char* A; const char* B; int c, G;
    __device__ __forceinline__ bool next(int i, ge::Unit& u) const {
        if (c < 0) return false;
        const int L = i * G + c; u.g = mode;
        if (mode == 0) { if (L >= 192) return false; u.pm = L / 3; u.pn = L % 3; }
        else if (mode == 1) { if (L >= 128) return false; u.pm = L >> 1; u.pn = L & 1; }
        else { if (L >= 128) return false; u.pm = L & 1; u.pn = L >> 1; }
        return true; }
    __device__ __forceinline__ const char* aptr(const ge::Unit& u) const { return mode == 2 ? A + (size_t)u.pm * 256 * 256 * 2 : A + (size_t)u.pm * 256 * HW * 2; }
    __device__ __forceinline__ const char* bptr(const ge::Unit& u) const { return mode == 2 ? B + (size_t)u.pn * 256 * HW * 2 : B + (size_t)u.pn * 256 * 256 * 2; }
};
template <int MODE> struct EpiMla { MlaP p;
    __device__ __forceinline__ void operator()(ge::Acc& acc, const ge::Unit& u, int wr, int wc, int fr, int fq) const {
        if constexpr (MODE == 0) {
#pragma unroll
            for (int ai = 0; ai < 2; ++ai)
#pragma unroll
                for (int m = 0; m < 4; ++m) { asm volatile("" ::: "memory"); const int t = u.pm * 256 + ai * 128 + wr * 64 + m * 16 + fr; const float rs = rstd4(p.ssq_q, t, 1.f / 256.f) * QSCALE;
                    if (u.pn < 2) {
#pragma unroll
                        for (int bj = 0; bj < 2; ++bj) { const int c0 = u.pn * 256 + bj * 128 + wc * 32 + 8 * fq, head = c0 >> 7, dim = c0 & 127;
                            const f32x4 v0 = acc[ai][bj][m][0] * rs, v1 = acc[ai][bj][m][1] * rs;
                            u32x4 o = {cvt_pk_bf16(v0[0], v0[1]), cvt_pk_bf16(v0[2], v0[3]), cvt_pk_bf16(v1[0], v1[1]), cvt_pk_bf16(v1[2], v1[3])};
                            *(u32x4*)(p.Qb + (size_t)t * 768 + head * 192 + dim) = o; }
                    } else { const int head = wc, i0 = 8 * fq;
                        float o1[8], o2[8];
#pragma unroll
                        for (int n = 0; n < 2; ++n) { const f32x4 c4 = *(const f32x4*)(p.cs + (size_t)t * 32 + i0 + 4 * n), s4 = *(const f32x4*)(p.sn + (size_t)t * 32 + i0 + 4 * n);
#pragma unroll
                            for (int j = 0; j < 4; ++j) { const float x1 = acc[ai][0][m][n][j] * rs, x2 = acc[ai][1][m][n][j] * rs; o1[4 * n + j] = x1 * c4[j] - x2 * s4[j]; o2[4 * n + j] = x1 * s4[j] + x2 * c4[j]; } }
                        u32x4 a = {cvt_pk_bf16(o1[0], o1[1]), cvt_pk_bf16(o1[2], o1[3]), cvt_pk_bf16(o1[4], o1[5]), cvt_pk_bf16(o1[6], o1[7])};
                        u32x4 b = {cvt_pk_bf16(o2[0], o2[1]), cvt_pk_bf16(o2[2], o2[3]), cvt_pk_bf16(o2[4], o2[5]), cvt_pk_bf16(o2[6], o2[7])};
                        *(u32x4*)(p.Qb + (size_t)t * 768 + head * 192 + 128 + i0) = a; *(u32x4*)(p.Qb + (size_t)t * 768 + head * 192 + 160 + i0) = b; } }
        } else if constexpr (MODE == 1) {
#pragma unroll
            for (int ai = 0; ai < 2; ++ai)
#pragma unroll
                for (int m = 0; m < 4; ++m) { asm volatile("" ::: "memory"); const int t = u.pm * 256 + ai * 128 + wr * 64 + m * 16 + fr; const float rs = rstd4(p.ssq_kv, t, 1.f / 128.f);
                    const int tile = t >> 6, key = t & 63;
#pragma unroll
                    for (int bj = 0; bj < 2; ++bj) { const int c0 = u.pn * 256 + bj * 128 + wc * 32 + 8 * fq, head = c0 >> 7, chunk = (c0 & 127) >> 3;
                        const f32x4 v0 = acc[ai][bj][m][0] * rs, v1 = acc[ai][bj][m][1] * rs;
                        u32x4 o = {cvt_pk_bf16(v0[0], v0[1]), cvt_pk_bf16(v0[2], v0[3]), cvt_pk_bf16(v1[0], v1[1]), cvt_pk_bf16(v1[2], v1[3])};
                        *(u32x4*)((char*)p.KnImg + ((size_t)(head * 256 + tile) * 16384) + key * 256 + ((chunk ^ (key & 15)) << 4)) = o; } }
        } else {
#pragma unroll
            for (int bj = 0; bj < 2; ++bj) { const int t0 = u.pn * 256 + bj * 128 + wc * 32 + 8 * fq;
                float rs[8];
#pragma unroll
                for (int j = 0; j < 8; ++j) rs[j] = rstd4(p.ssq_kv, t0 + j, 1.f / 128.f);
                const int tile = t0 >> 6, p0 = (t0 & 48) + ((t0 & 8) >> 1);
#pragma unroll
                for (int ai = 0; ai < 2; ++ai)
#pragma unroll
                    for (int m = 0; m < 4; ++m) { asm volatile("" ::: "memory"); const int r = u.pm * 256 + ai * 128 + wr * 64 + m * 16 + fr, head = r >> 7, d = r & 127;
                        char* base = (char*)p.VtImg + ((size_t)(head * 256 + tile) * 16384) + d * 128;
                        const f32x4 v0 = acc[ai][bj][m][0], v1 = acc[ai][bj][m][1];
                        u32x2 o0 = {cvt_pk_bf16(v0[0] * rs[0], v0[1] * rs[1]), cvt_pk_bf16(v0[2] * rs[2], v0[3] * rs[3])};
                        u32x2 o1 = {cvt_pk_bf16(v1[0] * rs[4], v1[1] * rs[5]), cvt_pk_bf16(v1[2] * rs[6], v1[3] * rs[7])};
                        const int sw = (d >> 1) & 7, pa = p0, pb = p0 + 8;
                        *(u32x2*)(base + (((pa >> 3) ^ sw) << 4) + (pa & 7) * 2) = o0;
                        *(u32x2*)(base + (((pb >> 3) ^ sw) << 4) + (pb & 7) * 2) = o1; } }
        }
    }
};
__device__ __forceinline__ void kr_phase(const MlaP& p, int gtid, int gthreads) {
    for (int idx = gtid; idx < T * 4; idx += gthreads) { const int t = idx >> 2, c = idx & 3, i0 = 8 * c;
        const u32x4 a = *(const u32x4*)(p.Hp + (size_t)t * HW + H_KR + i0), b = *(const u32x4*)(p.Hp + (size_t)t * HW + H_KR + 32 + i0);
        float o1[8], o2[8];
#pragma unroll
        for (int n = 0; n < 2; ++n) { const f32x4 c4 = *(const f32x4*)(p.cs + (size_t)t * 32 + i0 + 4 * n), s4 = *(const f32x4*)(p.sn + (size_t)t * 32 + i0 + 4 * n);
#pragma unroll
            for (int j = 0; j < 4; ++j) { const int e = 4 * n + j; const unsigned wa = a[e >> 1], wb = b[e >> 1];
                const float x1 = (e & 1) ? bfhi(wa) : bflo(wa), x2 = (e & 1) ? bfhi(wb) : bflo(wb);
                o1[e] = x1 * c4[j] - x2 * s4[j]; o2[e] = x1 * s4[j] + x2 * c4[j]; } }
        u32x4 oa = {cvt_pk_bf16(o1[0], o1[1]), cvt_pk_bf16(o1[2], o1[3]), cvt_pk_bf16(o1[4], o1[5]), cvt_pk_bf16(o1[6], o1[7])};
        u32x4 ob = {cvt_pk_bf16(o2[0], o2[1]), cvt_pk_bf16(o2[2], o2[3]), cvt_pk_bf16(o2[4], o2[5]), cvt_pk_bf16(o2[6], o2[7])};
        const int tile = t >> 6, key = t & 63, sw = (key >> 1) & 7;
        char* base = (char*)p.KrImg + (size_t)tile * 8192 + key * 128;
        *(u32x4*)(base + ((c ^ sw) << 4)) = oa; *(u32x4*)(base + (((c + 4) ^ sw) << 4)) = ob; }
}
constexpr int ATT_STEPS = 130;
__device__ __forceinline__ void attn_item(LAS unsigned char* lds, const MlaP& p, int head, int b, int j0, int j1, int slot) {
    const int tid = tid_now(), wid = __builtin_amdgcn_readfirstlane(tid >> 6), lane = tid & 63, q = lane & 31, hh = lane >> 5;
    const int trow = b * 256 + wid * 32 + q;
    bf16x8 qf[12];
    { const bf16_t* qp = p.Qb + (size_t)trow * 768 + head * 192 + 8 * hh;
#pragma unroll
      for (int s = 0; s < 12; ++s) qf[s] = *(const bf16x8*)(qp + 16 * s); }
    f32x16 O[4];
#pragma unroll
    for (int d = 0; d < 4; ++d)
#pragma unroll
        for (int r = 0; r < 16; ++r) O[d][r] = 0.f;
    float m_run = -1e30f, l_run = 0.f;
    const char* knb = (const char*)p.KnImg + (size_t)head * 256 * 16384; const char* vtb = (const char*)p.VtImg + (size_t)head * 256 * 16384; const char* krb = (const char*)p.KrImg;
    const unsigned lo = (unsigned)lane * 16u;
#define AT_ISSUE(j, bi) do { const unsigned _bo = (unsigned)(bi) * 40960u; \
        __builtin_amdgcn_global_load_lds((const unsigned*)(knb + (size_t)(j) * 16384 + (wid * 2) * 1024 + lo), (LAS unsigned*)(lds + _bo + (wid * 2) * 1024), 16, 0, 0); \
        __builtin_amdgcn_global_load_lds((const unsigned*)(knb + (size_t)(j) * 16384 + (wid * 2 + 1) * 1024 + lo), (LAS unsigned*)(lds + _bo + (wid * 2 + 1) * 1024), 16, 0, 0); \
        __builtin_amdgcn_global_load_lds((const unsigned*)(krb + (size_t)(j) * 8192 + wid * 1024 + lo), (LAS unsigned*)(lds + _bo + 16384 + wid * 1024), 16, 0, 0); \
        __builtin_amdgcn_global_load_lds((const unsigned*)(vtb + (size_t)(j) * 16384 + (wid * 2) * 1024 + lo), (LAS unsigned*)(lds + _bo + 24576 + (wid * 2) * 1024), 16, 0, 0); \
        __builtin_amdgcn_global_load_lds((const unsigned*)(vtb + (size_t)(j) * 16384 + (wid * 2 + 1) * 1024 + lo), (LAS unsigned*)(lds + _bo + 24576 + (wid * 2 + 1) * 1024), 16, 0, 0); } while (0)
    const int kn_off0 = q * 256, kn_sw = q & 15, kr_off0 = q * 128, kr_sw = (q >> 1) & 7;
    const int vt_sw = (q >> 1) & 7;
    constexpr float THR = 8.f;
    AT_ISSUE(j0, 0);
    if (j0 + 1 < j1) AT_ISSUE(j0 + 1, 1);
    bool first = true;
    for (int j = j0; j < j1; ++j) {
        const int cur = (j - j0) % 3;
        if (j + 1 < j1) asm volatile("s_waitcnt vmcnt(5)" ::: "memory"); else asm volatile("s_waitcnt vmcnt(0)" ::: "memory");
        __builtin_amdgcn_s_barrier(); asm volatile("" ::: "memory");
        if (j + 2 < j1) AT_ISSUE(j + 2, (j + 2 - j0) % 3);
        const int jj = j - 4 * b;
        if (!(jj >= 0 && 64 * jj > 32 * wid + 31)) {
            LAS unsigned char* bb = lds + cur * 40960;
            const float mref = first ? 0.f : m_run;
            f32x16 S0, S1;
#pragma unroll
            for (int r = 0; r < 16; ++r) { S0[r] = -mref; S1[r] = -mref; }
#pragma unroll
            for (int s = 0; s < 8; ++s) {
                const bf16x8 k0 = *(const LAS bf16x8*)(bb + kn_off0 + (((2 * s + hh) ^ kn_sw) << 4));
                const bf16x8 k1 = *(const LAS bf16x8*)(bb + 8192 + kn_off0 + (((2 * s + hh) ^ kn_sw) << 4));
                S0 = __builtin_amdgcn_mfma_f32_32x32x16_bf16(k0, qf[s], S0, 0, 0, 0);
                S1 = __builtin_amdgcn_mfma_f32_32x32x16_bf16(k1, qf[s], S1, 0, 0, 0); }
#pragma unroll
            for (int s = 0; s < 4; ++s) {
                const bf16x8 k0 = *(const LAS bf16x8*)(bb + 16384 + kr_off0 + (((2 * s + hh) ^ kr_sw) << 4));
                const bf16x8 k1 = *(const LAS bf16x8*)(bb + 16384 + 4096 + kr_off0 + (((2 * s + hh) ^ kr_sw) << 4));
                S0 = __builtin_amdgcn_mfma_f32_32x32x16_bf16(k0, qf[8 + s], S0, 0, 0, 0);
                S1 = __builtin_amdgcn_mfma_f32_32x32x16_bf16(k1, qf[8 + s], S1, 0, 0, 0); }
            if (jj >= 0) {
                const int dq = wid * 32 + q - 64 * jj - 4 * hh;
                const float NEG = -__builtin_inff();
#pragma unroll
                for (int r = 0; r < 16; ++r) { const int c = (r & 3) + 8 * (r >> 2);
                    if (c > dq) S0[r] = NEG;
                    if (c + 32 > dq) S1[r] = NEG; } }
            float mx = S0[0];
#pragma unroll
            for (int r = 1; r < 16; ++r) mx = fmaxf(mx, S0[r]);
#pragma unroll
            for (int r = 0; r < 16; ++r) mx = fmaxf(mx, S1[r]);
            { auto rr = __builtin_amdgcn_permlane32_swap(__float_as_uint(mx), __float_as_uint(mx), false, false); mx = fmaxf(__uint_as_float(rr[0]), __uint_as_float(rr[1])); }
            float alpha = 1.f;
            if (first || !__all(mx <= THR)) {
                const float mn = fmaxf(m_run, mref + mx), sh = mn - mref;
                alpha = __builtin_amdgcn_exp2f(m_run - mn); m_run = mn;
#pragma unroll
                for (int r = 0; r < 16; ++r) { S0[r] -= sh; S1[r] -= sh; }
#pragma unroll
                for (int d = 0; d < 4; ++d)
#pragma unroll
                    for (int r = 0; r < 16; ++r) O[d][r] *= alpha;
                first = false;
            }
            float sum = 0.f;
#pragma unroll
            for (int r = 0; r < 16; ++r) { S0[r] = __builtin_amdgcn_exp2f(S0[r]); S1[r] = __builtin_amdgcn_exp2f(S1[r]); sum += S0[r] + S1[r]; }
            l_run = l_run * alpha + sum;
            bf16x8 pf[4];
#pragma unroll
            for (int h2 = 0; h2 < 2; ++h2) {
                u32x4 a = {cvt_pk_bf16(S0[8 * h2 + 0], S0[8 * h2 + 1]), cvt_pk_bf16(S0[8 * h2 + 2], S0[8 * h2 + 3]), cvt_pk_bf16(S0[8 * h2 + 4], S0[8 * h2 + 5]), cvt_pk_bf16(S0[8 * h2 + 6], S0[8 * h2 + 7])};
                u32x4 c = {cvt_pk_bf16(S1[8 * h2 + 0], S1[8 * h2 + 1]), cvt_pk_bf16(S1[8 * h2 + 2], S1[8 * h2 + 3]), cvt_pk_bf16(S1[8 * h2 + 4], S1[8 * h2 + 5]), cvt_pk_bf16(S1[8 * h2 + 6], S1[8 * h2 + 7])};
                pf[h2] = *(bf16x8*)&a; pf[2 + h2] = *(bf16x8*)&c; }
#pragma unroll
            for (int d = 0; d < 4; ++d) {
#pragma unroll
                for (int s2 = 0; s2 < 4; ++s2) {
                    const bf16x8 vf = *(const LAS bf16x8*)(bb + 24576 + (d * 32 + q) * 128 + (((2 * s2 + hh) ^ vt_sw) << 4));
                    O[d] = __builtin_amdgcn_mfma_f32_32x32x16_bf16(vf, pf[s2], O[d], 0, 0, 0); } }
        }
    }
    asm volatile("" ::: "memory"); __builtin_amdgcn_s_barrier(); asm volatile("" ::: "memory");
#undef AT_ISSUE
    { auto rr = __builtin_amdgcn_permlane32_swap(__float_as_uint(l_run), __float_as_uint(l_run), false, false); l_run = __uint_as_float(rr[0]) + __uint_as_float(rr[1]); }
    float* op = p.Opart + ((size_t)slot * 256 + wid * 32 + q) * 128 + 4 * hh;
#pragma unroll
    for (int d = 0; d < 4; ++d)
#pragma unroll
        for (int g = 0; g < 4; ++g) { f32x4 v = {O[d][4 * g], O[d][4 * g + 1], O[d][4 * g + 2], O[d][4 * g + 3]}; *(f32x4*)(op + d * 32 + g * 8) = v; }
    if (hh == 0) { float* ml = p.MLpart + ((size_t)slot * 256 + wid * 32 + q) * 2; ml[0] = m_run; ml[1] = l_run; }
}
__device__ __forceinline__ void attn_phase(LAS unsigned char* lds, const MlaP& p, int c) {
    int L = ATT_STEPS * c; const int Lend = L + ATT_STEPS;
    while (L < Lend) {
        const int head = L / 8320, rem = L - head * 8320;
        int b = (int)((sqrtf(1.f + 2.f * (float)rem) - 1.f) * 0.5f);
        while (2 * b * (b + 1) > rem) --b;
        while (2 * (b + 1) * (b + 2) <= rem) ++b;
        const int j0 = rem - 2 * b * (b + 1), nt = 4 * (b + 1);
        const int j1 = min(nt, j0 + (Lend - L));
        attn_item(lds, p, head, b, j0, j1, head * 64 + b + c);
        L += j1 - j0;
    }
}
struct GlaP {
    const bf16_t* Hp; const bf16_t* GVt; const float* wg; const float* bg; const float* ng; const float* wconv;
    bf16_t* QE; float* OI; float* kvT; float* decay; bf16_t* spT; bf16_t* Yab; bf16_t* Ybb; bf16_t* Ycb;
    const float* Opart; const float* MLpart;
};
__device__ __forceinline__ int pos16(int i) { return (i & 48) | ((i & 4) << 1) | ((i & 8) >> 1) | (i & 3); }
__device__ __forceinline__ void gla_g1(LAS unsigned char* lds, const GlaP& p, int c, int G) {
    const int tid = tid_now(), wid = __builtin_amdgcn_readfirstlane(tid >> 6), lane = tid & 63, l31 = lane & 31, hh = lane >> 5;
    LAS float* bsm = (LAS float*)lds; LAS float* gtot = (LAS float*)(lds + 17408); LAS float* blast = (LAS float*)(lds + 19456);
    LAS unsigned char* qeL = lds + 20480; LAS unsigned char* keL = lds + 28672; LAS unsigned char* ktL = lds + 36864;
    const int eb = wid & 3, hb = wid >> 2;
    for (int u = c; u < 1024; u += G) {
        const int n = u >> 2, h = u & 3;
        bf16x8 vf[4];
        { const bf16_t* vp = p.GVt + ((size_t)u * 128 + eb * 32 + l31) * 64 + 8 * hh;
#pragma unroll
          for (int s4 = 0; s4 < 4; ++s4) vf[s4] = *(const bf16x8*)(vp + 16 * s4); }
        { const int d = tid & 63, g = tid >> 6;
          float w[16];
#pragma unroll
          for (int r = 0; r < 16; ++r) w[r] = p.wg[r * 256 + h * 64 + d];
          const float bias = p.bg[h * 64 + d];
          float cs[8]; float run = 0.f;
#pragma unroll
          for (int k = 0; k < 8; ++k) { const int i = 8 * g + k;
              const u32x4 g0 = *(const u32x4*)(p.Hp + (size_t)(64 * n + i) * HW + H_GLR), g1 = *(const u32x4*)(p.Hp + (size_t)(64 * n + i) * HW + H_GLR + 8);
              float la = bias;
#pragma unroll
              for (int r = 0; r < 4; ++r) { la += bflo(g0[r]) * w[2 * r] + bfhi(g0[r]) * w[2 * r + 1]; la += bflo(g1[r]) * w[8 + 2 * r] + bfhi(g1[r]) * w[8 + 2 * r + 1]; }
              const float ls = (fminf(la, 0.f) - log1pf(expf(-fabsf(la)))) * (1.f / 16.f);
              run += ls; cs[k] = run; }
          gtot[g * 64 + d] = run;
          __syncthreads();
          float pre = 0.f, tot = 0.f;
#pragma unroll
          for (int gg = 0; gg < 8; ++gg) { const float v = gtot[gg * 64 + d]; tot += v; if (gg < g) pre += v; }
#pragma unroll
          for (int k = 0; k < 8; ++k) bsm[(8 * g + k) * 68 + d] = pre + cs[k];
          if (g == 0) { blast[d] = tot; p.decay[(size_t)u * 64 + d] = expf(tot); } }
        __syncthreads();
        { const int i = tid >> 3, cc = tid & 7, d0 = 8 * cc; const size_t t = (size_t)64 * n + i;
          const u32x4 qv = *(const u32x4*)(p.Hp + t * HW + H_GQ + h * 64 + d0), kv = *(const u32x4*)(p.Hp + t * HW + H_GK + h * 64 + d0);
          float b[8], bl[8];
          { const f32x4 b0 = *(const LAS f32x4*)(bsm + i * 68 + d0), b1 = *(const LAS f32x4*)(bsm + i * 68 + d0 + 4), l0 = *(const LAS f32x4*)(blast + d0), l1 = *(const LAS f32x4*)(blast + d0 + 4);
#pragma unroll
            for (int j = 0; j < 4; ++j) { b[j] = b0[j]; b[4 + j] = b1[j]; bl[j] = l0[j]; bl[4 + j] = l1[j]; } }
          float qe[8], ke[8], kt[8];
#pragma unroll
          for (int j = 0; j < 8; ++j) { const float qq = (j & 1) ? bfhi(qv[j >> 1]) : bflo(qv[j >> 1]), kk = (j & 1) ? bfhi(kv[j >> 1]) : bflo(kv[j >> 1]);
              qe[j] = qq * 0.125f * expf(b[j]); ke[j] = kk * expf(-b[j]); kt[j] = kk * expf(bl[j] - b[j]); }
          const u32x4 qo = {cvt_pk_bf16(qe[0], qe[1]), cvt_pk_bf16(qe[2], qe[3]), cvt_pk_bf16(qe[4], qe[5]), cvt_pk_bf16(qe[6], qe[7])};
          const u32x4 ko = {cvt_pk_bf16(ke[0], ke[1]), cvt_pk_bf16(ke[2], ke[3]), cvt_pk_bf16(ke[4], ke[5]), cvt_pk_bf16(ke[6], ke[7])};
          const int sw = (i >> 1) & 7;
          *(LAS u32x4*)(qeL + i * 128 + ((cc ^ sw) << 4)) = qo; *(LAS u32x4*)(keL + i * 128 + ((cc ^ sw) << 4)) = ko;
          *(u32x4*)(p.QE + t * 256 + h * 64 + d0) = qo;
          const int pi = pos16(i);
#pragma unroll
          for (int j = 0; j < 8; ++j) { const int d = d0 + j; const unsigned pk = cvt_pk_bf16(kt[j], 0.f);
              *(LAS unsigned short*)(ktL + d * 128 + (((pi >> 3) ^ ((d >> 1) & 7)) << 4) + (pi & 7) * 2) = (unsigned short)pk; } }
        __syncthreads();
        { f32x16 OT, KV;
#pragma unroll
          for (int r = 0; r < 16; ++r) { OT[r] = 0.f; KV[r] = 0.f; }
          const int sw = (l31 >> 1) & 7;
#pragma unroll
          for (int jb = 0; jb < 2; ++jb) {
              if (jb <= hb) {
                  f32x16 Sc;
#pragma unroll
                  for (int r = 0; r < 16; ++r) Sc[r] = 0.f;
#pragma unroll
                  for (int s = 0; s < 4; ++s) {
                      const bf16x8 ka = *(const LAS bf16x8*)(keL + (32 * jb + l31) * 128 + (((2 * s + hh) ^ sw) << 4));
                      const bf16x8 qb = *(const LAS bf16x8*)(qeL + (32 * hb + l31) * 128 + (((2 * s + hh) ^ sw) << 4));
                      Sc = __builtin_amdgcn_mfma_f32_32x32x16_bf16(ka, qb, Sc, 0, 0, 0); }
                  if (jb == hb) {
#pragma unroll
                      for (int r = 0; r < 16; ++r) { const int j = (r & 3) + 8 * (r >> 2) + 4 * hh; if (j > l31) Sc[r] = 0.f; } }
#pragma unroll
                  for (int h2 = 0; h2 < 2; ++h2) {
                      u32x4 a = {cvt_pk_bf16(Sc[8 * h2 + 0], Sc[8 * h2 + 1]), cvt_pk_bf16(Sc[8 * h2 + 2], Sc[8 * h2 + 3]), cvt_pk_bf16(Sc[8 * h2 + 4], Sc[8 * h2 + 5]), cvt_pk_bf16(Sc[8 * h2 + 6], Sc[8 * h2 + 7])};
                      OT = __builtin_amdgcn_mfma_f32_32x32x16_bf16(vf[2 * jb + h2], *(bf16x8*)&a, OT, 0, 0, 0); } } }
#pragma unroll
          for (int s4 = 0; s4 < 4; ++s4) {
              const bf16x8 kb = *(const LAS bf16x8*)(ktL + (32 * hb + l31) * 128 + (((2 * s4 + hh) ^ sw) << 4));
              KV = __builtin_amdgcn_mfma_f32_32x32x16_bf16(vf[s4], kb, KV, 0, 0, 0); }
          float* oi = p.OI + ((size_t)u * 8 + wid) * 1024 + lane;
#pragma unroll
          for (int r = 0; r < 16; ++r) oi[r * 64] = OT[r];
          float* kp = p.kvT + (size_t)u * 8192 + 32 * hb + l31;
#pragma unroll
          for (int r = 0; r < 16; ++r) { const int e = 32 * eb + (r & 3) + 8 * (r >> 2) + 4 * hh; kp[e * 64] = KV[r]; } }
        __syncthreads();
    }
}
__device__ __forceinline__ void gla_g2(LAS unsigned char* lds, const GlaP& p, int c) {
    const int tid = tid_now(), el = tid & 127, seg = tid >> 7;
    const int idx = c * 128 + el, h = idx >> 13, ed = idx & 8191, d = idx & 63;
    LAS float* segS = (LAS float*)lds; LAS float* segD = (LAS float*)(lds + 2048);
    float st = 0.f, dp = 1.f;
    for (int n0 = seg * 64; n0 < seg * 64 + 64; n0 += 16) {
        float kv[16], dc[16];
#pragma unroll
        for (int k = 0; k < 16; ++k) { const size_t u = (size_t)(n0 + k) * 4 + h; kv[k] = p.kvT[u * 8192 + ed]; dc[k] = p.decay[u * 64 + d]; }
#pragma unroll
        for (int k = 0; k < 16; ++k) { st = fmaf(dc[k], st, kv[k]); dp *= dc[k]; }
    }
    __syncthreads();
    segS[seg * 128 + el] = st; segD[seg * 128 + el] = dp;
    __syncthreads();
    st = 0.f;
    for (int s2 = 0; s2 < seg; ++s2) st = fmaf(segD[s2 * 128 + el], st, segS[s2 * 128 + el]);
    for (int n0 = seg * 64; n0 < seg * 64 + 64; n0 += 16) {
        float kv[16], dc[16];
#pragma unroll
        for (int k = 0; k < 16; ++k) { const size_t u = (size_t)(n0 + k) * 4 + h; kv[k] = p.kvT[u * 8192 + ed]; dc[k] = p.decay[u * 64 + d]; }
#pragma unroll
        for (int k = 0; k < 16; ++k) { const size_t u = (size_t)(n0 + k) * 4 + h; p.spT[u * 8192 + ed] = (bf16_t)(cvt_pk_bf16(st, 0.f) & 0xffffu); st = fmaf(dc[k], st, kv[k]); }
    }
    __syncthreads();
}
__device__ __forceinline__ void gla_g3(LAS unsigned char* lds, const GlaP& p, int c, int G) {
    const int tid = tid_now(), wid = __builtin_amdgcn_readfirstlane(tid >> 6), lane = tid & 63, l31 = lane & 31, hh = lane >> 5;
    LAS float* red = (LAS float*)lds;
    const int eb = wid & 3, ib = wid >> 2;
    for (int u = c; u < 1024; u += G) {
        const int n = u >> 2, h = u & 3;
        f32x16 O;
        { const float* oi = p.OI + ((size_t)u * 8 + wid) * 1024 + lane;
#pragma unroll
          for (int r = 0; r < 16; ++r) O[r] = oi[r * 64]; }
        const size_t t = (size_t)64 * n + 32 * ib + l31;
        { const bf16_t* sp = p.spT + ((size_t)u * 128 + 32 * eb + l31) * 64 + 8 * hh; const bf16_t* qp = p.QE + t * 256 + h * 64 + 8 * hh;
#pragma unroll
          for (int s = 0; s < 4; ++s) { const bf16x8 a = *(const bf16x8*)(sp + 16 * s), b = *(const bf16x8*)(qp + 16 * s); O = __builtin_amdgcn_mfma_f32_32x32x16_bf16(a, b, O, 0, 0, 0); } }
        float ss = 0.f;
#pragma unroll
        for (int r = 0; r < 16; ++r) ss += O[r] * O[r];
        { auto rr = __builtin_amdgcn_permlane32_swap(__float_as_uint(ss), __float_as_uint(ss), false, false); ss = __uint_as_float(rr[0]) + __uint_as_float(rr[1]); }
        __syncthreads();
        if (hh == 0) red[eb * 64 + 32 * ib + l31] = ss;
        __syncthreads();
        const int ti = 32 * ib + l31;
        const float tot = (red[ti] + red[64 + ti]) + (red[128 + ti] + red[192 + ti]);
        const float rs = rsqrtf(tot * (1.f / 128.f) + 1e-6f);
#pragma unroll
        for (int g = 0; g < 4; ++g) { const int e0 = 32 * eb + 8 * g + 4 * hh;
            const u32x2 rv = *(const u32x2*)(p.Hp + t * HW + H_GR + h * 128 + e0); const f32x4 gn = *(const f32x4*)(p.ng + e0);
            float y[4];
#pragma unroll
            for (int j = 0; j < 4; ++j) { const float r_ = (j & 1) ? bfhi(rv[j >> 1]) : bflo(rv[j >> 1]); y[j] = O[4 * g + j] * rs * gn[j] * (r_ / (1.f + __expf(-r_))); }
            u32x2 o = {cvt_pk_bf16(y[0], y[1]), cvt_pk_bf16(y[2], y[3])};
            *(u32x2*)(p.Ybb + t * 512 + h * 128 + e0) = o; }
    }
}
__device__ __forceinline__ void conv_phase(const GlaP& p, int gtid, int gthreads) {
    for (int idx = gtid; idx < T * 64; idx += gthreads) { const int t = idx >> 6, c0 = (idx & 63) * 8;
        float y[8];
#pragma unroll
        for (int j = 0; j < 8; ++j) y[j] = 0.f;
#pragma unroll
        for (int k = 0; k < 3; ++k) { const int tt = t - 2 + k; if (tt >= 0) {
            const u32x4 a = *(const u32x4*)(p.Hp + (size_t)tt * HW + H_AC + c0), x = *(const u32x4*)(p.Hp + (size_t)tt * HW + H_AX + c0);
            const f32x4 w0 = *(const f32x4*)(p.wconv + k * 512 + c0), w1 = *(const f32x4*)(p.wconv + k * 512 + c0 + 4);
#pragma unroll
            for (int j = 0; j < 4; ++j) { y[2 * j] += (j < 2 ? w0[2 * j] : w1[2 * j - 4]) * (bflo(a[j]) * bflo(x[j])); y[2 * j + 1] += (j < 2 ? w0[2 * j + 1] : w1[2 * j - 3]) * (bfhi(a[j]) * bfhi(x[j])); } } }
        const u32x4 b = *(const u32x4*)(p.Hp + (size_t)t * HW + H_AB + c0);
        u32x4 o;
#pragma unroll
        for (int j = 0; j < 4; ++j) o[j] = cvt_pk_bf16(bflo(b[j]) * y[2 * j], bfhi(b[j]) * y[2 * j + 1]);
        *(u32x4*)(p.Yab + (size_t)t * 512 + c0) = o; }
}
__device__ __forceinline__ void attn_combine_bf16(const GlaP& p, int gtid, int gthreads) {
    for (int idx = gtid; idx < 256 * 256 * 32; idx += gthreads) {
        const int dq = idx & 31, row = (idx >> 5) & 255, g = idx >> 13, head = g >> 6, b = g & 63;
        const int Ls = head * 8320 + 2 * b * (b + 1), Le = Ls + 4 * (b + 1);
        const int c0 = Ls / ATT_STEPS, c1 = (Le - 1) / ATT_STEPS;
        float M = -1e30f;
        for (int c = c0; c <= c1; ++c) M = fmaxf(M, p.MLpart[((size_t)(g + c) * 256 + row) * 2]);
        f32x4 acc = {0.f, 0.f, 0.f, 0.f}; float l = 0.f;
        for (int c = c0; c <= c1; ++c) { const size_t sl = (size_t)(g + c) * 256 + row; const float w = __builtin_amdgcn_exp2f(p.MLpart[sl * 2] - M);
            l += w * p.MLpart[sl * 2 + 1]; const f32x4 o = *(const f32x4*)(p.Opart + sl * 128 + dq * 4); acc += o * w; }
        const float il = 1.f / l;
        u32x2 o = {cvt_pk_bf16(acc[0] * il, acc[1] * il), cvt_pk_bf16(acc[2] * il, acc[3] * il)};
        *(u32x2*)(p.Ycb + (size_t)(b * 256 + row) * 512 + head * 128 + dq * 4) = o;
    }
}
struct P {
    const float *x, *pin; const int* pos;
    const float *ln0_g, *ln0_b, *w_in, *w_conv, *w_gg, *b_gg, *gla_ng, *qn_g, *kvn_g, *w_uq, *w_ukv, *w_br, *w_o, *ln1_g, *ln1_b, *w_grp, *b_grp, *w_exp, *b_exp,
                *w_gate, *w_up, *w_down, *ln2_g, *ln2_b, *w_pg, *b_pg, *w_pu, *ln3_g, *ln3_b;
    float* out;
    float *X, *Z, *cs, *sn, *ssq_q, *ssq_kv, *OI, *kvT, *decay, *MLpart, *ew;
    bf16_t *Xb, *Hp, *GVt, *Qb, *KnImg, *VtImg, *KrImg, *QE, *spT, *Yab, *Ybb, *Ycb, *Mgb, *Hbuf, *Ys, *Ub, *Pb;
    bf16_t *Wb_in, *Wb_gv, *Wb_uq, *Wb_uk, *Wb_uv, *Wb_br, *Wb_o, *Wb_gu, *Wb_d, *Wb_pg, *Wb_pu;
    int *cnt, *lists; unsigned* bar;
};
__device__ __forceinline__ MegaP mk_mega(const P& p) { MegaP m; m.w_in = p.w_in; m.Wb_in = p.Wb_in; m.Wb_gv = p.Wb_gv; m.Xb = p.Xb; m.Hp = p.Hp; m.GVt = p.GVt; m.ssq_q = p.ssq_q; m.ssq_kv = p.ssq_kv; return m; }
__device__ __forceinline__ MlaP mk_mla(const P& p) { MlaP q; q.w_uq = p.w_uq; q.w_ukv = p.w_ukv; q.qn_g = p.qn_g; q.kvn_g = p.kvn_g; q.Wb_uq = p.Wb_uq; q.Wb_uk = p.Wb_uk; q.Wb_uv = p.Wb_uv; q.Hp = p.Hp;
    q.ssq_q = p.ssq_q; q.ssq_kv = p.ssq_kv; q.cs = p.cs; q.sn = p.sn; q.Qb = p.Qb; q.KnImg = p.KnImg; q.VtImg = p.VtImg; q.KrImg = p.KrImg; q.Opart = p.Z; q.MLpart = p.MLpart; q.Yc = nullptr; return q; }
__device__ __forceinline__ GlaP mk_gla(const P& p, int layer) { GlaP g; g.Hp = p.Hp; g.GVt = p.GVt; g.wg = p.w_gg + layer * 16 * 256; g.bg = p.b_gg + layer * 256; g.ng = p.gla_ng + layer * 128; g.wconv = p.w_conv + layer * 3 * 512;
    g.QE = p.QE; g.OI = p.OI; g.kvT = p.kvT; g.decay = p.decay; g.spT = p.spT; g.Yab = p.Yab; g.Ybb = p.Ybb; g.Ycb = p.Ycb; g.Opart = p.Z; g.MLpart = p.MLpart; return g; }

struct CvJob { const float* W; bf16_t* Bt; const float* rs; int ldw, Ksrc, ldbt, n0, k0, kind, aux; };
struct MapId { __device__ __forceinline__ int operator()(int s) const { return s; } };
__device__ __forceinline__ int cv_map(int kind, int aux, int n) {
    if (kind == 0) return MapInMain{}(n);
    if (kind == 1) return aux + n;
    if (kind == 2) return MapQ{}(n);
    if (kind == 3) return MapKV{aux}(n);
    return n; }
__device__ __forceinline__ int cv_omap(int kind, int aux, int n) { return kind == 4 ? (n >> 7) * 256 + aux * 128 + (n & 127) : n; }
__device__ __forceinline__ bool cv_job(const P& p, int layer, int t, CvJob& j) {
    constexpr int S0 = 384, S1 = S0 + 32, S2 = S1 + 12, S3 = S2 + 8, S4 = S3 + 8, S5 = S4 + 96, S6 = S5 + 64, S7 = S6 + 64, S8 = S7 + 16, S9 = S8 + 1024, S10 = S9 + 1024, S11 = S10 + 1024;
    if (t >= S11) return false;
    j.rs = nullptr; j.aux = 0; j.kind = 5;
    if (t < S0) { j.W = p.w_in + (size_t)layer * D * INW; j.ldw = INW; j.Ksrc = D; j.Bt = p.Wb_in; j.ldbt = D; j.n0 = (t >> 2) * 64; j.k0 = (t & 3) * 256; j.kind = 0; }
    else if (t < S1) { const int u = t - S0; j.W = p.w_in + (size_t)layer * D * INW; j.ldw = INW; j.Ksrc = D; j.Bt = p.Wb_gv; j.ldbt = D; j.n0 = (u >> 2) * 64; j.k0 = (u & 3) * 256; j.kind = 1; j.aux = O_GV; }
    else if (t < S2) { const int u = t - S1; j.W = p.w_uq + (size_t)layer * 256 * 768; j.ldw = 768; j.Ksrc = 256; j.Bt = p.Wb_uq; j.ldbt = 256; j.n0 = u * 64; j.k0 = 0; j.kind = 2; j.rs = p.qn_g + layer * 256; }
    else if (t < S3) { const int u = t - S2; j.W = p.w_ukv + (size_t)layer * 128 * 1024; j.ldw = 1024; j.Ksrc = 128; j.Bt = p.Wb_uk; j.ldbt = 256; j.n0 = u * 64; j.k0 = 0; j.kind = 3; j.aux = 0; j.rs = p.kvn_g + layer * 128; }
    else if (t < S4) { const int u = t - S3; j.W = p.w_ukv + (size_t)layer * 128 * 1024; j.ldw = 1024; j.Ksrc = 128; j.Bt = p.Wb_uv; j.ldbt = 256; j.n0 = u * 64; j.k0 = 0; j.kind = 3; j.aux = 128; j.rs = p.kvn_g + layer * 128; }
    else if (t < S5) { const int u = t - S4, br = u >> 5, v = u & 31; j.W = p.w_br + (size_t)layer * 1536 * D + (size_t)br * 512 * D; j.ldw = D; j.Ksrc = 512; j.Bt = p.Wb_br + (size_t)br * 1024 * 512; j.ldbt = 512; j.n0 = (v >> 1) * 64; j.k0 = (v & 1) * 256; }
    else if (t < S6) { const int u = t - S5; j.W = p.w_o + (size_t)layer * D * D; j.ldw = D; j.Ksrc = D; j.Bt = p.Wb_o; j.ldbt = D; j.n0 = (u >> 2) * 64; j.k0 = (u & 3) * 256; }
    else if (t < S7) { const int u = t - S6; j.W = p.w_pg + (size_t)layer * D * D; j.ldw = D; j.Ksrc = D; j.Bt = p.Wb_pg; j.ldbt = D; j.n0 = (u >> 2) * 64; j.k0 = (u & 3) * 256; }
    else if (t < S8) { const int u = t - S7; j.W = p.w_pu + (size_t)layer * PLE * D; j.ldw = D; j.Ksrc = PLE; j.Bt = p.Wb_pu; j.ldbt = PLE; j.n0 = u * 64; j.k0 = 0; }
    else if (t < S9) { const int u = t - S8, e = u >> 4, v = u & 15; j.W = p.w_gate + ((size_t)layer * NE + e) * D * EH; j.ldw = EH; j.Ksrc = D; j.Bt = p.Wb_gu + (size_t)e * 512 * D; j.ldbt = D; j.n0 = (v >> 2) * 64; j.k0 = (v & 3) * 256; j.kind = 4; j.aux = 0; }
    else if (t < S10) { const int u = t - S9, e = u >> 4, v = u & 15; j.W = p.w_up + ((size_t)layer * NE + e) * D * EH; j.ldw = EH; j.Ksrc = D; j.Bt = p.Wb_gu + (size_t)e * 512 * D; j.ldbt = D; j.n0 = (v >> 2) * 64; j.k0 = (v & 3) * 256; j.kind = 4; j.aux = 1; }
    else { const int u = t - S10, e = u >> 4, v = u & 15; j.W = p.w_down + ((size_t)layer * NE + e) * EH * D; j.ldw = D; j.Ksrc = EH; j.Bt = p.Wb_d + (size_t)e * D * EH; j.ldbt = EH; j.n0 = v * 64; j.k0 = 0; }
    return true; }
__device__ __forceinline__ void cv_load(const CvJob& j, int tid, f32x4 (&v)[8]) {
    const int n4 = tid & 15, kr = tid >> 4; const int col = cv_map(j.kind, j.aux, j.n0 + 4 * n4);
#pragma unroll
    for (int r = 0; r < 8; ++r) { const int k = j.k0 + kr + 32 * r; v[r] = (f32x4){0.f, 0.f, 0.f, 0.f};
        if (col >= 0 && k < j.Ksrc) { v[r] = *(const f32x4*)(j.W + (size_t)k * j.ldw + col); if (j.rs) v[r] = v[r] * j.rs[k]; } }
}
__device__ __forceinline__ void ph_convert(LAS unsigned char* ldsl, const P& p, int layer) {
    LAS float* tile = (LAS float*)ldsl;
    const int tid = tid_now(), c = sgpr_now((int)blockIdx.x), G = gridDim.x;
    CvJob cur, nxt; f32x4 v[8], w[8];
    bool have = cv_job(p, layer, c, cur);
    if (have) cv_load(cur, tid, v);
    for (int t = c; have; t += G) {
        const bool hn = cv_job(p, layer, t + G, nxt);
        if (hn) cv_load(nxt, tid, w);
        __syncthreads();
        { const int n4 = tid & 15, kr = tid >> 4;
#pragma unroll
          for (int r = 0; r < 8; ++r) { LAS float* d = tile + (kr + 32 * r) * 65 + 4 * n4; d[0] = v[r][0]; d[1] = v[r][1]; d[2] = v[r][2]; d[3] = v[r][3]; } }
        __syncthreads();
        { const int kk = (tid & 127) * 2, nn = tid >> 7;
#pragma unroll
          for (int r = 0; r < 16; ++r) { const int n = nn + 4 * r;
              *(unsigned*)(cur.Bt + (size_t)cv_omap(cur.kind, cur.aux, cur.n0 + n) * cur.ldbt + cur.k0 + kk) = cvt_pk_bf16(tile[kk * 65 + n], tile[(kk + 1) * 65 + n]); } }
        have = hn; cur = nxt;
#pragma unroll
        for (int r = 0; r < 8; ++r) v[r] = w[r];
    }
    __syncthreads();
}

__device__ __forceinline__ float wsum(float v, int lane) {
#pragma unroll
    for (int o = 32; o > 0; o >>= 1) v += shx(v, o, lane);
    return v; }
template <int MODE>
__device__ __forceinline__ void ph_rows(const P& p, int layer) {
    const int lane = tid_now() & 63, gw = blockIdx.x * 8 + (tid_now() >> 6), nw = gridDim.x * 8;
    const float* gp = MODE == 0 ? p.ln0_g : MODE == 1 ? p.ln1_g + layer * D : MODE == 2 ? p.ln2_g + layer * D : p.ln3_g + layer * D;
    const float* bp = MODE == 0 ? p.ln0_b : MODE == 1 ? p.ln1_b + layer * D : MODE == 2 ? p.ln2_b + layer * D : p.ln3_b + layer * D;
    f32x4 gg[4], bb[4];
#pragma unroll
    for (int i = 0; i < 4; ++i) { gg[i] = *(const f32x4*)(gp + 256 * i + 4 * lane); bb[i] = *(const f32x4*)(bp + 256 * i + 4 * lane); }
    const float* in = MODE == 0 ? p.x : MODE == 2 ? p.X : p.Z;
    float* outf = (MODE == 3 && layer == DEPTH - 1) ? p.out : p.X;
    for (int row = gw; row < T; row += nw) {
        f32x4 v[4];
#pragma unroll
        for (int i = 0; i < 4; ++i) v[i] = *(const f32x4*)(in + (size_t)row * D + 256 * i + 4 * lane);
        if constexpr (MODE == 2) { const float w0 = p.ew[2 * row], w1 = p.ew[2 * row + 1];
#pragma unroll
            for (int i = 0; i < 4; ++i) { const u32x2 y0 = *(const u32x2*)(p.Ys + (size_t)(2 * row) * D + 256 * i + 4 * lane), y1 = *(const u32x2*)(p.Ys + (size_t)(2 * row + 1) * D + 256 * i + 4 * lane);
                v[i][0] = DN_ALPHA * v[i][0] + (w0 * bflo(y0[0]) + w1 * bflo(y1[0])); v[i][1] = DN_ALPHA * v[i][1] + (w0 * bfhi(y0[0]) + w1 * bfhi(y1[0]));
                v[i][2] = DN_ALPHA * v[i][2] + (w0 * bflo(y0[1]) + w1 * bflo(y1[1])); v[i][3] = DN_ALPHA * v[i][3] + (w0 * bfhi(y0[1]) + w1 * bfhi(y1[1])); } }
        float s = 0.f;
#pragma unroll
        for (int i = 0; i < 4; ++i) s += (v[i][0] + v[i][1]) + (v[i][2] + v[i][3]);
        const float mu = wsum(s, lane) * (1.f / D);
        float q = 0.f;
#pragma unroll
        for (int i = 0; i < 4; ++i) { v[i] = v[i] - mu; q += (v[i][0] * v[i][0] + v[i][1] * v[i][1]) + (v[i][2] * v[i][2] + v[i][3] * v[i][3]); }
        const float rs = rsqrtf(wsum(q, lane) * (1.f / D) + 1e-5f);
#pragma unroll
        for (int i = 0; i < 4; ++i) { v[i] = v[i] * rs * gg[i] + bb[i];
            *(f32x4*)(outf + (size_t)row * D + 256 * i + 4 * lane) = v[i];
            u32x2 o = {cvt_pk_bf16(v[i][0], v[i][1]), cvt_pk_bf16(v[i][2], v[i][3])};
            *(u32x2*)(p.Xb + (size_t)row * D + 256 * i + 4 * lane) = o; }
        if constexpr (MODE == 1) {
            const float* wg = p.w_grp + (size_t)layer * D * 8; const float* we = p.w_exp + (size_t)layer * D * 64;
            float gl[8];
#pragma unroll
            for (int g = 0; g < 8; ++g) gl[g] = 0.f;
#pragma unroll
            for (int i = 0; i < 4; ++i)
#pragma unroll
                for (int j = 0; j < 4; ++j) { const int k = 256 * i + 4 * lane + j; const f32x4 a = *(const f32x4*)(wg + k * 8), b = *(const f32x4*)(wg + k * 8 + 4); const float xv = v[i][j];
                    gl[0] = fmaf(xv, a[0], gl[0]); gl[1] = fmaf(xv, a[1], gl[1]); gl[2] = fmaf(xv, a[2], gl[2]); gl[3] = fmaf(xv, a[3], gl[3]);
                    gl[4] = fmaf(xv, b[0], gl[4]); gl[5] = fmaf(xv, b[1], gl[5]); gl[6] = fmaf(xv, b[2], gl[6]); gl[7] = fmaf(xv, b[3], gl[7]); }
            float mx = -INFINITY; int gt = 0;
#pragma unroll
            for (int g = 0; g < 8; ++g) { gl[g] = wsum(gl[g], lane) + p.b_grp[layer * 8 + g]; if (gl[g] > mx) { mx = gl[g]; gt = g; } }
            gt = __builtin_amdgcn_readfirstlane(gt);
            float sum = 0.f;
#pragma unroll
            for (int g = 0; g < 8; ++g) sum += expf(gl[g] - mx);
            const float pg = 1.f / sum;
            float el[8];
#pragma unroll
            for (int e = 0; e < 8; ++e) el[e] = 0.f;
#pragma unroll
            for (int i = 0; i < 4; ++i)
#pragma unroll
                for (int j = 0; j < 4; ++j) { const int k = 256 * i + 4 * lane + j; const f32x4 a = *(const f32x4*)(we + k * 64 + gt * 8), b = *(const f32x4*)(we + k * 64 + gt * 8 + 4); const float xv = v[i][j];
                    el[0] = fmaf(xv, a[0], el[0]); el[1] = fmaf(xv, a[1], el[1]); el[2] = fmaf(xv, a[2], el[2]); el[3] = fmaf(xv, a[3], el[3]);
                    el[4] = fmaf(xv, b[0], el[4]); el[5] = fmaf(xv, b[1], el[5]); el[6] = fmaf(xv, b[2], el[6]); el[7] = fmaf(xv, b[3], el[7]); }
            float v1 = -INFINITY, v2 = -INFINITY; int i1 = 0, i2 = 0;
#pragma unroll
            for (int e = 0; e < 8; ++e) { const float vv = wsum(el[e], lane) + p.b_exp[layer * 64 + gt * 8 + e];
                if (vv > v1) { v2 = v1; i2 = i1; v1 = vv; i1 = e; } else if (vv > v2) { v2 = vv; i2 = e; } }
            if (lane == 0) { const float e2 = expf(v2 - v1), w1 = pg / (1.f + e2), w2 = pg * e2 / (1.f + e2);
                const int ea = gt * 8 + i1, eb = gt * 8 + i2; int* cn = p.cnt + layer * 64;
                p.ew[2 * row] = w1; p.ew[2 * row + 1] = w2;
                const int pa = atomicAdd(&cn[ea], 1); p.lists[ea * LCAP + pa] = 2 * row;
                const int pb = atomicAdd(&cn[eb], 1); p.lists[eb * LCAP + pb] = 2 * row + 1; }
        }
    }
}

__device__ __forceinline__ void wsum8(float (&x)[8], int lane) {
    float y[4], z[2], w;
#pragma unroll
    for (int k = 0; k < 4; ++k) { const bool hi = lane & 32; const float snd = hi ? x[k] : x[k + 4], keep = hi ? x[k + 4] : x[k]; y[k] = keep + shx(snd, 32, lane); }
#pragma unroll
    for (int k = 0; k < 2; ++k) { const bool hi = lane & 16; const float snd = hi ? y[k] : y[k + 2], keep = hi ? y[k + 2] : y[k]; z[k] = keep + shx(snd, 16, lane); }
    { const bool hi = lane & 8; const float snd = hi ? z[0] : z[1], keep = hi ? z[1] : z[0]; w = keep + shx(snd, 8, lane); }
    w += shx(w, 4, lane); w += shx(w, 2, lane); w += shx(w, 1, lane);
#pragma unroll
    for (int k = 0; k < 8; ++k) x[k] = __int_as_float(__builtin_amdgcn_readlane(__float_as_int(w), (k >> 2) * 32 + ((k >> 1) & 1) * 16 + (k & 1) * 8));
}
__device__ __forceinline__ void ph_ln1_router(const P& p, int layer) {
    constexpr int RR = 2;
    const int tid = tid_now(), lane0 = tid & 63, gw = sgpr_now((int)blockIdx.x) * 8 + (tid >> 6), nw = gridDim.x * 8;
    const float* gp = p.ln1_g + layer * D; const float* bp = p.ln1_b + layer * D;
    const float* wg = p.w_grp + (size_t)layer * D * 8; const float* we = p.w_exp + (size_t)layer * D * 64;
    for (int row0 = gw * RR; row0 < T; row0 += nw * RR) {
        int lane = lane0; asm volatile("" : "+v"(lane));
        f32x4 v[RR][4];
#pragma unroll
        for (int r = 0; r < RR; ++r)
#pragma unroll
            for (int i = 0; i < 4; ++i) v[r][i] = *(const f32x4*)(p.Z + (size_t)(row0 + r) * D + 256 * i + 4 * lane);
#pragma unroll
        for (int r = 0; r < RR; ++r) {
            float s = 0.f;
#pragma unroll
            for (int i = 0; i < 4; ++i) s += (v[r][i][0] + v[r][i][1]) + (v[r][i][2] + v[r][i][3]);
            const float mu = wsum(s, lane) * (1.f / D);
            float q = 0.f;
#pragma unroll
            for (int i = 0; i < 4; ++i) { v[r][i] = v[r][i] - mu; q += (v[r][i][0] * v[r][i][0] + v[r][i][1] * v[r][i][1]) + (v[r][i][2] * v[r][i][2] + v[r][i][3] * v[r][i][3]); }
            const float rs = rsqrtf(wsum(q, lane) * (1.f / D) + 1e-5f);
#pragma unroll
            for (int i = 0; i < 4; ++i) { const f32x4 gg = *(const f32x4*)(gp + 256 * i + 4 * lane), bb = *(const f32x4*)(bp + 256 * i + 4 * lane);
                v[r][i] = v[r][i] * rs * gg + bb;
                *(f32x4*)(p.X + (size_t)(row0 + r) * D + 256 * i + 4 * lane) = v[r][i];
                u32x2 o = {cvt_pk_bf16(v[r][i][0], v[r][i][1]), cvt_pk_bf16(v[r][i][2], v[r][i][3])};
                *(u32x2*)(p.Xb + (size_t)(row0 + r) * D + 256 * i + 4 * lane) = o; } }
        float gl[RR][8];
#pragma unroll
        for (int r = 0; r < RR; ++r)
#pragma unroll
            for (int g = 0; g < 8; ++g) gl[r][g] = 0.f;
#pragma unroll
        for (int i = 0; i < 4; ++i) { asm volatile("" : "+v"(lane) :: "memory");
#pragma unroll
            for (int j = 0; j < 4; ++j) { const int k = 256 * i + 4 * lane + j; const f32x4 a = *(const f32x4*)(wg + k * 8), b = *(const f32x4*)(wg + k * 8 + 4);
#pragma unroll
                for (int r = 0; r < RR; ++r) { const float xv = v[r][i][j];
                    gl[r][0] = fmaf(xv, a[0], gl[r][0]); gl[r][1] = fmaf(xv, a[1], gl[r][1]); gl[r][2] = fmaf(xv, a[2], gl[r][2]); gl[r][3] = fmaf(xv, a[3], gl[r][3]);
                    gl[r][4] = fmaf(xv, b[0], gl[r][4]); gl[r][5] = fmaf(xv, b[1], gl[r][5]); gl[r][6] = fmaf(xv, b[2], gl[r][6]); gl[r][7] = fmaf(xv, b[3], gl[r][7]); } } }
        int gt[RR]; float pg[RR];
#pragma unroll
        for (int r = 0; r < RR; ++r) { wsum8(gl[r], lane);
            float mx = -INFINITY; int gi = 0;
#pragma unroll
            for (int g = 0; g < 8; ++g) { gl[r][g] += p.b_grp[layer * 8 + g]; if (gl[r][g] > mx) { mx = gl[r][g]; gi = g; } }
            float sum = 0.f;
#pragma unroll
            for (int g = 0; g < 8; ++g) sum += expf(gl[r][g] - mx);
            gt[r] = __builtin_amdgcn_readfirstlane(gi); pg[r] = 1.f / sum; }
        float el[RR][8];
#pragma unroll
        for (int r = 0; r < RR; ++r) {
#pragma unroll
            for (int e = 0; e < 8; ++e) el[r][e] = 0.f;
#pragma unroll
            for (int i = 0; i < 4; ++i) { asm volatile("" : "+v"(lane) :: "memory");
#pragma unroll
                for (int j = 0; j < 4; ++j) { const int k = 256 * i + 4 * lane + j; const f32x4 a = *(const f32x4*)(we + k * 64 + gt[r] * 8), b = *(const f32x4*)(we + k * 64 + gt[r] * 8 + 4); const float xv = v[r][i][j];
                    el[r][0] = fmaf(xv, a[0], el[r][0]); el[r][1] = fmaf(xv, a[1], el[r][1]); el[r][2] = fmaf(xv, a[2], el[r][2]); el[r][3] = fmaf(xv, a[3], el[r][3]);
                    el[r][4] = fmaf(xv, b[0], el[r][4]); el[r][5] = fmaf(xv, b[1], el[r][5]); el[r][6] = fmaf(xv, b[2], el[r][6]); el[r][7] = fmaf(xv, b[3], el[r][7]); } } }
#pragma unroll
        for (int r = 0; r < RR; ++r) { wsum8(el[r], lane);
            float v1 = -INFINITY, v2 = -INFINITY; int i1 = 0, i2 = 0;
#pragma unroll
            for (int e = 0; e < 8; ++e) { const float vv = el[r][e] + p.b_exp[layer * 64 + gt[r] * 8 + e];
                if (vv > v1) { v2 = v1; i2 = i1; v1 = vv; i1 = e; } else if (vv > v2) { v2 = vv; i2 = e; } }
            if (lane == 0) { const int row = row0 + r; const float e2 = expf(v2 - v1), w1 = pg[r] / (1.f + e2), w2 = pg[r] * e2 / (1.f + e2);
                const int ea = gt[r] * 8 + i1, eb = gt[r] * 8 + i2; int* cn = p.cnt + layer * 64;
                p.ew[2 * row] = w1; p.ew[2 * row + 1] = w2;
                const int pa = atomicAdd(&cn[ea], 1); p.lists[ea * LCAP + pa] = 2 * row;
                const int pb = atomicAdd(&cn[eb], 1); p.lists[eb * LCAP + pb] = 2 * row + 1; } }
    }
}
__device__ __forceinline__ void ph_prologue(const P& p) {
    const int gtid = blockIdx.x * NTHR + tid_now(), gth = gridDim.x * NTHR;
    for (int idx = gtid; idx < T * 32; idx += gth) { const int t = idx >> 5, i = idx & 31;
        const float inv = (float)(1.0 / pow(10000.0, (double)(2 * i) / 64.0)); const float ang = (float)p.pos[t] * inv;
        p.cs[idx] = (float)cos((double)ang); p.sn[idx] = (float)sin((double)ang); }
    for (size_t i = gtid; i < (size_t)DEPTH * T * PLE / 4; i += gth) { const f32x4 v = ((const f32x4*)p.pin)[i]; u32x2 o = {cvt_pk_bf16(v[0], v[1]), cvt_pk_bf16(v[2], v[3])}; ((u32x2*)p.Pb)[i] = o; }
    ph_rows<0>(p, 0);
}

struct SchedBr { __device__ __forceinline__ bool carry(const ge::Unit& u) const { return u.g < 2; }
    const char* Ya; const char* Yb; const char* Yc; const char* W; int c, G;
    __device__ __forceinline__ bool next(int i, ge::Unit& u) const { const int tile = (i / 3) * G + c; if (tile >= 256) return false; u.g = i % 3; ge::tile_order(tile, 64, 4, u.pm, u.pn); return true; }
    __device__ __forceinline__ const char* aptr(const ge::Unit& u) const { return (u.g == 0 ? Ya : u.g == 1 ? Yb : Yc) + (size_t)u.pm * 256 * 512 * 2; }
    __device__ __forceinline__ const char* bptr(const ge::Unit& u) const { return W + ((size_t)u.g * 1024 + u.pn * 256) * 512 * 2; } };
struct EpiBr { const bf16_t* Hp; bf16_t* Mgb;
    __device__ __forceinline__ void operator()(ge::Acc& acc, const ge::Unit& u, int wr, int wc, int fr, int fq) const {
        const int row0 = u.pm * 256 + wr * 64 + fr, col0 = u.pn * 256 + wc * 32 + 8 * fq;
#pragma unroll
        for (int ai = 0; ai < 2; ++ai)
#pragma unroll
            for (int m = 0; m < 4; ++m) { asm volatile("" ::: "memory"); const int row = row0 + ai * 128 + m * 16;
#pragma unroll
                for (int bj = 0; bj < 2; ++bj) { const int col = col0 + bj * 128;
                    const u32x4 gt = *(const u32x4*)(Hp + (size_t)row * HW + H_GTA + u.g * 1024 + col);
                    f32x4 s0 = {bflo(gt[0]), bfhi(gt[0]), bflo(gt[1]), bfhi(gt[1])}, s1 = {bflo(gt[2]), bfhi(gt[2]), bflo(gt[3]), bfhi(gt[3])};
                    if (u.g < 2) { const u32x4 gn = *(const u32x4*)(Hp + (size_t)row * HW + H_GTA + (u.g + 1) * 1024 + col);
                        f32x4 d0 = {bflo(gn[0]), bfhi(gn[0]), bflo(gn[1]), bfhi(gn[1])}, d1 = {bflo(gn[2]), bfhi(gn[2]), bflo(gn[3]), bfhi(gn[3])};
#pragma unroll
                        for (int j = 0; j < 4; ++j) { s0[j] = s0[j] / d0[j]; s1[j] = s1[j] / d1[j]; } }
                    acc[ai][bj][m][0] = acc[ai][bj][m][0] * s0; acc[ai][bj][m][1] = acc[ai][bj][m][1] * s1;
                    if (u.g == 2) { const f32x4 v0 = acc[ai][bj][m][0], v1 = acc[ai][bj][m][1];
                        u32x4 o = {cvt_pk_bf16(v0[0], v0[1]), cvt_pk_bf16(v0[2], v0[3]), cvt_pk_bf16(v1[0], v1[1]), cvt_pk_bf16(v1[2], v1[3])}; *(u32x4*)(Mgb + (size_t)row * D + col) = o; } } }
    } };
struct SchedT4 : ge::NoCarry { const char* A; const char* B; int lda2, ldb2, c, G;
    __device__ __forceinline__ bool next(int i, ge::Unit& u) const { const int L = i * G + c; if (L >= 256) return false; u.g = 0; ge::tile_order(L, 64, 4, u.pm, u.pn); return true; }
    __device__ __forceinline__ const char* aptr(const ge::Unit& u) const { return A + (size_t)u.pm * lda2; }
    __device__ __forceinline__ const char* bptr(const ge::Unit& u) const { return B + (size_t)u.pn * ldb2; } };
struct EpiRes { const float* X; float* Z;
    __device__ __forceinline__ void operator()(ge::Acc& acc, const ge::Unit& u, int wr, int wc, int fr, int fq) const {
        const int row0 = u.pm * 256 + wr * 64 + fr, col0 = u.pn * 256 + wc * 32 + 8 * fq;
#pragma unroll
        for (int ai = 0; ai < 2; ++ai)
#pragma unroll
            for (int m = 0; m < 4; ++m) { asm volatile("" ::: "memory"); const size_t o = (size_t)(row0 + ai * 128 + m * 16) * D + col0;
#pragma unroll
                for (int bj = 0; bj < 2; ++bj) { const f32x4 x0 = *(const f32x4*)(X + o + bj * 128), x1 = *(const f32x4*)(X + o + bj * 128 + 4);
                    *(f32x4*)(Z + o + bj * 128) = x0 * DN_ALPHA + acc[ai][bj][m][0]; *(f32x4*)(Z + o + bj * 128 + 4) = x1 * DN_ALPHA + acc[ai][bj][m][1]; } }
    } };
struct EpiU { bf16_t* Ub;
    __device__ __forceinline__ void operator()(ge::Acc& acc, const ge::Unit& u, int wr, int wc, int fr, int fq) const {
        const int row0 = u.pm * 256 + wr * 64 + fr, col0 = u.pn * 256 + wc * 32 + 8 * fq;
#pragma unroll
        for (int ai = 0; ai < 2; ++ai)
#pragma unroll
            for (int m = 0; m < 4; ++m) { const size_t o = (size_t)(row0 + ai * 128 + m * 16) * D + col0;
#pragma unroll
                for (int bj = 0; bj < 2; ++bj) { const f32x4 v0 = acc[ai][bj][m][0], v1 = acc[ai][bj][m][1];
                    u32x4 w = {cvt_pk_bf16(v0[0], v0[1]), cvt_pk_bf16(v0[2], v0[3]), cvt_pk_bf16(v1[0], v1[1]), cvt_pk_bf16(v1[2], v1[3])}; *(u32x4*)(Ub + o + bj * 128) = w; } }
    } };
struct EpiPle { const float* X; float* Z; const bf16_t* Ub; const float* bias;
    __device__ __forceinline__ void operator()(ge::Acc& acc, const ge::Unit& u, int wr, int wc, int fr, int fq) const {
        const int row0 = u.pm * 256 + wr * 64 + fr, col0 = u.pn * 256 + wc * 32 + 8 * fq;
        f32x4 bv[2][2];
#pragma unroll
        for (int bj = 0; bj < 2; ++bj) { bv[bj][0] = *(const f32x4*)(bias + col0 + bj * 128); bv[bj][1] = *(const f32x4*)(bias + col0 + bj * 128 + 4); }
#pragma unroll
        for (int ai = 0; ai < 2; ++ai)
#pragma unroll
            for (int m = 0; m < 4; ++m) { asm volatile("" ::: "memory"); const size_t o = (size_t)(row0 + ai * 128 + m * 16) * D + col0;
#pragma unroll
                for (int bj = 0; bj < 2; ++bj) { const f32x4 x0 = *(const f32x4*)(X + o + bj * 128), x1 = *(const f32x4*)(X + o + bj * 128 + 4); const u32x4 uu = *(const u32x4*)(Ub + o + bj * 128);
                    f32x4 g0 = acc[ai][bj][m][0] + bv[bj][0], g1 = acc[ai][bj][m][1] + bv[bj][1];
#pragma unroll
                    for (int j = 0; j < 4; ++j) { g0[j] = 1.f / (1.f + __expf(-g0[j])); g1[j] = 1.f / (1.f + __expf(-g1[j])); }
                    f32x4 u0 = {bflo(uu[0]), bfhi(uu[0]), bflo(uu[1]), bfhi(uu[1])}, u1 = {bflo(uu[2]), bfhi(uu[2]), bflo(uu[3]), bfhi(uu[3])};
                    *(f32x4*)(Z + o + bj * 128) = x0 * DN_ALPHA + g0 * u0; *(f32x4*)(Z + o + bj * 128 + 4) = x1 * DN_ALPHA + g1 * u1; } }
    } };

__device__ __forceinline__ void moe_table(LAS unsigned char* lds, const int* cnt) {
    LAS int* te = (LAS int*)(lds + 131072); LAS int* tr = te + 256; LAS int* cl = tr + 256; LAS int* nt = cl + 64;
    __syncthreads();
    if (tid_now() < 64) cl[tid_now()] = cnt[tid_now()];
    __syncthreads();
    if (tid_now() == 0) { int n = 0; for (int e = 0; e < NE; ++e) for (int r = 0; r < cl[e]; r += 256) { te[n] = e; tr[n] = r; ++n; } nt[0] = n; }
    __syncthreads();
}
struct SchedM1 : ge::NoCarry { const char* Xb; const char* W; const int* lists; LAS int* te; int c, G;
    __device__ __forceinline__ bool next(int i, ge::Unit& u) const { const int L = i * G + c; if (L >= 2 * te[576]) return false; u.pm = L >> 1; u.pn = L & 1; u.g = te[u.pm]; return true; }
    __device__ __forceinline__ int arow(const ge::Unit& u, int r) const { const int n = te[512 + u.g], idx = min(te[256 + u.pm] + r, n - 1); return lists[u.g * LCAP + idx] >> 1; }
    __device__ __forceinline__ const char* aptr(const ge::Unit&) const { return Xb; }
    __device__ __forceinline__ const char* bptr(const ge::Unit& u) const { return W + ((size_t)u.g * 512 + u.pn * 256) * D * 2; } };
struct EpiM1 { bf16_t* Hbuf;
    __device__ __forceinline__ void operator()(ge::Acc& acc, const ge::Unit& u, int wr, int wc, int fr, int fq) const {
#pragma unroll
        for (int ai = 0; ai < 2; ++ai)
#pragma unroll
            for (int m = 0; m < 4; ++m) { const int row = ai * 128 + wr * 64 + m * 16 + fr;
                float h[8];
#pragma unroll
                for (int n = 0; n < 2; ++n)
#pragma unroll
                    for (int j = 0; j < 4; ++j) { const float g = acc[ai][0][m][n][j], uu = acc[ai][1][m][n][j]; h[4 * n + j] = g / (1.f + __expf(-g)) * uu; }
                u32x4 o = {cvt_pk_bf16(h[0], h[1]), cvt_pk_bf16(h[2], h[3]), cvt_pk_bf16(h[4], h[5]), cvt_pk_bf16(h[6], h[7])};
                *(u32x4*)(Hbuf + ((size_t)u.pm * 256 + row) * EH + u.pn * 128 + wc * 32 + 8 * fq) = o; }
    } };
struct SchedM2 : ge::NoCarry { const char* Hb; const char* W; LAS int* te; int c, G;
    __device__ __forceinline__ bool next(int i, ge::Unit& u) const { const int L = i * G + c; if (L >= 4 * te[576]) return false; u.pm = L >> 2; u.pn = L & 3; u.g = te[u.pm]; return true; }
    __device__ __forceinline__ const char* aptr(const ge::Unit& u) const { return Hb + (size_t)u.pm * 256 * EH * 2; }
    __device__ __forceinline__ const char* bptr(const ge::Unit& u) const { return W + ((size_t)u.g * D + u.pn * 256) * EH * 2; } };
struct EpiM2 { bf16_t* Ys; const int* lists; LAS int* te;
    __device__ __forceinline__ void operator()(ge::Acc& acc, const ge::Unit& u, int wr, int wc, int fr, int fq) const {
        const int r0 = te[256 + u.pm], n = te[512 + u.g];
#pragma unroll
        for (int ai = 0; ai < 2; ++ai)
#pragma unroll
            for (int m = 0; m < 4; ++m) { const int row = r0 + ai * 128 + wr * 64 + m * 16 + fr;
                if (row < n) { const int a = lists[u.g * LCAP + row];
#pragma unroll
                    for (int bj = 0; bj < 2; ++bj) { const f32x4 v0 = acc[ai][bj][m][0], v1 = acc[ai][bj][m][1];
                        u32x4 o = {cvt_pk_bf16(v0[0], v0[1]), cvt_pk_bf16(v0[2], v0[3]), cvt_pk_bf16(v1[0], v1[1]), cvt_pk_bf16(v1[2], v1[3])};
                        *(u32x4*)(Ys + (size_t)a * D + u.pn * 256 + bj * 128 + wc * 32 + 8 * fq) = o; } } }
    } };

#define XB_TMO      128
#define XB_XCNT(j)  (256  + 64 * (j))
#define XB_XSUB(j)  (1280 + 64 * (j))
#define XB_XGEN(j)  (2304 + 64 * (j))
#define XB_TOP      3328
#define XB_TOPGEN   3392
#define XCD_BAR_WORDS 3456
#define XB_SPIN_CAP (1u << 18)

__device__ __forceinline__ unsigned xb_ld(unsigned* p)              { return __hip_atomic_load(p, __ATOMIC_RELAXED, __HIP_MEMORY_SCOPE_AGENT); }
__device__ __forceinline__ unsigned xb_add(unsigned* p, unsigned v) { return __hip_atomic_fetch_add(p, v, __ATOMIC_RELAXED, __HIP_MEMORY_SCOPE_AGENT); }
__device__ __forceinline__ unsigned xb_xcc_id() { return (unsigned)__builtin_amdgcn_s_getreg((3 << 11) | 20) & 0xFu; }
#define XB_SPIN(cond, bar) do { unsigned _sp = 0; while (cond) { __builtin_amdgcn_s_sleep(1); \
    if ((++_sp & 255u) == 0u) { if (xb_ld(&(bar)[XB_TMO])) break; if (_sp > XB_SPIN_CAP) { atomicAdd(&(bar)[XB_TMO], 1u); break; } } } } while (0)

struct XcdBarrier {
    unsigned* bar; unsigned x;
    volatile LAS unsigned* st;
};

__device__ __forceinline__ XcdBarrier xcd_barrier_post(unsigned* bar, volatile LAS unsigned* st) {
    XcdBarrier b; b.bar = bar; b.x = xb_xcc_id(); b.st = st;
    if (threadIdx.x == 0) (void)xb_add(&bar[XB_XCNT(b.x)], 1u);
    return b;
}
__device__ __forceinline__ void xcd_barrier_complete(unsigned* bar, unsigned x, unsigned& nloc, unsigned& nx) {
    const unsigned G = gridDim.x * gridDim.y * gridDim.z;
    unsigned sum, cnt, mine, sp = 0u;
    for (;;) {
        sum = 0u; cnt = 0u; mine = 0u;
#pragma unroll
        for (unsigned j = 0; j < 16; ++j) { const unsigned c = xb_ld(&bar[XB_XCNT(j)]); sum += c; cnt += (c > 0u) ? 1u : 0u; mine = (j == x) ? c : mine; }
        if (sum == G) break;
        __builtin_amdgcn_s_sleep(1);
        if ((++sp & 255u) == 0u) { if (xb_ld(&bar[XB_TMO])) break; if (sp > XB_SPIN_CAP) { atomicAdd(&bar[XB_TMO], 1u); break; } }
    }
    nloc = mine > 0u ? mine : 1u; nx = cnt > 0u ? cnt : 1u;
}

__device__ __forceinline__ void xcd_barrier(const XcdBarrier& b) {
    asm volatile("s_waitcnt vmcnt(0)" ::: "memory");
    __syncthreads();
    if (threadIdx.x == 0) {
        unsigned* bar = b.bar;
        __builtin_amdgcn_s_waitcnt(0);
        unsigned nloc = b.st[0], nx = b.st[1];
        if (nloc == 0u) { xcd_barrier_complete(bar, b.x, nloc, nx); b.st[0] = nloc; b.st[1] = nx; }
        const unsigned old = xb_add(&bar[XB_XSUB(b.x)], 1u);
        const unsigned gen = old / nloc;
        if (old + 1u == (gen + 1u) * nloc) {
            __builtin_amdgcn_fence(__ATOMIC_RELEASE, "agent");
            asm volatile("s_waitcnt vmcnt(0)" ::: "memory");
            const unsigned og = xb_add(&bar[XB_TOP], 1u);
            const unsigned tg = og / nx;
            if (og + 1u == (tg + 1u) * nx) xb_add(&bar[XB_TOPGEN], 1u);
            else XB_SPIN(xb_ld(&bar[XB_TOPGEN]) == tg, bar);
            __builtin_amdgcn_fence(__ATOMIC_ACQUIRE, "agent");
            xb_add(&bar[XB_XGEN(b.x)], 1u);
            asm volatile("s_waitcnt vmcnt(0)" ::: "memory");
        } else {
            XB_SPIN(xb_ld(&bar[XB_XGEN(b.x)]) == gen, bar);
            __builtin_amdgcn_fence(__ATOMIC_ACQUIRE, "agent");
            asm volatile("s_waitcnt vmcnt(0)" ::: "memory");
        }
    }
    __syncthreads();
}

enum { PH_PRO = 0, PH_CONV, PH_IN, PH_PREP_Q, PH_PREP_K, PH_PREP_V, PH_PREP_G, PH_ATT, PH_FIN, PH_BR, PH_WO, PH_LN1, PH_M1, PH_M2, PH_LN2, PH_PLE, PH_LN3 };
template <int PH> __global__ __launch_bounds__(NTHR, 2) void k_ph(P p, int layer) {
    extern __shared__ __attribute__((aligned(16))) unsigned char smem[];
    LAS unsigned char* lds = (LAS unsigned char*)smem;
    tid_setup();
    const int c = blockIdx.x, G = gridDim.x;
    if constexpr (PH == PH_PRO) ph_prologue(p);
    if constexpr (PH == PH_CONV) ph_convert(lds, p, layer);
    if constexpr (PH == PH_IN) { const MegaP m = mk_mega(p); SchedIn S{{}, (const char*)m.Xb, (const char*)m.Wb_in, (const char*)m.Wb_gv, c, G, 0}; EpiIn<2> E{m.Hp, m.GVt, m.ssq_q, m.ssq_kv}; ge::gemm_stream<EpiIn<2>, SchedIn, false>(lds, D, D, D, S, E); }
    if constexpr (PH == PH_PREP_Q) { const MlaP q = mk_mla(p); SchedMla<0> S{{}, (const char*)(q.Hp + H_CQ), (const char*)q.Wb_uq, c, G}; EpiMla<0> E{q}; ge::gemm_stream<EpiMla<0>, SchedMla<0>, false>(lds, 256, HW, 256, S, E); }
    if constexpr (PH == PH_PREP_K) { const MlaP q = mk_mla(p); SchedMla<1> S{{}, (const char*)(q.Hp + H_CKV), (const char*)q.Wb_uk, (c + 64) % G, G}; EpiMla<1> E{q}; ge::gemm_stream<EpiMla<1>, SchedMla<1>, false>(lds, 256, HW, 256, S, E); }
    if constexpr (PH == PH_PREP_V) { const MlaP q = mk_mla(p); SchedMla<2> S{{}, (const char*)q.Wb_uv, (const char*)(q.Hp + H_CKV), (c + 192) % G, G}; EpiMla<2> E{q}; ge::gemm_stream<EpiMla<2>, SchedMla<2>, false>(lds, 256, 256, HW, S, E); }
    if constexpr (PH == PH_PREP_G) { { const MegaP m = mk_mega(p); SchedIn S{{}, (const char*)m.Xb, (const char*)m.Wb_in, (const char*)m.Wb_gv, (c + 128) % G, G, 1}; EpiIn<0> E{m.Hp, m.GVt, m.ssq_q, m.ssq_kv}; ge::gemm_stream<EpiIn<0>, SchedIn, false>(lds, D, D, D, S, E); } const MlaP q = mk_mla(p); kr_phase(q, c * NTHR + tid_now(), G * NTHR); const GlaP g = mk_gla(p, layer); gla_g1(lds, g, c, G); }
    if constexpr (PH == PH_ATT) { const GlaP g = mk_gla(p, layer); gla_g2(lds, g, c); const MlaP q = mk_mla(p); attn_phase(lds, q, c); }
    if constexpr (PH == PH_FIN) { const GlaP g = mk_gla(p, layer); gla_g3(lds, g, c, G); conv_phase(g, c * NTHR + tid_now(), G * NTHR); attn_combine_bf16(g, c * NTHR + tid_now(), G * NTHR); }
    if constexpr (PH == PH_BR) { SchedBr S{(const char*)p.Yab, (const char*)p.Ybb, (const char*)p.Ycb, (const char*)p.Wb_br, c, G}; EpiBr E{p.Hp, p.Mgb}; ge::gemm_stream<EpiBr, SchedBr, false>(lds, 512, 512, 512, S, E); }
    if constexpr (PH == PH_WO) { SchedT4 S{{}, (const char*)p.Mgb, (const char*)p.Wb_o, 256 * D * 2, 256 * D * 2, c, G}; EpiRes E{p.X, p.Z}; ge::gemm_stream<EpiRes, SchedT4, false>(lds, D, D, D, S, E); }
    if constexpr (PH == PH_LN1) ph_ln1_router(p, layer);
    if constexpr (PH == PH_M1) { moe_table(lds, p.cnt + layer * 64); LAS int* te = (LAS int*)(lds + 131072);
        SchedM1 S{{}, (const char*)p.Xb, (const char*)p.Wb_gu, p.lists, te, c, G}; EpiM1 E{p.Hbuf}; ge::gemm_stream<EpiM1, SchedM1, true>(lds, D, D, D, S, E); }
    if constexpr (PH == PH_M2) { moe_table(lds, p.cnt + layer * 64); LAS int* te = (LAS int*)(lds + 131072);
        SchedM2 S{{}, (const char*)p.Hbuf, (const char*)p.Wb_d, te, c, G}; EpiM2 E{p.Ys, p.lists, te}; ge::gemm_stream<EpiM2, SchedM2, false>(lds, EH, EH, EH, S, E); }
    if constexpr (PH == PH_LN2) ph_rows<2>(p, layer);
    if constexpr (PH == PH_PLE) {
        { SchedT4 S{{}, (const char*)(p.Pb + (size_t)layer * T * PLE), (const char*)p.Wb_pu, 256 * PLE * 2, 256 * PLE * 2, c, G}; EpiU E{p.Ub}; ge::gemm_stream<EpiU, SchedT4, false>(lds, PLE, PLE, PLE, S, E); }
        { SchedT4 S{{}, (const char*)p.Xb, (const char*)p.Wb_pg, 256 * D * 2, 256 * D * 2, c, G}; EpiPle E{p.X, p.Z, p.Ub, p.b_pg + layer * D}; ge::gemm_stream<EpiPle, SchedT4, false>(lds, D, D, D, S, E); } }
    if constexpr (PH == PH_LN3) ph_rows<3>(p, layer);
}


typedef const P __attribute__((address_space(4))) CP;
__device__ __forceinline__ P load_params() { CP* q = (CP*)__builtin_amdgcn_kernarg_segment_ptr(); asm volatile("" : "+s"(q)); return *(const P*)q; }
#define GRID_BAR() do { XcdBarrier b_; b_.bar = load_params().bar; b_.x = xb_xcc_id(); b_.st = xbw; xcd_barrier(b_); } while (0)
__global__ __launch_bounds__(NTHR, 2) void k_mega(P p_arg) {
    extern __shared__ __attribute__((aligned(16))) unsigned char smem[];
    LAS unsigned char* lds = (LAS unsigned char*)smem;
    const int G = NBLK;
#define c sgpr_now((int)blockIdx.x)
    volatile LAS unsigned* xbw = (volatile LAS unsigned*)(lds + XBW_OFF);
    tid_setup();
    if (tid_now() < 4) xbw[tid_now()] = 0u;
    __syncthreads();
    (void)xcd_barrier_post(p_arg.bar, xbw);
    { const P p = load_params(); ph_prologue(p); }
    { const P p = load_params(); ph_convert(lds, p, 0); }
    GRID_BAR();
    for (int layer = 0; layer < DEPTH; ++layer) {
        { const P p = load_params(); const MegaP m = mk_mega(p); SchedIn S{{}, (const char*)m.Xb, (const char*)m.Wb_in, (const char*)m.Wb_gv, c, G, 0}; EpiIn<2> E{m.Hp, m.GVt, m.ssq_q, m.ssq_kv}; ge::gemm_stream<EpiIn<2>, SchedIn, false>(lds, D, D, D, S, E); }
        GRID_BAR();
        { const P p = load_params(); const MlaP q = mk_mla(p);
          { SchedMla<0> S{{}, (const char*)(q.Hp + H_CQ), (const char*)q.Wb_uq, (c >= 128 ? c - 128 : -1), 128}; EpiMla<0> E{q}; ge::gemm_stream<EpiMla<0>, SchedMla<0>, false>(lds, 256, HW, 256, S, E); }
          { SchedMla<1> S{{}, (const char*)(q.Hp + H_CKV), (const char*)q.Wb_uk, (c >= 128 ? c - 128 : -1), 128}; EpiMla<1> E{q}; ge::gemm_stream<EpiMla<1>, SchedMla<1>, false>(lds, 256, HW, 256, S, E); }
          { SchedMla<2> S{{}, (const char*)q.Wb_uv, (const char*)(q.Hp + H_CKV), (c >= 128 ? c - 128 : -1), 128}; EpiMla<2> E{q}; ge::gemm_stream<EpiMla<2>, SchedMla<2>, false>(lds, 256, 256, HW, S, E); }
          { const MegaP m = mk_mega(p); SchedIn S{{}, (const char*)m.Xb, (const char*)m.Wb_in, (const char*)m.Wb_gv, c, G, 1}; EpiIn<0> E{m.Hp, m.GVt, m.ssq_q, m.ssq_kv}; ge::gemm_stream<EpiIn<0>, SchedIn, false>(lds, D, D, D, S, E); }
          kr_phase(q, c * NTHR + tid_now(), G * NTHR);
          const GlaP g = mk_gla(p, layer); gla_g1(lds, g, c, G); }
        GRID_BAR();
        { const P p = load_params(); const GlaP g = mk_gla(p, layer); gla_g2(lds, g, c); const MlaP q = mk_mla(p); attn_phase(lds, q, c); }
        GRID_BAR();
        { const P p = load_params(); const GlaP g = mk_gla(p, layer); gla_g3(lds, g, c, G); conv_phase(g, c * NTHR + tid_now(), G * NTHR); attn_combine_bf16(g, c * NTHR + tid_now(), G * NTHR); }
        GRID_BAR();
        { const P p = load_params(); SchedBr S{(const char*)p.Yab, (const char*)p.Ybb, (const char*)p.Ycb, (const char*)p.Wb_br, c, G}; EpiBr E{p.Hp, p.Mgb}; ge::gemm_stream<EpiBr, SchedBr, false>(lds, 512, 512, 512, S, E); }
        GRID_BAR();
        { const P p = load_params(); SchedT4 S{{}, (const char*)p.Mgb, (const char*)p.Wb_o, 256 * D * 2, 256 * D * 2, c, G}; EpiRes E{p.X, p.Z}; ge::gemm_stream<EpiRes, SchedT4, false>(lds, D, D, D, S, E); }
        GRID_BAR();
        { const P p = load_params(); ph_ln1_router(p, layer); }
        GRID_BAR();
        { const P p = load_params(); moe_table(lds, p.cnt + layer * 64); LAS int* te = (LAS int*)(lds + 131072);
          SchedM1 S{{}, (const char*)p.Xb, (const char*)p.Wb_gu, p.lists, te, c, G}; EpiM1 E{p.Hbuf}; ge::gemm_stream<EpiM1, SchedM1, true>(lds, D, D, D, S, E); }
        GRID_BAR();
        { const P p = load_params(); LAS int* te = (LAS int*)(lds + 131072);
          SchedM2 S{{}, (const char*)p.Hbuf, (const char*)p.Wb_d, te, c, G}; EpiM2 E{p.Ys, p.lists, te}; ge::gemm_stream<EpiM2, SchedM2, false>(lds, EH, EH, EH, S, E); }
        GRID_BAR();
        { const P p = load_params(); ph_rows<2>(p, layer); }
        GRID_BAR();
        { const P p = load_params(); SchedT4 S{{}, (const char*)(p.Pb + (size_t)layer * T * PLE), (const char*)p.Wb_pu, 256 * PLE * 2, 256 * PLE * 2, c, G}; EpiU E{p.Ub}; ge::gemm_stream<EpiU, SchedT4, false>(lds, PLE, PLE, PLE, S, E); }
        { const P p = load_params(); SchedT4 S{{}, (const char*)p.Xb, (const char*)p.Wb_pg, 256 * D * 2, 256 * D * 2, c, G}; EpiPle E{p.X, p.Z, p.Ub, p.b_pg + layer * D}; ge::gemm_stream<EpiPle, SchedT4, false>(lds, D, D, D, S, E); }
        GRID_BAR();
        { const P p = load_params(); ph_rows<3>(p, layer); }
        if (layer + 1 < DEPTH) { { const P p = load_params(); ph_convert(lds, p, layer + 1); } GRID_BAR(); }
    }
#undef c
}

template <int PH> static void launch_ph(const P& p, int layer, hipStream_t st) {
    static bool set = false;
    if (!set) { (void)hipFuncSetAttribute((const void*)k_ph<PH>, hipFuncAttributeMaxDynamicSharedMemorySize, LDS_BYTES); set = true; }
    hipLaunchKernelGGL((k_ph<PH>), dim3(NBLK), dim3(NTHR), LDS_BYTES, st, p, layer);
}
extern "C" void kernel_launch(void* const* d_in, const int* in_sizes, int n_in, void* d_out, int out_size, void* d_ws, size_t ws_size, hipStream_t st) {
    (void)in_sizes; (void)n_in; (void)out_size;
    P p{};
    p.x = (const float*)d_in[0]; p.pin = (const float*)d_in[1]; p.pos = (const int*)d_in[2]; p.ln0_g = (const float*)d_in[3]; p.ln0_b = (const float*)d_in[4];
    p.w_in = (const float*)d_in[5]; p.w_conv = (const float*)d_in[6]; p.w_gg = (const float*)d_in[7]; p.b_gg = (const float*)d_in[8]; p.gla_ng = (const float*)d_in[9];
    p.qn_g = (const float*)d_in[10]; p.kvn_g = (const float*)d_in[11]; p.w_uq = (const float*)d_in[12]; p.w_ukv = (const float*)d_in[13]; p.w_br = (const float*)d_in[14]; p.w_o = (const float*)d_in[15];
    p.ln1_g = (const float*)d_in[16]; p.ln1_b = (const float*)d_in[17]; p.w_grp = (const float*)d_in[18]; p.b_grp = (const float*)d_in[19]; p.w_exp = (const float*)d_in[20]; p.b_exp = (const float*)d_in[21];
    p.w_gate = (const float*)d_in[22]; p.w_up = (const float*)d_in[23]; p.w_down = (const float*)d_in[24]; p.ln2_g = (const float*)d_in[25]; p.ln2_b = (const float*)d_in[26];
    p.w_pg = (const float*)d_in[27]; p.b_pg = (const float*)d_in[28]; p.w_pu = (const float*)d_in[29]; p.ln3_g = (const float*)d_in[30]; p.ln3_b = (const float*)d_in[31];
    p.out = (float*)d_out;
    char* w = (char*)d_ws; size_t off = 0;
    auto alloc = [&](size_t bytes) { void* r = w + off; off += (bytes + 255) & ~(size_t)255; return r; };
    p.bar = (unsigned*)alloc(16384); p.cnt = (int*)alloc(DEPTH * 64 * 4);
    const size_t zero_bytes = off;
    p.X = (float*)alloc((size_t)T * D * 4); p.Z = (float*)alloc((size_t)T * D * 4); p.Xb = (bf16_t*)alloc((size_t)T * D * 2);
    p.cs = (float*)alloc((size_t)T * 32 * 4); p.sn = (float*)alloc((size_t)T * 32 * 4); p.ssq_q = (float*)alloc((size_t)4 * T * 4); p.ssq_kv = (float*)alloc((size_t)4 * T * 4);
    p.Hp = (bf16_t*)alloc((size_t)T * HW * 2); p.GVt = (bf16_t*)alloc((size_t)T * 512 * 2);
    p.Qb = (bf16_t*)alloc((size_t)T * 768 * 2); p.KnImg = (bf16_t*)alloc((size_t)T * 512 * 2); p.VtImg = (bf16_t*)alloc((size_t)T * 512 * 2); p.KrImg = (bf16_t*)alloc((size_t)T * 64 * 2);
    p.MLpart = (float*)alloc((size_t)512 * 256 * 2 * 4);
    p.QE = (bf16_t*)alloc((size_t)T * 256 * 2); p.OI = (float*)alloc((size_t)T * 512 * 4); p.kvT = (float*)alloc((size_t)1024 * 8192 * 4); p.decay = (float*)alloc((size_t)1024 * 64 * 4); p.spT = (bf16_t*)alloc((size_t)1024 * 8192 * 2);
    p.Yab = (bf16_t*)alloc((size_t)T * 512 * 2); p.Ybb = (bf16_t*)alloc((size_t)T * 512 * 2); p.Ycb = (bf16_t*)alloc((size_t)T * 512 * 2); p.Mgb = (bf16_t*)alloc((size_t)T * D * 2);
    p.ew = (float*)alloc((size_t)T * 2 * 4); p.lists = (int*)alloc((size_t)NE * LCAP * 4);
    p.Hbuf = (bf16_t*)alloc((size_t)192 * 256 * EH * 2); p.Ys = (bf16_t*)alloc((size_t)2 * T * D * 2); p.Ub = (bf16_t*)alloc((size_t)T * D * 2); p.Pb = (bf16_t*)alloc((size_t)DEPTH * T * PLE * 2);
    p.Wb_in = (bf16_t*)alloc((size_t)HW * D * 2); p.Wb_gv = (bf16_t*)alloc((size_t)512 * D * 2); p.Wb_uq = (bf16_t*)alloc((size_t)768 * 256 * 2); p.Wb_uk = (bf16_t*)alloc((size_t)512 * 256 * 2); p.Wb_uv = (bf16_t*)alloc((size_t)512 * 256 * 2);
    p.Wb_br = (bf16_t*)alloc((size_t)3 * D * 512 * 2); p.Wb_o = (bf16_t*)alloc((size_t)D * D * 2); p.Wb_gu = (bf16_t*)alloc((size_t)NE * 512 * D * 2); p.Wb_d = (bf16_t*)alloc((size_t)NE * D * EH * 2);
    p.Wb_pg = (bf16_t*)alloc((size_t)D * D * 2); p.Wb_pu = (bf16_t*)alloc((size_t)D * PLE * 2);
    if (off > ws_size) return;
    (void)hipMemsetAsync(d_ws, 0, zero_bytes, st);
#if defined(MULTI_LAUNCH)
    launch_ph<PH_PRO>(p, 0, st);
    for (int i = 0; i < DEPTH; ++i) {
        launch_ph<PH_CONV>(p, i, st); launch_ph<PH_IN>(p, i, st);
        launch_ph<PH_PREP_Q>(p, i, st); launch_ph<PH_PREP_K>(p, i, st); launch_ph<PH_PREP_V>(p, i, st); launch_ph<PH_PREP_G>(p, i, st);
        launch_ph<PH_ATT>(p, i, st); launch_ph<PH_FIN>(p, i, st); launch_ph<PH_BR>(p, i, st); launch_ph<PH_WO>(p, i, st); launch_ph<PH_LN1>(p, i, st);
        launch_ph<PH_M1>(p, i, st); launch_ph<PH_M2>(p, i, st); launch_ph<PH_LN2>(p, i, st); launch_ph<PH_PLE>(p, i, st); launch_ph<PH_LN3>(p, i, st);
    }
#else
    static bool set = false;
    if (!set) { (void)hipFuncSetAttribute((const void*)k_mega, hipFuncAttributeMaxDynamicSharedMemorySize, LDS_BYTES); set = true; }
    hipLaunchKernelGGL(k_mega, dim3(NBLK), dim3(NTHR), LDS_BYTES, st, p);
#endif
}
```

```cpp
#include <hip/hip_runtime.h>
#include <hip/hip_bf16.h>
#include <stdint.h>

constexpr int T = 16384, D = 1024, DEPTH = 4, PLE = 256;
constexpr int NE = 64, EH = 256;
constexpr int INW = 6608;
constexpr int O_GV = 2048;
constexpr float DN_ALPHA = 1.681792830507429f;
constexpr int LCAP = 32768;
#define LAS __attribute__((address_space(3)))
typedef unsigned short bf16_t;
typedef short bf16x8 __attribute__((ext_vector_type(8)));
typedef float f32x4 __attribute__((ext_vector_type(4)));
typedef float f32x16 __attribute__((ext_vector_type(16)));
typedef unsigned u32x4 __attribute__((ext_vector_type(4)));
typedef unsigned u32x2 __attribute__((ext_vector_type(2)));
constexpr int NBLK = 256, NTHR = 512;
constexpr int STAGE_BYTES = 131072, LDS_BYTES = 147456 + 512, XBW_OFF = 147456 + 256;
constexpr int HW = 6144;
constexpr int H_AB = 0, H_AC = 512, H_AX = 1024, H_GQ = 1536, H_GK = 1792, H_GR = 2048, H_CQ = 2560, H_CKV = 2816, H_KR = 2944, H_GLR = 3008, H_GTA = 3072, H_GTB = 4096, H_GTC = 5120;

__device__ __forceinline__ unsigned cvt_pk_bf16(float lo, float hi) { unsigned r; asm volatile("v_cvt_pk_bf16_f32 %0, %1, %2" : "=v"(r) : "v"(lo), "v"(hi)); return r; }
constexpr int WTAB_OFF = 147456;
__device__ __forceinline__ int tid_now() {
    const unsigned hw = (unsigned)__builtin_amdgcn_s_getreg((5 << 11) | 4) & 63u;
    extern __shared__ __attribute__((aligned(16))) unsigned char smem_tid[];
    const int w = __builtin_amdgcn_readfirstlane(*(volatile LAS int*)((LAS unsigned char*)smem_tid + WTAB_OFF + 4 * hw));
    int l = (int)__builtin_amdgcn_mbcnt_hi(~0u, __builtin_amdgcn_mbcnt_lo(~0u, 0u));
    asm volatile("" : "+v"(l));
    return w * 64 + l; }
__device__ __forceinline__ void tid_setup() {
    const unsigned hw = (unsigned)__builtin_amdgcn_s_getreg((5 << 11) | 4) & 63u;
    extern __shared__ __attribute__((aligned(16))) unsigned char smem_tid[];
    if ((threadIdx.x & 63) == 0) *(volatile LAS int*)((LAS unsigned char*)smem_tid + WTAB_OFF + 4 * hw) = (int)(threadIdx.x >> 6);
    __syncthreads(); }
__device__ __forceinline__ int sgpr_now(int v) { asm volatile("" : "+s"(v)); return v; }
__device__ __forceinline__ float shx(float v, int mask, int lane) { return __int_as_float(__builtin_amdgcn_ds_bpermute((lane ^ mask) << 2, __float_as_int(v))); }
__device__ __forceinline__ float bf2f(bf16_t b) { return __uint_as_float(((unsigned)b) << 16); }
__device__ __forceinline__ float bflo(unsigned w) { return __uint_as_float(w << 16); }
__device__ __forceinline__ float bfhi(unsigned w) { return __uint_as_float(w & 0xffff0000u); }

namespace ge {
constexpr int BM = 256, BK = 64, HALF = 128, HTB = HALF * BK * 2;
__device__ __forceinline__ int lds_byte(int r, int c) { const int st = (r >> 4) * 2 + (c >> 5), rr = r & 15, cc = c & 31, ob = rr * 64 + cc * 2; return st * 1024 + (ob ^ (((ob >> 9) & 1) << 5)); }
__device__ __forceinline__ void stage_rc(int b, int& R, int& C) { const int st = b / 1024, sb = b % 1024, swz = sb ^ (((sb >> 9) & 1) << 5); R = (st >> 1) * 16 + swz / 64; C = (st & 1) * 32 + (swz % 64) / 2; }
__device__ __forceinline__ int perm32(int rho) { const int n = rho >> 4, i = rho & 15; return 8 * (i >> 2) + 4 * n + (i & 3); }
struct Unit { int pm, pn, g; };
typedef f32x4 Acc[2][2][4][2];
struct NoCarry { __device__ __forceinline__ bool carry(const struct Unit&) const { return false; } };

template <class Epi, class Sched, bool GATHER>
__device__ __forceinline__ void gemm_stream(LAS unsigned char* lds, const int K, const int lda, const int ldb, const Sched& S, const Epi& E) {
    const int tid = tid_now(), wid = __builtin_amdgcn_readfirstlane(tid >> 6), lane = tid & 63, wr = wid >> 2, wc = wid & 3, fr = lane & 15, fq = lane >> 4;
    const int nt = K / BK;
    Unit cur, nxt; int ui = 0;
    if (!S.next(0, cur)) return;
    unsigned voffA[2][2], nvoffA[2][2], voffB[2][2];
#pragma unroll
    for (int i = 0; i < 2; ++i) { int R, C; stage_rc(tid * 16 + i * 8192, R, C); const int Rb = (R & ~31) + perm32(R & 31);
        voffB[0][i] = (unsigned)(Rb * ldb + C) * 2u; voffB[1][i] = (unsigned)((Rb + 128) * ldb + C) * 2u;
        if constexpr (GATHER) { voffA[0][i] = (unsigned)(S.arow(cur, R) * lda + C) * 2u; voffA[1][i] = (unsigned)(S.arow(cur, R + 128) * lda + C) * 2u; }
        else { voffA[0][i] = (unsigned)(R * lda + C) * 2u; voffA[1][i] = (unsigned)((R + 128) * lda + C) * 2u; }
        nvoffA[0][i] = voffA[0][i]; nvoffA[1][i] = voffA[1][i]; }
    const size_t kstep = (size_t)(BK * 2);
    const unsigned ldsw = (unsigned)wid * 1024u;
    const int aoff = lds_byte(wr * 64 + fr, fq * 8), boff = lds_byte(wc * 32 + fr, fq * 8);
#define GE_SA(b, h) (((b) * 2 + (h)) * HTB)
#define GE_SB(b, h) ((4 + (b) * 2 + (h)) * HTB)
#define GE_STAGE(bufoff, gbase, voff) do { _Pragma("unroll") for (int _i = 0; _i < 2; ++_i) \
        __builtin_amdgcn_global_load_lds((const unsigned*)((const char*)(gbase) + (voff)[_i]), (LAS unsigned*)(lds + (bufoff) + ldsw + _i * 8192), 16, 0, 0); } while (0)
#define GE_LDA(dst, b, h) do { _Pragma("unroll") for (int m = 0; m < 4; ++m) _Pragma("unroll") for (int k = 0; k < 2; ++k) dst[m][k] = *(const LAS bf16x8*)(lds + GE_SA(b, h) + aoff + m * 2048 + k * 1024); } while (0)
#define GE_LDB(dst, b, h) do { _Pragma("unroll") for (int n = 0; n < 2; ++n) _Pragma("unroll") for (int k = 0; k < 2; ++k) dst[n][k] = *(const LAS bf16x8*)(lds + GE_SB(b, h) + boff + n * 2048 + k * 1024); } while (0)
#define GE_MMA(ai, bj, At, Bt) do { __builtin_amdgcn_s_setprio(1); _Pragma("unroll") for (int m = 0; m < 4; ++m) _Pragma("unroll") for (int n = 0; n < 2; ++n) _Pragma("unroll") for (int k = 0; k < 2; ++k) \
        acc[ai][bj][m][n] = __builtin_amdgcn_mfma_f32_16x16x32_bf16(Bt[n][k], At[m][k], acc[ai][bj][m][n], 0, 0, 0); __builtin_amdgcn_s_setprio(0); } while (0)
#define GE_WAIT_V(n) asm volatile("s_waitcnt vmcnt(" #n ")" ::: "memory")
#define GE_WAIT_L(n) asm volatile("s_waitcnt lgkmcnt(" #n ")" ::: "memory")
#define GE_BAR __builtin_amdgcn_s_barrier()
#define GE_SCHED __builtin_amdgcn_sched_barrier(0)
    Acc acc;
#pragma unroll
    for (int a = 0; a < 2; ++a)
#pragma unroll
        for (int b = 0; b < 2; ++b)
#pragma unroll
            for (int m = 0; m < 4; ++m)
#pragma unroll
                for (int n = 0; n < 2; ++n) acc[a][b][m][n] = (f32x4){0.f, 0.f, 0.f, 0.f};
    bf16x8 At[4][2], B0[2][2], B1[2][2];
    const char* cA = S.aptr(cur); const char* cB = S.bptr(cur);
    GE_STAGE(GE_SB(0, 0), cB, voffB[0]); GE_STAGE(GE_SA(0, 0), cA, voffA[0]); GE_STAGE(GE_SB(0, 1), cB, voffB[1]); GE_STAGE(GE_SA(0, 1), cA, voffA[1]);
    if (wr == 1) GE_BAR;
    GE_WAIT_V(4); GE_BAR;
    GE_STAGE(GE_SB(1, 0), cB + kstep, voffB[0]); GE_STAGE(GE_SA(1, 0), cA + kstep, voffA[0]); GE_STAGE(GE_SB(1, 1), cB + kstep, voffB[1]);
    GE_WAIT_V(6); GE_BAR;
    for (;;) {
        const bool has_next = S.next(ui + 1, nxt);
        const char* nA = has_next ? S.aptr(nxt) : cA; const char* nB = has_next ? S.bptr(nxt) : cB;
#pragma unroll 1
        for (int t = 0; t < nt; t += 2) {
            const bool last = (t == nt - 2);
            const char* a1 = cA + (size_t)(t + 1) * kstep;
            const char* a2 = last ? nA : cA + (size_t)(t + 2) * kstep; const char* b2 = last ? nB : cB + (size_t)(t + 2) * kstep;
            const char* a3 = a2 + kstep; const char* b3 = b2 + kstep;
            if constexpr (GATHER) { if (last && has_next) {
#pragma unroll
                for (int i = 0; i < 2; ++i) { int R, C; stage_rc(tid * 16 + i * 8192, R, C);
                    nvoffA[0][i] = (unsigned)(S.arow(nxt, R) * lda + C) * 2u; nvoffA[1][i] = (unsigned)(S.arow(nxt, R + 128) * lda + C) * 2u; } } }
            unsigned va2[2][2];
#pragma unroll
            for (int h = 0; h < 2; ++h)
#pragma unroll
                for (int i = 0; i < 2; ++i) va2[h][i] = (GATHER && last) ? nvoffA[h][i] : voffA[h][i];
            GE_LDB(B0, 0, 0); GE_SCHED; GE_LDA(At, 0, 0); GE_STAGE(GE_SA(1, 1), a1, voffA[1]);
            GE_WAIT_L(8); GE_BAR; GE_WAIT_L(0); GE_MMA(0, 0, At, B0); GE_BAR; GE_SCHED;
            GE_LDB(B1, 0, 1); GE_STAGE(GE_SB(0, 0), b2, voffB[0]);
            GE_BAR; GE_WAIT_L(0); GE_MMA(0, 1, At, B1); GE_BAR;
            GE_LDA(At, 0, 1); GE_STAGE(GE_SA(0, 0), a2, va2[0]);
            GE_BAR; GE_WAIT_L(0); GE_MMA(1, 0, At, B0); GE_BAR; GE_SCHED;
            GE_STAGE(GE_SB(0, 1), b2, voffB[1]);
            GE_WAIT_V(6); GE_BAR; GE_MMA(1, 1, At, B1); GE_BAR;
            GE_LDB(B0, 1, 0); GE_SCHED; GE_LDA(At, 1, 0); GE_STAGE(GE_SA(0, 1), a2, va2[1]);
            GE_WAIT_L(8); GE_BAR; GE_WAIT_L(0); GE_MMA(0, 0, At, B0); GE_BAR; GE_SCHED;
            GE_LDB(B1, 1, 1); GE_STAGE(GE_SB(1, 0), b3, voffB[0]);
            GE_BAR; GE_WAIT_L(0); GE_MMA(0, 1, At, B1); GE_BAR;
            GE_LDA(At, 1, 1); GE_STAGE(GE_SA(1, 0), a3, va2[0]);
            GE_BAR; GE_WAIT_L(0); GE_MMA(1, 0, At, B0); GE_BAR; GE_SCHED;
            GE_STAGE(GE_SB(1, 1), b3, voffB[1]);
            GE_WAIT_V(6); GE_BAR; GE_MMA(1, 1, At, B1); GE_BAR;
        }
        { int tz = tid; asm volatile("" : "+v"(tz));
          const int wid2 = tz >> 6, lane2 = tz & 63; E(acc, cur, wid2 >> 2, wid2 & 3, lane2 & 15, lane2 >> 4); }
        if (!has_next) break;
        if (!S.carry(cur)) {
#pragma unroll
        for (int a = 0; a < 2; ++a)
#pragma unroll
            for (int b = 0; b < 2; ++b)
#pragma unroll
                for (int m = 0; m < 4; ++m)
#pragma unroll
                    for (int n = 0; n < 2; ++n) acc[a][b][m][n] = (f32x4){0.f, 0.f, 0.f, 0.f}; }
        cur = nxt; cA = nA; cB = nB; ++ui;
        if (GATHER) {
#pragma unroll
            for (int h = 0; h < 2; ++h)
#pragma unroll
                for (int i = 0; i < 2; ++i) voffA[h][i] = nvoffA[h][i]; }
    }
    GE_WAIT_V(0);
    if (wr == 0) GE_BAR;
    GE_BAR;
#undef GE_SA
#undef GE_SB
#undef GE_STAGE
#undef GE_LDA
#undef GE_LDB
#undef GE_MMA
#undef GE_WAIT_V
#undef GE_WAIT_L
#undef GE_BAR
#undef GE_SCHED
}
__device__ __forceinline__ void tile_order(int L, int nM, int nN, int& pm, int& pn) {
    const int nwg = nM * nN; int wgid = L;
    { const int q = nwg / 8, r = nwg % 8, xcd = wgid % 8, off = wgid / 8; wgid = (xcd < r ? xcd * (q + 1) : r * (q + 1) + (xcd - r) * q) + off; }
    const int nig = 8 * nN, gid = wgid / nig, fm = gid * 8, gsz = (nM - fm) < 8 ? (nM - fm) : 8;
    pm = fm + ((wgid % nig) % gsz); pn = (wgid % nig) / gsz;
}
}
struct MapInMain { __device__ __forceinline__ int operator()(int s) const {
    if (s < 2048) return s;
    if (s < 2560) return 2576 + (s - 2048);
    if (s < 2816) return 3088 + (s - 2560);
    if (s < 2944) return 3344 + (s - 2816);
    if (s < 3008) return 3472 + (s - 2944);
    if (s < 3024) return 2560 + (s - 3008);
    if (s < 3072) return -1;
    return 3536 + (s - 3072); } };
struct MapOff { int off; __device__ __forceinline__ int operator()(int s) const { return off + s; } };struct MegaP {
    const float* w_in; bf16_t* Wb_in; bf16_t* Wb_gv; const bf16_t* Xb; bf16_t* Hp; bf16_t* GVt; float* ssq_q; float* ssq_kv;
};
struct SchedIn : ge::NoCarry {
    const char* Xb; const char* Wm; const char* Wg; int c, G, gv;
    __device__ __forceinline__ bool next(int i, ge::Unit& u) const {
        const int L = i * G + c;
        if (gv) { if (L >= 128) return false; u.g = 0; u.pm = L >> 1; u.pn = 8 + (L & 1); return true; }
        if (L >= 1536) return false;
        if (L < 1408) { u.g = 0; ge::tile_order(L, 64, 22, u.pm, u.pn); if (u.pn >= 8) u.pn += 2; } else { u.g = 1; const int l = L - 1408; u.pm = l & 1; u.pn = l >> 1; }
        return true; }
    __device__ __forceinline__ const char* aptr(const ge::Unit& u) const { return u.g == 0 ? Xb + (size_t)u.pm * 256 * D * 2 : Wg + (size_t)u.pm * 256 * D * 2; }
    __device__ __forceinline__ const char* bptr(const ge::Unit& u) const { return u.g == 0 ? Wm + (size_t)u.pn * 256 * D * 2 : Xb + (size_t)u.pn * 256 * D * 2; }
};
template <int GV> struct EpiIn {
    bf16_t* Hp; bf16_t* GVt; float* ssq_q; float* ssq_kv;
    __device__ __forceinline__ void operator()(ge::Acc& acc, const ge::Unit& u, int wr, int wc, int fr, int fq) const {
        if (GV == 0 || (GV == 2 && u.g == 0)) {
            const int row0 = u.pm * 256 + wr * 64 + fr, col0 = u.pn * 256 + wc * 32 + 8 * fq;
            const bool sg = u.pn >= 12;
#pragma unroll
            for (int ai = 0; ai < 2; ++ai)
#pragma unroll
                for (int m = 0; m < 4; ++m) { const int row = row0 + ai * 128 + m * 16; bf16_t* rp = Hp + (size_t)row * HW + col0;
                    float sq0 = 0.f, sq1 = 0.f;
#pragma unroll
                    for (int bj = 0; bj < 2; ++bj) { f32x4 v0 = acc[ai][bj][m][0], v1 = acc[ai][bj][m][1];
                        if (sg) {
#pragma unroll
                            for (int j = 0; j < 4; ++j) { v0[j] = 1.f / (1.f + __expf(-v0[j])); v1[j] = 1.f / (1.f + __expf(-v1[j])); } }
                        const float s = v0[0] * v0[0] + v0[1] * v0[1] + v0[2] * v0[2] + v0[3] * v0[3] + v1[0] * v1[0] + v1[1] * v1[1] + v1[2] * v1[2] + v1[3] * v1[3];
                        if (bj == 0) sq0 = s; else sq1 = s;
                        u32x4 o = {cvt_pk_bf16(v0[0], v0[1]), cvt_pk_bf16(v0[2], v0[3]), cvt_pk_bf16(v1[0], v1[1]), cvt_pk_bf16(v1[2], v1[3])};
                        *(u32x4*)(rp + bj * 128) = o; }
                    if (u.pn == 10 || u.pn == 11) {
                        float s = (u.pn == 10) ? (sq0 + sq1) : sq0;
                        { const int ln = fq * 16 + fr; s += shx(s, 16, ln); s += shx(s, 32, ln); }
                        if (fq == 0) { float* dst = (u.pn == 10 ? ssq_q : ssq_kv); dst[(size_t)wc * T + row] = s; } } }
        } else {
#pragma unroll
            for (int ai = 0; ai < 2; ++ai)
#pragma unroll
                for (int m = 0; m < 4; ++m) { const int r = u.pm * 256 + ai * 128 + wr * 64 + m * 16 + fr, h = r >> 7, e = r & 127;
#pragma unroll
                    for (int bj = 0; bj < 2; ++bj) { const int t0 = u.pn * 256 + bj * 128 + wc * 32 + 8 * fq;
                        const int chunk = t0 >> 6, p0 = (t0 & 48) + ((t0 & 8) >> 1);
                        bf16_t* base = GVt + ((size_t)(chunk * 4 + h) * 128 + e) * 64;
                        const f32x4 v0 = acc[ai][bj][m][0], v1 = acc[ai][bj][m][1];
                        u32x2 o0 = {cvt_pk_bf16(v0[0], v0[1]), cvt_pk_bf16(v0[2], v0[3])}, o1 = {cvt_pk_bf16(v1[0], v1[1]), cvt_pk_bf16(v1[2], v1[3])};
                        *(u32x2*)(base + p0) = o0; *(u32x2*)(base + p0 + 8) = o1; } }
        }
    }
};
constexpr float QSCALE = 0.07216878364870322f * 1.4426950408889634f;
struct MapQ { __device__ __forceinline__ int operator()(int s) const {
    if (s < 512) return (s >> 7) * 192 + (s & 127);
    const int s2 = s - 512, bj = s2 >> 7, w = s2 & 127; return (w >> 5) * 192 + 128 + bj * 32 + (w & 31); } };
struct MapKV { int voff; __device__ __forceinline__ int operator()(int s) const { return (s >> 7) * 256 + voff + (s & 127); } };

struct MlaP {
    const float* w_uq; const float* w_ukv; const float* qn_g; const float* kvn_g;
    bf16_t* Wb_uq; bf16_t* Wb_uk; bf16_t* Wb_uv;
    const bf16_t* Hp; const float* ssq_q; const float* ssq_kv; const float* cs; const float* sn;
    bf16_t* Qb; bf16_t* KnImg; bf16_t* VtImg; bf16_t* KrImg; float* Opart; float* MLpart; float* Yc;
};
__device__ __forceinline__ float rstd4(const float* ssq, int row, float invw) {
    const float s = (ssq[row] + ssq[T + row]) + (ssq[2 * T + row] + ssq[3 * T + row]); return rsqrtf(s * invw + 1e-6f); }

template <int mode> struct SchedMla : ge::NoCarry { const char* A; const char* B; int c, G;
    __device__ __forceinline__ bool next(int i, ge::Unit& u) const {
        if (c < 0) return false;
        const int L = i * G + c; u.g = mode;
        if (mode == 0) { if (L >= 192) return false; u.pm = L / 3; u.pn = L % 3; }
        else if (mode == 1) { if (L >= 128) return false; u.pm = L >> 1; u.pn = L & 1; }
        else { if (L >= 128) return false; u.pm = L & 1; u.pn = L >> 1; }
        return true; }
    __device__ __forceinline__ const char* aptr(const ge::Unit& u) const { return mode == 2 ? A + (size_t)u.pm * 256 * 256 * 2 : A + (size_t)u.pm * 256 * HW * 2; }
    __device__ __forceinline__ const char* bptr(const ge::Unit& u) const { return mode == 2 ? B + (size_t)u.pn * 256 * HW * 2 : B + (size_t)u.pn * 256 * 256 * 2; }
};
template <int MODE> struct EpiMla { MlaP p;
    __device__ __forceinline__ void operator()(ge::Acc& acc, const ge::Unit& u, int wr, int wc, int fr, int fq) const {
        if constexpr (MODE == 0) {
#pragma unroll
            for (int ai = 0; ai < 2; ++ai)
#pragma unroll
                for (int m = 0; m < 4; ++m) { asm volatile("" ::: "memory"); const int t = u.pm * 256 + ai * 128 + wr * 64 + m * 16 + fr; const float rs = rstd4(p.ssq_q, t, 1.f / 256.f) * QSCALE;
                    if (u.pn < 2) {
#pragma unroll
                        for (int bj = 0; bj < 2; ++bj) { const int c0 = u.pn * 256 + bj * 128 + wc * 32 + 8 * fq, head = c0 >> 7, dim = c0 & 127;
                            const f32x4 v0 = acc[ai][bj][m][0] * rs, v1 = acc[ai][bj][m][1] * rs;
                            u32x4 o = {cvt_pk_bf16(v0[0], v0[1]), cvt_pk_bf16(v0[2], v0[3]), cvt_pk_bf16(v1[0], v1[1]), cvt_pk_bf16(v1[2], v1[3])};
                            *(u32x4*)(p.Qb + (size_t)t * 768 + head * 192 + dim) = o; }
                    } else { const int head = wc, i0 = 8 * fq;
                        float o1[8], o2[8];
#pragma unroll
                        for (int n = 0; n < 2; ++n) { const f32x4 c4 = *(const f32x4*)(p.cs + (size_t)t * 32 + i0 + 4 * n), s4 = *(const f32x4*)(p.sn + (size_t)t * 32 + i0 + 4 * n);
#pragma unroll
                            for (int j = 0; j < 4; ++j) { const float x1 = acc[ai][0][m][n][j] * rs, x2 = acc[ai][1][m][n][j] * rs; o1[4 * n + j] = x1 * c4[j] - x2 * s4[j]; o2[4 * n + j] = x1 * s4[j] + x2 * c4[j]; } }
                        u32x4 a = {cvt_pk_bf16(o1[0], o1[1]), cvt_pk_bf16(o1[2], o1[3]), cvt_pk_bf16(o1[4], o1[5]), cvt_pk_bf16(o1[6], o1[7])};
                        u32x4 b = {cvt_pk_bf16(o2[0], o2[1]), cvt_pk_bf16(o2[2], o2[3]), cvt_pk_bf16(o2[4], o2[5]), cvt_pk_bf16(o2[6], o2[7])};
                        *(u32x4*)(p.Qb + (size_t)t * 768 + head * 192 + 128 + i0) = a; *(u32x4*)(p.Qb + (size_t)t * 768 + head * 192 + 160 + i0) = b; } }
        } else if constexpr (MODE == 1) {
#pragma unroll
            for (int ai = 0; ai < 2; ++ai)
#pragma unroll
                for (int m = 0; m < 4; ++m) { asm volatile("" ::: "memory"); const int t = u.pm * 256 + ai * 128 + wr * 64 + m * 16 + fr; const float rs = rstd4(p.ssq_kv, t, 1.f / 128.f);
                    const int tile = t >> 6, key = t & 63;
#pragma unroll
                    for (int bj = 0; bj < 2; ++bj) { const int c0 = u.pn * 256 + bj * 128 + wc * 32 + 8 * fq, head = c0 >> 7, chunk = (c0 & 127) >> 3;
                        const f32x4 v0 = acc[ai][bj][m][0] * rs, v1 = acc[ai][bj][m][1] * rs;
                        u32x4 o = {cvt_pk_bf16(v0[0], v0[1]), cvt_pk_bf16(v0[2], v0[3]), cvt_pk_bf16(v1[0], v1[1]), cvt_pk_bf16(v1[2], v1[3])};
                        *(u32x4*)((char*)p.KnImg + ((size_t)(head * 256 + tile) * 16384) + key * 256 + ((chunk ^ (key & 15)) << 4)) = o; } }
        } else {
#pragma unroll
            for (int bj = 0; bj < 2; ++bj) { const int t0 = u.pn * 256 + bj * 128 + wc * 32 + 8 * fq;
                float rs[8];
#pragma unroll
                for (int j = 0; j < 8; ++j) rs[j] = rstd4(p.ssq_kv, t0 + j, 1.f / 128.f);
                const int tile = t0 >> 6, p0 = (t0 & 48) + ((t0 & 8) >> 1);
#pragma unroll
                for (int ai = 0; ai < 2; ++ai)
#pragma unroll
                    for (int m = 0; m < 4; ++m) { asm volatile("" ::: "memory"); const int r = u.pm * 256 + ai * 128 + wr * 64 + m * 16 + fr, head = r >> 7, d = r & 127;
                        char* base = (char*)p.VtImg + ((size_t)(head * 256 + tile) * 16384) + d * 128;
                        const f32x4 v0 = acc[ai][bj][m][0], v1 = acc[ai][bj][m][1];
                        u32x2 o0 = {cvt_pk_bf16(v0[0] * rs[0], v0[1] * rs[1]), cvt_pk_bf16(v0[2] * rs[2], v0[3] * rs[3])};
                        u32x2 o1 = {cvt_pk_bf16(v1[0] * rs[4], v1[1] * rs[5]), cvt_pk_bf16(v1[2] * rs[6], v1[3] * rs[7])};
                        const int sw = (d >> 1) & 7, pa = p0, pb = p0 + 8;
                        *(u32x2*)(base + (((pa >> 3) ^ sw) << 4) + (pa & 7) * 2) = o0;
                        *(u32x2*)(base + (((pb >> 3) ^ sw) << 4) + (pb & 7) * 2) = o1; } }
        }
    }
};
__device__ __forceinline__ void kr_phase(const MlaP& p, int gtid, int gthreads) {
    for (int idx = gtid; idx < T * 4; idx += gthreads) { const int t = idx >> 2, c = idx & 3, i0 = 8 * c;
        const u32x4 a = *(const u32x4*)(p.Hp + (size_t)t * HW + H_KR + i0), b = *(const u32x4*)(p.Hp + (size_t)t * HW + H_KR + 32 + i0);
        float o1[8], o2[8];
#pragma unroll
        for (int n = 0; n < 2; ++n) { const f32x4 c4 = *(const f32x4*)(p.cs + (size_t)t * 32 + i0 + 4 * n), s4 = *(const f32x4*)(p.sn + (size_t)t * 32 + i0 + 4 * n);
#pragma unroll
            for (int j = 0; j < 4; ++j) { const int e = 4 * n + j; const unsigned wa = a[e >> 1], wb = b[e >> 1];
                const float x1 = (e & 1) ? bfhi(wa) : bflo(wa), x2 = (e & 1) ? bfhi(wb) : bflo(wb);
                o1[e] = x1 * c4[j] - x2 * s4[j]; o2[e] = x1 * s4[j] + x2 * c4[j]; } }
        u32x4 oa = {cvt_pk_bf16(o1[0], o1[1]), cvt_pk_bf16(o1[2], o1[3]), cvt_pk_bf16(o1[4], o1[5]), cvt_pk_bf16(o1[6], o1[7])};
        u32x4 ob = {cvt_pk_bf16(o2[0], o2[1]), cvt_pk_bf16(o2[2], o2[3]), cvt_pk_bf16(o2[4], o2[5]), cvt_pk_bf16(o2[6], o2[7])};
        const int tile = t >> 6, key = t & 63, sw = (key >> 1) & 7;
        char* base = (char*)p.KrImg + (size_t)tile * 8192 + key * 128;
        *(u32x4*)(base + ((c ^ sw) << 4)) = oa; *(u32x4*)(base + (((c + 4) ^ sw) << 4)) = ob; }
}
constexpr int ATT_STEPS = 130;
__device__ __forceinline__ void attn_item(LAS unsigned char* lds, const MlaP& p, int head, int b, int j0, int j1, int slot) {
    const int tid = tid_now(), wid = __builtin_amdgcn_readfirstlane(tid >> 6), lane = tid & 63, q = lane & 31, hh = lane >> 5;
    const int trow = b * 256 + wid * 32 + q;
    bf16x8 qf[12];
    { const bf16_t* qp = p.Qb + (size_t)trow * 768 + head * 192 + 8 * hh;
#pragma unroll
      for (int s = 0; s < 12; ++s) qf[s] = *(const bf16x8*)(qp + 16 * s); }
    f32x16 O[4];
#pragma unroll
    for (int d = 0; d < 4; ++d)
#pragma unroll
        for (int r = 0; r < 16; ++r) O[d][r] = 0.f;
    float m_run = -1e30f, l_run = 0.f;
    const char* knb = (const char*)p.KnImg + (size_t)head * 256 * 16384; const char* vtb = (const char*)p.VtImg + (size_t)head * 256 * 16384; const char* krb = (const char*)p.KrImg;
    const unsigned lo = (unsigned)lane * 16u;
#define AT_ISSUE(j, bi) do { const unsigned _bo = (unsigned)(bi) * 40960u; \
        __builtin_amdgcn_global_load_lds((const unsigned*)(knb + (size_t)(j) * 16384 + (wid * 2) * 1024 + lo), (LAS unsigned*)(lds + _bo + (wid * 2) * 1024), 16, 0, 0); \
        __builtin_amdgcn_global_load_lds((const unsigned*)(knb + (size_t)(j) * 16384 + (wid * 2 + 1) * 1024 + lo), (LAS unsigned*)(lds + _bo + (wid * 2 + 1) * 1024), 16, 0, 0); \
        __builtin_amdgcn_global_load_lds((const unsigned*)(krb + (size_t)(j) * 8192 + wid * 1024 + lo), (LAS unsigned*)(lds + _bo + 16384 + wid * 1024), 16, 0, 0); \
        __builtin_amdgcn_global_load_lds((const unsigned*)(vtb + (size_t)(j) * 16384 + (wid * 2) * 1024 + lo), (LAS unsigned*)(lds + _bo + 24576 + (wid * 2) * 1024), 16, 0, 0); \
        __builtin_amdgcn_global_load_lds((const unsigned*)(vtb + (size_t)(j) * 16384 + (wid * 2 + 1) * 1024 + lo), (LAS unsigned*)(lds + _bo + 24576 + (wid * 2 + 1) * 1024), 16, 0, 0); } while (0)
    const int kn_off0 = q * 256, kn_sw = q & 15, kr_off0 = q * 128, kr_sw = (q >> 1) & 7;
    const int vt_sw = (q >> 1) & 7;
    constexpr float THR = 8.f;
    AT_ISSUE(j0, 0);
    if (j0 + 1 < j1) AT_ISSUE(j0 + 1, 1);
    bool first = true;
    for (int j = j0; j < j1; ++j) {
        const int cur = (j - j0) % 3;
        if (j + 1 < j1) asm volatile("s_waitcnt vmcnt(5)" ::: "memory"); else asm volatile("s_waitcnt vmcnt(0)" ::: "memory");
        __builtin_amdgcn_s_barrier(); asm volatile("" ::: "memory");
        if (j + 2 < j1) AT_ISSUE(j + 2, (j + 2 - j0) % 3);
        const int jj = j - 4 * b;
        if (!(jj >= 0 && 64 * jj > 32 * wid + 31)) {
            LAS unsigned char* bb = lds + cur * 40960;
            const float mref = first ? 0.f : m_run;
            f32x16 S0, S1;
#pragma unroll
            for (int r = 0; r < 16; ++r) { S0[r] = -mref; S1[r] = -mref; }
#pragma unroll
            for (int s = 0; s < 8; ++s) {
                const bf16x8 k0 = *(const LAS bf16x8*)(bb + kn_off0 + (((2 * s + hh) ^ kn_sw) << 4));
                const bf16x8 k1 = *(const LAS bf16x8*)(bb + 8192 + kn_off0 + (((2 * s + hh) ^ kn_sw) << 4));
                S0 = __builtin_amdgcn_mfma_f32_32x32x16_bf16(k0, qf[s], S0, 0, 0, 0);
                S1 = __builtin_amdgcn_mfma_f32_32x32x16_bf16(k1, qf[s], S1, 0, 0, 0); }
#pragma unroll
            for (int s = 0; s < 4; ++s) {
                const bf16x8 k0 = *(const LAS bf16x8*)(bb + 16384 + kr_off0 + (((2 * s + hh) ^ kr_sw) << 4));
                const bf16x8 k1 = *(const LAS bf16x8*)(bb + 16384 + 4096 + kr_off0 + (((2 * s + hh) ^ kr_sw) << 4));
                S0 = __builtin_amdgcn_mfma_f32_32x32x16_bf16(k0, qf[8 + s], S0, 0, 0, 0);
                S1 = __builtin_amdgcn_mfma_f32_32x32x16_bf16(k1, qf[8 + s], S1, 0, 0, 0); }
            if (jj >= 0) {
                const int dq = wid * 32 + q - 64 * jj - 4 * hh;
                const float NEG = -__builtin_inff();
#pragma unroll
                for (int r = 0; r < 16; ++r) { const int c = (r & 3) + 8 * (r >> 2);
                    if (c > dq) S0[r] = NEG;
                    if (c + 32 > dq) S1[r] = NEG; } }
            float mx = S0[0];
#pragma unroll
            for (int r = 1; r < 16; ++r) mx = fmaxf(mx, S0[r]);
#pragma unroll
            for (int r = 0; r < 16; ++r) mx = fmaxf(mx, S1[r]);
            { auto rr = __builtin_amdgcn_permlane32_swap(__float_as_uint(mx), __float_as_uint(mx), false, false); mx = fmaxf(__uint_as_float(rr[0]), __uint_as_float(rr[1])); }
            float alpha = 1.f;
            if (first || !__all(mx <= THR)) {
                const float mn = fmaxf(m_run, mref + mx), sh = mn - mref;
                alpha = __builtin_amdgcn_exp2f(m_run - mn); m_run = mn;
#pragma unroll
                for (int r = 0; r < 16; ++r) { S0[r] -= sh; S1[r] -= sh; }
#pragma unroll
                for (int d = 0; d < 4; ++d)
#pragma unroll
                    for (int r = 0; r < 16; ++r) O[d][r] *= alpha;
                first = false;
            }
            float sum = 0.f;
#pragma unroll
            for (int r = 0; r < 16; ++r) { S0[r] = __builtin_amdgcn_exp2f(S0[r]); S1[r] = __builtin_amdgcn_exp2f(S1[r]); sum += S0[r] + S1[r]; }
            l_run = l_run * alpha + sum;
            bf16x8 pf[4];
#pragma unroll
            for (int h2 = 0; h2 < 2; ++h2) {
                u32x4 a = {cvt_pk_bf16(S0[8 * h2 + 0], S0[8 * h2 + 1]), cvt_pk_bf16(S0[8 * h2 + 2], S0[8 * h2 + 3]), cvt_pk_bf16(S0[8 * h2 + 4], S0[8 * h2 + 5]), cvt_pk_bf16(S0[8 * h2 + 6], S0[8 * h2 + 7])};
                u32x4 c = {cvt_pk_bf16(S1[8 * h2 + 0], S1[8 * h2 + 1]), cvt_pk_bf16(S1[8 * h2 + 2], S1[8 * h2 + 3]), cvt_pk_bf16(S1[8 * h2 + 4], S1[8 * h2 + 5]), cvt_pk_bf16(S1[8 * h2 + 6], S1[8 * h2 + 7])};
                pf[h2] = *(bf16x8*)&a; pf[2 + h2] = *(bf16x8*)&c; }
#pragma unroll
            for (int d = 0; d < 4; ++d) {
#pragma unroll
                for (int s2 = 0; s2 < 4; ++s2) {
                    const bf16x8 vf = *(const LAS bf16x8*)(bb + 24576 + (d * 32 + q) * 128 + (((2 * s2 + hh) ^ vt_sw) << 4));
                    O[d] = __builtin_amdgcn_mfma_f32_32x32x16_bf16(vf, pf[s2], O[d], 0, 0, 0); } }
        }
    }
    asm volatile("" ::: "memory"); __builtin_amdgcn_s_barrier(); asm volatile("" ::: "memory");
#undef AT_ISSUE
    { auto rr = __builtin_amdgcn_permlane32_swap(__float_as_uint(l_run), __float_as_uint(l_run), false, false); l_run = __uint_as_float(rr[0]) + __uint_as_float(rr[1]); }
    bf16_t* op = (bf16_t*)p.Opart + ((size_t)slot * 256 + wid * 32 + q) * 128 + 4 * hh;
#pragma unroll
    for (int d = 0; d < 4; ++d)
#pragma unroll
        for (int g = 0; g < 4; ++g) { u32x2 v = {cvt_pk_bf16(O[d][4 * g], O[d][4 * g + 1]), cvt_pk_bf16(O[d][4 * g + 2], O[d][4 * g + 3])}; *(u32x2*)(op + d * 32 + g * 8) = v; }
    if (hh == 0) { float* ml = p.MLpart + ((size_t)slot * 256 + wid * 32 + q) * 2; ml[0] = m_run; ml[1] = l_run; }
}
__device__ __forceinline__ void attn_phase(LAS unsigned char* lds, const MlaP& p, int c) {
    int L = ATT_STEPS * c; const int Lend = L + ATT_STEPS;
    while (L < Lend) {
        const int head = L / 8320, rem = L - head * 8320;
        int b = (int)((sqrtf(1.f + 2.f * (float)rem) - 1.f) * 0.5f);
        while (2 * b * (b + 1) > rem) --b;
        while (2 * (b + 1) * (b + 2) <= rem) ++b;
        const int j0 = rem - 2 * b * (b + 1), nt = 4 * (b + 1);
        const int j1 = min(nt, j0 + (Lend - L));
        attn_item(lds, p, head, b, j0, j1, head * 64 + b + c);
        L += j1 - j0;
    }
}
struct GlaP {
    const bf16_t* Hp; const bf16_t* GVt; const float* wg; const float* bg; const float* ng; const float* wconv;
    bf16_t* QE; float* OI; float* kvT; float* decay; bf16_t* spT; bf16_t* Yab; bf16_t* Ybb; bf16_t* Ycb;
    const float* Opart; const float* MLpart;
};
__device__ __forceinline__ int pos16(int i) { return (i & 48) | ((i & 4) << 1) | ((i & 8) >> 1) | (i & 3); }
__device__ __forceinline__ void gla_g1(LAS unsigned char* lds, const GlaP& p, int c, int G) {
    const int tid = tid_now(), wid = __builtin_amdgcn_readfirstlane(tid >> 6), lane = tid & 63, l31 = lane & 31, hh = lane >> 5;
    LAS float* bsm = (LAS float*)lds; LAS float* gtot = (LAS float*)(lds + 17408); LAS float* blast = (LAS float*)(lds + 19456);
    LAS unsigned char* qeL = lds + 20480; LAS unsigned char* keL = lds + 28672; LAS unsigned char* ktL = lds + 36864;
    const int eb = wid & 3, hb = wid >> 2;
    for (int u = c; u < 1024; u += G) {
        const int n = u >> 2, h = u & 3;
        bf16x8 vf[4];
        { const bf16_t* vp = p.GVt + ((size_t)u * 128 + eb * 32 + l31) * 64 + 8 * hh;
#pragma unroll
          for (int s4 = 0; s4 < 4; ++s4) vf[s4] = *(const bf16x8*)(vp + 16 * s4); }
        { const int d = tid & 63, g = tid >> 6;
          float w[16];
#pragma unroll
          for (int r = 0; r < 16; ++r) w[r] = p.wg[r * 256 + h * 64 + d];
          const float bias = p.bg[h * 64 + d];
          float cs[8]; float run = 0.f;
#pragma unroll
          for (int k = 0; k < 8; ++k) { const int i = 8 * g + k;
              const u32x4 g0 = *(const u32x4*)(p.Hp + (size_t)(64 * n + i) * HW + H_GLR), g1 = *(const u32x4*)(p.Hp + (size_t)(64 * n + i) * HW + H_GLR + 8);
              float la = bias;
#pragma unroll
              for (int r = 0; r < 4; ++r) { la += bflo(g0[r]) * w[2 * r] + bfhi(g0[r]) * w[2 * r + 1]; la += bflo(g1[r]) * w[8 + 2 * r] + bfhi(g1[r]) * w[8 + 2 * r + 1]; }
              const float ls = (fminf(la, 0.f) - log1pf(expf(-fabsf(la)))) * (1.f / 16.f);
              run += ls; cs[k] = run; }
          gtot[g * 64 + d] = run;
          __syncthreads();
          float pre = 0.f, tot = 0.f;
#pragma unroll
          for (int gg = 0; gg < 8; ++gg) { const float v = gtot[gg * 64 + d]; tot += v; if (gg < g) pre += v; }
#pragma unroll
          for (int k = 0; k < 8; ++k) bsm[(8 * g + k) * 68 + d] = pre + cs[k];
          if (g == 0) { blast[d] = tot; p.decay[(size_t)u * 64 + d] = expf(tot); } }
        __syncthreads();
        { const int i = tid >> 3, cc = tid & 7, d0 = 8 * cc; const size_t t = (size_t)64 * n + i;
          const u32x4 qv = *(const u32x4*)(p.Hp + t * HW + H_GQ + h * 64 + d0), kv = *(const u32x4*)(p.Hp + t * HW + H_GK + h * 64 + d0);
          float b[8], bl[8];
          { const f32x4 b0 = *(const LAS f32x4*)(bsm + i * 68 + d0), b1 = *(const LAS f32x4*)(bsm + i * 68 + d0 + 4), l0 = *(const LAS f32x4*)(blast + d0), l1 = *(const LAS f32x4*)(blast + d0 + 4);
#pragma unroll
            for (int j = 0; j < 4; ++j) { b[j] = b0[j]; b[4 + j] = b1[j]; bl[j] = l0[j]; bl[4 + j] = l1[j]; } }
          float qe[8], ke[8], kt[8];
#pragma unroll
          for (int j = 0; j < 8; ++j) { const float qq = (j & 1) ? bfhi(qv[j >> 1]) : bflo(qv[j >> 1]), kk = (j & 1) ? bfhi(kv[j >> 1]) : bflo(kv[j >> 1]);
              qe[j] = qq * 0.125f * expf(b[j]); ke[j] = kk * expf(-b[j]); kt[j] = kk * expf(bl[j] - b[j]); }
          const u32x4 qo = {cvt_pk_bf16(qe[0], qe[1]), cvt_pk_bf16(qe[2], qe[3]), cvt_pk_bf16(qe[4], qe[5]), cvt_pk_bf16(qe[6], qe[7])};
          const u32x4 ko = {cvt_pk_bf16(ke[0], ke[1]), cvt_pk_bf16(ke[2], ke[3]), cvt_pk_bf16(ke[4], ke[5]), cvt_pk_bf16(ke[6], ke[7])};
          const int sw = (i >> 1) & 7;
          *(LAS u32x4*)(qeL + i * 128 + ((cc ^ sw) << 4)) = qo; *(LAS u32x4*)(keL + i * 128 + ((cc ^ sw) << 4)) = ko;
          *(u32x4*)(p.QE + t * 256 + h * 64 + d0) = qo;
          const int pi = pos16(i);
#pragma unroll
          for (int j = 0; j < 8; ++j) { const int d = d0 + j; const unsigned pk = cvt_pk_bf16(kt[j], 0.f);
              *(LAS unsigned short*)(ktL + d * 128 + (((pi >> 3) ^ ((d >> 1) & 7)) << 4) + (pi & 7) * 2) = (unsigned short)pk; } }
        __syncthreads();
        { f32x16 OT, KV;
#pragma unroll
          for (int r = 0; r < 16; ++r) { OT[r] = 0.f; KV[r] = 0.f; }
          const int sw = (l31 >> 1) & 7;
#pragma unroll
          for (int jb = 0; jb < 2; ++jb) {
              if (jb <= hb) {
                  f32x16 Sc;
#pragma unroll
                  for (int r = 0; r < 16; ++r) Sc[r] = 0.f;
#pragma unroll
                  for (int s = 0; s < 4; ++s) {
                      const bf16x8 ka = *(const LAS bf16x8*)(keL + (32 * jb + l31) * 128 + (((2 * s + hh) ^ sw) << 4));
                      const bf16x8 qb = *(const LAS bf16x8*)(qeL + (32 * hb + l31) * 128 + (((2 * s + hh) ^ sw) << 4));
                      Sc = __builtin_amdgcn_mfma_f32_32x32x16_bf16(ka, qb, Sc, 0, 0, 0); }
                  if (jb == hb) {
#pragma unroll
                      for (int r = 0; r < 16; ++r) { const int j = (r & 3) + 8 * (r >> 2) + 4 * hh; if (j > l31) Sc[r] = 0.f; } }
#pragma unroll
                  for (int h2 = 0; h2 < 2; ++h2) {
                      u32x4 a = {cvt_pk_bf16(Sc[8 * h2 + 0], Sc[8 * h2 + 1]), cvt_pk_bf16(Sc[8 * h2 + 2], Sc[8 * h2 + 3]), cvt_pk_bf16(Sc[8 * h2 + 4], Sc[8 * h2 + 5]), cvt_pk_bf16(Sc[8 * h2 + 6], Sc[8 * h2 + 7])};
                      OT = __builtin_amdgcn_mfma_f32_32x32x16_bf16(vf[2 * jb + h2], *(bf16x8*)&a, OT, 0, 0, 0); } } }
#pragma unroll
          for (int s4 = 0; s4 < 4; ++s4) {
              const bf16x8 kb = *(const LAS bf16x8*)(ktL + (32 * hb + l31) * 128 + (((2 * s4 + hh) ^ sw) << 4));
              KV = __builtin_amdgcn_mfma_f32_32x32x16_bf16(vf[s4], kb, KV, 0, 0, 0); }
          float* oi = p.OI + ((size_t)u * 8 + wid) * 1024 + lane;
#pragma unroll
          for (int r = 0; r < 16; ++r) oi[r * 64] = OT[r];
          float* kp = p.kvT + (size_t)u * 8192 + 32 * hb + l31;
#pragma unroll
          for (int r = 0; r < 16; ++r) { const int e = 32 * eb + (r & 3) + 8 * (r >> 2) + 4 * hh; kp[e * 64] = KV[r]; } }
        __syncthreads();
    }
}
__device__ __forceinline__ void gla_g2(LAS unsigned char* lds, const GlaP& p, int c) {
    const int tid = tid_now(), el = tid & 127, seg = tid >> 7;
    const int idx = c * 128 + el, h = idx >> 13, ed = idx & 8191, d = idx & 63;
    LAS float* segS = (LAS float*)lds; LAS float* segD = (LAS float*)(lds + 2048);
    float st = 0.f, dp = 1.f;
    for (int n0 = seg * 64; n0 < seg * 64 + 64; n0 += 16) {
        float kv[16], dc[16];
#pragma unroll
        for (int k = 0; k < 16; ++k) { const size_t u = (size_t)(n0 + k) * 4 + h; kv[k] = p.kvT[u * 8192 + ed]; dc[k] = p.decay[u * 64 + d]; }
#pragma unroll
        for (int k = 0; k < 16; ++k) { st = fmaf(dc[k], st, kv[k]); dp *= dc[k]; }
    }
    __syncthreads();
    segS[seg * 128 + el] = st; segD[seg * 128 + el] = dp;
    __syncthreads();
    st = 0.f;
    for (int s2 = 0; s2 < seg; ++s2) st = fmaf(segD[s2 * 128 + el], st, segS[s2 * 128 + el]);
    for (int n0 = seg * 64; n0 < seg * 64 + 64; n0 += 16) {
        float kv[16], dc[16];
#pragma unroll
        for (int k = 0; k < 16; ++k) { const size_t u = (size_t)(n0 + k) * 4 + h; kv[k] = p.kvT[u * 8192 + ed]; dc[k] = p.decay[u * 64 + d]; }
#pragma unroll
        for (int k = 0; k < 16; ++k) { const size_t u = (size_t)(n0 + k) * 4 + h; p.spT[u * 8192 + ed] = (bf16_t)(cvt_pk_bf16(st, 0.f) & 0xffffu); st = fmaf(dc[k], st, kv[k]); }
    }
    __syncthreads();
}
__device__ __forceinline__ void gla_g3(LAS unsigned char* lds, const GlaP& p, int c, int G) {
    const int tid = tid_now(), wid = __builtin_amdgcn_readfirstlane(tid >> 6), lane = tid & 63, l31 = lane & 31, hh = lane >> 5;
    LAS float* red = (LAS float*)lds;
    const int eb = wid & 3, ib = wid >> 2;
    for (int u = c; u < 1024; u += G) {
        const int n = u >> 2, h = u & 3;
        f32x16 O;
        { const float* oi = p.OI + ((size_t)u * 8 + wid) * 1024 + lane;
#pragma unroll
          for (int r = 0; r < 16; ++r) O[r] = oi[r * 64]; }
        const size_t t = (size_t)64 * n + 32 * ib + l31;
        { const bf16_t* sp = p.spT + ((size_t)u * 128 + 32 * eb + l31) * 64 + 8 * hh; const bf16_t* qp = p.QE + t * 256 + h * 64 + 8 * hh;
#pragma unroll
          for (int s = 0; s < 4; ++s) { const bf16x8 a = *(const bf16x8*)(sp + 16 * s), b = *(const bf16x8*)(qp + 16 * s); O = __builtin_amdgcn_mfma_f32_32x32x16_bf16(a, b, O, 0, 0, 0); } }
        float ss = 0.f;
#pragma unroll
        for (int r = 0; r < 16; ++r) ss += O[r] * O[r];
        { auto rr = __builtin_amdgcn_permlane32_swap(__float_as_uint(ss), __float_as_uint(ss), false, false); ss = __uint_as_float(rr[0]) + __uint_as_float(rr[1]); }
        __syncthreads();
        if (hh == 0) red[eb * 64 + 32 * ib + l31] = ss;
        __syncthreads();
        const int ti = 32 * ib + l31;
        const float tot = (red[ti] + red[64 + ti]) + (red[128 + ti] + red[192 + ti]);
        const float rs = rsqrtf(tot * (1.f / 128.f) + 1e-6f);
#pragma unroll
        for (int g = 0; g < 4; ++g) { const int e0 = 32 * eb + 8 * g + 4 * hh;
            const u32x2 rv = *(const u32x2*)(p.Hp + t * HW + H_GR + h * 128 + e0); const f32x4 gn = *(const f32x4*)(p.ng + e0);
            float y[4];
#pragma unroll
            for (int j = 0; j < 4; ++j) { const float r_ = (j & 1) ? bfhi(rv[j >> 1]) : bflo(rv[j >> 1]); y[j] = O[4 * g + j] * rs * gn[j] * (r_ / (1.f + __expf(-r_))); }
            u32x2 o = {cvt_pk_bf16(y[0], y[1]), cvt_pk_bf16(y[2], y[3])};
            *(u32x2*)(p.Ybb + t * 512 + h * 128 + e0) = o; }
    }
}
__device__ __forceinline__ void conv_phase(const GlaP& p, int gtid, int gthreads) {
    for (int idx = gtid; idx < T * 64; idx += gthreads) { const int t = idx >> 6, c0 = (idx & 63) * 8;
        float y[8];
#pragma unroll
        for (int j = 0; j < 8; ++j) y[j] = 0.f;
#pragma unroll
        for (int k = 0; k < 3; ++k) { const int tt = t - 2 + k; if (tt >= 0) {
            const u32x4 a = *(const u32x4*)(p.Hp + (size_t)tt * HW + H_AC + c0), x = *(const u32x4*)(p.Hp + (size_t)tt * HW + H_AX + c0);
            const f32x4 w0 = *(const f32x4*)(p.wconv + k * 512 + c0), w1 = *(const f32x4*)(p.wconv + k * 512 + c0 + 4);
#pragma unroll
            for (int j = 0; j < 4; ++j) { y[2 * j] += (j < 2 ? w0[2 * j] : w1[2 * j - 4]) * (bflo(a[j]) * bflo(x[j])); y[2 * j + 1] += (j < 2 ? w0[2 * j + 1] : w1[2 * j - 3]) * (bfhi(a[j]) * bfhi(x[j])); } } }
        const u32x4 b = *(const u32x4*)(p.Hp + (size_t)t * HW + H_AB + c0);
        u32x4 o;
#pragma unroll
        for (int j = 0; j < 4; ++j) o[j] = cvt_pk_bf16(bflo(b[j]) * y[2 * j], bfhi(b[j]) * y[2 * j + 1]);
        *(u32x4*)(p.Yab + (size_t)t * 512 + c0) = o; }
}
__device__ __forceinline__ void attn_combine_bf16(const GlaP& p, int gtid, int gthreads) {
    for (int idx = gtid; idx < 256 * 256 * 32; idx += gthreads) {
        const int dq = idx & 31, row = (idx >> 5) & 255, g = idx >> 13, head = g >> 6, b = g & 63;
        const int Ls = head * 8320 + 2 * b * (b + 1), Le = Ls + 4 * (b + 1);
        const int c0 = Ls / ATT_STEPS, c1 = (Le - 1) / ATT_STEPS;
        float M = -1e30f;
        for (int c = c0; c <= c1; ++c) M = fmaxf(M, p.MLpart[((size_t)(g + c) * 256 + row) * 2]);
        f32x4 acc = {0.f, 0.f, 0.f, 0.f}; float l = 0.f;
        for (int c = c0; c <= c1; ++c) { const size_t sl = (size_t)(g + c) * 256 + row; const float w = __builtin_amdgcn_exp2f(p.MLpart[sl * 2] - M);
            l += w * p.MLpart[sl * 2 + 1]; const u32x2 ob = *(const u32x2*)((const bf16_t*)p.Opart + sl * 128 + dq * 4); const f32x4 o = {bflo(ob[0]), bfhi(ob[0]), bflo(ob[1]), bfhi(ob[1])}; acc += o * w; }
        const float il = 1.f / l;
        u32x2 o = {cvt_pk_bf16(acc[0] * il, acc[1] * il), cvt_pk_bf16(acc[2] * il, acc[3] * il)};
        *(u32x2*)(p.Ycb + (size_t)(b * 256 + row) * 512 + head * 128 + dq * 4) = o;
    }
}
struct P {
    const float *x, *pin; const int* pos;
    const float *ln0_g, *ln0_b, *w_in, *w_conv, *w_gg, *b_gg, *gla_ng, *qn_g, *kvn_g, *w_uq, *w_ukv, *w_br, *w_o, *ln1_g, *ln1_b, *w_grp, *b_grp, *w_exp, *b_exp,
                *w_gate, *w_up, *w_down, *ln2_g, *ln2_b, *w_pg, *b_pg, *w_pu, *ln3_g, *ln3_b;
    float* out;
    float *X, *Z, *cs, *sn, *ssq_q, *ssq_kv, *OI, *kvT, *decay, *MLpart, *ew;
    bf16_t *Db, *Xb, *Hp, *GVt, *Qb, *KnImg, *VtImg, *KrImg, *QE, *spT, *Yab, *Ybb, *Ycb, *Mgb, *Hbuf, *Ys, *Ub, *Pb;
    bf16_t *Wb_in, *Wb_gv, *Wb_uq, *Wb_uk, *Wb_uv, *Wb_br, *Wb_o, *Wb_gu, *Wb_d, *Wb_pg, *Wb_pu;
    int *cnt, *lists; unsigned* bar;
};
__device__ __forceinline__ MegaP mk_mega(const P& p) { MegaP m; m.w_in = p.w_in; m.Wb_in = p.Wb_in; m.Wb_gv = p.Wb_gv; m.Xb = p.Xb; m.Hp = p.Hp; m.GVt = p.GVt; m.ssq_q = p.ssq_q; m.ssq_kv = p.ssq_kv; return m; }
__device__ __forceinline__ MlaP mk_mla(const P& p) { MlaP q; q.w_uq = p.w_uq; q.w_ukv = p.w_ukv; q.qn_g = p.qn_g; q.kvn_g = p.kvn_g; q.Wb_uq = p.Wb_uq; q.Wb_uk = p.Wb_uk; q.Wb_uv = p.Wb_uv; q.Hp = p.Hp;
    q.ssq_q = p.ssq_q; q.ssq_kv = p.ssq_kv; q.cs = p.cs; q.sn = p.sn; q.Qb = p.Qb; q.KnImg = p.KnImg; q.VtImg = p.VtImg; q.KrImg = p.KrImg; q.Opart = p.Z; q.MLpart = p.MLpart; q.Yc = nullptr; return q; }
__device__ __forceinline__ GlaP mk_gla(const P& p, int layer) { GlaP g; g.Hp = p.Hp; g.GVt = p.GVt; g.wg = p.w_gg + layer * 16 * 256; g.bg = p.b_gg + layer * 256; g.ng = p.gla_ng + layer * 128; g.wconv = p.w_conv + layer * 3 * 512;
    g.QE = p.QE; g.OI = p.OI; g.kvT = p.kvT; g.decay = p.decay; g.spT = p.spT; g.Yab = p.Yab; g.Ybb = p.Ybb; g.Ycb = p.Ycb; g.Opart = p.Z; g.MLpart = p.MLpart; return g; }

struct CvJob { const float* W; bf16_t* Bt; const float* rs; int ldw, Ksrc, ldbt, n0, k0, kind, aux; };
struct MapId { __device__ __forceinline__ int operator()(int s) const { return s; } };
__device__ __forceinline__ int cv_map(int kind, int aux, int n) {
    if (kind == 0) return MapInMain{}(n);
    if (kind == 1) return aux + n;
    if (kind == 2) return MapQ{}(n);
    if (kind == 3) return MapKV{aux}(n);
    return n; }
__device__ __forceinline__ int cv_omap(int kind, int aux, int n) { return kind == 4 ? (n >> 7) * 256 + aux * 128 + (n & 127) : n; }
__device__ __forceinline__ bool cv_job(const P& p, int layer, int t, CvJob& j) {
    constexpr int S0 = 384, S1 = S0 + 32, S2 = S1 + 12, S3 = S2 + 8, S4 = S3 + 8, S5 = S4 + 96, S6 = S5 + 64, S7 = S6 + 64, S8 = S7 + 16, S9 = S8 + 1024, S10 = S9 + 1024, S11 = S10 + 1024;
    if (t >= S11) return false;
    j.rs = nullptr; j.aux = 0; j.kind = 5;
    if (t < S0) { j.W = p.w_in + (size_t)layer * D * INW; j.ldw = INW; j.Ksrc = D; j.Bt = p.Wb_in; j.ldbt = D; j.n0 = (t >> 2) * 64; j.k0 = (t & 3) * 256; j.kind = 0; }
    else if (t < S1) { const int u = t - S0; j.W = p.w_in + (size_t)layer * D * INW; j.ldw = INW; j.Ksrc = D; j.Bt = p.Wb_gv; j.ldbt = D; j.n0 = (u >> 2) * 64; j.k0 = (u & 3) * 256; j.kind = 1; j.aux = O_GV; }
    else if (t < S2) { const int u = t - S1; j.W = p.w_uq + (size_t)layer * 256 * 768; j.ldw = 768; j.Ksrc = 256; j.Bt = p.Wb_uq; j.ldbt = 256; j.n0 = u * 64; j.k0 = 0; j.kind = 2; j.rs = p.qn_g + layer * 256; }
    else if (t < S3) { const int u = t - S2; j.W = p.w_ukv + (size_t)layer * 128 * 1024; j.ldw = 1024; j.Ksrc = 128; j.Bt = p.Wb_uk; j.ldbt = 256; j.n0 = u * 64; j.k0 = 0; j.kind = 3; j.aux = 0; j.rs = p.kvn_g + layer * 128; }
    else if (t < S4) { const int u = t - S3; j.W = p.w_ukv + (size_t)layer * 128 * 1024; j.ldw = 1024; j.Ksrc = 128; j.Bt = p.Wb_uv; j.ldbt = 256; j.n0 = u * 64; j.k0 = 0; j.kind = 3; j.aux = 128; j.rs = p.kvn_g + layer * 128; }
    else if (t < S5) { const int u = t - S4, br = u >> 5, v = u & 31; j.W = p.w_br + (size_t)layer * 1536 * D + (size_t)br * 512 * D; j.ldw = D; j.Ksrc = 512; j.Bt = p.Wb_br + (size_t)br * 1024 * 512; j.ldbt = 512; j.n0 = (v >> 1) * 64; j.k0 = (v & 1) * 256; }
    else if (t < S6) { const int u = t - S5; j.W = p.w_o + (size_t)layer * D * D; j.ldw = D; j.Ksrc = D; j.Bt = p.Wb_o; j.ldbt = D; j.n0 = (u >> 2) * 64; j.k0 = (u & 3) * 256; }
    else if (t < S7) { const int u = t - S6; j.W = p.w_pg + (size_t)layer * D * D; j.ldw = D; j.Ksrc = D; j.Bt = p.Wb_pg; j.ldbt = D; j.n0 = (u >> 2) * 64; j.k0 = (u & 3) * 256; }
    else if (t < S8) { const int u = t - S7; j.W = p.w_pu + (size_t)layer * PLE * D; j.ldw = D; j.Ksrc = PLE; j.Bt = p.Wb_pu; j.ldbt = PLE; j.n0 = u * 64; j.k0 = 0; }
    else if (t < S9) { const int u = t - S8, e = u >> 4, v = u & 15; j.W = p.w_gate + ((size_t)layer * NE + e) * D * EH; j.ldw = EH; j.Ksrc = D; j.Bt = p.Wb_gu + (size_t)e * 512 * D; j.ldbt = D; j.n0 = (v >> 2) * 64; j.k0 = (v & 3) * 256; j.kind = 4; j.aux = 0; }
    else if (t < S10) { const int u = t - S9, e = u >> 4, v = u & 15; j.W = p.w_up + ((size_t)layer * NE + e) * D * EH; j.ldw = EH; j.Ksrc = D; j.Bt = p.Wb_gu + (size_t)e * 512 * D; j.ldbt = D; j.n0 = (v >> 2) * 64; j.k0 = (v & 3) * 256; j.kind = 4; j.aux = 1; }
    else { const int u = t - S10, e = u >> 4, v = u & 15; j.W = p.w_down + ((size_t)layer * NE + e) * EH * D; j.ldw = D; j.Ksrc = EH; j.Bt = p.Wb_d + (size_t)e * D * EH; j.ldbt = EH; j.n0 = v * 64; j.k0 = 0; }
    return true; }
__device__ __forceinline__ void cv_load(const CvJob& j, int tid, f32x4 (&v)[8]) {
    const int n4 = tid & 15, kr = tid >> 4; const int col = cv_map(j.kind, j.aux, j.n0 + 4 * n4);
#pragma unroll
    for (int r = 0; r < 8; ++r) { const int k = j.k0 + kr + 32 * r; v[r] = (f32x4){0.f, 0.f, 0.f, 0.f};
        if (col >= 0 && k < j.Ksrc) { v[r] = *(const f32x4*)(j.W + (size_t)k * j.ldw + col); if (j.rs) v[r] = v[r] * j.rs[k]; } }
}
__device__ __forceinline__ void ph_convert(LAS unsigned char* ldsl, const P& p, int layer) {
    LAS float* tile = (LAS float*)ldsl;
    const int tid = tid_now(), c = sgpr_now((int)blockIdx.x), G = gridDim.x;
    CvJob cur, nxt; f32x4 v[8], w[8];
    bool have = cv_job(p, layer, c, cur);
    if (have) cv_load(cur, tid, v);
    for (int t = c; have; t += G) {
        const bool hn = cv_job(p, layer, t + G, nxt);
        if (hn) cv_load(nxt, tid, w);
        __syncthreads();
        { const int n4 = tid & 15, kr = tid >> 4;
#pragma unroll
          for (int r = 0; r < 8; ++r) { LAS float* d = tile + (kr + 32 * r) * 65 + 4 * n4; d[0] = v[r][0]; d[1] = v[r][1]; d[2] = v[r][2]; d[3] = v[r][3]; } }
        __syncthreads();
        { const int kk = (tid & 127) * 2, nn = tid >> 7;
#pragma unroll
          for (int r = 0; r < 16; ++r) { const int n = nn + 4 * r;
              *(unsigned*)(cur.Bt + (size_t)cv_omap(cur.kind, cur.aux, cur.n0 + n) * cur.ldbt + cur.k0 + kk) = cvt_pk_bf16(tile[kk * 65 + n], tile[(kk + 1) * 65 + n]); } }
        have = hn; cur = nxt;
#pragma unroll
        for (int r = 0; r < 8; ++r) v[r] = w[r];
    }
    __syncthreads();
}

__device__ __forceinline__ float wsum(float v, int lane) {
#pragma unroll
    for (int o = 32; o > 0; o >>= 1) v += shx(v, o, lane);
    return v; }
template <int MODE>
__device__ __forceinline__ void ph_rows(const P& p, int layer) {
    const int lane = tid_now() & 63, gw = blockIdx.x * 8 + (tid_now() >> 6), nw = gridDim.x * 8;
    const float* gp = MODE == 0 ? p.ln0_g : MODE == 1 ? p.ln1_g + layer * D : MODE == 2 ? p.ln2_g + layer * D : p.ln3_g + layer * D;
    const float* bp = MODE == 0 ? p.ln0_b : MODE == 1 ? p.ln1_b + layer * D : MODE == 2 ? p.ln2_b + layer * D : p.ln3_b + layer * D;
    f32x4 gg[4], bb[4];
#pragma unroll
    for (int i = 0; i < 4; ++i) { gg[i] = *(const f32x4*)(gp + 256 * i + 4 * lane); bb[i] = *(const f32x4*)(bp + 256 * i + 4 * lane); }
    const float* in = MODE == 0 ? p.x : p.X;
    float* outf = (MODE == 3 && layer == DEPTH - 1) ? p.out : p.X;
    for (int row = gw; row < T; row += nw) {
        f32x4 v[4];
#pragma unroll
        for (int i = 0; i < 4; ++i) v[i] = *(const f32x4*)(in + (size_t)row * D + 256 * i + 4 * lane);
        if constexpr (MODE == 3) {
#pragma unroll
            for (int i = 0; i < 4; ++i) { const u32x2 dd = *(const u32x2*)(p.Db + (size_t)row * D + 256 * i + 4 * lane);
                v[i][0] = DN_ALPHA * v[i][0] + bflo(dd[0]); v[i][1] = DN_ALPHA * v[i][1] + bfhi(dd[0]); v[i][2] = DN_ALPHA * v[i][2] + bflo(dd[1]); v[i][3] = DN_ALPHA * v[i][3] + bfhi(dd[1]); } }
        if constexpr (MODE == 2) { const float w0 = p.ew[2 * row], w1 = p.ew[2 * row + 1];
#pragma unroll
            for (int i = 0; i < 4; ++i) { const u32x2 y0 = *(const u32x2*)(p.Ys + (size_t)(2 * row) * D + 256 * i + 4 * lane), y1 = *(const u32x2*)(p.Ys + (size_t)(2 * row + 1) * D + 256 * i + 4 * lane);
                v[i][0] = DN_ALPHA * v[i][0] + (w0 * bflo(y0[0]) + w1 * bflo(y1[0])); v[i][1] = DN_ALPHA * v[i][1] + (w0 * bfhi(y0[0]) + w1 * bfhi(y1[0]));
                v[i][2] = DN_ALPHA * v[i][2] + (w0 * bflo(y0[1]) + w1 * bflo(y1[1])); v[i][3] = DN_ALPHA * v[i][3] + (w0 * bfhi(y0[1]) + w1 * bfhi(y1[1])); } }
        float s = 0.f;
#pragma unroll
        for (int i = 0; i < 4; ++i) s += (v[i][0] + v[i][1]) + (v[i][2] + v[i][3]);
        const float mu = wsum(s, lane) * (1.f / D);
        float q = 0.f;
#pragma unroll
        for (int i = 0; i < 4; ++i) { v[i] = v[i] - mu; q += (v[i][0] * v[i][0] + v[i][1] * v[i][1]) + (v[i][2] * v[i][2] + v[i][3] * v[i][3]); }
        const float rs = rsqrtf(wsum(q, lane) * (1.f / D) + 1e-5f);
#pragma unroll
        for (int i = 0; i < 4; ++i) { v[i] = v[i] * rs * gg[i] + bb[i];
            *(f32x4*)(outf + (size_t)row * D + 256 * i + 4 * lane) = v[i];
            u32x2 o = {cvt_pk_bf16(v[i][0], v[i][1]), cvt_pk_bf16(v[i][2], v[i][3])};
            *(u32x2*)(p.Xb + (size_t)row * D + 256 * i + 4 * lane) = o; }
        if constexpr (MODE == 1) {
            const float* wg = p.w_grp + (size_t)layer * D * 8; const float* we = p.w_exp + (size_t)layer * D * 64;
            float gl[8];
#pragma unroll
            for (int g = 0; g < 8; ++g) gl[g] = 0.f;
#pragma unroll
            for (int i = 0; i < 4; ++i)
#pragma unroll
                for (int j = 0; j < 4; ++j) { const int k = 256 * i + 4 * lane + j; const f32x4 a = *(const f32x4*)(wg + k * 8), b = *(const f32x4*)(wg + k * 8 + 4); const float xv = v[i][j];
                    gl[0] = fmaf(xv, a[0], gl[0]); gl[1] = fmaf(xv, a[1], gl[1]); gl[2] = fmaf(xv, a[2], gl[2]); gl[3] = fmaf(xv, a[3], gl[3]);
                    gl[4] = fmaf(xv, b[0], gl[4]); gl[5] = fmaf(xv, b[1], gl[5]); gl[6] = fmaf(xv, b[2], gl[6]); gl[7] = fmaf(xv, b[3], gl[7]); }
            float mx = -INFINITY; int gt = 0;
#pragma unroll
            for (int g = 0; g < 8; ++g) { gl[g] = wsum(gl[g], lane) + p.b_grp[layer * 8 + g]; if (gl[g] > mx) { mx = gl[g]; gt = g; } }
            gt = __builtin_amdgcn_readfirstlane(gt);
            float sum = 0.f;
#pragma unroll
            for (int g = 0; g < 8; ++g) sum += expf(gl[g] - mx);
            const float pg = 1.f / sum;
            float el[8];
#pragma unroll
            for (int e = 0; e < 8; ++e) el[e] = 0.f;
#pragma unroll
            for (int i = 0; i < 4; ++i)
#pragma unroll
                for (int j = 0; j < 4; ++j) { const int k = 256 * i + 4 * lane + j; const f32x4 a = *(const f32x4*)(we + k * 64 + gt * 8), b = *(const f32x4*)(we + k * 64 + gt * 8 + 4); const float xv = v[i][j];
                    el[0] = fmaf(xv, a[0], el[0]); el[1] = fmaf(xv, a[1], el[1]); el[2] = fmaf(xv, a[2], el[2]); el[3] = fmaf(xv, a[3], el[3]);
                    el[4] = fmaf(xv, b[0], el[4]); el[5] = fmaf(xv, b[1], el[5]); el[6] = fmaf(xv, b[2], el[6]); el[7] = fmaf(xv, b[3], el[7]); }
            float v1 = -INFINITY, v2 = -INFINITY; int i1 = 0, i2 = 0;
#pragma unroll
            for (int e = 0; e < 8; ++e) { const float vv = wsum(el[e], lane) + p.b_exp[layer * 64 + gt * 8 + e];
                if (vv > v1) { v2 = v1; i2 = i1; v1 = vv; i1 = e; } else if (vv > v2) { v2 = vv; i2 = e; } }
            if (lane == 0) { const float e2 = expf(v2 - v1), w1 = pg / (1.f + e2), w2 = pg * e2 / (1.f + e2);
                const int ea = gt * 8 + i1, eb = gt * 8 + i2; int* cn = p.cnt + layer * 64;
                p.ew[2 * row] = w1; p.ew[2 * row + 1] = w2;
                const int pa = atomicAdd(&cn[ea], 1); p.lists[ea * LCAP + pa] = 2 * row;
                const int pb = atomicAdd(&cn[eb], 1); p.lists[eb * LCAP + pb] = 2 * row + 1; }
        }
    }
}

__device__ __forceinline__ void wsum8(float (&x)[8], int lane) {
    float y[4], z[2], w;
#pragma unroll
    for (int k = 0; k < 4; ++k) { const bool hi = lane & 32; const float snd = hi ? x[k] : x[k + 4], keep = hi ? x[k + 4] : x[k]; y[k] = keep + shx(snd, 32, lane); }
#pragma unroll
    for (int k = 0; k < 2; ++k) { const bool hi = lane & 16; const float snd = hi ? y[k] : y[k + 2], keep = hi ? y[k + 2] : y[k]; z[k] = keep + shx(snd, 16, lane); }
    { const bool hi = lane & 8; const float snd = hi ? z[0] : z[1], keep = hi ? z[1] : z[0]; w = keep + shx(snd, 8, lane); }
    w += shx(w, 4, lane); w += shx(w, 2, lane); w += shx(w, 1, lane);
#pragma unroll
    for (int k = 0; k < 8; ++k) x[k] = __int_as_float(__builtin_amdgcn_readlane(__float_as_int(w), (k >> 2) * 32 + ((k >> 1) & 1) * 16 + (k & 1) * 8));
}
__device__ __forceinline__ void ph_ln1_router(const P& p, int layer) {
    constexpr int RR = 2;
    const int tid = tid_now(), lane0 = tid & 63, gw = sgpr_now((int)blockIdx.x) * 8 + (tid >> 6), nw = gridDim.x * 8;
    const float* gp = p.ln1_g + layer * D; const float* bp = p.ln1_b + layer * D;
    const float* wg = p.w_grp + (size_t)layer * D * 8; const float* we = p.w_exp + (size_t)layer * D * 64;
    for (int row0 = gw * RR; row0 < T; row0 += nw * RR) {
        int lane = lane0; asm volatile("" : "+v"(lane));
        f32x4 v[RR][4];
#pragma unroll
        for (int r = 0; r < RR; ++r)
#pragma unroll
            for (int i = 0; i < 4; ++i) { v[r][i] = *(const f32x4*)(p.X + (size_t)(row0 + r) * D + 256 * i + 4 * lane);
                const u32x2 dd = *(const u32x2*)(p.Db + (size_t)(row0 + r) * D + 256 * i + 4 * lane);
                v[r][i][0] = DN_ALPHA * v[r][i][0] + bflo(dd[0]); v[r][i][1] = DN_ALPHA * v[r][i][1] + bfhi(dd[0]); v[r][i][2] = DN_ALPHA * v[r][i][2] + bflo(dd[1]); v[r][i][3] = DN_ALPHA * v[r][i][3] + bfhi(dd[1]); }
#pragma unroll
        for (int r = 0; r < RR; ++r) {
            float s = 0.f;
#pragma unroll
            for (int i = 0; i < 4; ++i) s += (v[r][i][0] + v[r][i][1]) + (v[r][i][2] + v[r][i][3]);
            const float mu = wsum(s, lane) * (1.f / D);
            float q = 0.f;
#pragma unroll
            for (int i = 0; i < 4; ++i) { v[r][i] = v[r][i] - mu; q += (v[r][i][0] * v[r][i][0] + v[r][i][1] * v[r][i][1]) + (v[r][i][2] * v[r][i][2] + v[r][i][3] * v[r][i][3]); }
            const float rs = rsqrtf(wsum(q, lane) * (1.f / D) + 1e-5f);
#pragma unroll
            for (int i = 0; i < 4; ++i) { const f32x4 gg = *(const f32x4*)(gp + 256 * i + 4 * lane), bb = *(const f32x4*)(bp + 256 * i + 4 * lane);
                v[r][i] = v[r][i] * rs * gg + bb;
                *(f32x4*)(p.X + (size_t)(row0 + r) * D + 256 * i + 4 * lane) = v[r][i];
                u32x2 o = {cvt_pk_bf16(v[r][i][0], v[r][i][1]), cvt_pk_bf16(v[r][i][2], v[r][i][3])};
                *(u32x2*)(p.Xb + (size_t)(row0 + r) * D + 256 * i + 4 * lane) = o; } }
        float gl[RR][8];
#pragma unroll
        for (int r = 0; r < RR; ++r)
#pragma unroll
            for (int g = 0; g < 8; ++g) gl[r][g] = 0.f;
#pragma unroll
        for (int i = 0; i < 4; ++i) { asm volatile("" : "+v"(lane) :: "memory");
#pragma unroll
            for (int j = 0; j < 4; ++j) { const int k = 256 * i + 4 * lane + j; const f32x4 a = *(const f32x4*)(wg + k * 8), b = *(const f32x4*)(wg + k * 8 + 4);
#pragma unroll
                for (int r = 0; r < RR; ++r) { const float xv = v[r][i][j];
                    gl[r][0] = fmaf(xv, a[0], gl[r][0]); gl[r][1] = fmaf(xv, a[1], gl[r][1]); gl[r][2] = fmaf(xv, a[2], gl[r][2]); gl[r][3] = fmaf(xv, a[3], gl[r][3]);
                    gl[r][4] = fmaf(xv, b[0], gl[r][4]); gl[r][5] = fmaf(xv, b[1], gl[r][5]); gl[r][6] = fmaf(xv, b[2], gl[r][6]); gl[r][7] = fmaf(xv, b[3], gl[r][7]); } } }
        int gt[RR]; float pg[RR];
#pragma unroll
        for (int r = 0; r < RR; ++r) { wsum8(gl[r], lane);
            float mx = -INFINITY; int gi = 0;
#pragma unroll
            for (int g = 0; g < 8; ++g) { gl[r][g] += p.b_grp[layer * 8 + g]; if (gl[r][g] > mx) { mx = gl[r][g]; gi = g; } }
            float sum = 0.f;
#pragma unroll
            for (int g = 0; g < 8; ++g) sum += expf(gl[r][g] - mx);
            gt[r] = __builtin_amdgcn_readfirstlane(gi); pg[r] = 1.f / sum; }
        float el[RR][8];
#pragma unroll
        for (int r = 0; r < RR; ++r) {
#pragma unroll
            for (int e = 0; e < 8; ++e) el[r][e] = 0.f;
#pragma unroll
            for (int i = 0; i < 4; ++i) { asm volatile("" : "+v"(lane) :: "memory");
#pragma unroll
                for (int j = 0; j < 4; ++j) { const int k = 256 * i + 4 * lane + j; const f32x4 a = *(const f32x4*)(we + k * 64 + gt[r] * 8), b = *(const f32x4*)(we + k * 64 + gt[r] * 8 + 4); const float xv = v[r][i][j];
                    el[r][0] = fmaf(xv, a[0], el[r][0]); el[r][1] = fmaf(xv, a[1], el[r][1]); el[r][2] = fmaf(xv, a[2], el[r][2]); el[r][3] = fmaf(xv, a[3], el[r][3]);
                    el[r][4] = fmaf(xv, b[0], el[r][4]); el[r][5] = fmaf(xv, b[1], el[r][5]); el[r][6] = fmaf(xv, b[2], el[r][6]); el[r][7] = fmaf(xv, b[3], el[r][7]); } } }
#pragma unroll
        for (int r = 0; r < RR; ++r) { wsum8(el[r], lane);
            float v1 = -INFINITY, v2 = -INFINITY; int i1 = 0, i2 = 0;
#pragma unroll
            for (int e = 0; e < 8; ++e) { const float vv = el[r][e] + p.b_exp[layer * 64 + gt[r] * 8 + e];
                if (vv > v1) { v2 = v1; i2 = i1; v1 = vv; i1 = e; } else if (vv > v2) { v2 = vv; i2 = e; } }
            if (lane == 0) { const int row = row0 + r; const float e2 = expf(v2 - v1), w1 = pg[r] / (1.f + e2), w2 = pg[r] * e2 / (1.f + e2);
                const int ea = gt[r] * 8 + i1, eb = gt[r] * 8 + i2; int* cn = p.cnt + layer * 64;
                p.ew[2 * row] = w1; p.ew[2 * row + 1] = w2;
                const int pa = atomicAdd(&cn[ea], 1); p.lists[ea * LCAP + pa] = 2 * row;
                const int pb = atomicAdd(&cn[eb], 1); p.lists[eb * LCAP + pb] = 2 * row + 1; } }
    }
}
__device__ __forceinline__ void ph_prologue(const P& p) {
    const int gtid = blockIdx.x * NTHR + tid_now(), gth = gridDim.x * NTHR;
    for (int idx = gtid; idx < T * 32; idx += gth) { const int t = idx >> 5, i = idx & 31;
        const float inv = (float)(1.0 / pow(10000.0, (double)(2 * i) / 64.0)); const float ang = (float)p.pos[t] * inv;
        p.cs[idx] = (float)cos((double)ang); p.sn[idx] = (float)sin((double)ang); }
    for (size_t i = gtid; i < (size_t)DEPTH * T * PLE / 4; i += gth) { const f32x4 v = ((const f32x4*)p.pin)[i]; u32x2 o = {cvt_pk_bf16(v[0], v[1]), cvt_pk_bf16(v[2], v[3])}; ((u32x2*)p.Pb)[i] = o; }
    ph_rows<0>(p, 0);
}

struct SchedBr { __device__ __forceinline__ bool carry(const ge::Unit& u) const { return u.g < 2; }
    const char* Ya; const char* Yb; const char* Yc; const char* W; int c, G;
    __device__ __forceinline__ bool next(int i, ge::Unit& u) const { const int tile = (i / 3) * G + c; if (tile >= 256) return false; u.g = i % 3; ge::tile_order(tile, 64, 4, u.pm, u.pn); return true; }
    __device__ __forceinline__ const char* aptr(const ge::Unit& u) const { return (u.g == 0 ? Ya : u.g == 1 ? Yb : Yc) + (size_t)u.pm * 256 * 512 * 2; }
    __device__ __forceinline__ const char* bptr(const ge::Unit& u) const { return W + ((size_t)u.g * 1024 + u.pn * 256) * 512 * 2; } };
struct EpiBr { const bf16_t* Hp; bf16_t* Mgb;
    __device__ __forceinline__ void operator()(ge::Acc& acc, const ge::Unit& u, int wr, int wc, int fr, int fq) const {
        const int row0 = u.pm * 256 + wr * 64 + fr, col0 = u.pn * 256 + wc * 32 + 8 * fq;
#pragma unroll
        for (int ai = 0; ai < 2; ++ai)
#pragma unroll
            for (int m = 0; m < 4; ++m) { asm volatile("" ::: "memory"); const int row = row0 + ai * 128 + m * 16;
#pragma unroll
                for (int bj = 0; bj < 2; ++bj) { const int col = col0 + bj * 128;
                    const u32x4 gt = *(const u32x4*)(Hp + (size_t)row * HW + H_GTA + u.g * 1024 + col);
                    f32x4 s0 = {bflo(gt[0]), bfhi(gt[0]), bflo(gt[1]), bfhi(gt[1])}, s1 = {bflo(gt[2]), bfhi(gt[2]), bflo(gt[3]), bfhi(gt[3])};
                    if (u.g < 2) { const u32x4 gn = *(const u32x4*)(Hp + (size_t)row * HW + H_GTA + (u.g + 1) * 1024 + col);
                        f32x4 d0 = {bflo(gn[0]), bfhi(gn[0]), bflo(gn[1]), bfhi(gn[1])}, d1 = {bflo(gn[2]), bfhi(gn[2]), bflo(gn[3]), bfhi(gn[3])};
#pragma unroll
                        for (int j = 0; j < 4; ++j) { s0[j] = s0[j] / d0[j]; s1[j] = s1[j] / d1[j]; } }
                    acc[ai][bj][m][0] = acc[ai][bj][m][0] * s0; acc[ai][bj][m][1] = acc[ai][bj][m][1] * s1;
                    if (u.g == 2) { const f32x4 v0 = acc[ai][bj][m][0], v1 = acc[ai][bj][m][1];
                        u32x4 o = {cvt_pk_bf16(v0[0], v0[1]), cvt_pk_bf16(v0[2], v0[3]), cvt_pk_bf16(v1[0], v1[1]), cvt_pk_bf16(v1[2], v1[3])}; *(u32x4*)(Mgb + (size_t)row * D + col) = o; } } }
    } };
struct SchedT4 : ge::NoCarry { const char* A; const char* B; int lda2, ldb2, c, G;
    __device__ __forceinline__ bool next(int i, ge::Unit& u) const { const int L = i * G + c; if (L >= 256) return false; u.g = 0; ge::tile_order(L, 64, 4, u.pm, u.pn); return true; }
    __device__ __forceinline__ const char* aptr(const ge::Unit& u) const { return A + (size_t)u.pm * lda2; }
    __device__ __forceinline__ const char* bptr(const ge::Unit& u) const { return B + (size_t)u.pn * ldb2; } };
struct EpiRes { bf16_t* Db;
    __device__ __forceinline__ void operator()(ge::Acc& acc, const ge::Unit& u, int wr, int wc, int fr, int fq) const {
        const int row0 = u.pm * 256 + wr * 64 + fr, col0 = u.pn * 256 + wc * 32 + 8 * fq;
#pragma unroll
        for (int ai = 0; ai < 2; ++ai)
#pragma unroll
            for (int m = 0; m < 4; ++m) { const size_t o = (size_t)(row0 + ai * 128 + m * 16) * D + col0;
#pragma unroll
                for (int bj = 0; bj < 2; ++bj) { const f32x4 v0 = acc[ai][bj][m][0], v1 = acc[ai][bj][m][1];
                    u32x4 w = {cvt_pk_bf16(v0[0], v0[1]), cvt_pk_bf16(v0[2], v0[3]), cvt_pk_bf16(v1[0], v1[1]), cvt_pk_bf16(v1[2], v1[3])}; *(u32x4*)(Db + o + bj * 128) = w; } }
    } };
struct EpiU { bf16_t* Ub;
    __device__ __forceinline__ void operator()(ge::Acc& acc, const ge::Unit& u, int wr, int wc, int fr, int fq) const {
        const int row0 = u.pm * 256 + wr * 64 + fr, col0 = u.pn * 256 + wc * 32 + 8 * fq;
#pragma unroll
        for (int ai = 0; ai < 2; ++ai)
#pragma unroll
            for (int m = 0; m < 4; ++m) { const size_t o = (size_t)(row0 + ai * 128 + m * 16) * D + col0;
#pragma unroll
                for (int bj = 0; bj < 2; ++bj) { const f32x4 v0 = acc[ai][bj][m][0], v1 = acc[ai][bj][m][1];
                    u32x4 w = {cvt_pk_bf16(v0[0], v0[1]), cvt_pk_bf16(v0[2], v0[3]), cvt_pk_bf16(v1[0], v1[1]), cvt_pk_bf16(v1[2], v1[3])}; *(u32x4*)(Ub + o + bj * 128) = w; } }
    } };
struct EpiPle { bf16_t* Db; const bf16_t* Ub; const float* bias;
    __device__ __forceinline__ void operator()(ge::Acc& acc, const ge::Unit& u, int wr, int wc, int fr, int fq) const {
        const int row0 = u.pm * 256 + wr * 64 + fr, col0 = u.pn * 256 + wc * 32 + 8 * fq;
        f32x4 bv[2][2];
#pragma unroll
        for (int bj = 0; bj < 2; ++bj) { bv[bj][0] = *(const f32x4*)(bias + col0 + bj * 128); bv[bj][1] = *(const f32x4*)(bias + col0 + bj * 128 + 4); }
#pragma unroll
        for (int ai = 0; ai < 2; ++ai)
#pragma unroll
            for (int m = 0; m < 4; ++m) { asm volatile("" ::: "memory"); const size_t o = (size_t)(row0 + ai * 128 + m * 16) * D + col0;
#pragma unroll
                for (int bj = 0; bj < 2; ++bj) { const u32x4 uu = *(const u32x4*)(Ub + o + bj * 128);
                    f32x4 g0 = acc[ai][bj][m][0] + bv[bj][0], g1 = acc[ai][bj][m][1] + bv[bj][1];
#pragma unroll
                    for (int j = 0; j < 4; ++j) { g0[j] = 1.f / (1.f + __expf(-g0[j])); g1[j] = 1.f / (1.f + __expf(-g1[j])); }
                    const f32x4 u0 = {bflo(uu[0]), bfhi(uu[0]), bflo(uu[1]), bfhi(uu[1])}, u1 = {bflo(uu[2]), bfhi(uu[2]), bflo(uu[3]), bfhi(uu[3])};
                    g0 = g0 * u0; g1 = g1 * u1;
                    u32x4 w = {cvt_pk_bf16(g0[0], g0[1]), cvt_pk_bf16(g0[2], g0[3]), cvt_pk_bf16(g1[0], g1[1]), cvt_pk_bf16(g1[2], g1[3])}; *(u32x4*)(Db + o + bj * 128) = w; } }
    } };

__device__ __forceinline__ void moe_table(LAS unsigned char* lds, const int* cnt) {
    LAS int* te = (LAS int*)(lds + 131072); LAS int* tr = te + 256; LAS int* cl = tr + 256; LAS int* nt = cl + 64;
    __syncthreads();
    if (tid_now() < 64) cl[tid_now()] = cnt[tid_now()];
    __syncthreads();
    if (tid_now() == 0) { int n = 0; for (int e = 0; e < NE; ++e) for (int r = 0; r < cl[e]; r += 256) { te[n] = e; tr[n] = r; ++n; } nt[0] = n; }
    __syncthreads();
}
struct SchedM1 : ge::NoCarry { const char* Xb; const char* W; const int* lists; LAS int* te; int c, G;
    __device__ __forceinline__ bool next(int i, ge::Unit& u) const { const int L = i * G + c; if (L >= 2 * te[576]) return false; u.pm = L >> 1; u.pn = L & 1; u.g = te[u.pm]; return true; }
    __device__ __forceinline__ int arow(const ge::Unit& u, int r) const { const int n = te[512 + u.g], idx = min(te[256 + u.pm] + r, n - 1); return lists[u.g * LCAP + idx] >> 1; }
    __device__ __forceinline__ const char* aptr(const ge::Unit&) const { return Xb; }
    __device__ __forceinline__ const char* bptr(const ge::Unit& u) const { return W + ((size_t)u.g * 512 + u.pn * 256) * D * 2; } };
struct EpiM1 { bf16_t* Hbuf;
    __device__ __forceinline__ void operator()(ge::Acc& acc, const ge::Unit& u, int wr, int wc, int fr, int fq) const {
#pragma unroll
        for (int ai = 0; ai < 2; ++ai)
#pragma unroll
            for (int m = 0; m < 4; ++m) { const int row = ai * 128 + wr * 64 + m * 16 + fr;
                float h[8];
#pragma unroll
                for (int n = 0; n < 2; ++n)
#pragma unroll
                    for (int j = 0; j < 4; ++j) { const float g = acc[ai][0][m][n][j], uu = acc[ai][1][m][n][j]; h[4 * n + j] = g / (1.f + __expf(-g)) * uu; }
                u32x4 o = {cvt_pk_bf16(h[0], h[1]), cvt_pk_bf16(h[2], h[3]), cvt_pk_bf16(h[4], h[5]), cvt_pk_bf16(h[6], h[7])};
                *(u32x4*)(Hbuf + ((size_t)u.pm * 256 + row) * EH + u.pn * 128 + wc * 32 + 8 * fq) = o; }
    } };
struct SchedM2 : ge::NoCarry { const char* Hb; const char* W; LAS int* te; int c, G;
    __device__ __forceinline__ bool next(int i, ge::Unit& u) const { const int L = i * G + c; if (L >= 4 * te[576]) return false; u.pm = L >> 2; u.pn = L & 3; u.g = te[u.pm]; return true; }
    __device__ __forceinline__ const char* aptr(const ge::Unit& u) const { return Hb + (size_t)u.pm * 256 * EH * 2; }
    __device__ __forceinline__ const char* bptr(const ge::Unit& u) const { return W + ((size_t)u.g * D + u.pn * 256) * EH * 2; } };
struct EpiM2 { bf16_t* Ys; const int* lists; LAS int* te;
    __device__ __forceinline__ void operator()(ge::Acc& acc, const ge::Unit& u, int wr, int wc, int fr, int fq) const {
        const int r0 = te[256 + u.pm], n = te[512 + u.g];
#pragma unroll
        for (int ai = 0; ai < 2; ++ai)
#pragma unroll
            for (int m = 0; m < 4; ++m) { const int row = r0 + ai * 128 + wr * 64 + m * 16 + fr;
                if (row < n) { const int a = lists[u.g * LCAP + row];
#pragma unroll
                    for (int bj = 0; bj < 2; ++bj) { const f32x4 v0 = acc[ai][bj][m][0], v1 = acc[ai][bj][m][1];
                        u32x4 o = {cvt_pk_bf16(v0[0], v0[1]), cvt_pk_bf16(v0[2], v0[3]), cvt_pk_bf16(v1[0], v1[1]), cvt_pk_bf16(v1[2], v1[3])};
                        *(u32x4*)(Ys + (size_t)a * D + u.pn * 256 + bj * 128 + wc * 32 + 8 * fq) = o; } } }
    } };

#define XB_TMO      128
#define XB_XCNT(j)  (256  + 64 * (j))
#define XB_XSUB(j)  (1280 + 64 * (j))
#define XB_XGEN(j)  (2304 + 64 * (j))
#define XB_TOP      3328
#define XB_TOPGEN   3392
#define XCD_BAR_WORDS 3456
#define XB_SPIN_CAP (1u << 18)

__device__ __forceinline__ unsigned xb_ld(unsigned* p)              { return __hip_atomic_load(p, __ATOMIC_RELAXED, __HIP_MEMORY_SCOPE_AGENT); }
__device__ __forceinline__ unsigned xb_add(unsigned* p, unsigned v) { return __hip_atomic_fetch_add(p, v, __ATOMIC_RELAXED, __HIP_MEMORY_SCOPE_AGENT); }
__device__ __forceinline__ unsigned xb_xcc_id() { return (unsigned)__builtin_amdgcn_s_getreg((3 << 11) | 20) & 0xFu; }
#define XB_SPIN(cond, bar) do { unsigned _sp = 0; while (cond) { __builtin_amdgcn_s_sleep(1); \
    if ((++_sp & 255u) == 0u) { if (xb_ld(&(bar)[XB_TMO])) break; if (_sp > XB_SPIN_CAP) { atomicAdd(&(bar)[XB_TMO], 1u); break; } } } } while (0)

struct XcdBarrier {
    unsigned* bar; unsigned x;
    volatile LAS unsigned* st;
};

__device__ __forceinline__ XcdBarrier xcd_barrier_post(unsigned* bar, volatile LAS unsigned* st) {
    XcdBarrier b; b.bar = bar; b.x = xb_xcc_id(); b.st = st;
    if (threadIdx.x == 0) (void)xb_add(&bar[XB_XCNT(b.x)], 1u);
    return b;
}
__device__ __forceinline__ void xcd_barrier_complete(unsigned* bar, unsigned x, unsigned& nloc, unsigned& nx) {
    const unsigned G = gridDim.x * gridDim.y * gridDim.z;
    unsigned sum, cnt, mine, sp = 0u;
    for (;;) {
        sum = 0u; cnt = 0u; mine = 0u;
#pragma unroll
        for (unsigned j = 0; j < 16; ++j) { const unsigned c = xb_ld(&bar[XB_XCNT(j)]); sum += c; cnt += (c > 0u) ? 1u : 0u; mine = (j == x) ? c : mine; }
        if (sum == G) break;
        __builtin_amdgcn_s_sleep(1);
        if ((++sp & 255u) == 0u) { if (xb_ld(&bar[XB_TMO])) break; if (sp > XB_SPIN_CAP) { atomicAdd(&bar[XB_TMO], 1u); break; } }
    }
    nloc = mine > 0u ? mine : 1u; nx = cnt > 0u ? cnt : 1u;
}

__device__ __forceinline__ void xcd_barrier(const XcdBarrier& b) {
    asm volatile("s_waitcnt vmcnt(0)" ::: "memory");
    __syncthreads();
    if (threadIdx.x == 0) {
        unsigned* bar = b.bar;
        __builtin_amdgcn_s_waitcnt(0);
        unsigned nloc = b.st[0], nx = b.st[1];
        if (nloc == 0u) { xcd_barrier_complete(bar, b.x, nloc, nx); b.st[0] = nloc; b.st[1] = nx; }
        const unsigned old = xb_add(&bar[XB_XSUB(b.x)], 1u);
        const unsigned gen = old / nloc;
        if (old + 1u == (gen + 1u) * nloc) {
            __builtin_amdgcn_fence(__ATOMIC_RELEASE, "agent");
            asm volatile("s_waitcnt vmcnt(0)" ::: "memory");
            const unsigned og = xb_add(&bar[XB_TOP], 1u);
            const unsigned tg = og / nx;
            if (og + 1u == (tg + 1u) * nx) xb_add(&bar[XB_TOPGEN], 1u);
            else XB_SPIN(xb_ld(&bar[XB_TOPGEN]) == tg, bar);
            __builtin_amdgcn_fence(__ATOMIC_ACQUIRE, "agent");
            xb_add(&bar[XB_XGEN(b.x)], 1u);
            asm volatile("s_waitcnt vmcnt(0)" ::: "memory");
        } else {
            XB_SPIN(xb_ld(&bar[XB_XGEN(b.x)]) == gen, bar);
            __builtin_amdgcn_fence(__ATOMIC_ACQUIRE, "agent");
            asm volatile("s_waitcnt vmcnt(0)" ::: "memory");
        }
    }
    __syncthreads();
}

enum { PH_PRO = 0, PH_CONV, PH_IN, PH_PREP_Q, PH_PREP_K, PH_PREP_V, PH_PREP_G, PH_ATT, PH_FIN, PH_BR, PH_WO, PH_LN1, PH_M1, PH_M2, PH_LN2, PH_PLE, PH_LN3 };
template <int PH> __global__ __launch_bounds__(NTHR, 2) void k_ph(P p, int layer) {
    extern __shared__ __attribute__((aligned(16))) unsigned char smem[];
    LAS unsigned char* lds = (LAS unsigned char*)smem;
    tid_setup();
    const int c = blockIdx.x, G = gridDim.x;
    if constexpr (PH == PH_PRO) ph_prologue(p);
    if constexpr (PH == PH_CONV) ph_convert(lds, p, layer);
    if constexpr (PH == PH_IN) { const MegaP m = mk_mega(p); SchedIn S{{}, (const char*)m.Xb, (const char*)m.Wb_in, (const char*)m.Wb_gv, c, G, 0}; EpiIn<2> E{m.Hp, m.GVt, m.ssq_q, m.ssq_kv}; ge::gemm_stream<EpiIn<2>, SchedIn, false>(lds, D, D, D, S, E); }
    if constexpr (PH == PH_PREP_Q) { const MlaP q = mk_mla(p); SchedMla<0> S{{}, (const char*)(q.Hp + H_CQ), (const char*)q.Wb_uq, c, G}; EpiMla<0> E{q}; ge::gemm_stream<EpiMla<0>, SchedMla<0>, false>(lds, 256, HW, 256, S, E); }
    if constexpr (PH == PH_PREP_K) { const MlaP q = mk_mla(p); SchedMla<1> S{{}, (const char*)(q.Hp + H_CKV), (const char*)q.Wb_uk, (c + 64) % G, G}; EpiMla<1> E{q}; ge::gemm_stream<EpiMla<1>, SchedMla<1>, false>(lds, 256, HW, 256, S, E); }
    if constexpr (PH == PH_PREP_V) { const MlaP q = mk_mla(p); SchedMla<2> S{{}, (const char*)q.Wb_uv, (const char*)(q.Hp + H_CKV), (c + 192) % G, G}; EpiMla<2> E{q}; ge::gemm_stream<EpiMla<2>, SchedMla<2>, false>(lds, 256, 256, HW, S, E); }
    if constexpr (PH == PH_PREP_G) { { const MegaP m = mk_mega(p); SchedIn S{{}, (const char*)m.Xb, (const char*)m.Wb_in, (const char*)m.Wb_gv, (c + 128) % G, G, 1}; EpiIn<0> E{m.Hp, m.GVt, m.ssq_q, m.ssq_kv}; ge::gemm_stream<EpiIn<0>, SchedIn, false>(lds, D, D, D, S, E); } const MlaP q = mk_mla(p); kr_phase(q, c * NTHR + tid_now(), G * NTHR); const GlaP g = mk_gla(p, layer); gla_g1(lds, g, c, G); }
    if constexpr (PH == PH_ATT) { const GlaP g = mk_gla(p, layer); gla_g2(lds, g, c); const MlaP q = mk_mla(p); attn_phase(lds, q, c); }
    if constexpr (PH == PH_FIN) { const GlaP g = mk_gla(p, layer); gla_g3(lds, g, c, G); conv_phase(g, c * NTHR + tid_now(), G * NTHR); attn_combine_bf16(g, c * NTHR + tid_now(), G * NTHR); }
    if constexpr (PH == PH_BR) { SchedBr S{(const char*)p.Yab, (const char*)p.Ybb, (const char*)p.Ycb, (const char*)p.Wb_br, c, G}; EpiBr E{p.Hp, p.Mgb}; ge::gemm_stream<EpiBr, SchedBr, false>(lds, 512, 512, 512, S, E); }
    if constexpr (PH == PH_WO) { SchedT4 S{{}, (const char*)p.Mgb, (const char*)p.Wb_o, 256 * D * 2, 256 * D * 2, c, G}; EpiRes E{p.Db}; ge::gemm_stream<EpiRes, SchedT4, false>(lds, D, D, D, S, E); }
    if constexpr (PH == PH_LN1) ph_ln1_router(p, layer);
    if constexpr (PH == PH_M1) { moe_table(lds, p.cnt + layer * 64); LAS int* te = (LAS int*)(lds + 131072);
        SchedM1 S{{}, (const char*)p.Xb, (const char*)p.Wb_gu, p.lists, te, c, G}; EpiM1 E{p.Hbuf}; ge::gemm_stream<EpiM1, SchedM1, true>(lds, D, D, D, S, E); }
    if constexpr (PH == PH_M2) { moe_table(lds, p.cnt + layer * 64); LAS int* te = (LAS int*)(lds + 131072);
        SchedM2 S{{}, (const char*)p.Hbuf, (const char*)p.Wb_d, te, c, G}; EpiM2 E{p.Ys, p.lists, te}; ge::gemm_stream<EpiM2, SchedM2, false>(lds, EH, EH, EH, S, E); }
    if constexpr (PH == PH_LN2) ph_rows<2>(p, layer);
    if constexpr (PH == PH_PLE) {
        { SchedT4 S{{}, (const char*)(p.Pb + (size_t)layer * T * PLE), (const char*)p.Wb_pu, 256 * PLE * 2, 256 * PLE * 2, c, G}; EpiU E{p.Ub}; ge::gemm_stream<EpiU, SchedT4, false>(lds, PLE, PLE, PLE, S, E); }
        { SchedT4 S{{}, (const char*)p.Xb, (const char*)p.Wb_pg, 256 * D * 2, 256 * D * 2, c, G}; EpiPle E{p.Db, p.Ub, p.b_pg + layer * D}; ge::gemm_stream<EpiPle, SchedT4, false>(lds, D, D, D, S, E); } }
    if constexpr (PH == PH_LN3) ph_rows<3>(p, layer);
}


typedef const P __attribute__((address_space(4))) CP;
__device__ __forceinline__ P load_params() { CP* q = (CP*)__builtin_amdgcn_kernarg_segment_ptr(); asm volatile("" : "+s"(q)); return *(const P*)q; }
#define GRID_BAR() do { XcdBarrier b_; b_.bar = load_params().bar; b_.x = xb_xcc_id(); b_.st = xbw; xcd_barrier(b_); } while (0)
__global__ __launch_bounds__(NTHR, 2) void k_mega(P p_arg) {
    extern __shared__ __attribute__((aligned(16))) unsigned char smem[];
    LAS unsigned char* lds = (LAS unsigned char*)smem;
    const int G = NBLK;
#define c sgpr_now((int)blockIdx.x)
    volatile LAS unsigned* xbw = (volatile LAS unsigned*)(lds + XBW_OFF);
    tid_setup();
    if (tid_now() < 4) xbw[tid_now()] = 0u;
    __syncthreads();
    (void)xcd_barrier_post(p_arg.bar, xbw);
    { const P p = load_params(); ph_prologue(p); }
    { const P p = load_params(); ph_convert(lds, p, 0); }
    GRID_BAR();
    for (int layer = 0; layer < DEPTH; ++layer) {
        { const P p = load_params(); const MegaP m = mk_mega(p); SchedIn S{{}, (const char*)m.Xb, (const char*)m.Wb_in, (const char*)m.Wb_gv, c, G, 0}; EpiIn<2> E{m.Hp, m.GVt, m.ssq_q, m.ssq_kv}; ge::gemm_stream<EpiIn<2>, SchedIn, false>(lds, D, D, D, S, E); }
        GRID_BAR();
        { const P p = load_params(); const MlaP q = mk_mla(p);
          { SchedMla<0> S{{}, (const char*)(q.Hp + H_CQ), (const char*)q.Wb_uq, (c >= 128 ? c - 128 : -1), 128}; EpiMla<0> E{q}; ge::gemm_stream<EpiMla<0>, SchedMla<0>, false>(lds, 256, HW, 256, S, E); }
          { SchedMla<1> S{{}, (const char*)(q.Hp + H_CKV), (const char*)q.Wb_uk, (c >= 128 ? c - 128 : -1), 128}; EpiMla<1> E{q}; ge::gemm_stream<EpiMla<1>, SchedMla<1>, false>(lds, 256, HW, 256, S, E); }
          { SchedMla<2> S{{}, (const char*)q.Wb_uv, (const char*)(q.Hp + H_CKV), (c >= 128 ? c - 128 : -1), 128}; EpiMla<2> E{q}; ge::gemm_stream<EpiMla<2>, SchedMla<2>, false>(lds, 256, 256, HW, S, E); }
          { const MegaP m = mk_mega(p); SchedIn S{{}, (const char*)m.Xb, (const char*)m.Wb_in, (const char*)m.Wb_gv, c, G, 1}; EpiIn<0> E{m.Hp, m.GVt, m.ssq_q, m.ssq_kv}; ge::gemm_stream<EpiIn<0>, SchedIn, false>(lds, D, D, D, S, E); }
          kr_phase(q, c * NTHR + tid_now(), G * NTHR);
          const GlaP g = mk_gla(p, layer); gla_g1(lds, g, c, G); }
        GRID_BAR();
        { const P p = load_params(); const GlaP g = mk_gla(p, layer); gla_g2(lds, g, c); const MlaP q = mk_mla(p); attn_phase(lds, q, c); }
        GRID_BAR();
        { const P p = load_params(); const GlaP g = mk_gla(p, layer); gla_g3(lds, g, c, G); conv_phase(g, c * NTHR + tid_now(), G * NTHR); attn_combine_bf16(g, c * NTHR + tid_now(), G * NTHR); }
        GRID_BAR();
        { const P p = load_params(); SchedBr S{(const char*)p.Yab, (const char*)p.Ybb, (const char*)p.Ycb, (const char*)p.Wb_br, c, G}; EpiBr E{p.Hp, p.Mgb}; ge::gemm_stream<EpiBr, SchedBr, false>(lds, 512, 512, 512, S, E); }
        GRID_BAR();
        { const P p = load_params(); SchedT4 S{{}, (const char*)p.Mgb, (const char*)p.Wb_o, 256 * D * 2, 256 * D * 2, c, G}; EpiRes E{p.Db}; ge::gemm_stream<EpiRes, SchedT4, false>(lds, D, D, D, S, E); }
        GRID_BAR();
        { const P p = load_params(); ph_ln1_router(p, layer); }
        GRID_BAR();
        { const P p = load_params(); moe_table(lds, p.cnt + layer * 64); LAS int* te = (LAS int*)(lds + 131072);
          SchedM1 S{{}, (const char*)p.Xb, (const char*)p.Wb_gu, p.lists, te, c, G}; EpiM1 E{p.Hbuf}; ge::gemm_stream<EpiM1, SchedM1, true>(lds, D, D, D, S, E);
          const int extra = max(0, 2 * te[576] - NBLK), cu = c - extra;
          SchedT4 SU{{}, (const char*)(p.Pb + (size_t)layer * T * PLE), (const char*)p.Wb_pu, 256 * PLE * 2, 256 * PLE * 2, cu >= 0 ? cu : 256, NBLK - extra}; EpiU EU{p.Ub};
          ge::gemm_stream<EpiU, SchedT4, false>(lds, PLE, PLE, PLE, SU, EU); }
        GRID_BAR();
        { const P p = load_params(); LAS int* te = (LAS int*)(lds + 131072);
          SchedM2 S{{}, (const char*)p.Hbuf, (const char*)p.Wb_d, te, c, G}; EpiM2 E{p.Ys, p.lists, te}; ge::gemm_stream<EpiM2, SchedM2, false>(lds, EH, EH, EH, S, E); }
        GRID_BAR();
        { const P p = load_params(); ph_rows<2>(p, layer); }
        GRID_BAR();
        { const P p = load_params(); SchedT4 S{{}, (const char*)p.Xb, (const char*)p.Wb_pg, 256 * D * 2, 256 * D * 2, c, G}; EpiPle E{p.Db, p.Ub, p.b_pg + layer * D}; ge::gemm_stream<EpiPle, SchedT4, false>(lds, D, D, D, S, E); }
        GRID_BAR();
        { const P p = load_params(); ph_rows<3>(p, layer); }
        if (layer + 1 < DEPTH) { { const P p = load_params(); ph_convert(lds, p, layer + 1); } GRID_BAR(); }
    }
#undef c
}

template <int PH> static void launch_ph(const P& p, int layer, hipStream_t st) {
    static bool set = false;
    if (!set) { (void)hipFuncSetAttribute((const void*)k_ph<PH>, hipFuncAttributeMaxDynamicSharedMemorySize, LDS_BYTES); set = true; }
    hipLaunchKernelGGL((k_ph<PH>), dim3(NBLK), dim3(NTHR), LDS_BYTES, st, p, layer);
}
extern "C" void kernel_launch(void* const* d_in, const int* in_sizes, int n_in, void* d_out, int out_size, void* d_ws, size_t ws_size, hipStream_t st) {
    (void)in_sizes; (void)n_in; (void)out_size;
    P p{};
    p.x = (const float*)d_in[0]; p.pin = (const float*)d_in[1]; p.pos = (const int*)d_in[2]; p.ln0_g = (const float*)d_in[3]; p.ln0_b = (const float*)d_in[4];
    p.w_in = (const float*)d_in[5]; p.w_conv = (const float*)d_in[6]; p.w_gg = (const float*)d_in[7]; p.b_gg = (const float*)d_in[8]; p.gla_ng = (const float*)d_in[9];
    p.qn_g = (const float*)d_in[10]; p.kvn_g = (const float*)d_in[11]; p.w_uq = (const float*)d_in[12]; p.w_ukv = (const float*)d_in[13]; p.w_br = (const float*)d_in[14]; p.w_o = (const float*)d_in[15];
    p.ln1_g = (const float*)d_in[16]; p.ln1_b = (const float*)d_in[17]; p.w_grp = (const float*)d_in[18]; p.b_grp = (const float*)d_in[19]; p.w_exp = (const float*)d_in[20]; p.b_exp = (const float*)d_in[21];
    p.w_gate = (const float*)d_in[22]; p.w_up = (const float*)d_in[23]; p.w_down = (const float*)d_in[24]; p.ln2_g = (const float*)d_in[25]; p.ln2_b = (const float*)d_in[26];
    p.w_pg = (const float*)d_in[27]; p.b_pg = (const float*)d_in[28]; p.w_pu = (const float*)d_in[29]; p.ln3_g = (const float*)d_in[30]; p.ln3_b = (const float*)d_in[31];
    p.out = (float*)d_out;
    char* w = (char*)d_ws; size_t off = 0;
    auto alloc = [&](size_t bytes) { void* r = w + off; off += (bytes + 255) & ~(size_t)255; return r; };
    p.bar = (unsigned*)alloc(16384); p.cnt = (int*)alloc(DEPTH * 64 * 4);
    const size_t zero_bytes = off;
    p.X = (float*)alloc((size_t)T * D * 4); p.Z = (float*)alloc((size_t)T * D * 4); p.Xb = (bf16_t*)alloc((size_t)T * D * 2); p.Db = (bf16_t*)alloc((size_t)T * D * 2);
    p.cs = (float*)alloc((size_t)T * 32 * 4); p.sn = (float*)alloc((size_t)T * 32 * 4); p.ssq_q = (float*)alloc((size_t)4 * T * 4); p.ssq_kv = (float*)alloc((size_t)4 * T * 4);
    p.Hp = (bf16_t*)alloc((size_t)T * HW * 2); p.GVt = (bf16_t*)alloc((size_t)T * 512 * 2);
    p.Qb = (bf16_t*)alloc((size_t)T * 768 * 2); p.KnImg = (bf16_t*)alloc((size_t)T * 512 * 2); p.VtImg = (bf16_t*)alloc((size_t)T * 512 * 2); p.KrImg = (bf16_t*)alloc((size_t)T * 64 * 2);
    p.MLpart = (float*)alloc((size_t)512 * 256 * 2 * 4);
    p.QE = (bf16_t*)alloc((size_t)T * 256 * 2); p.OI = (float*)alloc((size_t)T * 512 * 4); p.kvT = (float*)alloc((size_t)1024 * 8192 * 4); p.decay = (float*)alloc((size_t)1024 * 64 * 4); p.spT = (bf16_t*)alloc((size_t)1024 * 8192 * 2);
    p.Yab = (bf16_t*)alloc((size_t)T * 512 * 2); p.Ybb = (bf16_t*)alloc((size_t)T * 512 * 2); p.Ycb = (bf16_t*)alloc((size_t)T * 512 * 2); p.Mgb = (bf16_t*)alloc((size_t)T * D * 2);
    p.ew = (float*)alloc((size_t)T * 2 * 4); p.lists = (int*)alloc((size_t)NE * LCAP * 4);
    p.Hbuf = (bf16_t*)alloc((size_t)192 * 256 * EH * 2); p.Ys = (bf16_t*)alloc((size_t)2 * T * D * 2); p.Ub = (bf16_t*)alloc((size_t)T * D * 2); p.Pb = (bf16_t*)alloc((size_t)DEPTH * T * PLE * 2);
    p.Wb_in = (bf16_t*)alloc((size_t)HW * D * 2); p.Wb_gv = (bf16_t*)alloc((size_t)512 * D * 2); p.Wb_uq = (bf16_t*)alloc((size_t)768 * 256 * 2); p.Wb_uk = (bf16_t*)alloc((size_t)512 * 256 * 2); p.Wb_uv = (bf16_t*)alloc((size_t)512 * 256 * 2);
    p.Wb_br = (bf16_t*)alloc((size_t)3 * D * 512 * 2); p.Wb_o = (bf16_t*)alloc((size_t)D * D * 2); p.Wb_gu = (bf16_t*)alloc((size_t)NE * 512 * D * 2); p.Wb_d = (bf16_t*)alloc((size_t)NE * D * EH * 2);
    p.Wb_pg = (bf16_t*)alloc((size_t)D * D * 2); p.Wb_pu = (bf16_t*)alloc((size_t)D * PLE * 2);
    if (off > ws_size) return;
    (void)hipMemsetAsync(d_ws, 0, zero_bytes, st);
#if defined(MULTI_LAUNCH)
    launch_ph<PH_PRO>(p, 0, st);
    for (int i = 0; i < DEPTH; ++i) {
        launch_ph<PH_CONV>(p, i, st); launch_ph<PH_IN>(p, i, st);
        launch_ph<PH_PREP_Q>(p, i, st); launch_ph<PH_PREP_K>(p, i, st); launch_ph<PH_PREP_V>(p, i, st); launch_ph<PH_PREP_G>(p, i, st);
        launch_ph<PH_ATT>(p, i, st); launch_ph<PH_FIN>(p, i, st); launch_ph<PH_BR>(p, i, st); launch_ph<PH_WO>(p, i, st); launch_ph<PH_LN1>(p, i, st);
        launch_ph<PH_M1>(p, i, st); launch_ph<PH_M2>(p, i, st); launch_ph<PH_LN2>(p, i, st); launch_ph<PH_PLE>(p, i, st); launch_ph<PH_LN3>(p, i, st);
    }
#else
    static bool set = false;
    if (!set) { (void)hipFuncSetAttribute((const void*)k_mega, hipFuncAttributeMaxDynamicSharedMemorySize, LDS_BYTES); set = true; }
    hipLaunchKernelGGL(k_mega, dim3(NBLK), dim3(NTHR), LDS_BYTES, st, p);
#endif
}
```

```cpp
#include <hip/hip_runtime.h>
#include <hip/hip_bf16.h>
#include <stdint.h>

constexpr int T = 16384, D = 1024, DEPTH = 4, PLE = 256;
constexpr int NE = 64, EH = 256;
constexpr int INW = 6608;
constexpr int O_GV = 2048;
constexpr float DN_ALPHA = 1.681792830507429f;
constexpr int LCAP = 32768;
#define LAS __attribute__((address_space(3)))
typedef unsigned short bf16_t;
typedef short bf16x8 __attribute__((ext_vector_type(8)));
typedef float f32x4 __attribute__((ext_vector_type(4)));
typedef float f32x16 __attribute__((ext_vector_type(16)));
typedef unsigned u32x4 __attribute__((ext_vector_type(4)));
typedef unsigned u32x2 __attribute__((ext_vector_type(2)));
typedef float f32x2 __attribute__((ext_vector_type(2)));
constexpr int NBLK = 256, NTHR = 512;
constexpr int STAGE_BYTES = 131072, LDS_BYTES = 147456 + 512, XBW_OFF = 147456 + 256;
constexpr int HW = 6144;
constexpr int H_AB = 0, H_AC = 512, H_AX = 1024, H_GQ = 1536, H_GK = 1792, H_GR = 2048, H_CQ = 2560, H_CKV = 2816, H_KR = 2944, H_GLR = 3008, H_GTA = 3072, H_GTB = 4096, H_GTC = 5120;

__device__ __forceinline__ unsigned cvt_pk_bf16(float lo, float hi) { unsigned r; asm volatile("v_cvt_pk_bf16_f32 %0, %1, %2" : "=v"(r) : "v"(lo), "v"(hi)); return r; }
constexpr int WTAB_OFF = 147456;
__device__ __forceinline__ int tid_now() {
    const unsigned hw = (unsigned)__builtin_amdgcn_s_getreg((5 << 11) | 4) & 63u;
    extern __shared__ __attribute__((aligned(16))) unsigned char smem_tid[];
    const int w = __builtin_amdgcn_readfirstlane(*(volatile LAS int*)((LAS unsigned char*)smem_tid + WTAB_OFF + 4 * hw));
    int l = (int)__builtin_amdgcn_mbcnt_hi(~0u, __builtin_amdgcn_mbcnt_lo(~0u, 0u));
    asm volatile("" : "+v"(l));
    return w * 64 + l; }
__device__ __forceinline__ void tid_setup() {
    const unsigned hw = (unsigned)__builtin_amdgcn_s_getreg((5 << 11) | 4) & 63u;
    extern __shared__ __attribute__((aligned(16))) unsigned char smem_tid[];
    if ((threadIdx.x & 63) == 0) *(volatile LAS int*)((LAS unsigned char*)smem_tid + WTAB_OFF + 4 * hw) = (int)(threadIdx.x >> 6);
    __syncthreads(); }
__device__ __forceinline__ int sgpr_now(int v) { asm volatile("" : "+s"(v)); return v; }
__device__ __forceinline__ float shx(float v, int mask, int lane) { return __int_as_float(__builtin_amdgcn_ds_bpermute((lane ^ mask) << 2, __float_as_int(v))); }
__device__ __forceinline__ float bf2f(bf16_t b) { return __uint_as_float(((unsigned)b) << 16); }
__device__ __forceinline__ float bflo(unsigned w) { return __uint_as_float(w << 16); }
__device__ __forceinline__ float bfhi(unsigned w) { return __uint_as_float(w & 0xffff0000u); }

namespace ge {
constexpr int BM = 256, BK = 64, HALF = 128, HTB = HALF * BK * 2;
__device__ __forceinline__ int lds_byte(int r, int c) { const int st = (r >> 4) * 2 + (c >> 5), rr = r & 15, cc = c & 31, ob = rr * 64 + cc * 2; return st * 1024 + (ob ^ (((ob >> 9) & 1) << 5)); }
__device__ __forceinline__ void stage_rc(int b, int& R, int& C) { const int st = b / 1024, sb = b % 1024, swz = sb ^ (((sb >> 9) & 1) << 5); R = (st >> 1) * 16 + swz / 64; C = (st & 1) * 32 + (swz % 64) / 2; }
__device__ __forceinline__ int perm32(int rho) { const int n = rho >> 4, i = rho & 15; return 8 * (i >> 2) + 4 * n + (i & 3); }
struct Unit { int pm, pn, g; };
typedef f32x4 Acc[2][2][4][2];
struct NoCarry { __device__ __forceinline__ bool carry(const struct Unit&) const { return false; } };

template <class Epi, class Sched, bool GATHER>
__device__ __forceinline__ void gemm_stream(LAS unsigned char* lds, const int K, const int lda, const int ldb, const Sched& S, const Epi& E) {
    const int tid = tid_now(), wid = __builtin_amdgcn_readfirstlane(tid >> 6), lane = tid & 63, wr = wid >> 2, wc = wid & 3, fr = lane & 15, fq = lane >> 4;
    const int nt = K / BK;
    Unit cur, nxt; int ui = 0;
    if (!S.next(0, cur)) return;
    unsigned voffA[2][2], nvoffA[2][2], voffB[2][2];
#pragma unroll
    for (int i = 0; i < 2; ++i) { int R, C; stage_rc(tid * 16 + i * 8192, R, C); const int Rb = (R & ~31) + perm32(R & 31);
        voffB[0][i] = (unsigned)(Rb * ldb + C) * 2u; voffB[1][i] = (unsigned)((Rb + 128) * ldb + C) * 2u;
        if constexpr (GATHER) { voffA[0][i] = (unsigned)(S.arow(cur, R) * lda + C) * 2u; voffA[1][i] = (unsigned)(S.arow(cur, R + 128) * lda + C) * 2u; }
        else { voffA[0][i] = (unsigned)(R * lda + C) * 2u; voffA[1][i] = (unsigned)((R + 128) * lda + C) * 2u; }
        nvoffA[0][i] = voffA[0][i]; nvoffA[1][i] = voffA[1][i]; }
    const size_t kstep = (size_t)(BK * 2);
    const unsigned ldsw = (unsigned)wid * 1024u;
    const int aoff = lds_byte(wr * 64 + fr, fq * 8), boff = lds_byte(wc * 32 + fr, fq * 8);
#define GE_SA(b, h) (((b) * 2 + (h)) * HTB)
#define GE_SB(b, h) ((4 + (b) * 2 + (h)) * HTB)
#define GE_STAGE(bufoff, gbase, voff) do { _Pragma("unroll") for (int _i = 0; _i < 2; ++_i) \
        __builtin_amdgcn_global_load_lds((const unsigned*)((const char*)(gbase) + (voff)[_i]), (LAS unsigned*)(lds + (bufoff) + ldsw + _i * 8192), 16, 0, 0); } while (0)
#define GE_LDA(dst, b, h) do { _Pragma("unroll") for (int m = 0; m < 4; ++m) _Pragma("unroll") for (int k = 0; k < 2; ++k) dst[m][k] = *(const LAS bf16x8*)(lds + GE_SA(b, h) + aoff + m * 2048 + k * 1024); } while (0)
#define GE_LDB(dst, b, h) do { _Pragma("unroll") for (int n = 0; n < 2; ++n) _Pragma("unroll") for (int k = 0; k < 2; ++k) dst[n][k] = *(const LAS bf16x8*)(lds + GE_SB(b, h) + boff + n * 2048 + k * 1024); } while (0)
#define GE_MMA(ai, bj, At, Bt) do { __builtin_amdgcn_s_setprio(1); _Pragma("unroll") for (int m = 0; m < 4; ++m) _Pragma("unroll") for (int n = 0; n < 2; ++n) _Pragma("unroll") for (int k = 0; k < 2; ++k) \
        acc[ai][bj][m][n] = __builtin_amdgcn_mfma_f32_16x16x32_bf16(Bt[n][k], At[m][k], acc[ai][bj][m][n], 0, 0, 0); __builtin_amdgcn_s_setprio(0); } while (0)
#define GE_WAIT_V(n) asm volatile("s_waitcnt vmcnt(" #n ")" ::: "memory")
#define GE_WAIT_L(n) asm volatile("s_waitcnt lgkmcnt(" #n ")" ::: "memory")
#define GE_BAR __builtin_amdgcn_s_barrier()
#define GE_SCHED __builtin_amdgcn_sched_barrier(0)
    Acc acc;
#pragma unroll
    for (int a = 0; a < 2; ++a)
#pragma unroll
        for (int b = 0; b < 2; ++b)
#pragma unroll
            for (int m = 0; m < 4; ++m)
#pragma unroll
                for (int n = 0; n < 2; ++n) acc[a][b][m][n] = (f32x4){0.f, 0.f, 0.f, 0.f};
    bf16x8 At[4][2], B0[2][2], B1[2][2];
    const char* cA = S.aptr(cur); const char* cB = S.bptr(cur);
    GE_STAGE(GE_SB(0, 0), cB, voffB[0]); GE_STAGE(GE_SA(0, 0), cA, voffA[0]); GE_STAGE(GE_SB(0, 1), cB, voffB[1]); GE_STAGE(GE_SA(0, 1), cA, voffA[1]);
    if (wr == 1) GE_BAR;
    GE_WAIT_V(4); GE_BAR;
    GE_STAGE(GE_SB(1, 0), cB + kstep, voffB[0]); GE_STAGE(GE_SA(1, 0), cA + kstep, voffA[0]); GE_STAGE(GE_SB(1, 1), cB + kstep, voffB[1]);
    GE_WAIT_V(6); GE_BAR;
    for (;;) {
        const bool has_next = S.next(ui + 1, nxt);
        const char* nA = has_next ? S.aptr(nxt) : cA; const char* nB = has_next ? S.bptr(nxt) : cB;
#pragma unroll 1
        for (int t = 0; t < nt; t += 2) {
            const bool last = (t == nt - 2);
            const char* a1 = cA + (size_t)(t + 1) * kstep;
            const char* a2 = last ? nA : cA + (size_t)(t + 2) * kstep; const char* b2 = last ? nB : cB + (size_t)(t + 2) * kstep;
            const char* a3 = a2 + kstep; const char* b3 = b2 + kstep;
            if constexpr (GATHER) { if (last && has_next) {
#pragma unroll
                for (int i = 0; i < 2; ++i) { int R, C; stage_rc(tid * 16 + i * 8192, R, C);
                    nvoffA[0][i] = (unsigned)(S.arow(nxt, R) * lda + C) * 2u; nvoffA[1][i] = (unsigned)(S.arow(nxt, R + 128) * lda + C) * 2u; } } }
            unsigned va2[2][2];
#pragma unroll
            for (int h = 0; h < 2; ++h)
#pragma unroll
                for (int i = 0; i < 2; ++i) va2[h][i] = (GATHER && last) ? nvoffA[h][i] : voffA[h][i];
            GE_LDB(B0, 0, 0); GE_SCHED; GE_LDA(At, 0, 0); GE_STAGE(GE_SA(1, 1), a1, voffA[1]);
            GE_WAIT_L(8); GE_BAR; GE_WAIT_L(0); GE_MMA(0, 0, At, B0); GE_BAR; GE_SCHED;
            GE_LDB(B1, 0, 1); GE_STAGE(GE_SB(0, 0), b2, voffB[0]);
            GE_BAR; GE_WAIT_L(0); GE_MMA(0, 1, At, B1); GE_BAR;
            GE_LDA(At, 0, 1); GE_STAGE(GE_SA(0, 0), a2, va2[0]);
            GE_BAR; GE_WAIT_L(0); GE_MMA(1, 0, At, B0); GE_BAR; GE_SCHED;
            GE_STAGE(GE_SB(0, 1), b2, voffB[1]);
            GE_WAIT_V(6); GE_BAR; GE_MMA(1, 1, At, B1); GE_BAR;
            GE_LDB(B0, 1, 0); GE_SCHED; GE_LDA(At, 1, 0); GE_STAGE(GE_SA(0, 1), a2, va2[1]);
            GE_WAIT_L(8); GE_BAR; GE_WAIT_L(0); GE_MMA(0, 0, At, B0); GE_BAR; GE_SCHED;
            GE_LDB(B1, 1, 1); GE_STAGE(GE_SB(1, 0), b3, voffB[0]);
            GE_BAR; GE_WAIT_L(0); GE_MMA(0, 1, At, B1); GE_BAR;
            GE_LDA(At, 1, 1); GE_STAGE(GE_SA(1, 0), a3, va2[0]);
            GE_BAR; GE_WAIT_L(0); GE_MMA(1, 0, At, B0); GE_BAR; GE_SCHED;
            GE_STAGE(GE_SB(1, 1), b3, voffB[1]);
            GE_WAIT_V(6); GE_BAR; GE_MMA(1, 1, At, B1); GE_BAR;
        }
        { int tz = tid; asm volatile("" : "+v"(tz));
          const int wid2 = tz >> 6, lane2 = tz & 63; E(acc, cur, wid2 >> 2, wid2 & 3, lane2 & 15, lane2 >> 4); }
        if (!has_next) break;
        if (!S.carry(cur)) {
#pragma unroll
        for (int a = 0; a < 2; ++a)
#pragma unroll
            for (int b = 0; b < 2; ++b)
#pragma unroll
                for (int m = 0; m < 4; ++m)
#pragma unroll
                    for (int n = 0; n < 2; ++n) acc[a][b][m][n] = (f32x4){0.f, 0.f, 0.f, 0.f}; }
        cur = nxt; cA = nA; cB = nB; ++ui;
        if (GATHER) {
#pragma unroll
            for (int h = 0; h < 2; ++h)
#pragma unroll
                for (int i = 0; i < 2; ++i) voffA[h][i] = nvoffA[h][i]; }
    }
    GE_WAIT_V(0);
    if (wr == 0) GE_BAR;
    GE_BAR;
#undef GE_SA
#undef GE_SB
#undef GE_STAGE
#undef GE_LDA
#undef GE_LDB
#undef GE_MMA
#undef GE_WAIT_V
#undef GE_WAIT_L
#undef GE_BAR
#undef GE_SCHED
}
__device__ __forceinline__ void tile_order(int L, int nM, int nN, int& pm, int& pn) {
    const int nwg = nM * nN; int wgid = L;
    { const int q = nwg / 8, r = nwg % 8, xcd = wgid % 8, off = wgid / 8; wgid = (xcd < r ? xcd * (q + 1) : r * (q + 1) + (xcd - r) * q) + off; }
    const int nig = 8 * nN, gid = wgid / nig, fm = gid * 8, gsz = (nM - fm) < 8 ? (nM - fm) : 8;
    pm = fm + ((wgid % nig) % gsz); pn = (wgid % nig) / gsz;
}
}
struct MapInMain { __device__ __forceinline__ int operator()(int s) const {
    if (s < 2048) return s;
    if (s < 2560) return 2576 + (s - 2048);
    if (s < 2816) return 3088 + (s - 2560);
    if (s < 2944) return 3344 + (s - 2816);
    if (s < 3008) return 3472 + (s - 2944);
    if (s < 3024) return 2560 + (s - 3008);
    if (s < 3072) return -1;
    return 3536 + (s - 3072); } };
struct MapOff { int off; __device__ __forceinline__ int operator()(int s) const { return off + s; } };struct MegaP {
    const float* w_in; bf16_t* Wb_in; bf16_t* Wb_gv; const bf16_t* Xb; bf16_t* Hp; bf16_t* GVt; float* ssq_q; float* ssq_kv;
};
struct SchedIn : ge::NoCarry {
    const char* Xb; const char* Wm; const char* Wg; int c, G, gv;
    __device__ __forceinline__ bool next(int i, ge::Unit& u) const {
        const int L = i * G + c;
        if (gv) { if (L >= 128) return false; u.g = 0; u.pm = L >> 1; u.pn = 8 + (L & 1); return true; }
        if (L >= 1536) return false;
        if (L < 1408) { u.g = 0; ge::tile_order(L, 64, 22, u.pm, u.pn); if (u.pn >= 8) u.pn += 2; } else { u.g = 1; const int l = L - 1408; u.pm = l & 1; u.pn = l >> 1; }
        return true; }
    __device__ __forceinline__ const char* aptr(const ge::Unit& u) const { return u.g == 0 ? Xb + (size_t)u.pm * 256 * D * 2 : Wg + (size_t)u.pm * 256 * D * 2; }
    __device__ __forceinline__ const char* bptr(const ge::Unit& u) const { return u.g == 0 ? Wm + (size_t)u.pn * 256 * D * 2 : Xb + (size_t)u.pn * 256 * D * 2; }
};
template <int GV> struct EpiIn {
    bf16_t* Hp; bf16_t* GVt; float* ssq_q; float* ssq_kv;
    __device__ __forceinline__ void operator()(ge::Acc& acc, const ge::Unit& u, int wr, int wc, int fr, int fq) const {
        if (GV == 0 || (GV == 2 && u.g == 0)) {
            const int row0 = u.pm * 256 + wr * 64 + fr, col0 = u.pn * 256 + wc * 32 + 8 * fq;
            const bool sg = u.pn >= 12;
#pragma unroll
            for (int ai = 0; ai < 2; ++ai)
#pragma unroll
                for (int m = 0; m < 4; ++m) { const int row = row0 + ai * 128 + m * 16; bf16_t* rp = Hp + (size_t)row * HW + col0;
                    float sq0 = 0.f, sq1 = 0.f;
#pragma unroll
                    for (int bj = 0; bj < 2; ++bj) { f32x4 v0 = acc[ai][bj][m][0], v1 = acc[ai][bj][m][1];
                        if (sg) {
#pragma unroll
                            for (int j = 0; j < 4; ++j) { v0[j] = 1.f / (1.f + __expf(-v0[j])); v1[j] = 1.f / (1.f + __expf(-v1[j])); } }
                        const float s = v0[0] * v0[0] + v0[1] * v0[1] + v0[2] * v0[2] + v0[3] * v0[3] + v1[0] * v1[0] + v1[1] * v1[1] + v1[2] * v1[2] + v1[3] * v1[3];
                        if (bj == 0) sq0 = s; else sq1 = s;
                        u32x4 o = {cvt_pk_bf16(v0[0], v0[1]), cvt_pk_bf16(v0[2], v0[3]), cvt_pk_bf16(v1[0], v1[1]), cvt_pk_bf16(v1[2], v1[3])};
                        *(u32x4*)(rp + bj * 128) = o; }
                    if (u.pn == 10 || u.pn == 11) {
                        float s = (u.pn == 10) ? (sq0 + sq1) : sq0;
                        { const int ln = fq * 16 + fr; s += shx(s, 16, ln); s += shx(s, 32, ln); }
                        if (fq == 0) { float* dst = (u.pn == 10 ? ssq_q : ssq_kv); dst[(size_t)wc * T + row] = s; } } }
        } else {
#pragma unroll
            for (int ai = 0; ai < 2; ++ai)
#pragma unroll
                for (int m = 0; m < 4; ++m) { const int r = u.pm * 256 + ai * 128 + wr * 64 + m * 16 + fr, h = r >> 7, e = r & 127;
#pragma unroll
                    for (int bj = 0; bj < 2; ++bj) { const int t0 = u.pn * 256 + bj * 128 + wc * 32 + 8 * fq;
                        const int chunk = t0 >> 6, p0 = (t0 & 48) + ((t0 & 8) >> 1);
                        bf16_t* base = GVt + ((size_t)(chunk * 4 + h) * 128 + e) * 64;
                        const f32x4 v0 = acc[ai][bj][m][0], v1 = acc[ai][bj][m][1];
                        u32x2 o0 = {cvt_pk_bf16(v0[0], v0[1]), cvt_pk_bf16(v0[2], v0[3])}, o1 = {cvt_pk_bf16(v1[0], v1[1]), cvt_pk_bf16(v1[2], v1[3])};
                        *(u32x2*)(base + p0) = o0; *(u32x2*)(base + p0 + 8) = o1; } }
        }
    }
};
constexpr float QSCALE = 0.07216878364870322f * 1.4426950408889634f;
struct MapQ { __device__ __forceinline__ int operator()(int s) const {
    if (s < 512) return (s >> 7) * 192 + (s & 127);
    const int s2 = s - 512, bj = s2 >> 7, w = s2 & 127; return (w >> 5) * 192 + 128 + bj * 32 + (w & 31); } };
struct MapKV { int voff; __device__ __forceinline__ int operator()(int s) const { return (s >> 7) * 256 + voff + (s & 127); } };

struct MlaP {
    const float* w_uq; const float* w_ukv; const float* qn_g; const float* kvn_g;
    bf16_t* Wb_uq; bf16_t* Wb_uk; bf16_t* Wb_uv;
    const bf16_t* Hp; const float* ssq_q; const float* ssq_kv; const float* cs; const float* sn;
    bf16_t* Qb; bf16_t* KnImg; bf16_t* VtImg; bf16_t* KrImg; float* Opart; float* MLpart; float* Yc;
};
__device__ __forceinline__ float rstd4(const float* ssq, int row, float invw) {
    const float s = (ssq[row] + ssq[T + row]) + (ssq[2 * T + row] + ssq[3 * T + row]); return rsqrtf(s * invw + 1e-6f); }

template <int mode> struct SchedMla : ge::NoCarry { const char* A; const char* B; int c, G;
    __device__ __forceinline__ bool next(int i, ge::Unit& u) const {
        if (c < 0) return false;
        const int L = i * G + c; u.g = mode;
        if (mode == 0) { if (L >= 192) return false; u.pm = L / 3; u.pn = L % 3; }
        else if (mode == 1) { if (L >= 128) return false; u.pm = L >> 1; u.pn = L & 1; }
        else { if (L >= 128) return false; u.pm = L & 1; u.pn = L >> 1; }
        return true; }
    __device__ __forceinline__ const char* aptr(const ge::Unit& u) const { return mode == 2 ? A + (size_t)u.pm * 256 * 256 * 2 : A + (size_t)u.pm * 256 * HW * 2; }
    __device__ __forceinline__ const char* bptr(const ge::Unit& u) const { return mode == 2 ? B + (size_t)u.pn * 256 * HW * 2 : B + (size_t)u.pn * 256 * 256 * 2; }
};
template <int MODE> struct EpiMla { MlaP p;
    __device__ __forceinline__ void operator()(ge::Acc& acc, const ge::Unit& u, int wr, int wc, int fr, int fq) const {
        if constexpr (MODE == 0) {
#pragma unroll
            for (int ai = 0; ai < 2; ++ai)
#pragma unroll
                for (int m = 0; m < 4; ++m) { asm volatile("" ::: "memory"); const int t = u.pm * 256 + ai * 128 + wr * 64 + m * 16 + fr; const float rs = rstd4(p.ssq_q, t, 1.f / 256.f) * QSCALE;
                    if (u.pn < 2) {
#pragma unroll
                        for (int bj = 0; bj < 2; ++bj) { const int c0 = u.pn * 256 + bj * 128 + wc * 32 + 8 * fq, head = c0 >> 7, dim = c0 & 127;
                            const f32x4 v0 = acc[ai][bj][m][0] * rs, v1 = acc[ai][bj][m][1] * rs;
                            u32x4 o = {cvt_pk_bf16(v0[0], v0[1]), cvt_pk_bf16(v0[2], v0[3]), cvt_pk_bf16(v1[0], v1[1]), cvt_pk_bf16(v1[2], v1[3])};
                            *(u32x4*)(p.Qb + (size_t)t * 768 + head * 192 + dim) = o; }
                    } else { const int head = wc, i0 = 8 * fq;
                        float o1[8], o2[8];
#pragma unroll
                        for (int n = 0; n < 2; ++n) { const f32x4 c4 = *(const f32x4*)(p.cs + (size_t)t * 32 + i0 + 4 * n), s4 = *(const f32x4*)(p.sn + (size_t)t * 32 + i0 + 4 * n);
#pragma unroll
                            for (int j = 0; j < 4; ++j) { const float x1 = acc[ai][0][m][n][j] * rs, x2 = acc[ai][1][m][n][j] * rs; o1[4 * n + j] = x1 * c4[j] - x2 * s4[j]; o2[4 * n + j] = x1 * s4[j] + x2 * c4[j]; } }
                        u32x4 a = {cvt_pk_bf16(o1[0], o1[1]), cvt_pk_bf16(o1[2], o1[3]), cvt_pk_bf16(o1[4], o1[5]), cvt_pk_bf16(o1[6], o1[7])};
                        u32x4 b = {cvt_pk_bf16(o2[0], o2[1]), cvt_pk_bf16(o2[2], o2[3]), cvt_pk_bf16(o2[4], o2[5]), cvt_pk_bf16(o2[6], o2[7])};
                        *(u32x4*)(p.Qb + (size_t)t * 768 + head * 192 + 128 + i0) = a; *(u32x4*)(p.Qb + (size_t)t * 768 + head * 192 + 160 + i0) = b; } }
        } else if constexpr (MODE == 1) {
#pragma unroll
            for (int ai = 0; ai < 2; ++ai)
#pragma unroll
                for (int m = 0; m < 4; ++m) { asm volatile("" ::: "memory"); const int t = u.pm * 256 + ai * 128 + wr * 64 + m * 16 + fr; const float rs = rstd4(p.ssq_kv, t, 1.f / 128.f);
                    const int tile = t >> 6, key = t & 63;
#pragma unroll
                    for (int bj = 0; bj < 2; ++bj) { const int c0 = u.pn * 256 + bj * 128 + wc * 32 + 8 * fq, head = c0 >> 7, chunk = (c0 & 127) >> 3;
                        const f32x4 v0 = acc[ai][bj][m][0] * rs, v1 = acc[ai][bj][m][1] * rs;
                        u32x4 o = {cvt_pk_bf16(v0[0], v0[1]), cvt_pk_bf16(v0[2], v0[3]), cvt_pk_bf16(v1[0], v1[1]), cvt_pk_bf16(v1[2], v1[3])};
                        *(u32x4*)((char*)p.KnImg + ((size_t)(head * 256 + tile) * 16384) + key * 256 + ((chunk ^ (key & 15)) << 4)) = o; } }
        } else {
#pragma unroll
            for (int bj = 0; bj < 2; ++bj) { const int t0 = u.pn * 256 + bj * 128 + wc * 32 + 8 * fq;
                float rs[8];
#pragma unroll
                for (int j = 0; j < 8; ++j) rs[j] = rstd4(p.ssq_kv, t0 + j, 1.f / 128.f);
                const int tile = t0 >> 6, p0 = (t0 & 48) + ((t0 & 8) >> 1);
#pragma unroll
                for (int ai = 0; ai < 2; ++ai)
#pragma unroll
                    for (int m = 0; m < 4; ++m) { asm volatile("" ::: "memory"); const int r = u.pm * 256 + ai * 128 + wr * 64 + m * 16 + fr, head = r >> 7, d = r & 127;
                        char* base = (char*)p.VtImg + ((size_t)(head * 256 + tile) * 16384) + d * 128;
                        const f32x4 v0 = acc[ai][bj][m][0], v1 = acc[ai][bj][m][1];
                        u32x2 o0 = {cvt_pk_bf16(v0[0] * rs[0], v0[1] * rs[1]), cvt_pk_bf16(v0[2] * rs[2], v0[3] * rs[3])};
                        u32x2 o1 = {cvt_pk_bf16(v1[0] * rs[4], v1[1] * rs[5]), cvt_pk_bf16(v1[2] * rs[6], v1[3] * rs[7])};
                        const int sw = (d >> 1) & 7, pa = p0, pb = p0 + 8;
                        *(u32x2*)(base + (((pa >> 3) ^ sw) << 4) + (pa & 7) * 2) = o0;
                        *(u32x2*)(base + (((pb >> 3) ^ sw) << 4) + (pb & 7) * 2) = o1; } }
        }
    }
};
__device__ __forceinline__ void kr_phase(const MlaP& p, int gtid, int gthreads) {
    for (int idx = gtid; idx < T * 4; idx += gthreads) { const int t = idx >> 2, c = idx & 3, i0 = 8 * c;
        const u32x4 a = *(const u32x4*)(p.Hp + (size_t)t * HW + H_KR + i0), b = *(const u32x4*)(p.Hp + (size_t)t * HW + H_KR + 32 + i0);
        float o1[8], o2[8];
#pragma unroll
        for (int n = 0; n < 2; ++n) { const f32x4 c4 = *(const f32x4*)(p.cs + (size_t)t * 32 + i0 + 4 * n), s4 = *(const f32x4*)(p.sn + (size_t)t * 32 + i0 + 4 * n);
#pragma unroll
            for (int j = 0; j < 4; ++j) { const int e = 4 * n + j; const unsigned wa = a[e >> 1], wb = b[e >> 1];
                const float x1 = (e & 1) ? bfhi(wa) : bflo(wa), x2 = (e & 1) ? bfhi(wb) : bflo(wb);
                o1[e] = x1 * c4[j] - x2 * s4[j]; o2[e] = x1 * s4[j] + x2 * c4[j]; } }
        u32x4 oa = {cvt_pk_bf16(o1[0], o1[1]), cvt_pk_bf16(o1[2], o1[3]), cvt_pk_bf16(o1[4], o1[5]), cvt_pk_bf16(o1[6], o1[7])};
        u32x4 ob = {cvt_pk_bf16(o2[0], o2[1]), cvt_pk_bf16(o2[2], o2[3]), cvt_pk_bf16(o2[4], o2[5]), cvt_pk_bf16(o2[6], o2[7])};
        const int tile = t >> 6, key = t & 63, sw = (key >> 1) & 7;
        char* base = (char*)p.KrImg + (size_t)tile * 8192 + key * 128;
        *(u32x4*)(base + ((c ^ sw) << 4)) = oa; *(u32x4*)(base + (((c + 4) ^ sw) << 4)) = ob; }
}
constexpr int ATT_STEPS = 130;
__device__ __forceinline__ void attn_item(LAS unsigned char* lds, const MlaP& p, int head, int b, int j0, int j1, int slot) {
    const int tid = tid_now(), wid = __builtin_amdgcn_readfirstlane(tid >> 6), lane = tid & 63, q = lane & 31, hh = lane >> 5;
    const int trow = b * 256 + wid * 32 + q;
    bf16x8 qf[12];
    { const bf16_t* qp = p.Qb + (size_t)trow * 768 + head * 192 + 8 * hh;
#pragma unroll
      for (int s = 0; s < 12; ++s) qf[s] = *(const bf16x8*)(qp + 16 * s); }
    f32x16 O[4];
#pragma unroll
    for (int d = 0; d < 4; ++d)
#pragma unroll
        for (int r = 0; r < 16; ++r) O[d][r] = 0.f;
    float m_run = -1e30f, l_run = 0.f;
    const char* knb = (const char*)p.KnImg + (size_t)head * 256 * 16384; const char* vtb = (const char*)p.VtImg + (size_t)head * 256 * 16384; const char* krb = (const char*)p.KrImg;
    const unsigned lo = (unsigned)lane * 16u;
#define AT_ISSUE(j, bi) do { const unsigned _bo = (unsigned)(bi) * 40960u; \
        __builtin_amdgcn_global_load_lds((const unsigned*)(knb + (size_t)(j) * 16384 + (wid * 2) * 1024 + lo), (LAS unsigned*)(lds + _bo + (wid * 2) * 1024), 16, 0, 0); \
        __builtin_amdgcn_global_load_lds((const unsigned*)(knb + (size_t)(j) * 16384 + (wid * 2 + 1) * 1024 + lo), (LAS unsigned*)(lds + _bo + (wid * 2 + 1) * 1024), 16, 0, 0); \
        __builtin_amdgcn_global_load_lds((const unsigned*)(krb + (size_t)(j) * 8192 + wid * 1024 + lo), (LAS unsigned*)(lds + _bo + 16384 + wid * 1024), 16, 0, 0); \
        __builtin_amdgcn_global_load_lds((const unsigned*)(vtb + (size_t)(j) * 16384 + (wid * 2) * 1024 + lo), (LAS unsigned*)(lds + _bo + 24576 + (wid * 2) * 1024), 16, 0, 0); \
        __builtin_amdgcn_global_load_lds((const unsigned*)(vtb + (size_t)(j) * 16384 + (wid * 2 + 1) * 1024 + lo), (LAS unsigned*)(lds + _bo + 24576 + (wid * 2 + 1) * 1024), 16, 0, 0); } while (0)
    const int kn_off0 = q * 256, kn_sw = q & 15, kr_off0 = q * 128, kr_sw = (q >> 1) & 7;
    const int vt_sw = (q >> 1) & 7;
    constexpr float THR = 8.f;
    AT_ISSUE(j0, 0);
    if (j0 + 1 < j1) AT_ISSUE(j0 + 1, 1);
    bool first = true;
    for (int j = j0; j < j1; ++j) {
        const int cur = (j - j0) % 3;
        if (j + 1 < j1) asm volatile("s_waitcnt vmcnt(5)" ::: "memory"); else asm volatile("s_waitcnt vmcnt(0)" ::: "memory");
        __builtin_amdgcn_s_barrier(); asm volatile("" ::: "memory");
        if (j + 2 < j1) AT_ISSUE(j + 2, (j + 2 - j0) % 3);
        const int jj = j - 4 * b;
        if (!(jj >= 0 && 64 * jj > 32 * wid + 31)) {
            LAS unsigned char* bb = lds + cur * 40960;
            const float mref = first ? 0.f : m_run;
            f32x16 S0, S1;
#pragma unroll
            for (int r = 0; r < 16; ++r) { S0[r] = -mref; S1[r] = -mref; }
#pragma unroll
            for (int s = 0; s < 8; ++s) {
                const bf16x8 k0 = *(const LAS bf16x8*)(bb + kn_off0 + (((2 * s + hh) ^ kn_sw) << 4));
                const bf16x8 k1 = *(const LAS bf16x8*)(bb + 8192 + kn_off0 + (((2 * s + hh) ^ kn_sw) << 4));
                S0 = __builtin_amdgcn_mfma_f32_32x32x16_bf16(k0, qf[s], S0, 0, 0, 0);
                S1 = __builtin_amdgcn_mfma_f32_32x32x16_bf16(k1, qf[s], S1, 0, 0, 0); }
#pragma unroll
            for (int s = 0; s < 4; ++s) {
                const bf16x8 k0 = *(const LAS bf16x8*)(bb + 16384 + kr_off0 + (((2 * s + hh) ^ kr_sw) << 4));
                const bf16x8 k1 = *(const LAS bf16x8*)(bb + 16384 + 4096 + kr_off0 + (((2 * s + hh) ^ kr_sw) << 4));
                S0 = __builtin_amdgcn_mfma_f32_32x32x16_bf16(k0, qf[8 + s], S0, 0, 0, 0);
                S1 = __builtin_amdgcn_mfma_f32_32x32x16_bf16(k1, qf[8 + s], S1, 0, 0, 0); }
            if (jj >= 0) {
                const int dq = wid * 32 + q - 64 * jj - 4 * hh;
                const float NEG = -__builtin_inff();
#pragma unroll
                for (int r = 0; r < 16; ++r) { const int c = (r & 3) + 8 * (r >> 2);
                    if (c > dq) S0[r] = NEG;
                    if (c + 32 > dq) S1[r] = NEG; } }
            float mx = S0[0];
#pragma unroll
            for (int r = 1; r < 16; ++r) mx = fmaxf(mx, S0[r]);
#pragma unroll
            for (int r = 0; r < 16; ++r) mx = fmaxf(mx, S1[r]);
            { auto rr = __builtin_amdgcn_permlane32_swap(__float_as_uint(mx), __float_as_uint(mx), false, false); mx = fmaxf(__uint_as_float(rr[0]), __uint_as_float(rr[1])); }
            float alpha = 1.f;
            if (first || !__all(mx <= THR)) {
                const float mn = fmaxf(m_run, mref + mx), sh = mn - mref;
                alpha = __builtin_amdgcn_exp2f(m_run - mn); m_run = mn;
#pragma unroll
                for (int r = 0; r < 16; ++r) { S0[r] -= sh; S1[r] -= sh; }
#pragma unroll
                for (int d = 0; d < 4; ++d)
#pragma unroll
                    for (int r = 0; r < 16; ++r) O[d][r] *= alpha;
                first = false;
            }
            float sum = 0.f;
#pragma unroll
            for (int r = 0; r < 16; ++r) { S0[r] = __builtin_amdgcn_exp2f(S0[r]); S1[r] = __builtin_amdgcn_exp2f(S1[r]); sum += S0[r] + S1[r]; }
            l_run = l_run * alpha + sum;
            bf16x8 pf[4];
#pragma unroll
            for (int h2 = 0; h2 < 2; ++h2) {
                u32x4 a = {cvt_pk_bf16(S0[8 * h2 + 0], S0[8 * h2 + 1]), cvt_pk_bf16(S0[8 * h2 + 2], S0[8 * h2 + 3]), cvt_pk_bf16(S0[8 * h2 + 4], S0[8 * h2 + 5]), cvt_pk_bf16(S0[8 * h2 + 6], S0[8 * h2 + 7])};
                u32x4 c = {cvt_pk_bf16(S1[8 * h2 + 0], S1[8 * h2 + 1]), cvt_pk_bf16(S1[8 * h2 + 2], S1[8 * h2 + 3]), cvt_pk_bf16(S1[8 * h2 + 4], S1[8 * h2 + 5]), cvt_pk_bf16(S1[8 * h2 + 6], S1[8 * h2 + 7])};
                pf[h2] = *(bf16x8*)&a; pf[2 + h2] = *(bf16x8*)&c; }
#pragma unroll
            for (int d = 0; d < 4; ++d) {
#pragma unroll
                for (int s2 = 0; s2 < 4; ++s2) {
                    const bf16x8 vf = *(const LAS bf16x8*)(bb + 24576 + (d * 32 + q) * 128 + (((2 * s2 + hh) ^ vt_sw) << 4));
                    O[d] = __builtin_amdgcn_mfma_f32_32x32x16_bf16(vf, pf[s2], O[d], 0, 0, 0); } }
        }
    }
    asm volatile("" ::: "memory"); __builtin_amdgcn_s_barrier(); asm volatile("" ::: "memory");
#undef AT_ISSUE
    { auto rr = __builtin_amdgcn_permlane32_swap(__float_as_uint(l_run), __float_as_uint(l_run), false, false); l_run = __uint_as_float(rr[0]) + __uint_as_float(rr[1]); }
    bf16_t* op = (bf16_t*)p.Opart + ((size_t)slot * 256 + wid * 32 + q) * 128 + 4 * hh;
#pragma unroll
    for (int d = 0; d < 4; ++d)
#pragma unroll
        for (int g = 0; g < 4; ++g) { u32x2 v = {cvt_pk_bf16(O[d][4 * g], O[d][4 * g + 1]), cvt_pk_bf16(O[d][4 * g + 2], O[d][4 * g + 3])}; *(u32x2*)(op + d * 32 + g * 8) = v; }
    if (hh == 0) { float* ml = p.MLpart + ((size_t)slot * 256 + wid * 32 + q) * 2; ml[0] = m_run; ml[1] = l_run; }
}
__device__ __forceinline__ void attn_phase(LAS unsigned char* lds, const MlaP& p, int c) {
    int L = ATT_STEPS * c; const int Lend = L + ATT_STEPS;
    while (L < Lend) {
        const int head = L / 8320, rem = L - head * 8320;
        int b = (int)((sqrtf(1.f + 2.f * (float)rem) - 1.f) * 0.5f);
        while (2 * b * (b + 1) > rem) --b;
        while (2 * (b + 1) * (b + 2) <= rem) ++b;
        const int j0 = rem - 2 * b * (b + 1), nt = 4 * (b + 1);
        const int j1 = min(nt, j0 + (Lend - L));
        attn_item(lds, p, head, b, j0, j1, head * 64 + b + c);
        L += j1 - j0;
    }
}
struct GlaP {
    const bf16_t* Hp; const bf16_t* GVt; const float* wg; const float* bg; const float* ng; const float* wconv;
    bf16_t* QE; float* OI; float* kvT; float* decay; bf16_t* spT; bf16_t* Yab; bf16_t* Ybb; bf16_t* Ycb;
    const float* Opart; const float* MLpart;
};
__device__ __forceinline__ int pos16(int i) { return (i & 48) | ((i & 4) << 1) | ((i & 8) >> 1) | (i & 3); }
__device__ __forceinline__ void gla_g1(LAS unsigned char* lds, const GlaP& p, int c, int G) {
    const int tid = tid_now(), wid = __builtin_amdgcn_readfirstlane(tid >> 6), lane = tid & 63, l31 = lane & 31, hh = lane >> 5;
    LAS float* bsm = (LAS float*)lds; LAS float* gtot = (LAS float*)(lds + 17408); LAS float* blast = (LAS float*)(lds + 19456);
    LAS unsigned char* qeL = lds + 20480; LAS unsigned char* keL = lds + 28672; LAS unsigned char* ktL = lds + 36864;
    const int eb = wid & 3, hb = wid >> 2;
    for (int u = c; u < 1024; u += G) {
        const int n = u >> 2, h = u & 3;
        bf16x8 vf[4];
        { const bf16_t* vp = p.GVt + ((size_t)u * 128 + eb * 32 + l31) * 64 + 8 * hh;
#pragma unroll
          for (int s4 = 0; s4 < 4; ++s4) vf[s4] = *(const bf16x8*)(vp + 16 * s4); }
        { const int d = tid & 63, g = tid >> 6;
          float w[16];
#pragma unroll
          for (int r = 0; r < 16; ++r) w[r] = p.wg[r * 256 + h * 64 + d];
          const float bias = p.bg[h * 64 + d];
          float cs[8]; float run = 0.f;
#pragma unroll
          for (int k = 0; k < 8; ++k) { const int i = 8 * g + k;
              const u32x4 g0 = *(const u32x4*)(p.Hp + (size_t)(64 * n + i) * HW + H_GLR), g1 = *(const u32x4*)(p.Hp + (size_t)(64 * n + i) * HW + H_GLR + 8);
              float la = bias;
#pragma unroll
              for (int r = 0; r < 4; ++r) { la += bflo(g0[r]) * w[2 * r] + bfhi(g0[r]) * w[2 * r + 1]; la += bflo(g1[r]) * w[8 + 2 * r] + bfhi(g1[r]) * w[8 + 2 * r + 1]; }
              const float ls = (fminf(la, 0.f) - log1pf(expf(-fabsf(la)))) * (1.f / 16.f);
              run += ls; cs[k] = run; }
          gtot[g * 64 + d] = run;
          __syncthreads();
          float pre = 0.f, tot = 0.f;
#pragma unroll
          for (int gg = 0; gg < 8; ++gg) { const float v = gtot[gg * 64 + d]; tot += v; if (gg < g) pre += v; }
#pragma unroll
          for (int k = 0; k < 8; ++k) bsm[(8 * g + k) * 68 + d] = pre + cs[k];
          if (g == 0) { blast[d] = tot; p.decay[(size_t)u * 64 + d] = expf(tot); } }
        __syncthreads();
        { const int i = tid >> 3, cc = tid & 7, d0 = 8 * cc; const size_t t = (size_t)64 * n + i;
          const u32x4 qv = *(const u32x4*)(p.Hp + t * HW + H_GQ + h * 64 + d0), kv = *(const u32x4*)(p.Hp + t * HW + H_GK + h * 64 + d0);
          float b[8], bl[8];
          { const f32x4 b0 = *(const LAS f32x4*)(bsm + i * 68 + d0), b1 = *(const LAS f32x4*)(bsm + i * 68 + d0 + 4), l0 = *(const LAS f32x4*)(blast + d0), l1 = *(const LAS f32x4*)(blast + d0 + 4);
#pragma unroll
            for (int j = 0; j < 4; ++j) { b[j] = b0[j]; b[4 + j] = b1[j]; bl[j] = l0[j]; bl[4 + j] = l1[j]; } }
          float qe[8], ke[8], kt[8];
#pragma unroll
          for (int j = 0; j < 8; ++j) { const float qq = (j & 1) ? bfhi(qv[j >> 1]) : bflo(qv[j >> 1]), kk = (j & 1) ? bfhi(kv[j >> 1]) : bflo(kv[j >> 1]);
              qe[j] = qq * 0.125f * expf(b[j]); ke[j] = kk * expf(-b[j]); kt[j] = kk * expf(bl[j] - b[j]); }
          const u32x4 qo = {cvt_pk_bf16(qe[0], qe[1]), cvt_pk_bf16(qe[2], qe[3]), cvt_pk_bf16(qe[4], qe[5]), cvt_pk_bf16(qe[6], qe[7])};
          const u32x4 ko = {cvt_pk_bf16(ke[0], ke[1]), cvt_pk_bf16(ke[2], ke[3]), cvt_pk_bf16(ke[4], ke[5]), cvt_pk_bf16(ke[6], ke[7])};
          const int sw = (i >> 1) & 7;
          *(LAS u32x4*)(qeL + i * 128 + ((cc ^ sw) << 4)) = qo; *(LAS u32x4*)(keL + i * 128 + ((cc ^ sw) << 4)) = ko;
          *(u32x4*)(p.QE + t * 256 + h * 64 + d0) = qo;
          const int pi = pos16(i);
#pragma unroll
          for (int j = 0; j < 8; ++j) { const int d = d0 + j; const unsigned pk = cvt_pk_bf16(kt[j], 0.f);
              *(LAS unsigned short*)(ktL + d * 128 + (((pi >> 3) ^ ((d >> 1) & 7)) << 4) + (pi & 7) * 2) = (unsigned short)pk; } }
        __syncthreads();
        { f32x16 OT, KV;
#pragma unroll
          for (int r = 0; r < 16; ++r) { OT[r] = 0.f; KV[r] = 0.f; }
          const int sw = (l31 >> 1) & 7;
#pragma unroll
          for (int jb = 0; jb < 2; ++jb) {
              if (jb <= hb) {
                  f32x16 Sc;
#pragma unroll
                  for (int r = 0; r < 16; ++r) Sc[r] = 0.f;
#pragma unroll
                  for (int s = 0; s < 4; ++s) {
                      const bf16x8 ka = *(const LAS bf16x8*)(keL + (32 * jb + l31) * 128 + (((2 * s + hh) ^ sw) << 4));
                      const bf16x8 qb = *(const LAS bf16x8*)(qeL + (32 * hb + l31) * 128 + (((2 * s + hh) ^ sw) << 4));
                      Sc = __builtin_amdgcn_mfma_f32_32x32x16_bf16(ka, qb, Sc, 0, 0, 0); }
                  if (jb == hb) {
#pragma unroll
                      for (int r = 0; r < 16; ++r) { const int j = (r & 3) + 8 * (r >> 2) + 4 * hh; if (j > l31) Sc[r] = 0.f; } }
#pragma unroll
                  for (int h2 = 0; h2 < 2; ++h2) {
                      u32x4 a = {cvt_pk_bf16(Sc[8 * h2 + 0], Sc[8 * h2 + 1]), cvt_pk_bf16(Sc[8 * h2 + 2], Sc[8 * h2 + 3]), cvt_pk_bf16(Sc[8 * h2 + 4], Sc[8 * h2 + 5]), cvt_pk_bf16(Sc[8 * h2 + 6], Sc[8 * h2 + 7])};
                      OT = __builtin_amdgcn_mfma_f32_32x32x16_bf16(vf[2 * jb + h2], *(bf16x8*)&a, OT, 0, 0, 0); } } }
#pragma unroll
          for (int s4 = 0; s4 < 4; ++s4) {
              const bf16x8 kb = *(const LAS bf16x8*)(ktL + (32 * hb + l31) * 128 + (((2 * s4 + hh) ^ sw) << 4));
              KV = __builtin_amdgcn_mfma_f32_32x32x16_bf16(vf[s4], kb, KV, 0, 0, 0); }
          float* oi = p.OI + ((size_t)u * 8 + wid) * 1024 + lane;
#pragma unroll
          for (int r = 0; r < 16; ++r) oi[r * 64] = OT[r];
          float* kp = p.kvT + (size_t)u * 8192 + 32 * hb + l31;
#pragma unroll
          for (int r = 0; r < 16; ++r) { const int e = 32 * eb + (r & 3) + 8 * (r >> 2) + 4 * hh; kp[e * 64] = KV[r]; } }
        __syncthreads();
    }
}
__device__ __forceinline__ void gla_g2(LAS unsigned char* lds, const GlaP& p, int c) {
    const int tid = tid_now(), el = tid & 127, seg = tid >> 7;
    const int idx = c * 128 + el, h = idx >> 13, ed = idx & 8191, d = idx & 63;
    LAS float* segS = (LAS float*)lds; LAS float* segD = (LAS float*)(lds + 2048);
    float st = 0.f, dp = 1.f;
    for (int n0 = seg * 64; n0 < seg * 64 + 64; n0 += 16) {
        float kv[16], dc[16];
#pragma unroll
        for (int k = 0; k < 16; ++k) { const size_t u = (size_t)(n0 + k) * 4 + h; kv[k] = p.kvT[u * 8192 + ed]; dc[k] = p.decay[u * 64 + d]; }
#pragma unroll
        for (int k = 0; k < 16; ++k) { st = fmaf(dc[k], st, kv[k]); dp *= dc[k]; }
    }
    __syncthreads();
    segS[seg * 128 + el] = st; segD[seg * 128 + el] = dp;
    __syncthreads();
    st = 0.f;
    for (int s2 = 0; s2 < seg; ++s2) st = fmaf(segD[s2 * 128 + el], st, segS[s2 * 128 + el]);
    for (int n0 = seg * 64; n0 < seg * 64 + 64; n0 += 16) {
        float kv[16], dc[16];
#pragma unroll
        for (int k = 0; k < 16; ++k) { const size_t u = (size_t)(n0 + k) * 4 + h; kv[k] = p.kvT[u * 8192 + ed]; dc[k] = p.decay[u * 64 + d]; }
#pragma unroll
        for (int k = 0; k < 16; ++k) { const size_t u = (size_t)(n0 + k) * 4 + h; p.spT[u * 8192 + ed] = (bf16_t)(cvt_pk_bf16(st, 0.f) & 0xffffu); st = fmaf(dc[k], st, kv[k]); }
    }
    __syncthreads();
}
__device__ __forceinline__ void gla_g3(LAS unsigned char* lds, const GlaP& p, int c, int G) {
    const int tid = tid_now(), wid = __builtin_amdgcn_readfirstlane(tid >> 6), lane = tid & 63, l31 = lane & 31, hh = lane >> 5;
    LAS float* red = (LAS float*)lds;
    const int eb = wid & 3, ib = wid >> 2;
    struct In { f32x16 oi; bf16x8 sp[4], qe[4]; u32x2 rv[4]; };
    auto load = [&](int u, In& x) __attribute__((always_inline)) {
        const int n = u >> 2, h = u & 3; const size_t t = (size_t)64 * n + 32 * ib + l31;
        const float* oi = p.OI + ((size_t)u * 8 + wid) * 1024 + lane;
#pragma unroll
        for (int r = 0; r < 16; ++r) x.oi[r] = oi[r * 64];
        const bf16_t* sp = p.spT + ((size_t)u * 128 + 32 * eb + l31) * 64 + 8 * hh; const bf16_t* qp = p.QE + t * 256 + h * 64 + 8 * hh;
#pragma unroll
        for (int s = 0; s < 4; ++s) { x.sp[s] = *(const bf16x8*)(sp + 16 * s); x.qe[s] = *(const bf16x8*)(qp + 16 * s); }
#pragma unroll
        for (int g = 0; g < 4; ++g) x.rv[g] = *(const u32x2*)(p.Hp + t * HW + H_GR + h * 128 + 32 * eb + 8 * g + 4 * hh);
    };
    In cur, nxt;
    if (c < 1024) load(c, cur);
    for (int u = c; u < 1024; u += G) {
        const int n = u >> 2, h = u & 3;
        const bool hn = u + G < 1024;
        if (hn) load(u + G, nxt);
        f32x16 O = cur.oi;
        const size_t t = (size_t)64 * n + 32 * ib + l31;
#pragma unroll
        for (int s = 0; s < 4; ++s) O = __builtin_amdgcn_mfma_f32_32x32x16_bf16(cur.sp[s], cur.qe[s], O, 0, 0, 0);
        float ss = 0.f;
#pragma unroll
        for (int r = 0; r < 16; ++r) ss += O[r] * O[r];
        { auto rr = __builtin_amdgcn_permlane32_swap(__float_as_uint(ss), __float_as_uint(ss), false, false); ss = __uint_as_float(rr[0]) + __uint_as_float(rr[1]); }
        __syncthreads();
        if (hh == 0) red[eb * 64 + 32 * ib + l31] = ss;
        __syncthreads();
        const int ti = 32 * ib + l31;
        const float tot = (red[ti] + red[64 + ti]) + (red[128 + ti] + red[192 + ti]);
        const float rs = rsqrtf(tot * (1.f / 128.f) + 1e-6f);
#pragma unroll
        for (int g = 0; g < 4; ++g) { const int e0 = 32 * eb + 8 * g + 4 * hh;
            const u32x2 rv = cur.rv[g]; const f32x4 gn = *(const f32x4*)(p.ng + e0);
            float y[4];
#pragma unroll
            for (int j = 0; j < 4; ++j) { const float r_ = (j & 1) ? bfhi(rv[j >> 1]) : bflo(rv[j >> 1]); y[j] = O[4 * g + j] * rs * gn[j] * (r_ / (1.f + __expf(-r_))); }
            u32x2 o = {cvt_pk_bf16(y[0], y[1]), cvt_pk_bf16(y[2], y[3])};
            *(u32x2*)(p.Ybb + t * 512 + h * 128 + e0) = o; }
        if (hn) cur = nxt;
    }
}
__device__ __forceinline__ void conv_phase(const GlaP& p, int gtid, int gthreads) {
    constexpr int NT = T * 64;
    for (int idx0 = gtid; idx0 < NT; idx0 += 2 * gthreads) {
        u32x4 av[2][3], xv[2][3], bv[2]; int tt[2], cc[2];
#pragma unroll
        for (int u = 0; u < 2; ++u) { const int idx = min(idx0 + u * gthreads, NT - 1); const int t = idx >> 6, c0 = (idx & 63) * 8; tt[u] = t; cc[u] = c0;
#pragma unroll
            for (int k = 0; k < 3; ++k) { const int ts = max(t - 2 + k, 0);
                av[u][k] = *(const u32x4*)(p.Hp + (size_t)ts * HW + H_AC + c0); xv[u][k] = *(const u32x4*)(p.Hp + (size_t)ts * HW + H_AX + c0); }
            bv[u] = *(const u32x4*)(p.Hp + (size_t)t * HW + H_AB + c0); }
#pragma unroll
        for (int u = 0; u < 2; ++u) { if (idx0 + u * gthreads < NT) { const int t = tt[u], c0 = cc[u];
            float y[8];
#pragma unroll
            for (int j = 0; j < 8; ++j) y[j] = 0.f;
#pragma unroll
            for (int k = 0; k < 3; ++k) { if (t - 2 + k >= 0) {
                const f32x4 w0 = *(const f32x4*)(p.wconv + k * 512 + c0), w1 = *(const f32x4*)(p.wconv + k * 512 + c0 + 4);
#pragma unroll
                for (int j = 0; j < 4; ++j) { y[2 * j] += (j < 2 ? w0[2 * j] : w1[2 * j - 4]) * (bflo(av[u][k][j]) * bflo(xv[u][k][j])); y[2 * j + 1] += (j < 2 ? w0[2 * j + 1] : w1[2 * j - 3]) * (bfhi(av[u][k][j]) * bfhi(xv[u][k][j])); } } }
            u32x4 o;
#pragma unroll
            for (int j = 0; j < 4; ++j) o[j] = cvt_pk_bf16(bflo(bv[u][j]) * y[2 * j], bfhi(bv[u][j]) * y[2 * j + 1]);
            *(u32x4*)(p.Yab + (size_t)t * 512 + c0) = o; } }
    }
}
__device__ __forceinline__ void attn_combine_bf16(const GlaP& p, int gtid, int gthreads) {
    constexpr int NT = 256 * 256 * 32;
    for (int idx0 = gtid; idx0 < NT; idx0 += 2 * gthreads) {
        float mv[2][3], lv[2][3]; u32x2 ov[2][3]; int nval[2]; size_t orow[2]; int ocol[2];
#pragma unroll
        for (int u = 0; u < 2; ++u) { const int idx = min(idx0 + u * gthreads, NT - 1);
            const int dq = idx & 31, row = (idx >> 5) & 255, g = idx >> 13, head = g >> 6, b = g & 63;
            const int Ls = head * 8320 + 2 * b * (b + 1), Le = Ls + 4 * (b + 1);
            const int c0 = Ls / ATT_STEPS, c1 = (Le - 1) / ATT_STEPS;
            nval[u] = c1 - c0 + 1; orow[u] = (size_t)(b * 256 + row) * 512 + head * 128; ocol[u] = dq * 4;
#pragma unroll
            for (int k = 0; k < 3; ++k) { const size_t sl = (size_t)(g + min(c0 + k, c1)) * 256 + row;
                const f32x2 ml = *(const f32x2*)(p.MLpart + sl * 2); mv[u][k] = ml[0]; lv[u][k] = ml[1];
                ov[u][k] = *(const u32x2*)((const bf16_t*)p.Opart + sl * 128 + dq * 4); } }
#pragma unroll
        for (int u = 0; u < 2; ++u) { if (idx0 + u * gthreads < NT) {
            float M = mv[u][0];
#pragma unroll
            for (int k = 1; k < 3; ++k) if (k < nval[u]) M = fmaxf(M, mv[u][k]);
            f32x4 acc = {0.f, 0.f, 0.f, 0.f}; float l = 0.f;
#pragma unroll
            for (int k = 0; k < 3; ++k) { const float w = k < nval[u] ? __builtin_amdgcn_exp2f(mv[u][k] - M) : 0.f;
                l += w * lv[u][k]; const f32x4 o = {bflo(ov[u][k][0]), bfhi(ov[u][k][0]), bflo(ov[u][k][1]), bfhi(ov[u][k][1])}; acc += o * w; }
            const float il = 1.f / l;
            u32x2 o = {cvt_pk_bf16(acc[0] * il, acc[1] * il), cvt_pk_bf16(acc[2] * il, acc[3] * il)};
            *(u32x2*)(p.Ycb + orow[u] + ocol[u]) = o; } }
    }
}
struct P {
    const float *x, *pin; const int* pos;
    const float *ln0_g, *ln0_b, *w_in, *w_conv, *w_gg, *b_gg, *gla_ng, *qn_g, *kvn_g, *w_uq, *w_ukv, *w_br, *w_o, *ln1_g, *ln1_b, *w_grp, *b_grp, *w_exp, *b_exp,
                *w_gate, *w_up, *w_down, *ln2_g, *ln2_b, *w_pg, *b_pg, *w_pu, *ln3_g, *ln3_b;
    float* out;
    float *X, *Z, *cs, *sn, *ssq_q, *ssq_kv, *OI, *kvT, *decay, *MLpart, *ew;
    bf16_t *Db, *Xb, *Hp, *GVt, *Qb, *KnImg, *VtImg, *KrImg, *QE, *spT, *Yab, *Ybb, *Ycb, *Mgb, *Hbuf, *Ys, *Ub, *Pb;
    bf16_t *Wb_in, *Wb_gv, *Wb_uq, *Wb_uk, *Wb_uv, *Wb_br, *Wb_o, *Wb_gu, *Wb_d, *Wb_pg, *Wb_pu;
    int *cnt, *lists; unsigned* bar;
};
__device__ __forceinline__ MegaP mk_mega(const P& p) { MegaP m; m.w_in = p.w_in; m.Wb_in = p.Wb_in; m.Wb_gv = p.Wb_gv; m.Xb = p.Xb; m.Hp = p.Hp; m.GVt = p.GVt; m.ssq_q = p.ssq_q; m.ssq_kv = p.ssq_kv; return m; }
__device__ __forceinline__ MlaP mk_mla(const P& p) { MlaP q; q.w_uq = p.w_uq; q.w_ukv = p.w_ukv; q.qn_g = p.qn_g; q.kvn_g = p.kvn_g; q.Wb_uq = p.Wb_uq; q.Wb_uk = p.Wb_uk; q.Wb_uv = p.Wb_uv; q.Hp = p.Hp;
    q.ssq_q = p.ssq_q; q.ssq_kv = p.ssq_kv; q.cs = p.cs; q.sn = p.sn; q.Qb = p.Qb; q.KnImg = p.KnImg; q.VtImg = p.VtImg; q.KrImg = p.KrImg; q.Opart = p.Z; q.MLpart = p.MLpart; q.Yc = nullptr; return q; }
__device__ __forceinline__ GlaP mk_gla(const P& p, int layer) { GlaP g; g.Hp = p.Hp; g.GVt = p.GVt; g.wg = p.w_gg + layer * 16 * 256; g.bg = p.b_gg + layer * 256; g.ng = p.gla_ng + layer * 128; g.wconv = p.w_conv + layer * 3 * 512;
    g.QE = p.QE; g.OI = p.OI; g.kvT = p.kvT; g.decay = p.decay; g.spT = p.spT; g.Yab = p.Yab; g.Ybb = p.Ybb; g.Ycb = p.Ycb; g.Opart = p.Z; g.MLpart = p.MLpart; return g; }

struct CvJob { const float* W; bf16_t* Bt; const float* rs; int ldw, Ksrc, ldbt, n0, k0, kind, aux; };
struct MapId { __device__ __forceinline__ int operator()(int s) const { return s; } };
__device__ __forceinline__ int cv_map(int kind, int aux, int n) {
    if (kind == 0) return MapInMain{}(n);
    if (kind == 1) return aux + n;
    if (kind == 2) return MapQ{}(n);
    if (kind == 3) return MapKV{aux}(n);
    return n; }
__device__ __forceinline__ int cv_omap(int kind, int aux, int n) { return kind == 4 ? (n >> 7) * 256 + aux * 128 + (n & 127) : n; }
__device__ __forceinline__ bool cv_job(const P& p, int layer, int t, CvJob& j) {
    constexpr int S0 = 384, S1 = S0 + 32, S2 = S1 + 12, S3 = S2 + 8, S4 = S3 + 8, S5 = S4 + 96, S6 = S5 + 64, S7 = S6 + 64, S8 = S7 + 16, S9 = S8 + 1024, S10 = S9 + 1024, S11 = S10 + 1024;
    if (t >= S11) return false;
    j.rs = nullptr; j.aux = 0; j.kind = 5;
    if (t < S0) { j.W = p.w_in + (size_t)layer * D * INW; j.ldw = INW; j.Ksrc = D; j.Bt = p.Wb_in; j.ldbt = D; j.n0 = (t >> 2) * 64; j.k0 = (t & 3) * 256; j.kind = 0; }
    else if (t < S1) { const int u = t - S0; j.W = p.w_in + (size_t)layer * D * INW; j.ldw = INW; j.Ksrc = D; j.Bt = p.Wb_gv; j.ldbt = D; j.n0 = (u >> 2) * 64; j.k0 = (u & 3) * 256; j.kind = 1; j.aux = O_GV; }
    else if (t < S2) { const int u = t - S1; j.W = p.w_uq + (size_t)layer * 256 * 768; j.ldw = 768; j.Ksrc = 256; j.Bt = p.Wb_uq; j.ldbt = 256; j.n0 = u * 64; j.k0 = 0; j.kind = 2; j.rs = p.qn_g + layer * 256; }
    else if (t < S3) { const int u = t - S2; j.W = p.w_ukv + (size_t)layer * 128 * 1024; j.ldw = 1024; j.Ksrc = 128; j.Bt = p.Wb_uk; j.ldbt = 256; j.n0 = u * 64; j.k0 = 0; j.kind = 3; j.aux = 0; j.rs = p.kvn_g + layer * 128; }
    else if (t < S4) { const int u = t - S3; j.W = p.w_ukv + (size_t)layer * 128 * 1024; j.ldw = 1024; j.Ksrc = 128; j.Bt = p.Wb_uv; j.ldbt = 256; j.n0 = u * 64; j.k0 = 0; j.kind = 3; j.aux = 128; j.rs = p.kvn_g + layer * 128; }
    else if (t < S5) { const int u = t - S4, br = u >> 5, v = u & 31; j.W = p.w_br + (size_t)layer * 1536 * D + (size_t)br * 512 * D; j.ldw = D; j.Ksrc = 512; j.Bt = p.Wb_br + (size_t)br * 1024 * 512; j.ldbt = 512; j.n0 = (v >> 1) * 64; j.k0 = (v & 1) * 256; }
    else if (t < S6) { const int u = t - S5; j.W = p.w_o + (size_t)layer * D * D; j.ldw = D; j.Ksrc = D; j.Bt = p.Wb_o; j.ldbt = D; j.n0 = (u >> 2) * 64; j.k0 = (u & 3) * 256; }
    else if (t < S7) { const int u = t - S6; j.W = p.w_pg + (size_t)layer * D * D; j.ldw = D; j.Ksrc = D; j.Bt = p.Wb_pg; j.ldbt = D; j.n0 = (u >> 2) * 64; j.k0 = (u & 3) * 256; }
    else if (t < S8) { const int u = t - S7; j.W = p.w_pu + (size_t)layer * PLE * D; j.ldw = D; j.Ksrc = PLE; j.Bt = p.Wb_pu; j.ldbt = PLE; j.n0 = u * 64; j.k0 = 0; }
    else if (t < S9) { const int u = t - S8, e = u >> 4, v = u & 15; j.W = p.w_gate + ((size_t)layer * NE + e) * D * EH; j.ldw = EH; j.Ksrc = D; j.Bt = p.Wb_gu + (size_t)e * 512 * D; j.ldbt = D; j.n0 = (v >> 2) * 64; j.k0 = (v & 3) * 256; j.kind = 4; j.aux = 0; }
    else if (t < S10) { const int u = t - S9, e = u >> 4, v = u & 15; j.W = p.w_up + ((size_t)layer * NE + e) * D * EH; j.ldw = EH; j.Ksrc = D; j.Bt = p.Wb_gu + (size_t)e * 512 * D; j.ldbt = D; j.n0 = (v >> 2) * 64; j.k0 = (v & 3) * 256; j.kind = 4; j.aux = 1; }
    else { const int u = t - S10, e = u >> 4, v = u & 15; j.W = p.w_down + ((size_t)layer * NE + e) * EH * D; j.ldw = D; j.Ksrc = EH; j.Bt = p.Wb_d + (size_t)e * D * EH; j.ldbt = EH; j.n0 = v * 64; j.k0 = 0; }
    return true; }
__device__ __forceinline__ void cv_load(const CvJob& j, int tid, f32x4 (&v)[8]) {
    const int n4 = tid & 15, kr = tid >> 4; const int col = cv_map(j.kind, j.aux, j.n0 + 4 * n4);
#pragma unroll
    for (int r = 0; r < 8; ++r) { const int k = j.k0 + kr + 32 * r; v[r] = (f32x4){0.f, 0.f, 0.f, 0.f};
        if (col >= 0 && k < j.Ksrc) { v[r] = *(const f32x4*)(j.W + (size_t)k * j.ldw + col); if (j.rs) v[r] = v[r] * j.rs[k]; } }
}
__device__ __forceinline__ void ph_convert(LAS unsigned char* ldsl, const P& p, int layer) {
    LAS float* tile = (LAS float*)ldsl;
    const int tid = tid_now(), c = sgpr_now((int)blockIdx.x), G = gridDim.x;
    CvJob cur, nxt; f32x4 v[8], w[8];
    bool have = cv_job(p, layer, c, cur);
    if (have) cv_load(cur, tid, v);
    for (int t = c; have; t += G) {
        const bool hn = cv_job(p, layer, t + G, nxt);
        if (hn) cv_load(nxt, tid, w);
        __syncthreads();
        { const int n4 = tid & 15, kr = tid >> 4;
#pragma unroll
          for (int r = 0; r < 8; ++r) { LAS float* d = tile + (kr + 32 * r) * 65 + 4 * n4; d[0] = v[r][0]; d[1] = v[r][1]; d[2] = v[r][2]; d[3] = v[r][3]; } }
        __syncthreads();
        { const int kk = (tid & 127) * 2, nn = tid >> 7;
#pragma unroll
          for (int r = 0; r < 16; ++r) { const int n = nn + 4 * r;
              *(unsigned*)(cur.Bt + (size_t)cv_omap(cur.kind, cur.aux, cur.n0 + n) * cur.ldbt + cur.k0 + kk) = cvt_pk_bf16(tile[kk * 65 + n], tile[(kk + 1) * 65 + n]); } }
        have = hn; cur = nxt;
#pragma unroll
        for (int r = 0; r < 8; ++r) v[r] = w[r];
    }
    __syncthreads();
}

__device__ __forceinline__ float wsum(float v, int lane) {
#pragma unroll
    for (int o = 32; o > 0; o >>= 1) v += shx(v, o, lane);
    return v; }
template <int MODE>
__device__ __forceinline__ void ph_rows(const P& p, int layer) {
    const int lane = tid_now() & 63, gw = blockIdx.x * 8 + (tid_now() >> 6), nw = gridDim.x * 8;
    const float* gp = MODE == 0 ? p.ln0_g : MODE == 1 ? p.ln1_g + layer * D : MODE == 2 ? p.ln2_g + layer * D : p.ln3_g + layer * D;
    const float* bp = MODE == 0 ? p.ln0_b : MODE == 1 ? p.ln1_b + layer * D : MODE == 2 ? p.ln2_b + layer * D : p.ln3_b + layer * D;
    f32x4 gg[4], bb[4];
#pragma unroll
    for (int i = 0; i < 4; ++i) { gg[i] = *(const f32x4*)(gp + 256 * i + 4 * lane); bb[i] = *(const f32x4*)(bp + 256 * i + 4 * lane); }
    const float* in = MODE == 0 ? p.x : p.X;
    float* outf = (MODE == 3 && layer == DEPTH - 1) ? p.out : p.X;
    for (int row = gw; row < T; row += nw) {
        f32x4 v[4];
#pragma unroll
        for (int i = 0; i < 4; ++i) v[i] = *(const f32x4*)(in + (size_t)row * D + 256 * i + 4 * lane);
        if constexpr (MODE == 3) {
#pragma unroll
            for (int i = 0; i < 4; ++i) { const u32x2 dd = *(const u32x2*)(p.Db + (size_t)row * D + 256 * i + 4 * lane);
                v[i][0] = DN_ALPHA * v[i][0] + bflo(dd[0]); v[i][1] = DN_ALPHA * v[i][1] + bfhi(dd[0]); v[i][2] = DN_ALPHA * v[i][2] + bflo(dd[1]); v[i][3] = DN_ALPHA * v[i][3] + bfhi(dd[1]); } }
        if constexpr (MODE == 2) { const float w0 = p.ew[2 * row], w1 = p.ew[2 * row + 1];
#pragma unroll
            for (int i = 0; i < 4; ++i) { const u32x2 y0 = *(const u32x2*)(p.Ys + (size_t)(2 * row) * D + 256 * i + 4 * lane), y1 = *(const u32x2*)(p.Ys + (size_t)(2 * row + 1) * D + 256 * i + 4 * lane);
                v[i][0] = DN_ALPHA * v[i][0] + (w0 * bflo(y0[0]) + w1 * bflo(y1[0])); v[i][1] = DN_ALPHA * v[i][1] + (w0 * bfhi(y0[0]) + w1 * bfhi(y1[0]));
                v[i][2] = DN_ALPHA * v[i][2] + (w0 * bflo(y0[1]) + w1 * bflo(y1[1])); v[i][3] = DN_ALPHA * v[i][3] + (w0 * bfhi(y0[1]) + w1 * bfhi(y1[1])); } }
        float s = 0.f;
#pragma unroll
        for (int i = 0; i < 4; ++i) s += (v[i][0] + v[i][1]) + (v[i][2] + v[i][3]);
        const float mu = wsum(s, lane) * (1.f / D);
        float q = 0.f;
#pragma unroll
        for (int i = 0; i < 4; ++i) { v[i] = v[i] - mu; q += (v[i][0] * v[i][0] + v[i][1] * v[i][1]) + (v[i][2] * v[i][2] + v[i][3] * v[i][3]); }
        const float rs = rsqrtf(wsum(q, lane) * (1.f / D) + 1e-5f);
#pragma unroll
        for (int i = 0; i < 4; ++i) { v[i] = v[i] * rs * gg[i] + bb[i];
            *(f32x4*)(outf + (size_t)row * D + 256 * i + 4 * lane) = v[i];
            u32x2 o = {cvt_pk_bf16(v[i][0], v[i][1]), cvt_pk_bf16(v[i][2], v[i][3])};
            *(u32x2*)(p.Xb + (size_t)row * D + 256 * i + 4 * lane) = o; }
        if constexpr (MODE == 1) {
            const float* wg = p.w_grp + (size_t)layer * D * 8; const float* we = p.w_exp + (size_t)layer * D * 64;
            float gl[8];
#pragma unroll
            for (int g = 0; g < 8; ++g) gl[g] = 0.f;
#pragma unroll
            for (int i = 0; i < 4; ++i)
#pragma unroll
                for (int j = 0; j < 4; ++j) { const int k = 256 * i + 4 * lane + j; const f32x4 a = *(const f32x4*)(wg + k * 8), b = *(const f32x4*)(wg + k * 8 + 4); const float xv = v[i][j];
                    gl[0] = fmaf(xv, a[0], gl[0]); gl[1] = fmaf(xv, a[1], gl[1]); gl[2] = fmaf(xv, a[2], gl[2]); gl[3] = fmaf(xv, a[3], gl[3]);
                    gl[4] = fmaf(xv, b[0], gl[4]); gl[5] = fmaf(xv, b[1], gl[5]); gl[6] = fmaf(xv, b[2], gl[6]); gl[7] = fmaf(xv, b[3], gl[7]); }
            float mx = -INFINITY; int gt = 0;
#pragma unroll
            for (int g = 0; g < 8; ++g) { gl[g] = wsum(gl[g], lane) + p.b_grp[layer * 8 + g]; if (gl[g] > mx) { mx = gl[g]; gt = g; } }
            gt = __builtin_amdgcn_readfirstlane(gt);
            float sum = 0.f;
#pragma unroll
            for (int g = 0; g < 8; ++g) sum += expf(gl[g] - mx);
            const float pg = 1.f / sum;
            float el[8];
#pragma unroll
            for (int e = 0; e < 8; ++e) el[e] = 0.f;
#pragma unroll
            for (int i = 0; i < 4; ++i)
#pragma unroll
                for (int j = 0; j < 4; ++j) { const int k = 256 * i + 4 * lane + j; const f32x4 a = *(const f32x4*)(we + k * 64 + gt * 8), b = *(const f32x4*)(we + k * 64 + gt * 8 + 4); const float xv = v[i][j];
                    el[0] = fmaf(xv, a[0], el[0]); el[1] = fmaf(xv, a[1], el[1]); el[2] = fmaf(xv, a[2], el[2]); el[3] = fmaf(xv, a[3], el[3]);
                    el[4] = fmaf(xv, b[0], el[4]); el[5] = fmaf(xv, b[1], el[5]); el[6] = fmaf(xv, b[2], el[6]); el[7] = fmaf(xv, b[3], el[7]); }
            float v1 = -INFINITY, v2 = -INFINITY; int i1 = 0, i2 = 0;
#pragma unroll
            for (int e = 0; e < 8; ++e) { const float vv = wsum(el[e], lane) + p.b_exp[layer * 64 + gt * 8 + e];
                if (vv > v1) { v2 = v1; i2 = i1; v1 = vv; i1 = e; } else if (vv > v2) { v2 = vv; i2 = e; } }
            if (lane == 0) { const float e2 = expf(v2 - v1), w1 = pg / (1.f + e2), w2 = pg * e2 / (1.f + e2);
                const int ea = gt * 8 + i1, eb = gt * 8 + i2; int* cn = p.cnt + layer * 64;
                p.ew[2 * row] = w1; p.ew[2 * row + 1] = w2;
                const int pa = atomicAdd(&cn[ea], 1); p.lists[ea * LCAP + pa] = 2 * row;
                const int pb = atomicAdd(&cn[eb], 1); p.lists[eb * LCAP + pb] = 2 * row + 1; }
        }
    }
}

__device__ __forceinline__ void wsum8(float (&x)[8], int lane) {
    float y[4], z[2], w;
#pragma unroll
    for (int k = 0; k < 4; ++k) { const bool hi = lane & 32; const float snd = hi ? x[k] : x[k + 4], keep = hi ? x[k + 4] : x[k]; y[k] = keep + shx(snd, 32, lane); }
#pragma unroll
    for (int k = 0; k < 2; ++k) { const bool hi = lane & 16; const float snd = hi ? y[k] : y[k + 2], keep = hi ? y[k + 2] : y[k]; z[k] = keep + shx(snd, 16, lane); }
    { const bool hi = lane & 8; const float snd = hi ? z[0] : z[1], keep = hi ? z[1] : z[0]; w = keep + shx(snd, 8, lane); }
    w += shx(w, 4, lane); w += shx(w, 2, lane); w += shx(w, 1, lane);
#pragma unroll
    for (int k = 0; k < 8; ++k) x[k] = __int_as_float(__builtin_amdgcn_readlane(__float_as_int(w), (k >> 2) * 32 + ((k >> 1) & 1) * 16 + (k & 1) * 8));
}
__device__ __forceinline__ void ph_ln1_router(const P& p, int layer) {
    constexpr int RR = 2;
    const int tid = tid_now(), lane0 = tid & 63, gw = sgpr_now((int)blockIdx.x) * 8 + (tid >> 6), nw = gridDim.x * 8;
    const float* gp = p.ln1_g + layer * D; const float* bp = p.ln1_b + layer * D;
    const float* wg = p.w_grp + (size_t)layer * D * 8; const float* we = p.w_exp + (size_t)layer * D * 64;
    for (int row0 = gw * RR; row0 < T; row0 += nw * RR) {
        int lane = lane0; asm volatile("" : "+v"(lane));
        f32x4 v[RR][4];
#pragma unroll
        for (int r = 0; r < RR; ++r)
#pragma unroll
            for (int i = 0; i < 4; ++i) { v[r][i] = *(const f32x4*)(p.X + (size_t)(row0 + r) * D + 256 * i + 4 * lane);
                const u32x2 dd = *(const u32x2*)(p.Db + (size_t)(row0 + r) * D + 256 * i + 4 * lane);
                v[r][i][0] = DN_ALPHA * v[r][i][0] + bflo(dd[0]); v[r][i][1] = DN_ALPHA * v[r][i][1] + bfhi(dd[0]); v[r][i][2] = DN_ALPHA * v[r][i][2] + bflo(dd[1]); v[r][i][3] = DN_ALPHA * v[r][i][3] + bfhi(dd[1]); }
#pragma unroll
        for (int r = 0; r < RR; ++r) {
            float s = 0.f;
#pragma unroll
            for (int i = 0; i < 4; ++i) s += (v[r][i][0] + v[r][i][1]) + (v[r][i][2] + v[r][i][3]);
            const float mu = wsum(s, lane) * (1.f / D);
            float q = 0.f;
#pragma unroll
            for (int i = 0; i < 4; ++i) { v[r][i] = v[r][i] - mu; q += (v[r][i][0] * v[r][i][0] + v[r][i][1] * v[r][i][1]) + (v[r][i][2] * v[r][i][2] + v[r][i][3] * v[r][i][3]); }
            const float rs = rsqrtf(wsum(q, lane) * (1.f / D) + 1e-5f);
#pragma unroll
            for (int i = 0; i < 4; ++i) { const f32x4 gg = *(const f32x4*)(gp + 256 * i + 4 * lane), bb = *(const f32x4*)(bp + 256 * i + 4 * lane);
                v[r][i] = v[r][i] * rs * gg + bb;
                *(f32x4*)(p.X + (size_t)(row0 + r) * D + 256 * i + 4 * lane) = v[r][i];
                u32x2 o = {cvt_pk_bf16(v[r][i][0], v[r][i][1]), cvt_pk_bf16(v[r][i][2], v[r][i][3])};
                *(u32x2*)(p.Xb + (size_t)(row0 + r) * D + 256 * i + 4 * lane) = o; } }
        float gl[RR][8];
#pragma unroll
        for (int r = 0; r < RR; ++r)
#pragma unroll
            for (int g = 0; g < 8; ++g) gl[r][g] = 0.f;
#pragma unroll
        for (int i = 0; i < 4; ++i) { asm volatile("" : "+v"(lane) :: "memory");
#pragma unroll
            for (int j = 0; j < 4; ++j) { const int k = 256 * i + 4 * lane + j; const f32x4 a = *(const f32x4*)(wg + k * 8), b = *(const f32x4*)(wg + k * 8 + 4);
#pragma unroll
                for (int r = 0; r < RR; ++r) { const float xv = v[r][i][j];
                    gl[r][0] = fmaf(xv, a[0], gl[r][0]); gl[r][1] = fmaf(xv, a[1], gl[r][1]); gl[r][2] = fmaf(xv, a[2], gl[r][2]); gl[r][3] = fmaf(xv, a[3], gl[r][3]);
                    gl[r][4] = fmaf(xv, b[0], gl[r][4]); gl[r][5] = fmaf(xv, b[1], gl[r][5]); gl[r][6] = fmaf(xv, b[2], gl[r][6]); gl[r][7] = fmaf(xv, b[3], gl[r][7]); } } }
        int gt[RR]; float pg[RR];
#pragma unroll
        for (int r = 0; r < RR; ++r) { wsum8(gl[r], lane);
            float mx = -INFINITY; int gi = 0;
#pragma unroll
            for (int g = 0; g < 8; ++g) { gl[r][g] += p.b_grp[layer * 8 + g]; if (gl[r][g] > mx) { mx = gl[r][g]; gi = g; } }
            float sum = 0.f;
#pragma unroll
            for (int g = 0; g < 8; ++g) sum += expf(gl[r][g] - mx);
            gt[r] = __builtin_amdgcn_readfirstlane(gi); pg[r] = 1.f / sum; }
        float el[RR][8];
#pragma unroll
        for (int r = 0; r < RR; ++r) {
#pragma unroll
            for (int e = 0; e < 8; ++e) el[r][e] = 0.f;
#pragma unroll
            for (int i = 0; i < 4; ++i) { asm volatile("" : "+v"(lane) :: "memory");
#pragma unroll
                for (int j = 0; j < 4; ++j) { const int k = 256 * i + 4 * lane + j; const f32x4 a = *(const f32x4*)(we + k * 64 + gt[r] * 8), b = *(const f32x4*)(we + k * 64 + gt[r] * 8 + 4); const float xv = v[r][i][j];
                    el[r][0] = fmaf(xv, a[0], el[r][0]); el[r][1] = fmaf(xv, a[1], el[r][1]); el[r][2] = fmaf(xv, a[2], el[r][2]); el[r][3] = fmaf(xv, a[3], el[r][3]);
                    el[r][4] = fmaf(xv, b[0], el[r][4]); el[r][5] = fmaf(xv, b[1], el[r][5]); el[r][6] = fmaf(xv, b[2], el[r][6]); el[r][7] = fmaf(xv, b[3], el[r][7]); } } }
#pragma unroll
        for (int r = 0; r < RR; ++r) { wsum8(el[r], lane);
            float v1 = -INFINITY, v2 = -INFINITY; int i1 = 0, i2 = 0;
#pragma unroll
            for (int e = 0; e < 8; ++e) { const float vv = el[r][e] + p.b_exp[layer * 64 + gt[r] * 8 + e];
                if (vv > v1) { v2 = v1; i2 = i1; v1 = vv; i1 = e; } else if (vv > v2) { v2 = vv; i2 = e; } }
            if (lane == 0) { const int row = row0 + r; const float e2 = expf(v2 - v1), w1 = pg[r] / (1.f + e2), w2 = pg[r] * e2 / (1.f + e2);
                const int ea = gt[r] * 8 + i1, eb = gt[r] * 8 + i2; int* cn = p.cnt + layer * 64;
                p.ew[2 * row] = w1; p.ew[2 * row + 1] = w2;
                const int pa = atomicAdd(&cn[ea], 1); p.lists[ea * LCAP + pa] = 2 * row;
                const int pb = atomicAdd(&cn[eb], 1); p.lists[eb * LCAP + pb] = 2 * row + 1; } }
    }
}
__device__ __forceinline__ void ph_prologue(const P& p) {
    const int gtid = blockIdx.x * NTHR + tid_now(), gth = gridDim.x * NTHR;
    for (int idx = gtid; idx < T * 32; idx += gth) { const int t = idx >> 5, i = idx & 31;
        const float inv = (float)(1.0 / pow(10000.0, (double)(2 * i) / 64.0)); const float ang = (float)p.pos[t] * inv;
        p.cs[idx] = (float)cos((double)ang); p.sn[idx] = (float)sin((double)ang); }
    for (size_t i = gtid; i < (size_t)DEPTH * T * PLE / 4; i += gth) { const f32x4 v = ((const f32x4*)p.pin)[i]; u32x2 o = {cvt_pk_bf16(v[0], v[1]), cvt_pk_bf16(v[2], v[3])}; ((u32x2*)p.Pb)[i] = o; }
    ph_rows<0>(p, 0);
}

struct SchedBr { __device__ __forceinline__ bool carry(const ge::Unit& u) const { return u.g < 2; }
    const char* Ya; const char* Yb; const char* Yc; const char* W; int c, G;
    __device__ __forceinline__ bool next(int i, ge::Unit& u) const { const int tile = (i / 3) * G + c; if (tile >= 256) return false; u.g = i % 3; ge::tile_order(tile, 64, 4, u.pm, u.pn); return true; }
    __device__ __forceinline__ const char* aptr(const ge::Unit& u) const { return (u.g == 0 ? Ya : u.g == 1 ? Yb : Yc) + (size_t)u.pm * 256 * 512 * 2; }
    __device__ __forceinline__ const char* bptr(const ge::Unit& u) const { return W + ((size_t)u.g * 1024 + u.pn * 256) * 512 * 2; } };
struct EpiBr { const bf16_t* Hp; bf16_t* Mgb;
    __device__ __forceinline__ void operator()(ge::Acc& acc, const ge::Unit& u, int wr, int wc, int fr, int fq) const {
        const int row0 = u.pm * 256 + wr * 64 + fr, col0 = u.pn * 256 + wc * 32 + 8 * fq;
#pragma unroll
        for (int ai = 0; ai < 2; ++ai)
#pragma unroll
            for (int m = 0; m < 4; ++m) { asm volatile("" ::: "memory"); const int row = row0 + ai * 128 + m * 16;
#pragma unroll
                for (int bj = 0; bj < 2; ++bj) { const int col = col0 + bj * 128;
                    const u32x4 gt = *(const u32x4*)(Hp + (size_t)row * HW + H_GTA + u.g * 1024 + col);
                    f32x4 s0 = {bflo(gt[0]), bfhi(gt[0]), bflo(gt[1]), bfhi(gt[1])}, s1 = {bflo(gt[2]), bfhi(gt[2]), bflo(gt[3]), bfhi(gt[3])};
                    if (u.g < 2) { const u32x4 gn = *(const u32x4*)(Hp + (size_t)row * HW + H_GTA + (u.g + 1) * 1024 + col);
                        f32x4 d0 = {bflo(gn[0]), bfhi(gn[0]), bflo(gn[1]), bfhi(gn[1])}, d1 = {bflo(gn[2]), bfhi(gn[2]), bflo(gn[3]), bfhi(gn[3])};
#pragma unroll
                        for (int j = 0; j < 4; ++j) { s0[j] = s0[j] / d0[j]; s1[j] = s1[j] / d1[j]; } }
                    acc[ai][bj][m][0] = acc[ai][bj][m][0] * s0; acc[ai][bj][m][1] = acc[ai][bj][m][1] * s1;
                    if (u.g == 2) { const f32x4 v0 = acc[ai][bj][m][0], v1 = acc[ai][bj][m][1];
                        u32x4 o = {cvt_pk_bf16(v0[0], v0[1]), cvt_pk_bf16(v0[2], v0[3]), cvt_pk_bf16(v1[0], v1[1]), cvt_pk_bf16(v1[2], v1[3])}; *(u32x4*)(Mgb + (size_t)row * D + col) = o; } } }
    } };
struct SchedT4 : ge::NoCarry { const char* A; const char* B; int lda2, ldb2, c, G;
    __device__ __forceinline__ bool next(int i, ge::Unit& u) const { const int L = i * G + c; if (L >= 256) return false; u.g = 0; ge::tile_order(L, 64, 4, u.pm, u.pn); return true; }
    __device__ __forceinline__ const char* aptr(const ge::Unit& u) const { return A + (size_t)u.pm * lda2; }
    __device__ __forceinline__ const char* bptr(const ge::Unit& u) const { return B + (size_t)u.pn * ldb2; } };
struct EpiRes { bf16_t* Db;
    __device__ __forceinline__ void operator()(ge::Acc& acc, const ge::Unit& u, int wr, int wc, int fr, int fq) const {
        const int row0 = u.pm * 256 + wr * 64 + fr, col0 = u.pn * 256 + wc * 32 + 8 * fq;
#pragma unroll
        for (int ai = 0; ai < 2; ++ai)
#pragma unroll
            for (int m = 0; m < 4; ++m) { const size_t o = (size_t)(row0 + ai * 128 + m * 16) * D + col0;
#pragma unroll
                for (int bj = 0; bj < 2; ++bj) { const f32x4 v0 = acc[ai][bj][m][0], v1 = acc[ai][bj][m][1];
                    u32x4 w = {cvt_pk_bf16(v0[0], v0[1]), cvt_pk_bf16(v0[2], v0[3]), cvt_pk_bf16(v1[0], v1[1]), cvt_pk_bf16(v1[2], v1[3])}; *(u32x4*)(Db + o + bj * 128) = w; } }
    } };
struct EpiU { bf16_t* Ub;
    __device__ __forceinline__ void operator()(ge::Acc& acc, const ge::Unit& u, int wr, int wc, int fr, int fq) const {
        const int row0 = u.pm * 256 + wr * 64 + fr, col0 = u.pn * 256 + wc * 32 + 8 * fq;
#pragma unroll
        for (int ai = 0; ai < 2; ++ai)
#pragma unroll
            for (int m = 0; m < 4; ++m) { const size_t o = (size_t)(row0 + ai * 128 + m * 16) * D + col0;
#pragma unroll
                for (int bj = 0; bj < 2; ++bj) { const f32x4 v0 = acc[ai][bj][m][0], v1 = acc[ai][bj][m][1];
                    u32x4 w = {cvt_pk_bf16(v0[0], v0[1]), cvt_pk_bf16(v0[2], v0[3]), cvt_pk_bf16(v1[0], v1[1]), cvt_pk_bf16(v1[2], v1[3])}; *(u32x4*)(Ub + o + bj * 128) = w; } }
    } };
struct EpiPle { bf16_t* Db; const bf16_t* Ub; const float* bias;
    __device__ __forceinline__ void operator()(ge::Acc& acc, const ge::Unit& u, int wr, int wc, int fr, int fq) const {
        const int row0 = u.pm * 256 + wr * 64 + fr, col0 = u.pn * 256 + wc * 32 + 8 * fq;
        f32x4 bv[2][2];
#pragma unroll
        for (int bj = 0; bj < 2; ++bj) { bv[bj][0] = *(const f32x4*)(bias + col0 + bj * 128); bv[bj][1] = *(const f32x4*)(bias + col0 + bj * 128 + 4); }
#pragma unroll
        for (int ai = 0; ai < 2; ++ai)
#pragma unroll
            for (int m = 0; m < 4; ++m) { asm volatile("" ::: "memory"); const size_t o = (size_t)(row0 + ai * 128 + m * 16) * D + col0;
#pragma unroll
                for (int bj = 0; bj < 2; ++bj) { const u32x4 uu = *(const u32x4*)(Ub + o + bj * 128);
                    f32x4 g0 = acc[ai][bj][m][0] + bv[bj][0], g1 = acc[ai][bj][m][1] + bv[bj][1];
#pragma unroll
                    for (int j = 0; j < 4; ++j) { g0[j] = 1.f / (1.f + __expf(-g0[j])); g1[j] = 1.f / (1.f + __expf(-g1[j])); }
                    const f32x4 u0 = {bflo(uu[0]), bfhi(uu[0]), bflo(uu[1]), bfhi(uu[1])}, u1 = {bflo(uu[2]), bfhi(uu[2]), bflo(uu[3]), bfhi(uu[3])};
                    g0 = g0 * u0; g1 = g1 * u1;
                    u32x4 w = {cvt_pk_bf16(g0[0], g0[1]), cvt_pk_bf16(g0[2], g0[3]), cvt_pk_bf16(g1[0], g1[1]), cvt_pk_bf16(g1[2], g1[3])}; *(u32x4*)(Db + o + bj * 128) = w; } }
    } };

__device__ __forceinline__ void moe_table(LAS unsigned char* lds, const int* cnt) {
    LAS int* te = (LAS int*)(lds + 131072); LAS int* tr = te + 256; LAS int* cl = tr + 256; LAS int* nt = cl + 64;
    __syncthreads();
    if (tid_now() < 64) cl[tid_now()] = cnt[tid_now()];
    __syncthreads();
    if (tid_now() == 0) { int n = 0; for (int e = 0; e < NE; ++e) for (int r = 0; r < cl[e]; r += 256) { te[n] = e; tr[n] = r; ++n; } nt[0] = n; }
    __syncthreads();
}
struct SchedM1 : ge::NoCarry { const char* Xb; const char* W; const int* lists; LAS int* te; int c, G;
    __device__ __forceinline__ bool next(int i, ge::Unit& u) const { const int L = i * G + c; if (L >= 2 * te[576]) return false; u.pm = L >> 1; u.pn = L & 1; u.g = te[u.pm]; return true; }
    __device__ __forceinline__ int arow(const ge::Unit& u, int r) const { const int n = te[512 + u.g], idx = min(te[256 + u.pm] + r, n - 1); return lists[u.g * LCAP + idx] >> 1; }
    __device__ __forceinline__ const char* aptr(const ge::Unit&) const { return Xb; }
    __device__ __forceinline__ const char* bptr(const ge::Unit& u) const { return W + ((size_t)u.g * 512 + u.pn * 256) * D * 2; } };
struct EpiM1 { bf16_t* Hbuf;
    __device__ __forceinline__ void operator()(ge::Acc& acc, const ge::Unit& u, int wr, int wc, int fr, int fq) const {
#pragma unroll
        for (int ai = 0; ai < 2; ++ai)
#pragma unroll
            for (int m = 0; m < 4; ++m) { const int row = ai * 128 + wr * 64 + m * 16 + fr;
                float h[8];
#pragma unroll
                for (int n = 0; n < 2; ++n)
#pragma unroll
                    for (int j = 0; j < 4; ++j) { const float g = acc[ai][0][m][n][j], uu = acc[ai][1][m][n][j]; h[4 * n + j] = g / (1.f + __expf(-g)) * uu; }
                u32x4 o = {cvt_pk_bf16(h[0], h[1]), cvt_pk_bf16(h[2], h[3]), cvt_pk_bf16(h[4], h[5]), cvt_pk_bf16(h[6], h[7])};
                *(u32x4*)(Hbuf + ((size_t)u.pm * 256 + row) * EH + u.pn * 128 + wc * 32 + 8 * fq) = o; }
    } };
struct SchedM2 : ge::NoCarry { const char* Hb; const char* W; LAS int* te; int c, G;
    __device__ __forceinline__ bool next(int i, ge::Unit& u) const { const int L = i * G + c; if (L >= 4 * te[576]) return false; u.pm = L >> 2; u.pn = L & 3; u.g = te[u.pm]; return true; }
    __device__ __forceinline__ const char* aptr(const ge::Unit& u) const { return Hb + (size_t)u.pm * 256 * EH * 2; }
    __device__ __forceinline__ const char* bptr(const ge::Unit& u) const { return W + ((size_t)u.g * D + u.pn * 256) * EH * 2; } };
struct EpiM2 { bf16_t* Ys; const int* lists; LAS int* te;
    __device__ __forceinline__ void operator()(ge::Acc& acc, const ge::Unit& u, int wr, int wc, int fr, int fq) const {
        const int r0 = te[256 + u.pm], n = te[512 + u.g];
#pragma unroll
        for (int ai = 0; ai < 2; ++ai)
#pragma unroll
            for (int m = 0; m < 4; ++m) { const int row = r0 + ai * 128 + wr * 64 + m * 16 + fr;
                if (row < n) { const int a = lists[u.g * LCAP + row];
#pragma unroll
                    for (int bj = 0; bj < 2; ++bj) { const f32x4 v0 = acc[ai][bj][m][0], v1 = acc[ai][bj][m][1];
                        u32x4 o = {cvt_pk_bf16(v0[0], v0[1]), cvt_pk_bf16(v0[2], v0[3]), cvt_pk_bf16(v1[0], v1[1]), cvt_pk_bf16(v1[2], v1[3])};
                        *(u32x4*)(Ys + (size_t)a * D + u.pn * 256 + bj * 128 + wc * 32 + 8 * fq) = o; } } }
    } };

#define XB_TMO      128
#define XB_XCNT(j)  (256  + 64 * (j))
#define XB_XSUB(j)  (1280 + 64 * (j))
#define XB_XGEN(j)  (2304 + 64 * (j))
#define XB_TOP      3328
#define XB_TOPGEN   3392
#define XCD_BAR_WORDS 3456
#define XB_SPIN_CAP (1u << 18)

__device__ __forceinline__ unsigned xb_ld(unsigned* p)              { return __hip_atomic_load(p, __ATOMIC_RELAXED, __HIP_MEMORY_SCOPE_AGENT); }
__device__ __forceinline__ unsigned xb_add(unsigned* p, unsigned v) { return __hip_atomic_fetch_add(p, v, __ATOMIC_RELAXED, __HIP_MEMORY_SCOPE_AGENT); }
__device__ __forceinline__ unsigned xb_xcc_id() { return (unsigned)__builtin_amdgcn_s_getreg((3 << 11) | 20) & 0xFu; }
#define XB_SPIN(cond, bar) do { unsigned _sp = 0; while (cond) { __builtin_amdgcn_s_sleep(1); \
    if ((++_sp & 255u) == 0u) { if (xb_ld(&(bar)[XB_TMO])) break; if (_sp > XB_SPIN_CAP) { atomicAdd(&(bar)[XB_TMO], 1u); break; } } } } while (0)

struct XcdBarrier {
    unsigned* bar; unsigned x;
    volatile LAS unsigned* st;
};

__device__ __forceinline__ XcdBarrier xcd_barrier_post(unsigned* bar, volatile LAS unsigned* st) {
    XcdBarrier b; b.bar = bar; b.x = xb_xcc_id(); b.st = st;
    if (threadIdx.x == 0) (void)xb_add(&bar[XB_XCNT(b.x)], 1u);
    return b;
}
__device__ __forceinline__ void xcd_barrier_complete(unsigned* bar, unsigned x, unsigned& nloc, unsigned& nx) {
    const unsigned G = gridDim.x * gridDim.y * gridDim.z;
    unsigned sum, cnt, mine, sp = 0u;
    for (;;) {
        sum = 0u; cnt = 0u; mine = 0u;
#pragma unroll
        for (unsigned j = 0; j < 16; ++j) { const unsigned c = xb_ld(&bar[XB_XCNT(j)]); sum += c; cnt += (c > 0u) ? 1u : 0u; mine = (j == x) ? c : mine; }
        if (sum == G) break;
        __builtin_amdgcn_s_sleep(1);
        if ((++sp & 255u) == 0u) { if (xb_ld(&bar[XB_TMO])) break; if (sp > XB_SPIN_CAP) { atomicAdd(&bar[XB_TMO], 1u); break; } }
    }
    nloc = mine > 0u ? mine : 1u; nx = cnt > 0u ? cnt : 1u;
}

__device__ __forceinline__ void xcd_barrier(const XcdBarrier& b) {
    asm volatile("s_waitcnt vmcnt(0)" ::: "memory");
    __syncthreads();
    if (threadIdx.x == 0) {
        unsigned* bar = b.bar;
        __builtin_amdgcn_s_waitcnt(0);
        unsigned nloc = b.st[0], nx = b.st[1];
        if (nloc == 0u) { xcd_barrier_complete(bar, b.x, nloc, nx); b.st[0] = nloc; b.st[1] = nx; }
        const unsigned old = xb_add(&bar[XB_XSUB(b.x)], 1u);
        const unsigned gen = old / nloc;
        if (old + 1u == (gen + 1u) * nloc) {
            __builtin_amdgcn_fence(__ATOMIC_RELEASE, "agent");
            asm volatile("s_waitcnt vmcnt(0)" ::: "memory");
            const unsigned og = xb_add(&bar[XB_TOP], 1u);
            const unsigned tg = og / nx;
            if (og + 1u == (tg + 1u) * nx) xb_add(&bar[XB_TOPGEN], 1u);
            else XB_SPIN(xb_ld(&bar[XB_TOPGEN]) == tg, bar);
            __builtin_amdgcn_fence(__ATOMIC_ACQUIRE, "agent");
            xb_add(&bar[XB_XGEN(b.x)], 1u);
            asm volatile("s_waitcnt vmcnt(0)" ::: "memory");
        } else {
            XB_SPIN(xb_ld(&bar[XB_XGEN(b.x)]) == gen, bar);
            __builtin_amdgcn_fence(__ATOMIC_ACQUIRE, "agent");
            asm volatile("s_waitcnt vmcnt(0)" ::: "memory");
        }
    }
    __syncthreads();
}

enum { PH_PRO = 0, PH_CONV, PH_IN, PH_PREP_Q, PH_PREP_K, PH_PREP_V, PH_PREP_G, PH_ATT, PH_FIN, PH_BR, PH_WO, PH_LN1, PH_M1, PH_M2, PH_LN2, PH_PLE, PH_LN3 };
template <int PH> __global__ __launch_bounds__(NTHR, 2) void k_ph(P p, int layer) {
    extern __shared__ __attribute__((aligned(16))) unsigned char smem[];
    LAS unsigned char* lds = (LAS unsigned char*)smem;
    tid_setup();
    const int c = blockIdx.x, G = gridDim.x;
    if constexpr (PH == PH_PRO) ph_prologue(p);
    if constexpr (PH == PH_CONV) ph_convert(lds, p, layer);
    if constexpr (PH == PH_IN) { const MegaP m = mk_mega(p); SchedIn S{{}, (const char*)m.Xb, (const char*)m.Wb_in, (const char*)m.Wb_gv, c, G, 0}; EpiIn<2> E{m.Hp, m.GVt, m.ssq_q, m.ssq_kv}; ge::gemm_stream<EpiIn<2>, SchedIn, false>(lds, D, D, D, S, E); }
    if constexpr (PH == PH_PREP_Q) { const MlaP q = mk_mla(p); SchedMla<0> S{{}, (const char*)(q.Hp + H_CQ), (const char*)q.Wb_uq, c, G}; EpiMla<0> E{q}; ge::gemm_stream<EpiMla<0>, SchedMla<0>, false>(lds, 256, HW, 256, S, E); }
    if constexpr (PH == PH_PREP_K) { const MlaP q = mk_mla(p); SchedMla<1> S{{}, (const char*)(q.Hp + H_CKV), (const char*)q.Wb_uk, (c + 64) % G, G}; EpiMla<1> E{q}; ge::gemm_stream<EpiMla<1>, SchedMla<1>, false>(lds, 256, HW, 256, S, E); }
    if constexpr (PH == PH_PREP_V) { const MlaP q = mk_mla(p); SchedMla<2> S{{}, (const char*)q.Wb_uv, (const char*)(q.Hp + H_CKV), (c + 192) % G, G}; EpiMla<2> E{q}; ge::gemm_stream<EpiMla<2>, SchedMla<2>, false>(lds, 256, 256, HW, S, E); }
    if constexpr (PH == PH_PREP_G) { { const MegaP m = mk_mega(p); SchedIn S{{}, (const char*)m.Xb, (const char*)m.Wb_in, (const char*)m.Wb_gv, (c + 128) % G, G, 1}; EpiIn<0> E{m.Hp, m.GVt, m.ssq_q, m.ssq_kv}; ge::gemm_stream<EpiIn<0>, SchedIn, false>(lds, D, D, D, S, E); } const MlaP q = mk_mla(p); kr_phase(q, c * NTHR + tid_now(), G * NTHR); const GlaP g = mk_gla(p, layer); gla_g1(lds, g, c, G); }
    if constexpr (PH == PH_ATT) { const GlaP g = mk_gla(p, layer); gla_g2(lds, g, c); const MlaP q = mk_mla(p); attn_phase(lds, q, c); }
    if constexpr (PH == PH_FIN) { const GlaP g = mk_gla(p, layer); gla_g3(lds, g, c, G); conv_phase(g, c * NTHR + tid_now(), G * NTHR); attn_combine_bf16(g, c * NTHR + tid_now(), G * NTHR); }
    if constexpr (PH == PH_BR) { SchedBr S{(const char*)p.Yab, (const char*)p.Ybb, (const char*)p.Ycb, (const char*)p.Wb_br, c, G}; EpiBr E{p.Hp, p.Mgb}; ge::gemm_stream<EpiBr, SchedBr, false>(lds, 512, 512, 512, S, E); }
    if constexpr (PH == PH_WO) { SchedT4 S{{}, (const char*)p.Mgb, (const char*)p.Wb_o, 256 * D * 2, 256 * D * 2, c, G}; EpiRes E{p.Db}; ge::gemm_stream<EpiRes, SchedT4, false>(lds, D, D, D, S, E); }
    if constexpr (PH == PH_LN1) ph_ln1_router(p, layer);
    if constexpr (PH == PH_M1) { moe_table(lds, p.cnt + layer * 64); LAS int* te = (LAS int*)(lds + 131072);
        SchedM1 S{{}, (const char*)p.Xb, (const char*)p.Wb_gu, p.lists, te, c, G}; EpiM1 E{p.Hbuf}; ge::gemm_stream<EpiM1, SchedM1, true>(lds, D, D, D, S, E); }
    if constexpr (PH == PH_M2) { moe_table(lds, p.cnt + layer * 64); LAS int* te = (LAS int*)(lds + 131072);
        SchedM2 S{{}, (const char*)p.Hbuf, (const char*)p.Wb_d, te, c, G}; EpiM2 E{p.Ys, p.lists, te}; ge::gemm_stream<EpiM2, SchedM2, false>(lds, EH, EH, EH, S, E); }
    if constexpr (PH == PH_LN2) ph_rows<2>(p, layer);
    if constexpr (PH == PH_PLE) {
        { SchedT4 S{{}, (const char*)(p.Pb + (size_t)layer * T * PLE), (const char*)p.Wb_pu, 256 * PLE * 2, 256 * PLE * 2, c, G}; EpiU E{p.Ub}; ge::gemm_stream<EpiU, SchedT4, false>(lds, PLE, PLE, PLE, S, E); }
        { SchedT4 S{{}, (const char*)p.Xb, (const char*)p.Wb_pg, 256 * D * 2, 256 * D * 2, c, G}; EpiPle E{p.Db, p.Ub, p.b_pg + layer * D}; ge::gemm_stream<EpiPle, SchedT4, false>(lds, D, D, D, S, E); } }
    if constexpr (PH == PH_LN3) ph_rows<3>(p, layer);
}


typedef const P __attribute__((address_space(4))) CP;
__device__ __forceinline__ P load_params() { CP* q = (CP*)__builtin_amdgcn_kernarg_segment_ptr(); asm volatile("" : "+s"(q)); return *(const P*)q; }
#define GRID_BAR() do { XcdBarrier b_; b_.bar = load_params().bar; b_.x = xb_xcc_id(); b_.st = xbw; xcd_barrier(b_); } while (0)
__global__ __launch_bounds__(NTHR, 2) void k_mega(P p_arg) {
    extern __shared__ __attribute__((aligned(16))) unsigned char smem[];
    LAS unsigned char* lds = (LAS unsigned char*)smem;
    const int G = NBLK;
#define c sgpr_now((int)blockIdx.x)
    volatile LAS unsigned* xbw = (volatile LAS unsigned*)(lds + XBW_OFF);
    tid_setup();
    if (tid_now() < 4) xbw[tid_now()] = 0u;
    __syncthreads();
    (void)xcd_barrier_post(p_arg.bar, xbw);
    { const P p = load_params(); ph_prologue(p); }
    { const P p = load_params(); ph_convert(lds, p, 0); }
    GRID_BAR();
    for (int layer = 0; layer < DEPTH; ++layer) {
        { const P p = load_params(); const MegaP m = mk_mega(p); SchedIn S{{}, (const char*)m.Xb, (const char*)m.Wb_in, (const char*)m.Wb_gv, c, G, 0}; EpiIn<2> E{m.Hp, m.GVt, m.ssq_q, m.ssq_kv}; ge::gemm_stream<EpiIn<2>, SchedIn, false>(lds, D, D, D, S, E); }
        GRID_BAR();
        { const P p = load_params(); const MlaP q = mk_mla(p);
          { SchedMla<0> S{{}, (const char*)(q.Hp + H_CQ), (const char*)q.Wb_uq, (c >= 128 ? c - 128 : -1), 128}; EpiMla<0> E{q}; ge::gemm_stream<EpiMla<0>, SchedMla<0>, false>(lds, 256, HW, 256, S, E); }
          { SchedMla<1> S{{}, (const char*)(q.Hp + H_CKV), (const char*)q.Wb_uk, (c >= 128 ? c - 128 : -1), 128}; EpiMla<1> E{q}; ge::gemm_stream<EpiMla<1>, SchedMla<1>, false>(lds, 256, HW, 256, S, E); }
          { SchedMla<2> S{{}, (const char*)q.Wb_uv, (const char*)(q.Hp + H_CKV), (c >= 128 ? c - 128 : -1), 128}; EpiMla<2> E{q}; ge::gemm_stream<EpiMla<2>, SchedMla<2>, false>(lds, 256, 256, HW, S, E); }
          { const MegaP m = mk_mega(p); SchedIn S{{}, (const char*)m.Xb, (const char*)m.Wb_in, (const char*)m.Wb_gv, c, G, 1}; EpiIn<0> E{m.Hp, m.GVt, m.ssq_q, m.ssq_kv}; ge::gemm_stream<EpiIn<0>, SchedIn, false>(lds, D, D, D, S, E); }
          kr_phase(q, c * NTHR + tid_now(), G * NTHR);
          const GlaP g = mk_gla(p, layer); gla_g1(lds, g, c, G); }
        GRID_BAR();
        { const P p = load_params(); const GlaP g = mk_gla(p, layer); gla_g2(lds, g, c); const MlaP q = mk_mla(p); attn_phase(lds, q, c); }
        GRID_BAR();
        { const P p = load_params(); const GlaP g = mk_gla(p, layer); gla_g3(lds, g, c, G); conv_phase(g, c * NTHR + tid_now(), G * NTHR); attn_combine_bf16(g, c * NTHR + tid_now(), G * NTHR); }
        GRID_BAR();
        { const P p = load_params(); SchedBr S{(const char*)p.Yab, (const char*)p.Ybb, (const char*)p.Ycb, (const char*)p.Wb_br, c, G}; EpiBr E{p.Hp, p.Mgb}; ge::gemm_stream<EpiBr, SchedBr, false>(lds, 512, 512, 512, S, E); }
        GRID_BAR();
        { const P p = load_params(); SchedT4 S{{}, (const char*)p.Mgb, (const char*)p.Wb_o, 256 * D * 2, 256 * D * 2, c, G}; EpiRes E{p.Db}; ge::gemm_stream<EpiRes, SchedT4, false>(lds, D, D, D, S, E); }
        GRID_BAR();
        { const P p = load_params(); ph_ln1_router(p, layer); }
        GRID_BAR();
        { const P p = load_params(); moe_table(lds, p.cnt + layer * 64); LAS int* te = (LAS int*)(lds + 131072);
          SchedM1 S{{}, (const char*)p.Xb, (const char*)p.Wb_gu, p.lists, te, c, G}; EpiM1 E{p.Hbuf}; ge::gemm_stream<EpiM1, SchedM1, true>(lds, D, D, D, S, E);
          const int extra = max(0, 2 * te[576] - NBLK), cu = c - extra;
          SchedT4 SU{{}, (const char*)(p.Pb + (size_t)layer * T * PLE), (const char*)p.Wb_pu, 256 * PLE * 2, 256 * PLE * 2, cu >= 0 ? cu : 256, NBLK - extra}; EpiU EU{p.Ub};
          ge::gemm_stream<EpiU, SchedT4, false>(lds, PLE, PLE, PLE, SU, EU); }
        GRID_BAR();
        { const P p = load_params(); LAS int* te = (LAS int*)(lds + 131072);
          SchedM2 S{{}, (const char*)p.Hbuf, (const char*)p.Wb_d, te, c, G}; EpiM2 E{p.Ys, p.lists, te}; ge::gemm_stream<EpiM2, SchedM2, false>(lds, EH, EH, EH, S, E); }
        GRID_BAR();
        { const P p = load_params(); ph_rows<2>(p, layer); }
        GRID_BAR();
        { const P p = load_params(); SchedT4 S{{}, (const char*)p.Xb, (const char*)p.Wb_pg, 256 * D * 2, 256 * D * 2, c, G}; EpiPle E{p.Db, p.Ub, p.b_pg + layer * D}; ge::gemm_stream<EpiPle, SchedT4, false>(lds, D, D, D, S, E); }
        GRID_BAR();
        { const P p = load_params(); ph_rows<3>(p, layer); }
        if (layer + 1 < DEPTH) { { const P p = load_params(); ph_convert(lds, p, layer + 1); } GRID_BAR(); }
    }
#undef c
}

template <int PH> static void launch_ph(const P& p, int layer, hipStream_t st) {
    static bool set = false;
    if (!set) { (void)hipFuncSetAttribute((const void*)k_ph<PH>, hipFuncAttributeMaxDynamicSharedMemorySize, LDS_BYTES); set = true; }
    hipLaunchKernelGGL((k_ph<PH>), dim3(NBLK), dim3(NTHR), LDS_BYTES, st, p, layer);
}
extern "C" void kernel_launch(void* const* d_in, const int* in_sizes, int n_in, void* d_out, int out_size, void* d_ws, size_t ws_size, hipStream_t st) {
    (void)in_sizes; (void)n_in; (void)out_size;
    P p{};
    p.x = (const float*)d_in[0]; p.pin = (const float*)d_in[1]; p.pos = (const int*)d_in[2]; p.ln0_g = (const float*)d_in[3]; p.ln0_b = (const float*)d_in[4];
    p.w_in = (const float*)d_in[5]; p.w_conv = (const float*)d_in[6]; p.w_gg = (const float*)d_in[7]; p.b_gg = (const float*)d_in[8]; p.gla_ng = (const float*)d_in[9];
    p.qn_g = (const float*)d_in[10]; p.kvn_g = (const float*)d_in[11]; p.w_uq = (const float*)d_in[12]; p.w_ukv = (const float*)d_in[13]; p.w_br = (const float*)d_in[14]; p.w_o = (const float*)d_in[15];
    p.ln1_g = (const float*)d_in[16]; p.ln1_b = (const float*)d_in[17]; p.w_grp = (const float*)d_in[18]; p.b_grp = (const float*)d_in[19]; p.w_exp = (const float*)d_in[20]; p.b_exp = (const float*)d_in[21];
    p.w_gate = (const float*)d_in[22]; p.w_up = (const float*)d_in[23]; p.w_down = (const float*)d_in[24]; p.ln2_g = (const float*)d_in[25]; p.ln2_b = (const float*)d_in[26];
    p.w_pg = (const float*)d_in[27]; p.b_pg = (const float*)d_in[28]; p.w_pu = (const float*)d_in[29]; p.ln3_g = (const float*)d_in[30]; p.ln3_b = (const float*)d_in[31];
    p.out = (float*)d_out;
    char* w = (char*)d_ws; size_t off = 0;
    auto alloc = [&](size_t bytes) { void* r = w + off; off += (bytes + 255) & ~(size_t)255; return r; };
    p.bar = (unsigned*)alloc(16384); p.cnt = (int*)alloc(DEPTH * 64 * 4);
    const size_t zero_bytes = off;
    p.X = (float*)alloc((size_t)T * D * 4); p.Z = (float*)alloc((size_t)T * D * 4); p.Xb = (bf16_t*)alloc((size_t)T * D * 2); p.Db = (bf16_t*)alloc((size_t)T * D * 2);
    p.cs = (float*)alloc((size_t)T * 32 * 4); p.sn = (float*)alloc((size_t)T * 32 * 4); p.ssq_q = (float*)alloc((size_t)4 * T * 4); p.ssq_kv = (float*)alloc((size_t)4 * T * 4);
    p.Hp = (bf16_t*)alloc((size_t)T * HW * 2); p.GVt = (bf16_t*)alloc((size_t)T * 512 * 2);
    p.Qb = (bf16_t*)alloc((size_t)T * 768 * 2); p.KnImg = (bf16_t*)alloc((size_t)T * 512 * 2); p.VtImg = (bf16_t*)alloc((size_t)T * 512 * 2); p.KrImg = (bf16_t*)alloc((size_t)T * 64 * 2);
    p.MLpart = (float*)alloc((size_t)512 * 256 * 2 * 4);
    p.QE = (bf16_t*)alloc((size_t)T * 256 * 2); p.OI = (float*)alloc((size_t)T * 512 * 4); p.kvT = (float*)alloc((size_t)1024 * 8192 * 4); p.decay = (float*)alloc((size_t)1024 * 64 * 4); p.spT = (bf16_t*)alloc((size_t)1024 * 8192 * 2);
    p.Yab = (bf16_t*)alloc((size_t)T * 512 * 2); p.Ybb = (bf16_t*)alloc((size_t)T * 512 * 2); p.Ycb = (bf16_t*)alloc((size_t)T * 512 * 2); p.Mgb = (bf16_t*)alloc((size_t)T * D * 2);
    p.ew = (float*)alloc((size_t)T * 2 * 4); p.lists = (int*)alloc((size_t)NE * LCAP * 4);
    p.Hbuf = (bf16_t*)alloc((size_t)192 * 256 * EH * 2); p.Ys = (bf16_t*)alloc((size_t)2 * T * D * 2); p.Ub = (bf16_t*)alloc((size_t)T * D * 2); p.Pb = (bf16_t*)alloc((size_t)DEPTH * T * PLE * 2);
    p.Wb_in = (bf16_t*)alloc((size_t)HW * D * 2); p.Wb_gv = (bf16_t*)alloc((size_t)512 * D * 2); p.Wb_uq = (bf16_t*)alloc((size_t)768 * 256 * 2); p.Wb_uk = (bf16_t*)alloc((size_t)512 * 256 * 2); p.Wb_uv = (bf16_t*)alloc((size_t)512 * 256 * 2);
    p.Wb_br = (bf16_t*)alloc((size_t)3 * D * 512 * 2); p.Wb_o = (bf16_t*)alloc((size_t)D * D * 2); p.Wb_gu = (bf16_t*)alloc((size_t)NE * 512 * D * 2); p.Wb_d = (bf16_t*)alloc((size_t)NE * D * EH * 2);
    p.Wb_pg = (bf16_t*)alloc((size_t)D * D * 2); p.Wb_pu = (bf16_t*)alloc((size_t)D * PLE * 2);
    if (off > ws_size) return;
    (void)hipMemsetAsync(d_ws, 0, zero_bytes, st);
#if defined(MULTI_LAUNCH)
    launch_ph<PH_PRO>(p, 0, st);
    for (int i = 0; i < DEPTH; ++i) {
        launch_ph<PH_CONV>(p, i, st); launch_ph<PH_IN>(p, i, st);
        launch_ph<PH_PREP_Q>(p, i, st); launch_ph<PH_PREP_K>(p, i, st); launch_ph<PH_PREP_V>(p, i, st); launch_ph<PH_PREP_G>(p, i, st);
        launch_ph<PH_ATT>(p, i, st); launch_ph<PH_FIN>(p, i, st); launch_ph<PH_BR>(p, i, st); launch_ph<PH_WO>(p, i, st); launch_ph<PH_LN1>(p, i, st);
        launch_ph<PH_M1>(p, i, st); launch_ph<PH_M2>(p, i, st); launch_ph<PH_LN2>(p, i, st); launch_ph<PH_PLE>(p, i, st); launch_ph<PH_LN3>(p, i, st);
    }
#else
    static bool set = false;
    if (!set) { (void)hipFuncSetAttribute((const void*)k_mega, hipFuncAttributeMaxDynamicSharedMemorySize, LDS_BYTES); set = true; }
    hipLaunchKernelGGL(k_mega, dim3(NBLK), dim3(NTHR), LDS_BYTES, st, p);
#endif
}
```

```cpp
#include <hip/hip_runtime.h>
#include <hip/hip_bf16.h>
#include <stdint.h>

constexpr int T = 16384, D = 1024, DEPTH = 4, PLE = 256;
constexpr int NE = 64, EH = 256;
constexpr int INW = 6608;
constexpr int O_GV = 2048;
constexpr float DN_ALPHA = 1.681792830507429f;
constexpr int LCAP = 32768;
#define LAS __attribute__((address_space(3)))
typedef unsigned short bf16_t;
typedef short bf16x8 __attribute__((ext_vector_type(8)));
typedef float f32x4 __attribute__((ext_vector_type(4)));
typedef float f32x16 __attribute__((ext_vector_type(16)));
typedef unsigned u32x4 __attribute__((ext_vector_type(4)));
typedef unsigned u32x2 __attribute__((ext_vector_type(2)));
typedef float f32x2 __attribute__((ext_vector_type(2)));
constexpr int NBLK = 256, NTHR = 512;
constexpr int STAGE_BYTES = 131072, LDS_BYTES = 147456 + 512, XBW_OFF = 147456 + 256;
constexpr int HW = 6144;
constexpr int H_AB = 0, H_AC = 512, H_AX = 1024, H_GQ = 1536, H_GK = 1792, H_GR = 2048, H_CQ = 2560, H_CKV = 2816, H_KR = 2944, H_GLR = 3008, H_GTA = 3072, H_GTB = 4096, H_GTC = 5120;

__device__ __forceinline__ unsigned cvt_pk_bf16(float lo, float hi) { unsigned r; asm volatile("v_cvt_pk_bf16_f32 %0, %1, %2" : "=v"(r) : "v"(lo), "v"(hi)); return r; }
constexpr int WTAB_OFF = 147456;
__device__ __forceinline__ int tid_now() {
    const unsigned hw = (unsigned)__builtin_amdgcn_s_getreg((5 << 11) | 4) & 63u;
    extern __shared__ __attribute__((aligned(16))) unsigned char smem_tid[];
    const int w = __builtin_amdgcn_readfirstlane(*(volatile LAS int*)((LAS unsigned char*)smem_tid + WTAB_OFF + 4 * hw));
    int l = (int)__builtin_amdgcn_mbcnt_hi(~0u, __builtin_amdgcn_mbcnt_lo(~0u, 0u));
    asm volatile("" : "+v"(l));
    return w * 64 + l; }
__device__ __forceinline__ void tid_setup() {
    const unsigned hw = (unsigned)__builtin_amdgcn_s_getreg((5 << 11) | 4) & 63u;
    extern __shared__ __attribute__((aligned(16))) unsigned char smem_tid[];
    if ((threadIdx.x & 63) == 0) *(volatile LAS int*)((LAS unsigned char*)smem_tid + WTAB_OFF + 4 * hw) = (int)(threadIdx.x >> 6);
    __syncthreads(); }
__device__ __forceinline__ int sgpr_now(int v) { asm volatile("" : "+s"(v)); return v; }
__device__ __forceinline__ float shx(float v, int mask, int lane) { return __int_as_float(__builtin_amdgcn_ds_bpermute((lane ^ mask) << 2, __float_as_int(v))); }
__device__ __forceinline__ float bf2f(bf16_t b) { return __uint_as_float(((unsigned)b) << 16); }
__device__ __forceinline__ float bflo(unsigned w) { return __uint_as_float(w << 16); }
__device__ __forceinline__ float bfhi(unsigned w) { return __uint_as_float(w & 0xffff0000u); }

namespace ge {
constexpr int BM = 256, BK = 64, HALF = 128, HTB = HALF * BK * 2;
__device__ __forceinline__ int lds_byte(int r, int c) { const int st = (r >> 4) * 2 + (c >> 5), rr = r & 15, cc = c & 31, ob = rr * 64 + cc * 2; return st * 1024 + (ob ^ (((ob >> 9) & 1) << 5)); }
__device__ __forceinline__ void stage_rc(int b, int& R, int& C) { const int st = b / 1024, sb = b % 1024, swz = sb ^ (((sb >> 9) & 1) << 5); R = (st >> 1) * 16 + swz / 64; C = (st & 1) * 32 + (swz % 64) / 2; }
__device__ __forceinline__ int perm32(int rho) { const int n = rho >> 4, i = rho & 15; return 8 * (i >> 2) + 4 * n + (i & 3); }
struct Unit { int pm, pn, g; };
typedef f32x4 Acc[2][2][4][2];
struct NoCarry { __device__ __forceinline__ bool carry(const struct Unit&) const { return false; } };

template <class Epi, class Sched, bool GATHER>
__device__ __forceinline__ void gemm_stream(LAS unsigned char* lds, const int K, const int lda, const int ldb, const Sched& S, const Epi& E) {
    const int tid = tid_now(), wid = __builtin_amdgcn_readfirstlane(tid >> 6), lane = tid & 63, wr = wid >> 2, wc = wid & 3, fr = lane & 15, fq = lane >> 4;
    const int nt = K / BK;
    Unit cur, nxt; int ui = 0;
    if (!S.next(0, cur)) return;
    unsigned voffA[2][2], nvoffA[2][2], voffB[2][2];
#pragma unroll
    for (int i = 0; i < 2; ++i) { int R, C; stage_rc(tid * 16 + i * 8192, R, C); const int Rb = (R & ~31) + perm32(R & 31);
        voffB[0][i] = (unsigned)(Rb * ldb + C) * 2u; voffB[1][i] = (unsigned)((Rb + 128) * ldb + C) * 2u;
        if constexpr (GATHER) { voffA[0][i] = (unsigned)(S.arow(cur, R) * lda + C) * 2u; voffA[1][i] = (unsigned)(S.arow(cur, R + 128) * lda + C) * 2u; }
        else { voffA[0][i] = (unsigned)(R * lda + C) * 2u; voffA[1][i] = (unsigned)((R + 128) * lda + C) * 2u; }
        nvoffA[0][i] = voffA[0][i]; nvoffA[1][i] = voffA[1][i]; }
    const size_t kstep = (size_t)(BK * 2);
    const unsigned ldsw = (unsigned)wid * 1024u;
    const int aoff = lds_byte(wr * 64 + fr, fq * 8), boff = lds_byte(wc * 32 + fr, fq * 8);
#define GE_SA(b, h) (((b) * 2 + (h)) * HTB)
#define GE_SB(b, h) ((4 + (b) * 2 + (h)) * HTB)
#define GE_STAGE(bufoff, gbase, voff) do { _Pragma("unroll") for (int _i = 0; _i < 2; ++_i) \
        __builtin_amdgcn_global_load_lds((const unsigned*)((const char*)(gbase) + (voff)[_i]), (LAS unsigned*)(lds + (bufoff) + ldsw + _i * 8192), 16, 0, 0); } while (0)
#define GE_LDA(dst, b, h) do { _Pragma("unroll") for (int m = 0; m < 4; ++m) _Pragma("unroll") for (int k = 0; k < 2; ++k) dst[m][k] = *(const LAS bf16x8*)(lds + GE_SA(b, h) + aoff + m * 2048 + k * 1024); } while (0)
#define GE_LDB(dst, b, h) do { _Pragma("unroll") for (int n = 0; n < 2; ++n) _Pragma("unroll") for (int k = 0; k < 2; ++k) dst[n][k] = *(const LAS bf16x8*)(lds + GE_SB(b, h) + boff + n * 2048 + k * 1024); } while (0)
#define GE_MMA(ai, bj, At, Bt) do { __builtin_amdgcn_s_setprio(1); _Pragma("unroll") for (int m = 0; m < 4; ++m) _Pragma("unroll") for (int n = 0; n < 2; ++n) _Pragma("unroll") for (int k = 0; k < 2; ++k) \
        acc[ai][bj][m][n] = __builtin_amdgcn_mfma_f32_16x16x32_bf16(Bt[n][k], At[m][k], acc[ai][bj][m][n], 0, 0, 0); __builtin_amdgcn_s_setprio(0); } while (0)
#define GE_WAIT_V(n) asm volatile("s_waitcnt vmcnt(" #n ")" ::: "memory")
#define GE_WAIT_L(n) asm volatile("s_waitcnt lgkmcnt(" #n ")" ::: "memory")
#define GE_BAR __builtin_amdgcn_s_barrier()
#define GE_SCHED __builtin_amdgcn_sched_barrier(0)
    Acc acc;
#pragma unroll
    for (int a = 0; a < 2; ++a)
#pragma unroll
        for (int b = 0; b < 2; ++b)
#pragma unroll
            for (int m = 0; m < 4; ++m)
#pragma unroll
                for (int n = 0; n < 2; ++n) acc[a][b][m][n] = (f32x4){0.f, 0.f, 0.f, 0.f};
    bf16x8 At[4][2], B0[2][2], B1[2][2];
    const char* cA = S.aptr(cur); const char* cB = S.bptr(cur);
    GE_STAGE(GE_SB(0, 0), cB, voffB[0]); GE_STAGE(GE_SA(0, 0), cA, voffA[0]); GE_STAGE(GE_SB(0, 1), cB, voffB[1]); GE_STAGE(GE_SA(0, 1), cA, voffA[1]);
    if (wr == 1) GE_BAR;
    GE_WAIT_V(4); GE_BAR;
    GE_STAGE(GE_SB(1, 0), cB + kstep, voffB[0]); GE_STAGE(GE_SA(1, 0), cA + kstep, voffA[0]); GE_STAGE(GE_SB(1, 1), cB + kstep, voffB[1]);
    GE_WAIT_V(6); GE_BAR;
    for (;;) {
        const bool has_next = S.next(ui + 1, nxt);
        const char* nA = has_next ? S.aptr(nxt) : cA; const char* nB = has_next ? S.bptr(nxt) : cB;
#pragma unroll 1
        for (int t = 0; t < nt; t += 2) {
            const bool last = (t == nt - 2);
            const char* a1 = cA + (size_t)(t + 1) * kstep;
            const char* a2 = last ? nA : cA + (size_t)(t + 2) * kstep; const char* b2 = last ? nB : cB + (size_t)(t + 2) * kstep;
            const char* a3 = a2 + kstep; const char* b3 = b2 + kstep;
            if constexpr (GATHER) { if (last && has_next) {
#pragma unroll
                for (int i = 0; i < 2; ++i) { int R, C; stage_rc(tid * 16 + i * 8192, R, C);
                    nvoffA[0][i] = (unsigned)(S.arow(nxt, R) * lda + C) * 2u; nvoffA[1][i] = (unsigned)(S.arow(nxt, R + 128) * lda + C) * 2u; } } }
            unsigned va2[2][2];
#pragma unroll
            for (int h = 0; h < 2; ++h)
#pragma unroll
                for (int i = 0; i < 2; ++i) va2[h][i] = (GATHER && last) ? nvoffA[h][i] : voffA[h][i];
            GE_LDB(B0, 0, 0); GE_SCHED; GE_LDA(At, 0, 0); GE_STAGE(GE_SA(1, 1), a1, voffA[1]);
            GE_WAIT_L(8); GE_BAR; GE_WAIT_L(0); GE_MMA(0, 0, At, B0); GE_BAR; GE_SCHED;
            GE_LDB(B1, 0, 1); GE_STAGE(GE_SB(0, 0), b2, voffB[0]);
            GE_BAR; GE_WAIT_L(0); GE_MMA(0, 1, At, B1); GE_BAR;
            GE_LDA(At, 0, 1); GE_STAGE(GE_SA(0, 0), a2, va2[0]);
            GE_BAR; GE_WAIT_L(0); GE_MMA(1, 0, At, B0); GE_BAR; GE_SCHED;
            GE_STAGE(GE_SB(0, 1), b2, voffB[1]);
            GE_WAIT_V(6); GE_BAR; GE_MMA(1, 1, At, B1); GE_BAR;
            GE_LDB(B0, 1, 0); GE_SCHED; GE_LDA(At, 1, 0); GE_STAGE(GE_SA(0, 1), a2, va2[1]);
            GE_WAIT_L(8); GE_BAR; GE_WAIT_L(0); GE_MMA(0, 0, At, B0); GE_BAR; GE_SCHED;
            GE_LDB(B1, 1, 1); GE_STAGE(GE_SB(1, 0), b3, voffB[0]);
            GE_BAR; GE_WAIT_L(0); GE_MMA(0, 1, At, B1); GE_BAR;
            GE_LDA(At, 1, 1); GE_STAGE(GE_SA(1, 0), a3, va2[0]);
            GE_BAR; GE_WAIT_L(0); GE_MMA(1, 0, At, B0); GE_BAR; GE_SCHED;
            GE_STAGE(GE_SB(1, 1), b3, voffB[1]);
            GE_WAIT_V(6); GE_BAR; GE_MMA(1, 1, At, B1); GE_BAR;
        }
        { int tz = tid; asm volatile("" : "+v"(tz));
          const int wid2 = tz >> 6, lane2 = tz & 63; E(acc, cur, wid2 >> 2, wid2 & 3, lane2 & 15, lane2 >> 4); }
        if (!has_next) break;
        if (!S.carry(cur)) {
#pragma unroll
        for (int a = 0; a < 2; ++a)
#pragma unroll
            for (int b = 0; b < 2; ++b)
#pragma unroll
                for (int m = 0; m < 4; ++m)
#pragma unroll
                    for (int n = 0; n < 2; ++n) acc[a][b][m][n] = (f32x4){0.f, 0.f, 0.f, 0.f}; }
        cur = nxt; cA = nA; cB = nB; ++ui;
        if (GATHER) {
#pragma unroll
            for (int h = 0; h < 2; ++h)
#pragma unroll
                for (int i = 0; i < 2; ++i) voffA[h][i] = nvoffA[h][i]; }
    }
    GE_WAIT_V(0);
    if (wr == 0) GE_BAR;
    GE_BAR;
#undef GE_SA
#undef GE_SB
#undef GE_STAGE
#undef GE_LDA
#undef GE_LDB
#undef GE_MMA
#undef GE_WAIT_V
#undef GE_WAIT_L
#undef GE_BAR
#undef GE_SCHED
}
__device__ __forceinline__ void tile_order(int L, int nM, int nN, int& pm, int& pn) {
    const int nwg = nM * nN; int wgid = L;
    { const int q = nwg / 8, r = nwg % 8, xcd = wgid % 8, off = wgid / 8; wgid = (xcd < r ? xcd * (q + 1) : r * (q + 1) + (xcd - r) * q) + off; }
    const int nig = 8 * nN, gid = wgid / nig, fm = gid * 8, gsz = (nM - fm) < 8 ? (nM - fm) : 8;
    pm = fm + ((wgid % nig) % gsz); pn = (wgid % nig) / gsz;
}
}
struct MapInMain { __device__ __forceinline__ int operator()(int s) const {
    if (s < 2048) return s;
    if (s < 2560) return 2576 + (s - 2048);
    if (s < 2816) return 3088 + (s - 2560);
    if (s < 2944) return 3344 + (s - 2816);
    if (s < 3008) return 3472 + (s - 2944);
    if (s < 3024) return 2560 + (s - 3008);
    if (s < 3072) return -1;
    return 3536 + (s - 3072); } };
struct MapOff { int off; __device__ __forceinline__ int operator()(int s) const { return off + s; } };struct MegaP {
    const float* w_in; bf16_t* Wb_in; bf16_t* Wb_gv; const bf16_t* Xb; bf16_t* Hp; bf16_t* GVt; float* ssq_q; float* ssq_kv;
};
struct SchedIn : ge::NoCarry {
    const char* Xb; const char* Wm; const char* Wg; int c, G, gv;
    __device__ __forceinline__ bool next(int i, ge::Unit& u) const {
        const int L = i * G + c;
        if (gv) { if (L >= 128) return false; u.g = 0; u.pm = L >> 1; u.pn = 8 + (L & 1); return true; }
        if (L >= 1536) return false;
        if (L < 1408) { u.g = 0; ge::tile_order(L, 64, 22, u.pm, u.pn); if (u.pn >= 8) u.pn += 2; } else { u.g = 1; const int l = L - 1408; u.pm = l & 1; u.pn = l >> 1; }
        return true; }
    __device__ __forceinline__ const char* aptr(const ge::Unit& u) const { return u.g == 0 ? Xb + (size_t)u.pm * 256 * D * 2 : Wg + (size_t)u.pm * 256 * D * 2; }
    __device__ __forceinline__ const char* bptr(const ge::Unit& u) const { return u.g == 0 ? Wm + (size_t)u.pn * 256 * D * 2 : Xb + (size_t)u.pn * 256 * D * 2; }
};
template <int GV> struct EpiIn {
    bf16_t* Hp; bf16_t* GVt; float* ssq_q; float* ssq_kv;
    __device__ __forceinline__ void operator()(ge::Acc& acc, const ge::Unit& u, int wr, int wc, int fr, int fq) const {
        if (GV == 0 || (GV == 2 && u.g == 0)) {
            const int row0 = u.pm * 256 + wr * 64 + fr, col0 = u.pn * 256 + wc * 32 + 8 * fq;
            const bool sg = u.pn >= 12;
#pragma unroll
            for (int ai = 0; ai < 2; ++ai)
#pragma unroll
                for (int m = 0; m < 4; ++m) { const int row = row0 + ai * 128 + m * 16; bf16_t* rp = Hp + (size_t)row * HW + col0;
                    float sq0 = 0.f, sq1 = 0.f;
#pragma unroll
                    for (int bj = 0; bj < 2; ++bj) { f32x4 v0 = acc[ai][bj][m][0], v1 = acc[ai][bj][m][1];
                        if (sg) {
#pragma unroll
                            for (int j = 0; j < 4; ++j) { v0[j] = 1.f / (1.f + __expf(-v0[j])); v1[j] = 1.f / (1.f + __expf(-v1[j])); } }
                        const float s = v0[0] * v0[0] + v0[1] * v0[1] + v0[2] * v0[2] + v0[3] * v0[3] + v1[0] * v1[0] + v1[1] * v1[1] + v1[2] * v1[2] + v1[3] * v1[3];
                        if (bj == 0) sq0 = s; else sq1 = s;
                        u32x4 o = {cvt_pk_bf16(v0[0], v0[1]), cvt_pk_bf16(v0[2], v0[3]), cvt_pk_bf16(v1[0], v1[1]), cvt_pk_bf16(v1[2], v1[3])};
                        *(u32x4*)(rp + bj * 128) = o; }
                    if (u.pn == 10 || u.pn == 11) {
                        float s = (u.pn == 10) ? (sq0 + sq1) : sq0;
                        { const int ln = fq * 16 + fr; s += shx(s, 16, ln); s += shx(s, 32, ln); }
                        if (fq == 0) { float* dst = (u.pn == 10 ? ssq_q : ssq_kv); dst[(size_t)wc * T + row] = s; } } }
        } else {
#pragma unroll
            for (int ai = 0; ai < 2; ++ai)
#pragma unroll
                for (int m = 0; m < 4; ++m) { const int r = u.pm * 256 + ai * 128 + wr * 64 + m * 16 + fr, h = r >> 7, e = r & 127;
#pragma unroll
                    for (int bj = 0; bj < 2; ++bj) { const int t0 = u.pn * 256 + bj * 128 + wc * 32 + 8 * fq;
                        const int chunk = t0 >> 6, p0 = (t0 & 48) + ((t0 & 8) >> 1);
                        bf16_t* base = GVt + ((size_t)(chunk * 4 + h) * 128 + e) * 64;
                        const f32x4 v0 = acc[ai][bj][m][0], v1 = acc[ai][bj][m][1];
                        u32x2 o0 = {cvt_pk_bf16(v0[0], v0[1]), cvt_pk_bf16(v0[2], v0[3])}, o1 = {cvt_pk_bf16(v1[0], v1[1]), cvt_pk_bf16(v1[2], v1[3])};
                        *(u32x2*)(base + p0) = o0; *(u32x2*)(base + p0 + 8) = o1; } }
        }
    }
};
constexpr float QSCALE = 0.07216878364870322f * 1.4426950408889634f;
struct MapQ { __device__ __forceinline__ int operator()(int s) const {
    if (s < 512) return (s >> 7) * 192 + (s & 127);
    const int s2 = s - 512, bj = s2 >> 7, w = s2 & 127; return (w >> 5) * 192 + 128 + bj * 32 + (w & 31); } };
struct MapKV { int voff; __device__ __forceinline__ int operator()(int s) const { return (s >> 7) * 256 + voff + (s & 127); } };

struct MlaP {
    const float* w_uq; const float* w_ukv; const float* qn_g; const float* kvn_g;
    bf16_t* Wb_uq; bf16_t* Wb_uk; bf16_t* Wb_uv;
    const bf16_t* Hp; const float* ssq_q; const float* ssq_kv; const float* cs; const float* sn;
    bf16_t* Qb; bf16_t* KnImg; bf16_t* VtImg; bf16_t* KrImg; float* Opart; float* MLpart; float* Yc;
};
__device__ __forceinline__ float rstd4(const float* ssq, int row, float invw) {
    const float s = (ssq[row] + ssq[T + row]) + (ssq[2 * T + row] + ssq[3 * T + row]); return rsqrtf(s * invw + 1e-6f); }

template <int mode> struct SchedMla : ge::NoCarry { const char* A; const char* B; int c, G;
    __device__ __forceinline__ bool next(int i, ge::Unit& u) const {
        if (c < 0) return false;
        const int L = i * G + c; u.g = mode;
        if (mode == 0) { if (L >= 192) return false; u.pm = L / 3; u.pn = L % 3; }
        else if (mode == 1) { if (L >= 128) return false; u.pm = L >> 1; u.pn = L & 1; }
        else { if (L >= 128) return false; u.pm = L & 1; u.pn = L >> 1; }
        return true; }
    __device__ __forceinline__ const char* aptr(const ge::Unit& u) const { return mode == 2 ? A + (size_t)u.pm * 256 * 256 * 2 : A + (size_t)u.pm * 256 * HW * 2; }
    __device__ __forceinline__ const char* bptr(const ge::Unit& u) const { return mode == 2 ? B + (size_t)u.pn * 256 * HW * 2 : B + (size_t)u.pn * 256 * 256 * 2; }
};
template <int MODE> struct EpiMla { MlaP p;
    __device__ __forceinline__ void operator()(ge::Acc& acc, const ge::Unit& u, int wr, int wc, int fr, int fq) const {
        if constexpr (MODE == 0) {
#pragma unroll
            for (int ai = 0; ai < 2; ++ai)
#pragma unroll
                for (int m = 0; m < 4; ++m) { asm volatile("" ::: "memory"); const int t = u.pm * 256 + ai * 128 + wr * 64 + m * 16 + fr; const float rs = rstd4(p.ssq_q, t, 1.f / 256.f) * QSCALE;
                    if (u.pn < 2) {
#pragma unroll
                        for (int bj = 0; bj < 2; ++bj) { const int c0 = u.pn * 256 + bj * 128 + wc * 32 + 8 * fq, head = c0 >> 7, dim = c0 & 127;
                            const f32x4 v0 = acc[ai][bj][m][0] * rs, v1 = acc[ai][bj][m][1] * rs;
                            u32x4 o = {cvt_pk_bf16(v0[0], v0[1]), cvt_pk_bf16(v0[2], v0[3]), cvt_pk_bf16(v1[0], v1[1]), cvt_pk_bf16(v1[2], v1[3])};
                            *(u32x4*)(p.Qb + (size_t)t * 768 + head * 192 + dim) = o; }
                    } else { const int head = wc, i0 = 8 * fq;
                        float o1[8], o2[8];
#pragma unroll
                        for (int n = 0; n < 2; ++n) { const f32x4 c4 = *(const f32x4*)(p.cs + (size_t)t * 32 + i0 + 4 * n), s4 = *(const f32x4*)(p.sn + (size_t)t * 32 + i0 + 4 * n);
#pragma unroll
                            for (int j = 0; j < 4; ++j) { const float x1 = acc[ai][0][m][n][j] * rs, x2 = acc[ai][1][m][n][j] * rs; o1[4 * n + j] = x1 * c4[j] - x2 * s4[j]; o2[4 * n + j] = x1 * s4[j] + x2 * c4[j]; } }
                        u32x4 a = {cvt_pk_bf16(o1[0], o1[1]), cvt_pk_bf16(o1[2], o1[3]), cvt_pk_bf16(o1[4], o1[5]), cvt_pk_bf16(o1[6], o1[7])};
                        u32x4 b = {cvt_pk_bf16(o2[0], o2[1]), cvt_pk_bf16(o2[2], o2[3]), cvt_pk_bf16(o2[4], o2[5]), cvt_pk_bf16(o2[6], o2[7])};
                        *(u32x4*)(p.Qb + (size_t)t * 768 + head * 192 + 128 + i0) = a; *(u32x4*)(p.Qb + (size_t)t * 768 + head * 192 + 160 + i0) = b; } }
        } else if constexpr (MODE == 1) {
#pragma unroll
            for (int ai = 0; ai < 2; ++ai)
#pragma unroll
                for (int m = 0; m < 4; ++m) { asm volatile("" ::: "memory"); const int t = u.pm * 256 + ai * 128 + wr * 64 + m * 16 + fr; const float rs = rstd4(p.ssq_kv, t, 1.f / 128.f);
                    const int tile = t >> 6, key = t & 63;
#pragma unroll
                    for (int bj = 0; bj < 2; ++bj) { const int c0 = u.pn * 256 + bj * 128 + wc * 32 + 8 * fq, head = c0 >> 7, chunk = (c0 & 127) >> 3;
                        const f32x4 v0 = acc[ai][bj][m][0] * rs, v1 = acc[ai][bj][m][1] * rs;
                        u32x4 o = {cvt_pk_bf16(v0[0], v0[1]), cvt_pk_bf16(v0[2], v0[3]), cvt_pk_bf16(v1[0], v1[1]), cvt_pk_bf16(v1[2], v1[3])};
                        *(u32x4*)((char*)p.KnImg + ((size_t)(head * 256 + tile) * 16384) + key * 256 + ((chunk ^ (key & 15)) << 4)) = o; } }
        } else {
#pragma unroll
            for (int bj = 0; bj < 2; ++bj) { const int t0 = u.pn * 256 + bj * 128 + wc * 32 + 8 * fq;
                float rs[8];
#pragma unroll
                for (int j = 0; j < 8; ++j) rs[j] = rstd4(p.ssq_kv, t0 + j, 1.f / 128.f);
                const int tile = t0 >> 6, p0 = (t0 & 48) + ((t0 & 8) >> 1);
#pragma unroll
                for (int ai = 0; ai < 2; ++ai)
#pragma unroll
                    for (int m = 0; m < 4; ++m) { asm volatile("" ::: "memory"); const int r = u.pm * 256 + ai * 128 + wr * 64 + m * 16 + fr, head = r >> 7, d = r & 127;
                        char* base = (char*)p.VtImg + ((size_t)(head * 256 + tile) * 16384) + d * 128;
                        const f32x4 v0 = acc[ai][bj][m][0], v1 = acc[ai][bj][m][1];
                        u32x2 o0 = {cvt_pk_bf16(v0[0] * rs[0], v0[1] * rs[1]), cvt_pk_bf16(v0[2] * rs[2], v0[3] * rs[3])};
                        u32x2 o1 = {cvt_pk_bf16(v1[0] * rs[4], v1[1] * rs[5]), cvt_pk_bf16(v1[2] * rs[6], v1[3] * rs[7])};
                        const int sw = (d >> 1) & 7, pa = p0, pb = p0 + 8;
                        *(u32x2*)(base + (((pa >> 3) ^ sw) << 4) + (pa & 7) * 2) = o0;
                        *(u32x2*)(base + (((pb >> 3) ^ sw) << 4) + (pb & 7) * 2) = o1; } }
        }
    }
};
__device__ __forceinline__ void kr_phase(const MlaP& p, int gtid, int gthreads) {
    for (int idx = gtid; idx < T * 4; idx += gthreads) { const int t = idx >> 2, c = idx & 3, i0 = 8 * c;
        const u32x4 a = *(const u32x4*)(p.Hp + (size_t)t * HW + H_KR + i0), b = *(const u32x4*)(p.Hp + (size_t)t * HW + H_KR + 32 + i0);
        float o1[8], o2[8];
#pragma unroll
        for (int n = 0; n < 2; ++n) { const f32x4 c4 = *(const f32x4*)(p.cs + (size_t)t * 32 + i0 + 4 * n), s4 = *(const f32x4*)(p.sn + (size_t)t * 32 + i0 + 4 * n);
#pragma unroll
            for (int j = 0; j < 4; ++j) { const int e = 4 * n + j; const unsigned wa = a[e >> 1], wb = b[e >> 1];
                const float x1 = (e & 1) ? bfhi(wa) : bflo(wa), x2 = (e & 1) ? bfhi(wb) : bflo(wb);
                o1[e] = x1 * c4[j] - x2 * s4[j]; o2[e] = x1 * s4[j] + x2 * c4[j]; } }
        u32x4 oa = {cvt_pk_bf16(o1[0], o1[1]), cvt_pk_bf16(o1[2], o1[3]), cvt_pk_bf16(o1[4], o1[5]), cvt_pk_bf16(o1[6], o1[7])};
        u32x4 ob = {cvt_pk_bf16(o2[0], o2[1]), cvt_pk_bf16(o2[2], o2[3]), cvt_pk_bf16(o2[4], o2[5]), cvt_pk_bf16(o2[6], o2[7])};
        const int tile = t >> 6, key = t & 63, sw = (key >> 1) & 7;
        char* base = (char*)p.KrImg + (size_t)tile * 8192 + key * 128;
        *(u32x4*)(base + ((c ^ sw) << 4)) = oa; *(u32x4*)(base + (((c + 4) ^ sw) << 4)) = ob; }
}
constexpr int ATT_STEPS = 130;
__device__ __forceinline__ void attn_item(LAS unsigned char* lds, const MlaP& p, int head, int b, int j0, int j1, int slot) {
    const int tid = tid_now(), wid = __builtin_amdgcn_readfirstlane(tid >> 6), lane = tid & 63, q = lane & 31, hh = lane >> 5;
    const int trow = b * 256 + wid * 32 + q;
    bf16x8 qf[12];
    { const bf16_t* qp = p.Qb + (size_t)trow * 768 + head * 192 + 8 * hh;
#pragma unroll
      for (int s = 0; s < 12; ++s) qf[s] = *(const bf16x8*)(qp + 16 * s); }
    f32x16 O[4];
#pragma unroll
    for (int d = 0; d < 4; ++d)
#pragma unroll
        for (int r = 0; r < 16; ++r) O[d][r] = 0.f;
    float m_run = -1e30f, l_run = 0.f;
    const char* knb = (const char*)p.KnImg + (size_t)head * 256 * 16384; const char* vtb = (const char*)p.VtImg + (size_t)head * 256 * 16384; const char* krb = (const char*)p.KrImg;
    const unsigned lo = (unsigned)lane * 16u;
#define AT_ISSUE(j, bi) do { const unsigned _bo = (unsigned)(bi) * 40960u; \
        __builtin_amdgcn_global_load_lds((const unsigned*)(knb + (size_t)(j) * 16384 + (wid * 2) * 1024 + lo), (LAS unsigned*)(lds + _bo + (wid * 2) * 1024), 16, 0, 0); \
        __builtin_amdgcn_global_load_lds((const unsigned*)(knb + (size_t)(j) * 16384 + (wid * 2 + 1) * 1024 + lo), (LAS unsigned*)(lds + _bo + (wid * 2 + 1) * 1024), 16, 0, 0); \
        __builtin_amdgcn_global_load_lds((const unsigned*)(krb + (size_t)(j) * 8192 + wid * 1024 + lo), (LAS unsigned*)(lds + _bo + 16384 + wid * 1024), 16, 0, 0); \
        __builtin_amdgcn_global_load_lds((const unsigned*)(vtb + (size_t)(j) * 16384 + (wid * 2) * 1024 + lo), (LAS unsigned*)(lds + _bo + 24576 + (wid * 2) * 1024), 16, 0, 0); \
        __builtin_amdgcn_global_load_lds((const unsigned*)(vtb + (size_t)(j) * 16384 + (wid * 2 + 1) * 1024 + lo), (LAS unsigned*)(lds + _bo + 24576 + (wid * 2 + 1) * 1024), 16, 0, 0); } while (0)
    const int kn_off0 = q * 256, kn_sw = q & 15, kr_off0 = q * 128, kr_sw = (q >> 1) & 7;
    const int vt_sw = (q >> 1) & 7;
    constexpr float THR = 8.f;
    AT_ISSUE(j0, 0);
    if (j0 + 1 < j1) AT_ISSUE(j0 + 1, 1);
    bool first = true;
    for (int j = j0; j < j1; ++j) {
        const int cur = (j - j0) % 3;
        if (j + 1 < j1) asm volatile("s_waitcnt vmcnt(5)" ::: "memory"); else asm volatile("s_waitcnt vmcnt(0)" ::: "memory");
        __builtin_amdgcn_s_barrier(); asm volatile("" ::: "memory");
        if (j + 2 < j1) AT_ISSUE(j + 2, (j + 2 - j0) % 3);
        const int jj = j - 4 * b;
        if (!(jj >= 0 && 64 * jj > 32 * wid + 31)) {
            LAS unsigned char* bb = lds + cur * 40960;
            const float mref = first ? 0.f : m_run;
            f32x16 S0, S1;
#pragma unroll
            for (int r = 0; r < 16; ++r) { S0[r] = -mref; S1[r] = -mref; }
#pragma unroll
            for (int s = 0; s < 8; ++s) {
                const bf16x8 k0 = *(const LAS bf16x8*)(bb + kn_off0 + (((2 * s + hh) ^ kn_sw) << 4));
                const bf16x8 k1 = *(const LAS bf16x8*)(bb + 8192 + kn_off0 + (((2 * s + hh) ^ kn_sw) << 4));
                S0 = __builtin_amdgcn_mfma_f32_32x32x16_bf16(k0, qf[s], S0, 0, 0, 0);
                S1 = __builtin_amdgcn_mfma_f32_32x32x16_bf16(k1, qf[s], S1, 0, 0, 0); }
#pragma unroll
            for (int s = 0; s < 4; ++s) {
                const bf16x8 k0 = *(const LAS bf16x8*)(bb + 16384 + kr_off0 + (((2 * s + hh) ^ kr_sw) << 4));
                const bf16x8 k1 = *(const LAS bf16x8*)(bb + 16384 + 4096 + kr_off0 + (((2 * s + hh) ^ kr_sw) << 4));
                S0 = __builtin_amdgcn_mfma_f32_32x32x16_bf16(k0, qf[8 + s], S0, 0, 0, 0);
                S1 = __builtin_amdgcn_mfma_f32_32x32x16_bf16(k1, qf[8 + s], S1, 0, 0, 0); }
            if (jj >= 0) {
                const int dq = wid * 32 + q - 64 * jj - 4 * hh;
                const float NEG = -__builtin_inff();
#pragma unroll
                for (int r = 0; r < 16; ++r) { const int c = (r & 3) + 8 * (r >> 2);
                    if (c > dq) S0[r] = NEG;
                    if (c + 32 > dq) S1[r] = NEG; } }
            float mx = S0[0];
#pragma unroll
            for (int r = 1; r < 16; ++r) mx = fmaxf(mx, S0[r]);
#pragma unroll
            for (int r = 0; r < 16; ++r) mx = fmaxf(mx, S1[r]);
            { auto rr = __builtin_amdgcn_permlane32_swap(__float_as_uint(mx), __float_as_uint(mx), false, false); mx = fmaxf(__uint_as_float(rr[0]), __uint_as_float(rr[1])); }
            float alpha = 1.f;
            if (first || !__all(mx <= THR)) {
                const float mn = fmaxf(m_run, mref + mx), sh = mn - mref;
                alpha = __builtin_amdgcn_exp2f(m_run - mn); m_run = mn;
#pragma unroll
                for (int r = 0; r < 16; ++r) { S0[r] -= sh; S1[r] -= sh; }
#pragma unroll
                for (int d = 0; d < 4; ++d)
#pragma unroll
                    for (int r = 0; r < 16; ++r) O[d][r] *= alpha;
                first = false;
            }
            float sum = 0.f;
#pragma unroll
            for (int r = 0; r < 16; ++r) { S0[r] = __builtin_amdgcn_exp2f(S0[r]); S1[r] = __builtin_amdgcn_exp2f(S1[r]); sum += S0[r] + S1[r]; }
            l_run = l_run * alpha + sum;
            bf16x8 pf[4];
#pragma unroll
            for (int h2 = 0; h2 < 2; ++h2) {
                u32x4 a = {cvt_pk_bf16(S0[8 * h2 + 0], S0[8 * h2 + 1]), cvt_pk_bf16(S0[8 * h2 + 2], S0[8 * h2 + 3]), cvt_pk_bf16(S0[8 * h2 + 4], S0[8 * h2 + 5]), cvt_pk_bf16(S0[8 * h2 + 6], S0[8 * h2 + 7])};
                u32x4 c = {cvt_pk_bf16(S1[8 * h2 + 0], S1[8 * h2 + 1]), cvt_pk_bf16(S1[8 * h2 + 2], S1[8 * h2 + 3]), cvt_pk_bf16(S1[8 * h2 + 4], S1[8 * h2 + 5]), cvt_pk_bf16(S1[8 * h2 + 6], S1[8 * h2 + 7])};
                pf[h2] = *(bf16x8*)&a; pf[2 + h2] = *(bf16x8*)&c; }
#pragma unroll
            for (int d = 0; d < 4; ++d) {
#pragma unroll
                for (int s2 = 0; s2 < 4; ++s2) {
                    const bf16x8 vf = *(const LAS bf16x8*)(bb + 24576 + (d * 32 + q) * 128 + (((2 * s2 + hh) ^ vt_sw) << 4));
                    O[d] = __builtin_amdgcn_mfma_f32_32x32x16_bf16(vf, pf[s2], O[d], 0, 0, 0); } }
        }
    }
    asm volatile("" ::: "memory"); __builtin_amdgcn_s_barrier(); asm volatile("" ::: "memory");
#undef AT_ISSUE
    { auto rr = __builtin_amdgcn_permlane32_swap(__float_as_uint(l_run), __float_as_uint(l_run), false, false); l_run = __uint_as_float(rr[0]) + __uint_as_float(rr[1]); }
    bf16_t* op = (bf16_t*)p.Opart + ((size_t)slot * 256 + wid * 32 + q) * 128 + 4 * hh;
#pragma unroll
    for (int d = 0; d < 4; ++d)
#pragma unroll
        for (int g = 0; g < 4; ++g) { u32x2 v = {cvt_pk_bf16(O[d][4 * g], O[d][4 * g + 1]), cvt_pk_bf16(O[d][4 * g + 2], O[d][4 * g + 3])}; *(u32x2*)(op + d * 32 + g * 8) = v; }
    if (hh == 0) { float* ml = p.MLpart + ((size_t)slot * 256 + wid * 32 + q) * 2; ml[0] = m_run; ml[1] = l_run; }
}
__device__ __forceinline__ void attn_phase(LAS unsigned char* lds, const MlaP& p, int c) {
    const int head = c >> 6, cc = c & 63, pp = cc >> 1, bl = 63 - pp, nl = 4 * (64 - pp);
    if ((cc & 1) == 0) attn_item(lds, p, head, bl, 0, ATT_STEPS, 2 * c);
    else { attn_item(lds, p, head, bl, ATT_STEPS, nl, 2 * c); attn_item(lds, p, head, pp, 0, 4 * (pp + 1), 2 * c + 1); }
}
struct GlaP {
    const bf16_t* Hp; const bf16_t* GVt; const float* wg; const float* bg; const float* ng; const float* wconv;
    bf16_t* QE; float* OI; float* kvT; float* decay; bf16_t* spT; bf16_t* Yab; bf16_t* Ybb; bf16_t* Ycb;
    const float* Opart; const float* MLpart;
};
__device__ __forceinline__ int pos16(int i) { return (i & 48) | ((i & 4) << 1) | ((i & 8) >> 1) | (i & 3); }
__device__ __forceinline__ void gla_g1(LAS unsigned char* lds, const GlaP& p, int c, int G) {
    const int tid = tid_now(), wid = __builtin_amdgcn_readfirstlane(tid >> 6), lane = tid & 63, l31 = lane & 31, hh = lane >> 5;
    LAS float* bsm = (LAS float*)lds; LAS float* gtot = (LAS float*)(lds + 17408); LAS float* blast = (LAS float*)(lds + 19456);
    LAS unsigned char* qeL = lds + 20480; LAS unsigned char* keL = lds + 28672; LAS unsigned char* ktL = lds + 36864;
    const int eb = wid & 3, hb = wid >> 2;
    for (int u = c; u < 1024; u += G) {
        const int n = u >> 2, h = u & 3;
        bf16x8 vf[4];
        { const bf16_t* vp = p.GVt + ((size_t)u * 128 + eb * 32 + l31) * 64 + 8 * hh;
#pragma unroll
          for (int s4 = 0; s4 < 4; ++s4) vf[s4] = *(const bf16x8*)(vp + 16 * s4); }
        { const int d = tid & 63, g = tid >> 6;
          float w[16];
#pragma unroll
          for (int r = 0; r < 16; ++r) w[r] = p.wg[r * 256 + h * 64 + d];
          const float bias = p.bg[h * 64 + d];
          float cs[8]; float run = 0.f;
#pragma unroll
          for (int k = 0; k < 8; ++k) { const int i = 8 * g + k;
              const u32x4 g0 = *(const u32x4*)(p.Hp + (size_t)(64 * n + i) * HW + H_GLR), g1 = *(const u32x4*)(p.Hp + (size_t)(64 * n + i) * HW + H_GLR + 8);
              float la = bias;
#pragma unroll
              for (int r = 0; r < 4; ++r) { la += bflo(g0[r]) * w[2 * r] + bfhi(g0[r]) * w[2 * r + 1]; la += bflo(g1[r]) * w[8 + 2 * r] + bfhi(g1[r]) * w[8 + 2 * r + 1]; }
              const float ls = (fminf(la, 0.f) - log1pf(expf(-fabsf(la)))) * (1.f / 16.f);
              run += ls; cs[k] = run; }
          gtot[g * 64 + d] = run;
          __syncthreads();
          float pre = 0.f, tot = 0.f;
#pragma unroll
          for (int gg = 0; gg < 8; ++gg) { const float v = gtot[gg * 64 + d]; tot += v; if (gg < g) pre += v; }
#pragma unroll
          for (int k = 0; k < 8; ++k) bsm[(8 * g + k) * 68 + d] = pre + cs[k];
          if (g == 0) { blast[d] = tot; p.decay[(size_t)u * 64 + d] = expf(tot); } }
        __syncthreads();
        { const int i = tid >> 3, cc = tid & 7, d0 = 8 * cc; const size_t t = (size_t)64 * n + i;
          const u32x4 qv = *(const u32x4*)(p.Hp + t * HW + H_GQ + h * 64 + d0), kv = *(const u32x4*)(p.Hp + t * HW + H_GK + h * 64 + d0);
          float b[8], bl[8];
          { const f32x4 b0 = *(const LAS f32x4*)(bsm + i * 68 + d0), b1 = *(const LAS f32x4*)(bsm + i * 68 + d0 + 4), l0 = *(const LAS f32x4*)(blast + d0), l1 = *(const LAS f32x4*)(blast + d0 + 4);
#pragma unroll
            for (int j = 0; j < 4; ++j) { b[j] = b0[j]; b[4 + j] = b1[j]; bl[j] = l0[j]; bl[4 + j] = l1[j]; } }
          float qe[8], ke[8], kt[8];
#pragma unroll
          for (int j = 0; j < 8; ++j) { const float qq = (j & 1) ? bfhi(qv[j >> 1]) : bflo(qv[j >> 1]), kk = (j & 1) ? bfhi(kv[j >> 1]) : bflo(kv[j >> 1]);
              qe[j] = qq * 0.125f * expf(b[j]); ke[j] = kk * expf(-b[j]); kt[j] = kk * expf(bl[j] - b[j]); }
          const u32x4 qo = {cvt_pk_bf16(qe[0], qe[1]), cvt_pk_bf16(qe[2], qe[3]), cvt_pk_bf16(qe[4], qe[5]), cvt_pk_bf16(qe[6], qe[7])};
          const u32x4 ko = {cvt_pk_bf16(ke[0], ke[1]), cvt_pk_bf16(ke[2], ke[3]), cvt_pk_bf16(ke[4], ke[5]), cvt_pk_bf16(ke[6], ke[7])};
          const int sw = (i >> 1) & 7;
          *(LAS u32x4*)(qeL + i * 128 + ((cc ^ sw) << 4)) = qo; *(LAS u32x4*)(keL + i * 128 + ((cc ^ sw) << 4)) = ko;
          *(u32x4*)(p.QE + t * 256 + h * 64 + d0) = qo;
          const int pi = pos16(i);
#pragma unroll
          for (int j = 0; j < 8; ++j) { const int d = d0 + j; const unsigned pk = cvt_pk_bf16(kt[j], 0.f);
              *(LAS unsigned short*)(ktL + d * 128 + (((pi >> 3) ^ ((d >> 1) & 7)) << 4) + (pi & 7) * 2) = (unsigned short)pk; } }
        __syncthreads();
        { f32x16 OT, KV;
#pragma unroll
          for (int r = 0; r < 16; ++r) { OT[r] = 0.f; KV[r] = 0.f; }
          const int sw = (l31 >> 1) & 7;
#pragma unroll
          for (int jb = 0; jb < 2; ++jb) {
              if (jb <= hb) {
                  f32x16 Sc;
#pragma unroll
                  for (int r = 0; r < 16; ++r) Sc[r] = 0.f;
#pragma unroll
                  for (int s = 0; s < 4; ++s) {
                      const bf16x8 ka = *(const LAS bf16x8*)(keL + (32 * jb + l31) * 128 + (((2 * s + hh) ^ sw) << 4));
                      const bf16x8 qb = *(const LAS bf16x8*)(qeL + (32 * hb + l31) * 128 + (((2 * s + hh) ^ sw) << 4));
                      Sc = __builtin_amdgcn_mfma_f32_32x32x16_bf16(ka, qb, Sc, 0, 0, 0); }
                  if (jb == hb) {
#pragma unroll
                      for (int r = 0; r < 16; ++r) { const int j = (r & 3) + 8 * (r >> 2) + 4 * hh; if (j > l31) Sc[r] = 0.f; } }
#pragma unroll
                  for (int h2 = 0; h2 < 2; ++h2) {
                      u32x4 a = {cvt_pk_bf16(Sc[8 * h2 + 0], Sc[8 * h2 + 1]), cvt_pk_bf16(Sc[8 * h2 + 2], Sc[8 * h2 + 3]), cvt_pk_bf16(Sc[8 * h2 + 4], Sc[8 * h2 + 5]), cvt_pk_bf16(Sc[8 * h2 + 6], Sc[8 * h2 + 7])};
                      OT = __builtin_amdgcn_mfma_f32_32x32x16_bf16(vf[2 * jb + h2], *(bf16x8*)&a, OT, 0, 0, 0); } } }
#pragma unroll
          for (int s4 = 0; s4 < 4; ++s4) {
              const bf16x8 kb = *(const LAS bf16x8*)(ktL + (32 * hb + l31) * 128 + (((2 * s4 + hh) ^ sw) << 4));
              KV = __builtin_amdgcn_mfma_f32_32x32x16_bf16(vf[s4], kb, KV, 0, 0, 0); }
          float* oi = p.OI + ((size_t)u * 8 + wid) * 1024 + lane;
#pragma unroll
          for (int r = 0; r < 16; ++r) oi[r * 64] = OT[r];
          float* kp = p.kvT + (size_t)u * 8192 + 32 * hb + l31;
#pragma unroll
          for (int r = 0; r < 16; ++r) { const int e = 32 * eb + (r & 3) + 8 * (r >> 2) + 4 * hh; kp[e * 64] = KV[r]; } }
        __syncthreads();
    }
}
__device__ __forceinline__ void gla_g2(LAS unsigned char* lds, const GlaP& p, int c) {
    const int tid = tid_now(), el = tid & 127, seg = tid >> 7;
    const int idx = c * 128 + el, h = idx >> 13, ed = idx & 8191, d = idx & 63;
    LAS float* segS = (LAS float*)lds; LAS float* segD = (LAS float*)(lds + 2048);
    float st = 0.f, dp = 1.f;
    for (int n0 = seg * 64; n0 < seg * 64 + 64; n0 += 16) {
        float kv[16], dc[16];
#pragma unroll
        for (int k = 0; k < 16; ++k) { const size_t u = (size_t)(n0 + k) * 4 + h; kv[k] = p.kvT[u * 8192 + ed]; dc[k] = p.decay[u * 64 + d]; }
#pragma unroll
        for (int k = 0; k < 16; ++k) { st = fmaf(dc[k], st, kv[k]); dp *= dc[k]; }
    }
    __syncthreads();
    segS[seg * 128 + el] = st; segD[seg * 128 + el] = dp;
    __syncthreads();
    st = 0.f;
    for (int s2 = 0; s2 < seg; ++s2) st = fmaf(segD[s2 * 128 + el], st, segS[s2 * 128 + el]);
    for (int n0 = seg * 64; n0 < seg * 64 + 64; n0 += 16) {
        float kv[16], dc[16];
#pragma unroll
        for (int k = 0; k < 16; ++k) { const size_t u = (size_t)(n0 + k) * 4 + h; kv[k] = p.kvT[u * 8192 + ed]; dc[k] = p.decay[u * 64 + d]; }
#pragma unroll
        for (int k = 0; k < 16; ++k) { const size_t u = (size_t)(n0 + k) * 4 + h; p.spT[u * 8192 + ed] = (bf16_t)(cvt_pk_bf16(st, 0.f) & 0xffffu); st = fmaf(dc[k], st, kv[k]); }
    }
    __syncthreads();
}
__device__ __forceinline__ void gla_g3(LAS unsigned char* lds, const GlaP& p, int c, int G) {
    const int tid = tid_now(), wid = __builtin_amdgcn_readfirstlane(tid >> 6), lane = tid & 63, l31 = lane & 31, hh = lane >> 5;
    LAS float* red = (LAS float*)lds;
    const int eb = wid & 3, ib = wid >> 2;
    struct In { f32x16 oi; bf16x8 sp[4], qe[4]; u32x2 rv[4]; };
    auto load = [&](int u, In& x) __attribute__((always_inline)) {
        const int n = u >> 2, h = u & 3; const size_t t = (size_t)64 * n + 32 * ib + l31;
        const float* oi = p.OI + ((size_t)u * 8 + wid) * 1024 + lane;
#pragma unroll
        for (int r = 0; r < 16; ++r) x.oi[r] = oi[r * 64];
        const bf16_t* sp = p.spT + ((size_t)u * 128 + 32 * eb + l31) * 64 + 8 * hh; const bf16_t* qp = p.QE + t * 256 + h * 64 + 8 * hh;
#pragma unroll
        for (int s = 0; s < 4; ++s) { x.sp[s] = *(const bf16x8*)(sp + 16 * s); x.qe[s] = *(const bf16x8*)(qp + 16 * s); }
#pragma unroll
        for (int g = 0; g < 4; ++g) x.rv[g] = *(const u32x2*)(p.Hp + t * HW + H_GR + h * 128 + 32 * eb + 8 * g + 4 * hh);
    };
    In cur, nxt;
    if (c < 1024) load(c, cur);
    for (int u = c; u < 1024; u += G) {
        const int n = u >> 2, h = u & 3;
        const bool hn = u + G < 1024;
        if (hn) load(u + G, nxt);
        f32x16 O = cur.oi;
        const size_t t = (size_t)64 * n + 32 * ib + l31;
#pragma unroll
        for (int s = 0; s < 4; ++s) O = __builtin_amdgcn_mfma_f32_32x32x16_bf16(cur.sp[s], cur.qe[s], O, 0, 0, 0);
        float ss = 0.f;
#pragma unroll
        for (int r = 0; r < 16; ++r) ss += O[r] * O[r];
        { auto rr = __builtin_amdgcn_permlane32_swap(__float_as_uint(ss), __float_as_uint(ss), false, false); ss = __uint_as_float(rr[0]) + __uint_as_float(rr[1]); }
        __syncthreads();
        if (hh == 0) red[eb * 64 + 32 * ib + l31] = ss;
        __syncthreads();
        const int ti = 32 * ib + l31;
        const float tot = (red[ti] + red[64 + ti]) + (red[128 + ti] + red[192 + ti]);
        const float rs = rsqrtf(tot * (1.f / 128.f) + 1e-6f);
#pragma unroll
        for (int g = 0; g < 4; ++g) { const int e0 = 32 * eb + 8 * g + 4 * hh;
            const u32x2 rv = cur.rv[g]; const f32x4 gn = *(const f32x4*)(p.ng + e0);
            float y[4];
#pragma unroll
            for (int j = 0; j < 4; ++j) { const float r_ = (j & 1) ? bfhi(rv[j >> 1]) : bflo(rv[j >> 1]); y[j] = O[4 * g + j] * rs * gn[j] * (r_ / (1.f + __expf(-r_))); }
            u32x2 o = {cvt_pk_bf16(y[0], y[1]), cvt_pk_bf16(y[2], y[3])};
            *(u32x2*)(p.Ybb + t * 512 + h * 128 + e0) = o; }
        if (hn) cur = nxt;
    }
}
__device__ __forceinline__ void conv_phase(const GlaP& p, int gtid, int gthreads) {
    constexpr int NT = T * 64;
    for (int idx0 = gtid; idx0 < NT; idx0 += 2 * gthreads) {
        u32x4 av[2][3], xv[2][3], bv[2]; int tt[2], cc[2];
#pragma unroll
        for (int u = 0; u < 2; ++u) { const int idx = min(idx0 + u * gthreads, NT - 1); const int t = idx >> 6, c0 = (idx & 63) * 8; tt[u] = t; cc[u] = c0;
#pragma unroll
            for (int k = 0; k < 3; ++k) { const int ts = max(t - 2 + k, 0);
                av[u][k] = *(const u32x4*)(p.Hp + (size_t)ts * HW + H_AC + c0); xv[u][k] = *(const u32x4*)(p.Hp + (size_t)ts * HW + H_AX + c0); }
            bv[u] = *(const u32x4*)(p.Hp + (size_t)t * HW + H_AB + c0); }
#pragma unroll
        for (int u = 0; u < 2; ++u) { if (idx0 + u * gthreads < NT) { const int t = tt[u], c0 = cc[u];
            float y[8];
#pragma unroll
            for (int j = 0; j < 8; ++j) y[j] = 0.f;
#pragma unroll
            for (int k = 0; k < 3; ++k) { if (t - 2 + k >= 0) {
                const f32x4 w0 = *(const f32x4*)(p.wconv + k * 512 + c0), w1 = *(const f32x4*)(p.wconv + k * 512 + c0 + 4);
#pragma unroll
                for (int j = 0; j < 4; ++j) { y[2 * j] += (j < 2 ? w0[2 * j] : w1[2 * j - 4]) * (bflo(av[u][k][j]) * bflo(xv[u][k][j])); y[2 * j + 1] += (j < 2 ? w0[2 * j + 1] : w1[2 * j - 3]) * (bfhi(av[u][k][j]) * bfhi(xv[u][k][j])); } } }
            u32x4 o;
#pragma unroll
            for (int j = 0; j < 4; ++j) o[j] = cvt_pk_bf16(bflo(bv[u][j]) * y[2 * j], bfhi(bv[u][j]) * y[2 * j + 1]);
            *(u32x4*)(p.Yab + (size_t)t * 512 + c0) = o; } }
    }
}
__device__ __forceinline__ void attn_combine_bf16(const GlaP& p, int gtid, int gthreads) {
    constexpr int NT = 256 * 256 * 32;
    for (int idx0 = gtid; idx0 < NT; idx0 += 2 * gthreads) {
        float mv[2][2], lv[2][2]; u32x2 ov[2][2]; int nval[2]; size_t orow[2]; int ocol[2];
#pragma unroll
        for (int u = 0; u < 2; ++u) { const int idx = min(idx0 + u * gthreads, NT - 1);
            const int dq = idx & 31, row = (idx >> 5) & 255, g = idx >> 13, head = g >> 6, b = g & 63;
            const int s0 = b >= 32 ? 2 * (head * 64 + 2 * (63 - b)) : 2 * (head * 64 + 2 * b + 1) + 1;
            nval[u] = b >= 32 ? 2 : 1; orow[u] = (size_t)(b * 256 + row) * 512 + head * 128; ocol[u] = dq * 4;
#pragma unroll
            for (int k = 0; k < 2; ++k) { const size_t sl = (size_t)(s0 + (b >= 32 ? 2 * k : 0)) * 256 + row;
                const f32x2 ml = *(const f32x2*)(p.MLpart + sl * 2); mv[u][k] = ml[0]; lv[u][k] = ml[1];
                ov[u][k] = *(const u32x2*)((const bf16_t*)p.Opart + sl * 128 + dq * 4); } }
#pragma unroll
        for (int u = 0; u < 2; ++u) { if (idx0 + u * gthreads < NT) {
            float M = mv[u][0];
#pragma unroll
            for (int k = 1; k < 2; ++k) if (k < nval[u]) M = fmaxf(M, mv[u][k]);
            f32x4 acc = {0.f, 0.f, 0.f, 0.f}; float l = 0.f;
#pragma unroll
            for (int k = 0; k < 2; ++k) { const float w = k < nval[u] ? __builtin_amdgcn_exp2f(mv[u][k] - M) : 0.f;
                l += w * lv[u][k]; const f32x4 o = {bflo(ov[u][k][0]), bfhi(ov[u][k][0]), bflo(ov[u][k][1]), bfhi(ov[u][k][1])}; acc += o * w; }
            const float il = 1.f / l;
            u32x2 o = {cvt_pk_bf16(acc[0] * il, acc[1] * il), cvt_pk_bf16(acc[2] * il, acc[3] * il)};
            *(u32x2*)(p.Ycb + orow[u] + ocol[u]) = o; } }
    }
}
struct P {
    const float *x, *pin; const int* pos;
    const float *ln0_g, *ln0_b, *w_in, *w_conv, *w_gg, *b_gg, *gla_ng, *qn_g, *kvn_g, *w_uq, *w_ukv, *w_br, *w_o, *ln1_g, *ln1_b, *w_grp, *b_grp, *w_exp, *b_exp,
                *w_gate, *w_up, *w_down, *ln2_g, *ln2_b, *w_pg, *b_pg, *w_pu, *ln3_g, *ln3_b;
    float* out;
    float *X, *Z, *cs, *sn, *ssq_q, *ssq_kv, *OI, *kvT, *decay, *MLpart, *ew;
    bf16_t *Db, *Xb, *Hp, *GVt, *Qb, *KnImg, *VtImg, *KrImg, *QE, *spT, *Yab, *Ybb, *Ycb, *Mgb, *Hbuf, *Ys, *Ub, *Pb;
    bf16_t *Wb_in, *Wb_gv, *Wb_uq, *Wb_uk, *Wb_uv, *Wb_br, *Wb_o, *Wb_gu, *Wb_d, *Wb_pg, *Wb_pu;
    int *cnt, *lists; unsigned* bar;
};
__device__ __forceinline__ MegaP mk_mega(const P& p) { MegaP m; m.w_in = p.w_in; m.Wb_in = p.Wb_in; m.Wb_gv = p.Wb_gv; m.Xb = p.Xb; m.Hp = p.Hp; m.GVt = p.GVt; m.ssq_q = p.ssq_q; m.ssq_kv = p.ssq_kv; return m; }
__device__ __forceinline__ MlaP mk_mla(const P& p) { MlaP q; q.w_uq = p.w_uq; q.w_ukv = p.w_ukv; q.qn_g = p.qn_g; q.kvn_g = p.kvn_g; q.Wb_uq = p.Wb_uq; q.Wb_uk = p.Wb_uk; q.Wb_uv = p.Wb_uv; q.Hp = p.Hp;
    q.ssq_q = p.ssq_q; q.ssq_kv = p.ssq_kv; q.cs = p.cs; q.sn = p.sn; q.Qb = p.Qb; q.KnImg = p.KnImg; q.VtImg = p.VtImg; q.KrImg = p.KrImg; q.Opart = p.Z; q.MLpart = p.MLpart; q.Yc = nullptr; return q; }
__device__ __forceinline__ GlaP mk_gla(const P& p, int layer) { GlaP g; g.Hp = p.Hp; g.GVt = p.GVt; g.wg = p.w_gg + layer * 16 * 256; g.bg = p.b_gg + layer * 256; g.ng = p.gla_ng + layer * 128; g.wconv = p.w_conv + layer * 3 * 512;
    g.QE = p.QE; g.OI = p.OI; g.kvT = p.kvT; g.decay = p.decay; g.spT = p.spT; g.Yab = p.Yab; g.Ybb = p.Ybb; g.Ycb = p.Ycb; g.Opart = p.Z; g.MLpart = p.MLpart; return g; }

struct CvJob { const float* W; bf16_t* Bt; const float* rs; int ldw, Ksrc, ldbt, n0, k0, kind, aux; };
struct MapId { __device__ __forceinline__ int operator()(int s) const { return s; } };
__device__ __forceinline__ int cv_map(int kind, int aux, int n) {
    if (kind == 0) return MapInMain{}(n);
    if (kind == 1) return aux + n;
    if (kind == 2) return MapQ{}(n);
    if (kind == 3) return MapKV{aux}(n);
    return n; }
__device__ __forceinline__ int cv_omap(int kind, int aux, int n) { return kind == 4 ? (n >> 7) * 256 + aux * 128 + (n & 127) : n; }
__device__ __forceinline__ bool cv_job(const P& p, int layer, int t, CvJob& j) {
    constexpr int S0 = 384, S1 = S0 + 32, S2 = S1 + 12, S3 = S2 + 8, S4 = S3 + 8, S5 = S4 + 96, S6 = S5 + 64, S7 = S6 + 64, S8 = S7 + 16, S9 = S8 + 1024, S10 = S9 + 1024, S11 = S10 + 1024;
    if (t >= S11) return false;
    j.rs = nullptr; j.aux = 0; j.kind = 5;
    if (t < S0) { j.W = p.w_in + (size_t)layer * D * INW; j.ldw = INW; j.Ksrc = D; j.Bt = p.Wb_in; j.ldbt = D; j.n0 = (t >> 2) * 64; j.k0 = (t & 3) * 256; j.kind = 0; }
    else if (t < S1) { const int u = t - S0; j.W = p.w_in + (size_t)layer * D * INW; j.ldw = INW; j.Ksrc = D; j.Bt = p.Wb_gv; j.ldbt = D; j.n0 = (u >> 2) * 64; j.k0 = (u & 3) * 256; j.kind = 1; j.aux = O_GV; }
    else if (t < S2) { const int u = t - S1; j.W = p.w_uq + (size_t)layer * 256 * 768; j.ldw = 768; j.Ksrc = 256; j.Bt = p.Wb_uq; j.ldbt = 256; j.n0 = u * 64; j.k0 = 0; j.kind = 2; j.rs = p.qn_g + layer * 256; }
    else if (t < S3) { const int u = t - S2; j.W = p.w_ukv + (size_t)layer * 128 * 1024; j.ldw = 1024; j.Ksrc = 128; j.Bt = p.Wb_uk; j.ldbt = 256; j.n0 = u * 64; j.k0 = 0; j.kind = 3; j.aux = 0; j.rs = p.kvn_g + layer * 128; }
    else if (t < S4) { const int u = t - S3; j.W = p.w_ukv + (size_t)layer * 128 * 1024; j.ldw = 1024; j.Ksrc = 128; j.Bt = p.Wb_uv; j.ldbt = 256; j.n0 = u * 64; j.k0 = 0; j.kind = 3; j.aux = 128; j.rs = p.kvn_g + layer * 128; }
    else if (t < S5) { const int u = t - S4, br = u >> 5, v = u & 31; j.W = p.w_br + (size_t)layer * 1536 * D + (size_t)br * 512 * D; j.ldw = D; j.Ksrc = 512; j.Bt = p.Wb_br + (size_t)br * 1024 * 512; j.ldbt = 512; j.n0 = (v >> 1) * 64; j.k0 = (v & 1) * 256; }
    else if (t < S6) { const int u = t - S5; j.W = p.w_o + (size_t)layer * D * D; j.ldw = D; j.Ksrc = D; j.Bt = p.Wb_o; j.ldbt = D; j.n0 = (u >> 2) * 64; j.k0 = (u & 3) * 256; }
    else if (t < S7) { const int u = t - S6; j.W = p.w_pg + (size_t)layer * D * D; j.ldw = D; j.Ksrc = D; j.Bt = p.Wb_pg; j.ldbt = D; j.n0 = (u >> 2) * 64; j.k0 = (u & 3) * 256; }
    else if (t < S8) { const int u = t - S7; j.W = p.w_pu + (size_t)layer * PLE * D; j.ldw = D; j.Ksrc = PLE; j.Bt = p.Wb_pu; j.ldbt = PLE; j.n0 = u * 64; j.k0 = 0; }
    else if (t < S9) { const int u = t - S8, e = u >> 4, v = u & 15; j.W = p.w_gate + ((size_t)layer * NE + e) * D * EH; j.ldw = EH; j.Ksrc = D; j.Bt = p.Wb_gu + (size_t)e * 512 * D; j.ldbt = D; j.n0 = (v >> 2) * 64; j.k0 = (v & 3) * 256; j.kind = 4; j.aux = 0; }
    else if (t < S10) { const int u = t - S9, e = u >> 4, v = u & 15; j.W = p.w_up + ((size_t)layer * NE + e) * D * EH; j.ldw = EH; j.Ksrc = D; j.Bt = p.Wb_gu + (size_t)e * 512 * D; j.ldbt = D; j.n0 = (v >> 2) * 64; j.k0 = (v & 3) * 256; j.kind = 4; j.aux = 1; }
    else { const int u = t - S10, e = u >> 4, v = u & 15; j.W = p.w_down + ((size_t)layer * NE + e) * EH * D; j.ldw = D; j.Ksrc = EH; j.Bt = p.Wb_d + (size_t)e * D * EH; j.ldbt = EH; j.n0 = v * 64; j.k0 = 0; }
    return true; }
__device__ __forceinline__ void cv_load(const CvJob& j, int tid, f32x4 (&v)[8]) {
    const int n4 = tid & 15, kr = tid >> 4; const int col = cv_map(j.kind, j.aux, j.n0 + 4 * n4);
#pragma unroll
    for (int r = 0; r < 8; ++r) { const int k = j.k0 + kr + 32 * r; v[r] = (f32x4){0.f, 0.f, 0.f, 0.f};
        if (col >= 0 && k < j.Ksrc) { v[r] = *(const f32x4*)(j.W + (size_t)k * j.ldw + col); if (j.rs) v[r] = v[r] * j.rs[k]; } }
}
__device__ __forceinline__ void ph_convert(LAS unsigned char* ldsl, const P& p, int layer) {
    LAS float* tile = (LAS float*)ldsl;
    const int tid = tid_now(), c = sgpr_now((int)blockIdx.x), G = gridDim.x;
    CvJob cur, nxt; f32x4 v[8], w[8];
    bool have = cv_job(p, layer, c, cur);
    if (have) cv_load(cur, tid, v);
    for (int t = c; have; t += G) {
        const bool hn = cv_job(p, layer, t + G, nxt);
        if (hn) cv_load(nxt, tid, w);
        __syncthreads();
        { const int n4 = tid & 15, kr = tid >> 4;
#pragma unroll
          for (int r = 0; r < 8; ++r) { LAS float* d = tile + (kr + 32 * r) * 65 + 4 * n4; d[0] = v[r][0]; d[1] = v[r][1]; d[2] = v[r][2]; d[3] = v[r][3]; } }
        __syncthreads();
        { const int kk = (tid & 127) * 2, nn = tid >> 7;
#pragma unroll
          for (int r = 0; r < 16; ++r) { const int n = nn + 4 * r;
              *(unsigned*)(cur.Bt + (size_t)cv_omap(cur.kind, cur.aux, cur.n0 + n) * cur.ldbt + cur.k0 + kk) = cvt_pk_bf16(tile[kk * 65 + n], tile[(kk + 1) * 65 + n]); } }
        have = hn; cur = nxt;
#pragma unroll
        for (int r = 0; r < 8; ++r) v[r] = w[r];
    }
    __syncthreads();
}

__device__ __forceinline__ float wsum(float v, int lane) {
#pragma unroll
    for (int o = 32; o > 0; o >>= 1) v += shx(v, o, lane);
    return v; }
template <int MODE>
__device__ __forceinline__ void ph_rows(const P& p, int layer) {
    const int lane = tid_now() & 63, gw = blockIdx.x * 8 + (tid_now() >> 6), nw = gridDim.x * 8;
    const float* gp = MODE == 0 ? p.ln0_g : MODE == 1 ? p.ln1_g + layer * D : MODE == 2 ? p.ln2_g + layer * D : p.ln3_g + layer * D;
    const float* bp = MODE == 0 ? p.ln0_b : MODE == 1 ? p.ln1_b + layer * D : MODE == 2 ? p.ln2_b + layer * D : p.ln3_b + layer * D;
    f32x4 gg[4], bb[4];
#pragma unroll
    for (int i = 0; i < 4; ++i) { gg[i] = *(const f32x4*)(gp + 256 * i + 4 * lane); bb[i] = *(const f32x4*)(bp + 256 * i + 4 * lane); }
    const float* in = MODE == 0 ? p.x : p.X;
    float* outf = (MODE == 3 && layer == DEPTH - 1) ? p.out : p.X;
    for (int row = gw; row < T; row += nw) {
        f32x4 v[4];
#pragma unroll
        for (int i = 0; i < 4; ++i) v[i] = *(const f32x4*)(in + (size_t)row * D + 256 * i + 4 * lane);
        if constexpr (MODE == 3) {
#pragma unroll
            for (int i = 0; i < 4; ++i) { const u32x2 dd = *(const u32x2*)(p.Db + (size_t)row * D + 256 * i + 4 * lane);
                v[i][0] = DN_ALPHA * v[i][0] + bflo(dd[0]); v[i][1] = DN_ALPHA * v[i][1] + bfhi(dd[0]); v[i][2] = DN_ALPHA * v[i][2] + bflo(dd[1]); v[i][3] = DN_ALPHA * v[i][3] + bfhi(dd[1]); } }
        if constexpr (MODE == 2) { const float w0 = p.ew[2 * row], w1 = p.ew[2 * row + 1];
#pragma unroll
            for (int i = 0; i < 4; ++i) { const u32x2 y0 = *(const u32x2*)(p.Ys + (size_t)(2 * row) * D + 256 * i + 4 * lane), y1 = *(const u32x2*)(p.Ys + (size_t)(2 * row + 1) * D + 256 * i + 4 * lane);
                v[i][0] = DN_ALPHA * v[i][0] + (w0 * bflo(y0[0]) + w1 * bflo(y1[0])); v[i][1] = DN_ALPHA * v[i][1] + (w0 * bfhi(y0[0]) + w1 * bfhi(y1[0]));
                v[i][2] = DN_ALPHA * v[i][2] + (w0 * bflo(y0[1]) + w1 * bflo(y1[1])); v[i][3] = DN_ALPHA * v[i][3] + (w0 * bfhi(y0[1]) + w1 * bfhi(y1[1])); } }
        float s = 0.f;
#pragma unroll
        for (int i = 0; i < 4; ++i) s += (v[i][0] + v[i][1]) + (v[i][2] + v[i][3]);
        const float mu = wsum(s, lane) * (1.f / D);
        float q = 0.f;
#pragma unroll
        for (int i = 0; i < 4; ++i) { v[i] = v[i] - mu; q += (v[i][0] * v[i][0] + v[i][1] * v[i][1]) + (v[i][2] * v[i][2] + v[i][3] * v[i][3]); }
        const float rs = rsqrtf(wsum(q, lane) * (1.f / D) + 1e-5f);
#pragma unroll
        for (int i = 0; i < 4; ++i) { v[i] = v[i] * rs * gg[i] + bb[i];
            *(f32x4*)(outf + (size_t)row * D + 256 * i + 4 * lane) = v[i];
            u32x2 o = {cvt_pk_bf16(v[i][0], v[i][1]), cvt_pk_bf16(v[i][2], v[i][3])};
            *(u32x2*)(p.Xb + (size_t)row * D + 256 * i + 4 * lane) = o; }
        if constexpr (MODE == 1) {
            const float* wg = p.w_grp + (size_t)layer * D * 8; const float* we = p.w_exp + (size_t)layer * D * 64;
            float gl[8];
#pragma unroll
            for (int g = 0; g < 8; ++g) gl[g] = 0.f;
#pragma unroll
            for (int i = 0; i < 4; ++i)
#pragma unroll
                for (int j = 0; j < 4; ++j) { const int k = 256 * i + 4 * lane + j; const f32x4 a = *(const f32x4*)(wg + k * 8), b = *(const f32x4*)(wg + k * 8 + 4); const float xv = v[i][j];
                    gl[0] = fmaf(xv, a[0], gl[0]); gl[1] = fmaf(xv, a[1], gl[1]); gl[2] = fmaf(xv, a[2], gl[2]); gl[3] = fmaf(xv, a[3], gl[3]);
                    gl[4] = fmaf(xv, b[0], gl[4]); gl[5] = fmaf(xv, b[1], gl[5]); gl[6] = fmaf(xv, b[2], gl[6]); gl[7] = fmaf(xv, b[3], gl[7]); }
            float mx = -INFINITY; int gt = 0;
#pragma unroll
            for (int g = 0; g < 8; ++g) { gl[g] = wsum(gl[g], lane) + p.b_grp[layer * 8 + g]; if (gl[g] > mx) { mx = gl[g]; gt = g; } }
            gt = __builtin_amdgcn_readfirstlane(gt);
            float sum = 0.f;
#pragma unroll
            for (int g = 0; g < 8; ++g) sum += expf(gl[g] - mx);
            const float pg = 1.f / sum;
            float el[8];
#pragma unroll
            for (int e = 0; e < 8; ++e) el[e] = 0.f;
#pragma unroll
            for (int i = 0; i < 4; ++i)
#pragma unroll
                for (int j = 0; j < 4; ++j) { const int k = 256 * i + 4 * lane + j; const f32x4 a = *(const f32x4*)(we + k * 64 + gt * 8), b = *(const f32x4*)(we + k * 64 + gt * 8 + 4); const float xv = v[i][j];
                    el[0] = fmaf(xv, a[0], el[0]); el[1] = fmaf(xv, a[1], el[1]); el[2] = fmaf(xv, a[2], el[2]); el[3] = fmaf(xv, a[3], el[3]);
                    el[4] = fmaf(xv, b[0], el[4]); el[5] = fmaf(xv, b[1], el[5]); el[6] = fmaf(xv, b[2], el[6]); el[7] = fmaf(xv, b[3], el[7]); }
            float v1 = -INFINITY, v2 = -INFINITY; int i1 = 0, i2 = 0;
#pragma unroll
            for (int e = 0; e < 8; ++e) { const float vv = wsum(el[e], lane) + p.b_exp[layer * 64 + gt * 8 + e];
                if (vv > v1) { v2 = v1; i2 = i1; v1 = vv; i1 = e; } else if (vv > v2) { v2 = vv; i2 = e; } }
            if (lane == 0) { const float e2 = expf(v2 - v1), w1 = pg / (1.f + e2), w2 = pg * e2 / (1.f + e2);
                const int ea = gt * 8 + i1, eb = gt * 8 + i2; int* cn = p.cnt + layer * 64;
                p.ew[2 * row] = w1; p.ew[2 * row + 1] = w2;
                const int pa = atomicAdd(&cn[ea], 1); p.lists[ea * LCAP + pa] = 2 * row;
                const int pb = atomicAdd(&cn[eb], 1); p.lists[eb * LCAP + pb] = 2 * row + 1; }
        }
    }
}

__device__ __forceinline__ void wsum8(float (&x)[8], int lane) {
    float y[4], z[2], w;
#pragma unroll
    for (int k = 0; k < 4; ++k) { const bool hi = lane & 32; const float snd = hi ? x[k] : x[k + 4], keep = hi ? x[k + 4] : x[k]; y[k] = keep + shx(snd, 32, lane); }
#pragma unroll
    for (int k = 0; k < 2; ++k) { const bool hi = lane & 16; const float snd = hi ? y[k] : y[k + 2], keep = hi ? y[k + 2] : y[k]; z[k] = keep + shx(snd, 16, lane); }
    { const bool hi = lane & 8; const float snd = hi ? z[0] : z[1], keep = hi ? z[1] : z[0]; w = keep + shx(snd, 8, lane); }
    w += shx(w, 4, lane); w += shx(w, 2, lane); w += shx(w, 1, lane);
#pragma unroll
    for (int k = 0; k < 8; ++k) x[k] = __int_as_float(__builtin_amdgcn_readlane(__float_as_int(w), (k >> 2) * 32 + ((k >> 1) & 1) * 16 + (k & 1) * 8));
}
__device__ __forceinline__ void ph_ln1_router(const P& p, int layer) {
    constexpr int RR = 2;
    const int tid = tid_now(), lane0 = tid & 63, gw = sgpr_now((int)blockIdx.x) * 8 + (tid >> 6), nw = gridDim.x * 8;
    const float* gp = p.ln1_g + layer * D; const float* bp = p.ln1_b + layer * D;
    const float* wg = p.w_grp + (size_t)layer * D * 8; const float* we = p.w_exp + (size_t)layer * D * 64;
    for (int row0 = gw * RR; row0 < T; row0 += nw * RR) {
        int lane = lane0; asm volatile("" : "+v"(lane));
        f32x4 v[RR][4];
#pragma unroll
        for (int r = 0; r < RR; ++r)
#pragma unroll
            for (int i = 0; i < 4; ++i) { v[r][i] = *(const f32x4*)(p.X + (size_t)(row0 + r) * D + 256 * i + 4 * lane);
                const u32x2 dd = *(const u32x2*)(p.Db + (size_t)(row0 + r) * D + 256 * i + 4 * lane);
                v[r][i][0] = DN_ALPHA * v[r][i][0] + bflo(dd[0]); v[r][i][1] = DN_ALPHA * v[r][i][1] + bfhi(dd[0]); v[r][i][2] = DN_ALPHA * v[r][i][2] + bflo(dd[1]); v[r][i][3] = DN_ALPHA * v[r][i][3] + bfhi(dd[1]); }
#pragma unroll
        for (int r = 0; r < RR; ++r) {
            float s = 0.f;
#pragma unroll
            for (int i = 0; i < 4; ++i) s += (v[r][i][0] + v[r][i][1]) + (v[r][i][2] + v[r][i][3]);
            const float mu = wsum(s, lane) * (1.f / D);
            float q = 0.f;
#pragma unroll
            for (int i = 0; i < 4; ++i) { v[r][i] = v[r][i] - mu; q += (v[r][i][0] * v[r][i][0] + v[r][i][1] * v[r][i][1]) + (v[r][i][2] * v[r][i][2] + v[r][i][3] * v[r][i][3]); }
            const float rs = rsqrtf(wsum(q, lane) * (1.f / D) + 1e-5f);
#pragma unroll
            for (int i = 0; i < 4; ++i) { const f32x4 gg = *(const f32x4*)(gp + 256 * i + 4 * lane), bb = *(const f32x4*)(bp + 256 * i + 4 * lane);
                v[r][i] = v[r][i] * rs * gg + bb;
                *(f32x4*)(p.X + (size_t)(row0 + r) * D + 256 * i + 4 * lane) = v[r][i];
                u32x2 o = {cvt_pk_bf16(v[r][i][0], v[r][i][1]), cvt_pk_bf16(v[r][i][2], v[r][i][3])};
                *(u32x2*)(p.Xb + (size_t)(row0 + r) * D + 256 * i + 4 * lane) = o; } }
        float gl[RR][8];
#pragma unroll
        for (int r = 0; r < RR; ++r)
#pragma unroll
            for (int g = 0; g < 8; ++g) gl[r][g] = 0.f;
#pragma unroll
        for (int i = 0; i < 4; ++i) { asm volatile("" : "+v"(lane) :: "memory");
#pragma unroll
            for (int j = 0; j < 4; ++j) { const int k = 256 * i + 4 * lane + j; const f32x4 a = *(const f32x4*)(wg + k * 8), b = *(const f32x4*)(wg + k * 8 + 4);
#pragma unroll
                for (int r = 0; r < RR; ++r) { const float xv = v[r][i][j];
                    gl[r][0] = fmaf(xv, a[0], gl[r][0]); gl[r][1] = fmaf(xv, a[1], gl[r][1]); gl[r][2] = fmaf(xv, a[2], gl[r][2]); gl[r][3] = fmaf(xv, a[3], gl[r][3]);
                    gl[r][4] = fmaf(xv, b[0], gl[r][4]); gl[r][5] = fmaf(xv, b[1], gl[r][5]); gl[r][6] = fmaf(xv, b[2], gl[r][6]); gl[r][7] = fmaf(xv, b[3], gl[r][7]); } } }
        int gt[RR]; float pg[RR];
#pragma unroll
        for (int r = 0; r < RR; ++r) { wsum8(gl[r], lane);
            float mx = -INFINITY; int gi = 0;
#pragma unroll
            for (int g = 0; g < 8; ++g) { gl[r][g] += p.b_grp[layer * 8 + g]; if (gl[r][g] > mx) { mx = gl[r][g]; gi = g; } }
            float sum = 0.f;
#pragma unroll
            for (int g = 0; g < 8; ++g) sum += expf(gl[r][g] - mx);
            gt[r] = __builtin_amdgcn_readfirstlane(gi); pg[r] = 1.f / sum; }
        float el[RR][8];
#pragma unroll
        for (int r = 0; r < RR; ++r) {
#pragma unroll
            for (int e = 0; e < 8; ++e) el[r][e] = 0.f;
#pragma unroll
            for (int i = 0; i < 4; ++i) { asm volatile("" : "+v"(lane) :: "memory");
#pragma unroll
                for (int j = 0; j < 4; ++j) { const int k = 256 * i + 4 * lane + j; const f32x4 a = *(const f32x4*)(we + k * 64 + gt[r] * 8), b = *(const f32x4*)(we + k * 64 + gt[r] * 8 + 4); const float xv = v[r][i][j];
                    el[r][0] = fmaf(xv, a[0], el[r][0]); el[r][1] = fmaf(xv, a[1], el[r][1]); el[r][2] = fmaf(xv, a[2], el[r][2]); el[r][3] = fmaf(xv, a[3], el[r][3]);
                    el[r][4] = fmaf(xv, b[0], el[r][4]); el[r][5] = fmaf(xv, b[1], el[r][5]); el[r][6] = fmaf(xv, b[2], el[r][6]); el[r][7] = fmaf(xv, b[3], el[r][7]); } } }
#pragma unroll
        for (int r = 0; r < RR; ++r) { wsum8(el[r], lane);
            float v1 = -INFINITY, v2 = -INFINITY; int i1 = 0, i2 = 0;
#pragma unroll
            for (int e = 0; e < 8; ++e) { const float vv = el[r][e] + p.b_exp[layer * 64 + gt[r] * 8 + e];
                if (vv > v1) { v2 = v1; i2 = i1; v1 = vv; i1 = e; } else if (vv > v2) { v2 = vv; i2 = e; } }
            if (lane == 0) { const int row = row0 + r; const float e2 = expf(v2 - v1), w1 = pg[r] / (1.f + e2), w2 = pg[r] * e2 / (1.f + e2);
                const int ea = gt[r] * 8 + i1, eb = gt[r] * 8 + i2; int* cn = p.cnt + layer * 64;
                p.ew[2 * row] = w1; p.ew[2 * row + 1] = w2;
                const int pa = atomicAdd(&cn[ea], 1); p.lists[ea * LCAP + pa] = 2 * row;
                const int pb = atomicAdd(&cn[eb], 1); p.lists[eb * LCAP + pb] = 2 * row + 1; } }
    }
}
__device__ __forceinline__ void ph_prologue(const P& p) {
    const int gtid = blockIdx.x * NTHR + tid_now(), gth = gridDim.x * NTHR;
    for (int idx = gtid; idx < T * 32; idx += gth) { const int t = idx >> 5, i = idx & 31;
        const float inv = (float)(1.0 / pow(10000.0, (double)(2 * i) / 64.0)); const float ang = (float)p.pos[t] * inv;
        p.cs[idx] = (float)cos((double)ang); p.sn[idx] = (float)sin((double)ang); }
    for (size_t i = gtid; i < (size_t)DEPTH * T * PLE / 4; i += gth) { const f32x4 v = ((const f32x4*)p.pin)[i]; u32x2 o = {cvt_pk_bf16(v[0], v[1]), cvt_pk_bf16(v[2], v[3])}; ((u32x2*)p.Pb)[i] = o; }
    ph_rows<0>(p, 0);
}

struct SchedBr { __device__ __forceinline__ bool carry(const ge::Unit& u) const { return u.g < 2; }
    const char* Ya; const char* Yb; const char* Yc; const char* W; int c, G;
    __device__ __forceinline__ bool next(int i, ge::Unit& u) const { const int tile = (i / 3) * G + c; if (tile >= 256) return false; u.g = i % 3; ge::tile_order(tile, 64, 4, u.pm, u.pn); return true; }
    __device__ __forceinline__ const char* aptr(const ge::Unit& u) const { return (u.g == 0 ? Ya : u.g == 1 ? Yb : Yc) + (size_t)u.pm * 256 * 512 * 2; }
    __device__ __forceinline__ const char* bptr(const ge::Unit& u) const { return W + ((size_t)u.g * 1024 + u.pn * 256) * 512 * 2; } };
struct EpiBr { const bf16_t* Hp; bf16_t* Mgb;
    __device__ __forceinline__ void operator()(ge::Acc& acc, const ge::Unit& u, int wr, int wc, int fr, int fq) const {
        const int row0 = u.pm * 256 + wr * 64 + fr, col0 = u.pn * 256 + wc * 32 + 8 * fq;
#pragma unroll
        for (int ai = 0; ai < 2; ++ai)
#pragma unroll
            for (int m = 0; m < 4; ++m) { asm volatile("" ::: "memory"); const int row = row0 + ai * 128 + m * 16;
#pragma unroll
                for (int bj = 0; bj < 2; ++bj) { const int col = col0 + bj * 128;
                    const u32x4 gt = *(const u32x4*)(Hp + (size_t)row * HW + H_GTA + u.g * 1024 + col);
                    f32x4 s0 = {bflo(gt[0]), bfhi(gt[0]), bflo(gt[1]), bfhi(gt[1])}, s1 = {bflo(gt[2]), bfhi(gt[2]), bflo(gt[3]), bfhi(gt[3])};
                    if (u.g < 2) { const u32x4 gn = *(const u32x4*)(Hp + (size_t)row * HW + H_GTA + (u.g + 1) * 1024 + col);
                        f32x4 d0 = {bflo(gn[0]), bfhi(gn[0]), bflo(gn[1]), bfhi(gn[1])}, d1 = {bflo(gn[2]), bfhi(gn[2]), bflo(gn[3]), bfhi(gn[3])};
#pragma unroll
                        for (int j = 0; j < 4; ++j) { s0[j] = s0[j] / d0[j]; s1[j] = s1[j] / d1[j]; } }
                    acc[ai][bj][m][0] = acc[ai][bj][m][0] * s0; acc[ai][bj][m][1] = acc[ai][bj][m][1] * s1;
                    if (u.g == 2) { const f32x4 v0 = acc[ai][bj][m][0], v1 = acc[ai][bj][m][1];
                        u32x4 o = {cvt_pk_bf16(v0[0], v0[1]), cvt_pk_bf16(v0[2], v0[3]), cvt_pk_bf16(v1[0], v1[1]), cvt_pk_bf16(v1[2], v1[3])}; *(u32x4*)(Mgb + (size_t)row * D + col) = o; } } }
    } };
struct SchedT4 : ge::NoCarry { const char* A; const char* B; int lda2, ldb2, c, G;
    __device__ __forceinline__ bool next(int i, ge::Unit& u) const { const int L = i * G + c; if (L >= 256) return false; u.g = 0; ge::tile_order(L, 64, 4, u.pm, u.pn); return true; }
    __device__ __forceinline__ const char* aptr(const ge::Unit& u) const { return A + (size_t)u.pm * lda2; }
    __device__ __forceinline__ const char* bptr(const ge::Unit& u) const { return B + (size_t)u.pn * ldb2; } };
struct EpiRes { bf16_t* Db;
    __device__ __forceinline__ void operator()(ge::Acc& acc, const ge::Unit& u, int wr, int wc, int fr, int fq) const {
        const int row0 = u.pm * 256 + wr * 64 + fr, col0 = u.pn * 256 + wc * 32 + 8 * fq;
#pragma unroll
        for (int ai = 0; ai < 2; ++ai)
#pragma unroll
            for (int m = 0; m < 4; ++m) { const size_t o = (size_t)(row0 + ai * 128 + m * 16) * D + col0;
#pragma unroll
                for (int bj = 0; bj < 2; ++bj) { const f32x4 v0 = acc[ai][bj][m][0], v1 = acc[ai][bj][m][1];
                    u32x4 w = {cvt_pk_bf16(v0[0], v0[1]), cvt_pk_bf16(v0[2], v0[3]), cvt_pk_bf16(v1[0], v1[1]), cvt_pk_bf16(v1[2], v1[3])}; *(u32x4*)(Db + o + bj * 128) = w; } }
    } };
struct EpiU { bf16_t* Ub;
    __device__ __forceinline__ void operator()(ge::Acc& acc, const ge::Unit& u, int wr, int wc, int fr, int fq) const {
        const int row0 = u.pm * 256 + wr * 64 + fr, col0 = u.pn * 256 + wc * 32 + 8 * fq;
#pragma unroll
        for (int ai = 0; ai < 2; ++ai)
#pragma unroll
            for (int m = 0; m < 4; ++m) { const size_t o = (size_t)(row0 + ai * 128 + m * 16) * D + col0;
#pragma unroll
                for (int bj = 0; bj < 2; ++bj) { const f32x4 v0 = acc[ai][bj][m][0], v1 = acc[ai][bj][m][1];
                    u32x4 w = {cvt_pk_bf16(v0[0], v0[1]), cvt_pk_bf16(v0[2], v0[3]), cvt_pk_bf16(v1[0], v1[1]), cvt_pk_bf16(v1[2], v1[3])}; *(u32x4*)(Ub + o + bj * 128) = w; } }
    } };
struct EpiPle { bf16_t* Db; const bf16_t* Ub; const float* bias;
    __device__ __forceinline__ void operator()(ge::Acc& acc, const ge::Unit& u, int wr, int wc, int fr, int fq) const {
        const int row0 = u.pm * 256 + wr * 64 + fr, col0 = u.pn * 256 + wc * 32 + 8 * fq;
        f32x4 bv[2][2];
#pragma unroll
        for (int bj = 0; bj < 2; ++bj) { bv[bj][0] = *(const f32x4*)(bias + col0 + bj * 128); bv[bj][1] = *(const f32x4*)(bias + col0 + bj * 128 + 4); }
#pragma unroll
        for (int ai = 0; ai < 2; ++ai)
#pragma unroll
            for (int m = 0; m < 4; ++m) { asm volatile("" ::: "memory"); const size_t o = (size_t)(row0 + ai * 128 + m * 16) * D + col0;
#pragma unroll
                for (int bj = 0; bj < 2; ++bj) { const u32x4 uu = *(const u32x4*)(Ub + o + bj * 128);
                    f32x4 g0 = acc[ai][bj][m][0] + bv[bj][0], g1 = acc[ai][bj][m][1] + bv[bj][1];
#pragma unroll
                    for (int j = 0; j < 4; ++j) { g0[j] = 1.f / (1.f + __expf(-g0[j])); g1[j] = 1.f / (1.f + __expf(-g1[j])); }
                    const f32x4 u0 = {bflo(uu[0]), bfhi(uu[0]), bflo(uu[1]), bfhi(uu[1])}, u1 = {bflo(uu[2]), bfhi(uu[2]), bflo(uu[3]), bfhi(uu[3])};
                    g0 = g0 * u0; g1 = g1 * u1;
                    u32x4 w = {cvt_pk_bf16(g0[0], g0[1]), cvt_pk_bf16(g0[2], g0[3]), cvt_pk_bf16(g1[0], g1[1]), cvt_pk_bf16(g1[2], g1[3])}; *(u32x4*)(Db + o + bj * 128) = w; } }
    } };

__device__ __forceinline__ void moe_table(LAS unsigned char* lds, const int* cnt) {
    LAS int* te = (LAS int*)(lds + 131072); LAS int* tr = te + 256; LAS int* cl = tr + 256; LAS int* nt = cl + 64;
    __syncthreads();
    if (tid_now() < 64) cl[tid_now()] = cnt[tid_now()];
    __syncthreads();
    if (tid_now() == 0) { int n = 0; for (int e = 0; e < NE; ++e) for (int r = 0; r < cl[e]; r += 256) { te[n] = e; tr[n] = r; ++n; } nt[0] = n; }
    __syncthreads();
}
struct SchedM1 : ge::NoCarry { const char* Xb; const char* W; const int* lists; LAS int* te; int c, G;
    __device__ __forceinline__ bool next(int i, ge::Unit& u) const { const int L = i * G + c; if (L >= 2 * te[576]) return false; u.pm = L >> 1; u.pn = L & 1; u.g = te[u.pm]; return true; }
    __device__ __forceinline__ int arow(const ge::Unit& u, int r) const { const int n = te[512 + u.g], idx = min(te[256 + u.pm] + r, n - 1); return lists[u.g * LCAP + idx] >> 1; }
    __device__ __forceinline__ const char* aptr(const ge::Unit&) const { return Xb; }
    __device__ __forceinline__ const char* bptr(const ge::Unit& u) const { return W + ((size_t)u.g * 512 + u.pn * 256) * D * 2; } };
struct EpiM1 { bf16_t* Hbuf;
    __device__ __forceinline__ void operator()(ge::Acc& acc, const ge::Unit& u, int wr, int wc, int fr, int fq) const {
#pragma unroll
        for (int ai = 0; ai < 2; ++ai)
#pragma unroll
            for (int m = 0; m < 4; ++m) { const int row = ai * 128 + wr * 64 + m * 16 + fr;
                float h[8];
#pragma unroll
                for (int n = 0; n < 2; ++n)
#pragma unroll
                    for (int j = 0; j < 4; ++j) { const float g = acc[ai][0][m][n][j], uu = acc[ai][1][m][n][j]; h[4 * n + j] = g / (1.f + __expf(-g)) * uu; }
                u32x4 o = {cvt_pk_bf16(h[0], h[1]), cvt_pk_bf16(h[2], h[3]), cvt_pk_bf16(h[4], h[5]), cvt_pk_bf16(h[6], h[7])};
                *(u32x4*)(Hbuf + ((size_t)u.pm * 256 + row) * EH + u.pn * 128 + wc * 32 + 8 * fq) = o; }
    } };
struct SchedM2 : ge::NoCarry { const char* Hb; const char* W; LAS int* te; int c, G;
    __device__ __forceinline__ bool next(int i, ge::Unit& u) const { const int L = i * G + c; if (L >= 4 * te[576]) return false; u.pm = L >> 2; u.pn = L & 3; u.g = te[u.pm]; return true; }
    __device__ __forceinline__ const char* aptr(const ge::Unit& u) const { return Hb + (size_t)u.pm * 256 * EH * 2; }
    __device__ __forceinline__ const char* bptr(const ge::Unit& u) const { return W + ((size_t)u.g * D + u.pn * 256) * EH * 2; } };
struct EpiM2 { bf16_t* Ys; const int* lists; LAS int* te;
    __device__ __forceinline__ void operator()(ge::Acc& acc, const ge::Unit& u, int wr, int wc, int fr, int fq) const {
        const int r0 = te[256 + u.pm], n = te[512 + u.g];
#pragma unroll
        for (int ai = 0; ai < 2; ++ai)
#pragma unroll
            for (int m = 0; m < 4; ++m) { const int row = r0 + ai * 128 + wr * 64 + m * 16 + fr;
                if (row < n) { const int a = lists[u.g * LCAP + row];
#pragma unroll
                    for (int bj = 0; bj < 2; ++bj) { const f32x4 v0 = acc[ai][bj][m][0], v1 = acc[ai][bj][m][1];
                        u32x4 o = {cvt_pk_bf16(v0[0], v0[1]), cvt_pk_bf16(v0[2], v0[3]), cvt_pk_bf16(v1[0], v1[1]), cvt_pk_bf16(v1[2], v1[3])};
                        *(u32x4*)(Ys + (size_t)a * D + u.pn * 256 + bj * 128 + wc * 32 + 8 * fq) = o; } } }
    } };

#define XB_TMO      128
#define XB_XCNT(j)  (256  + 64 * (j))
#define XB_XSUB(j)  (1280 + 64 * (j))
#define XB_XGEN(j)  (2304 + 64 * (j))
#define XB_TOP      3328
#define XB_TOPGEN   3392
#define XCD_BAR_WORDS 3456
#define XB_SPIN_CAP (1u << 18)

__device__ __forceinline__ unsigned xb_ld(unsigned* p)              { return __hip_atomic_load(p, __ATOMIC_RELAXED, __HIP_MEMORY_SCOPE_AGENT); }
__device__ __forceinline__ unsigned xb_add(unsigned* p, unsigned v) { return __hip_atomic_fetch_add(p, v, __ATOMIC_RELAXED, __HIP_MEMORY_SCOPE_AGENT); }
__device__ __forceinline__ unsigned xb_xcc_id() { return (unsigned)__builtin_amdgcn_s_getreg((3 << 11) | 20) & 0xFu; }
#define XB_SPIN(cond, bar) do { unsigned _sp = 0; while (cond) { __builtin_amdgcn_s_sleep(1); \
    if ((++_sp & 255u) == 0u) { if (xb_ld(&(bar)[XB_TMO])) break; if (_sp > XB_SPIN_CAP) { atomicAdd(&(bar)[XB_TMO], 1u); break; } } } } while (0)

struct XcdBarrier {
    unsigned* bar; unsigned x;
    volatile LAS unsigned* st;
};

__device__ __forceinline__ XcdBarrier xcd_barrier_post(unsigned* bar, volatile LAS unsigned* st) {
    XcdBarrier b; b.bar = bar; b.x = xb_xcc_id(); b.st = st;
    if (threadIdx.x == 0) (void)xb_add(&bar[XB_XCNT(b.x)], 1u);
    return b;
}
__device__ __forceinline__ void xcd_barrier_complete(unsigned* bar, unsigned x, unsigned& nloc, unsigned& nx) {
    const unsigned G = gridDim.x * gridDim.y * gridDim.z;
    unsigned sum, cnt, mine, sp = 0u;
    for (;;) {
        sum = 0u; cnt = 0u; mine = 0u;
#pragma unroll
        for (unsigned j = 0; j < 16; ++j) { const unsigned c = xb_ld(&bar[XB_XCNT(j)]); sum += c; cnt += (c > 0u) ? 1u : 0u; mine = (j == x) ? c : mine; }
        if (sum == G) break;
        __builtin_amdgcn_s_sleep(1);
        if ((++sp & 255u) == 0u) { if (xb_ld(&bar[XB_TMO])) break; if (sp > XB_SPIN_CAP) { atomicAdd(&bar[XB_TMO], 1u); break; } }
    }
    nloc = mine > 0u ? mine : 1u; nx = cnt > 0u ? cnt : 1u;
}

__device__ __forceinline__ void xcd_barrier(const XcdBarrier& b) {
    asm volatile("s_waitcnt vmcnt(0)" ::: "memory");
    __syncthreads();
    if (threadIdx.x == 0) {
        unsigned* bar = b.bar;
        __builtin_amdgcn_s_waitcnt(0);
        unsigned nloc = b.st[0], nx = b.st[1];
        if (nloc == 0u) { xcd_barrier_complete(bar, b.x, nloc, nx); b.st[0] = nloc; b.st[1] = nx; }
        const unsigned old = xb_add(&bar[XB_XSUB(b.x)], 1u);
        const unsigned gen = old / nloc;
        if (old + 1u == (gen + 1u) * nloc) {
            __builtin_amdgcn_fence(__ATOMIC_RELEASE, "agent");
            asm volatile("s_waitcnt vmcnt(0)" ::: "memory");
            const unsigned og = xb_add(&bar[XB_TOP], 1u);
            const unsigned tg = og / nx;
            if (og + 1u == (tg + 1u) * nx) xb_add(&bar[XB_TOPGEN], 1u);
            else XB_SPIN(xb_ld(&bar[XB_TOPGEN]) == tg, bar);
            __builtin_amdgcn_fence(__ATOMIC_ACQUIRE, "agent");
            xb_add(&bar[XB_XGEN(b.x)], 1u);
            asm volatile("s_waitcnt vmcnt(0)" ::: "memory");
        } else {
            XB_SPIN(xb_ld(&bar[XB_XGEN(b.x)]) == gen, bar);
            __builtin_amdgcn_fence(__ATOMIC_ACQUIRE, "agent");
            asm volatile("s_waitcnt vmcnt(0)" ::: "memory");
        }
    }
    __syncthreads();
}

enum { PH_PRO = 0, PH_CONV, PH_IN, PH_PREP_Q, PH_PREP_K, PH_PREP_V, PH_PREP_G, PH_ATT, PH_FIN, PH_BR, PH_WO, PH_LN1, PH_M1, PH_M2, PH_LN2, PH_PLE, PH_LN3 };
template <int PH> __global__ __launch_bounds__(NTHR, 2) void k_ph(P p, int layer) {
    extern __shared__ __attribute__((aligned(16))) unsigned char smem[];
    LAS unsigned char* lds = (LAS unsigned char*)smem;
    tid_setup();
    const int c = blockIdx.x, G = gridDim.x;
    if constexpr (PH == PH_PRO) ph_prologue(p);
    if constexpr (PH == PH_CONV) ph_convert(lds, p, layer);
    if constexpr (PH == PH_IN) { const MegaP m = mk_mega(p); SchedIn S{{}, (const char*)m.Xb, (const char*)m.Wb_in, (const char*)m.Wb_gv, c, G, 0}; EpiIn<2> E{m.Hp, m.GVt, m.ssq_q, m.ssq_kv}; ge::gemm_stream<EpiIn<2>, SchedIn, false>(lds, D, D, D, S, E); }
    if constexpr (PH == PH_PREP_Q) { const MlaP q = mk_mla(p); SchedMla<0> S{{}, (const char*)(q.Hp + H_CQ), (const char*)q.Wb_uq, c, G}; EpiMla<0> E{q}; ge::gemm_stream<EpiMla<0>, SchedMla<0>, false>(lds, 256, HW, 256, S, E); }
    if constexpr (PH == PH_PREP_K) { const MlaP q = mk_mla(p); SchedMla<1> S{{}, (const char*)(q.Hp + H_CKV), (const char*)q.Wb_uk, (c + 64) % G, G}; EpiMla<1> E{q}; ge::gemm_stream<EpiMla<1>, SchedMla<1>, false>(lds, 256, HW, 256, S, E); }
    if constexpr (PH == PH_PREP_V) { const MlaP q = mk_mla(p); SchedMla<2> S{{}, (const char*)q.Wb_uv, (const char*)(q.Hp + H_CKV), (c + 192) % G, G}; EpiMla<2> E{q}; ge::gemm_stream<EpiMla<2>, SchedMla<2>, false>(lds, 256, 256, HW, S, E); }
    if constexpr (PH == PH_PREP_G) { { const MegaP m = mk_mega(p); SchedIn S{{}, (const char*)m.Xb, (const char*)m.Wb_in, (const char*)m.Wb_gv, (c + 128) % G, G, 1}; EpiIn<0> E{m.Hp, m.GVt, m.ssq_q, m.ssq_kv}; ge::gemm_stream<EpiIn<0>, SchedIn, false>(lds, D, D, D, S, E); } const MlaP q = mk_mla(p); kr_phase(q, c * NTHR + tid_now(), G * NTHR); const GlaP g = mk_gla(p, layer); gla_g1(lds, g, c, G); }
    if constexpr (PH == PH_ATT) { const GlaP g = mk_gla(p, layer); gla_g2(lds, g, c); const MlaP q = mk_mla(p); attn_phase(lds, q, c); }
    if constexpr (PH == PH_FIN) { const GlaP g = mk_gla(p, layer); gla_g3(lds, g, c, G); conv_phase(g, c * NTHR + tid_now(), G * NTHR); attn_combine_bf16(g, c * NTHR + tid_now(), G * NTHR); }
    if constexpr (PH == PH_BR) { SchedBr S{(const char*)p.Yab, (const char*)p.Ybb, (const char*)p.Ycb, (const char*)p.Wb_br, c, G}; EpiBr E{p.Hp, p.Mgb}; ge::gemm_stream<EpiBr, SchedBr, false>(lds, 512, 512, 512, S, E); }
    if constexpr (PH == PH_WO) { SchedT4 S{{}, (const char*)p.Mgb, (const char*)p.Wb_o, 256 * D * 2, 256 * D * 2, c, G}; EpiRes E{p.Db}; ge::gemm_stream<EpiRes, SchedT4, false>(lds, D, D, D, S, E); }
    if constexpr (PH == PH_LN1) ph_ln1_router(p, layer);
    if constexpr (PH == PH_M1) { moe_table(lds, p.cnt + layer * 64); LAS int* te = (LAS int*)(lds + 131072);
        SchedM1 S{{}, (const char*)p.Xb, (const char*)p.Wb_gu, p.lists, te, c, G}; EpiM1 E{p.Hbuf}; ge::gemm_stream<EpiM1, SchedM1, true>(lds, D, D, D, S, E); }
    if constexpr (PH == PH_M2) { moe_table(lds, p.cnt + layer * 64); LAS int* te = (LAS int*)(lds + 131072);
        SchedM2 S{{}, (const char*)p.Hbuf, (const char*)p.Wb_d, te, c, G}; EpiM2 E{p.Ys, p.lists, te}; ge::gemm_stream<EpiM2, SchedM2, false>(lds, EH, EH, EH, S, E); }
    if constexpr (PH == PH_LN2) ph_rows<2>(p, layer);
    if constexpr (PH == PH_PLE) {
        { SchedT4 S{{}, (const char*)(p.Pb + (size_t)layer * T * PLE), (const char*)p.Wb_pu, 256 * PLE * 2, 256 * PLE * 2, c, G}; EpiU E{p.Ub}; ge::gemm_stream<EpiU, SchedT4, false>(lds, PLE, PLE, PLE, S, E); }
        { SchedT4 S{{}, (const char*)p.Xb, (const char*)p.Wb_pg, 256 * D * 2, 256 * D * 2, c, G}; EpiPle E{p.Db, p.Ub, p.b_pg + layer * D}; ge::gemm_stream<EpiPle, SchedT4, false>(lds, D, D, D, S, E); } }
    if constexpr (PH == PH_LN3) ph_rows<3>(p, layer);
}


typedef const P __attribute__((address_space(4))) CP;
__device__ __forceinline__ P load_params() { CP* q = (CP*)__builtin_amdgcn_kernarg_segment_ptr(); asm volatile("" : "+s"(q)); return *(const P*)q; }
#define GRID_BAR() do { XcdBarrier b_; b_.bar = load_params().bar; b_.x = xb_xcc_id(); b_.st = xbw; xcd_barrier(b_); } while (0)
__global__ __launch_bounds__(NTHR, 2) void k_mega(P p_arg) {
    extern __shared__ __attribute__((aligned(16))) unsigned char smem[];
    LAS unsigned char* lds = (LAS unsigned char*)smem;
    const int G = NBLK;
#define c sgpr_now((int)blockIdx.x)
    volatile LAS unsigned* xbw = (volatile LAS unsigned*)(lds + XBW_OFF);
    tid_setup();
    if (tid_now() < 4) xbw[tid_now()] = 0u;
    __syncthreads();
    (void)xcd_barrier_post(p_arg.bar, xbw);
    { const P p = load_params(); ph_prologue(p); }
    { const P p = load_params(); ph_convert(lds, p, 0); }
    GRID_BAR();
    for (int layer = 0; layer < DEPTH; ++layer) {
        { const P p = load_params(); const MegaP m = mk_mega(p); SchedIn S{{}, (const char*)m.Xb, (const char*)m.Wb_in, (const char*)m.Wb_gv, c, G, 0}; EpiIn<2> E{m.Hp, m.GVt, m.ssq_q, m.ssq_kv}; ge::gemm_stream<EpiIn<2>, SchedIn, false>(lds, D, D, D, S, E); }
        GRID_BAR();
        { const P p = load_params(); const MlaP q = mk_mla(p);
          { SchedMla<0> S{{}, (const char*)(q.Hp + H_CQ), (const char*)q.Wb_uq, (c >= 128 ? c - 128 : -1), 128}; EpiMla<0> E{q}; ge::gemm_stream<EpiMla<0>, SchedMla<0>, false>(lds, 256, HW, 256, S, E); }
          { SchedMla<1> S{{}, (const char*)(q.Hp + H_CKV), (const char*)q.Wb_uk, (c >= 128 ? c - 128 : -1), 128}; EpiMla<1> E{q}; ge::gemm_stream<EpiMla<1>, SchedMla<1>, false>(lds, 256, HW, 256, S, E); }
          { SchedMla<2> S{{}, (const char*)q.Wb_uv, (const char*)(q.Hp + H_CKV), (c >= 128 ? c - 128 : -1), 128}; EpiMla<2> E{q}; ge::gemm_stream<EpiMla<2>, SchedMla<2>, false>(lds, 256, 256, HW, S, E); }
          { const MegaP m = mk_mega(p); SchedIn S{{}, (const char*)m.Xb, (const char*)m.Wb_in, (const char*)m.Wb_gv, c, G, 1}; EpiIn<0> E{m.Hp, m.GVt, m.ssq_q, m.ssq_kv}; ge::gemm_stream<EpiIn<0>, SchedIn, false>(lds, D, D, D, S, E); }
          kr_phase(q, c * NTHR + tid_now(), G * NTHR);
          const GlaP g = mk_gla(p, layer); gla_g1(lds, g, c, G); }
        GRID_BAR();
        { const P p = load_params(); const GlaP g = mk_gla(p, layer); gla_g2(lds, g, c); const MlaP q = mk_mla(p); attn_phase(lds, q, c); }
        GRID_BAR();
        { const P p = load_params(); const GlaP g = mk_gla(p, layer); gla_g3(lds, g, c, G); conv_phase(g, c * NTHR + tid_now(), G * NTHR); attn_combine_bf16(g, c * NTHR + tid_now(), G * NTHR); }
        GRID_BAR();
        { const P p = load_params(); SchedBr S{(const char*)p.Yab, (const char*)p.Ybb, (const char*)p.Ycb, (const char*)p.Wb_br, c, G}; EpiBr E{p.Hp, p.Mgb}; ge::gemm_stream<EpiBr, SchedBr, false>(lds, 512, 512, 512, S, E); }
        GRID_BAR();
        { const P p = load_params(); SchedT4 S{{}, (const char*)p.Mgb, (const char*)p.Wb_o, 256 * D * 2, 256 * D * 2, c, G}; EpiRes E{p.Db}; ge::gemm_stream<EpiRes, SchedT4, false>(lds, D, D, D, S, E); }
        GRID_BAR();
        { const P p = load_params(); ph_ln1_router(p, layer); }
        GRID_BAR();
        { const P p = load_params(); moe_table(lds, p.cnt + layer * 64); LAS int* te = (LAS int*)(lds + 131072);
          SchedM1 S{{}, (const char*)p.Xb, (const char*)p.Wb_gu, p.lists, te, c, G}; EpiM1 E{p.Hbuf}; ge::gemm_stream<EpiM1, SchedM1, true>(lds, D, D, D, S, E);
          const int extra = max(0, 2 * te[576] - NBLK), cu = c - extra;
          SchedT4 SU{{}, (const char*)(p.Pb + (size_t)layer * T * PLE), (const char*)p.Wb_pu, 256 * PLE * 2, 256 * PLE * 2, cu >= 0 ? cu : 256, NBLK - extra}; EpiU EU{p.Ub};
          ge::gemm_stream<EpiU, SchedT4, false>(lds, PLE, PLE, PLE, SU, EU); }
        GRID_BAR();
        { const P p = load_params(); LAS int* te = (LAS int*)(lds + 131072);
          SchedM2 S{{}, (const char*)p.Hbuf, (const char*)p.Wb_d, te, c, G}; EpiM2 E{p.Ys, p.lists, te}; ge::gemm_stream<EpiM2, SchedM2, false>(lds, EH, EH, EH, S, E); }
        GRID_BAR();
        { const P p = load_params(); ph_rows<2>(p, layer); }
        GRID_BAR();
        { const P p = load_params(); SchedT4 S{{}, (const char*)p.Xb, (const char*)p.Wb_pg, 256 * D * 2, 256 * D * 2, c, G}; EpiPle E{p.Db, p.Ub, p.b_pg + layer * D}; ge::gemm_stream<EpiPle, SchedT4, false>(lds, D, D, D, S, E); }
        GRID_BAR();
        { const P p = load_params(); ph_rows<3>(p, layer); }
        if (layer + 1 < DEPTH) { { const P p = load_params(); ph_convert(lds, p, layer + 1); } GRID_BAR(); }
    }
#undef c
}

template <int PH> static void launch_ph(const P& p, int layer, hipStream_t st) {
    static bool set = false;
    if (!set) { (void)hipFuncSetAttribute((const void*)k_ph<PH>, hipFuncAttributeMaxDynamicSharedMemorySize, LDS_BYTES); set = true; }
    hipLaunchKernelGGL((k_ph<PH>), dim3(NBLK), dim3(NTHR), LDS_BYTES, st, p, layer);
}
extern "C" void kernel_launch(void* const* d_in, const int* in_sizes, int n_in, void* d_out, int out_size, void* d_ws, size_t ws_size, hipStream_t st) {
    (void)in_sizes; (void)n_in; (void)out_size;
    P p{};
    p.x = (const float*)d_in[0]; p.pin = (const float*)d_in[1]; p.pos = (const int*)d_in[2]; p.ln0_g = (const float*)d_in[3]; p.ln0_b = (const float*)d_in[4];
    p.w_in = (const float*)d_in[5]; p.w_conv = (const float*)d_in[6]; p.w_gg = (const float*)d_in[7]; p.b_gg = (const float*)d_in[8]; p.gla_ng = (const float*)d_in[9];
    p.qn_g = (const float*)d_in[10]; p.kvn_g = (const float*)d_in[11]; p.w_uq = (const float*)d_in[12]; p.w_ukv = (const float*)d_in[13]; p.w_br = (const float*)d_in[14]; p.w_o = (const float*)d_in[15];
    p.ln1_g = (const float*)d_in[16]; p.ln1_b = (const float*)d_in[17]; p.w_grp = (const float*)d_in[18]; p.b_grp = (const float*)d_in[19]; p.w_exp = (const float*)d_in[20]; p.b_exp = (const float*)d_in[21];
    p.w_gate = (const float*)d_in[22]; p.w_up = (const float*)d_in[23]; p.w_down = (const float*)d_in[24]; p.ln2_g = (const float*)d_in[25]; p.ln2_b = (const float*)d_in[26];
    p.w_pg = (const float*)d_in[27]; p.b_pg = (const float*)d_in[28]; p.w_pu = (const float*)d_in[29]; p.ln3_g = (const float*)d_in[30]; p.ln3_b = (const float*)d_in[31];
    p.out = (float*)d_out;
    char* w = (char*)d_ws; size_t off = 0;
    auto alloc = [&](size_t bytes) { void* r = w + off; off += (bytes + 255) & ~(size_t)255; return r; };
    p.bar = (unsigned*)alloc(16384); p.cnt = (int*)alloc(DEPTH * 64 * 4);
    const size_t zero_bytes = off;
    p.X = (float*)alloc((size_t)T * D * 4); p.Z = (float*)alloc((size_t)T * D * 4); p.Xb = (bf16_t*)alloc((size_t)T * D * 2); p.Db = (bf16_t*)alloc((size_t)T * D * 2);
    p.cs = (float*)alloc((size_t)T * 32 * 4); p.sn = (float*)alloc((size_t)T * 32 * 4); p.ssq_q = (float*)alloc((size_t)4 * T * 4); p.ssq_kv = (float*)alloc((size_t)4 * T * 4);
    p.Hp = (bf16_t*)alloc((size_t)T * HW * 2); p.GVt = (bf16_t*)alloc((size_t)T * 512 * 2);
    p.Qb = (bf16_t*)alloc((size_t)T * 768 * 2); p.KnImg = (bf16_t*)alloc((size_t)T * 512 * 2); p.VtImg = (bf16_t*)alloc((size_t)T * 512 * 2); p.KrImg = (bf16_t*)alloc((size_t)T * 64 * 2);
    p.MLpart = (float*)alloc((size_t)512 * 256 * 2 * 4);
    p.QE = (bf16_t*)alloc((size_t)T * 256 * 2); p.OI = (float*)alloc((size_t)T * 512 * 4); p.kvT = (float*)alloc((size_t)1024 * 8192 * 4); p.decay = (float*)alloc((size_t)1024 * 64 * 4); p.spT = (bf16_t*)alloc((size_t)1024 * 8192 * 2);
    p.Yab = (bf16_t*)alloc((size_t)T * 512 * 2); p.Ybb = (bf16_t*)alloc((size_t)T * 512 * 2); p.Ycb = (bf16_t*)alloc((size_t)T * 512 * 2); p.Mgb = (bf16_t*)alloc((size_t)T * D * 2);
    p.ew = (float*)alloc((size_t)T * 2 * 4); p.lists = (int*)alloc((size_t)NE * LCAP * 4);
    p.Hbuf = (bf16_t*)alloc((size_t)192 * 256 * EH * 2); p.Ys = (bf16_t*)alloc((size_t)2 * T * D * 2); p.Ub = (bf16_t*)alloc((size_t)T * D * 2); p.Pb = (bf16_t*)alloc((size_t)DEPTH * T * PLE * 2);
    p.Wb_in = (bf16_t*)alloc((size_t)HW * D * 2); p.Wb_gv = (bf16_t*)alloc((size_t)512 * D * 2); p.Wb_uq = (bf16_t*)alloc((size_t)768 * 256 * 2); p.Wb_uk = (bf16_t*)alloc((size_t)512 * 256 * 2); p.Wb_uv = (bf16_t*)alloc((size_t)512 * 256 * 2);
    p.Wb_br = (bf16_t*)alloc((size_t)3 * D * 512 * 2); p.Wb_o = (bf16_t*)alloc((size_t)D * D * 2); p.Wb_gu = (bf16_t*)alloc((size_t)NE * 512 * D * 2); p.Wb_d = (bf16_t*)alloc((size_t)NE * D * EH * 2);
    p.Wb_pg = (bf16_t*)alloc((size_t)D * D * 2); p.Wb_pu = (bf16_t*)alloc((size_t)D * PLE * 2);
    if (off > ws_size) return;
    (void)hipMemsetAsync(d_ws, 0, zero_bytes, st);
#if defined(MULTI_LAUNCH)
    launch_ph<PH_PRO>(p, 0, st);
    for (int i = 0; i < DEPTH; ++i) {
        launch_ph<PH_CONV>(p, i, st); launch_ph<PH_IN>(p, i, st);
        launch_ph<PH_PREP_Q>(p, i, st); launch_ph<PH_PREP_K>(p, i, st); launch_ph<PH_PREP_V>(p, i, st); launch_ph<PH_PREP_G>(p, i, st);
        launch_ph<PH_ATT>(p, i, st); launch_ph<PH_FIN>(p, i, st); launch_ph<PH_BR>(p, i, st); launch_ph<PH_WO>(p, i, st); launch_ph<PH_LN1>(p, i, st);
        launch_ph<PH_M1>(p, i, st); launch_ph<PH_M2>(p, i, st); launch_ph<PH_LN2>(p, i, st); launch_ph<PH_PLE>(p, i, st); launch_ph<PH_LN3>(p, i, st);
    }
#else
    static bool set = false;
    if (!set) { (void)hipFuncSetAttribute((const void*)k_mega, hipFuncAttributeMaxDynamicSharedMemorySize, LDS_BYTES); set = true; }
    hipLaunchKernelGGL(k_mega, dim3(NBLK), dim3(NTHR), LDS_BYTES, st, p);
#endif
}
```

```cpp
#include <hip/hip_runtime.h>
#include <hip/hip_bf16.h>
#include <stdint.h>

constexpr int T = 16384, D = 1024, DEPTH = 4, PLE = 256;
constexpr int NE = 64, EH = 256;
constexpr int INW = 6608;
constexpr int O_GV = 2048;
constexpr float DN_ALPHA = 1.681792830507429f;
constexpr int LCAP = 32768;
#define LAS __attribute__((address_space(3)))
typedef unsigned short bf16_t;
typedef short bf16x8 __attribute__((ext_vector_type(8)));
typedef float f32x4 __attribute__((ext_vector_type(4)));
typedef float f32x16 __attribute__((ext_vector_type(16)));
typedef unsigned u32x4 __attribute__((ext_vector_type(4)));
typedef unsigned u32x2 __attribute__((ext_vector_type(2)));
typedef float f32x2 __attribute__((ext_vector_type(2)));
constexpr int NBLK = 256, NTHR = 512;
constexpr int STAGE_BYTES = 131072, LDS_BYTES = 147456 + 512, XBW_OFF = 147456 + 256;
constexpr int HW = 6144;
constexpr int H_AB = 0, H_AC = 512, H_AX = 1024, H_GQ = 1536, H_GK = 1792, H_GR = 2048, H_CQ = 2560, H_CKV = 2816, H_KR = 2944, H_GLR = 3008, H_GTA = 3072, H_GTB = 4096, H_GTC = 5120;

__device__ __forceinline__ unsigned cvt_pk_bf16(float lo, float hi) { unsigned r; asm volatile("v_cvt_pk_bf16_f32 %0, %1, %2" : "=v"(r) : "v"(lo), "v"(hi)); return r; }
constexpr int WTAB_OFF = 147456;
__device__ __forceinline__ int tid_now() {
    const unsigned hw = (unsigned)__builtin_amdgcn_s_getreg((5 << 11) | 4) & 63u;
    extern __shared__ __attribute__((aligned(16))) unsigned char smem_tid[];
    const int w = __builtin_amdgcn_readfirstlane(*(volatile LAS int*)((LAS unsigned char*)smem_tid + WTAB_OFF + 4 * hw));
    int l = (int)__builtin_amdgcn_mbcnt_hi(~0u, __builtin_amdgcn_mbcnt_lo(~0u, 0u));
    asm volatile("" : "+v"(l));
    return w * 64 + l; }
__device__ __forceinline__ void tid_setup() {
    const unsigned hw = (unsigned)__builtin_amdgcn_s_getreg((5 << 11) | 4) & 63u;
    extern __shared__ __attribute__((aligned(16))) unsigned char smem_tid[];
    if ((threadIdx.x & 63) == 0) *(volatile LAS int*)((LAS unsigned char*)smem_tid + WTAB_OFF + 4 * hw) = (int)(threadIdx.x >> 6);
    __syncthreads(); }
__device__ __forceinline__ int sgpr_now(int v) { asm volatile("" : "+s"(v)); return v; }
__device__ __forceinline__ float shx(float v, int mask, int lane) { return __int_as_float(__builtin_amdgcn_ds_bpermute((lane ^ mask) << 2, __float_as_int(v))); }
__device__ __forceinline__ float frcp(float x) { return __builtin_amdgcn_rcpf(x); }
__device__ __forceinline__ float bf2f(bf16_t b) { return __uint_as_float(((unsigned)b) << 16); }
__device__ __forceinline__ float bflo(unsigned w) { return __uint_as_float(w << 16); }
__device__ __forceinline__ float bfhi(unsigned w) { return __uint_as_float(w & 0xffff0000u); }

namespace ge {
constexpr int BM = 256, BK = 64, HALF = 128, HTB = HALF * BK * 2;
__device__ __forceinline__ int lds_byte(int r, int c) { const int st = (r >> 4) * 2 + (c >> 5), rr = r & 15, cc = c & 31, ob = rr * 64 + cc * 2; return st * 1024 + (ob ^ (((ob >> 9) & 1) << 5)); }
__device__ __forceinline__ void stage_rc(int b, int& R, int& C) { const int st = b / 1024, sb = b % 1024, swz = sb ^ (((sb >> 9) & 1) << 5); R = (st >> 1) * 16 + swz / 64; C = (st & 1) * 32 + (swz % 64) / 2; }
__device__ __forceinline__ int perm32(int rho) { const int n = rho >> 4, i = rho & 15; return 8 * (i >> 2) + 4 * n + (i & 3); }
struct Unit { int pm, pn, g; };
typedef f32x4 Acc[2][2][4][2];
struct NoCarry { __device__ __forceinline__ bool carry(const struct Unit&) const { return false; } };

template <class Epi, class Sched, bool GATHER>
__device__ __forceinline__ void gemm_stream(LAS unsigned char* lds, const int K, const int lda, const int ldb, const Sched& S, const Epi& E) {
    const int tid = tid_now(), wid = __builtin_amdgcn_readfirstlane(tid >> 6), lane = tid & 63, wr = wid >> 2, wc = wid & 3, fr = lane & 15, fq = lane >> 4;
    const int nt = K / BK;
    Unit cur, nxt; int ui = 0;
    if (!S.next(0, cur)) return;
    unsigned voffA[2][2], nvoffA[2][2], voffB[2][2];
#pragma unroll
    for (int i = 0; i < 2; ++i) { int R, C; stage_rc(tid * 16 + i * 8192, R, C); const int Rb = (R & ~31) + perm32(R & 31);
        voffB[0][i] = (unsigned)(Rb * ldb + C) * 2u; voffB[1][i] = (unsigned)((Rb + 128) * ldb + C) * 2u;
        if constexpr (GATHER) { voffA[0][i] = (unsigned)(S.arow(cur, R) * lda + C) * 2u; voffA[1][i] = (unsigned)(S.arow(cur, R + 128) * lda + C) * 2u; }
        else { voffA[0][i] = (unsigned)(R * lda + C) * 2u; voffA[1][i] = (unsigned)((R + 128) * lda + C) * 2u; }
        nvoffA[0][i] = voffA[0][i]; nvoffA[1][i] = voffA[1][i]; }
    const size_t kstep = (size_t)(BK * 2);
    const unsigned ldsw = (unsigned)wid * 1024u;
    const int aoff = lds_byte(wr * 64 + fr, fq * 8), boff = lds_byte(wc * 32 + fr, fq * 8);
#define GE_SA(b, h) (((b) * 2 + (h)) * HTB)
#define GE_SB(b, h) ((4 + (b) * 2 + (h)) * HTB)
#define GE_STAGE(bufoff, gbase, voff) do { _Pragma("unroll") for (int _i = 0; _i < 2; ++_i) \
        __builtin_amdgcn_global_load_lds((const unsigned*)((const char*)(gbase) + (voff)[_i]), (LAS unsigned*)(lds + (bufoff) + ldsw + _i * 8192), 16, 0, 0); } while (0)
#define GE_LDA(dst, b, h) do { _Pragma("unroll") for (int m = 0; m < 4; ++m) _Pragma("unroll") for (int k = 0; k < 2; ++k) dst[m][k] = *(const LAS bf16x8*)(lds + GE_SA(b, h) + aoff + m * 2048 + k * 1024); } while (0)
#define GE_LDB(dst, b, h) do { _Pragma("unroll") for (int n = 0; n < 2; ++n) _Pragma("unroll") for (int k = 0; k < 2; ++k) dst[n][k] = *(const LAS bf16x8*)(lds + GE_SB(b, h) + boff + n * 2048 + k * 1024); } while (0)
#define GE_MMA(ai, bj, At, Bt) do { __builtin_amdgcn_s_setprio(1); _Pragma("unroll") for (int m = 0; m < 4; ++m) _Pragma("unroll") for (int n = 0; n < 2; ++n) _Pragma("unroll") for (int k = 0; k < 2; ++k) \
        acc[ai][bj][m][n] = __builtin_amdgcn_mfma_f32_16x16x32_bf16(Bt[n][k], At[m][k], acc[ai][bj][m][n], 0, 0, 0); __builtin_amdgcn_s_setprio(0); } while (0)
#define GE_WAIT_V(n) asm volatile("s_waitcnt vmcnt(" #n ")" ::: "memory")
#define GE_WAIT_L(n) asm volatile("s_waitcnt lgkmcnt(" #n ")" ::: "memory")
#define GE_BAR __builtin_amdgcn_s_barrier()
#define GE_SCHED __builtin_amdgcn_sched_barrier(0)
    Acc acc;
#pragma unroll
    for (int a = 0; a < 2; ++a)
#pragma unroll
        for (int b = 0; b < 2; ++b)
#pragma unroll
            for (int m = 0; m < 4; ++m)
#pragma unroll
                for (int n = 0; n < 2; ++n) acc[a][b][m][n] = (f32x4){0.f, 0.f, 0.f, 0.f};
    bf16x8 At[4][2], B0[2][2], B1[2][2];
    const char* cA = S.aptr(cur); const char* cB = S.bptr(cur);
    GE_STAGE(GE_SB(0, 0), cB, voffB[0]); GE_STAGE(GE_SA(0, 0), cA, voffA[0]); GE_STAGE(GE_SB(0, 1), cB, voffB[1]); GE_STAGE(GE_SA(0, 1), cA, voffA[1]);
    if (wr == 1) GE_BAR;
    GE_WAIT_V(4); GE_BAR;
    GE_STAGE(GE_SB(1, 0), cB + kstep, voffB[0]); GE_STAGE(GE_SA(1, 0), cA + kstep, voffA[0]); GE_STAGE(GE_SB(1, 1), cB + kstep, voffB[1]);
    GE_WAIT_V(6); GE_BAR;
    for (;;) {
        const bool has_next = S.next(ui + 1, nxt);
        const char* nA = has_next ? S.aptr(nxt) : cA; const char* nB = has_next ? S.bptr(nxt) : cB;
#pragma unroll 1
        for (int t = 0; t < nt; t += 2) {
            const bool last = (t == nt - 2);
            const char* a1 = cA + (size_t)(t + 1) * kstep;
            const char* a2 = last ? nA : cA + (size_t)(t + 2) * kstep; const char* b2 = last ? nB : cB + (size_t)(t + 2) * kstep;
            const char* a3 = a2 + kstep; const char* b3 = b2 + kstep;
            if constexpr (GATHER) { if (last && has_next) {
#pragma unroll
                for (int i = 0; i < 2; ++i) { int R, C; stage_rc(tid * 16 + i * 8192, R, C);
                    nvoffA[0][i] = (unsigned)(S.arow(nxt, R) * lda + C) * 2u; nvoffA[1][i] = (unsigned)(S.arow(nxt, R + 128) * lda + C) * 2u; } } }
            unsigned va2[2][2];
#pragma unroll
            for (int h = 0; h < 2; ++h)
#pragma unroll
                for (int i = 0; i < 2; ++i) va2[h][i] = (GATHER && last) ? nvoffA[h][i] : voffA[h][i];
            GE_LDB(B0, 0, 0); GE_SCHED; GE_LDA(At, 0, 0); GE_STAGE(GE_SA(1, 1), a1, voffA[1]);
            GE_WAIT_L(8); GE_BAR; GE_WAIT_L(0); GE_MMA(0, 0, At, B0); GE_BAR; GE_SCHED;
            GE_LDB(B1, 0, 1); GE_STAGE(GE_SB(0, 0), b2, voffB[0]);
            GE_BAR; GE_WAIT_L(0); GE_MMA(0, 1, At, B1); GE_BAR;
            GE_LDA(At, 0, 1); GE_STAGE(GE_SA(0, 0), a2, va2[0]);
            GE_BAR; GE_WAIT_L(0); GE_MMA(1, 0, At, B0); GE_BAR; GE_SCHED;
            GE_STAGE(GE_SB(0, 1), b2, voffB[1]);
            GE_WAIT_V(6); GE_BAR; GE_MMA(1, 1, At, B1); GE_BAR;
            GE_LDB(B0, 1, 0); GE_SCHED; GE_LDA(At, 1, 0); GE_STAGE(GE_SA(0, 1), a2, va2[1]);
            GE_WAIT_L(8); GE_BAR; GE_WAIT_L(0); GE_MMA(0, 0, At, B0); GE_BAR; GE_SCHED;
            GE_LDB(B1, 1, 1); GE_STAGE(GE_SB(1, 0), b3, voffB[0]);
            GE_BAR; GE_WAIT_L(0); GE_MMA(0, 1, At, B1); GE_BAR;
            GE_LDA(At, 1, 1); GE_STAGE(GE_SA(1, 0), a3, va2[0]);
            GE_BAR; GE_WAIT_L(0); GE_MMA(1, 0, At, B0); GE_BAR; GE_SCHED;
            GE_STAGE(GE_SB(1, 1), b3, voffB[1]);
            GE_WAIT_V(6); GE_BAR; GE_MMA(1, 1, At, B1); GE_BAR;
        }
        { int tz = tid; asm volatile("" : "+v"(tz));
          const int wid2 = tz >> 6, lane2 = tz & 63; E(acc, cur, wid2 >> 2, wid2 & 3, lane2 & 15, lane2 >> 4); }
        if (!has_next) break;
        if (!S.carry(cur)) {
#pragma unroll
        for (int a = 0; a < 2; ++a)
#pragma unroll
            for (int b = 0; b < 2; ++b)
#pragma unroll
                for (int m = 0; m < 4; ++m)
#pragma unroll
                    for (int n = 0; n < 2; ++n) acc[a][b][m][n] = (f32x4){0.f, 0.f, 0.f, 0.f}; }
        cur = nxt; cA = nA; cB = nB; ++ui;
        if (GATHER) {
#pragma unroll
            for (int h = 0; h < 2; ++h)
#pragma unroll
                for (int i = 0; i < 2; ++i) voffA[h][i] = nvoffA[h][i]; }
    }
    GE_WAIT_V(0);
    if (wr == 0) GE_BAR;
    GE_BAR;
#undef GE_SA
#undef GE_SB
#undef GE_STAGE
#undef GE_LDA
#undef GE_LDB
#undef GE_MMA
#undef GE_WAIT_V
#undef GE_WAIT_L
#undef GE_BAR
#undef GE_SCHED
}
__device__ __forceinline__ void tile_order(int L, int nM, int nN, int& pm, int& pn) {
    const int nwg = nM * nN; int wgid = L;
    { const int q = nwg / 8, r = nwg % 8, xcd = wgid % 8, off = wgid / 8; wgid = (xcd < r ? xcd * (q + 1) : r * (q + 1) + (xcd - r) * q) + off; }
    const int nig = 8 * nN, gid = wgid / nig, fm = gid * 8, gsz = (nM - fm) < 8 ? (nM - fm) : 8;
    pm = fm + ((wgid % nig) % gsz); pn = (wgid % nig) / gsz;
}
}
struct MapInMain { __device__ __forceinline__ int operator()(int s) const {
    if (s < 2048) return s;
    if (s < 2560) return 2576 + (s - 2048);
    if (s < 2816) return 3088 + (s - 2560);
    if (s < 2944) return 3344 + (s - 2816);
    if (s < 3008) return 3472 + (s - 2944);
    if (s < 3024) return 2560 + (s - 3008);
    if (s < 3072) return -1;
    return 3536 + (s - 3072); } };
struct MapOff { int off; __device__ __forceinline__ int operator()(int s) const { return off + s; } };struct MegaP {
    const float* w_in; bf16_t* Wb_in; bf16_t* Wb_gv; const bf16_t* Xb; bf16_t* Hp; bf16_t* GVt; float* ssq_q; float* ssq_kv;
};
struct SchedIn : ge::NoCarry {
    const char* Xb; const char* Wm; const char* Wg; int c, G, gv;
    __device__ __forceinline__ bool next(int i, ge::Unit& u) const {
        const int L = i * G + c;
        if (gv) { if (L >= 128) return false; u.g = 0; u.pm = L >> 1; u.pn = 8 + (L & 1); return true; }
        if (L >= 1536) return false;
        if (L < 1408) { u.g = 0; ge::tile_order(L, 64, 22, u.pm, u.pn); if (u.pn >= 8) u.pn += 2; } else { u.g = 1; const int l = L - 1408; u.pm = l & 1; u.pn = l >> 1; }
        return true; }
    __device__ __forceinline__ const char* aptr(const ge::Unit& u) const { return u.g == 0 ? Xb + (size_t)u.pm * 256 * D * 2 : Wg + (size_t)u.pm * 256 * D * 2; }
    __device__ __forceinline__ const char* bptr(const ge::Unit& u) const { return u.g == 0 ? Wm + (size_t)u.pn * 256 * D * 2 : Xb + (size_t)u.pn * 256 * D * 2; }
};
template <int GV> struct EpiIn {
    bf16_t* Hp; bf16_t* GVt; float* ssq_q; float* ssq_kv;
    __device__ __forceinline__ void operator()(ge::Acc& acc, const ge::Unit& u, int wr, int wc, int fr, int fq) const {
        if (GV == 0 || (GV == 2 && u.g == 0)) {
            const int row0 = u.pm * 256 + wr * 64 + fr, col0 = u.pn * 256 + wc * 32 + 8 * fq;
            const bool sg = u.pn >= 12;
#pragma unroll
            for (int ai = 0; ai < 2; ++ai)
#pragma unroll
                for (int m = 0; m < 4; ++m) { const int row = row0 + ai * 128 + m * 16; bf16_t* rp = Hp + (size_t)row * HW + col0;
                    float sq0 = 0.f, sq1 = 0.f;
#pragma unroll
                    for (int bj = 0; bj < 2; ++bj) { f32x4 v0 = acc[ai][bj][m][0], v1 = acc[ai][bj][m][1];
                        if (sg) {
#pragma unroll
                            for (int j = 0; j < 4; ++j) { v0[j] = frcp(1.f + __expf(-v0[j])); v1[j] = frcp(1.f + __expf(-v1[j])); } }
                        const float s = v0[0] * v0[0] + v0[1] * v0[1] + v0[2] * v0[2] + v0[3] * v0[3] + v1[0] * v1[0] + v1[1] * v1[1] + v1[2] * v1[2] + v1[3] * v1[3];
                        if (bj == 0) sq0 = s; else sq1 = s;
                        u32x4 o = {cvt_pk_bf16(v0[0], v0[1]), cvt_pk_bf16(v0[2], v0[3]), cvt_pk_bf16(v1[0], v1[1]), cvt_pk_bf16(v1[2], v1[3])};
                        *(u32x4*)(rp + bj * 128) = o; }
                    if (u.pn == 10 || u.pn == 11) {
                        float s = (u.pn == 10) ? (sq0 + sq1) : sq0;
                        { const int ln = fq * 16 + fr; s += shx(s, 16, ln); s += shx(s, 32, ln); }
                        if (fq == 0) { float* dst = (u.pn == 10 ? ssq_q : ssq_kv); dst[(size_t)wc * T + row] = s; } } }
        } else {
#pragma unroll
            for (int ai = 0; ai < 2; ++ai)
#pragma unroll
                for (int m = 0; m < 4; ++m) { const int r = u.pm * 256 + ai * 128 + wr * 64 + m * 16 + fr, h = r >> 7, e = r & 127;
#pragma unroll
                    for (int bj = 0; bj < 2; ++bj) { const int t0 = u.pn * 256 + bj * 128 + wc * 32 + 8 * fq;
                        const int chunk = t0 >> 6, p0 = (t0 & 48) + ((t0 & 8) >> 1);
                        bf16_t* base = GVt + ((size_t)(chunk * 4 + h) * 128 + e) * 64;
                        const f32x4 v0 = acc[ai][bj][m][0], v1 = acc[ai][bj][m][1];
                        u32x2 o0 = {cvt_pk_bf16(v0[0], v0[1]), cvt_pk_bf16(v0[2], v0[3])}, o1 = {cvt_pk_bf16(v1[0], v1[1]), cvt_pk_bf16(v1[2], v1[3])};
                        *(u32x2*)(base + p0) = o0; *(u32x2*)(base + p0 + 8) = o1; } }
        }
    }
};
constexpr float QSCALE = 0.07216878364870322f * 1.4426950408889634f;
struct MapQ { __device__ __forceinline__ int operator()(int s) const {
    if (s < 512) return (s >> 7) * 192 + (s & 127);
    const int s2 = s - 512, bj = s2 >> 7, w = s2 & 127; return (w >> 5) * 192 + 128 + bj * 32 + (w & 31); } };
struct MapKV { int voff; __device__ __forceinline__ int operator()(int s) const { return (s >> 7) * 256 + voff + (s & 127); } };

struct MlaP {
    const float* w_uq; const float* w_ukv; const float* qn_g; const float* kvn_g;
    bf16_t* Wb_uq; bf16_t* Wb_uk; bf16_t* Wb_uv;
    const bf16_t* Hp; const float* ssq_q; const float* ssq_kv; const float* cs; const float* sn;
    bf16_t* Qb; bf16_t* KnImg; bf16_t* VtImg; bf16_t* KrImg; float* Opart; float* MLpart; float* Yc;
};
__device__ __forceinline__ float rstd4(const float* ssq, int row, float invw) {
    const float s = (ssq[row] + ssq[T + row]) + (ssq[2 * T + row] + ssq[3 * T + row]); return rsqrtf(s * invw + 1e-6f); }

template <int mode> struct SchedMla : ge::NoCarry { const char* A; const char* B; int c, G;
    __device__ __forceinline__ bool next(int i, ge::Unit& u) const {
        if (c < 0) return false;
        const int L = i * G + c; u.g = mode;
        if (mode == 0) { if (L >= 192) return false; u.pm = L / 3; u.pn = L % 3; }
        else if (mode == 1) { if (L >= 128) return false; u.pm = L >> 1; u.pn = L & 1; }
        else { if (L >= 128) return false; u.pm = L & 1; u.pn = L >> 1; }
        return true; }
    __device__ __forceinline__ const char* aptr(const ge::Unit& u) const { return mode == 2 ? A + (size_t)u.pm * 256 * 256 * 2 : A + (size_t)u.pm * 256 * HW * 2; }
    __device__ __forceinline__ const char* bptr(const ge::Unit& u) const { return mode == 2 ? B + (size_t)u.pn * 256 * HW * 2 : B + (size_t)u.pn * 256 * 256 * 2; }
};
template <int MODE> struct EpiMla { MlaP p;
    __device__ __forceinline__ void operator()(ge::Acc& acc, const ge::Unit& u, int wr, int wc, int fr, int fq) const {
        if constexpr (MODE == 0) {
#pragma unroll
            for (int ai = 0; ai < 2; ++ai)
#pragma unroll
                for (int m = 0; m < 4; ++m) { asm volatile("" ::: "memory"); const int t = u.pm * 256 + ai * 128 + wr * 64 + m * 16 + fr; const float rs = rstd4(p.ssq_q, t, 1.f / 256.f) * QSCALE;
                    if (u.pn < 2) {
#pragma unroll
                        for (int bj = 0; bj < 2; ++bj) { const int c0 = u.pn * 256 + bj * 128 + wc * 32 + 8 * fq, head = c0 >> 7, dim = c0 & 127;
                            const f32x4 v0 = acc[ai][bj][m][0] * rs, v1 = acc[ai][bj][m][1] * rs;
                            u32x4 o = {cvt_pk_bf16(v0[0], v0[1]), cvt_pk_bf16(v0[2], v0[3]), cvt_pk_bf16(v1[0], v1[1]), cvt_pk_bf16(v1[2], v1[3])};
                            *(u32x4*)(p.Qb + (size_t)t * 768 + head * 192 + dim) = o; }
                    } else { const int head = wc, i0 = 8 * fq;
                        float o1[8], o2[8];
#pragma unroll
                        for (int n = 0; n < 2; ++n) { const f32x4 c4 = *(const f32x4*)(p.cs + (size_t)t * 32 + i0 + 4 * n), s4 = *(const f32x4*)(p.sn + (size_t)t * 32 + i0 + 4 * n);
#pragma unroll
                            for (int j = 0; j < 4; ++j) { const float x1 = acc[ai][0][m][n][j] * rs, x2 = acc[ai][1][m][n][j] * rs; o1[4 * n + j] = x1 * c4[j] - x2 * s4[j]; o2[4 * n + j] = x1 * s4[j] + x2 * c4[j]; } }
                        u32x4 a = {cvt_pk_bf16(o1[0], o1[1]), cvt_pk_bf16(o1[2], o1[3]), cvt_pk_bf16(o1[4], o1[5]), cvt_pk_bf16(o1[6], o1[7])};
                        u32x4 b = {cvt_pk_bf16(o2[0], o2[1]), cvt_pk_bf16(o2[2], o2[3]), cvt_pk_bf16(o2[4], o2[5]), cvt_pk_bf16(o2[6], o2[7])};
                        *(u32x4*)(p.Qb + (size_t)t * 768 + head * 192 + 128 + i0) = a; *(u32x4*)(p.Qb + (size_t)t * 768 + head * 192 + 160 + i0) = b; } }
        } else if constexpr (MODE == 1) {
#pragma unroll
            for (int ai = 0; ai < 2; ++ai)
#pragma unroll
                for (int m = 0; m < 4; ++m) { asm volatile("" ::: "memory"); const int t = u.pm * 256 + ai * 128 + wr * 64 + m * 16 + fr; const float rs = rstd4(p.ssq_kv, t, 1.f / 128.f);
                    const int tile = t >> 6, key = t & 63;
#pragma unroll
                    for (int bj = 0; bj < 2; ++bj) { const int c0 = u.pn * 256 + bj * 128 + wc * 32 + 8 * fq, head = c0 >> 7, chunk = (c0 & 127) >> 3;
                        const f32x4 v0 = acc[ai][bj][m][0] * rs, v1 = acc[ai][bj][m][1] * rs;
                        u32x4 o = {cvt_pk_bf16(v0[0], v0[1]), cvt_pk_bf16(v0[2], v0[3]), cvt_pk_bf16(v1[0], v1[1]), cvt_pk_bf16(v1[2], v1[3])};
                        *(u32x4*)((char*)p.KnImg + ((size_t)(head * 256 + tile) * 16384) + key * 256 + ((chunk ^ (key & 15)) << 4)) = o; } }
        } else {
#pragma unroll
            for (int bj = 0; bj < 2; ++bj) { const int t0 = u.pn * 256 + bj * 128 + wc * 32 + 8 * fq;
                float rs[8];
#pragma unroll
                for (int j = 0; j < 8; ++j) rs[j] = rstd4(p.ssq_kv, t0 + j, 1.f / 128.f);
                const int tile = t0 >> 6, p0 = (t0 & 48) + ((t0 & 8) >> 1);
#pragma unroll
                for (int ai = 0; ai < 2; ++ai)
#pragma unroll
                    for (int m = 0; m < 4; ++m) { asm volatile("" ::: "memory"); const int r = u.pm * 256 + ai * 128 + wr * 64 + m * 16 + fr, head = r >> 7, d = r & 127;
                        char* base = (char*)p.VtImg + ((size_t)(head * 256 + tile) * 16384) + d * 128;
                        const f32x4 v0 = acc[ai][bj][m][0], v1 = acc[ai][bj][m][1];
                        u32x2 o0 = {cvt_pk_bf16(v0[0] * rs[0], v0[1] * rs[1]), cvt_pk_bf16(v0[2] * rs[2], v0[3] * rs[3])};
                        u32x2 o1 = {cvt_pk_bf16(v1[0] * rs[4], v1[1] * rs[5]), cvt_pk_bf16(v1[2] * rs[6], v1[3] * rs[7])};
                        const int sw = (d >> 1) & 7, pa = p0, pb = p0 + 8;
                        *(u32x2*)(base + (((pa >> 3) ^ sw) << 4) + (pa & 7) * 2) = o0;
                        *(u32x2*)(base + (((pb >> 3) ^ sw) << 4) + (pb & 7) * 2) = o1; } }
        }
    }
};
__device__ __forceinline__ void kr_phase(const MlaP& p, int gtid, int gthreads) {
    for (int idx = gtid; idx < T * 4; idx += gthreads) { const int t = idx >> 2, c = idx & 3, i0 = 8 * c;
        const u32x4 a = *(const u32x4*)(p.Hp + (size_t)t * HW + H_KR + i0), b = *(const u32x4*)(p.Hp + (size_t)t * HW + H_KR + 32 + i0);
        float o1[8], o2[8];
#pragma unroll
        for (int n = 0; n < 2; ++n) { const f32x4 c4 = *(const f32x4*)(p.cs + (size_t)t * 32 + i0 + 4 * n), s4 = *(const f32x4*)(p.sn + (size_t)t * 32 + i0 + 4 * n);
#pragma unroll
            for (int j = 0; j < 4; ++j) { const int e = 4 * n + j; const unsigned wa = a[e >> 1], wb = b[e >> 1];
                const float x1 = (e & 1) ? bfhi(wa) : bflo(wa), x2 = (e & 1) ? bfhi(wb) : bflo(wb);
                o1[e] = x1 * c4[j] - x2 * s4[j]; o2[e] = x1 * s4[j] + x2 * c4[j]; } }
        u32x4 oa = {cvt_pk_bf16(o1[0], o1[1]), cvt_pk_bf16(o1[2], o1[3]), cvt_pk_bf16(o1[4], o1[5]), cvt_pk_bf16(o1[6], o1[7])};
        u32x4 ob = {cvt_pk_bf16(o2[0], o2[1]), cvt_pk_bf16(o2[2], o2[3]), cvt_pk_bf16(o2[4], o2[5]), cvt_pk_bf16(o2[6], o2[7])};
        const int tile = t >> 6, key = t & 63, sw = (key >> 1) & 7;
        char* base = (char*)p.KrImg + (size_t)tile * 8192 + key * 128;
        *(u32x4*)(base + ((c ^ sw) << 4)) = oa; *(u32x4*)(base + (((c + 4) ^ sw) << 4)) = ob; }
}
constexpr int ATT_STEPS = 130;
__device__ __forceinline__ void attn_item(LAS unsigned char* lds, const MlaP& p, int head, int b, int j0, int j1, int slot) {
    const int tid = tid_now(), wid = __builtin_amdgcn_readfirstlane(tid >> 6), lane = tid & 63, q = lane & 31, hh = lane >> 5;
    const int trow = b * 256 + wid * 32 + q;
    bf16x8 qf[12];
    { const bf16_t* qp = p.Qb + (size_t)trow * 768 + head * 192 + 8 * hh;
#pragma unroll
      for (int s = 0; s < 12; ++s) qf[s] = *(const bf16x8*)(qp + 16 * s); }
    f32x16 O[4];
#pragma unroll
    for (int d = 0; d < 4; ++d)
#pragma unroll
        for (int r = 0; r < 16; ++r) O[d][r] = 0.f;
    float m_run = -1e30f, l_run = 0.f;
    const char* knb = (const char*)p.KnImg + (size_t)head * 256 * 16384; const char* vtb = (const char*)p.VtImg + (size_t)head * 256 * 16384; const char* krb = (const char*)p.KrImg;
    const unsigned lo = (unsigned)lane * 16u;
#define AT_ISSUE(j, bi) do { const unsigned _bo = (unsigned)(bi) * 40960u; \
        __builtin_amdgcn_global_load_lds((const unsigned*)(knb + (size_t)(j) * 16384 + (wid * 2) * 1024 + lo), (LAS unsigned*)(lds + _bo + (wid * 2) * 1024), 16, 0, 0); \
        __builtin_amdgcn_global_load_lds((const unsigned*)(knb + (size_t)(j) * 16384 + (wid * 2 + 1) * 1024 + lo), (LAS unsigned*)(lds + _bo + (wid * 2 + 1) * 1024), 16, 0, 0); \
        __builtin_amdgcn_global_load_lds((const unsigned*)(krb + (size_t)(j) * 8192 + wid * 1024 + lo), (LAS unsigned*)(lds + _bo + 16384 + wid * 1024), 16, 0, 0); \
        __builtin_amdgcn_global_load_lds((const unsigned*)(vtb + (size_t)(j) * 16384 + (wid * 2) * 1024 + lo), (LAS unsigned*)(lds + _bo + 24576 + (wid * 2) * 1024), 16, 0, 0); \
        __builtin_amdgcn_global_load_lds((const unsigned*)(vtb + (size_t)(j) * 16384 + (wid * 2 + 1) * 1024 + lo), (LAS unsigned*)(lds + _bo + 24576 + (wid * 2 + 1) * 1024), 16, 0, 0); } while (0)
    const int kn_off0 = q * 256, kn_sw = q & 15, kr_off0 = q * 128, kr_sw = (q >> 1) & 7;
    const int vt_sw = (q >> 1) & 7;
    constexpr float THR = 8.f;
    AT_ISSUE(j0, 0);
    if (j0 + 1 < j1) AT_ISSUE(j0 + 1, 1);
    bool first = true;
    for (int j = j0; j < j1; ++j) {
        const int cur = (j - j0) % 3;
        if (j + 1 < j1) asm volatile("s_waitcnt vmcnt(5)" ::: "memory"); else asm volatile("s_waitcnt vmcnt(0)" ::: "memory");
        __builtin_amdgcn_s_barrier(); asm volatile("" ::: "memory");
        if (j + 2 < j1) AT_ISSUE(j + 2, (j + 2 - j0) % 3);
        const int jj = j - 4 * b;
        if (!(jj >= 0 && 64 * jj > 32 * wid + 31)) {
            LAS unsigned char* bb = lds + cur * 40960;
            const float mref = first ? 0.f : m_run;
            f32x16 S0, S1;
#pragma unroll
            for (int r = 0; r < 16; ++r) { S0[r] = -mref; S1[r] = -mref; }
#pragma unroll
            for (int s = 0; s < 8; ++s) {
                const bf16x8 k0 = *(const LAS bf16x8*)(bb + kn_off0 + (((2 * s + hh) ^ kn_sw) << 4));
                const bf16x8 k1 = *(const LAS bf16x8*)(bb + 8192 + kn_off0 + (((2 * s + hh) ^ kn_sw) << 4));
                S0 = __builtin_amdgcn_mfma_f32_32x32x16_bf16(k0, qf[s], S0, 0, 0, 0);
                S1 = __builtin_amdgcn_mfma_f32_32x32x16_bf16(k1, qf[s], S1, 0, 0, 0); }
#pragma unroll
            for (int s = 0; s < 4; ++s) {
                const bf16x8 k0 = *(const LAS bf16x8*)(bb + 16384 + kr_off0 + (((2 * s + hh) ^ kr_sw) << 4));
                const bf16x8 k1 = *(const LAS bf16x8*)(bb + 16384 + 4096 + kr_off0 + (((2 * s + hh) ^ kr_sw) << 4));
                S0 = __builtin_amdgcn_mfma_f32_32x32x16_bf16(k0, qf[8 + s], S0, 0, 0, 0);
                S1 = __builtin_amdgcn_mfma_f32_32x32x16_bf16(k1, qf[8 + s], S1, 0, 0, 0); }
            if (jj >= 0) {
                const int dq = wid * 32 + q - 64 * jj - 4 * hh;
                const float NEG = -__builtin_inff();
#pragma unroll
                for (int r = 0; r < 16; ++r) { const int c = (r & 3) + 8 * (r >> 2);
                    if (c > dq) S0[r] = NEG;
                    if (c + 32 > dq) S1[r] = NEG; } }
            float mx = S0[0];
#pragma unroll
            for (int r = 1; r < 16; ++r) mx = fmaxf(mx, S0[r]);
#pragma unroll
            for (int r = 0; r < 16; ++r) mx = fmaxf(mx, S1[r]);
            { auto rr = __builtin_amdgcn_permlane32_swap(__float_as_uint(mx), __float_as_uint(mx), false, false); mx = fmaxf(__uint_as_float(rr[0]), __uint_as_float(rr[1])); }
            float alpha = 1.f;
            if (first || !__all(mx <= THR)) {
                const float mn = fmaxf(m_run, mref + mx), sh = mn - mref;
                alpha = __builtin_amdgcn_exp2f(m_run - mn); m_run = mn;
#pragma unroll
                for (int r = 0; r < 16; ++r) { S0[r] -= sh; S1[r] -= sh; }
#pragma unroll
                for (int d = 0; d < 4; ++d)
#pragma unroll
                    for (int r = 0; r < 16; ++r) O[d][r] *= alpha;
                first = false;
            }
            float sum = 0.f;
#pragma unroll
            for (int r = 0; r < 16; ++r) { S0[r] = __builtin_amdgcn_exp2f(S0[r]); S1[r] = __builtin_amdgcn_exp2f(S1[r]); sum += S0[r] + S1[r]; }
            l_run = l_run * alpha + sum;
            bf16x8 pf[4];
#pragma unroll
            for (int h2 = 0; h2 < 2; ++h2) {
                u32x4 a = {cvt_pk_bf16(S0[8 * h2 + 0], S0[8 * h2 + 1]), cvt_pk_bf16(S0[8 * h2 + 2], S0[8 * h2 + 3]), cvt_pk_bf16(S0[8 * h2 + 4], S0[8 * h2 + 5]), cvt_pk_bf16(S0[8 * h2 + 6], S0[8 * h2 + 7])};
                u32x4 c = {cvt_pk_bf16(S1[8 * h2 + 0], S1[8 * h2 + 1]), cvt_pk_bf16(S1[8 * h2 + 2], S1[8 * h2 + 3]), cvt_pk_bf16(S1[8 * h2 + 4], S1[8 * h2 + 5]), cvt_pk_bf16(S1[8 * h2 + 6], S1[8 * h2 + 7])};
                pf[h2] = *(bf16x8*)&a; pf[2 + h2] = *(bf16x8*)&c; }
#pragma unroll
            for (int d = 0; d < 4; ++d) {
#pragma unroll
                for (int s2 = 0; s2 < 4; ++s2) {
                    const bf16x8 vf = *(const LAS bf16x8*)(bb + 24576 + (d * 32 + q) * 128 + (((2 * s2 + hh) ^ vt_sw) << 4));
                    O[d] = __builtin_amdgcn_mfma_f32_32x32x16_bf16(vf, pf[s2], O[d], 0, 0, 0); } }
        }
    }
    asm volatile("" ::: "memory"); __builtin_amdgcn_s_barrier(); asm volatile("" ::: "memory");
#undef AT_ISSUE
    { auto rr = __builtin_amdgcn_permlane32_swap(__float_as_uint(l_run), __float_as_uint(l_run), false, false); l_run = __uint_as_float(rr[0]) + __uint_as_float(rr[1]); }
    bf16_t* op = (bf16_t*)p.Opart + ((size_t)slot * 256 + wid * 32 + q) * 128 + 4 * hh;
#pragma unroll
    for (int d = 0; d < 4; ++d)
#pragma unroll
        for (int g = 0; g < 4; ++g) { u32x2 v = {cvt_pk_bf16(O[d][4 * g], O[d][4 * g + 1]), cvt_pk_bf16(O[d][4 * g + 2], O[d][4 * g + 3])}; *(u32x2*)(op + d * 32 + g * 8) = v; }
    if (hh == 0) { float* ml = p.MLpart + ((size_t)slot * 256 + wid * 32 + q) * 2; ml[0] = m_run; ml[1] = l_run; }
}
__device__ __forceinline__ void attn_phase(LAS unsigned char* lds, const MlaP& p, int c) {
    const int head = c >> 6, cc = c & 63, pp = cc >> 1, bl = 63 - pp, nl = 4 * (64 - pp);
    if ((cc & 1) == 0) attn_item(lds, p, head, bl, 0, ATT_STEPS, 2 * c);
    else { attn_item(lds, p, head, bl, ATT_STEPS, nl, 2 * c); attn_item(lds, p, head, pp, 0, 4 * (pp + 1), 2 * c + 1); }
}
struct GlaP {
    const bf16_t* Hp; const bf16_t* GVt; const float* wg; const float* bg; const float* ng; const float* wconv;
    bf16_t* QE; float* OI; float* kvT; float* decay; bf16_t* spT; bf16_t* Yab; bf16_t* Ybb; bf16_t* Ycb;
    const float* Opart; const float* MLpart;
};
__device__ __forceinline__ int pos16(int i) { return (i & 48) | ((i & 4) << 1) | ((i & 8) >> 1) | (i & 3); }
__device__ __forceinline__ void gla_g1(LAS unsigned char* lds, const GlaP& p, int c, int G) {
    const int tid = tid_now(), wid = __builtin_amdgcn_readfirstlane(tid >> 6), lane = tid & 63, l31 = lane & 31, hh = lane >> 5;
    LAS float* bsm = (LAS float*)lds; LAS float* gtot = (LAS float*)(lds + 17408); LAS float* blast = (LAS float*)(lds + 19456);
    LAS unsigned char* qeL = lds + 20480; LAS unsigned char* keL = lds + 28672; LAS unsigned char* ktL = lds + 36864;
    const int eb = wid & 3, hb = wid >> 2;
    for (int u = c; u < 1024; u += G) {
        const int n = u >> 2, h = u & 3;
        bf16x8 vf[4];
        { const bf16_t* vp = p.GVt + ((size_t)u * 128 + eb * 32 + l31) * 64 + 8 * hh;
#pragma unroll
          for (int s4 = 0; s4 < 4; ++s4) vf[s4] = *(const bf16x8*)(vp + 16 * s4); }
        { const int d = tid & 63, g = tid >> 6;
          float w[16];
#pragma unroll
          for (int r = 0; r < 16; ++r) w[r] = p.wg[r * 256 + h * 64 + d];
          const float bias = p.bg[h * 64 + d];
          float cs[8]; float run = 0.f;
#pragma unroll
          for (int k = 0; k < 8; ++k) { const int i = 8 * g + k;
              const u32x4 g0 = *(const u32x4*)(p.Hp + (size_t)(64 * n + i) * HW + H_GLR), g1 = *(const u32x4*)(p.Hp + (size_t)(64 * n + i) * HW + H_GLR + 8);
              float la = bias;
#pragma unroll
              for (int r = 0; r < 4; ++r) { la += bflo(g0[r]) * w[2 * r] + bfhi(g0[r]) * w[2 * r + 1]; la += bflo(g1[r]) * w[8 + 2 * r] + bfhi(g1[r]) * w[8 + 2 * r + 1]; }
              const float ls = (fminf(la, 0.f) - __logf(1.f + __expf(-fabsf(la)))) * (1.f / 16.f);
              run += ls; cs[k] = run; }
          gtot[g * 64 + d] = run;
          __syncthreads();
          float pre = 0.f, tot = 0.f;
#pragma unroll
          for (int gg = 0; gg < 8; ++gg) { const float v = gtot[gg * 64 + d]; tot += v; if (gg < g) pre += v; }
#pragma unroll
          for (int k = 0; k < 8; ++k) bsm[(8 * g + k) * 68 + d] = pre + cs[k];
          if (g == 0) { blast[d] = tot; p.decay[(size_t)u * 64 + d] = __expf(tot); } }
        __syncthreads();
        { const int i = tid >> 3, cc = tid & 7, d0 = 8 * cc; const size_t t = (size_t)64 * n + i;
          const u32x4 qv = *(const u32x4*)(p.Hp + t * HW + H_GQ + h * 64 + d0), kv = *(const u32x4*)(p.Hp + t * HW + H_GK + h * 64 + d0);
          float b[8], bl[8];
          { const f32x4 b0 = *(const LAS f32x4*)(bsm + i * 68 + d0), b1 = *(const LAS f32x4*)(bsm + i * 68 + d0 + 4), l0 = *(const LAS f32x4*)(blast + d0), l1 = *(const LAS f32x4*)(blast + d0 + 4);
#pragma unroll
            for (int j = 0; j < 4; ++j) { b[j] = b0[j]; b[4 + j] = b1[j]; bl[j] = l0[j]; bl[4 + j] = l1[j]; } }
          float qe[8], ke[8], kt[8];
#pragma unroll
          for (int j = 0; j < 8; ++j) { const float qq = (j & 1) ? bfhi(qv[j >> 1]) : bflo(qv[j >> 1]), kk = (j & 1) ? bfhi(kv[j >> 1]) : bflo(kv[j >> 1]);
              qe[j] = qq * 0.125f * __expf(b[j]); ke[j] = kk * __expf(-b[j]); kt[j] = kk * __expf(bl[j] - b[j]); }
          const u32x4 qo = {cvt_pk_bf16(qe[0], qe[1]), cvt_pk_bf16(qe[2], qe[3]), cvt_pk_bf16(qe[4], qe[5]), cvt_pk_bf16(qe[6], qe[7])};
          const u32x4 ko = {cvt_pk_bf16(ke[0], ke[1]), cvt_pk_bf16(ke[2], ke[3]), cvt_pk_bf16(ke[4], ke[5]), cvt_pk_bf16(ke[6], ke[7])};
          const int sw = (i >> 1) & 7;
          *(LAS u32x4*)(qeL + i * 128 + ((cc ^ sw) << 4)) = qo; *(LAS u32x4*)(keL + i * 128 + ((cc ^ sw) << 4)) = ko;
          *(u32x4*)(p.QE + t * 256 + h * 64 + d0) = qo;
          const int pi = pos16(i);
#pragma unroll
          for (int j = 0; j < 8; ++j) { const int d = d0 + j; const unsigned pk = cvt_pk_bf16(kt[j], 0.f);
              *(LAS unsigned short*)(ktL + d * 128 + (((pi >> 3) ^ ((d >> 1) & 7)) << 4) + (pi & 7) * 2) = (unsigned short)pk; } }
        __syncthreads();
        { f32x16 OT, KV;
#pragma unroll
          for (int r = 0; r < 16; ++r) { OT[r] = 0.f; KV[r] = 0.f; }
          const int sw = (l31 >> 1) & 7;
#pragma unroll
          for (int jb = 0; jb < 2; ++jb) {
              if (jb <= hb) {
                  f32x16 Sc;
#pragma unroll
                  for (int r = 0; r < 16; ++r) Sc[r] = 0.f;
#pragma unroll
                  for (int s = 0; s < 4; ++s) {
                      const bf16x8 ka = *(const LAS bf16x8*)(keL + (32 * jb + l31) * 128 + (((2 * s + hh) ^ sw) << 4));
                      const bf16x8 qb = *(const LAS bf16x8*)(qeL + (32 * hb + l31) * 128 + (((2 * s + hh) ^ sw) << 4));
                      Sc = __builtin_amdgcn_mfma_f32_32x32x16_bf16(ka, qb, Sc, 0, 0, 0); }
                  if (jb == hb) {
#pragma unroll
                      for (int r = 0; r < 16; ++r) { const int j = (r & 3) + 8 * (r >> 2) + 4 * hh; if (j > l31) Sc[r] = 0.f; } }
#pragma unroll
                  for (int h2 = 0; h2 < 2; ++h2) {
                      u32x4 a = {cvt_pk_bf16(Sc[8 * h2 + 0], Sc[8 * h2 + 1]), cvt_pk_bf16(Sc[8 * h2 + 2], Sc[8 * h2 + 3]), cvt_pk_bf16(Sc[8 * h2 + 4], Sc[8 * h2 + 5]), cvt_pk_bf16(Sc[8 * h2 + 6], Sc[8 * h2 + 7])};
                      OT = __builtin_amdgcn_mfma_f32_32x32x16_bf16(vf[2 * jb + h2], *(bf16x8*)&a, OT, 0, 0, 0); } } }
#pragma unroll
          for (int s4 = 0; s4 < 4; ++s4) {
              const bf16x8 kb = *(const LAS bf16x8*)(ktL + (32 * hb + l31) * 128 + (((2 * s4 + hh) ^ sw) << 4));
              KV = __builtin_amdgcn_mfma_f32_32x32x16_bf16(vf[s4], kb, KV, 0, 0, 0); }
          float* oi = p.OI + ((size_t)u * 8 + wid) * 1024 + lane;
#pragma unroll
          for (int r = 0; r < 16; ++r) oi[r * 64] = OT[r];
          float* kp = p.kvT + (size_t)u * 8192 + 32 * hb + l31;
#pragma unroll
          for (int r = 0; r < 16; ++r) { const int e = 32 * eb + (r & 3) + 8 * (r >> 2) + 4 * hh; kp[e * 64] = KV[r]; } }
        __syncthreads();
    }
}
__device__ __forceinline__ void gla_g2(LAS unsigned char* lds, const GlaP& p, int c) {
    const int tid = tid_now(), el = tid & 127, seg = tid >> 7;
    const int idx = c * 128 + el, h = idx >> 13, ed = idx & 8191, d = idx & 63;
    LAS float* segS = (LAS float*)lds; LAS float* segD = (LAS float*)(lds + 2048);
    float st = 0.f, dp = 1.f;
    for (int n0 = seg * 64; n0 < seg * 64 + 64; n0 += 16) {
        float kv[16], dc[16];
#pragma unroll
        for (int k = 0; k < 16; ++k) { const size_t u = (size_t)(n0 + k) * 4 + h; kv[k] = p.kvT[u * 8192 + ed]; dc[k] = p.decay[u * 64 + d]; }
#pragma unroll
        for (int k = 0; k < 16; ++k) { st = fmaf(dc[k], st, kv[k]); dp *= dc[k]; }
    }
    __syncthreads();
    segS[seg * 128 + el] = st; segD[seg * 128 + el] = dp;
    __syncthreads();
    st = 0.f;
    for (int s2 = 0; s2 < seg; ++s2) st = fmaf(segD[s2 * 128 + el], st, segS[s2 * 128 + el]);
    for (int n0 = seg * 64; n0 < seg * 64 + 64; n0 += 16) {
        float kv[16], dc[16];
#pragma unroll
        for (int k = 0; k < 16; ++k) { const size_t u = (size_t)(n0 + k) * 4 + h; kv[k] = p.kvT[u * 8192 + ed]; dc[k] = p.decay[u * 64 + d]; }
#pragma unroll
        for (int k = 0; k < 16; ++k) { const size_t u = (size_t)(n0 + k) * 4 + h; p.spT[u * 8192 + ed] = (bf16_t)(cvt_pk_bf16(st, 0.f) & 0xffffu); st = fmaf(dc[k], st, kv[k]); }
    }
    __syncthreads();
}
__device__ __forceinline__ void gla_g3(LAS unsigned char* lds, const GlaP& p, int c, int G) {
    const int tid = tid_now(), wid = __builtin_amdgcn_readfirstlane(tid >> 6), lane = tid & 63, l31 = lane & 31, hh = lane >> 5;
    LAS float* red = (LAS float*)lds;
    const int eb = wid & 3, ib = wid >> 2;
    struct In { f32x16 oi; bf16x8 sp[4], qe[4]; u32x2 rv[4]; };
    auto load = [&](int u, In& x) __attribute__((always_inline)) {
        const int n = u >> 2, h = u & 3; const size_t t = (size_t)64 * n + 32 * ib + l31;
        const float* oi = p.OI + ((size_t)u * 8 + wid) * 1024 + lane;
#pragma unroll
        for (int r = 0; r < 16; ++r) x.oi[r] = oi[r * 64];
        const bf16_t* sp = p.spT + ((size_t)u * 128 + 32 * eb + l31) * 64 + 8 * hh; const bf16_t* qp = p.QE + t * 256 + h * 64 + 8 * hh;
#pragma unroll
        for (int s = 0; s < 4; ++s) { x.sp[s] = *(const bf16x8*)(sp + 16 * s); x.qe[s] = *(const bf16x8*)(qp + 16 * s); }
#pragma unroll
        for (int g = 0; g < 4; ++g) x.rv[g] = *(const u32x2*)(p.Hp + t * HW + H_GR + h * 128 + 32 * eb + 8 * g + 4 * hh);
    };
    In cur, nxt;
    if (c < 1024) load(c, cur);
    for (int u = c; u < 1024; u += G) {
        const int n = u >> 2, h = u & 3;
        const bool hn = u + G < 1024;
        if (hn) load(u + G, nxt);
        f32x16 O = cur.oi;
        const size_t t = (size_t)64 * n + 32 * ib + l31;
#pragma unroll
        for (int s = 0; s < 4; ++s) O = __builtin_amdgcn_mfma_f32_32x32x16_bf16(cur.sp[s], cur.qe[s], O, 0, 0, 0);
        float ss = 0.f;
#pragma unroll
        for (int r = 0; r < 16; ++r) ss += O[r] * O[r];
        { auto rr = __builtin_amdgcn_permlane32_swap(__float_as_uint(ss), __float_as_uint(ss), false, false); ss = __uint_as_float(rr[0]) + __uint_as_float(rr[1]); }
        __syncthreads();
        if (hh == 0) red[eb * 64 + 32 * ib + l31] = ss;
        __syncthreads();
        const int ti = 32 * ib + l31;
        const float tot = (red[ti] + red[64 + ti]) + (red[128 + ti] + red[192 + ti]);
        const float rs = rsqrtf(tot * (1.f / 128.f) + 1e-6f);
#pragma unroll
        for (int g = 0; g < 4; ++g) { const int e0 = 32 * eb + 8 * g + 4 * hh;
            const u32x2 rv = cur.rv[g]; const f32x4 gn = *(const f32x4*)(p.ng + e0);
            float y[4];
#pragma unroll
            for (int j = 0; j < 4; ++j) { const float r_ = (j & 1) ? bfhi(rv[j >> 1]) : bflo(rv[j >> 1]); y[j] = O[4 * g + j] * rs * gn[j] * (r_ * frcp(1.f + __expf(-r_))); }
            u32x2 o = {cvt_pk_bf16(y[0], y[1]), cvt_pk_bf16(y[2], y[3])};
            *(u32x2*)(p.Ybb + t * 512 + h * 128 + e0) = o; }
        if (hn) cur = nxt;
    }
}
__device__ __forceinline__ void conv_phase(const GlaP& p, int gtid, int gthreads) {
    constexpr int NT = T * 64;
    for (int idx0 = gtid; idx0 < NT; idx0 += 2 * gthreads) {
        u32x4 av[2][3], xv[2][3], bv[2]; int tt[2], cc[2];
#pragma unroll
        for (int u = 0; u < 2; ++u) { const int idx = min(idx0 + u * gthreads, NT - 1); const int t = idx >> 6, c0 = (idx & 63) * 8; tt[u] = t; cc[u] = c0;
#pragma unroll
            for (int k = 0; k < 3; ++k) { const int ts = max(t - 2 + k, 0);
                av[u][k] = *(const u32x4*)(p.Hp + (size_t)ts * HW + H_AC + c0); xv[u][k] = *(const u32x4*)(p.Hp + (size_t)ts * HW + H_AX + c0); }
            bv[u] = *(const u32x4*)(p.Hp + (size_t)t * HW + H_AB + c0); }
#pragma unroll
        for (int u = 0; u < 2; ++u) { if (idx0 + u * gthreads < NT) { const int t = tt[u], c0 = cc[u];
            float y[8];
#pragma unroll
            for (int j = 0; j < 8; ++j) y[j] = 0.f;
#pragma unroll
            for (int k = 0; k < 3; ++k) { if (t - 2 + k >= 0) {
                const f32x4 w0 = *(const f32x4*)(p.wconv + k * 512 + c0), w1 = *(const f32x4*)(p.wconv + k * 512 + c0 + 4);
#pragma unroll
                for (int j = 0; j < 4; ++j) { y[2 * j] += (j < 2 ? w0[2 * j] : w1[2 * j - 4]) * (bflo(av[u][k][j]) * bflo(xv[u][k][j])); y[2 * j + 1] += (j < 2 ? w0[2 * j + 1] : w1[2 * j - 3]) * (bfhi(av[u][k][j]) * bfhi(xv[u][k][j])); } } }
            u32x4 o;
#pragma unroll
            for (int j = 0; j < 4; ++j) o[j] = cvt_pk_bf16(bflo(bv[u][j]) * y[2 * j], bfhi(bv[u][j]) * y[2 * j + 1]);
            *(u32x4*)(p.Yab + (size_t)t * 512 + c0) = o; } }
    }
}
__device__ __forceinline__ void attn_combine_bf16(const GlaP& p, int gtid, int gthreads) {
    constexpr int NT = 256 * 256 * 32;
    for (int idx0 = gtid; idx0 < NT; idx0 += 2 * gthreads) {
        float mv[2][2], lv[2][2]; u32x2 ov[2][2]; int nval[2]; size_t orow[2]; int ocol[2];
#pragma unroll
        for (int u = 0; u < 2; ++u) { const int idx = min(idx0 + u * gthreads, NT - 1);
            const int dq = idx & 31, row = (idx >> 5) & 255, g = idx >> 13, head = g >> 6, b = g & 63;
            const int s0 = b >= 32 ? 2 * (head * 64 + 2 * (63 - b)) : 2 * (head * 64 + 2 * b + 1) + 1;
            nval[u] = b >= 32 ? 2 : 1; orow[u] = (size_t)(b * 256 + row) * 512 + head * 128; ocol[u] = dq * 4;
#pragma unroll
            for (int k = 0; k < 2; ++k) { const size_t sl = (size_t)(s0 + (b >= 32 ? 2 * k : 0)) * 256 + row;
                const f32x2 ml = *(const f32x2*)(p.MLpart + sl * 2); mv[u][k] = ml[0]; lv[u][k] = ml[1];
                ov[u][k] = *(const u32x2*)((const bf16_t*)p.Opart + sl * 128 + dq * 4); } }
#pragma unroll
        for (int u = 0; u < 2; ++u) { if (idx0 + u * gthreads < NT) {
            float M = mv[u][0];
#pragma unroll
            for (int k = 1; k < 2; ++k) if (k < nval[u]) M = fmaxf(M, mv[u][k]);
            f32x4 acc = {0.f, 0.f, 0.f, 0.f}; float l = 0.f;
#pragma unroll
            for (int k = 0; k < 2; ++k) { const float w = k < nval[u] ? __builtin_amdgcn_exp2f(mv[u][k] - M) : 0.f;
                l += w * lv[u][k]; const f32x4 o = {bflo(ov[u][k][0]), bfhi(ov[u][k][0]), bflo(ov[u][k][1]), bfhi(ov[u][k][1])}; acc += o * w; }
            const float il = frcp(l);
            u32x2 o = {cvt_pk_bf16(acc[0] * il, acc[1] * il), cvt_pk_bf16(acc[2] * il, acc[3] * il)};
            *(u32x2*)(p.Ycb + orow[u] + ocol[u]) = o; } }
    }
}
struct P {
    const float *x, *pin; const int* pos;
    const float *ln0_g, *ln0_b, *w_in, *w_conv, *w_gg, *b_gg, *gla_ng, *qn_g, *kvn_g, *w_uq, *w_ukv, *w_br, *w_o, *ln1_g, *ln1_b, *w_grp, *b_grp, *w_exp, *b_exp,
                *w_gate, *w_up, *w_down, *ln2_g, *ln2_b, *w_pg, *b_pg, *w_pu, *ln3_g, *ln3_b;
    float* out;
    float *X, *Z, *cs, *sn, *ssq_q, *ssq_kv, *OI, *kvT, *decay, *MLpart, *ew;
    bf16_t *Db, *Xb, *Hp, *GVt, *Qb, *KnImg, *VtImg, *KrImg, *QE, *spT, *Yab, *Ybb, *Ycb, *Mgb, *Hbuf, *Ys, *Ub, *Pb;
    bf16_t *Wb_in, *Wb_gv, *Wb_uq, *Wb_uk, *Wb_uv, *Wb_br, *Wb_o, *Wb_gu, *Wb_d, *Wb_pg, *Wb_pu;
    int *cnt, *lists; unsigned* bar;
};
__device__ __forceinline__ MegaP mk_mega(const P& p) { MegaP m; m.w_in = p.w_in; m.Wb_in = p.Wb_in; m.Wb_gv = p.Wb_gv; m.Xb = p.Xb; m.Hp = p.Hp; m.GVt = p.GVt; m.ssq_q = p.ssq_q; m.ssq_kv = p.ssq_kv; return m; }
__device__ __forceinline__ MlaP mk_mla(const P& p) { MlaP q; q.w_uq = p.w_uq; q.w_ukv = p.w_ukv; q.qn_g = p.qn_g; q.kvn_g = p.kvn_g; q.Wb_uq = p.Wb_uq; q.Wb_uk = p.Wb_uk; q.Wb_uv = p.Wb_uv; q.Hp = p.Hp;
    q.ssq_q = p.ssq_q; q.ssq_kv = p.ssq_kv; q.cs = p.cs; q.sn = p.sn; q.Qb = p.Qb; q.KnImg = p.KnImg; q.VtImg = p.VtImg; q.KrImg = p.KrImg; q.Opart = p.Z; q.MLpart = p.MLpart; q.Yc = nullptr; return q; }
__device__ __forceinline__ GlaP mk_gla(const P& p, int layer) { GlaP g; g.Hp = p.Hp; g.GVt = p.GVt; g.wg = p.w_gg + layer * 16 * 256; g.bg = p.b_gg + layer * 256; g.ng = p.gla_ng + layer * 128; g.wconv = p.w_conv + layer * 3 * 512;
    g.QE = p.QE; g.OI = p.OI; g.kvT = p.kvT; g.decay = p.decay; g.spT = p.spT; g.Yab = p.Yab; g.Ybb = p.Ybb; g.Ycb = p.Ycb; g.Opart = p.Z; g.MLpart = p.MLpart; return g; }

struct CvJob { const float* W; bf16_t* Bt; const float* rs; int ldw, Ksrc, ldbt, n0, k0, kind, aux; };
struct MapId { __device__ __forceinline__ int operator()(int s) const { return s; } };
__device__ __forceinline__ int cv_map(int kind, int aux, int n) {
    if (kind == 0) return MapInMain{}(n);
    if (kind == 1) return aux + n;
    if (kind == 2) return MapQ{}(n);
    if (kind == 3) return MapKV{aux}(n);
    return n; }
__device__ __forceinline__ int cv_omap(int kind, int aux, int n) { return kind == 4 ? (n >> 7) * 256 + aux * 128 + (n & 127) : n; }
__device__ __forceinline__ bool cv_job(const P& p, int layer, int t, CvJob& j) {
    constexpr int S0 = 384, S1 = S0 + 32, S2 = S1 + 12, S3 = S2 + 8, S4 = S3 + 8, S5 = S4 + 96, S6 = S5 + 64, S7 = S6 + 64, S8 = S7 + 16, S9 = S8 + 1024, S10 = S9 + 1024, S11 = S10 + 1024;
    if (t >= S11) return false;
    j.rs = nullptr; j.aux = 0; j.kind = 5;
    if (t < S0) { j.W = p.w_in + (size_t)layer * D * INW; j.ldw = INW; j.Ksrc = D; j.Bt = p.Wb_in; j.ldbt = D; j.n0 = (t >> 2) * 64; j.k0 = (t & 3) * 256; j.kind = 0; }
    else if (t < S1) { const int u = t - S0; j.W = p.w_in + (size_t)layer * D * INW; j.ldw = INW; j.Ksrc = D; j.Bt = p.Wb_gv; j.ldbt = D; j.n0 = (u >> 2) * 64; j.k0 = (u & 3) * 256; j.kind = 1; j.aux = O_GV; }
    else if (t < S2) { const int u = t - S1; j.W = p.w_uq + (size_t)layer * 256 * 768; j.ldw = 768; j.Ksrc = 256; j.Bt = p.Wb_uq; j.ldbt = 256; j.n0 = u * 64; j.k0 = 0; j.kind = 2; j.rs = p.qn_g + layer * 256; }
    else if (t < S3) { const int u = t - S2; j.W = p.w_ukv + (size_t)layer * 128 * 1024; j.ldw = 1024; j.Ksrc = 128; j.Bt = p.Wb_uk; j.ldbt = 256; j.n0 = u * 64; j.k0 = 0; j.kind = 3; j.aux = 0; j.rs = p.kvn_g + layer * 128; }
    else if (t < S4) { const int u = t - S3; j.W = p.w_ukv + (size_t)layer * 128 * 1024; j.ldw = 1024; j.Ksrc = 128; j.Bt = p.Wb_uv; j.ldbt = 256; j.n0 = u * 64; j.k0 = 0; j.kind = 3; j.aux = 128; j.rs = p.kvn_g + layer * 128; }
    else if (t < S5) { const int u = t - S4, br = u >> 5, v = u & 31; j.W = p.w_br + (size_t)layer * 1536 * D + (size_t)br * 512 * D; j.ldw = D; j.Ksrc = 512; j.Bt = p.Wb_br + (size_t)br * 1024 * 512; j.ldbt = 512; j.n0 = (v >> 1) * 64; j.k0 = (v & 1) * 256; }
    else if (t < S6) { const int u = t - S5; j.W = p.w_o + (size_t)layer * D * D; j.ldw = D; j.Ksrc = D; j.Bt = p.Wb_o; j.ldbt = D; j.n0 = (u >> 2) * 64; j.k0 = (u & 3) * 256; }
    else if (t < S7) { const int u = t - S6; j.W = p.w_pg + (size_t)layer * D * D; j.ldw = D; j.Ksrc = D; j.Bt = p.Wb_pg; j.ldbt = D; j.n0 = (u >> 2) * 64; j.k0 = (u & 3) * 256; }
    else if (t < S8) { const int u = t - S7; j.W = p.w_pu + (size_t)layer * PLE * D; j.ldw = D; j.Ksrc = PLE; j.Bt = p.Wb_pu; j.ldbt = PLE; j.n0 = u * 64; j.k0 = 0; }
    else if (t < S9) { const int u = t - S8, e = u >> 4, v = u & 15; j.W = p.w_gate + ((size_t)layer * NE + e) * D * EH; j.ldw = EH; j.Ksrc = D; j.Bt = p.Wb_gu + (size_t)e * 512 * D; j.ldbt = D; j.n0 = (v >> 2) * 64; j.k0 = (v & 3) * 256; j.kind = 4; j.aux = 0; }
    else if (t < S10) { const int u = t - S9, e = u >> 4, v = u & 15; j.W = p.w_up + ((size_t)layer * NE + e) * D * EH; j.ldw = EH; j.Ksrc = D; j.Bt = p.Wb_gu + (size_t)e * 512 * D; j.ldbt = D; j.n0 = (v >> 2) * 64; j.k0 = (v & 3) * 256; j.kind = 4; j.aux = 1; }
    else { const int u = t - S10, e = u >> 4, v = u & 15; j.W = p.w_down + ((size_t)layer * NE + e) * EH * D; j.ldw = D; j.Ksrc = EH; j.Bt = p.Wb_d + (size_t)e * D * EH; j.ldbt = EH; j.n0 = v * 64; j.k0 = 0; }
    return true; }
__device__ __forceinline__ void cv_load(const CvJob& j, int tid, f32x4 (&v)[8]) {
    const int n4 = tid & 15, kr = tid >> 4; const int col = cv_map(j.kind, j.aux, j.n0 + 4 * n4);
#pragma unroll
    for (int r = 0; r < 8; ++r) { const int k = j.k0 + kr + 32 * r; v[r] = (f32x4){0.f, 0.f, 0.f, 0.f};
        if (col >= 0 && k < j.Ksrc) { v[r] = *(const f32x4*)(j.W + (size_t)k * j.ldw + col); if (j.rs) v[r] = v[r] * j.rs[k]; } }
}
__device__ __forceinline__ void ph_convert(LAS unsigned char* ldsl, const P& p, int layer) {
    LAS float* tile = (LAS float*)ldsl;
    const int tid = tid_now(), c = sgpr_now((int)blockIdx.x), G = gridDim.x;
    CvJob cur, nxt; f32x4 v[8], w[8];
    bool have = cv_job(p, layer, c, cur);
    if (have) cv_load(cur, tid, v);
    for (int t = c; have; t += G) {
        const bool hn = cv_job(p, layer, t + G, nxt);
        if (hn) cv_load(nxt, tid, w);
        __syncthreads();
        { const int n4 = tid & 15, kr = tid >> 4;
#pragma unroll
          for (int r = 0; r < 8; ++r) { LAS float* d = tile + (kr + 32 * r) * 65 + 4 * n4; d[0] = v[r][0]; d[1] = v[r][1]; d[2] = v[r][2]; d[3] = v[r][3]; } }
        __syncthreads();
        { const int kk = (tid & 127) * 2, nn = tid >> 7;
#pragma unroll
          for (int r = 0; r < 16; ++r) { const int n = nn + 4 * r;
              *(unsigned*)(cur.Bt + (size_t)cv_omap(cur.kind, cur.aux, cur.n0 + n) * cur.ldbt + cur.k0 + kk) = cvt_pk_bf16(tile[kk * 65 + n], tile[(kk + 1) * 65 + n]); } }
        have = hn; cur = nxt;
#pragma unroll
        for (int r = 0; r < 8; ++r) v[r] = w[r];
    }
    __syncthreads();
}

__device__ __forceinline__ float wsum(float v, int lane) {
#pragma unroll
    for (int o = 32; o > 0; o >>= 1) v += shx(v, o, lane);
    return v; }
template <int MODE>
__device__ __forceinline__ void ph_rows(const P& p, int layer) {
    const int lane = tid_now() & 63, gw = blockIdx.x * 8 + (tid_now() >> 6), nw = gridDim.x * 8;
    const float* gp = MODE == 0 ? p.ln0_g : MODE == 1 ? p.ln1_g + layer * D : MODE == 2 ? p.ln2_g + layer * D : p.ln3_g + layer * D;
    const float* bp = MODE == 0 ? p.ln0_b : MODE == 1 ? p.ln1_b + layer * D : MODE == 2 ? p.ln2_b + layer * D : p.ln3_b + layer * D;
    f32x4 gg[4], bb[4];
#pragma unroll
    for (int i = 0; i < 4; ++i) { gg[i] = *(const f32x4*)(gp + 256 * i + 4 * lane); bb[i] = *(const f32x4*)(bp + 256 * i + 4 * lane); }
    const float* in = MODE == 0 ? p.x : p.X;
    float* outf = (MODE == 3 && layer == DEPTH - 1) ? p.out : p.X;
    for (int row = gw; row < T; row += nw) {
        f32x4 v[4];
#pragma unroll
        for (int i = 0; i < 4; ++i) v[i] = *(const f32x4*)(in + (size_t)row * D + 256 * i + 4 * lane);
        if constexpr (MODE == 3) {
#pragma unroll
            for (int i = 0; i < 4; ++i) { const u32x2 dd = *(const u32x2*)(p.Db + (size_t)row * D + 256 * i + 4 * lane);
                v[i][0] = DN_ALPHA * v[i][0] + bflo(dd[0]); v[i][1] = DN_ALPHA * v[i][1] + bfhi(dd[0]); v[i][2] = DN_ALPHA * v[i][2] + bflo(dd[1]); v[i][3] = DN_ALPHA * v[i][3] + bfhi(dd[1]); } }
        if constexpr (MODE == 2) { const float w0 = p.ew[2 * row], w1 = p.ew[2 * row + 1];
#pragma unroll
            for (int i = 0; i < 4; ++i) { const u32x2 y0 = *(const u32x2*)(p.Ys + (size_t)(2 * row) * D + 256 * i + 4 * lane), y1 = *(const u32x2*)(p.Ys + (size_t)(2 * row + 1) * D + 256 * i + 4 * lane);
                v[i][0] = DN_ALPHA * v[i][0] + (w0 * bflo(y0[0]) + w1 * bflo(y1[0])); v[i][1] = DN_ALPHA * v[i][1] + (w0 * bfhi(y0[0]) + w1 * bfhi(y1[0]));
                v[i][2] = DN_ALPHA * v[i][2] + (w0 * bflo(y0[1]) + w1 * bflo(y1[1])); v[i][3] = DN_ALPHA * v[i][3] + (w0 * bfhi(y0[1]) + w1 * bfhi(y1[1])); } }
        float s = 0.f;
#pragma unroll
        for (int i = 0; i < 4; ++i) s += (v[i][0] + v[i][1]) + (v[i][2] + v[i][3]);
        const float mu = wsum(s, lane) * (1.f / D);
        float q = 0.f;
#pragma unroll
        for (int i = 0; i < 4; ++i) { v[i] = v[i] - mu; q += (v[i][0] * v[i][0] + v[i][1] * v[i][1]) + (v[i][2] * v[i][2] + v[i][3] * v[i][3]); }
        const float rs = rsqrtf(wsum(q, lane) * (1.f / D) + 1e-5f);
#pragma unroll
        for (int i = 0; i < 4; ++i) { v[i] = v[i] * rs * gg[i] + bb[i];
            *(f32x4*)(outf + (size_t)row * D + 256 * i + 4 * lane) = v[i];
            u32x2 o = {cvt_pk_bf16(v[i][0], v[i][1]), cvt_pk_bf16(v[i][2], v[i][3])};
            *(u32x2*)(p.Xb + (size_t)row * D + 256 * i + 4 * lane) = o; }
        if constexpr (MODE == 1) {
            const float* wg = p.w_grp + (size_t)layer * D * 8; const float* we = p.w_exp + (size_t)layer * D * 64;
            float gl[8];
#pragma unroll
            for (int g = 0; g < 8; ++g) gl[g] = 0.f;
#pragma unroll
            for (int i = 0; i < 4; ++i)
#pragma unroll
                for (int j = 0; j < 4; ++j) { const int k = 256 * i + 4 * lane + j; const f32x4 a = *(const f32x4*)(wg + k * 8), b = *(const f32x4*)(wg + k * 8 + 4); const float xv = v[i][j];
                    gl[0] = fmaf(xv, a[0], gl[0]); gl[1] = fmaf(xv, a[1], gl[1]); gl[2] = fmaf(xv, a[2], gl[2]); gl[3] = fmaf(xv, a[3], gl[3]);
                    gl[4] = fmaf(xv, b[0], gl[4]); gl[5] = fmaf(xv, b[1], gl[5]); gl[6] = fmaf(xv, b[2], gl[6]); gl[7] = fmaf(xv, b[3], gl[7]); }
            float mx = -INFINITY; int gt = 0;
#pragma unroll
            for (int g = 0; g < 8; ++g) { gl[g] = wsum(gl[g], lane) + p.b_grp[layer * 8 + g]; if (gl[g] > mx) { mx = gl[g]; gt = g; } }
            gt = __builtin_amdgcn_readfirstlane(gt);
            float sum = 0.f;
#pragma unroll
            for (int g = 0; g < 8; ++g) sum += expf(gl[g] - mx);
            const float pg = 1.f / sum;
            float el[8];
#pragma unroll
            for (int e = 0; e < 8; ++e) el[e] = 0.f;
#pragma unroll
            for (int i = 0; i < 4; ++i)
#pragma unroll
                for (int j = 0; j < 4; ++j) { const int k = 256 * i + 4 * lane + j; const f32x4 a = *(const f32x4*)(we + k * 64 + gt * 8), b = *(const f32x4*)(we + k * 64 + gt * 8 + 4); const float xv = v[i][j];
                    el[0] = fmaf(xv, a[0], el[0]); el[1] = fmaf(xv, a[1], el[1]); el[2] = fmaf(xv, a[2], el[2]); el[3] = fmaf(xv, a[3], el[3]);
                    el[4] = fmaf(xv, b[0], el[4]); el[5] = fmaf(xv, b[1], el[5]); el[6] = fmaf(xv, b[2], el[6]); el[7] = fmaf(xv, b[3], el[7]); }
            float v1 = -INFINITY, v2 = -INFINITY; int i1 = 0, i2 = 0;
#pragma unroll
            for (int e = 0; e < 8; ++e) { const float vv = wsum(el[e], lane) + p.b_exp[layer * 64 + gt * 8 + e];
                if (vv > v1) { v2 = v1; i2 = i1; v1 = vv; i1 = e; } else if (vv > v2) { v2 = vv; i2 = e; } }
            if (lane == 0) { const float e2 = expf(v2 - v1), w1 = pg / (1.f + e2), w2 = pg * e2 / (1.f + e2);
                const int ea = gt * 8 + i1, eb = gt * 8 + i2; int* cn = p.cnt + layer * 64;
                p.ew[2 * row] = w1; p.ew[2 * row + 1] = w2;
                const int pa = atomicAdd(&cn[ea], 1); p.lists[ea * LCAP + pa] = 2 * row;
                const int pb = atomicAdd(&cn[eb], 1); p.lists[eb * LCAP + pb] = 2 * row + 1; }
        }
    }
}

__device__ __forceinline__ void wsum8(float (&x)[8], int lane) {
    float y[4], z[2], w;
#pragma unroll
    for (int k = 0; k < 4; ++k) { const bool hi = lane & 32; const float snd = hi ? x[k] : x[k + 4], keep = hi ? x[k + 4] : x[k]; y[k] = keep + shx(snd, 32, lane); }
#pragma unroll
    for (int k = 0; k < 2; ++k) { const bool hi = lane & 16; const float snd = hi ? y[k] : y[k + 2], keep = hi ? y[k + 2] : y[k]; z[k] = keep + shx(snd, 16, lane); }
    { const bool hi = lane & 8; const float snd = hi ? z[0] : z[1], keep = hi ? z[1] : z[0]; w = keep + shx(snd, 8, lane); }
    w += shx(w, 4, lane); w += shx(w, 2, lane); w += shx(w, 1, lane);
#pragma unroll
    for (int k = 0; k < 8; ++k) x[k] = __int_as_float(__builtin_amdgcn_readlane(__float_as_int(w), (k >> 2) * 32 + ((k >> 1) & 1) * 16 + (k & 1) * 8));
}
__device__ __forceinline__ void ph_ln1_router(const P& p, int layer) {
    constexpr int RR = 2;
    const int tid = tid_now(), lane0 = tid & 63, gw = sgpr_now((int)blockIdx.x) * 8 + (tid >> 6), nw = gridDim.x * 8;
    const float* gp = p.ln1_g + layer * D; const float* bp = p.ln1_b + layer * D;
    const float* wg = p.w_grp + (size_t)layer * D * 8; const float* we = p.w_exp + (size_t)layer * D * 64;
    for (int row0 = gw * RR; row0 < T; row0 += nw * RR) {
        int lane = lane0; asm volatile("" : "+v"(lane));
        f32x4 v[RR][4];
#pragma unroll
        for (int r = 0; r < RR; ++r)
#pragma unroll
            for (int i = 0; i < 4; ++i) { v[r][i] = *(const f32x4*)(p.X + (size_t)(row0 + r) * D + 256 * i + 4 * lane);
                const u32x2 dd = *(const u32x2*)(p.Db + (size_t)(row0 + r) * D + 256 * i + 4 * lane);
                v[r][i][0] = DN_ALPHA * v[r][i][0] + bflo(dd[0]); v[r][i][1] = DN_ALPHA * v[r][i][1] + bfhi(dd[0]); v[r][i][2] = DN_ALPHA * v[r][i][2] + bflo(dd[1]); v[r][i][3] = DN_ALPHA * v[r][i][3] + bfhi(dd[1]); }
#pragma unroll
        for (int r = 0; r < RR; ++r) {
            float s = 0.f;
#pragma unroll
            for (int i = 0; i < 4; ++i) s += (v[r][i][0] + v[r][i][1]) + (v[r][i][2] + v[r][i][3]);
            const float mu = wsum(s, lane) * (1.f / D);
            float q = 0.f;
#pragma unroll
            for (int i = 0; i < 4; ++i) { v[r][i] = v[r][i] - mu; q += (v[r][i][0] * v[r][i][0] + v[r][i][1] * v[r][i][1]) + (v[r][i][2] * v[r][i][2] + v[r][i][3] * v[r][i][3]); }
            const float rs = rsqrtf(wsum(q, lane) * (1.f / D) + 1e-5f);
#pragma unroll
            for (int i = 0; i < 4; ++i) { const f32x4 gg = *(const f32x4*)(gp + 256 * i + 4 * lane), bb = *(const f32x4*)(bp + 256 * i + 4 * lane);
                v[r][i] = v[r][i] * rs * gg + bb;
                *(f32x4*)(p.X + (size_t)(row0 + r) * D + 256 * i + 4 * lane) = v[r][i];
                u32x2 o = {cvt_pk_bf16(v[r][i][0], v[r][i][1]), cvt_pk_bf16(v[r][i][2], v[r][i][3])};
                *(u32x2*)(p.Xb + (size_t)(row0 + r) * D + 256 * i + 4 * lane) = o; } }
        float gl[RR][8];
#pragma unroll
        for (int r = 0; r < RR; ++r)
#pragma unroll
            for (int g = 0; g < 8; ++g) gl[r][g] = 0.f;
#pragma unroll
        for (int i = 0; i < 4; ++i) { asm volatile("" : "+v"(lane) :: "memory");
#pragma unroll
            for (int j = 0; j < 4; ++j) { const int k = 256 * i + 4 * lane + j; const f32x4 a = *(const f32x4*)(wg + k * 8), b = *(const f32x4*)(wg + k * 8 + 4);
#pragma unroll
                for (int r = 0; r < RR; ++r) { const float xv = v[r][i][j];
                    gl[r][0] = fmaf(xv, a[0], gl[r][0]); gl[r][1] = fmaf(xv, a[1], gl[r][1]); gl[r][2] = fmaf(xv, a[2], gl[r][2]); gl[r][3] = fmaf(xv, a[3], gl[r][3]);
                    gl[r][4] = fmaf(xv, b[0], gl[r][4]); gl[r][5] = fmaf(xv, b[1], gl[r][5]); gl[r][6] = fmaf(xv, b[2], gl[r][6]); gl[r][7] = fmaf(xv, b[3], gl[r][7]); } } }
        int gt[RR]; float pg[RR];
#pragma unroll
        for (int r = 0; r < RR; ++r) { wsum8(gl[r], lane);
            float mx = -INFINITY; int gi = 0;
#pragma unroll
            for (int g = 0; g < 8; ++g) { gl[r][g] += p.b_grp[layer * 8 + g]; if (gl[r][g] > mx) { mx = gl[r][g]; gi = g; } }
            float sum = 0.f;
#pragma unroll
            for (int g = 0; g < 8; ++g) sum += expf(gl[r][g] - mx);
            gt[r] = __builtin_amdgcn_readfirstlane(gi); pg[r] = 1.f / sum; }
        float el[RR][8];
#pragma unroll
        for (int r = 0; r < RR; ++r) {
#pragma unroll
            for (int e = 0; e < 8; ++e) el[r][e] = 0.f;
#pragma unroll
            for (int i = 0; i < 4; ++i) { asm volatile("" : "+v"(lane) :: "memory");
#pragma unroll
                for (int j = 0; j < 4; ++j) { const int k = 256 * i + 4 * lane + j; const f32x4 a = *(const f32x4*)(we + k * 64 + gt[r] * 8), b = *(const f32x4*)(we + k * 64 + gt[r] * 8 + 4); const float xv = v[r][i][j];
                    el[r][0] = fmaf(xv, a[0], el[r][0]); el[r][1] = fmaf(xv, a[1], el[r][1]); el[r][2] = fmaf(xv, a[2], el[r][2]); el[r][3] = fmaf(xv, a[3], el[r][3]);
                    el[r][4] = fmaf(xv, b[0], el[r][4]); el[r][5] = fmaf(xv, b[1], el[r][5]); el[r][6] = fmaf(xv, b[2], el[r][6]); el[r][7] = fmaf(xv, b[3], el[r][7]); } } }
#pragma unroll
        for (int r = 0; r < RR; ++r) { wsum8(el[r], lane);
            float v1 = -INFINITY, v2 = -INFINITY; int i1 = 0, i2 = 0;
#pragma unroll
            for (int e = 0; e < 8; ++e) { const float vv = el[r][e] + p.b_exp[layer * 64 + gt[r] * 8 + e];
                if (vv > v1) { v2 = v1; i2 = i1; v1 = vv; i1 = e; } else if (vv > v2) { v2 = vv; i2 = e; } }
            if (lane == 0) { const int row = row0 + r; const float e2 = expf(v2 - v1), w1 = pg[r] / (1.f + e2), w2 = pg[r] * e2 / (1.f + e2);
                const int ea = gt[r] * 8 + i1, eb = gt[r] * 8 + i2; int* cn = p.cnt + layer * 64;
                p.ew[2 * row] = w1; p.ew[2 * row + 1] = w2;
                const int pa = atomicAdd(&cn[ea], 1); p.lists[ea * LCAP + pa] = 2 * row;
                const int pb = atomicAdd(&cn[eb], 1); p.lists[eb * LCAP + pb] = 2 * row + 1; } }
    }
}
__device__ __forceinline__ void ph_prologue(const P& p) {
    const int gtid = blockIdx.x * NTHR + tid_now(), gth = gridDim.x * NTHR;
    for (int idx = gtid; idx < T * 32; idx += gth) { const int t = idx >> 5, i = idx & 31;
        const float inv = (float)(1.0 / pow(10000.0, (double)(2 * i) / 64.0)); const float ang = (float)p.pos[t] * inv;
        p.cs[idx] = (float)cos((double)ang); p.sn[idx] = (float)sin((double)ang); }
    for (size_t i = gtid; i < (size_t)DEPTH * T * PLE / 4; i += gth) { const f32x4 v = ((const f32x4*)p.pin)[i]; u32x2 o = {cvt_pk_bf16(v[0], v[1]), cvt_pk_bf16(v[2], v[3])}; ((u32x2*)p.Pb)[i] = o; }
    ph_rows<0>(p, 0);
}

struct SchedBr { __device__ __forceinline__ bool carry(const ge::Unit& u) const { return u.g < 2; }
    const char* Ya; const char* Yb; const char* Yc; const char* W; int c, G;
    __device__ __forceinline__ bool next(int i, ge::Unit& u) const { const int tile = (i / 3) * G + c; if (tile >= 256) return false; u.g = i % 3; ge::tile_order(tile, 64, 4, u.pm, u.pn); return true; }
    __device__ __forceinline__ const char* aptr(const ge::Unit& u) const { return (u.g == 0 ? Ya : u.g == 1 ? Yb : Yc) + (size_t)u.pm * 256 * 512 * 2; }
    __device__ __forceinline__ const char* bptr(const ge::Unit& u) const { return W + ((size_t)u.g * 1024 + u.pn * 256) * 512 * 2; } };
struct EpiBr { const bf16_t* Hp; bf16_t* Mgb;
    __device__ __forceinline__ void operator()(ge::Acc& acc, const ge::Unit& u, int wr, int wc, int fr, int fq) const {
        const int row0 = u.pm * 256 + wr * 64 + fr, col0 = u.pn * 256 + wc * 32 + 8 * fq;
#pragma unroll
        for (int ai = 0; ai < 2; ++ai)
#pragma unroll
            for (int m = 0; m < 4; ++m) { asm volatile("" ::: "memory"); const int row = row0 + ai * 128 + m * 16;
#pragma unroll
                for (int bj = 0; bj < 2; ++bj) { const int col = col0 + bj * 128;
                    const u32x4 gt = *(const u32x4*)(Hp + (size_t)row * HW + H_GTA + u.g * 1024 + col);
                    f32x4 s0 = {bflo(gt[0]), bfhi(gt[0]), bflo(gt[1]), bfhi(gt[1])}, s1 = {bflo(gt[2]), bfhi(gt[2]), bflo(gt[3]), bfhi(gt[3])};
                    if (u.g < 2) { const u32x4 gn = *(const u32x4*)(Hp + (size_t)row * HW + H_GTA + (u.g + 1) * 1024 + col);
                        f32x4 d0 = {bflo(gn[0]), bfhi(gn[0]), bflo(gn[1]), bfhi(gn[1])}, d1 = {bflo(gn[2]), bfhi(gn[2]), bflo(gn[3]), bfhi(gn[3])};
#pragma unroll
                        for (int j = 0; j < 4; ++j) { s0[j] = s0[j] * frcp(d0[j]); s1[j] = s1[j] * frcp(d1[j]); } }
                    acc[ai][bj][m][0] = acc[ai][bj][m][0] * s0; acc[ai][bj][m][1] = acc[ai][bj][m][1] * s1;
                    if (u.g == 2) { const f32x4 v0 = acc[ai][bj][m][0], v1 = acc[ai][bj][m][1];
                        u32x4 o = {cvt_pk_bf16(v0[0], v0[1]), cvt_pk_bf16(v0[2], v0[3]), cvt_pk_bf16(v1[0], v1[1]), cvt_pk_bf16(v1[2], v1[3])}; *(u32x4*)(Mgb + (size_t)row * D + col) = o; } } }
    } };
struct SchedT4 : ge::NoCarry { const char* A; const char* B; int lda2, ldb2, c, G;
    __device__ __forceinline__ bool next(int i, ge::Unit& u) const { const int L = i * G + c; if (L >= 256) return false; u.g = 0; ge::tile_order(L, 64, 4, u.pm, u.pn); return true; }
    __device__ __forceinline__ const char* aptr(const ge::Unit& u) const { return A + (size_t)u.pm * lda2; }
    __device__ __forceinline__ const char* bptr(const ge::Unit& u) const { return B + (size_t)u.pn * ldb2; } };
struct EpiRes { bf16_t* Db;
    __device__ __forceinline__ void operator()(ge::Acc& acc, const ge::Unit& u, int wr, int wc, int fr, int fq) const {
        const int row0 = u.pm * 256 + wr * 64 + fr, col0 = u.pn * 256 + wc * 32 + 8 * fq;
#pragma unroll
        for (int ai = 0; ai < 2; ++ai)
#pragma unroll
            for (int m = 0; m < 4; ++m) { const size_t o = (size_t)(row0 + ai * 128 + m * 16) * D + col0;
#pragma unroll
                for (int bj = 0; bj < 2; ++bj) { const f32x4 v0 = acc[ai][bj][m][0], v1 = acc[ai][bj][m][1];
                    u32x4 w = {cvt_pk_bf16(v0[0], v0[1]), cvt_pk_bf16(v0[2], v0[3]), cvt_pk_bf16(v1[0], v1[1]), cvt_pk_bf16(v1[2], v1[3])}; *(u32x4*)(Db + o + bj * 128) = w; } }
    } };
struct EpiU { bf16_t* Ub;
    __device__ __forceinline__ void operator()(ge::Acc& acc, const ge::Unit& u, int wr, int wc, int fr, int fq) const {
        const int row0 = u.pm * 256 + wr * 64 + fr, col0 = u.pn * 256 + wc * 32 + 8 * fq;
#pragma unroll
        for (int ai = 0; ai < 2; ++ai)
#pragma unroll
            for (int m = 0; m < 4; ++m) { const size_t o = (size_t)(row0 + ai * 128 + m * 16) * D + col0;
#pragma unroll
                for (int bj = 0; bj < 2; ++bj) { const f32x4 v0 = acc[ai][bj][m][0], v1 = acc[ai][bj][m][1];
                    u32x4 w = {cvt_pk_bf16(v0[0], v0[1]), cvt_pk_bf16(v0[2], v0[3]), cvt_pk_bf16(v1[0], v1[1]), cvt_pk_bf16(v1[2], v1[3])}; *(u32x4*)(Ub + o + bj * 128) = w; } }
    } };
struct EpiPle { bf16_t* Db; const bf16_t* Ub; const float* bias;
    __device__ __forceinline__ void operator()(ge::Acc& acc, const ge::Unit& u, int wr, int wc, int fr, int fq) const {
        const int row0 = u.pm * 256 + wr * 64 + fr, col0 = u.pn * 256 + wc * 32 + 8 * fq;
        f32x4 bv[2][2];
#pragma unroll
        for (int bj = 0; bj < 2; ++bj) { bv[bj][0] = *(const f32x4*)(bias + col0 + bj * 128); bv[bj][1] = *(const f32x4*)(bias + col0 + bj * 128 + 4); }
#pragma unroll
        for (int ai = 0; ai < 2; ++ai)
#pragma unroll
            for (int m = 0; m < 4; ++m) { asm volatile("" ::: "memory"); const size_t o = (size_t)(row0 + ai * 128 + m * 16) * D + col0;
#pragma unroll
                for (int bj = 0; bj < 2; ++bj) { const u32x4 uu = *(const u32x4*)(Ub + o + bj * 128);
                    f32x4 g0 = acc[ai][bj][m][0] + bv[bj][0], g1 = acc[ai][bj][m][1] + bv[bj][1];
#pragma unroll
                    for (int j = 0; j < 4; ++j) { g0[j] = frcp(1.f + __expf(-g0[j])); g1[j] = frcp(1.f + __expf(-g1[j])); }
                    const f32x4 u0 = {bflo(uu[0]), bfhi(uu[0]), bflo(uu[1]), bfhi(uu[1])}, u1 = {bflo(uu[2]), bfhi(uu[2]), bflo(uu[3]), bfhi(uu[3])};
                    g0 = g0 * u0; g1 = g1 * u1;
                    u32x4 w = {cvt_pk_bf16(g0[0], g0[1]), cvt_pk_bf16(g0[2], g0[3]), cvt_pk_bf16(g1[0], g1[1]), cvt_pk_bf16(g1[2], g1[3])}; *(u32x4*)(Db + o + bj * 128) = w; } }
    } };

__device__ __forceinline__ void moe_table(LAS unsigned char* lds, const int* cnt) {
    LAS int* te = (LAS int*)(lds + 131072); LAS int* tr = te + 256; LAS int* cl = tr + 256; LAS int* nt = cl + 64;
    __syncthreads();
    if (tid_now() < 64) cl[tid_now()] = cnt[tid_now()];
    __syncthreads();
    if (tid_now() == 0) { int n = 0; for (int e = 0; e < NE; ++e) for (int r = 0; r < cl[e]; r += 256) { te[n] = e; tr[n] = r; ++n; } nt[0] = n; }
    __syncthreads();
}
struct SchedM1 : ge::NoCarry { const char* Xb; const char* W; const int* lists; LAS int* te; int c, G;
    __device__ __forceinline__ bool next(int i, ge::Unit& u) const { const int L = i * G + c; if (L >= 2 * te[576]) return false; u.pm = L >> 1; u.pn = L & 1; u.g = te[u.pm]; return true; }
    __device__ __forceinline__ int arow(const ge::Unit& u, int r) const { const int n = te[512 + u.g], idx = min(te[256 + u.pm] + r, n - 1); return lists[u.g * LCAP + idx] >> 1; }
    __device__ __forceinline__ const char* aptr(const ge::Unit&) const { return Xb; }
    __device__ __forceinline__ const char* bptr(const ge::Unit& u) const { return W + ((size_t)u.g * 512 + u.pn * 256) * D * 2; } };
struct EpiM1 { bf16_t* Hbuf;
    __device__ __forceinline__ void operator()(ge::Acc& acc, const ge::Unit& u, int wr, int wc, int fr, int fq) const {
#pragma unroll
        for (int ai = 0; ai < 2; ++ai)
#pragma unroll
            for (int m = 0; m < 4; ++m) { const int row = ai * 128 + wr * 64 + m * 16 + fr;
                float h[8];
#pragma unroll
                for (int n = 0; n < 2; ++n)
#pragma unroll
                    for (int j = 0; j < 4; ++j) { const float g = acc[ai][0][m][n][j], uu = acc[ai][1][m][n][j]; h[4 * n + j] = g * frcp(1.f + __expf(-g)) * uu; }
                u32x4 o = {cvt_pk_bf16(h[0], h[1]), cvt_pk_bf16(h[2], h[3]), cvt_pk_bf16(h[4], h[5]), cvt_pk_bf16(h[6], h[7])};
                *(u32x4*)(Hbuf + ((size_t)u.pm * 256 + row) * EH + u.pn * 128 + wc * 32 + 8 * fq) = o; }
    } };
struct SchedM2 : ge::NoCarry { const char* Hb; const char* W; LAS int* te; int c, G;
    __device__ __forceinline__ bool next(int i, ge::Unit& u) const { const int L = i * G + c; if (L >= 4 * te[576]) return false; u.pm = L >> 2; u.pn = L & 3; u.g = te[u.pm]; return true; }
    __device__ __forceinline__ const char* aptr(const ge::Unit& u) const { return Hb + (size_t)u.pm * 256 * EH * 2; }
    __device__ __forceinline__ const char* bptr(const ge::Unit& u) const { return W + ((size_t)u.g * D + u.pn * 256) * EH * 2; } };
struct EpiM2 { bf16_t* Ys; const int* lists; LAS int* te;
    __device__ __forceinline__ void operator()(ge::Acc& acc, const ge::Unit& u, int wr, int wc, int fr, int fq) const {
        const int r0 = te[256 + u.pm], n = te[512 + u.g];
#pragma unroll
        for (int ai = 0; ai < 2; ++ai)
#pragma unroll
            for (int m = 0; m < 4; ++m) { const int row = r0 + ai * 128 + wr * 64 + m * 16 + fr;
                if (row < n) { const int a = lists[u.g * LCAP + row];
#pragma unroll
                    for (int bj = 0; bj < 2; ++bj) { const f32x4 v0 = acc[ai][bj][m][0], v1 = acc[ai][bj][m][1];
                        u32x4 o = {cvt_pk_bf16(v0[0], v0[1]), cvt_pk_bf16(v0[2], v0[3]), cvt_pk_bf16(v1[0], v1[1]), cvt_pk_bf16(v1[2], v1[3])};
                        *(u32x4*)(Ys + (size_t)a * D + u.pn * 256 + bj * 128 + wc * 32 + 8 * fq) = o; } } }
    } };

#define XB_TMO      128
#define XB_XCNT(j)  (256  + 64 * (j))
#define XB_XSUB(j)  (1280 + 64 * (j))
#define XB_XGEN(j)  (2304 + 64 * (j))
#define XB_TOP      3328
#define XB_TOPGEN   3392
#define XCD_BAR_WORDS 3456
#define XB_SPIN_CAP (1u << 18)

__device__ __forceinline__ unsigned xb_ld(unsigned* p)              { return __hip_atomic_load(p, __ATOMIC_RELAXED, __HIP_MEMORY_SCOPE_AGENT); }
__device__ __forceinline__ unsigned xb_add(unsigned* p, unsigned v) { return __hip_atomic_fetch_add(p, v, __ATOMIC_RELAXED, __HIP_MEMORY_SCOPE_AGENT); }
__device__ __forceinline__ unsigned xb_xcc_id() { return (unsigned)__builtin_amdgcn_s_getreg((3 << 11) | 20) & 0xFu; }
#define XB_SPIN(cond, bar) do { unsigned _sp = 0; while (cond) { __builtin_amdgcn_s_sleep(1); \
    if ((++_sp & 255u) == 0u) { if (xb_ld(&(bar)[XB_TMO])) break; if (_sp > XB_SPIN_CAP) { atomicAdd(&(bar)[XB_TMO], 1u); break; } } } } while (0)

struct XcdBarrier {
    unsigned* bar; unsigned x;
    volatile LAS unsigned* st;
};

__device__ __forceinline__ XcdBarrier xcd_barrier_post(unsigned* bar, volatile LAS unsigned* st) {
    XcdBarrier b; b.bar = bar; b.x = xb_xcc_id(); b.st = st;
    if (threadIdx.x == 0) (void)xb_add(&bar[XB_XCNT(b.x)], 1u);
    return b;
}
__device__ __forceinline__ void xcd_barrier_complete(unsigned* bar, unsigned x, unsigned& nloc, unsigned& nx) {
    const unsigned G = gridDim.x * gridDim.y * gridDim.z;
    unsigned sum, cnt, mine, sp = 0u;
    for (;;) {
        sum = 0u; cnt = 0u; mine = 0u;
#pragma unroll
        for (unsigned j = 0; j < 16; ++j) { const unsigned c = xb_ld(&bar[XB_XCNT(j)]); sum += c; cnt += (c > 0u) ? 1u : 0u; mine = (j == x) ? c : mine; }
        if (sum == G) break;
        __builtin_amdgcn_s_sleep(1);
        if ((++sp & 255u) == 0u) { if (xb_ld(&bar[XB_TMO])) break; if (sp > XB_SPIN_CAP) { atomicAdd(&bar[XB_TMO], 1u); break; } }
    }
    nloc = mine > 0u ? mine : 1u; nx = cnt > 0u ? cnt : 1u;
}

__device__ __forceinline__ void xcd_barrier(const XcdBarrier& b) {
    asm volatile("s_waitcnt vmcnt(0)" ::: "memory");
    __syncthreads();
    if (threadIdx.x == 0) {
        unsigned* bar = b.bar;
        __builtin_amdgcn_s_waitcnt(0);
        unsigned nloc = b.st[0], nx = b.st[1];
        if (nloc == 0u) { xcd_barrier_complete(bar, b.x, nloc, nx); b.st[0] = nloc; b.st[1] = nx; }
        const unsigned old = xb_add(&bar[XB_XSUB(b.x)], 1u);
        const unsigned gen = old / nloc;
        if (old + 1u == (gen + 1u) * nloc) {
            __builtin_amdgcn_fence(__ATOMIC_RELEASE, "agent");
            asm volatile("s_waitcnt vmcnt(0)" ::: "memory");
            const unsigned og = xb_add(&bar[XB_TOP], 1u);
            const unsigned tg = og / nx;
            if (og + 1u == (tg + 1u) * nx) xb_add(&bar[XB_TOPGEN], 1u);
            else XB_SPIN(xb_ld(&bar[XB_TOPGEN]) == tg, bar);
            __builtin_amdgcn_fence(__ATOMIC_ACQUIRE, "agent");
            xb_add(&bar[XB_XGEN(b.x)], 1u);
            asm volatile("s_waitcnt vmcnt(0)" ::: "memory");
        } else {
            XB_SPIN(xb_ld(&bar[XB_XGEN(b.x)]) == gen, bar);
            __builtin_amdgcn_fence(__ATOMIC_ACQUIRE, "agent");
            asm volatile("s_waitcnt vmcnt(0)" ::: "memory");
        }
    }
    __syncthreads();
}

enum { PH_PRO = 0, PH_CONV, PH_IN, PH_PREP_Q, PH_PREP_K, PH_PREP_V, PH_PREP_G, PH_ATT, PH_FIN, PH_BR, PH_WO, PH_LN1, PH_M1, PH_M2, PH_LN2, PH_PLE, PH_LN3 };
template <int PH> __global__ __launch_bounds__(NTHR, 2) void k_ph(P p, int layer) {
    extern __shared__ __attribute__((aligned(16))) unsigned char smem[];
    LAS unsigned char* lds = (LAS unsigned char*)smem;
    tid_setup();
    const int c = blockIdx.x, G = gridDim.x;
    if constexpr (PH == PH_PRO) ph_prologue(p);
    if constexpr (PH == PH_CONV) ph_convert(lds, p, layer);
    if constexpr (PH == PH_IN) { const MegaP m = mk_mega(p); SchedIn S{{}, (const char*)m.Xb, (const char*)m.Wb_in, (const char*)m.Wb_gv, c, G, 0}; EpiIn<2> E{m.Hp, m.GVt, m.ssq_q, m.ssq_kv}; ge::gemm_stream<EpiIn<2>, SchedIn, false>(lds, D, D, D, S, E); }
    if constexpr (PH == PH_PREP_Q) { const MlaP q = mk_mla(p); SchedMla<0> S{{}, (const char*)(q.Hp + H_CQ), (const char*)q.Wb_uq, c, G}; EpiMla<0> E{q}; ge::gemm_stream<EpiMla<0>, SchedMla<0>, false>(lds, 256, HW, 256, S, E); }
    if constexpr (PH == PH_PREP_K) { const MlaP q = mk_mla(p); SchedMla<1> S{{}, (const char*)(q.Hp + H_CKV), (const char*)q.Wb_uk, (c + 64) % G, G}; EpiMla<1> E{q}; ge::gemm_stream<EpiMla<1>, SchedMla<1>, false>(lds, 256, HW, 256, S, E); }
    if constexpr (PH == PH_PREP_V) { const MlaP q = mk_mla(p); SchedMla<2> S{{}, (const char*)q.Wb_uv, (const char*)(q.Hp + H_CKV), (c + 192) % G, G}; EpiMla<2> E{q}; ge::gemm_stream<EpiMla<2>, SchedMla<2>, false>(lds, 256, 256, HW, S, E); }
    if constexpr (PH == PH_PREP_G) { { const MegaP m = mk_mega(p); SchedIn S{{}, (const char*)m.Xb, (const char*)m.Wb_in, (const char*)m.Wb_gv, (c + 128) % G, G, 1}; EpiIn<0> E{m.Hp, m.GVt, m.ssq_q, m.ssq_kv}; ge::gemm_stream<EpiIn<0>, SchedIn, false>(lds, D, D, D, S, E); } const MlaP q = mk_mla(p); kr_phase(q, c * NTHR + tid_now(), G * NTHR); const GlaP g = mk_gla(p, layer); gla_g1(lds, g, c, G); }
    if constexpr (PH == PH_ATT) { const GlaP g = mk_gla(p, layer); gla_g2(lds, g, c); const MlaP q = mk_mla(p); attn_phase(lds, q, c); }
    if constexpr (PH == PH_FIN) { const GlaP g = mk_gla(p, layer); gla_g3(lds, g, c, G); conv_phase(g, c * NTHR + tid_now(), G * NTHR); attn_combine_bf16(g, c * NTHR + tid_now(), G * NTHR); }
    if constexpr (PH == PH_BR) { SchedBr S{(const char*)p.Yab, (const char*)p.Ybb, (const char*)p.Ycb, (const char*)p.Wb_br, c, G}; EpiBr E{p.Hp, p.Mgb}; ge::gemm_stream<EpiBr, SchedBr, false>(lds, 512, 512, 512, S, E); }
    if constexpr (PH == PH_WO) { SchedT4 S{{}, (const char*)p.Mgb, (const char*)p.Wb_o, 256 * D * 2, 256 * D * 2, c, G}; EpiRes E{p.Db}; ge::gemm_stream<EpiRes, SchedT4, false>(lds, D, D, D, S, E); }
    if constexpr (PH == PH_LN1) ph_ln1_router(p, layer);
    if constexpr (PH == PH_M1) { moe_table(lds, p.cnt + layer * 64); LAS int* te = (LAS int*)(lds + 131072);
        SchedM1 S{{}, (const char*)p.Xb, (const char*)p.Wb_gu, p.lists, te, c, G}; EpiM1 E{p.Hbuf}; ge::gemm_stream<EpiM1, SchedM1, true>(lds, D, D, D, S, E); }
    if constexpr (PH == PH_M2) { moe_table(lds, p.cnt + layer * 64); LAS int* te = (LAS int*)(lds + 131072);
        SchedM2 S{{}, (const char*)p.Hbuf, (const char*)p.Wb_d, te, c, G}; EpiM2 E{p.Ys, p.lists, te}; ge::gemm_stream<EpiM2, SchedM2, false>(lds, EH, EH, EH, S, E); }
    if constexpr (PH == PH_LN2) ph_rows<2>(p, layer);
    if constexpr (PH == PH_PLE) {
        { SchedT4 S{{}, (const char*)(p.Pb + (size_t)layer * T * PLE), (const char*)p.Wb_pu, 256 * PLE * 2, 256 * PLE * 2, c, G}; EpiU E{p.Ub}; ge::gemm_stream<EpiU, SchedT4, false>(lds, PLE, PLE, PLE, S, E); }
        { SchedT4 S{{}, (const char*)p.Xb, (const char*)p.Wb_pg, 256 * D * 2, 256 * D * 2, c, G}; EpiPle E{p.Db, p.Ub, p.b_pg + layer * D}; ge::gemm_stream<EpiPle, SchedT4, false>(lds, D, D, D, S, E); } }
    if constexpr (PH == PH_LN3) ph_rows<3>(p, layer);
}


typedef const P __attribute__((address_space(4))) CP;
__device__ __forceinline__ P load_params() { CP* q = (CP*)__builtin_amdgcn_kernarg_segment_ptr(); asm volatile("" : "+s"(q)); return *(const P*)q; }
#define GRID_BAR() do { XcdBarrier b_; b_.bar = load_params().bar; b_.x = xb_xcc_id(); b_.st = xbw; xcd_barrier(b_); } while (0)
__global__ __launch_bounds__(NTHR, 2) void k_mega(P p_arg) {
    extern __shared__ __attribute__((aligned(16))) unsigned char smem[];
    LAS unsigned char* lds = (LAS unsigned char*)smem;
    const int G = NBLK;
#define c sgpr_now((int)blockIdx.x)
    volatile LAS unsigned* xbw = (volatile LAS unsigned*)(lds + XBW_OFF);
    tid_setup();
    if (tid_now() < 4) xbw[tid_now()] = 0u;
    __syncthreads();
    (void)xcd_barrier_post(p_arg.bar, xbw);
    { const P p = load_params(); ph_prologue(p); }
    { const P p = load_params(); ph_convert(lds, p, 0); }
    GRID_BAR();
    for (int layer = 0; layer < DEPTH; ++layer) {
        { const P p = load_params(); const MegaP m = mk_mega(p); SchedIn S{{}, (const char*)m.Xb, (const char*)m.Wb_in, (const char*)m.Wb_gv, c, G, 0}; EpiIn<2> E{m.Hp, m.GVt, m.ssq_q, m.ssq_kv}; ge::gemm_stream<EpiIn<2>, SchedIn, false>(lds, D, D, D, S, E); }
        GRID_BAR();
        { const P p = load_params(); const MlaP q = mk_mla(p);
          { SchedMla<0> S{{}, (const char*)(q.Hp + H_CQ), (const char*)q.Wb_uq, (c >= 128 ? c - 128 : -1), 128}; EpiMla<0> E{q}; ge::gemm_stream<EpiMla<0>, SchedMla<0>, false>(lds, 256, HW, 256, S, E); }
          { SchedMla<1> S{{}, (const char*)(q.Hp + H_CKV), (const char*)q.Wb_uk, (c >= 128 ? c - 128 : -1), 128}; EpiMla<1> E{q}; ge::gemm_stream<EpiMla<1>, SchedMla<1>, false>(lds, 256, HW, 256, S, E); }
          { SchedMla<2> S{{}, (const char*)q.Wb_uv, (const char*)(q.Hp + H_CKV), (c >= 128 ? c - 128 : -1), 128}; EpiMla<2> E{q}; ge::gemm_stream<EpiMla<2>, SchedMla<2>, false>(lds, 256, 256, HW, S, E); }
          { const MegaP m = mk_mega(p); SchedIn S{{}, (const char*)m.Xb, (const char*)m.Wb_in, (const char*)m.Wb_gv, c, G, 1}; EpiIn<0> E{m.Hp, m.GVt, m.ssq_q, m.ssq_kv}; ge::gemm_stream<EpiIn<0>, SchedIn, false>(lds, D, D, D, S, E); }
          kr_phase(q, c * NTHR + tid_now(), G * NTHR);
          const GlaP g = mk_gla(p, layer); gla_g1(lds, g, c, G); }
        GRID_BAR();
        { const P p = load_params(); const GlaP g = mk_gla(p, layer); gla_g2(lds, g, c); const MlaP q = mk_mla(p); attn_phase(lds, q, c); }
        GRID_BAR();
        { const P p = load_params(); const GlaP g = mk_gla(p, layer); gla_g3(lds, g, c, G); conv_phase(g, c * NTHR + tid_now(), G * NTHR); attn_combine_bf16(g, c * NTHR + tid_now(), G * NTHR); }
        GRID_BAR();
        { const P p = load_params(); SchedBr S{(const char*)p.Yab, (const char*)p.Ybb, (const char*)p.Ycb, (const char*)p.Wb_br, c, G}; EpiBr E{p.Hp, p.Mgb}; ge::gemm_stream<EpiBr, SchedBr, false>(lds, 512, 512, 512, S, E); }
        GRID_BAR();
        { const P p = load_params(); SchedT4 S{{}, (const char*)p.Mgb, (const char*)p.Wb_o, 256 * D * 2, 256 * D * 2, c, G}; EpiRes E{p.Db}; ge::gemm_stream<EpiRes, SchedT4, false>(lds, D, D, D, S, E); }
        GRID_BAR();
        { const P p = load_params(); ph_ln1_router(p, layer); }
        GRID_BAR();
        { const P p = load_params(); moe_table(lds, p.cnt + layer * 64); LAS int* te = (LAS int*)(lds + 131072);
          SchedM1 S{{}, (const char*)p.Xb, (const char*)p.Wb_gu, p.lists, te, c, G}; EpiM1 E{p.Hbuf}; ge::gemm_stream<EpiM1, SchedM1, true>(lds, D, D, D, S, E);
          const int extra = max(0, 2 * te[576] - NBLK), cu = c - extra;
          SchedT4 SU{{}, (const char*)(p.Pb + (size_t)layer * T * PLE), (const char*)p.Wb_pu, 256 * PLE * 2, 256 * PLE * 2, cu >= 0 ? cu : 256, NBLK - extra}; EpiU EU{p.Ub};
          ge::gemm_stream<EpiU, SchedT4, false>(lds, PLE, PLE, PLE, SU, EU); }
        GRID_BAR();
        { const P p = load_params(); LAS int* te = (LAS int*)(lds + 131072);
          SchedM2 S{{}, (const char*)p.Hbuf, (const char*)p.Wb_d, te, c, G}; EpiM2 E{p.Ys, p.lists, te}; ge::gemm_stream<EpiM2, SchedM2, false>(lds, EH, EH, EH, S, E); }
        GRID_BAR();
        { const P p = load_params(); ph_rows<2>(p, layer); }
        GRID_BAR();
        { const P p = load_params(); SchedT4 S{{}, (const char*)p.Xb, (const char*)p.Wb_pg, 256 * D * 2, 256 * D * 2, c, G}; EpiPle E{p.Db, p.Ub, p.b_pg + layer * D}; ge::gemm_stream<EpiPle, SchedT4, false>(lds, D, D, D, S, E); }
        GRID_BAR();
        { const P p = load_params(); ph_rows<3>(p, layer); }
        if (layer + 1 < DEPTH) { { const P p = load_params(); ph_convert(lds, p, layer + 1); } GRID_BAR(); }
    }
#undef c
}

template <int PH> static void launch_ph(const P& p, int layer, hipStream_t st) {
    static bool set = false;
    if (!set) { (void)hipFuncSetAttribute((const void*)k_ph<PH>, hipFuncAttributeMaxDynamicSharedMemorySize, LDS_BYTES); set = true; }
    hipLaunchKernelGGL((k_ph<PH>), dim3(NBLK), dim3(NTHR), LDS_BYTES, st, p, layer);
}
extern "C" void kernel_launch(void* const* d_in, const int* in_sizes, int n_in, void* d_out, int out_size, void* d_ws, size_t ws_size, hipStream_t st) {
    (void)in_sizes; (void)n_in; (void)out_size;
    P p{};
    p.x = (const float*)d_in[0]; p.pin = (const float*)d_in[1]; p.pos = (const int*)d_in[2]; p.ln0_g = (const float*)d_in[3]; p.ln0_b = (const float*)d_in[4];
    p.w_in = (const float*)d_in[5]; p.w_conv = (const float*)d_in[6]; p.w_gg = (const float*)d_in[7]; p.b_gg = (const float*)d_in[8]; p.gla_ng = (const float*)d_in[9];
    p.qn_g = (const float*)d_in[10]; p.kvn_g = (const float*)d_in[11]; p.w_uq = (const float*)d_in[12]; p.w_ukv = (const float*)d_in[13]; p.w_br = (const float*)d_in[14]; p.w_o = (const float*)d_in[15];
    p.ln1_g = (const float*)d_in[16]; p.ln1_b = (const float*)d_in[17]; p.w_grp = (const float*)d_in[18]; p.b_grp = (const float*)d_in[19]; p.w_exp = (const float*)d_in[20]; p.b_exp = (const float*)d_in[21];
    p.w_gate = (const float*)d_in[22]; p.w_up = (const float*)d_in[23]; p.w_down = (const float*)d_in[24]; p.ln2_g = (const float*)d_in[25]; p.ln2_b = (const float*)d_in[26];
    p.w_pg = (const float*)d_in[27]; p.b_pg = (const float*)d_in[28]; p.w_pu = (const float*)d_in[29]; p.ln3_g = (const float*)d_in[30]; p.ln3_b = (const float*)d_in[31];
    p.out = (float*)d_out;
    char* w = (char*)d_ws; size_t off = 0;
    auto alloc = [&](size_t bytes) { void* r = w + off; off += (bytes + 255) & ~(size_t)255; return r; };
    p.bar = (unsigned*)alloc(16384); p.cnt = (int*)alloc(DEPTH * 64 * 4);
    const size_t zero_bytes = off;
    p.X = (float*)alloc((size_t)T * D * 4); p.Z = (float*)alloc((size_t)T * D * 4); p.Xb = (bf16_t*)alloc((size_t)T * D * 2); p.Db = (bf16_t*)alloc((size_t)T * D * 2);
    p.cs = (float*)alloc((size_t)T * 32 * 4); p.sn = (float*)alloc((size_t)T * 32 * 4); p.ssq_q = (float*)alloc((size_t)4 * T * 4); p.ssq_kv = (float*)alloc((size_t)4 * T * 4);
    p.Hp = (bf16_t*)alloc((size_t)T * HW * 2); p.GVt = (bf16_t*)alloc((size_t)T * 512 * 2);
    p.Qb = (bf16_t*)alloc((size_t)T * 768 * 2); p.KnImg = (bf16_t*)alloc((size_t)T * 512 * 2); p.VtImg = (bf16_t*)alloc((size_t)T * 512 * 2); p.KrImg = (bf16_t*)alloc((size_t)T * 64 * 2);
    p.MLpart = (float*)alloc((size_t)512 * 256 * 2 * 4);
    p.QE = (bf16_t*)alloc((size_t)T * 256 * 2); p.OI = (float*)alloc((size_t)T * 512 * 4); p.kvT = (float*)alloc((size_t)1024 * 8192 * 4); p.decay = (float*)alloc((size_t)1024 * 64 * 4); p.spT = (bf16_t*)alloc((size_t)1024 * 8192 * 2);
    p.Yab = (bf16_t*)alloc((size_t)T * 512 * 2); p.Ybb = (bf16_t*)alloc((size_t)T * 512 * 2); p.Ycb = (bf16_t*)alloc((size_t)T * 512 * 2); p.Mgb = (bf16_t*)alloc((size_t)T * D * 2);
    p.ew = (float*)alloc((size_t)T * 2 * 4); p.lists = (int*)alloc((size_t)NE * LCAP * 4);
    p.Hbuf = (bf16_t*)alloc((size_t)192 * 256 * EH * 2); p.Ys = (bf16_t*)alloc((size_t)2 * T * D * 2); p.Ub = (bf16_t*)alloc((size_t)T * D * 2); p.Pb = (bf16_t*)alloc((size_t)DEPTH * T * PLE * 2);
    p.Wb_in = (bf16_t*)alloc((size_t)HW * D * 2); p.Wb_gv = (bf16_t*)alloc((size_t)512 * D * 2); p.Wb_uq = (bf16_t*)alloc((size_t)768 * 256 * 2); p.Wb_uk = (bf16_t*)alloc((size_t)512 * 256 * 2); p.Wb_uv = (bf16_t*)alloc((size_t)512 * 256 * 2);
    p.Wb_br = (bf16_t*)alloc((size_t)3 * D * 512 * 2); p.Wb_o = (bf16_t*)alloc((size_t)D * D * 2); p.Wb_gu = (bf16_t*)alloc((size_t)NE * 512 * D * 2); p.Wb_d = (bf16_t*)alloc((size_t)NE * D * EH * 2);
    p.Wb_pg = (bf16_t*)alloc((size_t)D * D * 2); p.Wb_pu = (bf16_t*)alloc((size_t)D * PLE * 2);
    if (off > ws_size) return;
    (void)hipMemsetAsync(d_ws, 0, zero_bytes, st);
#if defined(MULTI_LAUNCH)
    launch_ph<PH_PRO>(p, 0, st);
    for (int i = 0; i < DEPTH; ++i) {
        launch_ph<PH_CONV>(p, i, st); launch_ph<PH_IN>(p, i, st);
        launch_ph<PH_PREP_Q>(p, i, st); launch_ph<PH_PREP_K>(p, i, st); launch_ph<PH_PREP_V>(p, i, st); launch_ph<PH_PREP_G>(p, i, st);
        launch_ph<PH_ATT>(p, i, st); launch_ph<PH_FIN>(p, i, st); launch_ph<PH_BR>(p, i, st); launch_ph<PH_WO>(p, i, st); launch_ph<PH_LN1>(p, i, st);
        launch_ph<PH_M1>(p, i, st); launch_ph<PH_M2>(p, i, st); launch_ph<PH_LN2>(p, i, st); launch_ph<PH_PLE>(p, i, st); launch_ph<PH_LN3>(p, i, st);
    }
#else
    static bool set = false;
    if (!set) { (void)hipFuncSetAttribute((const void*)k_mega, hipFuncAttributeMaxDynamicSharedMemorySize, LDS_BYTES); set = true; }
    hipLaunchKernelGGL(k_mega, dim3(NBLK), dim3(NTHR), LDS_BYTES, st, p);
#endif
}
```

```cpp
#include <hip/hip_runtime.h>
#include <hip/hip_bf16.h>
#include <stdint.h>

constexpr int T = 16384, D = 1024, DEPTH = 4, PLE = 256;
constexpr int NE = 64, EH = 256;
constexpr int INW = 6608;
constexpr int O_GV = 2048;
constexpr float DN_ALPHA = 1.681792830507429f;
constexpr int LCAP = 32768;
#define LAS __attribute__((address_space(3)))
typedef unsigned short bf16_t;
typedef short bf16x8 __attribute__((ext_vector_type(8)));
typedef float f32x4 __attribute__((ext_vector_type(4)));
typedef float f32x16 __attribute__((ext_vector_type(16)));
typedef unsigned u32x4 __attribute__((ext_vector_type(4)));
typedef unsigned u32x2 __attribute__((ext_vector_type(2)));
typedef float f32x2 __attribute__((ext_vector_type(2)));
constexpr int NBLK = 256, NTHR = 512;
constexpr int STAGE_BYTES = 131072, LDS_BYTES = 147456 + 512, XBW_OFF = 147456 + 256;
constexpr int HW = 6144;
constexpr int H_AB = 0, H_AC = 512, H_AX = 1024, H_GQ = 1536, H_GK = 1792, H_GR = 2048, H_CQ = 2560, H_CKV = 2816, H_KR = 2944, H_GLR = 3008, H_GTA = 3072, H_GTB = 4096, H_GTC = 5120;

__device__ __forceinline__ unsigned cvt_pk_bf16(float lo, float hi) { unsigned r; asm volatile("v_cvt_pk_bf16_f32 %0, %1, %2" : "=v"(r) : "v"(lo), "v"(hi)); return r; }
constexpr int WTAB_OFF = 147456;
__device__ __forceinline__ int tid_now() {
    const unsigned hw = (unsigned)__builtin_amdgcn_s_getreg((5 << 11) | 4) & 63u;
    extern __shared__ __attribute__((aligned(16))) unsigned char smem_tid[];
    const int w = __builtin_amdgcn_readfirstlane(*(volatile LAS int*)((LAS unsigned char*)smem_tid + WTAB_OFF + 4 * hw));
    int l = (int)__builtin_amdgcn_mbcnt_hi(~0u, __builtin_amdgcn_mbcnt_lo(~0u, 0u));
    asm volatile("" : "+v"(l));
    return w * 64 + l; }
__device__ __forceinline__ void tid_setup() {
    const unsigned hw = (unsigned)__builtin_amdgcn_s_getreg((5 << 11) | 4) & 63u;
    extern __shared__ __attribute__((aligned(16))) unsigned char smem_tid[];
    if ((threadIdx.x & 63) == 0) *(volatile LAS int*)((LAS unsigned char*)smem_tid + WTAB_OFF + 4 * hw) = (int)(threadIdx.x >> 6);
    __syncthreads(); }
__device__ __forceinline__ int sgpr_now(int v) { asm volatile("" : "+s"(v)); return v; }
__device__ __forceinline__ float shx(float v, int mask, int lane) { return __int_as_float(__builtin_amdgcn_ds_bpermute((lane ^ mask) << 2, __float_as_int(v))); }
__device__ __forceinline__ float frcp(float x) { return __builtin_amdgcn_rcpf(x); }
__device__ __forceinline__ float bf2f(bf16_t b) { return __uint_as_float(((unsigned)b) << 16); }
__device__ __forceinline__ float bflo(unsigned w) { return __uint_as_float(w << 16); }
__device__ __forceinline__ float bfhi(unsigned w) { return __uint_as_float(w & 0xffff0000u); }

namespace ge {
constexpr int BM = 256, BK = 64, HALF = 128, HTB = HALF * BK * 2;
__device__ __forceinline__ int lds_byte(int r, int c) { const int st = (r >> 4) * 2 + (c >> 5), rr = r & 15, cc = c & 31, ob = rr * 64 + cc * 2; return st * 1024 + (ob ^ (((ob >> 9) & 1) << 5)); }
__device__ __forceinline__ void stage_rc(int b, int& R, int& C) { const int st = b / 1024, sb = b % 1024, swz = sb ^ (((sb >> 9) & 1) << 5); R = (st >> 1) * 16 + swz / 64; C = (st & 1) * 32 + (swz % 64) / 2; }
__device__ __forceinline__ int perm32(int rho) { const int n = rho >> 4, i = rho & 15; return 8 * (i >> 2) + 4 * n + (i & 3); }
struct Unit { int pm, pn, g; };
typedef f32x4 Acc[2][2][4][2];
struct NoCarry { __device__ __forceinline__ bool carry(const struct Unit&) const { return false; } };

template <class Epi, class Sched, bool GATHER>
__device__ __forceinline__ void gemm_stream(LAS unsigned char* lds, const int K, const int lda, const int ldb, const Sched& S, const Epi& E) {
    const int tid = tid_now(), wid = __builtin_amdgcn_readfirstlane(tid >> 6), lane = tid & 63, wr = wid >> 2, wc = wid & 3, fr = lane & 15, fq = lane >> 4;
    const int nt = K / BK;
    Unit cur, nxt; int ui = 0;
    if (!S.next(0, cur)) return;
    unsigned voffA[2][2], nvoffA[2][2], voffB[2][2];
#pragma unroll
    for (int i = 0; i < 2; ++i) { int R, C; stage_rc(tid * 16 + i * 8192, R, C); const int Rb = (R & ~31) + perm32(R & 31);
        voffB[0][i] = (unsigned)(Rb * ldb + C) * 2u; voffB[1][i] = (unsigned)((Rb + 128) * ldb + C) * 2u;
        if constexpr (GATHER) { voffA[0][i] = (unsigned)(S.arow(cur, R) * lda + C) * 2u; voffA[1][i] = (unsigned)(S.arow(cur, R + 128) * lda + C) * 2u; }
        else { voffA[0][i] = (unsigned)(R * lda + C) * 2u; voffA[1][i] = (unsigned)((R + 128) * lda + C) * 2u; }
        nvoffA[0][i] = voffA[0][i]; nvoffA[1][i] = voffA[1][i]; }
    const size_t kstep = (size_t)(BK * 2);
    const unsigned ldsw = (unsigned)wid * 1024u;
    const int aoff = lds_byte(wr * 64 + fr, fq * 8), boff = lds_byte(wc * 32 + fr, fq * 8);
#define GE_SA(b, h) (((b) * 2 + (h)) * HTB)
#define GE_SB(b, h) ((4 + (b) * 2 + (h)) * HTB)
#define GE_STAGE(bufoff, gbase, voff) do { _Pragma("unroll") for (int _i = 0; _i < 2; ++_i) \
        __builtin_amdgcn_global_load_lds((const unsigned*)((const char*)(gbase) + (voff)[_i]), (LAS unsigned*)(lds + (bufoff) + ldsw + _i * 8192), 16, 0, 0); } while (0)
#define GE_LDA(dst, b, h) do { _Pragma("unroll") for (int m = 0; m < 4; ++m) _Pragma("unroll") for (int k = 0; k < 2; ++k) dst[m][k] = *(const LAS bf16x8*)(lds + GE_SA(b, h) + aoff + m * 2048 + k * 1024); } while (0)
#define GE_LDB(dst, b, h) do { _Pragma("unroll") for (int n = 0; n < 2; ++n) _Pragma("unroll") for (int k = 0; k < 2; ++k) dst[n][k] = *(const LAS bf16x8*)(lds + GE_SB(b, h) + boff + n * 2048 + k * 1024); } while (0)
#define GE_MMA(ai, bj, At, Bt) do { __builtin_amdgcn_s_setprio(1); _Pragma("unroll") for (int m = 0; m < 4; ++m) _Pragma("unroll") for (int n = 0; n < 2; ++n) _Pragma("unroll") for (int k = 0; k < 2; ++k) \
        acc[ai][bj][m][n] = __builtin_amdgcn_mfma_f32_16x16x32_bf16(Bt[n][k], At[m][k], acc[ai][bj][m][n], 0, 0, 0); __builtin_amdgcn_s_setprio(0); } while (0)
#define GE_WAIT_V(n) asm volatile("s_waitcnt vmcnt(" #n ")" ::: "memory")
#define GE_WAIT_L(n) asm volatile("s_waitcnt lgkmcnt(" #n ")" ::: "memory")
#define GE_BAR __builtin_amdgcn_s_barrier()
#define GE_SCHED __builtin_amdgcn_sched_barrier(0)
    Acc acc;
#pragma unroll
    for (int a = 0; a < 2; ++a)
#pragma unroll
        for (int b = 0; b < 2; ++b)
#pragma unroll
            for (int m = 0; m < 4; ++m)
#pragma unroll
                for (int n = 0; n < 2; ++n) acc[a][b][m][n] = (f32x4){0.f, 0.f, 0.f, 0.f};
    bf16x8 At[4][2], B0[2][2], B1[2][2];
    const char* cA = S.aptr(cur); const char* cB = S.bptr(cur);
    GE_STAGE(GE_SB(0, 0), cB, voffB[0]); GE_STAGE(GE_SA(0, 0), cA, voffA[0]); GE_STAGE(GE_SB(0, 1), cB, voffB[1]); GE_STAGE(GE_SA(0, 1), cA, voffA[1]);
    if (wr == 1) GE_BAR;
    GE_WAIT_V(4); GE_BAR;
    GE_STAGE(GE_SB(1, 0), cB + kstep, voffB[0]); GE_STAGE(GE_SA(1, 0), cA + kstep, voffA[0]); GE_STAGE(GE_SB(1, 1), cB + kstep, voffB[1]);
    GE_WAIT_V(6); GE_BAR;
    for (;;) {
        const bool has_next = S.next(ui + 1, nxt);
        const char* nA = has_next ? S.aptr(nxt) : cA; const char* nB = has_next ? S.bptr(nxt) : cB;
#pragma unroll 1
        for (int t = 0; t < nt; t += 2) {
            const bool last = (t == nt - 2);
            const char* a1 = cA + (size_t)(t + 1) * kstep;
            const char* a2 = last ? nA : cA + (size_t)(t + 2) * kstep; const char* b2 = last ? nB : cB + (size_t)(t + 2) * kstep;
            const char* a3 = a2 + kstep; const char* b3 = b2 + kstep;
            if constexpr (GATHER) { if (last && has_next) {
#pragma unroll
                for (int i = 0; i < 2; ++i) { int R, C; stage_rc(tid * 16 + i * 8192, R, C);
                    nvoffA[0][i] = (unsigned)(S.arow(nxt, R) * lda + C) * 2u; nvoffA[1][i] = (unsigned)(S.arow(nxt, R + 128) * lda + C) * 2u; } } }
            unsigned va2[2][2];
#pragma unroll
            for (int h = 0; h < 2; ++h)
#pragma unroll
                for (int i = 0; i < 2; ++i) va2[h][i] = (GATHER && last) ? nvoffA[h][i] : voffA[h][i];
            GE_LDB(B0, 0, 0); GE_SCHED; GE_LDA(At, 0, 0); GE_STAGE(GE_SA(1, 1), a1, voffA[1]);
            GE_WAIT_L(8); GE_BAR; GE_WAIT_L(0); GE_MMA(0, 0, At, B0); GE_BAR; GE_SCHED;
            GE_LDB(B1, 0, 1); GE_STAGE(GE_SB(0, 0), b2, voffB[0]);
            GE_BAR; GE_WAIT_L(0); GE_MMA(0, 1, At, B1); GE_BAR;
            GE_LDA(At, 0, 1); GE_STAGE(GE_SA(0, 0), a2, va2[0]);
            GE_BAR; GE_WAIT_L(0); GE_MMA(1, 0, At, B0); GE_BAR; GE_SCHED;
            GE_STAGE(GE_SB(0, 1), b2, voffB[1]);
            GE_WAIT_V(6); GE_BAR; GE_MMA(1, 1, At, B1); GE_BAR;
            GE_LDB(B0, 1, 0); GE_SCHED; GE_LDA(At, 1, 0); GE_STAGE(GE_SA(0, 1), a2, va2[1]);
            GE_WAIT_L(8); GE_BAR; GE_WAIT_L(0); GE_MMA(0, 0, At, B0); GE_BAR; GE_SCHED;
            GE_LDB(B1, 1, 1); GE_STAGE(GE_SB(1, 0), b3, voffB[0]);
            GE_BAR; GE_WAIT_L(0); GE_MMA(0, 1, At, B1); GE_BAR;
            GE_LDA(At, 1, 1); GE_STAGE(GE_SA(1, 0), a3, va2[0]);
            GE_BAR; GE_WAIT_L(0); GE_MMA(1, 0, At, B0); GE_BAR; GE_SCHED;
            GE_STAGE(GE_SB(1, 1), b3, voffB[1]);
            GE_WAIT_V(6); GE_BAR; GE_MMA(1, 1, At, B1); GE_BAR;
        }
        { int tz = tid; asm volatile("" : "+v"(tz));
          const int wid2 = tz >> 6, lane2 = tz & 63; E(acc, cur, wid2 >> 2, wid2 & 3, lane2 & 15, lane2 >> 4); }
        if (!has_next) break;
        if (!S.carry(cur)) {
#pragma unroll
        for (int a = 0; a < 2; ++a)
#pragma unroll
            for (int b = 0; b < 2; ++b)
#pragma unroll
                for (int m = 0; m < 4; ++m)
#pragma unroll
                    for (int n = 0; n < 2; ++n) acc[a][b][m][n] = (f32x4){0.f, 0.f, 0.f, 0.f}; }
        cur = nxt; cA = nA; cB = nB; ++ui;
        if (GATHER) {
#pragma unroll
            for (int h = 0; h < 2; ++h)
#pragma unroll
                for (int i = 0; i < 2; ++i) voffA[h][i] = nvoffA[h][i]; }
    }
    GE_WAIT_V(0);
    if (wr == 0) GE_BAR;
    GE_BAR;
#undef GE_SA
#undef GE_SB
#undef GE_STAGE
#undef GE_LDA
#undef GE_LDB
#undef GE_MMA
#undef GE_WAIT_V
#undef GE_WAIT_L
#undef GE_BAR
#undef GE_SCHED
}
__device__ __forceinline__ void tile_order(int L, int nM, int nN, int& pm, int& pn) {
    const int nwg = nM * nN; int wgid = L;
    { const int q = nwg / 8, r = nwg % 8, xcd = wgid % 8, off = wgid / 8; wgid = (xcd < r ? xcd * (q + 1) : r * (q + 1) + (xcd - r) * q) + off; }
    const int nig = 8 * nN, gid = wgid / nig, fm = gid * 8, gsz = (nM - fm) < 8 ? (nM - fm) : 8;
    pm = fm + ((wgid % nig) % gsz); pn = (wgid % nig) / gsz;
}
}
struct MapInMain { __device__ __forceinline__ int operator()(int s) const {
    if (s < 2048) return s;
    if (s < 2560) return 2576 + (s - 2048);
    if (s < 2816) return 3088 + (s - 2560);
    if (s < 2944) return 3344 + (s - 2816);
    if (s < 3008) return 3472 + (s - 2944);
    if (s < 3024) return 2560 + (s - 3008);
    if (s < 3072) return -1;
    return 3536 + (s - 3072); } };
struct MapOff { int off; __device__ __forceinline__ int operator()(int s) const { return off + s; } };struct MegaP {
    const float* w_in; bf16_t* Wb_in; bf16_t* Wb_gv; const bf16_t* Xb; bf16_t* Hp; bf16_t* GVt; float* ssq_q; float* ssq_kv;
};
struct SchedIn : ge::NoCarry {
    const char* Xb; const char* Wm; const char* Wg; int c, G, gv;
    __device__ __forceinline__ bool next(int i, ge::Unit& u) const {
        const int L = i * G + c;
        if (gv) { if (L >= 128) return false; u.g = 0; u.pm = L >> 1; u.pn = 8 + (L & 1); return true; }
        if (L >= 1536) return false;
        if (L < 1408) { u.g = 0; ge::tile_order(L, 64, 22, u.pm, u.pn); if (u.pn >= 8) u.pn += 2; } else { u.g = 1; const int l = L - 1408; u.pm = l & 1; u.pn = l >> 1; }
        return true; }
    __device__ __forceinline__ const char* aptr(const ge::Unit& u) const { return u.g == 0 ? Xb + (size_t)u.pm * 256 * D * 2 : Wg + (size_t)u.pm * 256 * D * 2; }
    __device__ __forceinline__ const char* bptr(const ge::Unit& u) const { return u.g == 0 ? Wm + (size_t)u.pn * 256 * D * 2 : Xb + (size_t)u.pn * 256 * D * 2; }
};
template <int GV> struct EpiIn {
    bf16_t* Hp; bf16_t* GVt; float* ssq_q; float* ssq_kv;
    __device__ __forceinline__ void operator()(ge::Acc& acc, const ge::Unit& u, int wr, int wc, int fr, int fq) const {
        if (GV == 0 || (GV == 2 && u.g == 0)) {
            const int row0 = u.pm * 256 + wr * 64 + fr, col0 = u.pn * 256 + wc * 32 + 8 * fq;
            const bool sg = u.pn >= 12;
#pragma unroll
            for (int ai = 0; ai < 2; ++ai)
#pragma unroll
                for (int m = 0; m < 4; ++m) { const int row = row0 + ai * 128 + m * 16; bf16_t* rp = Hp + (size_t)row * HW + col0;
                    float sq0 = 0.f, sq1 = 0.f;
#pragma unroll
                    for (int bj = 0; bj < 2; ++bj) { f32x4 v0 = acc[ai][bj][m][0], v1 = acc[ai][bj][m][1];
                        if (sg) {
#pragma unroll
                            for (int j = 0; j < 4; ++j) { v0[j] = frcp(1.f + __expf(-v0[j])); v1[j] = frcp(1.f + __expf(-v1[j])); } }
                        const float s = v0[0] * v0[0] + v0[1] * v0[1] + v0[2] * v0[2] + v0[3] * v0[3] + v1[0] * v1[0] + v1[1] * v1[1] + v1[2] * v1[2] + v1[3] * v1[3];
                        if (bj == 0) sq0 = s; else sq1 = s;
                        u32x4 o = {cvt_pk_bf16(v0[0], v0[1]), cvt_pk_bf16(v0[2], v0[3]), cvt_pk_bf16(v1[0], v1[1]), cvt_pk_bf16(v1[2], v1[3])};
                        *(u32x4*)(rp + bj * 128) = o; }
                    if (u.pn == 10 || u.pn == 11) {
                        float s = (u.pn == 10) ? (sq0 + sq1) : sq0;
                        { const int ln = fq * 16 + fr; s += shx(s, 16, ln); s += shx(s, 32, ln); }
                        if (fq == 0) { float* dst = (u.pn == 10 ? ssq_q : ssq_kv); dst[(size_t)wc * T + row] = s; } } }
        } else {
#pragma unroll
            for (int ai = 0; ai < 2; ++ai)
#pragma unroll
                for (int m = 0; m < 4; ++m) { const int r = u.pm * 256 + ai * 128 + wr * 64 + m * 16 + fr, h = r >> 7, e = r & 127;
#pragma unroll
                    for (int bj = 0; bj < 2; ++bj) { const int t0 = u.pn * 256 + bj * 128 + wc * 32 + 8 * fq;
                        const int chunk = t0 >> 6, p0 = (t0 & 48) + ((t0 & 8) >> 1);
                        bf16_t* base = GVt + ((size_t)(chunk * 4 + h) * 128 + e) * 64;
                        const f32x4 v0 = acc[ai][bj][m][0], v1 = acc[ai][bj][m][1];
                        u32x2 o0 = {cvt_pk_bf16(v0[0], v0[1]), cvt_pk_bf16(v0[2], v0[3])}, o1 = {cvt_pk_bf16(v1[0], v1[1]), cvt_pk_bf16(v1[2], v1[3])};
                        *(u32x2*)(base + p0) = o0; *(u32x2*)(base + p0 + 8) = o1; } }
        }
    }
};
constexpr float QSCALE = 0.07216878364870322f * 1.4426950408889634f;
struct MapQ { __device__ __forceinline__ int operator()(int s) const {
    if (s < 512) return (s >> 7) * 192 + (s & 127);
    const int s2 = s - 512, bj = s2 >> 7, w = s2 & 127; return (w >> 5) * 192 + 128 + bj * 32 + (w & 31); } };
struct MapKV { int voff; __device__ __forceinline__ int operator()(int s) const { return (s >> 7) * 256 + voff + (s & 127); } };

struct MlaP {
    const float* w_uq; const float* w_ukv; const float* qn_g; const float* kvn_g;
    bf16_t* Wb_uq; bf16_t* Wb_uk; bf16_t* Wb_uv;
    const bf16_t* Hp; const float* ssq_q; const float* ssq_kv; const float* cs; const float* sn;
    bf16_t* Qb; bf16_t* KnImg; bf16_t* VtImg; bf16_t* KrImg; float* Opart; float* MLpart; float* Yc;
};
__device__ __forceinline__ float rstd4(const float* ssq, int row, float invw) {
    const float s = (ssq[row] + ssq[T + row]) + (ssq[2 * T + row] + ssq[3 * T + row]); return rsqrtf(s * invw + 1e-6f); }

template <int mode> struct SchedMla : ge::NoCarry { const char* A; const char* B; int c, G;
    __device__ __forceinline__ bool next(int i, ge::Unit& u) const {
        if (c < 0) return false;
        const int L = i * G + c; u.g = mode;
        if (mode == 0) { if (L >= 192) return false; u.pm = L / 3; u.pn = L % 3; }
        else if (mode == 1) { if (L >= 128) return false; u.pm = L >> 1; u.pn = L & 1; }
        else { if (L >= 128) return false; u.pm = L & 1; u.pn = L >> 1; }
        return true; }
    __device__ __forceinline__ const char* aptr(const ge::Unit& u) const { return mode == 2 ? A + (size_t)u.pm * 256 * 256 * 2 : A + (size_t)u.pm * 256 * HW * 2; }
    __device__ __forceinline__ const char* bptr(const ge::Unit& u) const { return mode == 2 ? B + (size_t)u.pn * 256 * HW * 2 : B + (size_t)u.pn * 256 * 256 * 2; }
};
template <int MODE> struct EpiMla { MlaP p;
    __device__ __forceinline__ void operator()(ge::Acc& acc, const ge::Unit& u, int wr, int wc, int fr, int fq) const {
        if constexpr (MODE == 0) {
#pragma unroll
            for (int ai = 0; ai < 2; ++ai)
#pragma unroll
                for (int m = 0; m < 4; ++m) { asm volatile("" ::: "memory"); const int t = u.pm * 256 + ai * 128 + wr * 64 + m * 16 + fr; const float rs = rstd4(p.ssq_q, t, 1.f / 256.f) * QSCALE;
                    if (u.pn < 2) {
#pragma unroll
                        for (int bj = 0; bj < 2; ++bj) { const int c0 = u.pn * 256 + bj * 128 + wc * 32 + 8 * fq, head = c0 >> 7, dim = c0 & 127;
                            const f32x4 v0 = acc[ai][bj][m][0] * rs, v1 = acc[ai][bj][m][1] * rs;
                            u32x4 o = {cvt_pk_bf16(v0[0], v0[1]), cvt_pk_bf16(v0[2], v0[3]), cvt_pk_bf16(v1[0], v1[1]), cvt_pk_bf16(v1[2], v1[3])};
                            *(u32x4*)(p.Qb + (size_t)t * 768 + head * 192 + dim) = o; }
                    } else { const int head = wc, i0 = 8 * fq;
                        float o1[8], o2[8];
#pragma unroll
                        for (int n = 0; n < 2; ++n) { const f32x4 c4 = *(const f32x4*)(p.cs + (size_t)t * 32 + i0 + 4 * n), s4 = *(const f32x4*)(p.sn + (size_t)t * 32 + i0 + 4 * n);
#pragma unroll
                            for (int j = 0; j < 4; ++j) { const float x1 = acc[ai][0][m][n][j] * rs, x2 = acc[ai][1][m][n][j] * rs; o1[4 * n + j] = x1 * c4[j] - x2 * s4[j]; o2[4 * n + j] = x1 * s4[j] + x2 * c4[j]; } }
                        u32x4 a = {cvt_pk_bf16(o1[0], o1[1]), cvt_pk_bf16(o1[2], o1[3]), cvt_pk_bf16(o1[4], o1[5]), cvt_pk_bf16(o1[6], o1[7])};
                        u32x4 b = {cvt_pk_bf16(o2[0], o2[1]), cvt_pk_bf16(o2[2], o2[3]), cvt_pk_bf16(o2[4], o2[5]), cvt_pk_bf16(o2[6], o2[7])};
                        *(u32x4*)(p.Qb + (size_t)t * 768 + head * 192 + 128 + i0) = a; *(u32x4*)(p.Qb + (size_t)t * 768 + head * 192 + 160 + i0) = b; } }
        } else if constexpr (MODE == 1) {
#pragma unroll
            for (int ai = 0; ai < 2; ++ai)
#pragma unroll
                for (int m = 0; m < 4; ++m) { asm volatile("" ::: "memory"); const int t = u.pm * 256 + ai * 128 + wr * 64 + m * 16 + fr; const float rs = rstd4(p.ssq_kv, t, 1.f / 128.f);
                    const int tile = t >> 6, key = t & 63;
#pragma unroll
                    for (int bj = 0; bj < 2; ++bj) { const int c0 = u.pn * 256 + bj * 128 + wc * 32 + 8 * fq, head = c0 >> 7, chunk = (c0 & 127) >> 3;
                        const f32x4 v0 = acc[ai][bj][m][0] * rs, v1 = acc[ai][bj][m][1] * rs;
                        u32x4 o = {cvt_pk_bf16(v0[0], v0[1]), cvt_pk_bf16(v0[2], v0[3]), cvt_pk_bf16(v1[0], v1[1]), cvt_pk_bf16(v1[2], v1[3])};
                        *(u32x4*)((char*)p.KnImg + ((size_t)(head * 256 + tile) * 16384) + key * 256 + ((chunk ^ (key & 15)) << 4)) = o; } }
        } else {
#pragma unroll
            for (int bj = 0; bj < 2; ++bj) { const int t0 = u.pn * 256 + bj * 128 + wc * 32 + 8 * fq;
                float rs[8];
#pragma unroll
                for (int j = 0; j < 8; ++j) rs[j] = rstd4(p.ssq_kv, t0 + j, 1.f / 128.f);
                const int tile = t0 >> 6, p0 = (t0 & 48) + ((t0 & 8) >> 1);
#pragma unroll
                for (int ai = 0; ai < 2; ++ai)
#pragma unroll
                    for (int m = 0; m < 4; ++m) { asm volatile("" ::: "memory"); const int r = u.pm * 256 + ai * 128 + wr * 64 + m * 16 + fr, head = r >> 7, d = r & 127;
                        char* base = (char*)p.VtImg + ((size_t)(head * 256 + tile) * 16384) + d * 128;
                        const f32x4 v0 = acc[ai][bj][m][0], v1 = acc[ai][bj][m][1];
                        u32x2 o0 = {cvt_pk_bf16(v0[0] * rs[0], v0[1] * rs[1]), cvt_pk_bf16(v0[2] * rs[2], v0[3] * rs[3])};
                        u32x2 o1 = {cvt_pk_bf16(v1[0] * rs[4], v1[1] * rs[5]), cvt_pk_bf16(v1[2] * rs[6], v1[3] * rs[7])};
                        const int sw = (d >> 1) & 7, pa = p0, pb = p0 + 8;
                        *(u32x2*)(base + (((pa >> 3) ^ sw) << 4) + (pa & 7) * 2) = o0;
                        *(u32x2*)(base + (((pb >> 3) ^ sw) << 4) + (pb & 7) * 2) = o1; } }
        }
    }
};
__device__ __forceinline__ void kr_phase(const MlaP& p, int gtid, int gthreads) {
    for (int idx = gtid; idx < T * 4; idx += gthreads) { const int t = idx >> 2, c = idx & 3, i0 = 8 * c;
        const u32x4 a = *(const u32x4*)(p.Hp + (size_t)t * HW + H_KR + i0), b = *(const u32x4*)(p.Hp + (size_t)t * HW + H_KR + 32 + i0);
        float o1[8], o2[8];
#pragma unroll
        for (int n = 0; n < 2; ++n) { const f32x4 c4 = *(const f32x4*)(p.cs + (size_t)t * 32 + i0 + 4 * n), s4 = *(const f32x4*)(p.sn + (size_t)t * 32 + i0 + 4 * n);
#pragma unroll
            for (int j = 0; j < 4; ++j) { const int e = 4 * n + j; const unsigned wa = a[e >> 1], wb = b[e >> 1];
                const float x1 = (e & 1) ? bfhi(wa) : bflo(wa), x2 = (e & 1) ? bfhi(wb) : bflo(wb);
                o1[e] = x1 * c4[j] - x2 * s4[j]; o2[e] = x1 * s4[j] + x2 * c4[j]; } }
        u32x4 oa = {cvt_pk_bf16(o1[0], o1[1]), cvt_pk_bf16(o1[2], o1[3]), cvt_pk_bf16(o1[4], o1[5]), cvt_pk_bf16(o1[6], o1[7])};
        u32x4 ob = {cvt_pk_bf16(o2[0], o2[1]), cvt_pk_bf16(o2[2], o2[3]), cvt_pk_bf16(o2[4], o2[5]), cvt_pk_bf16(o2[6], o2[7])};
        const int tile = t >> 6, key = t & 63, sw = (key >> 1) & 7;
        char* base = (char*)p.KrImg + (size_t)tile * 8192 + key * 128;
        *(u32x4*)(base + ((c ^ sw) << 4)) = oa; *(u32x4*)(base + (((c + 4) ^ sw) << 4)) = ob; }
}
constexpr int ATT_STEPS = 130;
__device__ __forceinline__ void attn_item(LAS unsigned char* lds, const MlaP& p, int head, int b, int j0, int j1, int slot) {
    const int tid = tid_now(), wid = __builtin_amdgcn_readfirstlane(tid >> 6), lane = tid & 63, q = lane & 31, hh = lane >> 5;
    const int grp = wid >> 2, n = j1 - j0;
    const int trow = b * 256 + wid * 32 + q;
    bf16x8 qf[12];
    { const bf16_t* qp = p.Qb + (size_t)trow * 768 + head * 192 + 8 * hh;
#pragma unroll
      for (int s = 0; s < 12; ++s) qf[s] = *(const bf16x8*)(qp + 16 * s); }
    f32x16 O[4];
#pragma unroll
    for (int d = 0; d < 4; ++d)
#pragma unroll
        for (int r = 0; r < 16; ++r) O[d][r] = 0.f;
    float m_run = -1e30f, l_run = 0.f;
    const char* knb = (const char*)p.KnImg + (size_t)head * 256 * 16384; const char* vtb = (const char*)p.VtImg + (size_t)head * 256 * 16384; const char* krb = (const char*)p.KrImg;
    const unsigned lo = (unsigned)lane * 16u;
    constexpr int KB = 24576, VOFF = 3 * KB, VB = 16384;
#define AT_ISSUE(k) do { const unsigned _ko = (unsigned)((k) % 3) * KB, _vo = VOFF + (unsigned)((k) & 3) * VB; const size_t _j = (size_t)(j0 + (k)); \
        __builtin_amdgcn_global_load_lds((const unsigned*)(knb + _j * 16384 + (wid * 2) * 1024 + lo), (LAS unsigned*)(lds + _ko + (wid * 2) * 1024), 16, 0, 0); \
        __builtin_amdgcn_global_load_lds((const unsigned*)(knb + _j * 16384 + (wid * 2 + 1) * 1024 + lo), (LAS unsigned*)(lds + _ko + (wid * 2 + 1) * 1024), 16, 0, 0); \
        __builtin_amdgcn_global_load_lds((const unsigned*)(krb + _j * 8192 + wid * 1024 + lo), (LAS unsigned*)(lds + _ko + 16384 + wid * 1024), 16, 0, 0); \
        __builtin_amdgcn_global_load_lds((const unsigned*)(vtb + _j * 16384 + (wid * 2) * 1024 + lo), (LAS unsigned*)(lds + _vo + (wid * 2) * 1024), 16, 0, 0); \
        __builtin_amdgcn_global_load_lds((const unsigned*)(vtb + _j * 16384 + (wid * 2 + 1) * 1024 + lo), (LAS unsigned*)(lds + _vo + (wid * 2 + 1) * 1024), 16, 0, 0); } while (0)
#define AT_TOP(k) do { if ((k) + 1 < n) asm volatile("s_waitcnt vmcnt(5)" ::: "memory"); else asm volatile("s_waitcnt vmcnt(0)" ::: "memory"); \
        __builtin_amdgcn_s_barrier(); asm volatile("" ::: "memory"); if ((k) + 2 < n) AT_ISSUE((k) + 2); } while (0)
    const int kn_off0 = q * 256, kn_sw = q & 15, kr_off0 = q * 128, kr_sw = (q >> 1) & 7, vt_sw = (q >> 1) & 7;
    constexpr float THR = 8.f;
    f32x16 S0, S1; bool sval = false, first = true; int sjj = 0, sk = 0;
    auto QK = [&](int k) __attribute__((always_inline)) {
        const int jj = j0 + k - 4 * b; sjj = jj; sk = k; sval = !(jj >= 0 && 64 * jj > 32 * wid + 31);
        if (sval) {
            LAS unsigned char* bb = lds + (k % 3) * KB;
            const float mref = first ? 0.f : m_run;
#pragma unroll
            for (int r = 0; r < 16; ++r) { S0[r] = -mref; S1[r] = -mref; }
#pragma unroll
            for (int s = 0; s < 8; ++s) {
                const bf16x8 k0 = *(const LAS bf16x8*)(bb + kn_off0 + (((2 * s + hh) ^ kn_sw) << 4));
                const bf16x8 k1 = *(const LAS bf16x8*)(bb + 8192 + kn_off0 + (((2 * s + hh) ^ kn_sw) << 4));
                S0 = __builtin_amdgcn_mfma_f32_32x32x16_bf16(k0, qf[s], S0, 0, 0, 0);
                S1 = __builtin_amdgcn_mfma_f32_32x32x16_bf16(k1, qf[s], S1, 0, 0, 0); }
#pragma unroll
            for (int s = 0; s < 4; ++s) {
                const bf16x8 k0 = *(const LAS bf16x8*)(bb + 16384 + kr_off0 + (((2 * s + hh) ^ kr_sw) << 4));
                const bf16x8 k1 = *(const LAS bf16x8*)(bb + 16384 + 4096 + kr_off0 + (((2 * s + hh) ^ kr_sw) << 4));
                S0 = __builtin_amdgcn_mfma_f32_32x32x16_bf16(k0, qf[8 + s], S0, 0, 0, 0);
                S1 = __builtin_amdgcn_mfma_f32_32x32x16_bf16(k1, qf[8 + s], S1, 0, 0, 0); } }
    };
    auto SMPV = [&]() __attribute__((always_inline)) {
        if (sval) {
            LAS unsigned char* vb = lds + VOFF + (sk & 3) * VB;
            const float mref = first ? 0.f : m_run;
            if (sjj >= 0) {
                const int dq = wid * 32 + q - 64 * sjj - 4 * hh;
                const float NEG = -__builtin_inff();
#pragma unroll
                for (int r = 0; r < 16; ++r) { const int c = (r & 3) + 8 * (r >> 2);
                    if (c > dq) S0[r] = NEG;
                    if (c + 32 > dq) S1[r] = NEG; } }
            float mx = S0[0];
#pragma unroll
            for (int r = 1; r < 16; ++r) mx = fmaxf(mx, S0[r]);
#pragma unroll
            for (int r = 0; r < 16; ++r) mx = fmaxf(mx, S1[r]);
            { auto rr = __builtin_amdgcn_permlane32_swap(__float_as_uint(mx), __float_as_uint(mx), false, false); mx = fmaxf(__uint_as_float(rr[0]), __uint_as_float(rr[1])); }
            float alpha = 1.f;
            if (first || !__all(mx <= THR)) {
                const float mn = fmaxf(m_run, mref + mx), sh = mn - mref;
                alpha = __builtin_amdgcn_exp2f(m_run - mn); m_run = mn;
#pragma unroll
                for (int r = 0; r < 16; ++r) { S0[r] -= sh; S1[r] -= sh; }
#pragma unroll
                for (int d = 0; d < 4; ++d)
#pragma unroll
                    for (int r = 0; r < 16; ++r) O[d][r] *= alpha;
                first = false;
            }
            float sum = 0.f;
#pragma unroll
            for (int r = 0; r < 16; ++r) { S0[r] = __builtin_amdgcn_exp2f(S0[r]); S1[r] = __builtin_amdgcn_exp2f(S1[r]); sum += S0[r] + S1[r]; }
            l_run = l_run * alpha + sum;
            bf16x8 pf[4];
#pragma unroll
            for (int h2 = 0; h2 < 2; ++h2) {
                u32x4 a = {cvt_pk_bf16(S0[8 * h2 + 0], S0[8 * h2 + 1]), cvt_pk_bf16(S0[8 * h2 + 2], S0[8 * h2 + 3]), cvt_pk_bf16(S0[8 * h2 + 4], S0[8 * h2 + 5]), cvt_pk_bf16(S0[8 * h2 + 6], S0[8 * h2 + 7])};
                u32x4 c = {cvt_pk_bf16(S1[8 * h2 + 0], S1[8 * h2 + 1]), cvt_pk_bf16(S1[8 * h2 + 2], S1[8 * h2 + 3]), cvt_pk_bf16(S1[8 * h2 + 4], S1[8 * h2 + 5]), cvt_pk_bf16(S1[8 * h2 + 6], S1[8 * h2 + 7])};
                pf[h2] = *(bf16x8*)&a; pf[2 + h2] = *(bf16x8*)&c; }
#pragma unroll
            for (int d = 0; d < 4; ++d) {
#pragma unroll
                for (int s2 = 0; s2 < 4; ++s2) {
                    const bf16x8 vf = *(const LAS bf16x8*)(vb + (d * 32 + q) * 128 + (((2 * s2 + hh) ^ vt_sw) << 4));
                    O[d] = __builtin_amdgcn_mfma_f32_32x32x16_bf16(vf, pf[s2], O[d], 0, 0, 0); } }
        }
    };
    AT_ISSUE(0);
    if (n > 1) AT_ISSUE(1);
    if (grp == 0) {
#pragma unroll 1
        for (int k = 0; k < n; ++k) { AT_TOP(k); QK(k); SMPV(); }
    } else {
#pragma unroll 1
        for (int k = 0; k < n; ++k) { AT_TOP(k); SMPV(); QK(k); }
        SMPV();
    }
    asm volatile("" ::: "memory"); __builtin_amdgcn_s_barrier(); asm volatile("" ::: "memory");
#undef AT_ISSUE
#undef AT_TOP
    { auto rr = __builtin_amdgcn_permlane32_swap(__float_as_uint(l_run), __float_as_uint(l_run), false, false); l_run = __uint_as_float(rr[0]) + __uint_as_float(rr[1]); }
    bf16_t* op = (bf16_t*)p.Opart + ((size_t)slot * 256 + wid * 32 + q) * 128 + 4 * hh;
#pragma unroll
    for (int d = 0; d < 4; ++d)
#pragma unroll
        for (int g = 0; g < 4; ++g) { u32x2 v = {cvt_pk_bf16(O[d][4 * g], O[d][4 * g + 1]), cvt_pk_bf16(O[d][4 * g + 2], O[d][4 * g + 3])}; *(u32x2*)(op + d * 32 + g * 8) = v; }
    if (hh == 0) { float* ml = p.MLpart + ((size_t)slot * 256 + wid * 32 + q) * 2; ml[0] = m_run; ml[1] = l_run; }
}
__device__ __forceinline__ void attn_phase(LAS unsigned char* lds, const MlaP& p, int c) {
    const int head = c >> 6, cc = c & 63, pp = cc >> 1, bl = 63 - pp, nl = 4 * (64 - pp);
    if ((cc & 1) == 0) attn_item(lds, p, head, bl, 0, ATT_STEPS, 2 * c);
    else { attn_item(lds, p, head, bl, ATT_STEPS, nl, 2 * c); attn_item(lds, p, head, pp, 0, 4 * (pp + 1), 2 * c + 1); }
}
struct GlaP {
    const bf16_t* Hp; const bf16_t* GVt; const float* wg; const float* bg; const float* ng; const float* wconv;
    bf16_t* QE; float* OI; float* kvT; float* decay; bf16_t* spT; bf16_t* Yab; bf16_t* Ybb; bf16_t* Ycb;
    const float* Opart; const float* MLpart;
};
__device__ __forceinline__ int pos16(int i) { return (i & 48) | ((i & 4) << 1) | ((i & 8) >> 1) | (i & 3); }
__device__ __forceinline__ void gla_g1(LAS unsigned char* lds, const GlaP& p, int c, int G) {
    const int tid = tid_now(), wid = __builtin_amdgcn_readfirstlane(tid >> 6), lane = tid & 63, l31 = lane & 31, hh = lane >> 5;
    LAS float* bsm = (LAS float*)lds; LAS float* gtot = (LAS float*)(lds + 17408); LAS float* blast = (LAS float*)(lds + 19456);
    LAS unsigned char* qeL = lds + 20480; LAS unsigned char* keL = lds + 28672; LAS unsigned char* ktL = lds + 36864;
    const int eb = wid & 3, hb = wid >> 2;
    for (int u = c; u < 1024; u += G) {
        const int n = u >> 2, h = u & 3;
        bf16x8 vf[4];
        { const bf16_t* vp = p.GVt + ((size_t)u * 128 + eb * 32 + l31) * 64 + 8 * hh;
#pragma unroll
          for (int s4 = 0; s4 < 4; ++s4) vf[s4] = *(const bf16x8*)(vp + 16 * s4); }
        { const int d = tid & 63, g = tid >> 6;
          float w[16];
#pragma unroll
          for (int r = 0; r < 16; ++r) w[r] = p.wg[r * 256 + h * 64 + d];
          const float bias = p.bg[h * 64 + d];
          float cs[8]; float run = 0.f;
#pragma unroll
          for (int k = 0; k < 8; ++k) { const int i = 8 * g + k;
              const u32x4 g0 = *(const u32x4*)(p.Hp + (size_t)(64 * n + i) * HW + H_GLR), g1 = *(const u32x4*)(p.Hp + (size_t)(64 * n + i) * HW + H_GLR + 8);
              float la = bias;
#pragma unroll
              for (int r = 0; r < 4; ++r) { la += bflo(g0[r]) * w[2 * r] + bfhi(g0[r]) * w[2 * r + 1]; la += bflo(g1[r]) * w[8 + 2 * r] + bfhi(g1[r]) * w[8 + 2 * r + 1]; }
              const float ls = (fminf(la, 0.f) - __logf(1.f + __expf(-fabsf(la)))) * (1.f / 16.f);
              run += ls; cs[k] = run; }
          gtot[g * 64 + d] = run;
          __syncthreads();
          float pre = 0.f, tot = 0.f;
#pragma unroll
          for (int gg = 0; gg < 8; ++gg) { const float v = gtot[gg * 64 + d]; tot += v; if (gg < g) pre += v; }
#pragma unroll
          for (int k = 0; k < 8; ++k) bsm[(8 * g + k) * 68 + d] = pre + cs[k];
          if (g == 0) { blast[d] = tot; p.decay[(size_t)u * 64 + d] = __expf(tot); } }
        __syncthreads();
        { const int i = tid >> 3, cc = tid & 7, d0 = 8 * cc; const size_t t = (size_t)64 * n + i;
          const u32x4 qv = *(const u32x4*)(p.Hp + t * HW + H_GQ + h * 64 + d0), kv = *(const u32x4*)(p.Hp + t * HW + H_GK + h * 64 + d0);
          float b[8], bl[8];
          { const f32x4 b0 = *(const LAS f32x4*)(bsm + i * 68 + d0), b1 = *(const LAS f32x4*)(bsm + i * 68 + d0 + 4), l0 = *(const LAS f32x4*)(blast + d0), l1 = *(const LAS f32x4*)(blast + d0 + 4);
#pragma unroll
            for (int j = 0; j < 4; ++j) { b[j] = b0[j]; b[4 + j] = b1[j]; bl[j] = l0[j]; bl[4 + j] = l1[j]; } }
          float qe[8], ke[8], kt[8];
#pragma unroll
          for (int j = 0; j < 8; ++j) { const float qq = (j & 1) ? bfhi(qv[j >> 1]) : bflo(qv[j >> 1]), kk = (j & 1) ? bfhi(kv[j >> 1]) : bflo(kv[j >> 1]);
              qe[j] = qq * 0.125f * __expf(b[j]); ke[j] = kk * __expf(-b[j]); kt[j] = kk * __expf(bl[j] - b[j]); }
          const u32x4 qo = {cvt_pk_bf16(qe[0], qe[1]), cvt_pk_bf16(qe[2], qe[3]), cvt_pk_bf16(qe[4], qe[5]), cvt_pk_bf16(qe[6], qe[7])};
          const u32x4 ko = {cvt_pk_bf16(ke[0], ke[1]), cvt_pk_bf16(ke[2], ke[3]), cvt_pk_bf16(ke[4], ke[5]), cvt_pk_bf16(ke[6], ke[7])};
          const int sw = (i >> 1) & 7;
          *(LAS u32x4*)(qeL + i * 128 + ((cc ^ sw) << 4)) = qo; *(LAS u32x4*)(keL + i * 128 + ((cc ^ sw) << 4)) = ko;
          *(u32x4*)(p.QE + t * 256 + h * 64 + d0) = qo;
          const int pi = pos16(i);
#pragma unroll
          for (int j = 0; j < 8; ++j) { const int d = d0 + j; const unsigned pk = cvt_pk_bf16(kt[j], 0.f);
              *(LAS unsigned short*)(ktL + d * 128 + (((pi >> 3) ^ ((d >> 1) & 7)) << 4) + (pi & 7) * 2) = (unsigned short)pk; } }
        __syncthreads();
        { f32x16 OT, KV;
#pragma unroll
          for (int r = 0; r < 16; ++r) { OT[r] = 0.f; KV[r] = 0.f; }
          const int sw = (l31 >> 1) & 7;
#pragma unroll
          for (int jb = 0; jb < 2; ++jb) {
              if (jb <= hb) {
                  f32x16 Sc;
#pragma unroll
                  for (int r = 0; r < 16; ++r) Sc[r] = 0.f;
#pragma unroll
                  for (int s = 0; s < 4; ++s) {
                      const bf16x8 ka = *(const LAS bf16x8*)(keL + (32 * jb + l31) * 128 + (((2 * s + hh) ^ sw) << 4));
                      const bf16x8 qb = *(const LAS bf16x8*)(qeL + (32 * hb + l31) * 128 + (((2 * s + hh) ^ sw) << 4));
                      Sc = __builtin_amdgcn_mfma_f32_32x32x16_bf16(ka, qb, Sc, 0, 0, 0); }
                  if (jb == hb) {
#pragma unroll
                      for (int r = 0; r < 16; ++r) { const int j = (r & 3) + 8 * (r >> 2) + 4 * hh; if (j > l31) Sc[r] = 0.f; } }
#pragma unroll
                  for (int h2 = 0; h2 < 2; ++h2) {
                      u32x4 a = {cvt_pk_bf16(Sc[8 * h2 + 0], Sc[8 * h2 + 1]), cvt_pk_bf16(Sc[8 * h2 + 2], Sc[8 * h2 + 3]), cvt_pk_bf16(Sc[8 * h2 + 4], Sc[8 * h2 + 5]), cvt_pk_bf16(Sc[8 * h2 + 6], Sc[8 * h2 + 7])};
                      OT = __builtin_amdgcn_mfma_f32_32x32x16_bf16(vf[2 * jb + h2], *(bf16x8*)&a, OT, 0, 0, 0); } } }
#pragma unroll
          for (int s4 = 0; s4 < 4; ++s4) {
              const bf16x8 kb = *(const LAS bf16x8*)(ktL + (32 * hb + l31) * 128 + (((2 * s4 + hh) ^ sw) << 4));
              KV = __builtin_amdgcn_mfma_f32_32x32x16_bf16(vf[s4], kb, KV, 0, 0, 0); }
          float* oi = p.OI + ((size_t)u * 8 + wid) * 1024 + lane;
#pragma unroll
          for (int r = 0; r < 16; ++r) oi[r * 64] = OT[r];
          float* kp = p.kvT + (size_t)u * 8192 + 32 * hb + l31;
#pragma unroll
          for (int r = 0; r < 16; ++r) { const int e = 32 * eb + (r & 3) + 8 * (r >> 2) + 4 * hh; kp[e * 64] = KV[r]; } }
        __syncthreads();
    }
}
__device__ __forceinline__ void gla_g2(LAS unsigned char* lds, const GlaP& p, int c) {
    const int tid = tid_now(), el = tid & 127, seg = tid >> 7;
    const int idx = c * 128 + el, h = idx >> 13, ed = idx & 8191, d = idx & 63;
    LAS float* segS = (LAS float*)lds; LAS float* segD = (LAS float*)(lds + 2048);
    float st = 0.f, dp = 1.f;
    for (int n0 = seg * 64; n0 < seg * 64 + 64; n0 += 16) {
        float kv[16], dc[16];
#pragma unroll
        for (int k = 0; k < 16; ++k) { const size_t u = (size_t)(n0 + k) * 4 + h; kv[k] = p.kvT[u * 8192 + ed]; dc[k] = p.decay[u * 64 + d]; }
#pragma unroll
        for (int k = 0; k < 16; ++k) { st = fmaf(dc[k], st, kv[k]); dp *= dc[k]; }
    }
    __syncthreads();
    segS[seg * 128 + el] = st; segD[seg * 128 + el] = dp;
    __syncthreads();
    st = 0.f;
    for (int s2 = 0; s2 < seg; ++s2) st = fmaf(segD[s2 * 128 + el], st, segS[s2 * 128 + el]);
    for (int n0 = seg * 64; n0 < seg * 64 + 64; n0 += 16) {
        float kv[16], dc[16];
#pragma unroll
        for (int k = 0; k < 16; ++k) { const size_t u = (size_t)(n0 + k) * 4 + h; kv[k] = p.kvT[u * 8192 + ed]; dc[k] = p.decay[u * 64 + d]; }
#pragma unroll
        for (int k = 0; k < 16; ++k) { const size_t u = (size_t)(n0 + k) * 4 + h; p.spT[u * 8192 + ed] = (bf16_t)(cvt_pk_bf16(st, 0.f) & 0xffffu); st = fmaf(dc[k], st, kv[k]); }
    }
    __syncthreads();
}
__device__ __forceinline__ void gla_g3(LAS unsigned char* lds, const GlaP& p, int c, int G) {
    const int tid = tid_now(), wid = __builtin_amdgcn_readfirstlane(tid >> 6), lane = tid & 63, l31 = lane & 31, hh = lane >> 5;
    LAS float* red = (LAS float*)lds;
    const int eb = wid & 3, ib = wid >> 2;
    struct In { f32x16 oi; bf16x8 sp[4], qe[4]; u32x2 rv[4]; };
    auto load = [&](int u, In& x) __attribute__((always_inline)) {
        const int n = u >> 2, h = u & 3; const size_t t = (size_t)64 * n + 32 * ib + l31;
        const float* oi = p.OI + ((size_t)u * 8 + wid) * 1024 + lane;
#pragma unroll
        for (int r = 0; r < 16; ++r) x.oi[r] = oi[r * 64];
        const bf16_t* sp = p.spT + ((size_t)u * 128 + 32 * eb + l31) * 64 + 8 * hh; const bf16_t* qp = p.QE + t * 256 + h * 64 + 8 * hh;
#pragma unroll
        for (int s = 0; s < 4; ++s) { x.sp[s] = *(const bf16x8*)(sp + 16 * s); x.qe[s] = *(const bf16x8*)(qp + 16 * s); }
#pragma unroll
        for (int g = 0; g < 4; ++g) x.rv[g] = *(const u32x2*)(p.Hp + t * HW + H_GR + h * 128 + 32 * eb + 8 * g + 4 * hh);
    };
    In cur, nxt;
    if (c < 1024) load(c, cur);
    for (int u = c; u < 1024; u += G) {
        const int n = u >> 2, h = u & 3;
        const bool hn = u + G < 1024;
        if (hn) load(u + G, nxt);
        f32x16 O = cur.oi;
        const size_t t = (size_t)64 * n + 32 * ib + l31;
#pragma unroll
        for (int s = 0; s < 4; ++s) O = __builtin_amdgcn_mfma_f32_32x32x16_bf16(cur.sp[s], cur.qe[s], O, 0, 0, 0);
        float ss = 0.f;
#pragma unroll
        for (int r = 0; r < 16; ++r) ss += O[r] * O[r];
        { auto rr = __builtin_amdgcn_permlane32_swap(__float_as_uint(ss), __float_as_uint(ss), false, false); ss = __uint_as_float(rr[0]) + __uint_as_float(rr[1]); }
        __syncthreads();
        if (hh == 0) red[eb * 64 + 32 * ib + l31] = ss;
        __syncthreads();
        const int ti = 32 * ib + l31;
        const float tot = (red[ti] + red[64 + ti]) + (red[128 + ti] + red[192 + ti]);
        const float rs = rsqrtf(tot * (1.f / 128.f) + 1e-6f);
#pragma unroll
        for (int g = 0; g < 4; ++g) { const int e0 = 32 * eb + 8 * g + 4 * hh;
            const u32x2 rv = cur.rv[g]; const f32x4 gn = *(const f32x4*)(p.ng + e0);
            float y[4];
#pragma unroll
            for (int j = 0; j < 4; ++j) { const float r_ = (j & 1) ? bfhi(rv[j >> 1]) : bflo(rv[j >> 1]); y[j] = O[4 * g + j] * rs * gn[j] * (r_ * frcp(1.f + __expf(-r_))); }
            u32x2 o = {cvt_pk_bf16(y[0], y[1]), cvt_pk_bf16(y[2], y[3])};
            *(u32x2*)(p.Ybb + t * 512 + h * 128 + e0) = o; }
        if (hn) cur = nxt;
    }
}
__device__ __forceinline__ void conv_phase(const GlaP& p, int gtid, int gthreads) {
    constexpr int NT = T * 64;
    for (int idx0 = gtid; idx0 < NT; idx0 += 2 * gthreads) {
        u32x4 av[2][3], xv[2][3], bv[2]; int tt[2], cc[2];
#pragma unroll
        for (int u = 0; u < 2; ++u) { const int idx = min(idx0 + u * gthreads, NT - 1); const int t = idx >> 6, c0 = (idx & 63) * 8; tt[u] = t; cc[u] = c0;
#pragma unroll
            for (int k = 0; k < 3; ++k) { const int ts = max(t - 2 + k, 0);
                av[u][k] = *(const u32x4*)(p.Hp + (size_t)ts * HW + H_AC + c0); xv[u][k] = *(const u32x4*)(p.Hp + (size_t)ts * HW + H_AX + c0); }
            bv[u] = *(const u32x4*)(p.Hp + (size_t)t * HW + H_AB + c0); }
#pragma unroll
        for (int u = 0; u < 2; ++u) { if (idx0 + u * gthreads < NT) { const int t = tt[u], c0 = cc[u];
            float y[8];
#pragma unroll
            for (int j = 0; j < 8; ++j) y[j] = 0.f;
#pragma unroll
            for (int k = 0; k < 3; ++k) { if (t - 2 + k >= 0) {
                const f32x4 w0 = *(const f32x4*)(p.wconv + k * 512 + c0), w1 = *(const f32x4*)(p.wconv + k * 512 + c0 + 4);
#pragma unroll
                for (int j = 0; j < 4; ++j) { y[2 * j] += (j < 2 ? w0[2 * j] : w1[2 * j - 4]) * (bflo(av[u][k][j]) * bflo(xv[u][k][j])); y[2 * j + 1] += (j < 2 ? w0[2 * j + 1] : w1[2 * j - 3]) * (bfhi(av[u][k][j]) * bfhi(xv[u][k][j])); } } }
            u32x4 o;
#pragma unroll
            for (int j = 0; j < 4; ++j) o[j] = cvt_pk_bf16(bflo(bv[u][j]) * y[2 * j], bfhi(bv[u][j]) * y[2 * j + 1]);
            *(u32x4*)(p.Yab + (size_t)t * 512 + c0) = o; } }
    }
}
__device__ __forceinline__ void attn_combine_bf16(const GlaP& p, int gtid, int gthreads) {
    constexpr int NT = 256 * 256 * 32;
    for (int idx0 = gtid; idx0 < NT; idx0 += 2 * gthreads) {
        float mv[2][2], lv[2][2]; u32x2 ov[2][2]; int nval[2]; size_t orow[2]; int ocol[2];
#pragma unroll
        for (int u = 0; u < 2; ++u) { const int idx = min(idx0 + u * gthreads, NT - 1);
            const int dq = idx & 31, row = (idx >> 5) & 255, g = idx >> 13, head = g >> 6, b = g & 63;
            const int s0 = b >= 32 ? 2 * (head * 64 + 2 * (63 - b)) : 2 * (head * 64 + 2 * b + 1) + 1;
            nval[u] = b >= 32 ? 2 : 1; orow[u] = (size_t)(b * 256 + row) * 512 + head * 128; ocol[u] = dq * 4;
#pragma unroll
            for (int k = 0; k < 2; ++k) { const size_t sl = (size_t)(s0 + (b >= 32 ? 2 * k : 0)) * 256 + row;
                const f32x2 ml = *(const f32x2*)(p.MLpart + sl * 2); mv[u][k] = ml[0]; lv[u][k] = ml[1];
                ov[u][k] = *(const u32x2*)((const bf16_t*)p.Opart + sl * 128 + dq * 4); } }
#pragma unroll
        for (int u = 0; u < 2; ++u) { if (idx0 + u * gthreads < NT) {
            float M = mv[u][0];
#pragma unroll
            for (int k = 1; k < 2; ++k) if (k < nval[u]) M = fmaxf(M, mv[u][k]);
            f32x4 acc = {0.f, 0.f, 0.f, 0.f}; float l = 0.f;
#pragma unroll
            for (int k = 0; k < 2; ++k) { const float w = k < nval[u] ? __builtin_amdgcn_exp2f(mv[u][k] - M) : 0.f;
                l += w * lv[u][k]; const f32x4 o = {bflo(ov[u][k][0]), bfhi(ov[u][k][0]), bflo(ov[u][k][1]), bfhi(ov[u][k][1])}; acc += o * w; }
            const float il = frcp(l);
            u32x2 o = {cvt_pk_bf16(acc[0] * il, acc[1] * il), cvt_pk_bf16(acc[2] * il, acc[3] * il)};
            *(u32x2*)(p.Ycb + orow[u] + ocol[u]) = o; } }
    }
}
struct P {
    const float *x, *pin; const int* pos;
    const float *ln0_g, *ln0_b, *w_in, *w_conv, *w_gg, *b_gg, *gla_ng, *qn_g, *kvn_g, *w_uq, *w_ukv, *w_br, *w_o, *ln1_g, *ln1_b, *w_grp, *b_grp, *w_exp, *b_exp,
                *w_gate, *w_up, *w_down, *ln2_g, *ln2_b, *w_pg, *b_pg, *w_pu, *ln3_g, *ln3_b;
    float* out;
    float *X, *Z, *cs, *sn, *ssq_q, *ssq_kv, *OI, *kvT, *decay, *MLpart, *ew;
    bf16_t *Db, *Xb, *Hp, *GVt, *Qb, *KnImg, *VtImg, *KrImg, *QE, *spT, *Yab, *Ybb, *Ycb, *Mgb, *Hbuf, *Ys, *Ub, *Pb;
    bf16_t *Wb_in, *Wb_gv, *Wb_uq, *Wb_uk, *Wb_uv, *Wb_br, *Wb_o, *Wb_gu, *Wb_d, *Wb_pg, *Wb_pu;
    int *cnt, *lists; unsigned* bar;
};
__device__ __forceinline__ MegaP mk_mega(const P& p) { MegaP m; m.w_in = p.w_in; m.Wb_in = p.Wb_in; m.Wb_gv = p.Wb_gv; m.Xb = p.Xb; m.Hp = p.Hp; m.GVt = p.GVt; m.ssq_q = p.ssq_q; m.ssq_kv = p.ssq_kv; return m; }
__device__ __forceinline__ MlaP mk_mla(const P& p) { MlaP q; q.w_uq = p.w_uq; q.w_ukv = p.w_ukv; q.qn_g = p.qn_g; q.kvn_g = p.kvn_g; q.Wb_uq = p.Wb_uq; q.Wb_uk = p.Wb_uk; q.Wb_uv = p.Wb_uv; q.Hp = p.Hp;
    q.ssq_q = p.ssq_q; q.ssq_kv = p.ssq_kv; q.cs = p.cs; q.sn = p.sn; q.Qb = p.Qb; q.KnImg = p.KnImg; q.VtImg = p.VtImg; q.KrImg = p.KrImg; q.Opart = p.Z; q.MLpart = p.MLpart; q.Yc = nullptr; return q; }
__device__ __forceinline__ GlaP mk_gla(const P& p, int layer) { GlaP g; g.Hp = p.Hp; g.GVt = p.GVt; g.wg = p.w_gg + layer * 16 * 256; g.bg = p.b_gg + layer * 256; g.ng = p.gla_ng + layer * 128; g.wconv = p.w_conv + layer * 3 * 512;
    g.QE = p.QE; g.OI = p.OI; g.kvT = p.kvT; g.decay = p.decay; g.spT = p.spT; g.Yab = p.Yab; g.Ybb = p.Ybb; g.Ycb = p.Ycb; g.Opart = p.Z; g.MLpart = p.MLpart; return g; }

struct CvJob { const float* W; bf16_t* Bt; const float* rs; int ldw, Ksrc, ldbt, n0, k0, kind, aux; };
struct MapId { __device__ __forceinline__ int operator()(int s) const { return s; } };
__device__ __forceinline__ int cv_map(int kind, int aux, int n) {
    if (kind == 0) return MapInMain{}(n);
    if (kind == 1) return aux + n;
    if (kind == 2) return MapQ{}(n);
    if (kind == 3) return MapKV{aux}(n);
    return n; }
__device__ __forceinline__ int cv_omap(int kind, int aux, int n) { return kind == 4 ? (n >> 7) * 256 + aux * 128 + (n & 127) : n; }
__device__ __forceinline__ bool cv_job(const P& p, int layer, int t, CvJob& j) {
    constexpr int S0 = 384, S1 = S0 + 32, S2 = S1 + 12, S3 = S2 + 8, S4 = S3 + 8, S5 = S4 + 96, S6 = S5 + 64, S7 = S6 + 64, S8 = S7 + 16, S9 = S8 + 1024, S10 = S9 + 1024, S11 = S10 + 1024;
    if (t >= S11) return false;
    j.rs = nullptr; j.aux = 0; j.kind = 5;
    if (t < S0) { j.W = p.w_in + (size_t)layer * D * INW; j.ldw = INW; j.Ksrc = D; j.Bt = p.Wb_in; j.ldbt = D; j.n0 = (t >> 2) * 64; j.k0 = (t & 3) * 256; j.kind = 0; }
    else if (t < S1) { const int u = t - S0; j.W = p.w_in + (size_t)layer * D * INW; j.ldw = INW; j.Ksrc = D; j.Bt = p.Wb_gv; j.ldbt = D; j.n0 = (u >> 2) * 64; j.k0 = (u & 3) * 256; j.kind = 1; j.aux = O_GV; }
    else if (t < S2) { const int u = t - S1; j.W = p.w_uq + (size_t)layer * 256 * 768; j.ldw = 768; j.Ksrc = 256; j.Bt = p.Wb_uq; j.ldbt = 256; j.n0 = u * 64; j.k0 = 0; j.kind = 2; j.rs = p.qn_g + layer * 256; }
    else if (t < S3) { const int u = t - S2; j.W = p.w_ukv + (size_t)layer * 128 * 1024; j.ldw = 1024; j.Ksrc = 128; j.Bt = p.Wb_uk; j.ldbt = 256; j.n0 = u * 64; j.k0 = 0; j.kind = 3; j.aux = 0; j.rs = p.kvn_g + layer * 128; }
    else if (t < S4) { const int u = t - S3; j.W = p.w_ukv + (size_t)layer * 128 * 1024; j.ldw = 1024; j.Ksrc = 128; j.Bt = p.Wb_uv; j.ldbt = 256; j.n0 = u * 64; j.k0 = 0; j.kind = 3; j.aux = 128; j.rs = p.kvn_g + layer * 128; }
    else if (t < S5) { const int u = t - S4, br = u >> 5, v = u & 31; j.W = p.w_br + (size_t)layer * 1536 * D + (size_t)br * 512 * D; j.ldw = D; j.Ksrc = 512; j.Bt = p.Wb_br + (size_t)br * 1024 * 512; j.ldbt = 512; j.n0 = (v >> 1) * 64; j.k0 = (v & 1) * 256; }
    else if (t < S6) { const int u = t - S5; j.W = p.w_o + (size_t)layer * D * D; j.ldw = D; j.Ksrc = D; j.Bt = p.Wb_o; j.ldbt = D; j.n0 = (u >> 2) * 64; j.k0 = (u & 3) * 256; }
    else if (t < S7) { const int u = t - S6; j.W = p.w_pg + (size_t)layer * D * D; j.ldw = D; j.Ksrc = D; j.Bt = p.Wb_pg; j.ldbt = D; j.n0 = (u >> 2) * 64; j.k0 = (u & 3) * 256; }
    else if (t < S8) { const int u = t - S7; j.W = p.w_pu + (size_t)layer * PLE * D; j.ldw = D; j.Ksrc = PLE; j.Bt = p.Wb_pu; j.ldbt = PLE; j.n0 = u * 64; j.k0 = 0; }
    else if (t < S9) { const int u = t - S8, e = u >> 4, v = u & 15; j.W = p.w_gate + ((size_t)layer * NE + e) * D * EH; j.ldw = EH; j.Ksrc = D; j.Bt = p.Wb_gu + (size_t)e * 512 * D; j.ldbt = D; j.n0 = (v >> 2) * 64; j.k0 = (v & 3) * 256; j.kind = 4; j.aux = 0; }
    else if (t < S10) { const int u = t - S9, e = u >> 4, v = u & 15; j.W = p.w_up + ((size_t)layer * NE + e) * D * EH; j.ldw = EH; j.Ksrc = D; j.Bt = p.Wb_gu + (size_t)e * 512 * D; j.ldbt = D; j.n0 = (v >> 2) * 64; j.k0 = (v & 3) * 256; j.kind = 4; j.aux = 1; }
    else { const int u = t - S10, e = u >> 4, v = u & 15; j.W = p.w_down + ((size_t)layer * NE + e) * EH * D; j.ldw = D; j.Ksrc = EH; j.Bt = p.Wb_d + (size_t)e * D * EH; j.ldbt = EH; j.n0 = v * 64; j.k0 = 0; }
    return true; }
__device__ __forceinline__ void cv_load(const CvJob& j, int tid, f32x4 (&v)[8]) {
    const int n4 = tid & 15, kr = tid >> 4; const int col = cv_map(j.kind, j.aux, j.n0 + 4 * n4);
#pragma unroll
    for (int r = 0; r < 8; ++r) { const int k = j.k0 + kr + 32 * r; v[r] = (f32x4){0.f, 0.f, 0.f, 0.f};
        if (col >= 0 && k < j.Ksrc) { v[r] = *(const f32x4*)(j.W + (size_t)k * j.ldw + col); if (j.rs) v[r] = v[r] * j.rs[k]; } }
}
__device__ __forceinline__ void ph_convert(LAS unsigned char* ldsl, const P& p, int layer) {
    LAS float* tile = (LAS float*)ldsl;
    const int tid = tid_now(), c = sgpr_now((int)blockIdx.x), G = gridDim.x;
    CvJob cur, nxt; f32x4 v[8], w[8];
    bool have = cv_job(p, layer, c, cur);
    if (have) cv_load(cur, tid, v);
    for (int t = c; have; t += G) {
        const bool hn = cv_job(p, layer, t + G, nxt);
        if (hn) cv_load(nxt, tid, w);
        __syncthreads();
        { const int n4 = tid & 15, kr = tid >> 4;
#pragma unroll
          for (int r = 0; r < 8; ++r) { LAS float* d = tile + (kr + 32 * r) * 65 + 4 * n4; d[0] = v[r][0]; d[1] = v[r][1]; d[2] = v[r][2]; d[3] = v[r][3]; } }
        __syncthreads();
        { const int kk = (tid & 127) * 2, nn = tid >> 7;
#pragma unroll
          for (int r = 0; r < 16; ++r) { const int n = nn + 4 * r;
              *(unsigned*)(cur.Bt + (size_t)cv_omap(cur.kind, cur.aux, cur.n0 + n) * cur.ldbt + cur.k0 + kk) = cvt_pk_bf16(tile[kk * 65 + n], tile[(kk + 1) * 65 + n]); } }
        have = hn; cur = nxt;
#pragma unroll
        for (int r = 0; r < 8; ++r) v[r] = w[r];
    }
    __syncthreads();
}

__device__ __forceinline__ float wsum(float v, int lane) {
#pragma unroll
    for (int o = 32; o > 0; o >>= 1) v += shx(v, o, lane);
    return v; }
template <int MODE>
__device__ __forceinline__ void ph_rows(const P& p, int layer) {
    const int lane = tid_now() & 63, gw = blockIdx.x * 8 + (tid_now() >> 6), nw = gridDim.x * 8;
    const float* gp = MODE == 0 ? p.ln0_g : MODE == 1 ? p.ln1_g + layer * D : MODE == 2 ? p.ln2_g + layer * D : p.ln3_g + layer * D;
    const float* bp = MODE == 0 ? p.ln0_b : MODE == 1 ? p.ln1_b + layer * D : MODE == 2 ? p.ln2_b + layer * D : p.ln3_b + layer * D;
    f32x4 gg[4], bb[4];
#pragma unroll
    for (int i = 0; i < 4; ++i) { gg[i] = *(const f32x4*)(gp + 256 * i + 4 * lane); bb[i] = *(const f32x4*)(bp + 256 * i + 4 * lane); }
    const float* in = MODE == 0 ? p.x : p.X;
    float* outf = (MODE == 3 && layer == DEPTH - 1) ? p.out : p.X;
    for (int row = gw; row < T; row += nw) {
        f32x4 v[4];
#pragma unroll
        for (int i = 0; i < 4; ++i) v[i] = *(const f32x4*)(in + (size_t)row * D + 256 * i + 4 * lane);
        if constexpr (MODE == 3) {
#pragma unroll
            for (int i = 0; i < 4; ++i) { const u32x2 dd = *(const u32x2*)(p.Db + (size_t)row * D + 256 * i + 4 * lane);
                v[i][0] = DN_ALPHA * v[i][0] + bflo(dd[0]); v[i][1] = DN_ALPHA * v[i][1] + bfhi(dd[0]); v[i][2] = DN_ALPHA * v[i][2] + bflo(dd[1]); v[i][3] = DN_ALPHA * v[i][3] + bfhi(dd[1]); } }
        if constexpr (MODE == 2) { const float w0 = p.ew[2 * row], w1 = p.ew[2 * row + 1];
#pragma unroll
            for (int i = 0; i < 4; ++i) { const u32x2 y0 = *(const u32x2*)(p.Ys + (size_t)(2 * row) * D + 256 * i + 4 * lane), y1 = *(const u32x2*)(p.Ys + (size_t)(2 * row + 1) * D + 256 * i + 4 * lane);
                v[i][0] = DN_ALPHA * v[i][0] + (w0 * bflo(y0[0]) + w1 * bflo(y1[0])); v[i][1] = DN_ALPHA * v[i][1] + (w0 * bfhi(y0[0]) + w1 * bfhi(y1[0]));
                v[i][2] = DN_ALPHA * v[i][2] + (w0 * bflo(y0[1]) + w1 * bflo(y1[1])); v[i][3] = DN_ALPHA * v[i][3] + (w0 * bfhi(y0[1]) + w1 * bfhi(y1[1])); } }
        float s = 0.f;
#pragma unroll
        for (int i = 0; i < 4; ++i) s += (v[i][0] + v[i][1]) + (v[i][2] + v[i][3]);
        const float mu = wsum(s, lane) * (1.f / D);
        float q = 0.f;
#pragma unroll
        for (int i = 0; i < 4; ++i) { v[i] = v[i] - mu; q += (v[i][0] * v[i][0] + v[i][1] * v[i][1]) + (v[i][2] * v[i][2] + v[i][3] * v[i][3]); }
        const float rs = rsqrtf(wsum(q, lane) * (1.f / D) + 1e-5f);
#pragma unroll
        for (int i = 0; i < 4; ++i) { v[i] = v[i] * rs * gg[i] + bb[i];
            *(f32x4*)(outf + (size_t)row * D + 256 * i + 4 * lane) = v[i];
            u32x2 o = {cvt_pk_bf16(v[i][0], v[i][1]), cvt_pk_bf16(v[i][2], v[i][3])};
            *(u32x2*)(p.Xb + (size_t)row * D + 256 * i + 4 * lane) = o; }
        if constexpr (MODE == 1) {
            const float* wg = p.w_grp + (size_t)layer * D * 8; const float* we = p.w_exp + (size_t)layer * D * 64;
            float gl[8];
#pragma unroll
            for (int g = 0; g < 8; ++g) gl[g] = 0.f;
#pragma unroll
            for (int i = 0; i < 4; ++i)
#pragma unroll
                for (int j = 0; j < 4; ++j) { const int k = 256 * i + 4 * lane + j; const f32x4 a = *(const f32x4*)(wg + k * 8), b = *(const f32x4*)(wg + k * 8 + 4); const float xv = v[i][j];
                    gl[0] = fmaf(xv, a[0], gl[0]); gl[1] = fmaf(xv, a[1], gl[1]); gl[2] = fmaf(xv, a[2], gl[2]); gl[3] = fmaf(xv, a[3], gl[3]);
                    gl[4] = fmaf(xv, b[0], gl[4]); gl[5] = fmaf(xv, b[1], gl[5]); gl[6] = fmaf(xv, b[2], gl[6]); gl[7] = fmaf(xv, b[3], gl[7]); }
            float mx = -INFINITY; int gt = 0;
#pragma unroll
            for (int g = 0; g < 8; ++g) { gl[g] = wsum(gl[g], lane) + p.b_grp[layer * 8 + g]; if (gl[g] > mx) { mx = gl[g]; gt = g; } }
            gt = __builtin_amdgcn_readfirstlane(gt);
            float sum = 0.f;
#pragma unroll
            for (int g = 0; g < 8; ++g) sum += expf(gl[g] - mx);
            const float pg = 1.f / sum;
            float el[8];
#pragma unroll
            for (int e = 0; e < 8; ++e) el[e] = 0.f;
#pragma unroll
            for (int i = 0; i < 4; ++i)
#pragma unroll
                for (int j = 0; j < 4; ++j) { const int k = 256 * i + 4 * lane + j; const f32x4 a = *(const f32x4*)(we + k * 64 + gt * 8), b = *(const f32x4*)(we + k * 64 + gt * 8 + 4); const float xv = v[i][j];
                    el[0] = fmaf(xv, a[0], el[0]); el[1] = fmaf(xv, a[1], el[1]); el[2] = fmaf(xv, a[2], el[2]); el[3] = fmaf(xv, a[3], el[3]);
                    el[4] = fmaf(xv, b[0], el[4]); el[5] = fmaf(xv, b[1], el[5]); el[6] = fmaf(xv, b[2], el[6]); el[7] = fmaf(xv, b[3], el[7]); }
            float v1 = -INFINITY, v2 = -INFINITY; int i1 = 0, i2 = 0;
#pragma unroll
            for (int e = 0; e < 8; ++e) { const float vv = wsum(el[e], lane) + p.b_exp[layer * 64 + gt * 8 + e];
                if (vv > v1) { v2 = v1; i2 = i1; v1 = vv; i1 = e; } else if (vv > v2) { v2 = vv; i2 = e; } }
            if (lane == 0) { const float e2 = expf(v2 - v1), w1 = pg / (1.f + e2), w2 = pg * e2 / (1.f + e2);
                const int ea = gt * 8 + i1, eb = gt * 8 + i2; int* cn = p.cnt + layer * 64;
                p.ew[2 * row] = w1; p.ew[2 * row + 1] = w2;
                const int pa = atomicAdd(&cn[ea], 1); p.lists[ea * LCAP + pa] = 2 * row;
                const int pb = atomicAdd(&cn[eb], 1); p.lists[eb * LCAP + pb] = 2 * row + 1; }
        }
    }
}

__device__ __forceinline__ void wsum8(float (&x)[8], int lane) {
    float y[4], z[2], w;
#pragma unroll
    for (int k = 0; k < 4; ++k) { const bool hi = lane & 32; const float snd = hi ? x[k] : x[k + 4], keep = hi ? x[k + 4] : x[k]; y[k] = keep + shx(snd, 32, lane); }
#pragma unroll
    for (int k = 0; k < 2; ++k) { const bool hi = lane & 16; const float snd = hi ? y[k] : y[k + 2], keep = hi ? y[k + 2] : y[k]; z[k] = keep + shx(snd, 16, lane); }
    { const bool hi = lane & 8; const float snd = hi ? z[0] : z[1], keep = hi ? z[1] : z[0]; w = keep + shx(snd, 8, lane); }
    w += shx(w, 4, lane); w += shx(w, 2, lane); w += shx(w, 1, lane);
#pragma unroll
    for (int k = 0; k < 8; ++k) x[k] = __int_as_float(__builtin_amdgcn_readlane(__float_as_int(w), (k >> 2) * 32 + ((k >> 1) & 1) * 16 + (k & 1) * 8));
}
__device__ __forceinline__ void ph_ln1_router(const P& p, int layer) {
    constexpr int RR = 2;
    const int tid = tid_now(), lane0 = tid & 63, gw = sgpr_now((int)blockIdx.x) * 8 + (tid >> 6), nw = gridDim.x * 8;
    const float* gp = p.ln1_g + layer * D; const float* bp = p.ln1_b + layer * D;
    const float* wg = p.w_grp + (size_t)layer * D * 8; const float* we = p.w_exp + (size_t)layer * D * 64;
    for (int row0 = gw * RR; row0 < T; row0 += nw * RR) {
        int lane = lane0; asm volatile("" : "+v"(lane));
        f32x4 v[RR][4];
#pragma unroll
        for (int r = 0; r < RR; ++r)
#pragma unroll
            for (int i = 0; i < 4; ++i) { v[r][i] = *(const f32x4*)(p.X + (size_t)(row0 + r) * D + 256 * i + 4 * lane);
                const u32x2 dd = *(const u32x2*)(p.Db + (size_t)(row0 + r) * D + 256 * i + 4 * lane);
                v[r][i][0] = DN_ALPHA * v[r][i][0] + bflo(dd[0]); v[r][i][1] = DN_ALPHA * v[r][i][1] + bfhi(dd[0]); v[r][i][2] = DN_ALPHA * v[r][i][2] + bflo(dd[1]); v[r][i][3] = DN_ALPHA * v[r][i][3] + bfhi(dd[1]); }
#pragma unroll
        for (int r = 0; r < RR; ++r) {
            float s = 0.f;
#pragma unroll
            for (int i = 0; i < 4; ++i) s += (v[r][i][0] + v[r][i][1]) + (v[r][i][2] + v[r][i][3]);
            const float mu = wsum(s, lane) * (1.f / D);
            float q = 0.f;
#pragma unroll
            for (int i = 0; i < 4; ++i) { v[r][i] = v[r][i] - mu; q += (v[r][i][0] * v[r][i][0] + v[r][i][1] * v[r][i][1]) + (v[r][i][2] * v[r][i][2] + v[r][i][3] * v[r][i][3]); }
            const float rs = rsqrtf(wsum(q, lane) * (1.f / D) + 1e-5f);
#pragma unroll
            for (int i = 0; i < 4; ++i) { const f32x4 gg = *(const f32x4*)(gp + 256 * i + 4 * lane), bb = *(const f32x4*)(bp + 256 * i + 4 * lane);
                v[r][i] = v[r][i] * rs * gg + bb;
                *(f32x4*)(p.X + (size_t)(row0 + r) * D + 256 * i + 4 * lane) = v[r][i];
                u32x2 o = {cvt_pk_bf16(v[r][i][0], v[r][i][1]), cvt_pk_bf16(v[r][i][2], v[r][i][3])};
                *(u32x2*)(p.Xb + (size_t)(row0 + r) * D + 256 * i + 4 * lane) = o; } }
        float gl[RR][8];
#pragma unroll
        for (int r = 0; r < RR; ++r)
#pragma unroll
            for (int g = 0; g < 8; ++g) gl[r][g] = 0.f;
#pragma unroll
        for (int i = 0; i < 4; ++i) { asm volatile("" : "+v"(lane) :: "memory");
#pragma unroll
            for (int j = 0; j < 4; ++j) { const int k = 256 * i + 4 * lane + j; const f32x4 a = *(const f32x4*)(wg + k * 8), b = *(const f32x4*)(wg + k * 8 + 4);
#pragma unroll
                for (int r = 0; r < RR; ++r) { const float xv = v[r][i][j];
                    gl[r][0] = fmaf(xv, a[0], gl[r][0]); gl[r][1] = fmaf(xv, a[1], gl[r][1]); gl[r][2] = fmaf(xv, a[2], gl[r][2]); gl[r][3] = fmaf(xv, a[3], gl[r][3]);
                    gl[r][4] = fmaf(xv, b[0], gl[r][4]); gl[r][5] = fmaf(xv, b[1], gl[r][5]); gl[r][6] = fmaf(xv, b[2], gl[r][6]); gl[r][7] = fmaf(xv, b[3], gl[r][7]); } } }
        int gt[RR]; float pg[RR];
#pragma unroll
        for (int r = 0; r < RR; ++r) { wsum8(gl[r], lane);
            float mx = -INFINITY; int gi = 0;
#pragma unroll
            for (int g = 0; g < 8; ++g) { gl[r][g] += p.b_grp[layer * 8 + g]; if (gl[r][g] > mx) { mx = gl[r][g]; gi = g; } }
            float sum = 0.f;
#pragma unroll
            for (int g = 0; g < 8; ++g) sum += expf(gl[r][g] - mx);
            gt[r] = __builtin_amdgcn_readfirstlane(gi); pg[r] = 1.f / sum; }
        float el[RR][8];
#pragma unroll
        for (int r = 0; r < RR; ++r) {
#pragma unroll
            for (int e = 0; e < 8; ++e) el[r][e] = 0.f;
#pragma unroll
            for (int i = 0; i < 4; ++i) { asm volatile("" : "+v"(lane) :: "memory");
#pragma unroll
                for (int j = 0; j < 4; ++j) { const int k = 256 * i + 4 * lane + j; const f32x4 a = *(const f32x4*)(we + k * 64 + gt[r] * 8), b = *(const f32x4*)(we + k * 64 + gt[r] * 8 + 4); const float xv = v[r][i][j];
                    el[r][0] = fmaf(xv, a[0], el[r][0]); el[r][1] = fmaf(xv, a[1], el[r][1]); el[r][2] = fmaf(xv, a[2], el[r][2]); el[r][3] = fmaf(xv, a[3], el[r][3]);
                    el[r][4] = fmaf(xv, b[0], el[r][4]); el[r][5] = fmaf(xv, b[1], el[r][5]); el[r][6] = fmaf(xv, b[2], el[r][6]); el[r][7] = fmaf(xv, b[3], el[r][7]); } } }
#pragma unroll
        for (int r = 0; r < RR; ++r) { wsum8(el[r], lane);
            float v1 = -INFINITY, v2 = -INFINITY; int i1 = 0, i2 = 0;
#pragma unroll
            for (int e = 0; e < 8; ++e) { const float vv = el[r][e] + p.b_exp[layer * 64 + gt[r] * 8 + e];
                if (vv > v1) { v2 = v1; i2 = i1; v1 = vv; i1 = e; } else if (vv > v2) { v2 = vv; i2 = e; } }
            if (lane == 0) { const int row = row0 + r; const float e2 = expf(v2 - v1), w1 = pg[r] / (1.f + e2), w2 = pg[r] * e2 / (1.f + e2);
                const int ea = gt[r] * 8 + i1, eb = gt[r] * 8 + i2; int* cn = p.cnt + layer * 64;
                p.ew[2 * row] = w1; p.ew[2 * row + 1] = w2;
                const int pa = atomicAdd(&cn[ea], 1); p.lists[ea * LCAP + pa] = 2 * row;
                const int pb = atomicAdd(&cn[eb], 1); p.lists[eb * LCAP + pb] = 2 * row + 1; } }
    }
}
__device__ __forceinline__ void ph_prologue(const P& p) {
    const int gtid = blockIdx.x * NTHR + tid_now(), gth = gridDim.x * NTHR;
    for (int idx = gtid; idx < T * 32; idx += gth) { const int t = idx >> 5, i = idx & 31;
        const float inv = (float)(1.0 / pow(10000.0, (double)(2 * i) / 64.0)); const float ang = (float)p.pos[t] * inv;
        p.cs[idx] = (float)cos((double)ang); p.sn[idx] = (float)sin((double)ang); }
    for (size_t i = gtid; i < (size_t)DEPTH * T * PLE / 4; i += gth) { const f32x4 v = ((const f32x4*)p.pin)[i]; u32x2 o = {cvt_pk_bf16(v[0], v[1]), cvt_pk_bf16(v[2], v[3])}; ((u32x2*)p.Pb)[i] = o; }
    ph_rows<0>(p, 0);
}

struct SchedBr { __device__ __forceinline__ bool carry(const ge::Unit& u) const { return u.g < 2; }
    const char* Ya; const char* Yb; const char* Yc; const char* W; int c, G;
    __device__ __forceinline__ bool next(int i, ge::Unit& u) const { const int tile = (i / 3) * G + c; if (tile >= 256) return false; u.g = i % 3; ge::tile_order(tile, 64, 4, u.pm, u.pn); return true; }
    __device__ __forceinline__ const char* aptr(const ge::Unit& u) const { return (u.g == 0 ? Ya : u.g == 1 ? Yb : Yc) + (size_t)u.pm * 256 * 512 * 2; }
    __device__ __forceinline__ const char* bptr(const ge::Unit& u) const { return W + ((size_t)u.g * 1024 + u.pn * 256) * 512 * 2; } };
struct EpiBr { const bf16_t* Hp; bf16_t* Mgb;
    __device__ __forceinline__ void operator()(ge::Acc& acc, const ge::Unit& u, int wr, int wc, int fr, int fq) const {
        const int row0 = u.pm * 256 + wr * 64 + fr, col0 = u.pn * 256 + wc * 32 + 8 * fq;
#pragma unroll
        for (int ai = 0; ai < 2; ++ai)
#pragma unroll
            for (int m = 0; m < 4; ++m) { asm volatile("" ::: "memory"); const int row = row0 + ai * 128 + m * 16;
#pragma unroll
                for (int bj = 0; bj < 2; ++bj) { const int col = col0 + bj * 128;
                    const u32x4 gt = *(const u32x4*)(Hp + (size_t)row * HW + H_GTA + u.g * 1024 + col);
                    f32x4 s0 = {bflo(gt[0]), bfhi(gt[0]), bflo(gt[1]), bfhi(gt[1])}, s1 = {bflo(gt[2]), bfhi(gt[2]), bflo(gt[3]), bfhi(gt[3])};
                    if (u.g < 2) { const u32x4 gn = *(const u32x4*)(Hp + (size_t)row * HW + H_GTA + (u.g + 1) * 1024 + col);
                        f32x4 d0 = {bflo(gn[0]), bfhi(gn[0]), bflo(gn[1]), bfhi(gn[1])}, d1 = {bflo(gn[2]), bfhi(gn[2]), bflo(gn[3]), bfhi(gn[3])};
#pragma unroll
                        for (int j = 0; j < 4; ++j) { s0[j] = s0[j] * frcp(d0[j]); s1[j] = s1[j] * frcp(d1[j]); } }
                    acc[ai][bj][m][0] = acc[ai][bj][m][0] * s0; acc[ai][bj][m][1] = acc[ai][bj][m][1] * s1;
                    if (u.g == 2) { const f32x4 v0 = acc[ai][bj][m][0], v1 = acc[ai][bj][m][1];
                        u32x4 o = {cvt_pk_bf16(v0[0], v0[1]), cvt_pk_bf16(v0[2], v0[3]), cvt_pk_bf16(v1[0], v1[1]), cvt_pk_bf16(v1[2], v1[3])}; *(u32x4*)(Mgb + (size_t)row * D + col) = o; } } }
    } };
struct SchedT4 : ge::NoCarry { const char* A; const char* B; int lda2, ldb2, c, G;
    __device__ __forceinline__ bool next(int i, ge::Unit& u) const { const int L = i * G + c; if (L >= 256) return false; u.g = 0; ge::tile_order(L, 64, 4, u.pm, u.pn); return true; }
    __device__ __forceinline__ const char* aptr(const ge::Unit& u) const { return A + (size_t)u.pm * lda2; }
    __device__ __forceinline__ const char* bptr(const ge::Unit& u) const { return B + (size_t)u.pn * ldb2; } };
struct EpiRes { bf16_t* Db;
    __device__ __forceinline__ void operator()(ge::Acc& acc, const ge::Unit& u, int wr, int wc, int fr, int fq) const {
        const int row0 = u.pm * 256 + wr * 64 + fr, col0 = u.pn * 256 + wc * 32 + 8 * fq;
#pragma unroll
        for (int ai = 0; ai < 2; ++ai)
#pragma unroll
            for (int m = 0; m < 4; ++m) { const size_t o = (size_t)(row0 + ai * 128 + m * 16) * D + col0;
#pragma unroll
                for (int bj = 0; bj < 2; ++bj) { const f32x4 v0 = acc[ai][bj][m][0], v1 = acc[ai][bj][m][1];
                    u32x4 w = {cvt_pk_bf16(v0[0], v0[1]), cvt_pk_bf16(v0[2], v0[3]), cvt_pk_bf16(v1[0], v1[1]), cvt_pk_bf16(v1[2], v1[3])}; *(u32x4*)(Db + o + bj * 128) = w; } }
    } };
struct EpiU { bf16_t* Ub;
    __device__ __forceinline__ void operator()(ge::Acc& acc, const ge::Unit& u, int wr, int wc, int fr, int fq) const {
        const int row0 = u.pm * 256 + wr * 64 + fr, col0 = u.pn * 256 + wc * 32 + 8 * fq;
#pragma unroll
        for (int ai = 0; ai < 2; ++ai)
#pragma unroll
            for (int m = 0; m < 4; ++m) { const size_t o = (size_t)(row0 + ai * 128 + m * 16) * D + col0;
#pragma unroll
                for (int bj = 0; bj < 2; ++bj) { const f32x4 v0 = acc[ai][bj][m][0], v1 = acc[ai][bj][m][1];
                    u32x4 w = {cvt_pk_bf16(v0[0], v0[1]), cvt_pk_bf16(v0[2], v0[3]), cvt_pk_bf16(v1[0], v1[1]), cvt_pk_bf16(v1[2], v1[3])}; *(u32x4*)(Ub + o + bj * 128) = w; } }
    } };
struct EpiPle { bf16_t* Db; const bf16_t* Ub; const float* bias;
    __device__ __forceinline__ void operator()(ge::Acc& acc, const ge::Unit& u, int wr, int wc, int fr, int fq) const {
        const int row0 = u.pm * 256 + wr * 64 + fr, col0 = u.pn * 256 + wc * 32 + 8 * fq;
        f32x4 bv[2][2];
#pragma unroll
        for (int bj = 0; bj < 2; ++bj) { bv[bj][0] = *(const f32x4*)(bias + col0 + bj * 128); bv[bj][1] = *(const f32x4*)(bias + col0 + bj * 128 + 4); }
#pragma unroll
        for (int ai = 0; ai < 2; ++ai)
#pragma unroll
            for (int m = 0; m < 4; ++m) { asm volatile("" ::: "memory"); const size_t o = (size_t)(row0 + ai * 128 + m * 16) * D + col0;
#pragma unroll
                for (int bj = 0; bj < 2; ++bj) { const u32x4 uu = *(const u32x4*)(Ub + o + bj * 128);
                    f32x4 g0 = acc[ai][bj][m][0] + bv[bj][0], g1 = acc[ai][bj][m][1] + bv[bj][1];
#pragma unroll
                    for (int j = 0; j < 4; ++j) { g0[j] = frcp(1.f + __expf(-g0[j])); g1[j] = frcp(1.f + __expf(-g1[j])); }
                    const f32x4 u0 = {bflo(uu[0]), bfhi(uu[0]), bflo(uu[1]), bfhi(uu[1])}, u1 = {bflo(uu[2]), bfhi(uu[2]), bflo(uu[3]), bfhi(uu[3])};
                    g0 = g0 * u0; g1 = g1 * u1;
                    u32x4 w = {cvt_pk_bf16(g0[0], g0[1]), cvt_pk_bf16(g0[2], g0[3]), cvt_pk_bf16(g1[0], g1[1]), cvt_pk_bf16(g1[2], g1[3])}; *(u32x4*)(Db + o + bj * 128) = w; } }
    } };

__device__ __forceinline__ void moe_table(LAS unsigned char* lds, const int* cnt) {
    LAS int* te = (LAS int*)(lds + 131072); LAS int* tr = te + 256; LAS int* cl = tr + 256; LAS int* nt = cl + 64;
    __syncthreads();
    if (tid_now() < 64) cl[tid_now()] = cnt[tid_now()];
    __syncthreads();
    if (tid_now() == 0) { int n = 0; for (int e = 0; e < NE; ++e) for (int r = 0; r < cl[e]; r += 256) { te[n] = e; tr[n] = r; ++n; } nt[0] = n; }
    __syncthreads();
}
struct SchedM1 : ge::NoCarry { const char* Xb; const char* W; const int* lists; LAS int* te; int c, G;
    __device__ __forceinline__ bool next(int i, ge::Unit& u) const { const int L = i * G + c; if (L >= 2 * te[576]) return false; u.pm = L >> 1; u.pn = L & 1; u.g = te[u.pm]; return true; }
    __device__ __forceinline__ int arow(const ge::Unit& u, int r) const { const int n = te[512 + u.g], idx = min(te[256 + u.pm] + r, n - 1); return lists[u.g * LCAP + idx] >> 1; }
    __device__ __forceinline__ const char* aptr(const ge::Unit&) const { return Xb; }
    __device__ __forceinline__ const char* bptr(const ge::Unit& u) const { return W + ((size_t)u.g * 512 + u.pn * 256) * D * 2; } };
struct EpiM1 { bf16_t* Hbuf;
    __device__ __forceinline__ void operator()(ge::Acc& acc, const ge::Unit& u, int wr, int wc, int fr, int fq) const {
#pragma unroll
        for (int ai = 0; ai < 2; ++ai)
#pragma unroll
            for (int m = 0; m < 4; ++m) { const int row = ai * 128 + wr * 64 + m * 16 + fr;
                float h[8];
#pragma unroll
                for (int n = 0; n < 2; ++n)
#pragma unroll
                    for (int j = 0; j < 4; ++j) { const float g = acc[ai][0][m][n][j], uu = acc[ai][1][m][n][j]; h[4 * n + j] = g * frcp(1.f + __expf(-g)) * uu; }
                u32x4 o = {cvt_pk_bf16(h[0], h[1]), cvt_pk_bf16(h[2], h[3]), cvt_pk_bf16(h[4], h[5]), cvt_pk_bf16(h[6], h[7])};
                *(u32x4*)(Hbuf + ((size_t)u.pm * 256 + row) * EH + u.pn * 128 + wc * 32 + 8 * fq) = o; }
    } };
struct SchedM2 : ge::NoCarry { const char* Hb; const char* W; LAS int* te; int c, G;
    __device__ __forceinline__ bool next(int i, ge::Unit& u) const { const int L = i * G + c; if (L >= 4 * te[576]) return false; u.pm = L >> 2; u.pn = L & 3; u.g = te[u.pm]; return true; }
    __device__ __forceinline__ const char* aptr(const ge::Unit& u) const { return Hb + (size_t)u.pm * 256 * EH * 2; }
    __device__ __forceinline__ const char* bptr(const ge::Unit& u) const { return W + ((size_t)u.g * D + u.pn * 256) * EH * 2; } };
struct EpiM2 { bf16_t* Ys; const int* lists; LAS int* te;
    __device__ __forceinline__ void operator()(ge::Acc& acc, const ge::Unit& u, int wr, int wc, int fr, int fq) const {
        const int r0 = te[256 + u.pm], n = te[512 + u.g];
#pragma unroll
        for (int ai = 0; ai < 2; ++ai)
#pragma unroll
            for (int m = 0; m < 4; ++m) { const int row = r0 + ai * 128 + wr * 64 + m * 16 + fr;
                if (row < n) { const int a = lists[u.g * LCAP + row];
#pragma unroll
                    for (int bj = 0; bj < 2; ++bj) { const f32x4 v0 = acc[ai][bj][m][0], v1 = acc[ai][bj][m][1];
                        u32x4 o = {cvt_pk_bf16(v0[0], v0[1]), cvt_pk_bf16(v0[2], v0[3]), cvt_pk_bf16(v1[0], v1[1]), cvt_pk_bf16(v1[2], v1[3])};
                        *(u32x4*)(Ys + (size_t)a * D + u.pn * 256 + bj * 128 + wc * 32 + 8 * fq) = o; } } }
    } };

#define XB_TMO      128
#define XB_XCNT(j)  (256  + 64 * (j))
#define XB_XSUB(j)  (1280 + 64 * (j))
#define XB_XGEN(j)  (2304 + 64 * (j))
#define XB_TOP      3328
#define XB_TOPGEN   3392
#define XCD_BAR_WORDS 3456
#define XB_SPIN_CAP (1u << 18)

__device__ __forceinline__ unsigned xb_ld(unsigned* p)              { return __hip_atomic_load(p, __ATOMIC_RELAXED, __HIP_MEMORY_SCOPE_AGENT); }
__device__ __forceinline__ unsigned xb_add(unsigned* p, unsigned v) { return __hip_atomic_fetch_add(p, v, __ATOMIC_RELAXED, __HIP_MEMORY_SCOPE_AGENT); }
__device__ __forceinline__ unsigned xb_xcc_id() { return (unsigned)__builtin_amdgcn_s_getreg((3 << 11) | 20) & 0xFu; }
#define XB_SPIN(cond, bar) do { unsigned _sp = 0; while (cond) { __builtin_amdgcn_s_sleep(1); \
    if ((++_sp & 255u) == 0u) { if (xb_ld(&(bar)[XB_TMO])) break; if (_sp > XB_SPIN_CAP) { atomicAdd(&(bar)[XB_TMO], 1u); break; } } } } while (0)

struct XcdBarrier {
    unsigned* bar; unsigned x;
    volatile LAS unsigned* st;
};

__device__ __forceinline__ XcdBarrier xcd_barrier_post(unsigned* bar, volatile LAS unsigned* st) {
    XcdBarrier b; b.bar = bar; b.x = xb_xcc_id(); b.st = st;
    if (threadIdx.x == 0) (void)xb_add(&bar[XB_XCNT(b.x)], 1u);
    return b;
}
__device__ __forceinline__ void xcd_barrier_complete(unsigned* bar, unsigned x, unsigned& nloc, unsigned& nx) {
    const unsigned G = gridDim.x * gridDim.y * gridDim.z;
    unsigned sum, cnt, mine, sp = 0u;
    for (;;) {
        sum = 0u; cnt = 0u; mine = 0u;
#pragma unroll
        for (unsigned j = 0; j < 16; ++j) { const unsigned c = xb_ld(&bar[XB_XCNT(j)]); sum += c; cnt += (c > 0u) ? 1u : 0u; mine = (j == x) ? c : mine; }
        if (sum == G) break;
        __builtin_amdgcn_s_sleep(1);
        if ((++sp & 255u) == 0u) { if (xb_ld(&bar[XB_TMO])) break; if (sp > XB_SPIN_CAP) { atomicAdd(&bar[XB_TMO], 1u); break; } }
    }
    nloc = mine > 0u ? mine : 1u; nx = cnt > 0u ? cnt : 1u;
}

__device__ __forceinline__ void xcd_barrier(const XcdBarrier& b) {
    asm volatile("s_waitcnt vmcnt(0)" ::: "memory");
    __syncthreads();
    if (threadIdx.x == 0) {
        unsigned* bar = b.bar;
        __builtin_amdgcn_s_waitcnt(0);
        unsigned nloc = b.st[0], nx = b.st[1];
        if (nloc == 0u) { xcd_barrier_complete(bar, b.x, nloc, nx); b.st[0] = nloc; b.st[1] = nx; }
        const unsigned old = xb_add(&bar[XB_XSUB(b.x)], 1u);
        const unsigned gen = old / nloc;
        if (old + 1u == (gen + 1u) * nloc) {
            __builtin_amdgcn_fence(__ATOMIC_RELEASE, "agent");
            asm volatile("s_waitcnt vmcnt(0)" ::: "memory");
            const unsigned og = xb_add(&bar[XB_TOP], 1u);
            const unsigned tg = og / nx;
            if (og + 1u == (tg + 1u) * nx) xb_add(&bar[XB_TOPGEN], 1u);
            else XB_SPIN(xb_ld(&bar[XB_TOPGEN]) == tg, bar);
            __builtin_amdgcn_fence(__ATOMIC_ACQUIRE, "agent");
            xb_add(&bar[XB_XGEN(b.x)], 1u);
            asm volatile("s_waitcnt vmcnt(0)" ::: "memory");
        } else {
            XB_SPIN(xb_ld(&bar[XB_XGEN(b.x)]) == gen, bar);
            __builtin_amdgcn_fence(__ATOMIC_ACQUIRE, "agent");
            asm volatile("s_waitcnt vmcnt(0)" ::: "memory");
        }
    }
    __syncthreads();
}

enum { PH_PRO = 0, PH_CONV, PH_IN, PH_PREP_Q, PH_PREP_K, PH_PREP_V, PH_PREP_G, PH_ATT, PH_FIN, PH_BR, PH_WO, PH_LN1, PH_M1, PH_M2, PH_LN2, PH_PLE, PH_LN3 };
template <int PH> __global__ __launch_bounds__(NTHR, 2) void k_ph(P p, int layer) {
    extern __shared__ __attribute__((aligned(16))) unsigned char smem[];
    LAS unsigned char* lds = (LAS unsigned char*)smem;
    tid_setup();
    const int c = blockIdx.x, G = gridDim.x;
    if constexpr (PH == PH_PRO) ph_prologue(p);
    if constexpr (PH == PH_CONV) ph_convert(lds, p, layer);
    if constexpr (PH == PH_IN) { const MegaP m = mk_mega(p); SchedIn S{{}, (const char*)m.Xb, (const char*)m.Wb_in, (const char*)m.Wb_gv, c, G, 0}; EpiIn<2> E{m.Hp, m.GVt, m.ssq_q, m.ssq_kv}; ge::gemm_stream<EpiIn<2>, SchedIn, false>(lds, D, D, D, S, E); }
    if constexpr (PH == PH_PREP_Q) { const MlaP q = mk_mla(p); SchedMla<0> S{{}, (const char*)(q.Hp + H_CQ), (const char*)q.Wb_uq, c, G}; EpiMla<0> E{q}; ge::gemm_stream<EpiMla<0>, SchedMla<0>, false>(lds, 256, HW, 256, S, E); }
    if constexpr (PH == PH_PREP_K) { const MlaP q = mk_mla(p); SchedMla<1> S{{}, (const char*)(q.Hp + H_CKV), (const char*)q.Wb_uk, (c + 64) % G, G}; EpiMla<1> E{q}; ge::gemm_stream<EpiMla<1>, SchedMla<1>, false>(lds, 256, HW, 256, S, E); }
    if constexpr (PH == PH_PREP_V) { const MlaP q = mk_mla(p); SchedMla<2> S{{}, (const char*)q.Wb_uv, (const char*)(q.Hp + H_CKV), (c + 192) % G, G}; EpiMla<2> E{q}; ge::gemm_stream<EpiMla<2>, SchedMla<2>, false>(lds, 256, 256, HW, S, E); }
    if constexpr (PH == PH_PREP_G) { { const MegaP m = mk_mega(p); SchedIn S{{}, (const char*)m.Xb, (const char*)m.Wb_in, (const char*)m.Wb_gv, (c + 128) % G, G, 1}; EpiIn<0> E{m.Hp, m.GVt, m.ssq_q, m.ssq_kv}; ge::gemm_stream<EpiIn<0>, SchedIn, false>(lds, D, D, D, S, E); } const MlaP q = mk_mla(p); kr_phase(q, c * NTHR + tid_now(), G * NTHR); const GlaP g = mk_gla(p, layer); gla_g1(lds, g, c, G); }
    if constexpr (PH == PH_ATT) { const GlaP g = mk_gla(p, layer); gla_g2(lds, g, c); const MlaP q = mk_mla(p); attn_phase(lds, q, c); }
    if constexpr (PH == PH_FIN) { const GlaP g = mk_gla(p, layer); gla_g3(lds, g, c, G); conv_phase(g, c * NTHR + tid_now(), G * NTHR); attn_combine_bf16(g, c * NTHR + tid_now(), G * NTHR); }
    if constexpr (PH == PH_BR) { SchedBr S{(const char*)p.Yab, (const char*)p.Ybb, (const char*)p.Ycb, (const char*)p.Wb_br, c, G}; EpiBr E{p.Hp, p.Mgb}; ge::gemm_stream<EpiBr, SchedBr, false>(lds, 512, 512, 512, S, E); }
    if constexpr (PH == PH_WO) { SchedT4 S{{}, (const char*)p.Mgb, (const char*)p.Wb_o, 256 * D * 2, 256 * D * 2, c, G}; EpiRes E{p.Db}; ge::gemm_stream<EpiRes, SchedT4, false>(lds, D, D, D, S, E); }
    if constexpr (PH == PH_LN1) ph_ln1_router(p, layer);
    if constexpr (PH == PH_M1) { moe_table(lds, p.cnt + layer * 64); LAS int* te = (LAS int*)(lds + 131072);
        SchedM1 S{{}, (const char*)p.Xb, (const char*)p.Wb_gu, p.lists, te, c, G}; EpiM1 E{p.Hbuf}; ge::gemm_stream<EpiM1, SchedM1, true>(lds, D, D, D, S, E); }
    if constexpr (PH == PH_M2) { moe_table(lds, p.cnt + layer * 64); LAS int* te = (LAS int*)(lds + 131072);
        SchedM2 S{{}, (const char*)p.Hbuf, (const char*)p.Wb_d, te, c, G}; EpiM2 E{p.Ys, p.lists, te}; ge::gemm_stream<EpiM2, SchedM2, false>(lds, EH, EH, EH, S, E); }
    if constexpr (PH == PH_LN2) ph_rows<2>(p, layer);
    if constexpr (PH == PH_PLE) {
        { SchedT4 S{{}, (const char*)(p.Pb + (size_t)layer * T * PLE), (const char*)p.Wb_pu, 256 * PLE * 2, 256 * PLE * 2, c, G}; EpiU E{p.Ub}; ge::gemm_stream<EpiU, SchedT4, false>(lds, PLE, PLE, PLE, S, E); }
        { SchedT4 S{{}, (const char*)p.Xb, (const char*)p.Wb_pg, 256 * D * 2, 256 * D * 2, c, G}; EpiPle E{p.Db, p.Ub, p.b_pg + layer * D}; ge::gemm_stream<EpiPle, SchedT4, false>(lds, D, D, D, S, E); } }
    if constexpr (PH == PH_LN3) ph_rows<3>(p, layer);
}


typedef const P __attribute__((address_space(4))) CP;
__device__ __forceinline__ P load_params() { CP* q = (CP*)__builtin_amdgcn_kernarg_segment_ptr(); asm volatile("" : "+s"(q)); return *(const P*)q; }
#define GRID_BAR() do { XcdBarrier b_; b_.bar = load_params().bar; b_.x = xb_xcc_id(); b_.st = xbw; xcd_barrier(b_); } while (0)
__global__ __launch_bounds__(NTHR, 2) void k_mega(P p_arg) {
    extern __shared__ __attribute__((aligned(16))) unsigned char smem[];
    LAS unsigned char* lds = (LAS unsigned char*)smem;
    const int G = NBLK;
#define c sgpr_now((int)blockIdx.x)
    volatile LAS unsigned* xbw = (volatile LAS unsigned*)(lds + XBW_OFF);
    tid_setup();
    if (tid_now() < 4) xbw[tid_now()] = 0u;
    __syncthreads();
    (void)xcd_barrier_post(p_arg.bar, xbw);
    { const P p = load_params(); ph_prologue(p); }
    { const P p = load_params(); ph_convert(lds, p, 0); }
    GRID_BAR();
    for (int layer = 0; layer < DEPTH; ++layer) {
        { const P p = load_params(); const MegaP m = mk_mega(p); SchedIn S{{}, (const char*)m.Xb, (const char*)m.Wb_in, (const char*)m.Wb_gv, c, G, 0}; EpiIn<2> E{m.Hp, m.GVt, m.ssq_q, m.ssq_kv}; ge::gemm_stream<EpiIn<2>, SchedIn, false>(lds, D, D, D, S, E); }
        GRID_BAR();
        { const P p = load_params(); const MlaP q = mk_mla(p);
          { SchedMla<0> S{{}, (const char*)(q.Hp + H_CQ), (const char*)q.Wb_uq, (c >= 128 ? c - 128 : -1), 128}; EpiMla<0> E{q}; ge::gemm_stream<EpiMla<0>, SchedMla<0>, false>(lds, 256, HW, 256, S, E); }
          { SchedMla<1> S{{}, (const char*)(q.Hp + H_CKV), (const char*)q.Wb_uk, (c >= 128 ? c - 128 : -1), 128}; EpiMla<1> E{q}; ge::gemm_stream<EpiMla<1>, SchedMla<1>, false>(lds, 256, HW, 256, S, E); }
          { SchedMla<2> S{{}, (const char*)q.Wb_uv, (const char*)(q.Hp + H_CKV), (c >= 128 ? c - 128 : -1), 128}; EpiMla<2> E{q}; ge::gemm_stream<EpiMla<2>, SchedMla<2>, false>(lds, 256, 256, HW, S, E); }
          { const MegaP m = mk_mega(p); SchedIn S{{}, (const char*)m.Xb, (const char*)m.Wb_in, (const char*)m.Wb_gv, c, G, 1}; EpiIn<0> E{m.Hp, m.GVt, m.ssq_q, m.ssq_kv}; ge::gemm_stream<EpiIn<0>, SchedIn, false>(lds, D, D, D, S, E); }
          kr_phase(q, c * NTHR + tid_now(), G * NTHR);
          const GlaP g = mk_gla(p, layer); gla_g1(lds, g, c, G); }
        GRID_BAR();
        { const P p = load_params(); const GlaP g = mk_gla(p, layer); gla_g2(lds, g, c); const MlaP q = mk_mla(p); attn_phase(lds, q, c); }
        GRID_BAR();
        { const P p = load_params(); const GlaP g = mk_gla(p, layer); gla_g3(lds, g, c, G); conv_phase(g, c * NTHR + tid_now(), G * NTHR); attn_combine_bf16(g, c * NTHR + tid_now(), G * NTHR); }
        GRID_BAR();
        { const P p = load_params(); SchedBr S{(const char*)p.Yab, (const char*)p.Ybb, (const char*)p.Ycb, (const char*)p.Wb_br, c, G}; EpiBr E{p.Hp, p.Mgb}; ge::gemm_stream<EpiBr, SchedBr, false>(lds, 512, 512, 512, S, E); }
        GRID_BAR();
        { const P p = load_params(); SchedT4 S{{}, (const char*)p.Mgb, (const char*)p.Wb_o, 256 * D * 2, 256 * D * 2, c, G}; EpiRes E{p.Db}; ge::gemm_stream<EpiRes, SchedT4, false>(lds, D, D, D, S, E); }
        GRID_BAR();
        { const P p = load_params(); ph_ln1_router(p, layer); }
        GRID_BAR();
        { const P p = load_params(); moe_table(lds, p.cnt + layer * 64); LAS int* te = (LAS int*)(lds + 131072);
          SchedM1 S{{}, (const char*)p.Xb, (const char*)p.Wb_gu, p.lists, te, c, G}; EpiM1 E{p.Hbuf}; ge::gemm_stream<EpiM1, SchedM1, true>(lds, D, D, D, S, E);
          const int extra = max(0, 2 * te[576] - NBLK), cu = c - extra;
          SchedT4 SU{{}, (const char*)(p.Pb + (size_t)layer * T * PLE), (const char*)p.Wb_pu, 256 * PLE * 2, 256 * PLE * 2, cu >= 0 ? cu : 256, NBLK - extra}; EpiU EU{p.Ub};
          ge::gemm_stream<EpiU, SchedT4, false>(lds, PLE, PLE, PLE, SU, EU); }
        GRID_BAR();
        { const P p = load_params(); LAS int* te = (LAS int*)(lds + 131072);
          SchedM2 S{{}, (const char*)p.Hbuf, (const char*)p.Wb_d, te, c, G}; EpiM2 E{p.Ys, p.lists, te}; ge::gemm_stream<EpiM2, SchedM2, false>(lds, EH, EH, EH, S, E); }
        GRID_BAR();
        { const P p = load_params(); ph_rows<2>(p, layer); }
        GRID_BAR();
        { const P p = load_params(); SchedT4 S{{}, (const char*)p.Xb, (const char*)p.Wb_pg, 256 * D * 2, 256 * D * 2, c, G}; EpiPle E{p.Db, p.Ub, p.b_pg + layer * D}; ge::gemm_stream<EpiPle, SchedT4, false>(lds, D, D, D, S, E); }
        GRID_BAR();
        { const P p = load_params(); ph_rows<3>(p, layer); }
        if (layer + 1 < DEPTH) { { const P p = load_params(); ph_convert(lds, p, layer + 1); } GRID_BAR(); }
    }
#undef c
}

template <int PH> static void launch_ph(const P& p, int layer, hipStream_t st) {
    static bool set = false;
    if (!set) { (void)hipFuncSetAttribute((const void*)k_ph<PH>, hipFuncAttributeMaxDynamicSharedMemorySize, LDS_BYTES); set = true; }
    hipLaunchKernelGGL((k_ph<PH>), dim3(NBLK), dim3(NTHR), LDS_BYTES, st, p, layer);
}
extern "C" void kernel_launch(void* const* d_in, const int* in_sizes, int n_in, void* d_out, int out_size, void* d_ws, size_t ws_size, hipStream_t st) {
    (void)in_sizes; (void)n_in; (void)out_size;
    P p{};
    p.x = (const float*)d_in[0]; p.pin = (const float*)d_in[1]; p.pos = (const int*)d_in[2]; p.ln0_g = (const float*)d_in[3]; p.ln0_b = (const float*)d_in[4];
    p.w_in = (const float*)d_in[5]; p.w_conv = (const float*)d_in[6]; p.w_gg = (const float*)d_in[7]; p.b_gg = (const float*)d_in[8]; p.gla_ng = (const float*)d_in[9];
    p.qn_g = (const float*)d_in[10]; p.kvn_g = (const float*)d_in[11]; p.w_uq = (const float*)d_in[12]; p.w_ukv = (const float*)d_in[13]; p.w_br = (const float*)d_in[14]; p.w_o = (const float*)d_in[15];
    p.ln1_g = (const float*)d_in[16]; p.ln1_b = (const float*)d_in[17]; p.w_grp = (const float*)d_in[18]; p.b_grp = (const float*)d_in[19]; p.w_exp = (const float*)d_in[20]; p.b_exp = (const float*)d_in[21];
    p.w_gate = (const float*)d_in[22]; p.w_up = (const float*)d_in[23]; p.w_down = (const float*)d_in[24]; p.ln2_g = (const float*)d_in[25]; p.ln2_b = (const float*)d_in[26];
    p.w_pg = (const float*)d_in[27]; p.b_pg = (const float*)d_in[28]; p.w_pu = (const float*)d_in[29]; p.ln3_g = (const float*)d_in[30]; p.ln3_b = (const float*)d_in[31];
    p.out = (float*)d_out;
    char* w = (char*)d_ws; size_t off = 0;
    auto alloc = [&](size_t bytes) { void* r = w + off; off += (bytes + 255) & ~(size_t)255; return r; };
    p.bar = (unsigned*)alloc(16384); p.cnt = (int*)alloc(DEPTH * 64 * 4);
    const size_t zero_bytes = off;
    p.X = (float*)alloc((size_t)T * D * 4); p.Z = (float*)alloc((size_t)T * D * 4); p.Xb = (bf16_t*)alloc((size_t)T * D * 2); p.Db = (bf16_t*)alloc((size_t)T * D * 2);
    p.cs = (float*)alloc((size_t)T * 32 * 4); p.sn = (float*)alloc((size_t)T * 32 * 4); p.ssq_q = (float*)alloc((size_t)4 * T * 4); p.ssq_kv = (float*)alloc((size_t)4 * T * 4);
    p.Hp = (bf16_t*)alloc((size_t)T * HW * 2); p.GVt = (bf16_t*)alloc((size_t)T * 512 * 2);
    p.Qb = (bf16_t*)alloc((size_t)T * 768 * 2); p.KnImg = (bf16_t*)alloc((size_t)T * 512 * 2); p.VtImg = (bf16_t*)alloc((size_t)T * 512 * 2); p.KrImg = (bf16_t*)alloc((size_t)T * 64 * 2);
    p.MLpart = (float*)alloc((size_t)512 * 256 * 2 * 4);
    p.QE = (bf16_t*)alloc((size_t)T * 256 * 2); p.OI = (float*)alloc((size_t)T * 512 * 4); p.kvT = (float*)alloc((size_t)1024 * 8192 * 4); p.decay = (float*)alloc((size_t)1024 * 64 * 4); p.spT = (bf16_t*)alloc((size_t)1024 * 8192 * 2);
    p.Yab = (bf16_t*)alloc((size_t)T * 512 * 2); p.Ybb = (bf16_t*)alloc((size_t)T * 512 * 2); p.Ycb = (bf16_t*)alloc((size_t)T * 512 * 2); p.Mgb = (bf16_t*)alloc((size_t)T * D * 2);
    p.ew = (float*)alloc((size_t)T * 2 * 4); p.lists = (int*)alloc((size_t)NE * LCAP * 4);
    p.Hbuf = (bf16_t*)alloc((size_t)192 * 256 * EH * 2); p.Ys = (bf16_t*)alloc((size_t)2 * T * D * 2); p.Ub = (bf16_t*)alloc((size_t)T * D * 2); p.Pb = (bf16_t*)alloc((size_t)DEPTH * T * PLE * 2);
    p.Wb_in = (bf16_t*)alloc((size_t)HW * D * 2); p.Wb_gv = (bf16_t*)alloc((size_t)512 * D * 2); p.Wb_uq = (bf16_t*)alloc((size_t)768 * 256 * 2); p.Wb_uk = (bf16_t*)alloc((size_t)512 * 256 * 2); p.Wb_uv = (bf16_t*)alloc((size_t)512 * 256 * 2);
    p.Wb_br = (bf16_t*)alloc((size_t)3 * D * 512 * 2); p.Wb_o = (bf16_t*)alloc((size_t)D * D * 2); p.Wb_gu = (bf16_t*)alloc((size_t)NE * 512 * D * 2); p.Wb_d = (bf16_t*)alloc((size_t)NE * D * EH * 2);
    p.Wb_pg = (bf16_t*)alloc((size_t)D * D * 2); p.Wb_pu = (bf16_t*)alloc((size_t)D * PLE * 2);
    if (off > ws_size) return;
    (void)hipMemsetAsync(d_ws, 0, zero_bytes, st);
#if defined(MULTI_LAUNCH)
    launch_ph<PH_PRO>(p, 0, st);
    for (int i = 0; i < DEPTH; ++i) {
        launch_ph<PH_CONV>(p, i, st); launch_ph<PH_IN>(p, i, st);
        launch_ph<PH_PREP_Q>(p, i, st); launch_ph<PH_PREP_K>(p, i, st); launch_ph<PH_PREP_V>(p, i, st); launch_ph<PH_PREP_G>(p, i, st);
        launch_ph<PH_ATT>(p, i, st); launch_ph<PH_FIN>(p, i, st); launch_ph<PH_BR>(p, i, st); launch_ph<PH_WO>(p, i, st); launch_ph<PH_LN1>(p, i, st);
        launch_ph<PH_M1>(p, i, st); launch_ph<PH_M2>(p, i, st); launch_ph<PH_LN2>(p, i, st); launch_ph<PH_PLE>(p, i, st); launch_ph<PH_LN3>(p, i, st);
    }
#else
    static bool set = false;
    if (!set) { (void)hipFuncSetAttribute((const void*)k_mega, hipFuncAttributeMaxDynamicSharedMemorySize, LDS_BYTES); set = true; }
    hipLaunchKernelGGL(k_mega, dim3(NBLK), dim3(NTHR), LDS_BYTES, st, p);
#endif
}
```

```cpp
#include <hip/hip_runtime.h>
#include <hip/hip_bf16.h>
#include <stdint.h>

constexpr int T = 16384, D = 1024, DEPTH = 4, PLE = 256;
constexpr int NE = 64, EH = 256;
constexpr int INW = 6608;
constexpr int O_GV = 2048;
constexpr float DN_ALPHA = 1.681792830507429f;
constexpr int LCAP = 32768;
#define LAS __attribute__((address_space(3)))
typedef unsigned short bf16_t;
typedef short bf16x8 __attribute__((ext_vector_type(8)));
typedef float f32x4 __attribute__((ext_vector_type(4)));
typedef float f32x16 __attribute__((ext_vector_type(16)));
typedef unsigned u32x4 __attribute__((ext_vector_type(4)));
typedef unsigned u32x2 __attribute__((ext_vector_type(2)));
typedef float f32x2 __attribute__((ext_vector_type(2)));
constexpr int NBLK = 256, NTHR = 512;
constexpr int STAGE_BYTES = 131072, LDS_BYTES = 147456 + 512, XBW_OFF = 147456 + 256;
constexpr int HW = 6144;
constexpr int H_AB = 0, H_AC = 512, H_AX = 1024, H_GQ = 1536, H_GK = 1792, H_GR = 2048, H_CQ = 2560, H_CKV = 2816, H_KR = 2944, H_GLR = 3008, H_GTA = 3072, H_GTB = 4096, H_GTC = 5120;

__device__ __forceinline__ unsigned cvt_pk_bf16(float lo, float hi) { unsigned r; asm volatile("v_cvt_pk_bf16_f32 %0, %1, %2" : "=v"(r) : "v"(lo), "v"(hi)); return r; }
constexpr int WTAB_OFF = 147456;
__device__ __forceinline__ int tid_now() {
    const unsigned hw = (unsigned)__builtin_amdgcn_s_getreg((5 << 11) | 4) & 63u;
    extern __shared__ __attribute__((aligned(16))) unsigned char smem_tid[];
    const int w = __builtin_amdgcn_readfirstlane(*(volatile LAS int*)((LAS unsigned char*)smem_tid + WTAB_OFF + 4 * hw));
    int l = (int)__builtin_amdgcn_mbcnt_hi(~0u, __builtin_amdgcn_mbcnt_lo(~0u, 0u));
    asm volatile("" : "+v"(l));
    return w * 64 + l; }
__device__ __forceinline__ void tid_setup() {
    const unsigned hw = (unsigned)__builtin_amdgcn_s_getreg((5 << 11) | 4) & 63u;
    extern __shared__ __attribute__((aligned(16))) unsigned char smem_tid[];
    if ((threadIdx.x & 63) == 0) *(volatile LAS int*)((LAS unsigned char*)smem_tid + WTAB_OFF + 4 * hw) = (int)(threadIdx.x >> 6);
    __syncthreads(); }
__device__ __forceinline__ int sgpr_now(int v) { asm volatile("" : "+s"(v)); return v; }
__device__ __forceinline__ float shx(float v, int mask, int lane) { return __int_as_float(__builtin_amdgcn_ds_bpermute((lane ^ mask) << 2, __float_as_int(v))); }
__device__ __forceinline__ float frcp(float x) { return __builtin_amdgcn_rcpf(x); }
__device__ __forceinline__ float bf2f(bf16_t b) { return __uint_as_float(((unsigned)b) << 16); }
__device__ __forceinline__ float bflo(unsigned w) { return __uint_as_float(w << 16); }
__device__ __forceinline__ float bfhi(unsigned w) { return __uint_as_float(w & 0xffff0000u); }

namespace ge {
constexpr int BM = 256, BK = 64, HALF = 128, HTB = HALF * BK * 2;
__device__ __forceinline__ int lds_byte(int r, int c) { const int st = (r >> 4) * 2 + (c >> 5), rr = r & 15, cc = c & 31, ob = rr * 64 + cc * 2; return st * 1024 + (ob ^ (((ob >> 9) & 1) << 5)); }
__device__ __forceinline__ void stage_rc(int b, int& R, int& C) { const int st = b / 1024, sb = b % 1024, swz = sb ^ (((sb >> 9) & 1) << 5); R = (st >> 1) * 16 + swz / 64; C = (st & 1) * 32 + (swz % 64) / 2; }
__device__ __forceinline__ int perm32(int rho) { const int n = rho >> 4, i = rho & 15; return 8 * (i >> 2) + 4 * n + (i & 3); }
struct Unit { int pm, pn, g; };
typedef f32x4 Acc[2][2][4][2];
struct NoCarry { __device__ __forceinline__ bool carry(const struct Unit&) const { return false; } };

template <class Epi, class Sched, bool GATHER>
__device__ __forceinline__ void gemm_stream(LAS unsigned char* lds, const int K, const int lda, const int ldb, const Sched& S, const Epi& E) {
    const int tid = tid_now(), wid = __builtin_amdgcn_readfirstlane(tid >> 6), lane = tid & 63, wr = wid >> 2, wc = wid & 3, fr = lane & 15, fq = lane >> 4;
    const int nt = K / BK;
    Unit cur, nxt; int ui = 0;
    if (!S.next(0, cur)) return;
    unsigned voffA[2][2], nvoffA[2][2], voffB[2][2];
#pragma unroll
    for (int i = 0; i < 2; ++i) { int R, C; stage_rc(tid * 16 + i * 8192, R, C); const int Rb = (R & ~31) + perm32(R & 31);
        voffB[0][i] = (unsigned)(Rb * ldb + C) * 2u; voffB[1][i] = (unsigned)((Rb + 128) * ldb + C) * 2u;
        if constexpr (GATHER) { voffA[0][i] = (unsigned)(S.arow(cur, R) * lda + C) * 2u; voffA[1][i] = (unsigned)(S.arow(cur, R + 128) * lda + C) * 2u; }
        else { voffA[0][i] = (unsigned)(R * lda + C) * 2u; voffA[1][i] = (unsigned)((R + 128) * lda + C) * 2u; }
        nvoffA[0][i] = voffA[0][i]; nvoffA[1][i] = voffA[1][i]; }
    const size_t kstep = (size_t)(BK * 2);
    const unsigned ldsw = (unsigned)wid * 1024u;
    const int aoff = lds_byte(wr * 64 + fr, fq * 8), boff = lds_byte(wc * 32 + fr, fq * 8);
#define GE_SA(b, h) (((b) * 2 + (h)) * HTB)
#define GE_SB(b, h) ((4 + (b) * 2 + (h)) * HTB)
#define GE_STAGE(bufoff, gbase, voff) do { _Pragma("unroll") for (int _i = 0; _i < 2; ++_i) \
        __builtin_amdgcn_global_load_lds((const unsigned*)((const char*)(gbase) + (voff)[_i]), (LAS unsigned*)(lds + (bufoff) + ldsw + _i * 8192), 16, 0, 0); } while (0)
#define GE_LDA(dst, b, h) do { _Pragma("unroll") for (int m = 0; m < 4; ++m) _Pragma("unroll") for (int k = 0; k < 2; ++k) dst[m][k] = *(const LAS bf16x8*)(lds + GE_SA(b, h) + aoff + m * 2048 + k * 1024); } while (0)
#define GE_LDB(dst, b, h) do { _Pragma("unroll") for (int n = 0; n < 2; ++n) _Pragma("unroll") for (int k = 0; k < 2; ++k) dst[n][k] = *(const LAS bf16x8*)(lds + GE_SB(b, h) + boff + n * 2048 + k * 1024); } while (0)
#define GE_MMA(ai, bj, At, Bt) do { __builtin_amdgcn_s_setprio(1); _Pragma("unroll") for (int m = 0; m < 4; ++m) _Pragma("unroll") for (int n = 0; n < 2; ++n) _Pragma("unroll") for (int k = 0; k < 2; ++k) \
        acc[ai][bj][m][n] = __builtin_amdgcn_mfma_f32_16x16x32_bf16(Bt[n][k], At[m][k], acc[ai][bj][m][n], 0, 0, 0); __builtin_amdgcn_s_setprio(0); } while (0)
#define GE_WAIT_V(n) asm volatile("s_waitcnt vmcnt(" #n ")" ::: "memory")
#define GE_WAIT_L(n) asm volatile("s_waitcnt lgkmcnt(" #n ")" ::: "memory")
#define GE_BAR __builtin_amdgcn_s_barrier()
#define GE_SCHED __builtin_amdgcn_sched_barrier(0)
    Acc acc;
#pragma unroll
    for (int a = 0; a < 2; ++a)
#pragma unroll
        for (int b = 0; b < 2; ++b)
#pragma unroll
            for (int m = 0; m < 4; ++m)
#pragma unroll
                for (int n = 0; n < 2; ++n) acc[a][b][m][n] = (f32x4){0.f, 0.f, 0.f, 0.f};
    bf16x8 At[4][2], B0[2][2], B1[2][2];
    const char* cA = S.aptr(cur); const char* cB = S.bptr(cur);
    GE_STAGE(GE_SB(0, 0), cB, voffB[0]); GE_STAGE(GE_SA(0, 0), cA, voffA[0]); GE_STAGE(GE_SB(0, 1), cB, voffB[1]); GE_STAGE(GE_SA(0, 1), cA, voffA[1]);
    if (wr == 1) GE_BAR;
    GE_WAIT_V(4); GE_BAR;
    GE_STAGE(GE_SB(1, 0), cB + kstep, voffB[0]); GE_STAGE(GE_SA(1, 0), cA + kstep, voffA[0]); GE_STAGE(GE_SB(1, 1), cB + kstep, voffB[1]);
    GE_WAIT_V(6); GE_BAR;
    for (;;) {
        const bool has_next = S.next(ui + 1, nxt);
        const char* nA = has_next ? S.aptr(nxt) : cA; const char* nB = has_next ? S.bptr(nxt) : cB;
#pragma unroll 1
        for (int t = 0; t < nt; t += 2) {
            const bool last = (t == nt - 2);
            const char* a1 = cA + (size_t)(t + 1) * kstep;
            const char* a2 = last ? nA : cA + (size_t)(t + 2) * kstep; const char* b2 = last ? nB : cB + (size_t)(t + 2) * kstep;
            const char* a3 = a2 + kstep; const char* b3 = b2 + kstep;
            if constexpr (GATHER) { if (last && has_next) {
#pragma unroll
                for (int i = 0; i < 2; ++i) { int R, C; stage_rc(tid * 16 + i * 8192, R, C);
                    nvoffA[0][i] = (unsigned)(S.arow(nxt, R) * lda + C) * 2u; nvoffA[1][i] = (unsigned)(S.arow(nxt, R + 128) * lda + C) * 2u; } } }
            unsigned va2[2][2];
#pragma unroll
            for (int h = 0; h < 2; ++h)
#pragma unroll
                for (int i = 0; i < 2; ++i) va2[h][i] = (GATHER && last) ? nvoffA[h][i] : voffA[h][i];
            GE_LDB(B0, 0, 0); GE_SCHED; GE_LDA(At, 0, 0); GE_STAGE(GE_SA(1, 1), a1, voffA[1]);
            GE_WAIT_L(8); GE_BAR; GE_WAIT_L(0); GE_MMA(0, 0, At, B0); GE_BAR; GE_SCHED;
            GE_LDB(B1, 0, 1); GE_STAGE(GE_SB(0, 0), b2, voffB[0]);
            GE_BAR; GE_WAIT_L(0); GE_MMA(0, 1, At, B1); GE_BAR;
            GE_LDA(At, 0, 1); GE_STAGE(GE_SA(0, 0), a2, va2[0]);
            GE_BAR; GE_WAIT_L(0); GE_MMA(1, 0, At, B0); GE_BAR; GE_SCHED;
            GE_STAGE(GE_SB(0, 1), b2, voffB[1]);
            GE_WAIT_V(6); GE_BAR; GE_MMA(1, 1, At, B1); GE_BAR;
            GE_LDB(B0, 1, 0); GE_SCHED; GE_LDA(At, 1, 0); GE_STAGE(GE_SA(0, 1), a2, va2[1]);
            GE_WAIT_L(8); GE_BAR; GE_WAIT_L(0); GE_MMA(0, 0, At, B0); GE_BAR; GE_SCHED;
            GE_LDB(B1, 1, 1); GE_STAGE(GE_SB(1, 0), b3, voffB[0]);
            GE_BAR; GE_WAIT_L(0); GE_MMA(0, 1, At, B1); GE_BAR;
            GE_LDA(At, 1, 1); GE_STAGE(GE_SA(1, 0), a3, va2[0]);
            GE_BAR; GE_WAIT_L(0); GE_MMA(1, 0, At, B0); GE_BAR; GE_SCHED;
            GE_STAGE(GE_SB(1, 1), b3, voffB[1]);
            GE_WAIT_V(6); GE_BAR; GE_MMA(1, 1, At, B1); GE_BAR;
        }
        { int tz = tid; asm volatile("" : "+v"(tz));
          const int wid2 = tz >> 6, lane2 = tz & 63; E(acc, cur, wid2 >> 2, wid2 & 3, lane2 & 15, lane2 >> 4); }
        if (!has_next) break;
        if (!S.carry(cur)) {
#pragma unroll
        for (int a = 0; a < 2; ++a)
#pragma unroll
            for (int b = 0; b < 2; ++b)
#pragma unroll
                for (int m = 0; m < 4; ++m)
#pragma unroll
                    for (int n = 0; n < 2; ++n) acc[a][b][m][n] = (f32x4){0.f, 0.f, 0.f, 0.f}; }
        cur = nxt; cA = nA; cB = nB; ++ui;
        if (GATHER) {
#pragma unroll
            for (int h = 0; h < 2; ++h)
#pragma unroll
                for (int i = 0; i < 2; ++i) voffA[h][i] = nvoffA[h][i]; }
    }
    GE_WAIT_V(0);
    if (wr == 0) GE_BAR;
    GE_BAR;
#undef GE_SA
#undef GE_SB
#undef GE_STAGE
#undef GE_LDA
#undef GE_LDB
#undef GE_MMA
#undef GE_WAIT_V
#undef GE_WAIT_L
#undef GE_BAR
#undef GE_SCHED
}
__device__ __forceinline__ void tile_order(int L, int nM, int nN, int& pm, int& pn) {
    const int nwg = nM * nN; int wgid = L;
    { const int q = nwg / 8, r = nwg % 8, xcd = wgid % 8, off = wgid / 8; wgid = (xcd < r ? xcd * (q + 1) : r * (q + 1) + (xcd - r) * q) + off; }
    const int nig = 8 * nN, gid = wgid / nig, fm = gid * 8, gsz = (nM - fm) < 8 ? (nM - fm) : 8;
    pm = fm + ((wgid % nig) % gsz); pn = (wgid % nig) / gsz;
}
}
struct MapInMain { __device__ __forceinline__ int operator()(int s) const {
    if (s < 2048) return s;
    if (s < 2560) return 2576 + (s - 2048);
    if (s < 2816) return 3088 + (s - 2560);
    if (s < 2944) return 3344 + (s - 2816);
    if (s < 3008) return 3472 + (s - 2944);
    if (s < 3024) return 2560 + (s - 3008);
    if (s < 3072) return -1;
    return 3536 + (s - 3072); } };
struct MapOff { int off; __device__ __forceinline__ int operator()(int s) const { return off + s; } };struct MegaP {
    const float* w_in; bf16_t* Wb_in; bf16_t* Wb_gv; const bf16_t* Xb; bf16_t* Hp; bf16_t* GVt; float* ssq_q; float* ssq_kv;
};
struct SchedIn : ge::NoCarry {
    const char* Xb; const char* Wm; const char* Wg; int c, G, gv;
    __device__ __forceinline__ bool next(int i, ge::Unit& u) const {
        const int L = i * G + c;
        if (gv) { if (L >= 128) return false; u.g = 0; u.pm = L >> 1; u.pn = 8 + (L & 1); return true; }
        if (L >= 1536) return false;
        if (L < 1408) { u.g = 0; ge::tile_order(L, 64, 22, u.pm, u.pn); if (u.pn >= 8) u.pn += 2; } else { u.g = 1; const int l = L - 1408; u.pm = l & 1; u.pn = l >> 1; }
        return true; }
    __device__ __forceinline__ const char* aptr(const ge::Unit& u) const { return u.g == 0 ? Xb + (size_t)u.pm * 256 * D * 2 : Wg + (size_t)u.pm * 256 * D * 2; }
    __device__ __forceinline__ const char* bptr(const ge::Unit& u) const { return u.g == 0 ? Wm + (size_t)u.pn * 256 * D * 2 : Xb + (size_t)u.pn * 256 * D * 2; }
};
template <int GV> struct EpiIn {
    bf16_t* Hp; bf16_t* GVt; float* ssq_q; float* ssq_kv;
    __device__ __forceinline__ void operator()(ge::Acc& acc, const ge::Unit& u, int wr, int wc, int fr, int fq) const {
        if (GV == 0 || (GV == 2 && u.g == 0)) {
            const int row0 = u.pm * 256 + wr * 64 + fr, col0 = u.pn * 256 + wc * 32 + 8 * fq;
            const bool sg = u.pn >= 12;
#pragma unroll
            for (int ai = 0; ai < 2; ++ai)
#pragma unroll
                for (int m = 0; m < 4; ++m) { const int row = row0 + ai * 128 + m * 16; bf16_t* rp = Hp + (size_t)row * HW + col0;
                    float sq0 = 0.f, sq1 = 0.f;
#pragma unroll
                    for (int bj = 0; bj < 2; ++bj) { f32x4 v0 = acc[ai][bj][m][0], v1 = acc[ai][bj][m][1];
                        if (sg) {
#pragma unroll
                            for (int j = 0; j < 4; ++j) { v0[j] = frcp(1.f + __expf(-v0[j])); v1[j] = frcp(1.f + __expf(-v1[j])); } }
                        const float s = v0[0] * v0[0] + v0[1] * v0[1] + v0[2] * v0[2] + v0[3] * v0[3] + v1[0] * v1[0] + v1[1] * v1[1] + v1[2] * v1[2] + v1[3] * v1[3];
                        if (bj == 0) sq0 = s; else sq1 = s;
                        u32x4 o = {cvt_pk_bf16(v0[0], v0[1]), cvt_pk_bf16(v0[2], v0[3]), cvt_pk_bf16(v1[0], v1[1]), cvt_pk_bf16(v1[2], v1[3])};
                        *(u32x4*)(rp + bj * 128) = o; }
                    if (u.pn == 10 || u.pn == 11) {
                        float s = (u.pn == 10) ? (sq0 + sq1) : sq0;
                        { const int ln = fq * 16 + fr; s += shx(s, 16, ln); s += shx(s, 32, ln); }
                        if (fq == 0) { float* dst = (u.pn == 10 ? ssq_q : ssq_kv); dst[(size_t)wc * T + row] = s; } } }
        } else {
#pragma unroll
            for (int ai = 0; ai < 2; ++ai)
#pragma unroll
                for (int m = 0; m < 4; ++m) { const int r = u.pm * 256 + ai * 128 + wr * 64 + m * 16 + fr, h = r >> 7, e = r & 127;
#pragma unroll
                    for (int bj = 0; bj < 2; ++bj) { const int t0 = u.pn * 256 + bj * 128 + wc * 32 + 8 * fq;
                        const int chunk = t0 >> 6, p0 = (t0 & 48) + ((t0 & 8) >> 1);
                        bf16_t* base = GVt + ((size_t)(chunk * 4 + h) * 128 + e) * 64;
                        const f32x4 v0 = acc[ai][bj][m][0], v1 = acc[ai][bj][m][1];
                        u32x2 o0 = {cvt_pk_bf16(v0[0], v0[1]), cvt_pk_bf16(v0[2], v0[3])}, o1 = {cvt_pk_bf16(v1[0], v1[1]), cvt_pk_bf16(v1[2], v1[3])};
                        *(u32x2*)(base + p0) = o0; *(u32x2*)(base + p0 + 8) = o1; } }
        }
    }
};
constexpr float QSCALE = 0.07216878364870322f * 1.4426950408889634f;
struct MapQ { __device__ __forceinline__ int operator()(int s) const {
    if (s < 512) return (s >> 7) * 192 + (s & 127);
    const int s2 = s - 512, bj = s2 >> 7, w = s2 & 127; return (w >> 5) * 192 + 128 + bj * 32 + (w & 31); } };
struct MapKV { int voff; __device__ __forceinline__ int operator()(int s) const { return (s >> 7) * 256 + voff + (s & 127); } };

struct MlaP {
    const float* w_uq; const float* w_ukv; const float* qn_g; const float* kvn_g;
    bf16_t* Wb_uq; bf16_t* Wb_uk; bf16_t* Wb_uv;
    const bf16_t* Hp; const float* ssq_q; const float* ssq_kv; const float* cs; const float* sn;
    bf16_t* Qb; bf16_t* KnImg; bf16_t* VtImg; bf16_t* KrImg; float* Opart; float* MLpart; float* Yc;
};
__device__ __forceinline__ float rstd4(const float* ssq, int row, float invw) {
    const float s = (ssq[row] + ssq[T + row]) + (ssq[2 * T + row] + ssq[3 * T + row]); return rsqrtf(s * invw + 1e-6f); }

template <int mode> struct SchedMla : ge::NoCarry { const char* A; const char* B; int c, G;
    __device__ __forceinline__ bool next(int i, ge::Unit& u) const {
        if (c < 0) return false;
        const int L = i * G + c; u.g = mode;
        if (mode == 0) { if (L >= 192) return false; u.pm = L / 3; u.pn = L % 3; }
        else if (mode == 1) { if (L >= 128) return false; u.pm = L >> 1; u.pn = L & 1; }
        else { if (L >= 128) return false; u.pm = L & 1; u.pn = L >> 1; }
        return true; }
    __device__ __forceinline__ const char* aptr(const ge::Unit& u) const { return mode == 2 ? A + (size_t)u.pm * 256 * 256 * 2 : A + (size_t)u.pm * 256 * HW * 2; }
    __device__ __forceinline__ const char* bptr(const ge::Unit& u) const { return mode == 2 ? B + (size_t)u.pn * 256 * HW * 2 : B + (size_t)u.pn * 256 * 256 * 2; }
};
template <int MODE> struct EpiMla { MlaP p;
    __device__ __forceinline__ void operator()(ge::Acc& acc, const ge::Unit& u, int wr, int wc, int fr, int fq) const {
        if constexpr (MODE == 0) {
            float rsv[2][4];
#pragma unroll
            for (int ai = 0; ai < 2; ++ai)
#pragma unroll
                for (int m = 0; m < 4; ++m) rsv[ai][m] = rstd4(p.ssq_q, u.pm * 256 + ai * 128 + wr * 64 + m * 16 + fr, 1.f / 256.f) * QSCALE;
#pragma unroll
            for (int ai = 0; ai < 2; ++ai) {
#pragma unroll
                for (int m = 0; m < 4; ++m) { const int t = u.pm * 256 + ai * 128 + wr * 64 + m * 16 + fr; const float rs = rsv[ai][m];
                    if (u.pn < 2) {
#pragma unroll
                        for (int bj = 0; bj < 2; ++bj) { const int c0 = u.pn * 256 + bj * 128 + wc * 32 + 8 * fq, head = c0 >> 7, dim = c0 & 127;
                            const f32x4 v0 = acc[ai][bj][m][0] * rs, v1 = acc[ai][bj][m][1] * rs;
                            u32x4 o = {cvt_pk_bf16(v0[0], v0[1]), cvt_pk_bf16(v0[2], v0[3]), cvt_pk_bf16(v1[0], v1[1]), cvt_pk_bf16(v1[2], v1[3])};
                            *(u32x4*)(p.Qb + (size_t)t * 768 + head * 192 + dim) = o; }
                    } else { const int head = wc, i0 = 8 * fq;
                        float o1[8], o2[8];
#pragma unroll
                        for (int n = 0; n < 2; ++n) { const f32x4 c4 = *(const f32x4*)(p.cs + (size_t)t * 32 + i0 + 4 * n), s4 = *(const f32x4*)(p.sn + (size_t)t * 32 + i0 + 4 * n);
#pragma unroll
                            for (int j = 0; j < 4; ++j) { const float x1 = acc[ai][0][m][n][j] * rs, x2 = acc[ai][1][m][n][j] * rs; o1[4 * n + j] = x1 * c4[j] - x2 * s4[j]; o2[4 * n + j] = x1 * s4[j] + x2 * c4[j]; } }
                        u32x4 a = {cvt_pk_bf16(o1[0], o1[1]), cvt_pk_bf16(o1[2], o1[3]), cvt_pk_bf16(o1[4], o1[5]), cvt_pk_bf16(o1[6], o1[7])};
                        u32x4 b = {cvt_pk_bf16(o2[0], o2[1]), cvt_pk_bf16(o2[2], o2[3]), cvt_pk_bf16(o2[4], o2[5]), cvt_pk_bf16(o2[6], o2[7])};
                        *(u32x4*)(p.Qb + (size_t)t * 768 + head * 192 + 128 + i0) = a; *(u32x4*)(p.Qb + (size_t)t * 768 + head * 192 + 160 + i0) = b; } } }
        } else if constexpr (MODE == 1) {
            float rsv[2][4];
#pragma unroll
            for (int ai = 0; ai < 2; ++ai)
#pragma unroll
                for (int m = 0; m < 4; ++m) rsv[ai][m] = rstd4(p.ssq_kv, u.pm * 256 + ai * 128 + wr * 64 + m * 16 + fr, 1.f / 128.f);
            asm volatile("" ::: "memory");
#pragma unroll
            for (int ai = 0; ai < 2; ++ai)
#pragma unroll
                for (int m = 0; m < 4; ++m) { const int t = u.pm * 256 + ai * 128 + wr * 64 + m * 16 + fr; const float rs = rsv[ai][m];
                    const int tile = t >> 6, key = t & 63;
#pragma unroll
                    for (int bj = 0; bj < 2; ++bj) { const int c0 = u.pn * 256 + bj * 128 + wc * 32 + 8 * fq, head = c0 >> 7, chunk = (c0 & 127) >> 3;
                        const f32x4 v0 = acc[ai][bj][m][0] * rs, v1 = acc[ai][bj][m][1] * rs;
                        u32x4 o = {cvt_pk_bf16(v0[0], v0[1]), cvt_pk_bf16(v0[2], v0[3]), cvt_pk_bf16(v1[0], v1[1]), cvt_pk_bf16(v1[2], v1[3])};
                        *(u32x4*)((char*)p.KnImg + ((size_t)(head * 256 + tile) * 16384) + key * 256 + ((chunk ^ (key & 15)) << 4)) = o; } }
        } else {
#pragma unroll
            for (int bj = 0; bj < 2; ++bj) { const int t0 = u.pn * 256 + bj * 128 + wc * 32 + 8 * fq;
                float rs[8];
#pragma unroll
                for (int j = 0; j < 8; ++j) rs[j] = rstd4(p.ssq_kv, t0 + j, 1.f / 128.f);
                const int tile = t0 >> 6, p0 = (t0 & 48) + ((t0 & 8) >> 1);
#pragma unroll
                for (int ai = 0; ai < 2; ++ai)
#pragma unroll
                    for (int m = 0; m < 4; ++m) { asm volatile("" ::: "memory"); const int r = u.pm * 256 + ai * 128 + wr * 64 + m * 16 + fr, head = r >> 7, d = r & 127;
                        char* base = (char*)p.VtImg + ((size_t)(head * 256 + tile) * 16384) + d * 128;
                        const f32x4 v0 = acc[ai][bj][m][0], v1 = acc[ai][bj][m][1];
                        u32x2 o0 = {cvt_pk_bf16(v0[0] * rs[0], v0[1] * rs[1]), cvt_pk_bf16(v0[2] * rs[2], v0[3] * rs[3])};
                        u32x2 o1 = {cvt_pk_bf16(v1[0] * rs[4], v1[1] * rs[5]), cvt_pk_bf16(v1[2] * rs[6], v1[3] * rs[7])};
                        const int sw = (d >> 1) & 7, pa = p0, pb = p0 + 8;
                        *(u32x2*)(base + (((pa >> 3) ^ sw) << 4) + (pa & 7) * 2) = o0;
                        *(u32x2*)(base + (((pb >> 3) ^ sw) << 4) + (pb & 7) * 2) = o1; } }
        }
    }
};
__device__ __forceinline__ void kr_phase(const MlaP& p, int gtid, int gthreads) {
    for (int idx = gtid; idx < T * 4; idx += gthreads) { const int t = idx >> 2, c = idx & 3, i0 = 8 * c;
        const u32x4 a = *(const u32x4*)(p.Hp + (size_t)t * HW + H_KR + i0), b = *(const u32x4*)(p.Hp + (size_t)t * HW + H_KR + 32 + i0);
        float o1[8], o2[8];
#pragma unroll
        for (int n = 0; n < 2; ++n) { const f32x4 c4 = *(const f32x4*)(p.cs + (size_t)t * 32 + i0 + 4 * n), s4 = *(const f32x4*)(p.sn + (size_t)t * 32 + i0 + 4 * n);
#pragma unroll
            for (int j = 0; j < 4; ++j) { const int e = 4 * n + j; const unsigned wa = a[e >> 1], wb = b[e >> 1];
                const float x1 = (e & 1) ? bfhi(wa) : bflo(wa), x2 = (e & 1) ? bfhi(wb) : bflo(wb);
                o1[e] = x1 * c4[j] - x2 * s4[j]; o2[e] = x1 * s4[j] + x2 * c4[j]; } }
        u32x4 oa = {cvt_pk_bf16(o1[0], o1[1]), cvt_pk_bf16(o1[2], o1[3]), cvt_pk_bf16(o1[4], o1[5]), cvt_pk_bf16(o1[6], o1[7])};
        u32x4 ob = {cvt_pk_bf16(o2[0], o2[1]), cvt_pk_bf16(o2[2], o2[3]), cvt_pk_bf16(o2[4], o2[5]), cvt_pk_bf16(o2[6], o2[7])};
        const int tile = t >> 6, key = t & 63, sw = (key >> 1) & 7;
        char* base = (char*)p.KrImg + (size_t)tile * 8192 + key * 128;
        *(u32x4*)(base + ((c ^ sw) << 4)) = oa; *(u32x4*)(base + (((c + 4) ^ sw) << 4)) = ob; }
}
constexpr int ATT_STEPS = 130;
__device__ __forceinline__ void attn_item(LAS unsigned char* lds, const MlaP& p, int head, int b, int j0, int j1, int slot) {
    const int tid = tid_now(), wid = __builtin_amdgcn_readfirstlane(tid >> 6), lane = tid & 63, q = lane & 31, hh = lane >> 5;
    const int grp = wid >> 2, n = j1 - j0;
    const int trow = b * 256 + wid * 32 + q;
    bf16x8 qf[12];
    { const bf16_t* qp = p.Qb + (size_t)trow * 768 + head * 192 + 8 * hh;
#pragma unroll
      for (int s = 0; s < 12; ++s) qf[s] = *(const bf16x8*)(qp + 16 * s); }
    f32x16 O[4];
#pragma unroll
    for (int d = 0; d < 4; ++d)
#pragma unroll
        for (int r = 0; r < 16; ++r) O[d][r] = 0.f;
    float m_run = -1e30f, l_run = 0.f;
    const char* knb = (const char*)p.KnImg + (size_t)head * 256 * 16384; const char* vtb = (const char*)p.VtImg + (size_t)head * 256 * 16384; const char* krb = (const char*)p.KrImg;
    const unsigned lo = (unsigned)lane * 16u;
    constexpr int KB = 24576, VOFF = 3 * KB, VB = 16384;
#define AT_ISSUE(k) do { const unsigned _ko = (unsigned)((k) % 3) * KB, _vo = VOFF + (unsigned)((k) & 3) * VB; const size_t _j = (size_t)(j0 + (k)); \
        __builtin_amdgcn_global_load_lds((const unsigned*)(knb + _j * 16384 + (wid * 2) * 1024 + lo), (LAS unsigned*)(lds + _ko + (wid * 2) * 1024), 16, 0, 0); \
        __builtin_amdgcn_global_load_lds((const unsigned*)(knb + _j * 16384 + (wid * 2 + 1) * 1024 + lo), (LAS unsigned*)(lds + _ko + (wid * 2 + 1) * 1024), 16, 0, 0); \
        __builtin_amdgcn_global_load_lds((const unsigned*)(krb + _j * 8192 + wid * 1024 + lo), (LAS unsigned*)(lds + _ko + 16384 + wid * 1024), 16, 0, 0); \
        __builtin_amdgcn_global_load_lds((const unsigned*)(vtb + _j * 16384 + (wid * 2) * 1024 + lo), (LAS unsigned*)(lds + _vo + (wid * 2) * 1024), 16, 0, 0); \
        __builtin_amdgcn_global_load_lds((const unsigned*)(vtb + _j * 16384 + (wid * 2 + 1) * 1024 + lo), (LAS unsigned*)(lds + _vo + (wid * 2 + 1) * 1024), 16, 0, 0); } while (0)
#define AT_TOP(k) do { if ((k) + 1 < n) asm volatile("s_waitcnt vmcnt(5)" ::: "memory"); else asm volatile("s_waitcnt vmcnt(0)" ::: "memory"); \
        __builtin_amdgcn_s_barrier(); asm volatile("" ::: "memory"); if ((k) + 2 < n) AT_ISSUE((k) + 2); } while (0)
    const int kn_off0 = q * 256, kn_sw = q & 15, kr_off0 = q * 128, kr_sw = (q >> 1) & 7, vt_sw = (q >> 1) & 7;
    constexpr float THR = 8.f;
    f32x16 S0, S1; bool sval = false, first = true; int sjj = 0, sk = 0;
    auto QK = [&](int k) __attribute__((always_inline)) {
        const int jj = j0 + k - 4 * b; sjj = jj; sk = k; sval = !(jj >= 0 && 64 * jj > 32 * wid + 31);
        if (sval) {
            LAS unsigned char* bb = lds + (k % 3) * KB;
            const float mref = first ? 0.f : m_run;
#pragma unroll
            for (int r = 0; r < 16; ++r) { S0[r] = -mref; S1[r] = -mref; }
#pragma unroll
            for (int s = 0; s < 8; ++s) {
                const bf16x8 k0 = *(const LAS bf16x8*)(bb + kn_off0 + (((2 * s + hh) ^ kn_sw) << 4));
                const bf16x8 k1 = *(const LAS bf16x8*)(bb + 8192 + kn_off0 + (((2 * s + hh) ^ kn_sw) << 4));
                S0 = __builtin_amdgcn_mfma_f32_32x32x16_bf16(k0, qf[s], S0, 0, 0, 0);
                S1 = __builtin_amdgcn_mfma_f32_32x32x16_bf16(k1, qf[s], S1, 0, 0, 0); }
#pragma unroll
            for (int s = 0; s < 4; ++s) {
                const bf16x8 k0 = *(const LAS bf16x8*)(bb + 16384 + kr_off0 + (((2 * s + hh) ^ kr_sw) << 4));
                const bf16x8 k1 = *(const LAS bf16x8*)(bb + 16384 + 4096 + kr_off0 + (((2 * s + hh) ^ kr_sw) << 4));
                S0 = __builtin_amdgcn_mfma_f32_32x32x16_bf16(k0, qf[8 + s], S0, 0, 0, 0);
                S1 = __builtin_amdgcn_mfma_f32_32x32x16_bf16(k1, qf[8 + s], S1, 0, 0, 0); } }
    };
    auto SMPV = [&]() __attribute__((always_inline)) {
        if (sval) {
            LAS unsigned char* vb = lds + VOFF + (sk & 3) * VB;
            const float mref = first ? 0.f : m_run;
            if (sjj >= 0) {
                const int dq = wid * 32 + q - 64 * sjj - 4 * hh;
                const float NEG = -__builtin_inff();
#pragma unroll
                for (int r = 0; r < 16; ++r) { const int c = (r & 3) + 8 * (r >> 2);
                    if (c > dq) S0[r] = NEG;
                    if (c + 32 > dq) S1[r] = NEG; } }
            float mx = S0[0];
#pragma unroll
            for (int r = 1; r < 16; ++r) mx = fmaxf(mx, S0[r]);
#pragma unroll
            for (int r = 0; r < 16; ++r) mx = fmaxf(mx, S1[r]);
            { auto rr = __builtin_amdgcn_permlane32_swap(__float_as_uint(mx), __float_as_uint(mx), false, false); mx = fmaxf(__uint_as_float(rr[0]), __uint_as_float(rr[1])); }
            float alpha = 1.f;
            if (first || !__all(mx <= THR)) {
                const float mn = fmaxf(m_run, mref + mx), sh = mn - mref;
                alpha = __builtin_amdgcn_exp2f(m_run - mn); m_run = mn;
#pragma unroll
                for (int r = 0; r < 16; ++r) { S0[r] -= sh; S1[r] -= sh; }
#pragma unroll
                for (int d = 0; d < 4; ++d)
#pragma unroll
                    for (int r = 0; r < 16; ++r) O[d][r] *= alpha;
                first = false;
            }
            float sum = 0.f;
#pragma unroll
            for (int r = 0; r < 16; ++r) { S0[r] = __builtin_amdgcn_exp2f(S0[r]); S1[r] = __builtin_amdgcn_exp2f(S1[r]); sum += S0[r] + S1[r]; }
            l_run = l_run * alpha + sum;
            bf16x8 pf[4];
#pragma unroll
            for (int h2 = 0; h2 < 2; ++h2) {
                u32x4 a = {cvt_pk_bf16(S0[8 * h2 + 0], S0[8 * h2 + 1]), cvt_pk_bf16(S0[8 * h2 + 2], S0[8 * h2 + 3]), cvt_pk_bf16(S0[8 * h2 + 4], S0[8 * h2 + 5]), cvt_pk_bf16(S0[8 * h2 + 6], S0[8 * h2 + 7])};
                u32x4 c = {cvt_pk_bf16(S1[8 * h2 + 0], S1[8 * h2 + 1]), cvt_pk_bf16(S1[8 * h2 + 2], S1[8 * h2 + 3]), cvt_pk_bf16(S1[8 * h2 + 4], S1[8 * h2 + 5]), cvt_pk_bf16(S1[8 * h2 + 6], S1[8 * h2 + 7])};
                pf[h2] = *(bf16x8*)&a; pf[2 + h2] = *(bf16x8*)&c; }
#pragma unroll
            for (int d = 0; d < 4; ++d) {
#pragma unroll
                for (int s2 = 0; s2 < 4; ++s2) {
                    const bf16x8 vf = *(const LAS bf16x8*)(vb + (d * 32 + q) * 128 + (((2 * s2 + hh) ^ vt_sw) << 4));
                    O[d] = __builtin_amdgcn_mfma_f32_32x32x16_bf16(vf, pf[s2], O[d], 0, 0, 0); } }
        }
    };
    AT_ISSUE(0);
    if (n > 1) AT_ISSUE(1);
    if (grp == 0) {
#pragma unroll 1
        for (int k = 0; k < n; ++k) { AT_TOP(k); QK(k); SMPV(); }
    } else {
#pragma unroll 1
        for (int k = 0; k < n; ++k) { AT_TOP(k); SMPV(); QK(k); }
        SMPV();
    }
    asm volatile("" ::: "memory"); __builtin_amdgcn_s_barrier(); asm volatile("" ::: "memory");
#undef AT_ISSUE
#undef AT_TOP
    { auto rr = __builtin_amdgcn_permlane32_swap(__float_as_uint(l_run), __float_as_uint(l_run), false, false); l_run = __uint_as_float(rr[0]) + __uint_as_float(rr[1]); }
    bf16_t* op = (bf16_t*)p.Opart + ((size_t)slot * 256 + wid * 32 + q) * 128 + 4 * hh;
#pragma unroll
    for (int d = 0; d < 4; ++d)
#pragma unroll
        for (int g = 0; g < 4; ++g) { u32x2 v = {cvt_pk_bf16(O[d][4 * g], O[d][4 * g + 1]), cvt_pk_bf16(O[d][4 * g + 2], O[d][4 * g + 3])}; *(u32x2*)(op + d * 32 + g * 8) = v; }
    if (hh == 0) { float* ml = p.MLpart + ((size_t)slot * 256 + wid * 32 + q) * 2; ml[0] = m_run; ml[1] = l_run; }
}
__device__ __forceinline__ void attn_phase(LAS unsigned char* lds, const MlaP& p, int c) {
    const int head = c >> 6, cc = c & 63, pp = cc >> 1, bl = 63 - pp, nl = 4 * (64 - pp);
    if ((cc & 1) == 0) attn_item(lds, p, head, bl, 0, ATT_STEPS, 2 * c);
    else { attn_item(lds, p, head, bl, ATT_STEPS, nl, 2 * c); attn_item(lds, p, head, pp, 0, 4 * (pp + 1), 2 * c + 1); }
}
struct GlaP {
    const bf16_t* Hp; const bf16_t* GVt; const float* wg; const float* bg; const float* ng; const float* wconv;
    bf16_t* QE; float* OI; float* kvT; float* decay; bf16_t* spT; bf16_t* Yab; bf16_t* Ybb; bf16_t* Ycb;
    const float* Opart; const float* MLpart;
};
__device__ __forceinline__ int pos16(int i) { return (i & 48) | ((i & 4) << 1) | ((i & 8) >> 1) | (i & 3); }
__device__ __forceinline__ void gla_g1(LAS unsigned char* lds, const GlaP& p, int c, int G) {
    const int tid = tid_now(), wid = __builtin_amdgcn_readfirstlane(tid >> 6), lane = tid & 63, l31 = lane & 31, hh = lane >> 5;
    LAS float* bsm = (LAS float*)lds; LAS float* gtot = (LAS float*)(lds + 17408); LAS float* blast = (LAS float*)(lds + 19456);
    LAS unsigned char* qeL = lds + 20480; LAS unsigned char* keL = lds + 28672; LAS unsigned char* ktL = lds + 36864;
    const int eb = wid & 3, hb = wid >> 2;
    for (int u = c; u < 1024; u += G) {
        const int n = u >> 2, h = u & 3;
        bf16x8 vf[4];
        { const bf16_t* vp = p.GVt + ((size_t)u * 128 + eb * 32 + l31) * 64 + 8 * hh;
#pragma unroll
          for (int s4 = 0; s4 < 4; ++s4) vf[s4] = *(const bf16x8*)(vp + 16 * s4); }
        { const int d = tid & 63, g = tid >> 6;
          float w[16];
#pragma unroll
          for (int r = 0; r < 16; ++r) w[r] = p.wg[r * 256 + h * 64 + d];
          const float bias = p.bg[h * 64 + d];
          float cs[8]; float run = 0.f;
#pragma unroll
          for (int k = 0; k < 8; ++k) { const int i = 8 * g + k;
              const u32x4 g0 = *(const u32x4*)(p.Hp + (size_t)(64 * n + i) * HW + H_GLR), g1 = *(const u32x4*)(p.Hp + (size_t)(64 * n + i) * HW + H_GLR + 8);
              float la = bias;
#pragma unroll
              for (int r = 0; r < 4; ++r) { la += bflo(g0[r]) * w[2 * r] + bfhi(g0[r]) * w[2 * r + 1]; la += bflo(g1[r]) * w[8 + 2 * r] + bfhi(g1[r]) * w[8 + 2 * r + 1]; }
              const float ls = (fminf(la, 0.f) - __logf(1.f + __expf(-fabsf(la)))) * (1.f / 16.f);
              run += ls; cs[k] = run; }
          gtot[g * 64 + d] = run;
          __syncthreads();
          float pre = 0.f, tot = 0.f;
#pragma unroll
          for (int gg = 0; gg < 8; ++gg) { const float v = gtot[gg * 64 + d]; tot += v; if (gg < g) pre += v; }
#pragma unroll
          for (int k = 0; k < 8; ++k) bsm[(8 * g + k) * 68 + d] = pre + cs[k];
          if (g == 0) { blast[d] = tot; p.decay[(size_t)u * 64 + d] = __expf(tot); } }
        __syncthreads();
        { const int i = tid >> 3, cc = tid & 7, d0 = 8 * cc; const size_t t = (size_t)64 * n + i;
          const u32x4 qv = *(const u32x4*)(p.Hp + t * HW + H_GQ + h * 64 + d0), kv = *(const u32x4*)(p.Hp + t * HW + H_GK + h * 64 + d0);
          float b[8], bl[8];
          { const f32x4 b0 = *(const LAS f32x4*)(bsm + i * 68 + d0), b1 = *(const LAS f32x4*)(bsm + i * 68 + d0 + 4), l0 = *(const LAS f32x4*)(blast + d0), l1 = *(const LAS f32x4*)(blast + d0 + 4);
#pragma unroll
            for (int j = 0; j < 4; ++j) { b[j] = b0[j]; b[4 + j] = b1[j]; bl[j] = l0[j]; bl[4 + j] = l1[j]; } }
          float qe[8], ke[8], kt[8];
#pragma unroll
          for (int j = 0; j < 8; ++j) { const float qq = (j & 1) ? bfhi(qv[j >> 1]) : bflo(qv[j >> 1]), kk = (j & 1) ? bfhi(kv[j >> 1]) : bflo(kv[j >> 1]);
              qe[j] = qq * 0.125f * __expf(b[j]); ke[j] = kk * __expf(-b[j]); kt[j] = kk * __expf(bl[j] - b[j]); }
          const u32x4 qo = {cvt_pk_bf16(qe[0], qe[1]), cvt_pk_bf16(qe[2], qe[3]), cvt_pk_bf16(qe[4], qe[5]), cvt_pk_bf16(qe[6], qe[7])};
          const u32x4 ko = {cvt_pk_bf16(ke[0], ke[1]), cvt_pk_bf16(ke[2], ke[3]), cvt_pk_bf16(ke[4], ke[5]), cvt_pk_bf16(ke[6], ke[7])};
          const int sw = (i >> 1) & 7;
          *(LAS u32x4*)(qeL + i * 128 + ((cc ^ sw) << 4)) = qo; *(LAS u32x4*)(keL + i * 128 + ((cc ^ sw) << 4)) = ko;
          *(u32x4*)(p.QE + t * 256 + h * 64 + d0) = qo;
          const int pi = pos16(i);
#pragma unroll
          for (int j = 0; j < 8; ++j) { const int d = d0 + j; const unsigned pk = cvt_pk_bf16(kt[j], 0.f);
              *(LAS unsigned short*)(ktL + d * 128 + (((pi >> 3) ^ ((d >> 1) & 7)) << 4) + (pi & 7) * 2) = (unsigned short)pk; } }
        __syncthreads();
        { f32x16 OT, KV;
#pragma unroll
          for (int r = 0; r < 16; ++r) { OT[r] = 0.f; KV[r] = 0.f; }
          const int sw = (l31 >> 1) & 7;
#pragma unroll
          for (int jb = 0; jb < 2; ++jb) {
              if (jb <= hb) {
                  f32x16 Sc;
#pragma unroll
                  for (int r = 0; r < 16; ++r) Sc[r] = 0.f;
#pragma unroll
                  for (int s = 0; s < 4; ++s) {
                      const bf16x8 ka = *(const LAS bf16x8*)(keL + (32 * jb + l31) * 128 + (((2 * s + hh) ^ sw) << 4));
                      const bf16x8 qb = *(const LAS bf16x8*)(qeL + (32 * hb + l31) * 128 + (((2 * s + hh) ^ sw) << 4));
                      Sc = __builtin_amdgcn_mfma_f32_32x32x16_bf16(ka, qb, Sc, 0, 0, 0); }
                  if (jb == hb) {
#pragma unroll
                      for (int r = 0; r < 16; ++r) { const int j = (r & 3) + 8 * (r >> 2) + 4 * hh; if (j > l31) Sc[r] = 0.f; } }
#pragma unroll
                  for (int h2 = 0; h2 < 2; ++h2) {
                      u32x4 a = {cvt_pk_bf16(Sc[8 * h2 + 0], Sc[8 * h2 + 1]), cvt_pk_bf16(Sc[8 * h2 + 2], Sc[8 * h2 + 3]), cvt_pk_bf16(Sc[8 * h2 + 4], Sc[8 * h2 + 5]), cvt_pk_bf16(Sc[8 * h2 + 6], Sc[8 * h2 + 7])};
                      OT = __builtin_amdgcn_mfma_f32_32x32x16_bf16(vf[2 * jb + h2], *(bf16x8*)&a, OT, 0, 0, 0); } } }
#pragma unroll
          for (int s4 = 0; s4 < 4; ++s4) {
              const bf16x8 kb = *(const LAS bf16x8*)(ktL + (32 * hb + l31) * 128 + (((2 * s4 + hh) ^ sw) << 4));
              KV = __builtin_amdgcn_mfma_f32_32x32x16_bf16(vf[s4], kb, KV, 0, 0, 0); }
          float* oi = p.OI + ((size_t)u * 8 + wid) * 1024 + lane;
#pragma unroll
          for (int r = 0; r < 16; ++r) oi[r * 64] = OT[r];
          float* kp = p.kvT + (size_t)u * 8192 + 32 * hb + l31;
#pragma unroll
          for (int r = 0; r < 16; ++r) { const int e = 32 * eb + (r & 3) + 8 * (r >> 2) + 4 * hh; kp[e * 64] = KV[r]; } }
        __syncthreads();
    }
}
__device__ __forceinline__ void gla_g2(LAS unsigned char* lds, const GlaP& p, int c) {
    const int tid = tid_now(), el = tid & 127, seg = tid >> 7;
    const int idx = c * 128 + el, h = idx >> 13, ed = idx & 8191, d = idx & 63;
    LAS float* segS = (LAS float*)lds; LAS float* segD = (LAS float*)(lds + 2048);
    float st = 0.f, dp = 1.f;
    for (int n0 = seg * 64; n0 < seg * 64 + 64; n0 += 16) {
        float kv[16], dc[16];
#pragma unroll
        for (int k = 0; k < 16; ++k) { const size_t u = (size_t)(n0 + k) * 4 + h; kv[k] = p.kvT[u * 8192 + ed]; dc[k] = p.decay[u * 64 + d]; }
#pragma unroll
        for (int k = 0; k < 16; ++k) { st = fmaf(dc[k], st, kv[k]); dp *= dc[k]; }
    }
    __syncthreads();
    segS[seg * 128 + el] = st; segD[seg * 128 + el] = dp;
    __syncthreads();
    st = 0.f;
    for (int s2 = 0; s2 < seg; ++s2) st = fmaf(segD[s2 * 128 + el], st, segS[s2 * 128 + el]);
    for (int n0 = seg * 64; n0 < seg * 64 + 64; n0 += 16) {
        float kv[16], dc[16];
#pragma unroll
        for (int k = 0; k < 16; ++k) { const size_t u = (size_t)(n0 + k) * 4 + h; kv[k] = p.kvT[u * 8192 + ed]; dc[k] = p.decay[u * 64 + d]; }
#pragma unroll
        for (int k = 0; k < 16; ++k) { const size_t u = (size_t)(n0 + k) * 4 + h; p.spT[u * 8192 + ed] = (bf16_t)(cvt_pk_bf16(st, 0.f) & 0xffffu); st = fmaf(dc[k], st, kv[k]); }
    }
    __syncthreads();
}
__device__ __forceinline__ void gla_g3(LAS unsigned char* lds, const GlaP& p, int c, int G) {
    const int tid = tid_now(), wid = __builtin_amdgcn_readfirstlane(tid >> 6), lane = tid & 63, l31 = lane & 31, hh = lane >> 5;
    LAS float* red = (LAS float*)lds;
    const int eb = wid & 3, ib = wid >> 2;
    struct In { f32x16 oi; bf16x8 sp[4], qe[4]; u32x2 rv[4]; };
    auto load = [&](int u, In& x) __attribute__((always_inline)) {
        const int n = u >> 2, h = u & 3; const size_t t = (size_t)64 * n + 32 * ib + l31;
        const float* oi = p.OI + ((size_t)u * 8 + wid) * 1024 + lane;
#pragma unroll
        for (int r = 0; r < 16; ++r) x.oi[r] = oi[r * 64];
        const bf16_t* sp = p.spT + ((size_t)u * 128 + 32 * eb + l31) * 64 + 8 * hh; const bf16_t* qp = p.QE + t * 256 + h * 64 + 8 * hh;
#pragma unroll
        for (int s = 0; s < 4; ++s) { x.sp[s] = *(const bf16x8*)(sp + 16 * s); x.qe[s] = *(const bf16x8*)(qp + 16 * s); }
#pragma unroll
        for (int g = 0; g < 4; ++g) x.rv[g] = *(const u32x2*)(p.Hp + t * HW + H_GR + h * 128 + 32 * eb + 8 * g + 4 * hh);
    };
    In cur, nxt;
    if (c < 1024) load(c, cur);
    for (int u = c; u < 1024; u += G) {
        const int n = u >> 2, h = u & 3;
        const bool hn = u + G < 1024;
        if (hn) load(u + G, nxt);
        f32x16 O = cur.oi;
        const size_t t = (size_t)64 * n + 32 * ib + l31;
#pragma unroll
        for (int s = 0; s < 4; ++s) O = __builtin_amdgcn_mfma_f32_32x32x16_bf16(cur.sp[s], cur.qe[s], O, 0, 0, 0);
        float ss = 0.f;
#pragma unroll
        for (int r = 0; r < 16; ++r) ss += O[r] * O[r];
        { auto rr = __builtin_amdgcn_permlane32_swap(__float_as_uint(ss), __float_as_uint(ss), false, false); ss = __uint_as_float(rr[0]) + __uint_as_float(rr[1]); }
        __syncthreads();
        if (hh == 0) red[eb * 64 + 32 * ib + l31] = ss;
        __syncthreads();
        const int ti = 32 * ib + l31;
        const float tot = (red[ti] + red[64 + ti]) + (red[128 + ti] + red[192 + ti]);
        const float rs = rsqrtf(tot * (1.f / 128.f) + 1e-6f);
#pragma unroll
        for (int g = 0; g < 4; ++g) { const int e0 = 32 * eb + 8 * g + 4 * hh;
            const u32x2 rv = cur.rv[g]; const f32x4 gn = *(const f32x4*)(p.ng + e0);
            float y[4];
#pragma unroll
            for (int j = 0; j < 4; ++j) { const float r_ = (j & 1) ? bfhi(rv[j >> 1]) : bflo(rv[j >> 1]); y[j] = O[4 * g + j] * rs * gn[j] * (r_ * frcp(1.f + __expf(-r_))); }
            u32x2 o = {cvt_pk_bf16(y[0], y[1]), cvt_pk_bf16(y[2], y[3])};
            *(u32x2*)(p.Ybb + t * 512 + h * 128 + e0) = o; }
        if (hn) cur = nxt;
    }
}
__device__ __forceinline__ void conv_phase(const GlaP& p, int gtid, int gthreads) {
    constexpr int NT = T * 64;
    for (int idx0 = gtid; idx0 < NT; idx0 += 2 * gthreads) {
        u32x4 av[2][3], xv[2][3], bv[2]; int tt[2], cc[2];
#pragma unroll
        for (int u = 0; u < 2; ++u) { const int idx = min(idx0 + u * gthreads, NT - 1); const int t = idx >> 6, c0 = (idx & 63) * 8; tt[u] = t; cc[u] = c0;
#pragma unroll
            for (int k = 0; k < 3; ++k) { const int ts = max(t - 2 + k, 0);
                av[u][k] = *(const u32x4*)(p.Hp + (size_t)ts * HW + H_AC + c0); xv[u][k] = *(const u32x4*)(p.Hp + (size_t)ts * HW + H_AX + c0); }
            bv[u] = *(const u32x4*)(p.Hp + (size_t)t * HW + H_AB + c0); }
#pragma unroll
        for (int u = 0; u < 2; ++u) { if (idx0 + u * gthreads < NT) { const int t = tt[u], c0 = cc[u];
            float y[8];
#pragma unroll
            for (int j = 0; j < 8; ++j) y[j] = 0.f;
#pragma unroll
            for (int k = 0; k < 3; ++k) { if (t - 2 + k >= 0) {
                const f32x4 w0 = *(const f32x4*)(p.wconv + k * 512 + c0), w1 = *(const f32x4*)(p.wconv + k * 512 + c0 + 4);
#pragma unroll
                for (int j = 0; j < 4; ++j) { y[2 * j] += (j < 2 ? w0[2 * j] : w1[2 * j - 4]) * (bflo(av[u][k][j]) * bflo(xv[u][k][j])); y[2 * j + 1] += (j < 2 ? w0[2 * j + 1] : w1[2 * j - 3]) * (bfhi(av[u][k][j]) * bfhi(xv[u][k][j])); } } }
            u32x4 o;
#pragma unroll
            for (int j = 0; j < 4; ++j) o[j] = cvt_pk_bf16(bflo(bv[u][j]) * y[2 * j], bfhi(bv[u][j]) * y[2 * j + 1]);
            *(u32x4*)(p.Yab + (size_t)t * 512 + c0) = o; } }
    }
}
__device__ __forceinline__ void attn_combine_bf16(const GlaP& p, int gtid, int gthreads) {
    constexpr int NT = 256 * 256 * 32;
    for (int idx0 = gtid; idx0 < NT; idx0 += 2 * gthreads) {
        float mv[2][2], lv[2][2]; u32x2 ov[2][2]; int nval[2]; size_t orow[2]; int ocol[2];
#pragma unroll
        for (int u = 0; u < 2; ++u) { const int idx = min(idx0 + u * gthreads, NT - 1);
            const int dq = idx & 31, row = (idx >> 5) & 255, g = idx >> 13, head = g >> 6, b = g & 63;
            const int s0 = b >= 32 ? 2 * (head * 64 + 2 * (63 - b)) : 2 * (head * 64 + 2 * b + 1) + 1;
            nval[u] = b >= 32 ? 2 : 1; orow[u] = (size_t)(b * 256 + row) * 512 + head * 128; ocol[u] = dq * 4;
#pragma unroll
            for (int k = 0; k < 2; ++k) { const size_t sl = (size_t)(s0 + (b >= 32 ? 2 * k : 0)) * 256 + row;
                const f32x2 ml = *(const f32x2*)(p.MLpart + sl * 2); mv[u][k] = ml[0]; lv[u][k] = ml[1];
                ov[u][k] = *(const u32x2*)((const bf16_t*)p.Opart + sl * 128 + dq * 4); } }
#pragma unroll
        for (int u = 0; u < 2; ++u) { if (idx0 + u * gthreads < NT) {
            float M = mv[u][0];
#pragma unroll
            for (int k = 1; k < 2; ++k) if (k < nval[u]) M = fmaxf(M, mv[u][k]);
            f32x4 acc = {0.f, 0.f, 0.f, 0.f}; float l = 0.f;
#pragma unroll
            for (int k = 0; k < 2; ++k) { const float w = k < nval[u] ? __builtin_amdgcn_exp2f(mv[u][k] - M) : 0.f;
                l += w * lv[u][k]; const f32x4 o = {bflo(ov[u][k][0]), bfhi(ov[u][k][0]), bflo(ov[u][k][1]), bfhi(ov[u][k][1])}; acc += o * w; }
            const float il = frcp(l);
            u32x2 o = {cvt_pk_bf16(acc[0] * il, acc[1] * il), cvt_pk_bf16(acc[2] * il, acc[3] * il)};
            *(u32x2*)(p.Ycb + orow[u] + ocol[u]) = o; } }
    }
}
struct P {
    const float *x, *pin; const int* pos;
    const float *ln0_g, *ln0_b, *w_in, *w_conv, *w_gg, *b_gg, *gla_ng, *qn_g, *kvn_g, *w_uq, *w_ukv, *w_br, *w_o, *ln1_g, *ln1_b, *w_grp, *b_grp, *w_exp, *b_exp,
                *w_gate, *w_up, *w_down, *ln2_g, *ln2_b, *w_pg, *b_pg, *w_pu, *ln3_g, *ln3_b;
    float* out;
    float *X, *Z, *cs, *sn, *ssq_q, *ssq_kv, *OI, *kvT, *decay, *MLpart, *ew;
    bf16_t *Db, *Xb, *Hp, *GVt, *Qb, *KnImg, *VtImg, *KrImg, *QE, *spT, *Yab, *Ybb, *Ycb, *Mgb, *Hbuf, *Ys, *Ub, *Pb;
    bf16_t *Wb_in, *Wb_gv, *Wb_uq, *Wb_uk, *Wb_uv, *Wb_br, *Wb_o, *Wb_gu, *Wb_d, *Wb_pg, *Wb_pu;
    int *cnt, *lists; unsigned* bar;
};
__device__ __forceinline__ MegaP mk_mega(const P& p) { MegaP m; m.w_in = p.w_in; m.Wb_in = p.Wb_in; m.Wb_gv = p.Wb_gv; m.Xb = p.Xb; m.Hp = p.Hp; m.GVt = p.GVt; m.ssq_q = p.ssq_q; m.ssq_kv = p.ssq_kv; return m; }
__device__ __forceinline__ MlaP mk_mla(const P& p) { MlaP q; q.w_uq = p.w_uq; q.w_ukv = p.w_ukv; q.qn_g = p.qn_g; q.kvn_g = p.kvn_g; q.Wb_uq = p.Wb_uq; q.Wb_uk = p.Wb_uk; q.Wb_uv = p.Wb_uv; q.Hp = p.Hp;
    q.ssq_q = p.ssq_q; q.ssq_kv = p.ssq_kv; q.cs = p.cs; q.sn = p.sn; q.Qb = p.Qb; q.KnImg = p.KnImg; q.VtImg = p.VtImg; q.KrImg = p.KrImg; q.Opart = p.Z; q.MLpart = p.MLpart; q.Yc = nullptr; return q; }
__device__ __forceinline__ GlaP mk_gla(const P& p, int layer) { GlaP g; g.Hp = p.Hp; g.GVt = p.GVt; g.wg = p.w_gg + layer * 16 * 256; g.bg = p.b_gg + layer * 256; g.ng = p.gla_ng + layer * 128; g.wconv = p.w_conv + layer * 3 * 512;
    g.QE = p.QE; g.OI = p.OI; g.kvT = p.kvT; g.decay = p.decay; g.spT = p.spT; g.Yab = p.Yab; g.Ybb = p.Ybb; g.Ycb = p.Ycb; g.Opart = p.Z; g.MLpart = p.MLpart; return g; }

struct CvJob { const float* W; bf16_t* Bt; const float* rs; int ldw, Ksrc, ldbt, n0, k0, kind, aux; };
struct MapId { __device__ __forceinline__ int operator()(int s) const { return s; } };
__device__ __forceinline__ int cv_map(int kind, int aux, int n) {
    if (kind == 0) return MapInMain{}(n);
    if (kind == 1) return aux + n;
    if (kind == 2) return MapQ{}(n);
    if (kind == 3) return MapKV{aux}(n);
    return n; }
__device__ __forceinline__ int cv_omap(int kind, int aux, int n) { return kind == 4 ? (n >> 7) * 256 + aux * 128 + (n & 127) : n; }
__device__ __forceinline__ bool cv_job(const P& p, int layer, int t, CvJob& j) {
    constexpr int S0 = 384, S1 = S0 + 32, S2 = S1 + 12, S3 = S2 + 8, S4 = S3 + 8, S5 = S4 + 96, S6 = S5 + 64, S7 = S6 + 64, S8 = S7 + 16, S9 = S8 + 1024, S10 = S9 + 1024, S11 = S10 + 1024;
    if (t >= S11) return false;
    j.rs = nullptr; j.aux = 0; j.kind = 5;
    if (t < S0) { j.W = p.w_in + (size_t)layer * D * INW; j.ldw = INW; j.Ksrc = D; j.Bt = p.Wb_in; j.ldbt = D; j.n0 = (t >> 2) * 64; j.k0 = (t & 3) * 256; j.kind = 0; }
    else if (t < S1) { const int u = t - S0; j.W = p.w_in + (size_t)layer * D * INW; j.ldw = INW; j.Ksrc = D; j.Bt = p.Wb_gv; j.ldbt = D; j.n0 = (u >> 2) * 64; j.k0 = (u & 3) * 256; j.kind = 1; j.aux = O_GV; }
    else if (t < S2) { const int u = t - S1; j.W = p.w_uq + (size_t)layer * 256 * 768; j.ldw = 768; j.Ksrc = 256; j.Bt = p.Wb_uq; j.ldbt = 256; j.n0 = u * 64; j.k0 = 0; j.kind = 2; j.rs = p.qn_g + layer * 256; }
    else if (t < S3) { const int u = t - S2; j.W = p.w_ukv + (size_t)layer * 128 * 1024; j.ldw = 1024; j.Ksrc = 128; j.Bt = p.Wb_uk; j.ldbt = 256; j.n0 = u * 64; j.k0 = 0; j.kind = 3; j.aux = 0; j.rs = p.kvn_g + layer * 128; }
    else if (t < S4) { const int u = t - S3; j.W = p.w_ukv + (size_t)layer * 128 * 1024; j.ldw = 1024; j.Ksrc = 128; j.Bt = p.Wb_uv; j.ldbt = 256; j.n0 = u * 64; j.k0 = 0; j.kind = 3; j.aux = 128; j.rs = p.kvn_g + layer * 128; }
    else if (t < S5) { const int u = t - S4, br = u >> 5, v = u & 31; j.W = p.w_br + (size_t)layer * 1536 * D + (size_t)br * 512 * D; j.ldw = D; j.Ksrc = 512; j.Bt = p.Wb_br + (size_t)br * 1024 * 512; j.ldbt = 512; j.n0 = (v >> 1) * 64; j.k0 = (v & 1) * 256; }
    else if (t < S6) { const int u = t - S5; j.W = p.w_o + (size_t)layer * D * D; j.ldw = D; j.Ksrc = D; j.Bt = p.Wb_o; j.ldbt = D; j.n0 = (u >> 2) * 64; j.k0 = (u & 3) * 256; }
    else if (t < S7) { const int u = t - S6; j.W = p.w_pg + (size_t)layer * D * D; j.ldw = D; j.Ksrc = D; j.Bt = p.Wb_pg; j.ldbt = D; j.n0 = (u >> 2) * 64; j.k0 = (u & 3) * 256; }
    else if (t < S8) { const int u = t - S7; j.W = p.w_pu + (size_t)layer * PLE * D; j.ldw = D; j.Ksrc = PLE; j.Bt = p.Wb_pu; j.ldbt = PLE; j.n0 = u * 64; j.k0 = 0; }
    else if (t < S9) { const int u = t - S8, e = u >> 4, v = u & 15; j.W = p.w_gate + ((size_t)layer * NE + e) * D * EH; j.ldw = EH; j.Ksrc = D; j.Bt = p.Wb_gu + (size_t)e * 512 * D; j.ldbt = D; j.n0 = (v >> 2) * 64; j.k0 = (v & 3) * 256; j.kind = 4; j.aux = 0; }
    else if (t < S10) { const int u = t - S9, e = u >> 4, v = u & 15; j.W = p.w_up + ((size_t)layer * NE + e) * D * EH; j.ldw = EH; j.Ksrc = D; j.Bt = p.Wb_gu + (size_t)e * 512 * D; j.ldbt = D; j.n0 = (v >> 2) * 64; j.k0 = (v & 3) * 256; j.kind = 4; j.aux = 1; }
    else { const int u = t - S10, e = u >> 4, v = u & 15; j.W = p.w_down + ((size_t)layer * NE + e) * EH * D; j.ldw = D; j.Ksrc = EH; j.Bt = p.Wb_d + (size_t)e * D * EH; j.ldbt = EH; j.n0 = v * 64; j.k0 = 0; }
    return true; }
__device__ __forceinline__ void cv_load(const CvJob& j, int tid, f32x4 (&v)[8]) {
    const int n4 = tid & 15, kr = tid >> 4; const int col = cv_map(j.kind, j.aux, j.n0 + 4 * n4);
#pragma unroll
    for (int r = 0; r < 8; ++r) { const int k = j.k0 + kr + 32 * r; v[r] = (f32x4){0.f, 0.f, 0.f, 0.f};
        if (col >= 0 && k < j.Ksrc) { v[r] = *(const f32x4*)(j.W + (size_t)k * j.ldw + col); if (j.rs) v[r] = v[r] * j.rs[k]; } }
}
__device__ __forceinline__ void ph_convert(LAS unsigned char* ldsl, const P& p, int layer) {
    LAS float* tile = (LAS float*)ldsl;
    const int tid = tid_now(), c = sgpr_now((int)blockIdx.x), G = gridDim.x;
    CvJob cur, nxt; f32x4 v[8], w[8];
    bool have = cv_job(p, layer, c, cur);
    if (have) cv_load(cur, tid, v);
    for (int t = c; have; t += G) {
        const bool hn = cv_job(p, layer, t + G, nxt);
        if (hn) cv_load(nxt, tid, w);
        __syncthreads();
        { const int n4 = tid & 15, kr = tid >> 4;
#pragma unroll
          for (int r = 0; r < 8; ++r) { LAS float* d = tile + (kr + 32 * r) * 65 + 4 * n4; d[0] = v[r][0]; d[1] = v[r][1]; d[2] = v[r][2]; d[3] = v[r][3]; } }
        __syncthreads();
        { const int kk = (tid & 127) * 2, nn = tid >> 7;
#pragma unroll
          for (int r = 0; r < 16; ++r) { const int n = nn + 4 * r;
              *(unsigned*)(cur.Bt + (size_t)cv_omap(cur.kind, cur.aux, cur.n0 + n) * cur.ldbt + cur.k0 + kk) = cvt_pk_bf16(tile[kk * 65 + n], tile[(kk + 1) * 65 + n]); } }
        have = hn; cur = nxt;
#pragma unroll
        for (int r = 0; r < 8; ++r) v[r] = w[r];
    }
    __syncthreads();
}

__device__ __forceinline__ float wsum(float v, int lane) {
#pragma unroll
    for (int o = 32; o > 0; o >>= 1) v += shx(v, o, lane);
    return v; }
template <int MODE>
__device__ __forceinline__ void ph_rows(const P& p, int layer) {
    const int lane = tid_now() & 63, gw = blockIdx.x * 8 + (tid_now() >> 6), nw = gridDim.x * 8;
    const float* gp = MODE == 0 ? p.ln0_g : MODE == 1 ? p.ln1_g + layer * D : MODE == 2 ? p.ln2_g + layer * D : p.ln3_g + layer * D;
    const float* bp = MODE == 0 ? p.ln0_b : MODE == 1 ? p.ln1_b + layer * D : MODE == 2 ? p.ln2_b + layer * D : p.ln3_b + layer * D;
    f32x4 gg[4], bb[4];
#pragma unroll
    for (int i = 0; i < 4; ++i) { gg[i] = *(const f32x4*)(gp + 256 * i + 4 * lane); bb[i] = *(const f32x4*)(bp + 256 * i + 4 * lane); }
    const float* in = MODE == 0 ? p.x : p.X;
    float* outf = (MODE == 3 && layer == DEPTH - 1) ? p.out : p.X;
    for (int row = gw; row < T; row += nw) {
        f32x4 v[4];
#pragma unroll
        for (int i = 0; i < 4; ++i) v[i] = *(const f32x4*)(in + (size_t)row * D + 256 * i + 4 * lane);
        if constexpr (MODE == 3) {
#pragma unroll
            for (int i = 0; i < 4; ++i) { const u32x2 dd = *(const u32x2*)(p.Db + (size_t)row * D + 256 * i + 4 * lane);
                v[i][0] = DN_ALPHA * v[i][0] + bflo(dd[0]); v[i][1] = DN_ALPHA * v[i][1] + bfhi(dd[0]); v[i][2] = DN_ALPHA * v[i][2] + bflo(dd[1]); v[i][3] = DN_ALPHA * v[i][3] + bfhi(dd[1]); } }
        if constexpr (MODE == 2) { const float w0 = p.ew[2 * row], w1 = p.ew[2 * row + 1];
#pragma unroll
            for (int i = 0; i < 4; ++i) { const u32x2 y0 = *(const u32x2*)(p.Ys + (size_t)(2 * row) * D + 256 * i + 4 * lane), y1 = *(const u32x2*)(p.Ys + (size_t)(2 * row + 1) * D + 256 * i + 4 * lane);
                v[i][0] = DN_ALPHA * v[i][0] + (w0 * bflo(y0[0]) + w1 * bflo(y1[0])); v[i][1] = DN_ALPHA * v[i][1] + (w0 * bfhi(y0[0]) + w1 * bfhi(y1[0]));
                v[i][2] = DN_ALPHA * v[i][2] + (w0 * bflo(y0[1]) + w1 * bflo(y1[1])); v[i][3] = DN_ALPHA * v[i][3] + (w0 * bfhi(y0[1]) + w1 * bfhi(y1[1])); } }
        float s = 0.f;
#pragma unroll
        for (int i = 0; i < 4; ++i) s += (v[i][0] + v[i][1]) + (v[i][2] + v[i][3]);
        const float mu = wsum(s, lane) * (1.f / D);
        float q = 0.f;
#pragma unroll
        for (int i = 0; i < 4; ++i) { v[i] = v[i] - mu; q += (v[i][0] * v[i][0] + v[i][1] * v[i][1]) + (v[i][2] * v[i][2] + v[i][3] * v[i][3]); }
        const float rs = rsqrtf(wsum(q, lane) * (1.f / D) + 1e-5f);
#pragma unroll
        for (int i = 0; i < 4; ++i) { v[i] = v[i] * rs * gg[i] + bb[i];
            *(f32x4*)(outf + (size_t)row * D + 256 * i + 4 * lane) = v[i];
            u32x2 o = {cvt_pk_bf16(v[i][0], v[i][1]), cvt_pk_bf16(v[i][2], v[i][3])};
            *(u32x2*)(p.Xb + (size_t)row * D + 256 * i + 4 * lane) = o; }
        if constexpr (MODE == 1) {
            const float* wg = p.w_grp + (size_t)layer * D * 8; const float* we = p.w_exp + (size_t)layer * D * 64;
            float gl[8];
#pragma unroll
            for (int g = 0; g < 8; ++g) gl[g] = 0.f;
#pragma unroll
            for (int i = 0; i < 4; ++i)
#pragma unroll
                for (int j = 0; j < 4; ++j) { const int k = 256 * i + 4 * lane + j; const f32x4 a = *(const f32x4*)(wg + k * 8), b = *(const f32x4*)(wg + k * 8 + 4); const float xv = v[i][j];
                    gl[0] = fmaf(xv, a[0], gl[0]); gl[1] = fmaf(xv, a[1], gl[1]); gl[2] = fmaf(xv, a[2], gl[2]); gl[3] = fmaf(xv, a[3], gl[3]);
                    gl[4] = fmaf(xv, b[0], gl[4]); gl[5] = fmaf(xv, b[1], gl[5]); gl[6] = fmaf(xv, b[2], gl[6]); gl[7] = fmaf(xv, b[3], gl[7]); }
            float mx = -INFINITY; int gt = 0;
#pragma unroll
            for (int g = 0; g < 8; ++g) { gl[g] = wsum(gl[g], lane) + p.b_grp[layer * 8 + g]; if (gl[g] > mx) { mx = gl[g]; gt = g; } }
            gt = __builtin_amdgcn_readfirstlane(gt);
            float sum = 0.f;
#pragma unroll
            for (int g = 0; g < 8; ++g) sum += expf(gl[g] - mx);
            const float pg = 1.f / sum;
            float el[8];
#pragma unroll
            for (int e = 0; e < 8; ++e) el[e] = 0.f;
#pragma unroll
            for (int i = 0; i < 4; ++i)
#pragma unroll
                for (int j = 0; j < 4; ++j) { const int k = 256 * i + 4 * lane + j; const f32x4 a = *(const f32x4*)(we + k * 64 + gt * 8), b = *(const f32x4*)(we + k * 64 + gt * 8 + 4); const float xv = v[i][j];
                    el[0] = fmaf(xv, a[0], el[0]); el[1] = fmaf(xv, a[1], el[1]); el[2] = fmaf(xv, a[2], el[2]); el[3] = fmaf(xv, a[3], el[3]);
                    el[4] = fmaf(xv, b[0], el[4]); el[5] = fmaf(xv, b[1], el[5]); el[6] = fmaf(xv, b[2], el[6]); el[7] = fmaf(xv, b[3], el[7]); }
            float v1 = -INFINITY, v2 = -INFINITY; int i1 = 0, i2 = 0;
#pragma unroll
            for (int e = 0; e < 8; ++e) { const float vv = wsum(el[e], lane) + p.b_exp[layer * 64 + gt * 8 + e];
                if (vv > v1) { v2 = v1; i2 = i1; v1 = vv; i1 = e; } else if (vv > v2) { v2 = vv; i2 = e; } }
            if (lane == 0) { const float e2 = expf(v2 - v1), w1 = pg / (1.f + e2), w2 = pg * e2 / (1.f + e2);
                const int ea = gt * 8 + i1, eb = gt * 8 + i2; int* cn = p.cnt + layer * 64;
                p.ew[2 * row] = w1; p.ew[2 * row + 1] = w2;
                const int pa = atomicAdd(&cn[ea], 1); p.lists[ea * LCAP + pa] = 2 * row;
                const int pb = atomicAdd(&cn[eb], 1); p.lists[eb * LCAP + pb] = 2 * row + 1; }
        }
    }
}

__device__ __forceinline__ void wsum8(float (&x)[8], int lane) {
    float y[4], z[2], w;
#pragma unroll
    for (int k = 0; k < 4; ++k) { const bool hi = lane & 32; const float snd = hi ? x[k] : x[k + 4], keep = hi ? x[k + 4] : x[k]; y[k] = keep + shx(snd, 32, lane); }
#pragma unroll
    for (int k = 0; k < 2; ++k) { const bool hi = lane & 16; const float snd = hi ? y[k] : y[k + 2], keep = hi ? y[k + 2] : y[k]; z[k] = keep + shx(snd, 16, lane); }
    { const bool hi = lane & 8; const float snd = hi ? z[0] : z[1], keep = hi ? z[1] : z[0]; w = keep + shx(snd, 8, lane); }
    w += shx(w, 4, lane); w += shx(w, 2, lane); w += shx(w, 1, lane);
#pragma unroll
    for (int k = 0; k < 8; ++k) x[k] = __int_as_float(__builtin_amdgcn_readlane(__float_as_int(w), (k >> 2) * 32 + ((k >> 1) & 1) * 16 + (k & 1) * 8));
}
__device__ __forceinline__ void ph_ln1_router(const P& p, int layer) {
    constexpr int RR = 2;
    const int tid = tid_now(), lane0 = tid & 63, gw = sgpr_now((int)blockIdx.x) * 8 + (tid >> 6), nw = gridDim.x * 8;
    const float* gp = p.ln1_g + layer * D; const float* bp = p.ln1_b + layer * D;
    const float* wg = p.w_grp + (size_t)layer * D * 8; const float* we = p.w_exp + (size_t)layer * D * 64;
    for (int row0 = gw * RR; row0 < T; row0 += nw * RR) {
        int lane = lane0; asm volatile("" : "+v"(lane));
        f32x4 v[RR][4];
#pragma unroll
        for (int r = 0; r < RR; ++r)
#pragma unroll
            for (int i = 0; i < 4; ++i) { v[r][i] = *(const f32x4*)(p.X + (size_t)(row0 + r) * D + 256 * i + 4 * lane);
                const u32x2 dd = *(const u32x2*)(p.Db + (size_t)(row0 + r) * D + 256 * i + 4 * lane);
                v[r][i][0] = DN_ALPHA * v[r][i][0] + bflo(dd[0]); v[r][i][1] = DN_ALPHA * v[r][i][1] + bfhi(dd[0]); v[r][i][2] = DN_ALPHA * v[r][i][2] + bflo(dd[1]); v[r][i][3] = DN_ALPHA * v[r][i][3] + bfhi(dd[1]); }
#pragma unroll
        for (int r = 0; r < RR; ++r) {
            float s = 0.f;
#pragma unroll
            for (int i = 0; i < 4; ++i) s += (v[r][i][0] + v[r][i][1]) + (v[r][i][2] + v[r][i][3]);
            const float mu = wsum(s, lane) * (1.f / D);
            float q = 0.f;
#pragma unroll
            for (int i = 0; i < 4; ++i) { v[r][i] = v[r][i] - mu; q += (v[r][i][0] * v[r][i][0] + v[r][i][1] * v[r][i][1]) + (v[r][i][2] * v[r][i][2] + v[r][i][3] * v[r][i][3]); }
            const float rs = rsqrtf(wsum(q, lane) * (1.f / D) + 1e-5f);
#pragma unroll
            for (int i = 0; i < 4; ++i) { const f32x4 gg = *(const f32x4*)(gp + 256 * i + 4 * lane), bb = *(const f32x4*)(bp + 256 * i + 4 * lane);
                v[r][i] = v[r][i] * rs * gg + bb;
                *(f32x4*)(p.X + (size_t)(row0 + r) * D + 256 * i + 4 * lane) = v[r][i];
                u32x2 o = {cvt_pk_bf16(v[r][i][0], v[r][i][1]), cvt_pk_bf16(v[r][i][2], v[r][i][3])};
                *(u32x2*)(p.Xb + (size_t)(row0 + r) * D + 256 * i + 4 * lane) = o; } }
        float gl[RR][8];
#pragma unroll
        for (int r = 0; r < RR; ++r)
#pragma unroll
            for (int g = 0; g < 8; ++g) gl[r][g] = 0.f;
#pragma unroll
        for (int i = 0; i < 4; ++i) { asm volatile("" : "+v"(lane) :: "memory");
#pragma unroll
            for (int j = 0; j < 4; ++j) { const int k = 256 * i + 4 * lane + j; const f32x4 a = *(const f32x4*)(wg + k * 8), b = *(const f32x4*)(wg + k * 8 + 4);
#pragma unroll
                for (int r = 0; r < RR; ++r) { const float xv = v[r][i][j];
                    gl[r][0] = fmaf(xv, a[0], gl[r][0]); gl[r][1] = fmaf(xv, a[1], gl[r][1]); gl[r][2] = fmaf(xv, a[2], gl[r][2]); gl[r][3] = fmaf(xv, a[3], gl[r][3]);
                    gl[r][4] = fmaf(xv, b[0], gl[r][4]); gl[r][5] = fmaf(xv, b[1], gl[r][5]); gl[r][6] = fmaf(xv, b[2], gl[r][6]); gl[r][7] = fmaf(xv, b[3], gl[r][7]); } } }
        int gt[RR]; float pg[RR];
#pragma unroll
        for (int r = 0; r < RR; ++r) { wsum8(gl[r], lane);
            float mx = -INFINITY; int gi = 0;
#pragma unroll
            for (int g = 0; g < 8; ++g) { gl[r][g] += p.b_grp[layer * 8 + g]; if (gl[r][g] > mx) { mx = gl[r][g]; gi = g; } }
            float sum = 0.f;
#pragma unroll
            for (int g = 0; g < 8; ++g) sum += expf(gl[r][g] - mx);
            gt[r] = __builtin_amdgcn_readfirstlane(gi); pg[r] = 1.f / sum; }
        float el[RR][8];
#pragma unroll
        for (int r = 0; r < RR; ++r) {
#pragma unroll
            for (int e = 0; e < 8; ++e) el[r][e] = 0.f;
#pragma unroll
            for (int i = 0; i < 4; ++i) { asm volatile("" : "+v"(lane) :: "memory");
#pragma unroll
                for (int j = 0; j < 4; ++j) { const int k = 256 * i + 4 * lane + j; const f32x4 a = *(const f32x4*)(we + k * 64 + gt[r] * 8), b = *(const f32x4*)(we + k * 64 + gt[r] * 8 + 4); const float xv = v[r][i][j];
                    el[r][0] = fmaf(xv, a[0], el[r][0]); el[r][1] = fmaf(xv, a[1], el[r][1]); el[r][2] = fmaf(xv, a[2], el[r][2]); el[r][3] = fmaf(xv, a[3], el[r][3]);
                    el[r][4] = fmaf(xv, b[0], el[r][4]); el[r][5] = fmaf(xv, b[1], el[r][5]); el[r][6] = fmaf(xv, b[2], el[r][6]); el[r][7] = fmaf(xv, b[3], el[r][7]); } } }
#pragma unroll
        for (int r = 0; r < RR; ++r) { wsum8(el[r], lane);
            float v1 = -INFINITY, v2 = -INFINITY; int i1 = 0, i2 = 0;
#pragma unroll
            for (int e = 0; e < 8; ++e) { const float vv = el[r][e] + p.b_exp[layer * 64 + gt[r] * 8 + e];
                if (vv > v1) { v2 = v1; i2 = i1; v1 = vv; i1 = e; } else if (vv > v2) { v2 = vv; i2 = e; } }
            if (lane == 0) { const int row = row0 + r; const float e2 = expf(v2 - v1), w1 = pg[r] / (1.f + e2), w2 = pg[r] * e2 / (1.f + e2);
                const int ea = gt[r] * 8 + i1, eb = gt[r] * 8 + i2; int* cn = p.cnt + layer * 64;
                p.ew[2 * row] = w1; p.ew[2 * row + 1] = w2;
                const int pa = atomicAdd(&cn[ea], 1); p.lists[ea * LCAP + pa] = 2 * row;
                const int pb = atomicAdd(&cn[eb], 1); p.lists[eb * LCAP + pb] = 2 * row + 1; } }
    }
}
__device__ __forceinline__ void ph_prologue(const P& p) {
    const int gtid = blockIdx.x * NTHR + tid_now(), gth = gridDim.x * NTHR;
    for (int idx = gtid; idx < T * 32; idx += gth) { const int t = idx >> 5, i = idx & 31;
        const float inv = (float)(1.0 / pow(10000.0, (double)(2 * i) / 64.0)); const float ang = (float)p.pos[t] * inv;
        p.cs[idx] = (float)cos((double)ang); p.sn[idx] = (float)sin((double)ang); }
    for (size_t i = gtid; i < (size_t)DEPTH * T * PLE / 4; i += gth) { const f32x4 v = ((const f32x4*)p.pin)[i]; u32x2 o = {cvt_pk_bf16(v[0], v[1]), cvt_pk_bf16(v[2], v[3])}; ((u32x2*)p.Pb)[i] = o; }
    ph_rows<0>(p, 0);
}

struct SchedBr { __device__ __forceinline__ bool carry(const ge::Unit& u) const { return u.g < 2; }
    const char* Ya; const char* Yb; const char* Yc; const char* W; int c, G;
    __device__ __forceinline__ bool next(int i, ge::Unit& u) const { const int tile = (i / 3) * G + c; if (tile >= 256) return false; u.g = i % 3; ge::tile_order(tile, 64, 4, u.pm, u.pn); return true; }
    __device__ __forceinline__ const char* aptr(const ge::Unit& u) const { return (u.g == 0 ? Ya : u.g == 1 ? Yb : Yc) + (size_t)u.pm * 256 * 512 * 2; }
    __device__ __forceinline__ const char* bptr(const ge::Unit& u) const { return W + ((size_t)u.g * 1024 + u.pn * 256) * 512 * 2; } };
struct EpiBr { const bf16_t* Hp; bf16_t* Mgb;
    __device__ __forceinline__ void operator()(ge::Acc& acc, const ge::Unit& u, int wr, int wc, int fr, int fq) const {
        const int row0 = u.pm * 256 + wr * 64 + fr, col0 = u.pn * 256 + wc * 32 + 8 * fq;
        const bool ratio = u.g < 2;
#pragma unroll
        for (int ai = 0; ai < 2; ++ai) {
            u32x4 gt[4][2], gn[4][2];
#pragma unroll
            for (int m = 0; m < 4; ++m)
#pragma unroll
                for (int bj = 0; bj < 2; ++bj) { const bf16_t* gp = Hp + (size_t)(row0 + ai * 128 + m * 16) * HW + H_GTA + u.g * 1024 + col0 + bj * 128;
                    gt[m][bj] = *(const u32x4*)gp; gn[m][bj] = ratio ? *(const u32x4*)(gp + 1024) : gt[m][bj]; }
            asm volatile("" ::: "memory");
#pragma unroll
            for (int m = 0; m < 4; ++m) { const int row = row0 + ai * 128 + m * 16;
#pragma unroll
                for (int bj = 0; bj < 2; ++bj) { const int col = col0 + bj * 128; const u32x4 g = gt[m][bj], d = gn[m][bj];
                    f32x4 s0 = {bflo(g[0]), bfhi(g[0]), bflo(g[1]), bfhi(g[1])}, s1 = {bflo(g[2]), bfhi(g[2]), bflo(g[3]), bfhi(g[3])};
                    if (ratio) { const f32x4 d0 = {bflo(d[0]), bfhi(d[0]), bflo(d[1]), bfhi(d[1])}, d1 = {bflo(d[2]), bfhi(d[2]), bflo(d[3]), bfhi(d[3])};
#pragma unroll
                        for (int j = 0; j < 4; ++j) { s0[j] = s0[j] * frcp(d0[j]); s1[j] = s1[j] * frcp(d1[j]); } }
                    acc[ai][bj][m][0] = acc[ai][bj][m][0] * s0; acc[ai][bj][m][1] = acc[ai][bj][m][1] * s1;
                    if (u.g == 2) { const f32x4 v0 = acc[ai][bj][m][0], v1 = acc[ai][bj][m][1];
                        u32x4 o = {cvt_pk_bf16(v0[0], v0[1]), cvt_pk_bf16(v0[2], v0[3]), cvt_pk_bf16(v1[0], v1[1]), cvt_pk_bf16(v1[2], v1[3])}; *(u32x4*)(Mgb + (size_t)row * D + col) = o; } } }
        }
    } };
struct SchedT4 : ge::NoCarry { const char* A; const char* B; int lda2, ldb2, c, G;
    __device__ __forceinline__ bool next(int i, ge::Unit& u) const { const int L = i * G + c; if (L >= 256) return false; u.g = 0; ge::tile_order(L, 64, 4, u.pm, u.pn); return true; }
    __device__ __forceinline__ const char* aptr(const ge::Unit& u) const { return A + (size_t)u.pm * lda2; }
    __device__ __forceinline__ const char* bptr(const ge::Unit& u) const { return B + (size_t)u.pn * ldb2; } };
struct EpiRes { bf16_t* Db;
    __device__ __forceinline__ void operator()(ge::Acc& acc, const ge::Unit& u, int wr, int wc, int fr, int fq) const {
        const int row0 = u.pm * 256 + wr * 64 + fr, col0 = u.pn * 256 + wc * 32 + 8 * fq;
#pragma unroll
        for (int ai = 0; ai < 2; ++ai)
#pragma unroll
            for (int m = 0; m < 4; ++m) { const size_t o = (size_t)(row0 + ai * 128 + m * 16) * D + col0;
#pragma unroll
                for (int bj = 0; bj < 2; ++bj) { const f32x4 v0 = acc[ai][bj][m][0], v1 = acc[ai][bj][m][1];
                    u32x4 w = {cvt_pk_bf16(v0[0], v0[1]), cvt_pk_bf16(v0[2], v0[3]), cvt_pk_bf16(v1[0], v1[1]), cvt_pk_bf16(v1[2], v1[3])}; *(u32x4*)(Db + o + bj * 128) = w; } }
    } };
struct EpiU { bf16_t* Ub;
    __device__ __forceinline__ void operator()(ge::Acc& acc, const ge::Unit& u, int wr, int wc, int fr, int fq) const {
        const int row0 = u.pm * 256 + wr * 64 + fr, col0 = u.pn * 256 + wc * 32 + 8 * fq;
#pragma unroll
        for (int ai = 0; ai < 2; ++ai)
#pragma unroll
            for (int m = 0; m < 4; ++m) { const size_t o = (size_t)(row0 + ai * 128 + m * 16) * D + col0;
#pragma unroll
                for (int bj = 0; bj < 2; ++bj) { const f32x4 v0 = acc[ai][bj][m][0], v1 = acc[ai][bj][m][1];
                    u32x4 w = {cvt_pk_bf16(v0[0], v0[1]), cvt_pk_bf16(v0[2], v0[3]), cvt_pk_bf16(v1[0], v1[1]), cvt_pk_bf16(v1[2], v1[3])}; *(u32x4*)(Ub + o + bj * 128) = w; } }
    } };
struct EpiPle { bf16_t* Db; const bf16_t* Ub; const float* bias;
    __device__ __forceinline__ void operator()(ge::Acc& acc, const ge::Unit& u, int wr, int wc, int fr, int fq) const {
        const int row0 = u.pm * 256 + wr * 64 + fr, col0 = u.pn * 256 + wc * 32 + 8 * fq;
        f32x4 bv[2][2];
#pragma unroll
        for (int bj = 0; bj < 2; ++bj) { bv[bj][0] = *(const f32x4*)(bias + col0 + bj * 128); bv[bj][1] = *(const f32x4*)(bias + col0 + bj * 128 + 4); }
#pragma unroll
        for (int ai = 0; ai < 2; ++ai) {
            u32x4 uv[4][2];
#pragma unroll
            for (int m = 0; m < 4; ++m)
#pragma unroll
                for (int bj = 0; bj < 2; ++bj) uv[m][bj] = *(const u32x4*)(Ub + (size_t)(row0 + ai * 128 + m * 16) * D + col0 + bj * 128);
            asm volatile("" ::: "memory");
#pragma unroll
            for (int m = 0; m < 4; ++m) { const size_t o = (size_t)(row0 + ai * 128 + m * 16) * D + col0;
#pragma unroll
                for (int bj = 0; bj < 2; ++bj) { const u32x4 uu = uv[m][bj];
                    f32x4 g0 = acc[ai][bj][m][0] + bv[bj][0], g1 = acc[ai][bj][m][1] + bv[bj][1];
#pragma unroll
                    for (int j = 0; j < 4; ++j) { g0[j] = frcp(1.f + __expf(-g0[j])); g1[j] = frcp(1.f + __expf(-g1[j])); }
                    const f32x4 u0 = {bflo(uu[0]), bfhi(uu[0]), bflo(uu[1]), bfhi(uu[1])}, u1 = {bflo(uu[2]), bfhi(uu[2]), bflo(uu[3]), bfhi(uu[3])};
                    g0 = g0 * u0; g1 = g1 * u1;
                    u32x4 w = {cvt_pk_bf16(g0[0], g0[1]), cvt_pk_bf16(g0[2], g0[3]), cvt_pk_bf16(g1[0], g1[1]), cvt_pk_bf16(g1[2], g1[3])}; *(u32x4*)(Db + o + bj * 128) = w; } } }
    } };

__device__ __forceinline__ void moe_table(LAS unsigned char* lds, const int* cnt) {
    LAS int* te = (LAS int*)(lds + 131072); LAS int* tr = te + 256; LAS int* cl = tr + 256; LAS int* nt = cl + 64;
    __syncthreads();
    if (tid_now() < 64) cl[tid_now()] = cnt[tid_now()];
    __syncthreads();
    if (tid_now() == 0) { int n = 0; for (int e = 0; e < NE; ++e) for (int r = 0; r < cl[e]; r += 256) { te[n] = e; tr[n] = r; ++n; } nt[0] = n; }
    __syncthreads();
}
struct SchedM1 : ge::NoCarry { const char* Xb; const char* W; const int* lists; LAS int* te; int c, G;
    __device__ __forceinline__ bool next(int i, ge::Unit& u) const { const int L = i * G + c; if (L >= 2 * te[576]) return false; u.pm = L >> 1; u.pn = L & 1; u.g = te[u.pm]; return true; }
    __device__ __forceinline__ int arow(const ge::Unit& u, int r) const { const int n = te[512 + u.g], idx = min(te[256 + u.pm] + r, n - 1); return lists[u.g * LCAP + idx] >> 1; }
    __device__ __forceinline__ const char* aptr(const ge::Unit&) const { return Xb; }
    __device__ __forceinline__ const char* bptr(const ge::Unit& u) const { return W + ((size_t)u.g * 512 + u.pn * 256) * D * 2; } };
struct EpiM1 { bf16_t* Hbuf;
    __device__ __forceinline__ void operator()(ge::Acc& acc, const ge::Unit& u, int wr, int wc, int fr, int fq) const {
#pragma unroll
        for (int ai = 0; ai < 2; ++ai)
#pragma unroll
            for (int m = 0; m < 4; ++m) { const int row = ai * 128 + wr * 64 + m * 16 + fr;
                float h[8];
#pragma unroll
                for (int n = 0; n < 2; ++n)
#pragma unroll
                    for (int j = 0; j < 4; ++j) { const float g = acc[ai][0][m][n][j], uu = acc[ai][1][m][n][j]; h[4 * n + j] = g * frcp(1.f + __expf(-g)) * uu; }
                u32x4 o = {cvt_pk_bf16(h[0], h[1]), cvt_pk_bf16(h[2], h[3]), cvt_pk_bf16(h[4], h[5]), cvt_pk_bf16(h[6], h[7])};
                *(u32x4*)(Hbuf + ((size_t)u.pm * 256 + row) * EH + u.pn * 128 + wc * 32 + 8 * fq) = o; }
    } };
struct SchedM2 : ge::NoCarry { const char* Hb; const char* W; LAS int* te; int c, G;
    __device__ __forceinline__ bool next(int i, ge::Unit& u) const { const int L = i * G + c; if (L >= 4 * te[576]) return false; u.pm = L >> 2; u.pn = L & 3; u.g = te[u.pm]; return true; }
    __device__ __forceinline__ const char* aptr(const ge::Unit& u) const { return Hb + (size_t)u.pm * 256 * EH * 2; }
    __device__ __forceinline__ const char* bptr(const ge::Unit& u) const { return W + ((size_t)u.g * D + u.pn * 256) * EH * 2; } };
struct EpiM2 { bf16_t* Ys; const int* lists; LAS int* te;
    __device__ __forceinline__ void operator()(ge::Acc& acc, const ge::Unit& u, int wr, int wc, int fr, int fq) const {
        const int r0 = te[256 + u.pm], n = te[512 + u.g];
        int av[2][4];
#pragma unroll
        for (int ai = 0; ai < 2; ++ai)
#pragma unroll
            for (int m = 0; m < 4; ++m) { const int row = r0 + ai * 128 + wr * 64 + m * 16 + fr; av[ai][m] = row < n ? lists[u.g * LCAP + row] : -1; }
#pragma unroll
        for (int ai = 0; ai < 2; ++ai)
#pragma unroll
            for (int m = 0; m < 4; ++m) { const int a = av[ai][m];
                if (a >= 0) {
#pragma unroll
                    for (int bj = 0; bj < 2; ++bj) { const f32x4 v0 = acc[ai][bj][m][0], v1 = acc[ai][bj][m][1];
                        u32x4 o = {cvt_pk_bf16(v0[0], v0[1]), cvt_pk_bf16(v0[2], v0[3]), cvt_pk_bf16(v1[0], v1[1]), cvt_pk_bf16(v1[2], v1[3])};
                        *(u32x4*)(Ys + (size_t)a * D + u.pn * 256 + bj * 128 + wc * 32 + 8 * fq) = o; } } }
    } };

#define XB_TMO      128
#define XB_XCNT(j)  (256  + 64 * (j))
#define XB_XSUB(j)  (1280 + 64 * (j))
#define XB_XGEN(j)  (2304 + 64 * (j))
#define XB_TOP      3328
#define XB_TOPGEN   3392
#define XCD_BAR_WORDS 3456
#define XB_SPIN_CAP (1u << 18)

__device__ __forceinline__ unsigned xb_ld(unsigned* p)              { return __hip_atomic_load(p, __ATOMIC_RELAXED, __HIP_MEMORY_SCOPE_AGENT); }
__device__ __forceinline__ unsigned xb_add(unsigned* p, unsigned v) { return __hip_atomic_fetch_add(p, v, __ATOMIC_RELAXED, __HIP_MEMORY_SCOPE_AGENT); }
__device__ __forceinline__ unsigned xb_xcc_id() { return (unsigned)__builtin_amdgcn_s_getreg((3 << 11) | 20) & 0xFu; }
#define XB_SPIN(cond, bar) do { unsigned _sp = 0; while (cond) { __builtin_amdgcn_s_sleep(1); \
    if ((++_sp & 255u) == 0u) { if (xb_ld(&(bar)[XB_TMO])) break; if (_sp > XB_SPIN_CAP) { atomicAdd(&(bar)[XB_TMO], 1u); break; } } } } while (0)

struct XcdBarrier {
    unsigned* bar; unsigned x;
    volatile LAS unsigned* st;
};

__device__ __forceinline__ XcdBarrier xcd_barrier_post(unsigned* bar, volatile LAS unsigned* st) {
    XcdBarrier b; b.bar = bar; b.x = xb_xcc_id(); b.st = st;
    if (threadIdx.x == 0) (void)xb_add(&bar[XB_XCNT(b.x)], 1u);
    return b;
}
__device__ __forceinline__ void xcd_barrier_complete(unsigned* bar, unsigned x, unsigned& nloc, unsigned& nx) {
    const unsigned G = gridDim.x * gridDim.y * gridDim.z;
    unsigned sum, cnt, mine, sp = 0u;
    for (;;) {
        sum = 0u; cnt = 0u; mine = 0u;
#pragma unroll
        for (unsigned j = 0; j < 16; ++j) { const unsigned c = xb_ld(&bar[XB_XCNT(j)]); sum += c; cnt += (c > 0u) ? 1u : 0u; mine = (j == x) ? c : mine; }
        if (sum == G) break;
        __builtin_amdgcn_s_sleep(1);
        if ((++sp & 255u) == 0u) { if (xb_ld(&bar[XB_TMO])) break; if (sp > XB_SPIN_CAP) { atomicAdd(&bar[XB_TMO], 1u); break; } }
    }
    nloc = mine > 0u ? mine : 1u; nx = cnt > 0u ? cnt : 1u;
}

__device__ __forceinline__ void xcd_barrier(const XcdBarrier& b) {
    asm volatile("s_waitcnt vmcnt(0)" ::: "memory");
    __syncthreads();
    if (threadIdx.x == 0) {
        unsigned* bar = b.bar;
        __builtin_amdgcn_s_waitcnt(0);
        unsigned nloc = b.st[0], nx = b.st[1];
        if (nloc == 0u) { xcd_barrier_complete(bar, b.x, nloc, nx); b.st[0] = nloc; b.st[1] = nx; }
        const unsigned old = xb_add(&bar[XB_XSUB(b.x)], 1u);
        const unsigned gen = old / nloc;
        if (old + 1u == (gen + 1u) * nloc) {
            __builtin_amdgcn_fence(__ATOMIC_RELEASE, "agent");
            asm volatile("s_waitcnt vmcnt(0)" ::: "memory");
            const unsigned og = xb_add(&bar[XB_TOP], 1u);
            const unsigned tg = og / nx;
            if (og + 1u == (tg + 1u) * nx) xb_add(&bar[XB_TOPGEN], 1u);
            else XB_SPIN(xb_ld(&bar[XB_TOPGEN]) == tg, bar);
            __builtin_amdgcn_fence(__ATOMIC_ACQUIRE, "agent");
            xb_add(&bar[XB_XGEN(b.x)], 1u);
            asm volatile("s_waitcnt vmcnt(0)" ::: "memory");
        } else {
            XB_SPIN(xb_ld(&bar[XB_XGEN(b.x)]) == gen, bar);
            __builtin_amdgcn_fence(__ATOMIC_ACQUIRE, "agent");
            asm volatile("s_waitcnt vmcnt(0)" ::: "memory");
        }
    }
    __syncthreads();
}

enum { PH_PRO = 0, PH_CONV, PH_IN, PH_PREP_Q, PH_PREP_K, PH_PREP_V, PH_PREP_G, PH_ATT, PH_FIN, PH_BR, PH_WO, PH_LN1, PH_M1, PH_M2, PH_LN2, PH_PLE, PH_LN3 };
template <int PH> __global__ __launch_bounds__(NTHR, 2) void k_ph(P p, int layer) {
    extern __shared__ __attribute__((aligned(16))) unsigned char smem[];
    LAS unsigned char* lds = (LAS unsigned char*)smem;
    tid_setup();
    const int c = blockIdx.x, G = gridDim.x;
    if constexpr (PH == PH_PRO) ph_prologue(p);
    if constexpr (PH == PH_CONV) ph_convert(lds, p, layer);
    if constexpr (PH == PH_IN) { const MegaP m = mk_mega(p); SchedIn S{{}, (const char*)m.Xb, (const char*)m.Wb_in, (const char*)m.Wb_gv, c, G, 0}; EpiIn<2> E{m.Hp, m.GVt, m.ssq_q, m.ssq_kv}; ge::gemm_stream<EpiIn<2>, SchedIn, false>(lds, D, D, D, S, E); }
    if constexpr (PH == PH_PREP_Q) { const MlaP q = mk_mla(p); SchedMla<0> S{{}, (const char*)(q.Hp + H_CQ), (const char*)q.Wb_uq, c, G}; EpiMla<0> E{q}; ge::gemm_stream<EpiMla<0>, SchedMla<0>, false>(lds, 256, HW, 256, S, E); }
    if constexpr (PH == PH_PREP_K) { const MlaP q = mk_mla(p); SchedMla<1> S{{}, (const char*)(q.Hp + H_CKV), (const char*)q.Wb_uk, (c + 64) % G, G}; EpiMla<1> E{q}; ge::gemm_stream<EpiMla<1>, SchedMla<1>, false>(lds, 256, HW, 256, S, E); }
    if constexpr (PH == PH_PREP_V) { const MlaP q = mk_mla(p); SchedMla<2> S{{}, (const char*)q.Wb_uv, (const char*)(q.Hp + H_CKV), (c + 192) % G, G}; EpiMla<2> E{q}; ge::gemm_stream<EpiMla<2>, SchedMla<2>, false>(lds, 256, 256, HW, S, E); }
    if constexpr (PH == PH_PREP_G) { { const MegaP m = mk_mega(p); SchedIn S{{}, (const char*)m.Xb, (const char*)m.Wb_in, (const char*)m.Wb_gv, (c + 128) % G, G, 1}; EpiIn<0> E{m.Hp, m.GVt, m.ssq_q, m.ssq_kv}; ge::gemm_stream<EpiIn<0>, SchedIn, false>(lds, D, D, D, S, E); } const MlaP q = mk_mla(p); kr_phase(q, c * NTHR + tid_now(), G * NTHR); const GlaP g = mk_gla(p, layer); gla_g1(lds, g, c, G); }
    if constexpr (PH == PH_ATT) { const GlaP g = mk_gla(p, layer); gla_g2(lds, g, c); const MlaP q = mk_mla(p); attn_phase(lds, q, c); }
    if constexpr (PH == PH_FIN) { const GlaP g = mk_gla(p, layer); gla_g3(lds, g, c, G); conv_phase(g, c * NTHR + tid_now(), G * NTHR); attn_combine_bf16(g, c * NTHR + tid_now(), G * NTHR); }
    if constexpr (PH == PH_BR) { SchedBr S{(const char*)p.Yab, (const char*)p.Ybb, (const char*)p.Ycb, (const char*)p.Wb_br, c, G}; EpiBr E{p.Hp, p.Mgb}; ge::gemm_stream<EpiBr, SchedBr, false>(lds, 512, 512, 512, S, E); }
    if constexpr (PH == PH_WO) { SchedT4 S{{}, (const char*)p.Mgb, (const char*)p.Wb_o, 256 * D * 2, 256 * D * 2, c, G}; EpiRes E{p.Db}; ge::gemm_stream<EpiRes, SchedT4, false>(lds, D, D, D, S, E); }
    if constexpr (PH == PH_LN1) ph_ln1_router(p, layer);
    if constexpr (PH == PH_M1) { moe_table(lds, p.cnt + layer * 64); LAS int* te = (LAS int*)(lds + 131072);
        SchedM1 S{{}, (const char*)p.Xb, (const char*)p.Wb_gu, p.lists, te, c, G}; EpiM1 E{p.Hbuf}; ge::gemm_stream<EpiM1, SchedM1, true>(lds, D, D, D, S, E); }
    if constexpr (PH == PH_M2) { moe_table(lds, p.cnt + layer * 64); LAS int* te = (LAS int*)(lds + 131072);
        SchedM2 S{{}, (const char*)p.Hbuf, (const char*)p.Wb_d, te, c, G}; EpiM2 E{p.Ys, p.lists, te}; ge::gemm_stream<EpiM2, SchedM2, false>(lds, EH, EH, EH, S, E); }
    if constexpr (PH == PH_LN2) ph_rows<2>(p, layer);
    if constexpr (PH == PH_PLE) {
        { SchedT4 S{{}, (const char*)(p.Pb + (size_t)layer * T * PLE), (const char*)p.Wb_pu, 256 * PLE * 2, 256 * PLE * 2, c, G}; EpiU E{p.Ub}; ge::gemm_stream<EpiU, SchedT4, false>(lds, PLE, PLE, PLE, S, E); }
        { SchedT4 S{{}, (const char*)p.Xb, (const char*)p.Wb_pg, 256 * D * 2, 256 * D * 2, c, G}; EpiPle E{p.Db, p.Ub, p.b_pg + layer * D}; ge::gemm_stream<EpiPle, SchedT4, false>(lds, D, D, D, S, E); } }
    if constexpr (PH == PH_LN3) ph_rows<3>(p, layer);
}


typedef const P __attribute__((address_space(4))) CP;
__device__ __forceinline__ P load_params() { CP* q = (CP*)__builtin_amdgcn_kernarg_segment_ptr(); asm volatile("" : "+s"(q)); return *(const P*)q; }
#define GRID_BAR() do { XcdBarrier b_; b_.bar = load_params().bar; b_.x = xb_xcc_id(); b_.st = xbw; xcd_barrier(b_); } while (0)
__global__ __launch_bounds__(NTHR, 2) void k_mega(P p_arg) {
    extern __shared__ __attribute__((aligned(16))) unsigned char smem[];
    LAS unsigned char* lds = (LAS unsigned char*)smem;
    const int G = NBLK;
#define c sgpr_now((int)blockIdx.x)
    volatile LAS unsigned* xbw = (volatile LAS unsigned*)(lds + XBW_OFF);
    tid_setup();
    if (tid_now() < 4) xbw[tid_now()] = 0u;
    __syncthreads();
    (void)xcd_barrier_post(p_arg.bar, xbw);
    { const P p = load_params(); ph_prologue(p); }
    { const P p = load_params(); ph_convert(lds, p, 0); }
    GRID_BAR();
    for (int layer = 0; layer < DEPTH; ++layer) {
        { const P p = load_params(); const MegaP m = mk_mega(p); SchedIn S{{}, (const char*)m.Xb, (const char*)m.Wb_in, (const char*)m.Wb_gv, c, G, 0}; EpiIn<2> E{m.Hp, m.GVt, m.ssq_q, m.ssq_kv}; ge::gemm_stream<EpiIn<2>, SchedIn, false>(lds, D, D, D, S, E); }
        GRID_BAR();
        { const P p = load_params(); const MlaP q = mk_mla(p);
          { SchedMla<0> S{{}, (const char*)(q.Hp + H_CQ), (const char*)q.Wb_uq, (c >= 128 ? c - 128 : -1), 128}; EpiMla<0> E{q}; ge::gemm_stream<EpiMla<0>, SchedMla<0>, false>(lds, 256, HW, 256, S, E); }
          { SchedMla<1> S{{}, (const char*)(q.Hp + H_CKV), (const char*)q.Wb_uk, (c >= 128 ? c - 128 : -1), 128}; EpiMla<1> E{q}; ge::gemm_stream<EpiMla<1>, SchedMla<1>, false>(lds, 256, HW, 256, S, E); }
          { SchedMla<2> S{{}, (const char*)q.Wb_uv, (const char*)(q.Hp + H_CKV), (c >= 128 ? c - 128 : -1), 128}; EpiMla<2> E{q}; ge::gemm_stream<EpiMla<2>, SchedMla<2>, false>(lds, 256, 256, HW, S, E); }
          { const MegaP m = mk_mega(p); SchedIn S{{}, (const char*)m.Xb, (const char*)m.Wb_in, (const char*)m.Wb_gv, c, G, 1}; EpiIn<0> E{m.Hp, m.GVt, m.ssq_q, m.ssq_kv}; ge::gemm_stream<EpiIn<0>, SchedIn, false>(lds, D, D, D, S, E); }
          kr_phase(q, c * NTHR + tid_now(), G * NTHR);
          const GlaP g = mk_gla(p, layer); gla_g1(lds, g, c, G); }
        GRID_BAR();
        { const P p = load_params(); const GlaP g = mk_gla(p, layer); gla_g2(lds, g, c); const MlaP q = mk_mla(p); attn_phase(lds, q, c); }
        GRID_BAR();
        { const P p = load_params(); const GlaP g = mk_gla(p, layer); gla_g3(lds, g, c, G); conv_phase(g, c * NTHR + tid_now(), G * NTHR); attn_combine_bf16(g, c * NTHR + tid_now(), G * NTHR); }
        GRID_BAR();
        { const P p = load_params(); SchedBr S{(const char*)p.Yab, (const char*)p.Ybb, (const char*)p.Ycb, (const char*)p.Wb_br, c, G}; EpiBr E{p.Hp, p.Mgb}; ge::gemm_stream<EpiBr, SchedBr, false>(lds, 512, 512, 512, S, E); }
        GRID_BAR();
        { const P p = load_params(); SchedT4 S{{}, (const char*)p.Mgb, (const char*)p.Wb_o, 256 * D * 2, 256 * D * 2, c, G}; EpiRes E{p.Db}; ge::gemm_stream<EpiRes, SchedT4, false>(lds, D, D, D, S, E); }
        GRID_BAR();
        { const P p = load_params(); ph_ln1_router(p, layer); }
        GRID_BAR();
        { const P p = load_params(); moe_table(lds, p.cnt + layer * 64); LAS int* te = (LAS int*)(lds + 131072);
          SchedM1 S{{}, (const char*)p.Xb, (const char*)p.Wb_gu, p.lists, te, c, G}; EpiM1 E{p.Hbuf}; ge::gemm_stream<EpiM1, SchedM1, true>(lds, D, D, D, S, E);
          const int extra = max(0, 2 * te[576] - NBLK), cu = c - extra;
          SchedT4 SU{{}, (const char*)(p.Pb + (size_t)layer * T * PLE), (const char*)p.Wb_pu, 256 * PLE * 2, 256 * PLE * 2, cu >= 0 ? cu : 256, NBLK - extra}; EpiU EU{p.Ub};
          ge::gemm_stream<EpiU, SchedT4, false>(lds, PLE, PLE, PLE, SU, EU); }
        GRID_BAR();
        { const P p = load_params(); LAS int* te = (LAS int*)(lds + 131072);
          SchedM2 S{{}, (const char*)p.Hbuf, (const char*)p.Wb_d, te, c, G}; EpiM2 E{p.Ys, p.lists, te}; ge::gemm_stream<EpiM2, SchedM2, false>(lds, EH, EH, EH, S, E); }
        GRID_BAR();
        { const P p = load_params(); ph_rows<2>(p, layer); }
        GRID_BAR();
        { const P p = load_params(); SchedT4 S{{}, (const char*)p.Xb, (const char*)p.Wb_pg, 256 * D * 2, 256 * D * 2, c, G}; EpiPle E{p.Db, p.Ub, p.b_pg + layer * D}; ge::gemm_stream<EpiPle, SchedT4, false>(lds, D, D, D, S, E); }
        GRID_BAR();
        { const P p = load_params(); ph_rows<3>(p, layer); }
        if (layer + 1 < DEPTH) { { const P p = load_params(); ph_convert(lds, p, layer + 1); } GRID_BAR(); }
    }
#undef c
}

template <int PH> static void launch_ph(const P& p, int layer, hipStream_t st) {
    static bool set = false;
    if (!set) { (void)hipFuncSetAttribute((const void*)k_ph<PH>, hipFuncAttributeMaxDynamicSharedMemorySize, LDS_BYTES); set = true; }
    hipLaunchKernelGGL((k_ph<PH>), dim3(NBLK), dim3(NTHR), LDS_BYTES, st, p, layer);
}
extern "C" void kernel_launch(void* const* d_in, const int* in_sizes, int n_in, void* d_out, int out_size, void* d_ws, size_t ws_size, hipStream_t st) {
    (void)in_sizes; (void)n_in; (void)out_size;
    P p{};
    p.x = (const float*)d_in[0]; p.pin = (const float*)d_in[1]; p.pos = (const int*)d_in[2]; p.ln0_g = (const float*)d_in[3]; p.ln0_b = (const float*)d_in[4];
    p.w_in = (const float*)d_in[5]; p.w_conv = (const float*)d_in[6]; p.w_gg = (const float*)d_in[7]; p.b_gg = (const float*)d_in[8]; p.gla_ng = (const float*)d_in[9];
    p.qn_g = (const float*)d_in[10]; p.kvn_g = (const float*)d_in[11]; p.w_uq = (const float*)d_in[12]; p.w_ukv = (const float*)d_in[13]; p.w_br = (const float*)d_in[14]; p.w_o = (const float*)d_in[15];
    p.ln1_g = (const float*)d_in[16]; p.ln1_b = (const float*)d_in[17]; p.w_grp = (const float*)d_in[18]; p.b_grp = (const float*)d_in[19]; p.w_exp = (const float*)d_in[20]; p.b_exp = (const float*)d_in[21];
    p.w_gate = (const float*)d_in[22]; p.w_up = (const float*)d_in[23]; p.w_down = (const float*)d_in[24]; p.ln2_g = (const float*)d_in[25]; p.ln2_b = (const float*)d_in[26];
    p.w_pg = (const float*)d_in[27]; p.b_pg = (const float*)d_in[28]; p.w_pu = (const float*)d_in[29]; p.ln3_g = (const float*)d_in[30]; p.ln3_b = (const float*)d_in[31];
    p.out = (float*)d_out;
    char* w = (char*)d_ws; size_t off = 0;
    auto alloc = [&](size_t bytes) { void* r = w + off; off += (bytes + 255) & ~(size_t)255; return r; };
    p.bar = (unsigned*)alloc(16384); p.cnt = (int*)alloc(DEPTH * 64 * 4);
    const size_t zero_bytes = off;
    p.X = (float*)alloc((size_t)T * D * 4); p.Z = (float*)alloc((size_t)T * D * 4); p.Xb = (bf16_t*)alloc((size_t)T * D * 2); p.Db = (bf16_t*)alloc((size_t)T * D * 2);
    p.cs = (float*)alloc((size_t)T * 32 * 4); p.sn = (float*)alloc((size_t)T * 32 * 4); p.ssq_q = (float*)alloc((size_t)4 * T * 4); p.ssq_kv = (float*)alloc((size_t)4 * T * 4);
    p.Hp = (bf16_t*)alloc((size_t)T * HW * 2); p.GVt = (bf16_t*)alloc((size_t)T * 512 * 2);
    p.Qb = (bf16_t*)alloc((size_t)T * 768 * 2); p.KnImg = (bf16_t*)alloc((size_t)T * 512 * 2); p.VtImg = (bf16_t*)alloc((size_t)T * 512 * 2); p.KrImg = (bf16_t*)alloc((size_t)T * 64 * 2);
    p.MLpart = (float*)alloc((size_t)512 * 256 * 2 * 4);
    p.QE = (bf16_t*)alloc((size_t)T * 256 * 2); p.OI = (float*)alloc((size_t)T * 512 * 4); p.kvT = (float*)alloc((size_t)1024 * 8192 * 4); p.decay = (float*)alloc((size_t)1024 * 64 * 4); p.spT = (bf16_t*)alloc((size_t)1024 * 8192 * 2);
    p.Yab = (bf16_t*)alloc((size_t)T * 512 * 2); p.Ybb = (bf16_t*)alloc((size_t)T * 512 * 2); p.Ycb = (bf16_t*)alloc((size_t)T * 512 * 2); p.Mgb = (bf16_t*)alloc((size_t)T * D * 2);
    p.ew = (float*)alloc((size_t)T * 2 * 4); p.lists = (int*)alloc((size_t)NE * LCAP * 4);
    p.Hbuf = (bf16_t*)alloc((size_t)192 * 256 * EH * 2); p.Ys = (bf16_t*)alloc((size_t)2 * T * D * 2); p.Ub = (bf16_t*)alloc((size_t)T * D * 2); p.Pb = (bf16_t*)alloc((size_t)DEPTH * T * PLE * 2);
    p.Wb_in = (bf16_t*)alloc((size_t)HW * D * 2); p.Wb_gv = (bf16_t*)alloc((size_t)512 * D * 2); p.Wb_uq = (bf16_t*)alloc((size_t)768 * 256 * 2); p.Wb_uk = (bf16_t*)alloc((size_t)512 * 256 * 2); p.Wb_uv = (bf16_t*)alloc((size_t)512 * 256 * 2);
    p.Wb_br = (bf16_t*)alloc((size_t)3 * D * 512 * 2); p.Wb_o = (bf16_t*)alloc((size_t)D * D * 2); p.Wb_gu = (bf16_t*)alloc((size_t)NE * 512 * D * 2); p.Wb_d = (bf16_t*)alloc((size_t)NE * D * EH * 2);
    p.Wb_pg = (bf16_t*)alloc((size_t)D * D * 2); p.Wb_pu = (bf16_t*)alloc((size_t)D * PLE * 2);
    if (off > ws_size) return;
    (void)hipMemsetAsync(d_ws, 0, zero_bytes, st);
#if defined(MULTI_LAUNCH)
    launch_ph<PH_PRO>(p, 0, st);
    for (int i = 0; i < DEPTH; ++i) {
        launch_ph<PH_CONV>(p, i, st); launch_ph<PH_IN>(p, i, st);
        launch_ph<PH_PREP_Q>(p, i, st); launch_ph<PH_PREP_K>(p, i, st); launch_ph<PH_PREP_V>(p, i, st); launch_ph<PH_PREP_G>(p, i, st);
        launch_ph<PH_ATT>(p, i, st); launch_ph<PH_FIN>(p, i, st); launch_ph<PH_BR>(p, i, st); launch_ph<PH_WO>(p, i, st); launch_ph<PH_LN1>(p, i, st);
        launch_ph<PH_M1>(p, i, st); launch_ph<PH_M2>(p, i, st); launch_ph<PH_LN2>(p, i, st); launch_ph<PH_PLE>(p, i, st); launch_ph<PH_LN3>(p, i, st);
    }
#else
    static bool set = false;
    if (!set) { (void)hipFuncSetAttribute((const void*)k_mega, hipFuncAttributeMaxDynamicSharedMemorySize, LDS_BYTES); set = true; }
    hipLaunchKernelGGL(k_mega, dim3(NBLK), dim3(NTHR), LDS_BYTES, st, p);
#endif
}
```

```cpp
#include <hip/hip_runtime.h>
#include <hip/hip_bf16.h>
#include <stdint.h>

constexpr int T = 16384, D = 1024, DEPTH = 4, PLE = 256;
constexpr int NE = 64, EH = 256;
constexpr int INW = 6608;
constexpr int O_GV = 2048;
constexpr float DN_ALPHA = 1.681792830507429f;
constexpr int LCAP = 32768;
#define LAS __attribute__((address_space(3)))
typedef unsigned short bf16_t;
typedef short bf16x8 __attribute__((ext_vector_type(8)));
typedef float f32x4 __attribute__((ext_vector_type(4)));
typedef float f32x16 __attribute__((ext_vector_type(16)));
typedef unsigned u32x4 __attribute__((ext_vector_type(4)));
typedef unsigned u32x2 __attribute__((ext_vector_type(2)));
typedef float f32x2 __attribute__((ext_vector_type(2)));
constexpr int NBLK = 256, NTHR = 512;
constexpr int STAGE_BYTES = 131072, LDS_BYTES = 147456 + 512, XBW_OFF = 147456 + 256;
constexpr int HW = 6144;
constexpr int H_AB = 0, H_AC = 512, H_AX = 1024, H_GQ = 1536, H_GK = 1792, H_GR = 2048, H_CQ = 2560, H_CKV = 2816, H_KR = 2944, H_GLR = 3008, H_GTA = 3072, H_GTB = 4096, H_GTC = 5120;

__device__ __forceinline__ unsigned cvt_pk_bf16(float lo, float hi) { unsigned r; asm volatile("v_cvt_pk_bf16_f32 %0, %1, %2" : "=v"(r) : "v"(lo), "v"(hi)); return r; }
constexpr int WTAB_OFF = 147456;
__device__ __forceinline__ int tid_now() {
    const unsigned hw = (unsigned)__builtin_amdgcn_s_getreg((5 << 11) | 4) & 63u;
    extern __shared__ __attribute__((aligned(16))) unsigned char smem_tid[];
    const int w = __builtin_amdgcn_readfirstlane(*(volatile LAS int*)((LAS unsigned char*)smem_tid + WTAB_OFF + 4 * hw));
    int l = (int)__builtin_amdgcn_mbcnt_hi(~0u, __builtin_amdgcn_mbcnt_lo(~0u, 0u));
    asm volatile("" : "+v"(l));
    return w * 64 + l; }
__device__ __forceinline__ void tid_setup() {
    const unsigned hw = (unsigned)__builtin_amdgcn_s_getreg((5 << 11) | 4) & 63u;
    extern __shared__ __attribute__((aligned(16))) unsigned char smem_tid[];
    if ((threadIdx.x & 63) == 0) *(volatile LAS int*)((LAS unsigned char*)smem_tid + WTAB_OFF + 4 * hw) = (int)(threadIdx.x >> 6);
    __syncthreads(); }
__device__ __forceinline__ int sgpr_now(int v) { asm volatile("" : "+s"(v)); return v; }
__device__ __forceinline__ float shx(float v, int mask, int lane) { return __int_as_float(__builtin_amdgcn_ds_bpermute((lane ^ mask) << 2, __float_as_int(v))); }
__device__ __forceinline__ float frcp(float x) { return __builtin_amdgcn_rcpf(x); }
__device__ __forceinline__ float bf2f(bf16_t b) { return __uint_as_float(((unsigned)b) << 16); }
__device__ __forceinline__ float bflo(unsigned w) { return __uint_as_float(w << 16); }
__device__ __forceinline__ float bfhi(unsigned w) { return __uint_as_float(w & 0xffff0000u); }

namespace ge {
constexpr int BM = 256, BK = 64, HALF = 128, HTB = HALF * BK * 2;
__device__ __forceinline__ int lds_byte(int r, int c) { const int st = (r >> 4) * 2 + (c >> 5), rr = r & 15, cc = c & 31, ob = rr * 64 + cc * 2; return st * 1024 + (ob ^ (((ob >> 9) & 1) << 5)); }
__device__ __forceinline__ void stage_rc(int b, int& R, int& C) { const int st = b / 1024, sb = b % 1024, swz = sb ^ (((sb >> 9) & 1) << 5); R = (st >> 1) * 16 + swz / 64; C = (st & 1) * 32 + (swz % 64) / 2; }
__device__ __forceinline__ int perm32(int rho) { const int n = rho >> 4, i = rho & 15; return 8 * (i >> 2) + 4 * n + (i & 3); }
struct Unit { int pm, pn, g; };
typedef f32x4 Acc[2][2][4][2];
struct NoCarry { __device__ __forceinline__ bool carry(const struct Unit&) const { return false; } };

template <class Epi, class Sched, bool GATHER>
__device__ __forceinline__ void gemm_stream(LAS unsigned char* lds, const int K, const int lda, const int ldb, const Sched& S, const Epi& E) {
    const int tid = tid_now(), wid = __builtin_amdgcn_readfirstlane(tid >> 6), lane = tid & 63, wr = wid >> 2, wc = wid & 3, fr = lane & 15, fq = lane >> 4;
    const int nt = K / BK;
    Unit cur, nxt; int ui = 0;
    if (!S.next(0, cur)) return;
    unsigned voffA[2][2], nvoffA[2][2], voffB[2][2];
#pragma unroll
    for (int i = 0; i < 2; ++i) { int R, C; stage_rc(tid * 16 + i * 8192, R, C); const int Rb = (R & ~31) + perm32(R & 31);
        voffB[0][i] = (unsigned)(Rb * ldb + C) * 2u; voffB[1][i] = (unsigned)((Rb + 128) * ldb + C) * 2u;
        if constexpr (GATHER) { voffA[0][i] = (unsigned)(S.arow(cur, R) * lda + C) * 2u; voffA[1][i] = (unsigned)(S.arow(cur, R + 128) * lda + C) * 2u; }
        else { voffA[0][i] = (unsigned)(R * lda + C) * 2u; voffA[1][i] = (unsigned)((R + 128) * lda + C) * 2u; }
        nvoffA[0][i] = voffA[0][i]; nvoffA[1][i] = voffA[1][i]; }
    const size_t kstep = (size_t)(BK * 2);
    const unsigned ldsw = (unsigned)wid * 1024u;
    const int aoff = lds_byte(wr * 64 + fr, fq * 8), boff = lds_byte(wc * 32 + fr, fq * 8);
#define GE_SA(b, h) (((b) * 2 + (h)) * HTB)
#define GE_SB(b, h) ((4 + (b) * 2 + (h)) * HTB)
#define GE_STAGE(bufoff, gbase, voff) do { _Pragma("unroll") for (int _i = 0; _i < 2; ++_i) \
        __builtin_amdgcn_global_load_lds((const unsigned*)((const char*)(gbase) + (voff)[_i]), (LAS unsigned*)(lds + (bufoff) + ldsw + _i * 8192), 16, 0, 0); } while (0)
#define GE_LDA(dst, b, h) do { _Pragma("unroll") for (int m = 0; m < 4; ++m) _Pragma("unroll") for (int k = 0; k < 2; ++k) dst[m][k] = *(const LAS bf16x8*)(lds + GE_SA(b, h) + aoff + m * 2048 + k * 1024); } while (0)
#define GE_LDB(dst, b, h) do { _Pragma("unroll") for (int n = 0; n < 2; ++n) _Pragma("unroll") for (int k = 0; k < 2; ++k) dst[n][k] = *(const LAS bf16x8*)(lds + GE_SB(b, h) + boff + n * 2048 + k * 1024); } while (0)
#define GE_MMA(ai, bj, At, Bt) do { __builtin_amdgcn_s_setprio(1); _Pragma("unroll") for (int m = 0; m < 4; ++m) _Pragma("unroll") for (int n = 0; n < 2; ++n) _Pragma("unroll") for (int k = 0; k < 2; ++k) \
        acc[ai][bj][m][n] = __builtin_amdgcn_mfma_f32_16x16x32_bf16(Bt[n][k], At[m][k], acc[ai][bj][m][n], 0, 0, 0); __builtin_amdgcn_s_setprio(0); } while (0)
#define GE_WAIT_V(n) asm volatile("s_waitcnt vmcnt(" #n ")" ::: "memory")
#define GE_WAIT_L(n) asm volatile("s_waitcnt lgkmcnt(" #n ")" ::: "memory")
#define GE_BAR __builtin_amdgcn_s_barrier()
#define GE_SCHED __builtin_amdgcn_sched_barrier(0)
    Acc acc;
#pragma unroll
    for (int a = 0; a < 2; ++a)
#pragma unroll
        for (int b = 0; b < 2; ++b)
#pragma unroll
            for (int m = 0; m < 4; ++m)
#pragma unroll
                for (int n = 0; n < 2; ++n) acc[a][b][m][n] = (f32x4){0.f, 0.f, 0.f, 0.f};
    bf16x8 At[4][2], B0[2][2], B1[2][2];
    const char* cA = S.aptr(cur); const char* cB = S.bptr(cur);
    GE_STAGE(GE_SB(0, 0), cB, voffB[0]); GE_STAGE(GE_SA(0, 0), cA, voffA[0]); GE_STAGE(GE_SB(0, 1), cB, voffB[1]); GE_STAGE(GE_SA(0, 1), cA, voffA[1]);
    if (wr == 1) GE_BAR;
    GE_WAIT_V(4); GE_BAR;
    GE_STAGE(GE_SB(1, 0), cB + kstep, voffB[0]); GE_STAGE(GE_SA(1, 0), cA + kstep, voffA[0]); GE_STAGE(GE_SB(1, 1), cB + kstep, voffB[1]);
    GE_WAIT_V(6); GE_BAR;
    for (;;) {
        const bool has_next = S.next(ui + 1, nxt);
        const char* nA = has_next ? S.aptr(nxt) : cA; const char* nB = has_next ? S.bptr(nxt) : cB;
#pragma unroll 1
        for (int t = 0; t < nt; t += 2) {
            const bool last = (t == nt - 2);
            const char* a1 = cA + (size_t)(t + 1) * kstep;
            const char* a2 = last ? nA : cA + (size_t)(t + 2) * kstep; const char* b2 = last ? nB : cB + (size_t)(t + 2) * kstep;
            const char* a3 = a2 + kstep; const char* b3 = b2 + kstep;
            if constexpr (GATHER) { if (last && has_next) {
#pragma unroll
                for (int i = 0; i < 2; ++i) { int R, C; stage_rc(tid * 16 + i * 8192, R, C);
                    nvoffA[0][i] = (unsigned)(S.arow(nxt, R) * lda + C) * 2u; nvoffA[1][i] = (unsigned)(S.arow(nxt, R + 128) * lda + C) * 2u; } } }
            unsigned va2[2][2];
#pragma unroll
            for (int h = 0; h < 2; ++h)
#pragma unroll
                for (int i = 0; i < 2; ++i) va2[h][i] = (GATHER && last) ? nvoffA[h][i] : voffA[h][i];
            GE_LDB(B0, 0, 0); GE_SCHED; GE_LDA(At, 0, 0); GE_STAGE(GE_SA(1, 1), a1, voffA[1]);
            GE_WAIT_L(8); GE_BAR; GE_WAIT_L(0); GE_MMA(0, 0, At, B0); GE_BAR; GE_SCHED;
            GE_LDB(B1, 0, 1); GE_STAGE(GE_SB(0, 0), b2, voffB[0]);
            GE_BAR; GE_WAIT_L(0); GE_MMA(0, 1, At, B1); GE_BAR;
            GE_LDA(At, 0, 1); GE_STAGE(GE_SA(0, 0), a2, va2[0]);
            GE_BAR; GE_WAIT_L(0); GE_MMA(1, 0, At, B0); GE_BAR; GE_SCHED;
            GE_STAGE(GE_SB(0, 1), b2, voffB[1]);
            GE_WAIT_V(6); GE_BAR; GE_MMA(1, 1, At, B1); GE_BAR;
            GE_LDB(B0, 1, 0); GE_SCHED; GE_LDA(At, 1, 0); GE_STAGE(GE_SA(0, 1), a2, va2[1]);
            GE_WAIT_L(8); GE_BAR; GE_WAIT_L(0); GE_MMA(0, 0, At, B0); GE_BAR; GE_SCHED;
            GE_LDB(B1, 1, 1); GE_STAGE(GE_SB(1, 0), b3, voffB[0]);
            GE_BAR; GE_WAIT_L(0); GE_MMA(0, 1, At, B1); GE_BAR;
            GE_LDA(At, 1, 1); GE_STAGE(GE_SA(1, 0), a3, va2[0]);
            GE_BAR; GE_WAIT_L(0); GE_MMA(1, 0, At, B0); GE_BAR; GE_SCHED;
            GE_STAGE(GE_SB(1, 1), b3, voffB[1]);
            GE_WAIT_V(6); GE_BAR; GE_MMA(1, 1, At, B1); GE_BAR;
        }
        { int tz = tid; asm volatile("" : "+v"(tz));
          const int wid2 = tz >> 6, lane2 = tz & 63; E(acc, cur, wid2 >> 2, wid2 & 3, lane2 & 15, lane2 >> 4); }
        if (!has_next) break;
        if (!S.carry(cur)) {
#pragma unroll
        for (int a = 0; a < 2; ++a)
#pragma unroll
            for (int b = 0; b < 2; ++b)
#pragma unroll
                for (int m = 0; m < 4; ++m)
#pragma unroll
                    for (int n = 0; n < 2; ++n) acc[a][b][m][n] = (f32x4){0.f, 0.f, 0.f, 0.f}; }
        cur = nxt; cA = nA; cB = nB; ++ui;
        if (GATHER) {
#pragma unroll
            for (int h = 0; h < 2; ++h)
#pragma unroll
                for (int i = 0; i < 2; ++i) voffA[h][i] = nvoffA[h][i]; }
    }
    GE_WAIT_V(0);
    if (wr == 0) GE_BAR;
    GE_BAR;
#undef GE_SA
#undef GE_SB
#undef GE_STAGE
#undef GE_LDA
#undef GE_LDB
#undef GE_MMA
#undef GE_WAIT_V
#undef GE_WAIT_L
#undef GE_BAR
#undef GE_SCHED
}
__device__ __forceinline__ void tile_order(int L, int nM, int nN, int& pm, int& pn) {
    const int nwg = nM * nN; int wgid = L;
    { const int q = nwg / 8, r = nwg % 8, xcd = wgid % 8, off = wgid / 8; wgid = (xcd < r ? xcd * (q + 1) : r * (q + 1) + (xcd - r) * q) + off; }
    const int nig = 8 * nN, gid = wgid / nig, fm = gid * 8, gsz = (nM - fm) < 8 ? (nM - fm) : 8;
    pm = fm + ((wgid % nig) % gsz); pn = (wgid % nig) / gsz;
}
}
struct MapInMain { __device__ __forceinline__ int operator()(int s) const {
    if (s < 2048) return s;
    if (s < 2560) return 2576 + (s - 2048);
    if (s < 2816) return 3088 + (s - 2560);
    if (s < 2944) return 3344 + (s - 2816);
    if (s < 3008) return 3472 + (s - 2944);
    if (s < 3024) return 2560 + (s - 3008);
    if (s < 3072) return -1;
    return 3536 + (s - 3072); } };
struct MapOff { int off; __device__ __forceinline__ int operator()(int s) const { return off + s; } };struct MegaP {
    const float* w_in; bf16_t* Wb_in; bf16_t* Wb_gv; const bf16_t* Xb; bf16_t* Hp; bf16_t* GVt; float* ssq_q; float* ssq_kv;
};
struct SchedIn : ge::NoCarry {
    const char* Xb; const char* Wm; const char* Wg; int c, G, gv;
    __device__ __forceinline__ bool next(int i, ge::Unit& u) const {
        const int L = i * G + c;
        if (gv) { if (L >= 128) return false; u.g = 0; u.pm = L >> 1; u.pn = 8 + (L & 1); return true; }
        if (L >= 1536) return false;
        if (L < 1408) { u.g = 0; ge::tile_order(L, 64, 22, u.pm, u.pn); if (u.pn >= 8) u.pn += 2; } else { u.g = 1; const int l = L - 1408; u.pm = l & 1; u.pn = l >> 1; }
        return true; }
    __device__ __forceinline__ const char* aptr(const ge::Unit& u) const { return u.g == 0 ? Xb + (size_t)u.pm * 256 * D * 2 : Wg + (size_t)u.pm * 256 * D * 2; }
    __device__ __forceinline__ const char* bptr(const ge::Unit& u) const { return u.g == 0 ? Wm + (size_t)u.pn * 256 * D * 2 : Xb + (size_t)u.pn * 256 * D * 2; }
};
template <int GV> struct EpiIn {
    bf16_t* Hp; bf16_t* GVt; float* ssq_q; float* ssq_kv;
    __device__ __forceinline__ void operator()(ge::Acc& acc, const ge::Unit& u, int wr, int wc, int fr, int fq) const {
        if (GV == 0 || (GV == 2 && u.g == 0)) {
            const int row0 = u.pm * 256 + wr * 64 + fr, col0 = u.pn * 256 + wc * 32 + 8 * fq;
            const bool sg = u.pn >= 12;
#pragma unroll
            for (int ai = 0; ai < 2; ++ai)
#pragma unroll
                for (int m = 0; m < 4; ++m) { const int row = row0 + ai * 128 + m * 16; bf16_t* rp = Hp + (size_t)row * HW + col0;
                    float sq0 = 0.f, sq1 = 0.f;
#pragma unroll
                    for (int bj = 0; bj < 2; ++bj) { f32x4 v0 = acc[ai][bj][m][0], v1 = acc[ai][bj][m][1];
                        if (sg) {
#pragma unroll
                            for (int j = 0; j < 4; ++j) { v0[j] = frcp(1.f + __expf(-v0[j])); v1[j] = frcp(1.f + __expf(-v1[j])); } }
                        const float s = v0[0] * v0[0] + v0[1] * v0[1] + v0[2] * v0[2] + v0[3] * v0[3] + v1[0] * v1[0] + v1[1] * v1[1] + v1[2] * v1[2] + v1[3] * v1[3];
                        if (bj == 0) sq0 = s; else sq1 = s;
                        u32x4 o = {cvt_pk_bf16(v0[0], v0[1]), cvt_pk_bf16(v0[2], v0[3]), cvt_pk_bf16(v1[0], v1[1]), cvt_pk_bf16(v1[2], v1[3])};
                        *(u32x4*)(rp + bj * 128) = o; }
                    if (u.pn == 10 || u.pn == 11) {
                        float s = (u.pn == 10) ? (sq0 + sq1) : sq0;
                        { const int ln = fq * 16 + fr; s += shx(s, 16, ln); s += shx(s, 32, ln); }
                        if (fq == 0) { float* dst = (u.pn == 10 ? ssq_q : ssq_kv); dst[(size_t)wc * T + row] = s; } } }
        } else {
#pragma unroll
            for (int ai = 0; ai < 2; ++ai)
#pragma unroll
                for (int m = 0; m < 4; ++m) { const int r = u.pm * 256 + ai * 128 + wr * 64 + m * 16 + fr, h = r >> 7, e = r & 127;
#pragma unroll
                    for (int bj = 0; bj < 2; ++bj) { const int t0 = u.pn * 256 + bj * 128 + wc * 32 + 8 * fq;
                        const int chunk = t0 >> 6, p0 = (t0 & 48) + ((t0 & 8) >> 1);
                        bf16_t* base = GVt + ((size_t)(chunk * 4 + h) * 128 + e) * 64;
                        const f32x4 v0 = acc[ai][bj][m][0], v1 = acc[ai][bj][m][1];
                        u32x2 o0 = {cvt_pk_bf16(v0[0], v0[1]), cvt_pk_bf16(v0[2], v0[3])}, o1 = {cvt_pk_bf16(v1[0], v1[1]), cvt_pk_bf16(v1[2], v1[3])};
                        *(u32x2*)(base + p0) = o0; *(u32x2*)(base + p0 + 8) = o1; } }
        }
    }
};
constexpr float QSCALE = 0.07216878364870322f * 1.4426950408889634f;
struct MapQ { __device__ __forceinline__ int operator()(int s) const {
    if (s < 512) return (s >> 7) * 192 + (s & 127);
    const int s2 = s - 512, bj = s2 >> 7, w = s2 & 127; return (w >> 5) * 192 + 128 + bj * 32 + (w & 31); } };
struct MapKV { int voff; __device__ __forceinline__ int operator()(int s) const { return (s >> 7) * 256 + voff + (s & 127); } };

struct MlaP {
    const float* w_uq; const float* w_ukv; const float* qn_g; const float* kvn_g;
    bf16_t* Wb_uq; bf16_t* Wb_uk; bf16_t* Wb_uv;
    const bf16_t* Hp; const float* ssq_q; const float* ssq_kv; const float* cs; const float* sn;
    bf16_t* Qb; bf16_t* KnImg; bf16_t* VtImg; bf16_t* KrImg; float* Opart; float* MLpart; float* Yc;
};
__device__ __forceinline__ float rstd4(const float* ssq, int row, float invw) {
    const float s = (ssq[row] + ssq[T + row]) + (ssq[2 * T + row] + ssq[3 * T + row]); return rsqrtf(s * invw + 1e-6f); }

template <int mode> struct SchedMla : ge::NoCarry { const char* A; const char* B; int c, G;
    __device__ __forceinline__ bool next(int i, ge::Unit& u) const {
        if (c < 0) return false;
        const int L = i * G + c; u.g = mode;
        if (mode == 0) { if (L >= 192) return false; u.pm = L / 3; u.pn = L % 3; }
        else if (mode == 1) { if (L >= 128) return false; u.pm = L >> 1; u.pn = L & 1; }
        else { if (L >= 128) return false; u.pm = L & 1; u.pn = L >> 1; }
        return true; }
    __device__ __forceinline__ const char* aptr(const ge::Unit& u) const { return mode == 2 ? A + (size_t)u.pm * 256 * 256 * 2 : A + (size_t)u.pm * 256 * HW * 2; }
    __device__ __forceinline__ const char* bptr(const ge::Unit& u) const { return mode == 2 ? B + (size_t)u.pn * 256 * HW * 2 : B + (size_t)u.pn * 256 * 256 * 2; }
};
template <int MODE> struct EpiMla { MlaP p;
    __device__ __forceinline__ void operator()(ge::Acc& acc, const ge::Unit& u, int wr, int wc, int fr, int fq) const {
        if constexpr (MODE == 0) {
            float rsv[2][4];
#pragma unroll
            for (int ai = 0; ai < 2; ++ai)
#pragma unroll
                for (int m = 0; m < 4; ++m) rsv[ai][m] = rstd4(p.ssq_q, u.pm * 256 + ai * 128 + wr * 64 + m * 16 + fr, 1.f / 256.f) * QSCALE;
#pragma unroll
            for (int ai = 0; ai < 2; ++ai) {
#pragma unroll
                for (int m = 0; m < 4; ++m) { const int t = u.pm * 256 + ai * 128 + wr * 64 + m * 16 + fr; const float rs = rsv[ai][m];
                    if (u.pn < 2) {
#pragma unroll
                        for (int bj = 0; bj < 2; ++bj) { const int c0 = u.pn * 256 + bj * 128 + wc * 32 + 8 * fq, head = c0 >> 7, dim = c0 & 127;
                            const f32x4 v0 = acc[ai][bj][m][0] * rs, v1 = acc[ai][bj][m][1] * rs;
                            u32x4 o = {cvt_pk_bf16(v0[0], v0[1]), cvt_pk_bf16(v0[2], v0[3]), cvt_pk_bf16(v1[0], v1[1]), cvt_pk_bf16(v1[2], v1[3])};
                            *(u32x4*)(p.Qb + (size_t)t * 768 + head * 192 + dim) = o; }
                    } else { const int head = wc, i0 = 8 * fq;
                        float o1[8], o2[8];
#pragma unroll
                        for (int n = 0; n < 2; ++n) { const f32x4 c4 = *(const f32x4*)(p.cs + (size_t)t * 32 + i0 + 4 * n), s4 = *(const f32x4*)(p.sn + (size_t)t * 32 + i0 + 4 * n);
#pragma unroll
                            for (int j = 0; j < 4; ++j) { const float x1 = acc[ai][0][m][n][j] * rs, x2 = acc[ai][1][m][n][j] * rs; o1[4 * n + j] = x1 * c4[j] - x2 * s4[j]; o2[4 * n + j] = x1 * s4[j] + x2 * c4[j]; } }
                        u32x4 a = {cvt_pk_bf16(o1[0], o1[1]), cvt_pk_bf16(o1[2], o1[3]), cvt_pk_bf16(o1[4], o1[5]), cvt_pk_bf16(o1[6], o1[7])};
                        u32x4 b = {cvt_pk_bf16(o2[0], o2[1]), cvt_pk_bf16(o2[2], o2[3]), cvt_pk_bf16(o2[4], o2[5]), cvt_pk_bf16(o2[6], o2[7])};
                        *(u32x4*)(p.Qb + (size_t)t * 768 + head * 192 + 128 + i0) = a; *(u32x4*)(p.Qb + (size_t)t * 768 + head * 192 + 160 + i0) = b; } } }
        } else if constexpr (MODE == 1) {
            float rsv[2][4];
#pragma unroll
            for (int ai = 0; ai < 2; ++ai)
#pragma unroll
                for (int m = 0; m < 4; ++m) rsv[ai][m] = rstd4(p.ssq_kv, u.pm * 256 + ai * 128 + wr * 64 + m * 16 + fr, 1.f / 128.f);
            asm volatile("" ::: "memory");
#pragma unroll
            for (int ai = 0; ai < 2; ++ai)
#pragma unroll
                for (int m = 0; m < 4; ++m) { const int t = u.pm * 256 + ai * 128 + wr * 64 + m * 16 + fr; const float rs = rsv[ai][m];
                    const int tile = t >> 6, key = t & 63;
#pragma unroll
                    for (int bj = 0; bj < 2; ++bj) { const int c0 = u.pn * 256 + bj * 128 + wc * 32 + 8 * fq, head = c0 >> 7, chunk = (c0 & 127) >> 3;
                        const f32x4 v0 = acc[ai][bj][m][0] * rs, v1 = acc[ai][bj][m][1] * rs;
                        u32x4 o = {cvt_pk_bf16(v0[0], v0[1]), cvt_pk_bf16(v0[2], v0[3]), cvt_pk_bf16(v1[0], v1[1]), cvt_pk_bf16(v1[2], v1[3])};
                        *(u32x4*)((char*)p.KnImg + ((size_t)(head * 256 + tile) * 16384) + key * 256 + ((chunk ^ (key & 15)) << 4)) = o; } }
        } else {
#pragma unroll
            for (int bj = 0; bj < 2; ++bj) { const int t0 = u.pn * 256 + bj * 128 + wc * 32 + 8 * fq;
                float rs[8];
#pragma unroll
                for (int j = 0; j < 8; ++j) rs[j] = rstd4(p.ssq_kv, t0 + j, 1.f / 128.f);
                const int tile = t0 >> 6, p0 = (t0 & 48) + ((t0 & 8) >> 1);
#pragma unroll
                for (int ai = 0; ai < 2; ++ai)
#pragma unroll
                    for (int m = 0; m < 4; ++m) { asm volatile("" ::: "memory"); const int r = u.pm * 256 + ai * 128 + wr * 64 + m * 16 + fr, head = r >> 7, d = r & 127;
                        char* base = (char*)p.VtImg + ((size_t)(head * 256 + tile) * 16384) + d * 128;
                        const f32x4 v0 = acc[ai][bj][m][0], v1 = acc[ai][bj][m][1];
                        u32x2 o0 = {cvt_pk_bf16(v0[0] * rs[0], v0[1] * rs[1]), cvt_pk_bf16(v0[2] * rs[2], v0[3] * rs[3])};
                        u32x2 o1 = {cvt_pk_bf16(v1[0] * rs[4], v1[1] * rs[5]), cvt_pk_bf16(v1[2] * rs[6], v1[3] * rs[7])};
                        const int sw = (d >> 1) & 7, pa = p0, pb = p0 + 8;
                        *(u32x2*)(base + (((pa >> 3) ^ sw) << 4) + (pa & 7) * 2) = o0;
                        *(u32x2*)(base + (((pb >> 3) ^ sw) << 4) + (pb & 7) * 2) = o1; } }
        }
    }
};
__device__ __forceinline__ void kr_phase(const MlaP& p, int gtid, int gthreads) {
    for (int idx = gtid; idx < T * 4; idx += gthreads) { const int t = idx >> 2, c = idx & 3, i0 = 8 * c;
        const u32x4 a = *(const u32x4*)(p.Hp + (size_t)t * HW + H_KR + i0), b = *(const u32x4*)(p.Hp + (size_t)t * HW + H_KR + 32 + i0);
        float o1[8], o2[8];
#pragma unroll
        for (int n = 0; n < 2; ++n) { const f32x4 c4 = *(const f32x4*)(p.cs + (size_t)t * 32 + i0 + 4 * n), s4 = *(const f32x4*)(p.sn + (size_t)t * 32 + i0 + 4 * n);
#pragma unroll
            for (int j = 0; j < 4; ++j) { const int e = 4 * n + j; const unsigned wa = a[e >> 1], wb = b[e >> 1];
                const float x1 = (e & 1) ? bfhi(wa) : bflo(wa), x2 = (e & 1) ? bfhi(wb) : bflo(wb);
                o1[e] = x1 * c4[j] - x2 * s4[j]; o2[e] = x1 * s4[j] + x2 * c4[j]; } }
        u32x4 oa = {cvt_pk_bf16(o1[0], o1[1]), cvt_pk_bf16(o1[2], o1[3]), cvt_pk_bf16(o1[4], o1[5]), cvt_pk_bf16(o1[6], o1[7])};
        u32x4 ob = {cvt_pk_bf16(o2[0], o2[1]), cvt_pk_bf16(o2[2], o2[3]), cvt_pk_bf16(o2[4], o2[5]), cvt_pk_bf16(o2[6], o2[7])};
        const int tile = t >> 6, key = t & 63, sw = (key >> 1) & 7;
        char* base = (char*)p.KrImg + (size_t)tile * 8192 + key * 128;
        *(u32x4*)(base + ((c ^ sw) << 4)) = oa; *(u32x4*)(base + (((c + 4) ^ sw) << 4)) = ob; }
}
constexpr int ATT_STEPS = 130;
__device__ __forceinline__ void attn_item(LAS unsigned char* lds, const MlaP& p, int head, int b, int j0, int j1, int slot) {
    const int tid = tid_now(), wid = __builtin_amdgcn_readfirstlane(tid >> 6), lane = tid & 63, q = lane & 31, hh = lane >> 5;
    const int grp = wid >> 2, n = j1 - j0;
    const int trow = b * 256 + wid * 32 + q;
    bf16x8 qf[12];
    { const bf16_t* qp = p.Qb + (size_t)trow * 768 + head * 192 + 8 * hh;
#pragma unroll
      for (int s = 0; s < 12; ++s) qf[s] = *(const bf16x8*)(qp + 16 * s); }
    f32x16 O[4];
#pragma unroll
    for (int d = 0; d < 4; ++d)
#pragma unroll
        for (int r = 0; r < 16; ++r) O[d][r] = 0.f;
    float m_run = -1e30f, l_run = 0.f;
    const char* knb = (const char*)p.KnImg + (size_t)head * 256 * 16384; const char* vtb = (const char*)p.VtImg + (size_t)head * 256 * 16384; const char* krb = (const char*)p.KrImg;
    const unsigned lo = (unsigned)lane * 16u;
    constexpr int KB = 24576, VOFF = 3 * KB, VB = 16384;
#define AT_ISSUE(k) do { const unsigned _ko = (unsigned)((k) % 3) * KB, _vo = VOFF + (unsigned)((k) & 3) * VB; const size_t _j = (size_t)(j0 + (k)); \
        __builtin_amdgcn_global_load_lds((const unsigned*)(knb + _j * 16384 + (wid * 2) * 1024 + lo), (LAS unsigned*)(lds + _ko + (wid * 2) * 1024), 16, 0, 0); \
        __builtin_amdgcn_global_load_lds((const unsigned*)(knb + _j * 16384 + (wid * 2 + 1) * 1024 + lo), (LAS unsigned*)(lds + _ko + (wid * 2 + 1) * 1024), 16, 0, 0); \
        __builtin_amdgcn_global_load_lds((const unsigned*)(krb + _j * 8192 + wid * 1024 + lo), (LAS unsigned*)(lds + _ko + 16384 + wid * 1024), 16, 0, 0); \
        __builtin_amdgcn_global_load_lds((const unsigned*)(vtb + _j * 16384 + (wid * 2) * 1024 + lo), (LAS unsigned*)(lds + _vo + (wid * 2) * 1024), 16, 0, 0); \
        __builtin_amdgcn_global_load_lds((const unsigned*)(vtb + _j * 16384 + (wid * 2 + 1) * 1024 + lo), (LAS unsigned*)(lds + _vo + (wid * 2 + 1) * 1024), 16, 0, 0); } while (0)
#define AT_TOP(k) do { if ((k) + 1 < n) asm volatile("s_waitcnt vmcnt(5)" ::: "memory"); else asm volatile("s_waitcnt vmcnt(0)" ::: "memory"); \
        __builtin_amdgcn_s_barrier(); asm volatile("" ::: "memory"); if ((k) + 2 < n) AT_ISSUE((k) + 2); } while (0)
    const int kn_off0 = q * 256, kn_sw = q & 15, kr_off0 = q * 128, kr_sw = (q >> 1) & 7, vt_sw = (q >> 1) & 7;
    constexpr float THR = 8.f;
    f32x16 S0, S1; bool sval = false, first = true; int sjj = 0, sk = 0;
    auto QK = [&](int k) __attribute__((always_inline)) {
        const int jj = j0 + k - 4 * b; sjj = jj; sk = k; sval = !(jj >= 0 && 64 * jj > 32 * wid + 31);
        if (sval) {
            LAS unsigned char* bb = lds + (k % 3) * KB;
            const float mref = first ? 0.f : m_run;
#pragma unroll
            for (int r = 0; r < 16; ++r) { S0[r] = -mref; S1[r] = -mref; }
#pragma unroll
            for (int s = 0; s < 8; ++s) {
                const bf16x8 k0 = *(const LAS bf16x8*)(bb + kn_off0 + (((2 * s + hh) ^ kn_sw) << 4));
                const bf16x8 k1 = *(const LAS bf16x8*)(bb + 8192 + kn_off0 + (((2 * s + hh) ^ kn_sw) << 4));
                S0 = __builtin_amdgcn_mfma_f32_32x32x16_bf16(k0, qf[s], S0, 0, 0, 0);
                S1 = __builtin_amdgcn_mfma_f32_32x32x16_bf16(k1, qf[s], S1, 0, 0, 0); }
#pragma unroll
            for (int s = 0; s < 4; ++s) {
                const bf16x8 k0 = *(const LAS bf16x8*)(bb + 16384 + kr_off0 + (((2 * s + hh) ^ kr_sw) << 4));
                const bf16x8 k1 = *(const LAS bf16x8*)(bb + 16384 + 4096 + kr_off0 + (((2 * s + hh) ^ kr_sw) << 4));
                S0 = __builtin_amdgcn_mfma_f32_32x32x16_bf16(k0, qf[8 + s], S0, 0, 0, 0);
                S1 = __builtin_amdgcn_mfma_f32_32x32x16_bf16(k1, qf[8 + s], S1, 0, 0, 0); } }
    };
    auto SMPV = [&]() __attribute__((always_inline)) {
        if (sval) {
            LAS unsigned char* vb = lds + VOFF + (sk & 3) * VB;
            const float mref = first ? 0.f : m_run;
            if (sjj >= 0) {
                const int dq = wid * 32 + q - 64 * sjj - 4 * hh;
                const float NEG = -__builtin_inff();
#pragma unroll
                for (int r = 0; r < 16; ++r) { const int c = (r & 3) + 8 * (r >> 2);
                    if (c > dq) S0[r] = NEG;
                    if (c + 32 > dq) S1[r] = NEG; } }
            float mx = S0[0];
#pragma unroll
            for (int r = 1; r < 16; ++r) mx = fmaxf(mx, S0[r]);
#pragma unroll
            for (int r = 0; r < 16; ++r) mx = fmaxf(mx, S1[r]);
            { auto rr = __builtin_amdgcn_permlane32_swap(__float_as_uint(mx), __float_as_uint(mx), false, false); mx = fmaxf(__uint_as_float(rr[0]), __uint_as_float(rr[1])); }
            float alpha = 1.f;
            if (first || !__all(mx <= THR)) {
                const float mn = fmaxf(m_run, mref + mx), sh = mn - mref;
                alpha = __builtin_amdgcn_exp2f(m_run - mn); m_run = mn;
#pragma unroll
                for (int r = 0; r < 16; ++r) { S0[r] -= sh; S1[r] -= sh; }
#pragma unroll
                for (int d = 0; d < 4; ++d)
#pragma unroll
                    for (int r = 0; r < 16; ++r) O[d][r] *= alpha;
                first = false;
            }
            float sum = 0.f;
#pragma unroll
            for (int r = 0; r < 16; ++r) { S0[r] = __builtin_amdgcn_exp2f(S0[r]); S1[r] = __builtin_amdgcn_exp2f(S1[r]); sum += S0[r] + S1[r]; }
            l_run = l_run * alpha + sum;
            bf16x8 pf[4];
#pragma unroll
            for (int h2 = 0; h2 < 2; ++h2) {
                u32x4 a = {cvt_pk_bf16(S0[8 * h2 + 0], S0[8 * h2 + 1]), cvt_pk_bf16(S0[8 * h2 + 2], S0[8 * h2 + 3]), cvt_pk_bf16(S0[8 * h2 + 4], S0[8 * h2 + 5]), cvt_pk_bf16(S0[8 * h2 + 6], S0[8 * h2 + 7])};
                u32x4 c = {cvt_pk_bf16(S1[8 * h2 + 0], S1[8 * h2 + 1]), cvt_pk_bf16(S1[8 * h2 + 2], S1[8 * h2 + 3]), cvt_pk_bf16(S1[8 * h2 + 4], S1[8 * h2 + 5]), cvt_pk_bf16(S1[8 * h2 + 6], S1[8 * h2 + 7])};
                pf[h2] = *(bf16x8*)&a; pf[2 + h2] = *(bf16x8*)&c; }
#pragma unroll
            for (int d = 0; d < 4; ++d) {
#pragma unroll
                for (int s2 = 0; s2 < 4; ++s2) {
                    const bf16x8 vf = *(const LAS bf16x8*)(vb + (d * 32 + q) * 128 + (((2 * s2 + hh) ^ vt_sw) << 4));
                    O[d] = __builtin_amdgcn_mfma_f32_32x32x16_bf16(vf, pf[s2], O[d], 0, 0, 0); } }
        }
    };
    AT_ISSUE(0);
    if (n > 1) AT_ISSUE(1);
    if (grp == 0) {
#pragma unroll 1
        for (int k = 0; k < n; ++k) { AT_TOP(k); QK(k); SMPV(); }
    } else {
#pragma unroll 1
        for (int k = 0; k < n; ++k) { AT_TOP(k); SMPV(); QK(k); }
        SMPV();
    }
    asm volatile("" ::: "memory"); __builtin_amdgcn_s_barrier(); asm volatile("" ::: "memory");
#undef AT_ISSUE
#undef AT_TOP
    { auto rr = __builtin_amdgcn_permlane32_swap(__float_as_uint(l_run), __float_as_uint(l_run), false, false); l_run = __uint_as_float(rr[0]) + __uint_as_float(rr[1]); }
    bf16_t* op = (bf16_t*)p.Opart + ((size_t)slot * 256 + wid * 32 + q) * 128 + 4 * hh;
#pragma unroll
    for (int d = 0; d < 4; ++d)
#pragma unroll
        for (int g = 0; g < 4; ++g) { u32x2 v = {cvt_pk_bf16(O[d][4 * g], O[d][4 * g + 1]), cvt_pk_bf16(O[d][4 * g + 2], O[d][4 * g + 3])}; *(u32x2*)(op + d * 32 + g * 8) = v; }
    if (hh == 0) { float* ml = p.MLpart + ((size_t)slot * 256 + wid * 32 + q) * 2; ml[0] = m_run; ml[1] = l_run; }
}
__device__ __forceinline__ void attn_phase(LAS unsigned char* lds, const MlaP& p, int c) {
    const int head = c >> 6, cc = c & 63, pp = cc >> 1, bl = 63 - pp, nl = 4 * (64 - pp);
    if ((cc & 1) == 0) attn_item(lds, p, head, bl, 0, ATT_STEPS, 2 * c);
    else { attn_item(lds, p, head, bl, ATT_STEPS, nl, 2 * c); attn_item(lds, p, head, pp, 0, 4 * (pp + 1), 2 * c + 1); }
}
struct GlaP {
    const bf16_t* Hp; const bf16_t* GVt; const float* wg; const float* bg; const float* ng; const float* wconv;
    bf16_t* QE; float* OI; float* kvT; float* decay; bf16_t* spT; bf16_t* Yab; bf16_t* Ybb; bf16_t* Ycb;
    const float* Opart; const float* MLpart;
};
__device__ __forceinline__ int pos16(int i) { return (i & 48) | ((i & 4) << 1) | ((i & 8) >> 1) | (i & 3); }
__device__ __forceinline__ void gla_g1(LAS unsigned char* lds, const GlaP& p, int c, int G) {
    const int tid = tid_now(), wid = __builtin_amdgcn_readfirstlane(tid >> 6), lane = tid & 63, l31 = lane & 31, hh = lane >> 5;
    LAS float* bsm = (LAS float*)lds; LAS float* gtot = (LAS float*)(lds + 17408); LAS float* blast = (LAS float*)(lds + 19456);
    LAS unsigned char* qeL = lds + 20480; LAS unsigned char* keL = lds + 28672; LAS unsigned char* ktL = lds + 36864;
    const int eb = wid & 3, hb = wid >> 2;
    for (int u = c; u < 1024; u += G) {
        const int n = u >> 2, h = u & 3;
        bf16x8 vf[4];
        { const bf16_t* vp = p.GVt + ((size_t)u * 128 + eb * 32 + l31) * 64 + 8 * hh;
#pragma unroll
          for (int s4 = 0; s4 < 4; ++s4) vf[s4] = *(const bf16x8*)(vp + 16 * s4); }
        { const int d = tid & 63, g = tid >> 6;
          float w[16];
#pragma unroll
          for (int r = 0; r < 16; ++r) w[r] = p.wg[r * 256 + h * 64 + d];
          const float bias = p.bg[h * 64 + d];
          float cs[8]; float run = 0.f;
#pragma unroll
          for (int k = 0; k < 8; ++k) { const int i = 8 * g + k;
              const u32x4 g0 = *(const u32x4*)(p.Hp + (size_t)(64 * n + i) * HW + H_GLR), g1 = *(const u32x4*)(p.Hp + (size_t)(64 * n + i) * HW + H_GLR + 8);
              float la = bias;
#pragma unroll
              for (int r = 0; r < 4; ++r) { la += bflo(g0[r]) * w[2 * r] + bfhi(g0[r]) * w[2 * r + 1]; la += bflo(g1[r]) * w[8 + 2 * r] + bfhi(g1[r]) * w[8 + 2 * r + 1]; }
              const float ls = (fminf(la, 0.f) - __logf(1.f + __expf(-fabsf(la)))) * (1.f / 16.f);
              run += ls; cs[k] = run; }
          gtot[g * 64 + d] = run;
          __syncthreads();
          float pre = 0.f, tot = 0.f;
#pragma unroll
          for (int gg = 0; gg < 8; ++gg) { const float v = gtot[gg * 64 + d]; tot += v; if (gg < g) pre += v; }
#pragma unroll
          for (int k = 0; k < 8; ++k) bsm[(8 * g + k) * 68 + d] = pre + cs[k];
          if (g == 0) { blast[d] = tot; p.decay[(size_t)u * 64 + d] = __expf(tot); } }
        __syncthreads();
        { const int i = tid >> 3, cc = tid & 7, d0 = 8 * cc; const size_t t = (size_t)64 * n + i;
          const u32x4 qv = *(const u32x4*)(p.Hp + t * HW + H_GQ + h * 64 + d0), kv = *(const u32x4*)(p.Hp + t * HW + H_GK + h * 64 + d0);
          float b[8], bl[8];
          { const f32x4 b0 = *(const LAS f32x4*)(bsm + i * 68 + d0), b1 = *(const LAS f32x4*)(bsm + i * 68 + d0 + 4), l0 = *(const LAS f32x4*)(blast + d0), l1 = *(const LAS f32x4*)(blast + d0 + 4);
#pragma unroll
            for (int j = 0; j < 4; ++j) { b[j] = b0[j]; b[4 + j] = b1[j]; bl[j] = l0[j]; bl[4 + j] = l1[j]; } }
          float qe[8], ke[8], kt[8];
#pragma unroll
          for (int j = 0; j < 8; ++j) { const float qq = (j & 1) ? bfhi(qv[j >> 1]) : bflo(qv[j >> 1]), kk = (j & 1) ? bfhi(kv[j >> 1]) : bflo(kv[j >> 1]);
              qe[j] = qq * 0.125f * __expf(b[j]); ke[j] = kk * __expf(-b[j]); kt[j] = kk * __expf(bl[j] - b[j]); }
          const u32x4 qo = {cvt_pk_bf16(qe[0], qe[1]), cvt_pk_bf16(qe[2], qe[3]), cvt_pk_bf16(qe[4], qe[5]), cvt_pk_bf16(qe[6], qe[7])};
          const u32x4 ko = {cvt_pk_bf16(ke[0], ke[1]), cvt_pk_bf16(ke[2], ke[3]), cvt_pk_bf16(ke[4], ke[5]), cvt_pk_bf16(ke[6], ke[7])};
          const int sw = (i >> 1) & 7;
          *(LAS u32x4*)(qeL + i * 128 + ((cc ^ sw) << 4)) = qo; *(LAS u32x4*)(keL + i * 128 + ((cc ^ sw) << 4)) = ko;
          *(u32x4*)(p.QE + t * 256 + h * 64 + d0) = qo;
          const int pi = pos16(i);
#pragma unroll
          for (int j = 0; j < 8; ++j) { const int d = d0 + j; const unsigned pk = cvt_pk_bf16(kt[j], 0.f);
              *(LAS unsigned short*)(ktL + d * 128 + (((pi >> 3) ^ ((d >> 1) & 7)) << 4) + (pi & 7) * 2) = (unsigned short)pk; } }
        __syncthreads();
        { f32x16 OT, KV;
#pragma unroll
          for (int r = 0; r < 16; ++r) { OT[r] = 0.f; KV[r] = 0.f; }
          const int sw = (l31 >> 1) & 7;
#pragma unroll
          for (int jb = 0; jb < 2; ++jb) {
              if (jb <= hb) {
                  f32x16 Sc;
#pragma unroll
                  for (int r = 0; r < 16; ++r) Sc[r] = 0.f;
#pragma unroll
                  for (int s = 0; s < 4; ++s) {
                      const bf16x8 ka = *(const LAS bf16x8*)(keL + (32 * jb + l31) * 128 + (((2 * s + hh) ^ sw) << 4));
                      const bf16x8 qb = *(const LAS bf16x8*)(qeL + (32 * hb + l31) * 128 + (((2 * s + hh) ^ sw) << 4));
                      Sc = __builtin_amdgcn_mfma_f32_32x32x16_bf16(ka, qb, Sc, 0, 0, 0); }
                  if (jb == hb) {
#pragma unroll
                      for (int r = 0; r < 16; ++r) { const int j = (r & 3) + 8 * (r >> 2) + 4 * hh; if (j > l31) Sc[r] = 0.f; } }
#pragma unroll
                  for (int h2 = 0; h2 < 2; ++h2) {
                      u32x4 a = {cvt_pk_bf16(Sc[8 * h2 + 0], Sc[8 * h2 + 1]), cvt_pk_bf16(Sc[8 * h2 + 2], Sc[8 * h2 + 3]), cvt_pk_bf16(Sc[8 * h2 + 4], Sc[8 * h2 + 5]), cvt_pk_bf16(Sc[8 * h2 + 6], Sc[8 * h2 + 7])};
                      OT = __builtin_amdgcn_mfma_f32_32x32x16_bf16(vf[2 * jb + h2], *(bf16x8*)&a, OT, 0, 0, 0); } } }
#pragma unroll
          for (int s4 = 0; s4 < 4; ++s4) {
              const bf16x8 kb = *(const LAS bf16x8*)(ktL + (32 * hb + l31) * 128 + (((2 * s4 + hh) ^ sw) << 4));
              KV = __builtin_amdgcn_mfma_f32_32x32x16_bf16(vf[s4], kb, KV, 0, 0, 0); }
          float* oi = p.OI + ((size_t)u * 8 + wid) * 1024 + lane;
#pragma unroll
          for (int r = 0; r < 16; ++r) oi[r * 64] = OT[r];
          float* kp = p.kvT + (size_t)u * 8192 + 32 * hb + l31;
#pragma unroll
          for (int r = 0; r < 16; ++r) { const int e = 32 * eb + (r & 3) + 8 * (r >> 2) + 4 * hh; kp[e * 64] = KV[r]; } }
        __syncthreads();
    }
}
__device__ __forceinline__ void gla_g2(LAS unsigned char* lds, const GlaP& p, int c) {
    const int tid = tid_now(), el = tid & 127, seg = tid >> 7;
    const int idx = c * 128 + el, h = idx >> 13, ed = idx & 8191, d = idx & 63;
    LAS float* segS = (LAS float*)lds; LAS float* segD = (LAS float*)(lds + 2048);
    float st = 0.f, dp = 1.f;
    for (int n0 = seg * 64; n0 < seg * 64 + 64; n0 += 16) {
        float kv[16], dc[16];
#pragma unroll
        for (int k = 0; k < 16; ++k) { const size_t u = (size_t)(n0 + k) * 4 + h; kv[k] = p.kvT[u * 8192 + ed]; dc[k] = p.decay[u * 64 + d]; }
#pragma unroll
        for (int k = 0; k < 16; ++k) { st = fmaf(dc[k], st, kv[k]); dp *= dc[k]; }
    }
    __syncthreads();
    segS[seg * 128 + el] = st; segD[seg * 128 + el] = dp;
    __syncthreads();
    st = 0.f;
    for (int s2 = 0; s2 < seg; ++s2) st = fmaf(segD[s2 * 128 + el], st, segS[s2 * 128 + el]);
    for (int n0 = seg * 64; n0 < seg * 64 + 64; n0 += 16) {
        float kv[16], dc[16];
#pragma unroll
        for (int k = 0; k < 16; ++k) { const size_t u = (size_t)(n0 + k) * 4 + h; kv[k] = p.kvT[u * 8192 + ed]; dc[k] = p.decay[u * 64 + d]; }
#pragma unroll
        for (int k = 0; k < 16; ++k) { const size_t u = (size_t)(n0 + k) * 4 + h; p.spT[u * 8192 + ed] = (bf16_t)(cvt_pk_bf16(st, 0.f) & 0xffffu); st = fmaf(dc[k], st, kv[k]); }
    }
    __syncthreads();
}
__device__ __forceinline__ void gla_g3(LAS unsigned char* lds, const GlaP& p, int c, int G) {
    const int tid = tid_now(), wid = __builtin_amdgcn_readfirstlane(tid >> 6), lane = tid & 63, l31 = lane & 31, hh = lane >> 5;
    LAS float* red = (LAS float*)lds;
    const int eb = wid & 3, ib = wid >> 2;
    struct In { f32x16 oi; bf16x8 sp[4], qe[4]; u32x2 rv[4]; };
    auto load = [&](int u, In& x) __attribute__((always_inline)) {
        const int n = u >> 2, h = u & 3; const size_t t = (size_t)64 * n + 32 * ib + l31;
        const float* oi = p.OI + ((size_t)u * 8 + wid) * 1024 + lane;
#pragma unroll
        for (int r = 0; r < 16; ++r) x.oi[r] = oi[r * 64];
        const bf16_t* sp = p.spT + ((size_t)u * 128 + 32 * eb + l31) * 64 + 8 * hh; const bf16_t* qp = p.QE + t * 256 + h * 64 + 8 * hh;
#pragma unroll
        for (int s = 0; s < 4; ++s) { x.sp[s] = *(const bf16x8*)(sp + 16 * s); x.qe[s] = *(const bf16x8*)(qp + 16 * s); }
#pragma unroll
        for (int g = 0; g < 4; ++g) x.rv[g] = *(const u32x2*)(p.Hp + t * HW + H_GR + h * 128 + 32 * eb + 8 * g + 4 * hh);
    };
    In cur, nxt;
    if (c < 1024) load(c, cur);
    for (int u = c; u < 1024; u += G) {
        const int n = u >> 2, h = u & 3;
        const bool hn = u + G < 1024;
        if (hn) load(u + G, nxt);
        f32x16 O = cur.oi;
        const size_t t = (size_t)64 * n + 32 * ib + l31;
#pragma unroll
        for (int s = 0; s < 4; ++s) O = __builtin_amdgcn_mfma_f32_32x32x16_bf16(cur.sp[s], cur.qe[s], O, 0, 0, 0);
        float ss = 0.f;
#pragma unroll
        for (int r = 0; r < 16; ++r) ss += O[r] * O[r];
        { auto rr = __builtin_amdgcn_permlane32_swap(__float_as_uint(ss), __float_as_uint(ss), false, false); ss = __uint_as_float(rr[0]) + __uint_as_float(rr[1]); }
        __syncthreads();
        if (hh == 0) red[eb * 64 + 32 * ib + l31] = ss;
        __syncthreads();
        const int ti = 32 * ib + l31;
        const float tot = (red[ti] + red[64 + ti]) + (red[128 + ti] + red[192 + ti]);
        const float rs = rsqrtf(tot * (1.f / 128.f) + 1e-6f);
#pragma unroll
        for (int g = 0; g < 4; ++g) { const int e0 = 32 * eb + 8 * g + 4 * hh;
            const u32x2 rv = cur.rv[g]; const f32x4 gn = *(const f32x4*)(p.ng + e0);
            float y[4];
#pragma unroll
            for (int j = 0; j < 4; ++j) { const float r_ = (j & 1) ? bfhi(rv[j >> 1]) : bflo(rv[j >> 1]); y[j] = O[4 * g + j] * rs * gn[j] * (r_ * frcp(1.f + __expf(-r_))); }
            u32x2 o = {cvt_pk_bf16(y[0], y[1]), cvt_pk_bf16(y[2], y[3])};
            *(u32x2*)(p.Ybb + t * 512 + h * 128 + e0) = o; }
        if (hn) cur = nxt;
    }
}
__device__ __forceinline__ void conv_phase(const GlaP& p, int gtid, int gthreads) {
    constexpr int NT = T * 64;
    for (int idx0 = gtid; idx0 < NT; idx0 += 2 * gthreads) {
        u32x4 av[2][3], xv[2][3], bv[2]; int tt[2], cc[2];
#pragma unroll
        for (int u = 0; u < 2; ++u) { const int idx = min(idx0 + u * gthreads, NT - 1); const int t = idx >> 6, c0 = (idx & 63) * 8; tt[u] = t; cc[u] = c0;
#pragma unroll
            for (int k = 0; k < 3; ++k) { const int ts = max(t - 2 + k, 0);
                av[u][k] = *(const u32x4*)(p.Hp + (size_t)ts * HW + H_AC + c0); xv[u][k] = *(const u32x4*)(p.Hp + (size_t)ts * HW + H_AX + c0); }
            bv[u] = *(const u32x4*)(p.Hp + (size_t)t * HW + H_AB + c0); }
#pragma unroll
        for (int u = 0; u < 2; ++u) { if (idx0 + u * gthreads < NT) { const int t = tt[u], c0 = cc[u];
            float y[8];
#pragma unroll
            for (int j = 0; j < 8; ++j) y[j] = 0.f;
#pragma unroll
            for (int k = 0; k < 3; ++k) { if (t - 2 + k >= 0) {
                const f32x4 w0 = *(const f32x4*)(p.wconv + k * 512 + c0), w1 = *(const f32x4*)(p.wconv + k * 512 + c0 + 4);
#pragma unroll
                for (int j = 0; j < 4; ++j) { y[2 * j] += (j < 2 ? w0[2 * j] : w1[2 * j - 4]) * (bflo(av[u][k][j]) * bflo(xv[u][k][j])); y[2 * j + 1] += (j < 2 ? w0[2 * j + 1] : w1[2 * j - 3]) * (bfhi(av[u][k][j]) * bfhi(xv[u][k][j])); } } }
            u32x4 o;
#pragma unroll
            for (int j = 0; j < 4; ++j) o[j] = cvt_pk_bf16(bflo(bv[u][j]) * y[2 * j], bfhi(bv[u][j]) * y[2 * j + 1]);
            *(u32x4*)(p.Yab + (size_t)t * 512 + c0) = o; } }
    }
}
__device__ __forceinline__ void attn_combine_bf16(const GlaP& p, int gtid, int gthreads) {
    constexpr int NT = 256 * 256 * 32;
    for (int idx0 = gtid; idx0 < NT; idx0 += 2 * gthreads) {
        float mv[2][2], lv[2][2]; u32x2 ov[2][2]; int nval[2]; size_t orow[2]; int ocol[2];
#pragma unroll
        for (int u = 0; u < 2; ++u) { const int idx = min(idx0 + u * gthreads, NT - 1);
            const int dq = idx & 31, row = (idx >> 5) & 255, g = idx >> 13, head = g >> 6, b = g & 63;
            const int s0 = b >= 32 ? 2 * (head * 64 + 2 * (63 - b)) : 2 * (head * 64 + 2 * b + 1) + 1;
            nval[u] = b >= 32 ? 2 : 1; orow[u] = (size_t)(b * 256 + row) * 512 + head * 128; ocol[u] = dq * 4;
#pragma unroll
            for (int k = 0; k < 2; ++k) { const size_t sl = (size_t)(s0 + (b >= 32 ? 2 * k : 0)) * 256 + row;
                const f32x2 ml = *(const f32x2*)(p.MLpart + sl * 2); mv[u][k] = ml[0]; lv[u][k] = ml[1];
                ov[u][k] = *(const u32x2*)((const bf16_t*)p.Opart + sl * 128 + dq * 4); } }
#pragma unroll
        for (int u = 0; u < 2; ++u) { if (idx0 + u * gthreads < NT) {
            float M = mv[u][0];
#pragma unroll
            for (int k = 1; k < 2; ++k) if (k < nval[u]) M = fmaxf(M, mv[u][k]);
            f32x4 acc = {0.f, 0.f, 0.f, 0.f}; float l = 0.f;
#pragma unroll
            for (int k = 0; k < 2; ++k) { const float w = k < nval[u] ? __builtin_amdgcn_exp2f(mv[u][k] - M) : 0.f;
                l += w * lv[u][k]; const f32x4 o = {bflo(ov[u][k][0]), bfhi(ov[u][k][0]), bflo(ov[u][k][1]), bfhi(ov[u][k][1])}; acc += o * w; }
            const float il = frcp(l);
            u32x2 o = {cvt_pk_bf16(acc[0] * il, acc[1] * il), cvt_pk_bf16(acc[2] * il, acc[3] * il)};
            *(u32x2*)(p.Ycb + orow[u] + ocol[u]) = o; } }
    }
}
struct P {
    const float *x, *pin; const int* pos;
    const float *ln0_g, *ln0_b, *w_in, *w_conv, *w_gg, *b_gg, *gla_ng, *qn_g, *kvn_g, *w_uq, *w_ukv, *w_br, *w_o, *ln1_g, *ln1_b, *w_grp, *b_grp, *w_exp, *b_exp,
                *w_gate, *w_up, *w_down, *ln2_g, *ln2_b, *w_pg, *b_pg, *w_pu, *ln3_g, *ln3_b;
    float* out;
    float *X, *Z, *cs, *sn, *ssq_q, *ssq_kv, *OI, *kvT, *decay, *MLpart, *ew;
    bf16_t *Db, *Xb, *Hp, *GVt, *Qb, *KnImg, *VtImg, *KrImg, *QE, *spT, *Yab, *Ybb, *Ycb, *Mgb, *Hbuf, *Ys, *Ub, *Pb;
    bf16_t *Wb_in, *Wb_gv, *Wb_uq, *Wb_uk, *Wb_uv, *Wb_br, *Wb_o, *Wb_gu, *Wb_d, *Wb_pg, *Wb_pu;
    int *cnt, *lists; unsigned* bar;
};
__device__ __forceinline__ MegaP mk_mega(const P& p) { MegaP m; m.w_in = p.w_in; m.Wb_in = p.Wb_in; m.Wb_gv = p.Wb_gv; m.Xb = p.Xb; m.Hp = p.Hp; m.GVt = p.GVt; m.ssq_q = p.ssq_q; m.ssq_kv = p.ssq_kv; return m; }
__device__ __forceinline__ MlaP mk_mla(const P& p) { MlaP q; q.w_uq = p.w_uq; q.w_ukv = p.w_ukv; q.qn_g = p.qn_g; q.kvn_g = p.kvn_g; q.Wb_uq = p.Wb_uq; q.Wb_uk = p.Wb_uk; q.Wb_uv = p.Wb_uv; q.Hp = p.Hp;
    q.ssq_q = p.ssq_q; q.ssq_kv = p.ssq_kv; q.cs = p.cs; q.sn = p.sn; q.Qb = p.Qb; q.KnImg = p.KnImg; q.VtImg = p.VtImg; q.KrImg = p.KrImg; q.Opart = p.Z; q.MLpart = p.MLpart; q.Yc = nullptr; return q; }
__device__ __forceinline__ GlaP mk_gla(const P& p, int layer) { GlaP g; g.Hp = p.Hp; g.GVt = p.GVt; g.wg = p.w_gg + layer * 16 * 256; g.bg = p.b_gg + layer * 256; g.ng = p.gla_ng + layer * 128; g.wconv = p.w_conv + layer * 3 * 512;
    g.QE = p.QE; g.OI = p.OI; g.kvT = p.kvT; g.decay = p.decay; g.spT = p.spT; g.Yab = p.Yab; g.Ybb = p.Ybb; g.Ycb = p.Ycb; g.Opart = p.Z; g.MLpart = p.MLpart; return g; }

struct CvJob { const float* W; bf16_t* Bt; const float* rs; int ldw, Ksrc, ldbt, n0, k0, kind, aux; };
struct MapId { __device__ __forceinline__ int operator()(int s) const { return s; } };
__device__ __forceinline__ int cv_map(int kind, int aux, int n) {
    if (kind == 0) return MapInMain{}(n);
    if (kind == 1) return aux + n;
    if (kind == 2) return MapQ{}(n);
    if (kind == 3) return MapKV{aux}(n);
    return n; }
__device__ __forceinline__ int cv_omap(int kind, int aux, int n) { return kind == 4 ? (n >> 7) * 256 + aux * 128 + (n & 127) : n; }
__device__ __forceinline__ bool cv_job(const P& p, int layer, int t, CvJob& j) {
    constexpr int S0 = 384, S1 = S0 + 32, S2 = S1 + 12, S3 = S2 + 8, S4 = S3 + 8, S5 = S4 + 96, S6 = S5 + 64, S7 = S6 + 64, S8 = S7 + 16, S9 = S8 + 1024, S10 = S9 + 1024, S11 = S10 + 1024;
    if (t >= S11) return false;
    j.rs = nullptr; j.aux = 0; j.kind = 5;
    if (t < S0) { j.W = p.w_in + (size_t)layer * D * INW; j.ldw = INW; j.Ksrc = D; j.Bt = p.Wb_in; j.ldbt = D; j.n0 = (t >> 2) * 64; j.k0 = (t & 3) * 256; j.kind = 0; }
    else if (t < S1) { const int u = t - S0; j.W = p.w_in + (size_t)layer * D * INW; j.ldw = INW; j.Ksrc = D; j.Bt = p.Wb_gv; j.ldbt = D; j.n0 = (u >> 2) * 64; j.k0 = (u & 3) * 256; j.kind = 1; j.aux = O_GV; }
    else if (t < S2) { const int u = t - S1; j.W = p.w_uq + (size_t)layer * 256 * 768; j.ldw = 768; j.Ksrc = 256; j.Bt = p.Wb_uq; j.ldbt = 256; j.n0 = u * 64; j.k0 = 0; j.kind = 2; j.rs = p.qn_g + layer * 256; }
    else if (t < S3) { const int u = t - S2; j.W = p.w_ukv + (size_t)layer * 128 * 1024; j.ldw = 1024; j.Ksrc = 128; j.Bt = p.Wb_uk; j.ldbt = 256; j.n0 = u * 64; j.k0 = 0; j.kind = 3; j.aux = 0; j.rs = p.kvn_g + layer * 128; }
    else if (t < S4) { const int u = t - S3; j.W = p.w_ukv + (size_t)layer * 128 * 1024; j.ldw = 1024; j.Ksrc = 128; j.Bt = p.Wb_uv; j.ldbt = 256; j.n0 = u * 64; j.k0 = 0; j.kind = 3; j.aux = 128; j.rs = p.kvn_g + layer * 128; }
    else if (t < S5) { const int u = t - S4, br = u >> 5, v = u & 31; j.W = p.w_br + (size_t)layer * 1536 * D + (size_t)br * 512 * D; j.ldw = D; j.Ksrc = 512; j.Bt = p.Wb_br + (size_t)br * 1024 * 512; j.ldbt = 512; j.n0 = (v >> 1) * 64; j.k0 = (v & 1) * 256; }
    else if (t < S6) { const int u = t - S5; j.W = p.w_o + (size_t)layer * D * D; j.ldw = D; j.Ksrc = D; j.Bt = p.Wb_o; j.ldbt = D; j.n0 = (u >> 2) * 64; j.k0 = (u & 3) * 256; }
    else if (t < S7) { const int u = t - S6; j.W = p.w_pg + (size_t)layer * D * D; j.ldw = D; j.Ksrc = D; j.Bt = p.Wb_pg; j.ldbt = D; j.n0 = (u >> 2) * 64; j.k0 = (u & 3) * 256; }
    else if (t < S8) { const int u = t - S7; j.W = p.w_pu + (size_t)layer * PLE * D; j.ldw = D; j.Ksrc = PLE; j.Bt = p.Wb_pu; j.ldbt = PLE; j.n0 = u * 64; j.k0 = 0; }
    else if (t < S9) { const int u = t - S8, e = u >> 4, v = u & 15; j.W = p.w_gate + ((size_t)layer * NE + e) * D * EH; j.ldw = EH; j.Ksrc = D; j.Bt = p.Wb_gu + (size_t)e * 512 * D; j.ldbt = D; j.n0 = (v >> 2) * 64; j.k0 = (v & 3) * 256; j.kind = 4; j.aux = 0; }
    else if (t < S10) { const int u = t - S9, e = u >> 4, v = u & 15; j.W = p.w_up + ((size_t)layer * NE + e) * D * EH; j.ldw = EH; j.Ksrc = D; j.Bt = p.Wb_gu + (size_t)e * 512 * D; j.ldbt = D; j.n0 = (v >> 2) * 64; j.k0 = (v & 3) * 256; j.kind = 4; j.aux = 1; }
    else { const int u = t - S10, e = u >> 4, v = u & 15; j.W = p.w_down + ((size_t)layer * NE + e) * EH * D; j.ldw = D; j.Ksrc = EH; j.Bt = p.Wb_d + (size_t)e * D * EH; j.ldbt = EH; j.n0 = v * 64; j.k0 = 0; }
    return true; }
__device__ __forceinline__ void cv_load(const CvJob& j, int tid, f32x4 (&v)[8]) {
    const int n4 = tid & 15, kr = tid >> 4; const int col = cv_map(j.kind, j.aux, j.n0 + 4 * n4);
#pragma unroll
    for (int r = 0; r < 8; ++r) { const int k = j.k0 + kr + 32 * r; v[r] = (f32x4){0.f, 0.f, 0.f, 0.f};
        if (col >= 0 && k < j.Ksrc) { v[r] = *(const f32x4*)(j.W + (size_t)k * j.ldw + col); if (j.rs) v[r] = v[r] * j.rs[k]; } }
}
__device__ __forceinline__ void ph_convert(LAS unsigned char* ldsl, const P& p, int layer) {
    LAS float* tile = (LAS float*)ldsl;
    const int tid = tid_now(), c = sgpr_now((int)blockIdx.x), G = gridDim.x;
    CvJob cur, nxt; f32x4 v[8], w[8];
    bool have = cv_job(p, layer, c, cur);
    if (have) cv_load(cur, tid, v);
    for (int t = c; have; t += G) {
        const bool hn = cv_job(p, layer, t + G, nxt);
        if (hn) cv_load(nxt, tid, w);
        __syncthreads();
        { const int n4 = tid & 15, kr = tid >> 4;
#pragma unroll
          for (int r = 0; r < 8; ++r) { LAS float* d = tile + (kr + 32 * r) * 65 + 4 * n4; d[0] = v[r][0]; d[1] = v[r][1]; d[2] = v[r][2]; d[3] = v[r][3]; } }
        __syncthreads();
        { const int kk = (tid & 127) * 2, nn = tid >> 7;
#pragma unroll
          for (int r = 0; r < 16; ++r) { const int n = nn + 4 * r;
              *(unsigned*)(cur.Bt + (size_t)cv_omap(cur.kind, cur.aux, cur.n0 + n) * cur.ldbt + cur.k0 + kk) = cvt_pk_bf16(tile[kk * 65 + n], tile[(kk + 1) * 65 + n]); } }
        have = hn; cur = nxt;
#pragma unroll
        for (int r = 0; r < 8; ++r) v[r] = w[r];
    }
    __syncthreads();
}

__device__ __forceinline__ float wsum(float v, int lane) {
#pragma unroll
    for (int o = 32; o > 0; o >>= 1) v += shx(v, o, lane);
    return v; }
template <int MODE>
__device__ __forceinline__ void ph_rows(const P& p, int layer) {
    const int lane = tid_now() & 63, gw = blockIdx.x * 8 + (tid_now() >> 6), nw = gridDim.x * 8;
    const float* gp = MODE == 0 ? p.ln0_g : MODE == 1 ? p.ln1_g + layer * D : MODE == 2 ? p.ln2_g + layer * D : p.ln3_g + layer * D;
    const float* bp = MODE == 0 ? p.ln0_b : MODE == 1 ? p.ln1_b + layer * D : MODE == 2 ? p.ln2_b + layer * D : p.ln3_b + layer * D;
    f32x4 gg[4], bb[4];
#pragma unroll
    for (int i = 0; i < 4; ++i) { gg[i] = *(const f32x4*)(gp + 256 * i + 4 * lane); bb[i] = *(const f32x4*)(bp + 256 * i + 4 * lane); }
    const float* in = MODE == 0 ? p.x : p.X;
    float* outf = (MODE == 3 && layer == DEPTH - 1) ? p.out : p.X;
    for (int row = gw; row < T; row += nw) {
        f32x4 v[4];
#pragma unroll
        for (int i = 0; i < 4; ++i) v[i] = *(const f32x4*)(in + (size_t)row * D + 256 * i + 4 * lane);
        if constexpr (MODE == 3) {
#pragma unroll
            for (int i = 0; i < 4; ++i) { const u32x2 dd = *(const u32x2*)(p.Db + (size_t)row * D + 256 * i + 4 * lane);
                v[i][0] = DN_ALPHA * v[i][0] + bflo(dd[0]); v[i][1] = DN_ALPHA * v[i][1] + bfhi(dd[0]); v[i][2] = DN_ALPHA * v[i][2] + bflo(dd[1]); v[i][3] = DN_ALPHA * v[i][3] + bfhi(dd[1]); } }
        if constexpr (MODE == 2) { const float w0 = p.ew[2 * row], w1 = p.ew[2 * row + 1];
#pragma unroll
            for (int i = 0; i < 4; ++i) { const u32x2 y0 = *(const u32x2*)(p.Ys + (size_t)(2 * row) * D + 256 * i + 4 * lane), y1 = *(const u32x2*)(p.Ys + (size_t)(2 * row + 1) * D + 256 * i + 4 * lane);
                v[i][0] = DN_ALPHA * v[i][0] + (w0 * bflo(y0[0]) + w1 * bflo(y1[0])); v[i][1] = DN_ALPHA * v[i][1] + (w0 * bfhi(y0[0]) + w1 * bfhi(y1[0]));
                v[i][2] = DN_ALPHA * v[i][2] + (w0 * bflo(y0[1]) + w1 * bflo(y1[1])); v[i][3] = DN_ALPHA * v[i][3] + (w0 * bfhi(y0[1]) + w1 * bfhi(y1[1])); } }
        float s = 0.f;
#pragma unroll
        for (int i = 0; i < 4; ++i) s += (v[i][0] + v[i][1]) + (v[i][2] + v[i][3]);
        const float mu = wsum(s, lane) * (1.f / D);
        float q = 0.f;
#pragma unroll
        for (int i = 0; i < 4; ++i) { v[i] = v[i] - mu; q += (v[i][0] * v[i][0] + v[i][1] * v[i][1]) + (v[i][2] * v[i][2] + v[i][3] * v[i][3]); }
        const float rs = rsqrtf(wsum(q, lane) * (1.f / D) + 1e-5f);
#pragma unroll
        for (int i = 0; i < 4; ++i) { v[i] = v[i] * rs * gg[i] + bb[i];
            *(f32x4*)(outf + (size_t)row * D + 256 * i + 4 * lane) = v[i];
            u32x2 o = {cvt_pk_bf16(v[i][0], v[i][1]), cvt_pk_bf16(v[i][2], v[i][3])};
            *(u32x2*)(p.Xb + (size_t)row * D + 256 * i + 4 * lane) = o; }
        if constexpr (MODE == 1) {
            const float* wg = p.w_grp + (size_t)layer * D * 8; const float* we = p.w_exp + (size_t)layer * D * 64;
            float gl[8];
#pragma unroll
            for (int g = 0; g < 8; ++g) gl[g] = 0.f;
#pragma unroll
            for (int i = 0; i < 4; ++i)
#pragma unroll
                for (int j = 0; j < 4; ++j) { const int k = 256 * i + 4 * lane + j; const f32x4 a = *(const f32x4*)(wg + k * 8), b = *(const f32x4*)(wg + k * 8 + 4); const float xv = v[i][j];
                    gl[0] = fmaf(xv, a[0], gl[0]); gl[1] = fmaf(xv, a[1], gl[1]); gl[2] = fmaf(xv, a[2], gl[2]); gl[3] = fmaf(xv, a[3], gl[3]);
                    gl[4] = fmaf(xv, b[0], gl[4]); gl[5] = fmaf(xv, b[1], gl[5]); gl[6] = fmaf(xv, b[2], gl[6]); gl[7] = fmaf(xv, b[3], gl[7]); }
            float mx = -INFINITY; int gt = 0;
#pragma unroll
            for (int g = 0; g < 8; ++g) { gl[g] = wsum(gl[g], lane) + p.b_grp[layer * 8 + g]; if (gl[g] > mx) { mx = gl[g]; gt = g; } }
            gt = __builtin_amdgcn_readfirstlane(gt);
            float sum = 0.f;
#pragma unroll
            for (int g = 0; g < 8; ++g) sum += expf(gl[g] - mx);
            const float pg = 1.f / sum;
            float el[8];
#pragma unroll
            for (int e = 0; e < 8; ++e) el[e] = 0.f;
#pragma unroll
            for (int i = 0; i < 4; ++i)
#pragma unroll
                for (int j = 0; j < 4; ++j) { const int k = 256 * i + 4 * lane + j; const f32x4 a = *(const f32x4*)(we + k * 64 + gt * 8), b = *(const f32x4*)(we + k * 64 + gt * 8 + 4); const float xv = v[i][j];
                    el[0] = fmaf(xv, a[0], el[0]); el[1] = fmaf(xv, a[1], el[1]); el[2] = fmaf(xv, a[2], el[2]); el[3] = fmaf(xv, a[3], el[3]);
                    el[4] = fmaf(xv, b[0], el[4]); el[5] = fmaf(xv, b[1], el[5]); el[6] = fmaf(xv, b[2], el[6]); el[7] = fmaf(xv, b[3], el[7]); }
            float v1 = -INFINITY, v2 = -INFINITY; int i1 = 0, i2 = 0;
#pragma unroll
            for (int e = 0; e < 8; ++e) { const float vv = wsum(el[e], lane) + p.b_exp[layer * 64 + gt * 8 + e];
                if (vv > v1) { v2 = v1; i2 = i1; v1 = vv; i1 = e; } else if (vv > v2) { v2 = vv; i2 = e; } }
            if (lane == 0) { const float e2 = expf(v2 - v1), w1 = pg / (1.f + e2), w2 = pg * e2 / (1.f + e2);
                const int ea = gt * 8 + i1, eb = gt * 8 + i2; int* cn = p.cnt + layer * 64;
                p.ew[2 * row] = w1; p.ew[2 * row + 1] = w2;
                const int pa = atomicAdd(&cn[ea], 1); p.lists[ea * LCAP + pa] = 2 * row;
                const int pb = atomicAdd(&cn[eb], 1); p.lists[eb * LCAP + pb] = 2 * row + 1; }
        }
    }
}

__device__ __forceinline__ void wsum8(float (&x)[8], int lane) {
    float y[4], z[2], w;
#pragma unroll
    for (int k = 0; k < 4; ++k) { const bool hi = lane & 32; const float snd = hi ? x[k] : x[k + 4], keep = hi ? x[k + 4] : x[k]; y[k] = keep + shx(snd, 32, lane); }
#pragma unroll
    for (int k = 0; k < 2; ++k) { const bool hi = lane & 16; const float snd = hi ? y[k] : y[k + 2], keep = hi ? y[k + 2] : y[k]; z[k] = keep + shx(snd, 16, lane); }
    { const bool hi = lane & 8; const float snd = hi ? z[0] : z[1], keep = hi ? z[1] : z[0]; w = keep + shx(snd, 8, lane); }
    w += shx(w, 4, lane); w += shx(w, 2, lane); w += shx(w, 1, lane);
#pragma unroll
    for (int k = 0; k < 8; ++k) x[k] = __int_as_float(__builtin_amdgcn_readlane(__float_as_int(w), (k >> 2) * 32 + ((k >> 1) & 1) * 16 + (k & 1) * 8));
}
__device__ __forceinline__ void ph_ln1_router(const P& p, int layer) {
    constexpr int RR = 2;
    const int tid = tid_now(), lane0 = tid & 63, gw = sgpr_now((int)blockIdx.x) * 8 + (tid >> 6), nw = gridDim.x * 8;
    const float* gp = p.ln1_g + layer * D; const float* bp = p.ln1_b + layer * D;
    const float* wg = p.w_grp + (size_t)layer * D * 8; const float* we = p.w_exp + (size_t)layer * D * 64;
    for (int row0 = gw * RR; row0 < T; row0 += nw * RR) {
        int lane = lane0; asm volatile("" : "+v"(lane));
        f32x4 v[RR][4];
#pragma unroll
        for (int r = 0; r < RR; ++r)
#pragma unroll
            for (int i = 0; i < 4; ++i) { v[r][i] = *(const f32x4*)(p.X + (size_t)(row0 + r) * D + 256 * i + 4 * lane);
                const u32x2 dd = *(const u32x2*)(p.Db + (size_t)(row0 + r) * D + 256 * i + 4 * lane);
                v[r][i][0] = DN_ALPHA * v[r][i][0] + bflo(dd[0]); v[r][i][1] = DN_ALPHA * v[r][i][1] + bfhi(dd[0]); v[r][i][2] = DN_ALPHA * v[r][i][2] + bflo(dd[1]); v[r][i][3] = DN_ALPHA * v[r][i][3] + bfhi(dd[1]); }
#pragma unroll
        for (int r = 0; r < RR; ++r) {
            float s = 0.f;
#pragma unroll
            for (int i = 0; i < 4; ++i) s += (v[r][i][0] + v[r][i][1]) + (v[r][i][2] + v[r][i][3]);
            const float mu = wsum(s, lane) * (1.f / D);
            float q = 0.f;
#pragma unroll
            for (int i = 0; i < 4; ++i) { v[r][i] = v[r][i] - mu; q += (v[r][i][0] * v[r][i][0] + v[r][i][1] * v[r][i][1]) + (v[r][i][2] * v[r][i][2] + v[r][i][3] * v[r][i][3]); }
            const float rs = rsqrtf(wsum(q, lane) * (1.f / D) + 1e-5f);
#pragma unroll
            for (int i = 0; i < 4; ++i) { const f32x4 gg = *(const f32x4*)(gp + 256 * i + 4 * lane), bb = *(const f32x4*)(bp + 256 * i + 4 * lane);
                v[r][i] = v[r][i] * rs * gg + bb;
                *(f32x4*)(p.X + (size_t)(row0 + r) * D + 256 * i + 4 * lane) = v[r][i];
                u32x2 o = {cvt_pk_bf16(v[r][i][0], v[r][i][1]), cvt_pk_bf16(v[r][i][2], v[r][i][3])};
                *(u32x2*)(p.Xb + (size_t)(row0 + r) * D + 256 * i + 4 * lane) = o; } }
        float gl[RR][8];
#pragma unroll
        for (int r = 0; r < RR; ++r)
#pragma unroll
            for (int g = 0; g < 8; ++g) gl[r][g] = 0.f;
        {
            f32x4 wa[2][4], wb[2][4];
            asm volatile("" : "+v"(lane));
#pragma unroll
            for (int j = 0; j < 4; ++j) { const int k = 4 * lane + j; wa[0][j] = *(const f32x4*)(wg + k * 8); wb[0][j] = *(const f32x4*)(wg + k * 8 + 4); }
#pragma unroll
            for (int i = 0; i < 4; ++i) {
                if (i + 1 < 4) { asm volatile("" : "+v"(lane));
#pragma unroll
                    for (int j = 0; j < 4; ++j) { const int k = 256 * (i + 1) + 4 * lane + j; wa[(i + 1) & 1][j] = *(const f32x4*)(wg + k * 8); wb[(i + 1) & 1][j] = *(const f32x4*)(wg + k * 8 + 4); } }
                asm volatile("" ::: "memory");
#pragma unroll
                for (int j = 0; j < 4; ++j) { const f32x4 a = wa[i & 1][j], b = wb[i & 1][j];
#pragma unroll
                    for (int r = 0; r < RR; ++r) { const float xv = v[r][i][j];
                        gl[r][0] = fmaf(xv, a[0], gl[r][0]); gl[r][1] = fmaf(xv, a[1], gl[r][1]); gl[r][2] = fmaf(xv, a[2], gl[r][2]); gl[r][3] = fmaf(xv, a[3], gl[r][3]);
                        gl[r][4] = fmaf(xv, b[0], gl[r][4]); gl[r][5] = fmaf(xv, b[1], gl[r][5]); gl[r][6] = fmaf(xv, b[2], gl[r][6]); gl[r][7] = fmaf(xv, b[3], gl[r][7]); } } } }
        int gt[RR]; float pg[RR];
#pragma unroll
        for (int r = 0; r < RR; ++r) { wsum8(gl[r], lane);
            float mx = -INFINITY; int gi = 0;
#pragma unroll
            for (int g = 0; g < 8; ++g) { gl[r][g] += p.b_grp[layer * 8 + g]; if (gl[r][g] > mx) { mx = gl[r][g]; gi = g; } }
            float sum = 0.f;
#pragma unroll
            for (int g = 0; g < 8; ++g) sum += expf(gl[r][g] - mx);
            gt[r] = __builtin_amdgcn_readfirstlane(gi); pg[r] = 1.f / sum; }
        float el[RR][8];
#pragma unroll
        for (int r = 0; r < RR; ++r) {
#pragma unroll
            for (int e = 0; e < 8; ++e) el[r][e] = 0.f;
            f32x4 wa[2][4], wb[2][4];
            const float* wr_ = we + gt[r] * 8;
            asm volatile("" : "+v"(lane));
#pragma unroll
            for (int j = 0; j < 4; ++j) { const int k = 4 * lane + j; wa[0][j] = *(const f32x4*)(wr_ + k * 64); wb[0][j] = *(const f32x4*)(wr_ + k * 64 + 4); }
#pragma unroll
            for (int i = 0; i < 4; ++i) {
                if (i + 1 < 4) { asm volatile("" : "+v"(lane));
#pragma unroll
                    for (int j = 0; j < 4; ++j) { const int k = 256 * (i + 1) + 4 * lane + j; wa[(i + 1) & 1][j] = *(const f32x4*)(wr_ + k * 64); wb[(i + 1) & 1][j] = *(const f32x4*)(wr_ + k * 64 + 4); } }
                asm volatile("" ::: "memory");
#pragma unroll
                for (int j = 0; j < 4; ++j) { const f32x4 a = wa[i & 1][j], b = wb[i & 1][j]; const float xv = v[r][i][j];
                    el[r][0] = fmaf(xv, a[0], el[r][0]); el[r][1] = fmaf(xv, a[1], el[r][1]); el[r][2] = fmaf(xv, a[2], el[r][2]); el[r][3] = fmaf(xv, a[3], el[r][3]);
                    el[r][4] = fmaf(xv, b[0], el[r][4]); el[r][5] = fmaf(xv, b[1], el[r][5]); el[r][6] = fmaf(xv, b[2], el[r][6]); el[r][7] = fmaf(xv, b[3], el[r][7]); } } }
#pragma unroll
        for (int r = 0; r < RR; ++r) { wsum8(el[r], lane);
            float v1 = -INFINITY, v2 = -INFINITY; int i1 = 0, i2 = 0;
#pragma unroll
            for (int e = 0; e < 8; ++e) { const float vv = el[r][e] + p.b_exp[layer * 64 + gt[r] * 8 + e];
                if (vv > v1) { v2 = v1; i2 = i1; v1 = vv; i1 = e; } else if (vv > v2) { v2 = vv; i2 = e; } }
            if (lane == 0) { const int row = row0 + r; const float e2 = expf(v2 - v1), w1 = pg[r] / (1.f + e2), w2 = pg[r] * e2 / (1.f + e2);
                const int ea = gt[r] * 8 + i1, eb = gt[r] * 8 + i2; int* cn = p.cnt + layer * 64;
                p.ew[2 * row] = w1; p.ew[2 * row + 1] = w2;
                const int pa = atomicAdd(&cn[ea], 1); p.lists[ea * LCAP + pa] = 2 * row;
                const int pb = atomicAdd(&cn[eb], 1); p.lists[eb * LCAP + pb] = 2 * row + 1; } }
    }
}
__device__ __forceinline__ void ph_prologue(const P& p) {
    const int gtid = blockIdx.x * NTHR + tid_now(), gth = gridDim.x * NTHR;
    for (int idx = gtid; idx < T * 32; idx += gth) { const int t = idx >> 5, i = idx & 31;
        const float inv = (float)(1.0 / pow(10000.0, (double)(2 * i) / 64.0)); const float ang = (float)p.pos[t] * inv;
        p.cs[idx] = (float)cos((double)ang); p.sn[idx] = (float)sin((double)ang); }
    for (size_t i = gtid; i < (size_t)DEPTH * T * PLE / 4; i += gth) { const f32x4 v = ((const f32x4*)p.pin)[i]; u32x2 o = {cvt_pk_bf16(v[0], v[1]), cvt_pk_bf16(v[2], v[3])}; ((u32x2*)p.Pb)[i] = o; }
    ph_rows<0>(p, 0);
}

struct SchedBr { __device__ __forceinline__ bool carry(const ge::Unit& u) const { return u.g < 2; }
    const char* Ya; const char* Yb; const char* Yc; const char* W; int c, G;
    __device__ __forceinline__ bool next(int i, ge::Unit& u) const { const int tile = (i / 3) * G + c; if (tile >= 256) return false; u.g = i % 3; ge::tile_order(tile, 64, 4, u.pm, u.pn); return true; }
    __device__ __forceinline__ const char* aptr(const ge::Unit& u) const { return (u.g == 0 ? Ya : u.g == 1 ? Yb : Yc) + (size_t)u.pm * 256 * 512 * 2; }
    __device__ __forceinline__ const char* bptr(const ge::Unit& u) const { return W + ((size_t)u.g * 1024 + u.pn * 256) * 512 * 2; } };
struct EpiBr { const bf16_t* Hp; bf16_t* Mgb;
    __device__ __forceinline__ void operator()(ge::Acc& acc, const ge::Unit& u, int wr, int wc, int fr, int fq) const {
        const int row0 = u.pm * 256 + wr * 64 + fr, col0 = u.pn * 256 + wc * 32 + 8 * fq;
        const bool ratio = u.g < 2;
#pragma unroll
        for (int ai = 0; ai < 2; ++ai) {
            u32x4 gt[4][2], gn[4][2];
#pragma unroll
            for (int m = 0; m < 4; ++m)
#pragma unroll
                for (int bj = 0; bj < 2; ++bj) { const bf16_t* gp = Hp + (size_t)(row0 + ai * 128 + m * 16) * HW + H_GTA + u.g * 1024 + col0 + bj * 128;
                    gt[m][bj] = *(const u32x4*)gp; gn[m][bj] = ratio ? *(const u32x4*)(gp + 1024) : gt[m][bj]; }
            asm volatile("" ::: "memory");
#pragma unroll
            for (int m = 0; m < 4; ++m) { const int row = row0 + ai * 128 + m * 16;
#pragma unroll
                for (int bj = 0; bj < 2; ++bj) { const int col = col0 + bj * 128; const u32x4 g = gt[m][bj], d = gn[m][bj];
                    f32x4 s0 = {bflo(g[0]), bfhi(g[0]), bflo(g[1]), bfhi(g[1])}, s1 = {bflo(g[2]), bfhi(g[2]), bflo(g[3]), bfhi(g[3])};
                    if (ratio) { const f32x4 d0 = {bflo(d[0]), bfhi(d[0]), bflo(d[1]), bfhi(d[1])}, d1 = {bflo(d[2]), bfhi(d[2]), bflo(d[3]), bfhi(d[3])};
#pragma unroll
                        for (int j = 0; j < 4; ++j) { s0[j] = s0[j] * frcp(d0[j]); s1[j] = s1[j] * frcp(d1[j]); } }
                    acc[ai][bj][m][0] = acc[ai][bj][m][0] * s0; acc[ai][bj][m][1] = acc[ai][bj][m][1] * s1;
                    if (u.g == 2) { const f32x4 v0 = acc[ai][bj][m][0], v1 = acc[ai][bj][m][1];
                        u32x4 o = {cvt_pk_bf16(v0[0], v0[1]), cvt_pk_bf16(v0[2], v0[3]), cvt_pk_bf16(v1[0], v1[1]), cvt_pk_bf16(v1[2], v1[3])}; *(u32x4*)(Mgb + (size_t)row * D + col) = o; } } }
        }
    } };
struct SchedT4 : ge::NoCarry { const char* A; const char* B; int lda2, ldb2, c, G;
    __device__ __forceinline__ bool next(int i, ge::Unit& u) const { const int L = i * G + c; if (L >= 256) return false; u.g = 0; ge::tile_order(L, 64, 4, u.pm, u.pn); return true; }
    __device__ __forceinline__ const char* aptr(const ge::Unit& u) const { return A + (size_t)u.pm * lda2; }
    __device__ __forceinline__ const char* bptr(const ge::Unit& u) const { return B + (size_t)u.pn * ldb2; } };
struct EpiRes { bf16_t* Db;
    __device__ __forceinline__ void operator()(ge::Acc& acc, const ge::Unit& u, int wr, int wc, int fr, int fq) const {
        const int row0 = u.pm * 256 + wr * 64 + fr, col0 = u.pn * 256 + wc * 32 + 8 * fq;
#pragma unroll
        for (int ai = 0; ai < 2; ++ai)
#pragma unroll
            for (int m = 0; m < 4; ++m) { const size_t o = (size_t)(row0 + ai * 128 + m * 16) * D + col0;
#pragma unroll
                for (int bj = 0; bj < 2; ++bj) { const f32x4 v0 = acc[ai][bj][m][0], v1 = acc[ai][bj][m][1];
                    u32x4 w = {cvt_pk_bf16(v0[0], v0[1]), cvt_pk_bf16(v0[2], v0[3]), cvt_pk_bf16(v1[0], v1[1]), cvt_pk_bf16(v1[2], v1[3])}; *(u32x4*)(Db + o + bj * 128) = w; } }
    } };
struct EpiU { bf16_t* Ub;
    __device__ __forceinline__ void operator()(ge::Acc& acc, const ge::Unit& u, int wr, int wc, int fr, int fq) const {
        const int row0 = u.pm * 256 + wr * 64 + fr, col0 = u.pn * 256 + wc * 32 + 8 * fq;
#pragma unroll
        for (int ai = 0; ai < 2; ++ai)
#pragma unroll
            for (int m = 0; m < 4; ++m) { const size_t o = (size_t)(row0 + ai * 128 + m * 16) * D + col0;
#pragma unroll
                for (int bj = 0; bj < 2; ++bj) { const f32x4 v0 = acc[ai][bj][m][0], v1 = acc[ai][bj][m][1];
                    u32x4 w = {cvt_pk_bf16(v0[0], v0[1]), cvt_pk_bf16(v0[2], v0[3]), cvt_pk_bf16(v1[0], v1[1]), cvt_pk_bf16(v1[2], v1[3])}; *(u32x4*)(Ub + o + bj * 128) = w; } }
    } };
struct EpiPle { bf16_t* Db; const bf16_t* Ub; const float* bias;
    __device__ __forceinline__ void operator()(ge::Acc& acc, const ge::Unit& u, int wr, int wc, int fr, int fq) const {
        const int row0 = u.pm * 256 + wr * 64 + fr, col0 = u.pn * 256 + wc * 32 + 8 * fq;
        f32x4 bv[2][2];
#pragma unroll
        for (int bj = 0; bj < 2; ++bj) { bv[bj][0] = *(const f32x4*)(bias + col0 + bj * 128); bv[bj][1] = *(const f32x4*)(bias + col0 + bj * 128 + 4); }
#pragma unroll
        for (int ai = 0; ai < 2; ++ai) {
            u32x4 uv[4][2];
#pragma unroll
            for (int m = 0; m < 4; ++m)
#pragma unroll
                for (int bj = 0; bj < 2; ++bj) uv[m][bj] = *(const u32x4*)(Ub + (size_t)(row0 + ai * 128 + m * 16) * D + col0 + bj * 128);
            asm volatile("" ::: "memory");
#pragma unroll
            for (int m = 0; m < 4; ++m) { const size_t o = (size_t)(row0 + ai * 128 + m * 16) * D + col0;
#pragma unroll
                for (int bj = 0; bj < 2; ++bj) { const u32x4 uu = uv[m][bj];
                    f32x4 g0 = acc[ai][bj][m][0] + bv[bj][0], g1 = acc[ai][bj][m][1] + bv[bj][1];
#pragma unroll
                    for (int j = 0; j < 4; ++j) { g0[j] = frcp(1.f + __expf(-g0[j])); g1[j] = frcp(1.f + __expf(-g1[j])); }
                    const f32x4 u0 = {bflo(uu[0]), bfhi(uu[0]), bflo(uu[1]), bfhi(uu[1])}, u1 = {bflo(uu[2]), bfhi(uu[2]), bflo(uu[3]), bfhi(uu[3])};
                    g0 = g0 * u0; g1 = g1 * u1;
                    u32x4 w = {cvt_pk_bf16(g0[0], g0[1]), cvt_pk_bf16(g0[2], g0[3]), cvt_pk_bf16(g1[0], g1[1]), cvt_pk_bf16(g1[2], g1[3])}; *(u32x4*)(Db + o + bj * 128) = w; } } }
    } };

__device__ __forceinline__ void moe_table(LAS unsigned char* lds, const int* cnt) {
    LAS int* te = (LAS int*)(lds + 131072); LAS int* tr = te + 256; LAS int* cl = tr + 256; LAS int* nt = cl + 64;
    __syncthreads();
    const int tid = tid_now();
    if (tid < 64) {
        const int ce = cnt[tid], ne = (ce + 255) >> 8;
        int pre = ne;
#pragma unroll
        for (int o = 1; o < 64; o <<= 1) { const int t = __builtin_amdgcn_ds_bpermute(((tid - o) & 63) << 2, pre); if (tid >= o) pre += t; }
        const int base = pre - ne;
        cl[tid] = ce;
        for (int j = 0; j < ne; ++j) { te[base + j] = tid; tr[base + j] = 256 * j; }
        if (tid == 63) nt[0] = pre;
    }
    __syncthreads();
}
struct SchedM1 : ge::NoCarry { const char* Xb; const char* W; const int* lists; LAS int* te; int c, G;
    __device__ __forceinline__ bool next(int i, ge::Unit& u) const { const int L = i * G + c; if (L >= 2 * te[576]) return false; u.pm = L >> 1; u.pn = L & 1; u.g = te[u.pm]; return true; }
    __device__ __forceinline__ int arow(const ge::Unit& u, int r) const { const int n = te[512 + u.g], idx = min(te[256 + u.pm] + r, n - 1); return lists[u.g * LCAP + idx] >> 1; }
    __device__ __forceinline__ const char* aptr(const ge::Unit&) const { return Xb; }
    __device__ __forceinline__ const char* bptr(const ge::Unit& u) const { return W + ((size_t)u.g * 512 + u.pn * 256) * D * 2; } };
struct EpiM1 { bf16_t* Hbuf;
    __device__ __forceinline__ void operator()(ge::Acc& acc, const ge::Unit& u, int wr, int wc, int fr, int fq) const {
#pragma unroll
        for (int ai = 0; ai < 2; ++ai)
#pragma unroll
            for (int m = 0; m < 4; ++m) { const int row = ai * 128 + wr * 64 + m * 16 + fr;
                float h[8];
#pragma unroll
                for (int n = 0; n < 2; ++n)
#pragma unroll
                    for (int j = 0; j < 4; ++j) { const float g = acc[ai][0][m][n][j], uu = acc[ai][1][m][n][j]; h[4 * n + j] = g * frcp(1.f + __expf(-g)) * uu; }
                u32x4 o = {cvt_pk_bf16(h[0], h[1]), cvt_pk_bf16(h[2], h[3]), cvt_pk_bf16(h[4], h[5]), cvt_pk_bf16(h[6], h[7])};
                *(u32x4*)(Hbuf + ((size_t)u.pm * 256 + row) * EH + u.pn * 128 + wc * 32 + 8 * fq) = o; }
    } };
struct SchedM2 : ge::NoCarry { const char* Hb; const char* W; LAS int* te; int c, G;
    __device__ __forceinline__ bool next(int i, ge::Unit& u) const { const int L = i * G + c; if (L >= 4 * te[576]) return false; u.pm = L >> 2; u.pn = L & 3; u.g = te[u.pm]; return true; }
    __device__ __forceinline__ const char* aptr(const ge::Unit& u) const { return Hb + (size_t)u.pm * 256 * EH * 2; }
    __device__ __forceinline__ const char* bptr(const ge::Unit& u) const { return W + ((size_t)u.g * D + u.pn * 256) * EH * 2; } };
struct EpiM2 { bf16_t* Ys; const int* lists; LAS int* te;
    __device__ __forceinline__ void operator()(ge::Acc& acc, const ge::Unit& u, int wr, int wc, int fr, int fq) const {
        const int r0 = te[256 + u.pm], n = te[512 + u.g];
        int av[2][4];
#pragma unroll
        for (int ai = 0; ai < 2; ++ai)
#pragma unroll
            for (int m = 0; m < 4; ++m) { const int row = r0 + ai * 128 + wr * 64 + m * 16 + fr; av[ai][m] = row < n ? lists[u.g * LCAP + row] : -1; }
#pragma unroll
        for (int ai = 0; ai < 2; ++ai)
#pragma unroll
            for (int m = 0; m < 4; ++m) { const int a = av[ai][m];
                if (a >= 0) {
#pragma unroll
                    for (int bj = 0; bj < 2; ++bj) { const f32x4 v0 = acc[ai][bj][m][0], v1 = acc[ai][bj][m][1];
                        u32x4 o = {cvt_pk_bf16(v0[0], v0[1]), cvt_pk_bf16(v0[2], v0[3]), cvt_pk_bf16(v1[0], v1[1]), cvt_pk_bf16(v1[2], v1[3])};
                        *(u32x4*)(Ys + (size_t)a * D + u.pn * 256 + bj * 128 + wc * 32 + 8 * fq) = o; } } }
    } };

#define XB_TMO      128
#define XB_XCNT(j)  (256  + 64 * (j))
#define XB_XSUB(j)  (1280 + 64 * (j))
#define XB_XGEN(j)  (2304 + 64 * (j))
#define XB_TOP      3328
#define XB_TOPGEN   3392
#define XCD_BAR_WORDS 3456
#define XB_SPIN_CAP (1u << 18)

__device__ __forceinline__ unsigned xb_ld(unsigned* p)              { return __hip_atomic_load(p, __ATOMIC_RELAXED, __HIP_MEMORY_SCOPE_AGENT); }
__device__ __forceinline__ unsigned xb_add(unsigned* p, unsigned v) { return __hip_atomic_fetch_add(p, v, __ATOMIC_RELAXED, __HIP_MEMORY_SCOPE_AGENT); }
__device__ __forceinline__ unsigned xb_xcc_id() { return (unsigned)__builtin_amdgcn_s_getreg((3 << 11) | 20) & 0xFu; }
#define XB_SPIN(cond, bar) do { unsigned _sp = 0; while (cond) { __builtin_amdgcn_s_sleep(1); \
    if ((++_sp & 255u) == 0u) { if (xb_ld(&(bar)[XB_TMO])) break; if (_sp > XB_SPIN_CAP) { atomicAdd(&(bar)[XB_TMO], 1u); break; } } } } while (0)

struct XcdBarrier {
    unsigned* bar; unsigned x;
    volatile LAS unsigned* st;
};

__device__ __forceinline__ XcdBarrier xcd_barrier_post(unsigned* bar, volatile LAS unsigned* st) {
    XcdBarrier b; b.bar = bar; b.x = xb_xcc_id(); b.st = st;
    if (threadIdx.x == 0) (void)xb_add(&bar[XB_XCNT(b.x)], 1u);
    return b;
}
__device__ __forceinline__ void xcd_barrier_complete(unsigned* bar, unsigned x, unsigned& nloc, unsigned& nx) {
    const unsigned G = gridDim.x * gridDim.y * gridDim.z;
    unsigned sum, cnt, mine, sp = 0u;
    for (;;) {
        sum = 0u; cnt = 0u; mine = 0u;
#pragma unroll
        for (unsigned j = 0; j < 16; ++j) { const unsigned c = xb_ld(&bar[XB_XCNT(j)]); sum += c; cnt += (c > 0u) ? 1u : 0u; mine = (j == x) ? c : mine; }
        if (sum == G) break;
        __builtin_amdgcn_s_sleep(1);
        if ((++sp & 255u) == 0u) { if (xb_ld(&bar[XB_TMO])) break; if (sp > XB_SPIN_CAP) { atomicAdd(&bar[XB_TMO], 1u); break; } }
    }
    nloc = mine > 0u ? mine : 1u; nx = cnt > 0u ? cnt : 1u;
}

__device__ __forceinline__ void xcd_barrier(const XcdBarrier& b) {
    asm volatile("s_waitcnt vmcnt(0)" ::: "memory");
    __syncthreads();
    if (threadIdx.x == 0) {
        unsigned* bar = b.bar;
        __builtin_amdgcn_s_waitcnt(0);
        unsigned nloc = b.st[0], nx = b.st[1];
        if (nloc == 0u) { xcd_barrier_complete(bar, b.x, nloc, nx); b.st[0] = nloc; b.st[1] = nx; }
        const unsigned old = xb_add(&bar[XB_XSUB(b.x)], 1u);
        const unsigned gen = old / nloc;
        if (old + 1u == (gen + 1u) * nloc) {
            __builtin_amdgcn_fence(__ATOMIC_RELEASE, "agent");
            asm volatile("s_waitcnt vmcnt(0)" ::: "memory");
            const unsigned og = xb_add(&bar[XB_TOP], 1u);
            const unsigned tg = og / nx;
            if (og + 1u == (tg + 1u) * nx) xb_add(&bar[XB_TOPGEN], 1u);
            else XB_SPIN(xb_ld(&bar[XB_TOPGEN]) == tg, bar);
            __builtin_amdgcn_fence(__ATOMIC_ACQUIRE, "agent");
            xb_add(&bar[XB_XGEN(b.x)], 1u);
            asm volatile("s_waitcnt vmcnt(0)" ::: "memory");
        } else {
            XB_SPIN(xb_ld(&bar[XB_XGEN(b.x)]) == gen, bar);
            __builtin_amdgcn_fence(__ATOMIC_ACQUIRE, "agent");
            asm volatile("s_waitcnt vmcnt(0)" ::: "memory");
        }
    }
    __syncthreads();
}

enum { PH_PRO = 0, PH_CONV, PH_IN, PH_PREP_Q, PH_PREP_K, PH_PREP_V, PH_PREP_G, PH_ATT, PH_FIN, PH_BR, PH_WO, PH_LN1, PH_M1, PH_M2, PH_LN2, PH_PLE, PH_LN3 };
template <int PH> __global__ __launch_bounds__(NTHR, 2) void k_ph(P p, int layer) {
    extern __shared__ __attribute__((aligned(16))) unsigned char smem[];
    LAS unsigned char* lds = (LAS unsigned char*)smem;
    tid_setup();
    const int c = blockIdx.x, G = gridDim.x;
    if constexpr (PH == PH_PRO) ph_prologue(p);
    if constexpr (PH == PH_CONV) ph_convert(lds, p, layer);
    if constexpr (PH == PH_IN) { const MegaP m = mk_mega(p); SchedIn S{{}, (const char*)m.Xb, (const char*)m.Wb_in, (const char*)m.Wb_gv, c, G, 0}; EpiIn<2> E{m.Hp, m.GVt, m.ssq_q, m.ssq_kv}; ge::gemm_stream<EpiIn<2>, SchedIn, false>(lds, D, D, D, S, E); }
    if constexpr (PH == PH_PREP_Q) { const MlaP q = mk_mla(p); SchedMla<0> S{{}, (const char*)(q.Hp + H_CQ), (const char*)q.Wb_uq, c, G}; EpiMla<0> E{q}; ge::gemm_stream<EpiMla<0>, SchedMla<0>, false>(lds, 256, HW, 256, S, E); }
    if constexpr (PH == PH_PREP_K) { const MlaP q = mk_mla(p); SchedMla<1> S{{}, (const char*)(q.Hp + H_CKV), (const char*)q.Wb_uk, (c + 64) % G, G}; EpiMla<1> E{q}; ge::gemm_stream<EpiMla<1>, SchedMla<1>, false>(lds, 256, HW, 256, S, E); }
    if constexpr (PH == PH_PREP_V) { const MlaP q = mk_mla(p); SchedMla<2> S{{}, (const char*)q.Wb_uv, (const char*)(q.Hp + H_CKV), (c + 192) % G, G}; EpiMla<2> E{q}; ge::gemm_stream<EpiMla<2>, SchedMla<2>, false>(lds, 256, 256, HW, S, E); }
    if constexpr (PH == PH_PREP_G) { { const MegaP m = mk_mega(p); SchedIn S{{}, (const char*)m.Xb, (const char*)m.Wb_in, (const char*)m.Wb_gv, (c + 128) % G, G, 1}; EpiIn<0> E{m.Hp, m.GVt, m.ssq_q, m.ssq_kv}; ge::gemm_stream<EpiIn<0>, SchedIn, false>(lds, D, D, D, S, E); } const MlaP q = mk_mla(p); kr_phase(q, c * NTHR + tid_now(), G * NTHR); const GlaP g = mk_gla(p, layer); gla_g1(lds, g, c, G); }
    if constexpr (PH == PH_ATT) { const GlaP g = mk_gla(p, layer); gla_g2(lds, g, c); const MlaP q = mk_mla(p); attn_phase(lds, q, c); }
    if constexpr (PH == PH_FIN) { const GlaP g = mk_gla(p, layer); gla_g3(lds, g, c, G); conv_phase(g, c * NTHR + tid_now(), G * NTHR); attn_combine_bf16(g, c * NTHR + tid_now(), G * NTHR); }
    if constexpr (PH == PH_BR) { SchedBr S{(const char*)p.Yab, (const char*)p.Ybb, (const char*)p.Ycb, (const char*)p.Wb_br, c, G}; EpiBr E{p.Hp, p.Mgb}; ge::gemm_stream<EpiBr, SchedBr, false>(lds, 512, 512, 512, S, E); }
    if constexpr (PH == PH_WO) { SchedT4 S{{}, (const char*)p.Mgb, (const char*)p.Wb_o, 256 * D * 2, 256 * D * 2, c, G}; EpiRes E{p.Db}; ge::gemm_stream<EpiRes, SchedT4, false>(lds, D, D, D, S, E); }
    if constexpr (PH == PH_LN1) ph_ln1_router(p, layer);
    if constexpr (PH == PH_M1) { moe_table(lds, p.cnt + layer * 64); LAS int* te = (LAS int*)(lds + 131072);
        SchedM1 S{{}, (const char*)p.Xb, (const char*)p.Wb_gu, p.lists, te, c, G}; EpiM1 E{p.Hbuf}; ge::gemm_stream<EpiM1, SchedM1, true>(lds, D, D, D, S, E); }
    if constexpr (PH == PH_M2) { moe_table(lds, p.cnt + layer * 64); LAS int* te = (LAS int*)(lds + 131072);
        SchedM2 S{{}, (const char*)p.Hbuf, (const char*)p.Wb_d, te, c, G}; EpiM2 E{p.Ys, p.lists, te}; ge::gemm_stream<EpiM2, SchedM2, false>(lds, EH, EH, EH, S, E); }
    if constexpr (PH == PH_LN2) ph_rows<2>(p, layer);
    if constexpr (PH == PH_PLE) {
        { SchedT4 S{{}, (const char*)(p.Pb + (size_t)layer * T * PLE), (const char*)p.Wb_pu, 256 * PLE * 2, 256 * PLE * 2, c, G}; EpiU E{p.Ub}; ge::gemm_stream<EpiU, SchedT4, false>(lds, PLE, PLE, PLE, S, E); }
        { SchedT4 S{{}, (const char*)p.Xb, (const char*)p.Wb_pg, 256 * D * 2, 256 * D * 2, c, G}; EpiPle E{p.Db, p.Ub, p.b_pg + layer * D}; ge::gemm_stream<EpiPle, SchedT4, false>(lds, D, D, D, S, E); } }
    if constexpr (PH == PH_LN3) ph_rows<3>(p, layer);
}


typedef const P __attribute__((address_space(4))) CP;
__device__ __forceinline__ P load_params() { CP* q = (CP*)__builtin_amdgcn_kernarg_segment_ptr(); asm volatile("" : "+s"(q)); return *(const P*)q; }
#define GRID_BAR() do { XcdBarrier b_; b_.bar = load_params().bar; b_.x = xb_xcc_id(); b_.st = xbw; xcd_barrier(b_); } while (0)
__global__ __launch_bounds__(NTHR, 2) void k_mega(P p_arg) {
    extern __shared__ __attribute__((aligned(16))) unsigned char smem[];
    LAS unsigned char* lds = (LAS unsigned char*)smem;
    const int G = NBLK;
#define c sgpr_now((int)blockIdx.x)
    volatile LAS unsigned* xbw = (volatile LAS unsigned*)(lds + XBW_OFF);
    tid_setup();
    if (tid_now() < 4) xbw[tid_now()] = 0u;
    __syncthreads();
    (void)xcd_barrier_post(p_arg.bar, xbw);
    { const P p = load_params(); ph_prologue(p); }
    { const P p = load_params(); ph_convert(lds, p, 0); }
    GRID_BAR();
    for (int layer = 0; layer < DEPTH; ++layer) {
        { const P p = load_params(); const MegaP m = mk_mega(p); SchedIn S{{}, (const char*)m.Xb, (const char*)m.Wb_in, (const char*)m.Wb_gv, c, G, 0}; EpiIn<2> E{m.Hp, m.GVt, m.ssq_q, m.ssq_kv}; ge::gemm_stream<EpiIn<2>, SchedIn, false>(lds, D, D, D, S, E); }
        GRID_BAR();
        { const P p = load_params(); const MlaP q = mk_mla(p);
          { SchedMla<0> S{{}, (const char*)(q.Hp + H_CQ), (const char*)q.Wb_uq, (c >= 128 ? c - 128 : -1), 128}; EpiMla<0> E{q}; ge::gemm_stream<EpiMla<0>, SchedMla<0>, false>(lds, 256, HW, 256, S, E); }
          { SchedMla<1> S{{}, (const char*)(q.Hp + H_CKV), (const char*)q.Wb_uk, (c >= 128 ? c - 128 : -1), 128}; EpiMla<1> E{q}; ge::gemm_stream<EpiMla<1>, SchedMla<1>, false>(lds, 256, HW, 256, S, E); }
          { SchedMla<2> S{{}, (const char*)q.Wb_uv, (const char*)(q.Hp + H_CKV), (c >= 128 ? c - 128 : -1), 128}; EpiMla<2> E{q}; ge::gemm_stream<EpiMla<2>, SchedMla<2>, false>(lds, 256, 256, HW, S, E); }
          { const MegaP m = mk_mega(p); SchedIn S{{}, (const char*)m.Xb, (const char*)m.Wb_in, (const char*)m.Wb_gv, c, G, 1}; EpiIn<0> E{m.Hp, m.GVt, m.ssq_q, m.ssq_kv}; ge::gemm_stream<EpiIn<0>, SchedIn, false>(lds, D, D, D, S, E); }
          kr_phase(q, c * NTHR + tid_now(), G * NTHR);
          const GlaP g = mk_gla(p, layer); gla_g1(lds, g, c, G); }
        GRID_BAR();
        { const P p = load_params(); const GlaP g = mk_gla(p, layer); gla_g2(lds, g, c); const MlaP q = mk_mla(p); attn_phase(lds, q, c); }
        GRID_BAR();
        { const P p = load_params(); const GlaP g = mk_gla(p, layer); gla_g3(lds, g, c, G); conv_phase(g, c * NTHR + tid_now(), G * NTHR); attn_combine_bf16(g, c * NTHR + tid_now(), G * NTHR); }
        GRID_BAR();
        { const P p = load_params(); SchedBr S{(const char*)p.Yab, (const char*)p.Ybb, (const char*)p.Ycb, (const char*)p.Wb_br, c, G}; EpiBr E{p.Hp, p.Mgb}; ge::gemm_stream<EpiBr, SchedBr, false>(lds, 512, 512, 512, S, E); }
        GRID_BAR();
        { const P p = load_params(); SchedT4 S{{}, (const char*)p.Mgb, (const char*)p.Wb_o, 256 * D * 2, 256 * D * 2, c, G}; EpiRes E{p.Db}; ge::gemm_stream<EpiRes, SchedT4, false>(lds, D, D, D, S, E); }
        GRID_BAR();
        { const P p = load_params(); ph_ln1_router(p, layer); }
        GRID_BAR();
        { const P p = load_params(); moe_table(lds, p.cnt + layer * 64); LAS int* te = (LAS int*)(lds + 131072);
          SchedM1 S{{}, (const char*)p.Xb, (const char*)p.Wb_gu, p.lists, te, c, G}; EpiM1 E{p.Hbuf}; ge::gemm_stream<EpiM1, SchedM1, true>(lds, D, D, D, S, E);
          const int extra = max(0, 2 * te[576] - NBLK), cu = c - extra;
          SchedT4 SU{{}, (const char*)(p.Pb + (size_t)layer * T * PLE), (const char*)p.Wb_pu, 256 * PLE * 2, 256 * PLE * 2, cu >= 0 ? cu : 256, NBLK - extra}; EpiU EU{p.Ub};
          ge::gemm_stream<EpiU, SchedT4, false>(lds, PLE, PLE, PLE, SU, EU); }
        GRID_BAR();
        { const P p = load_params(); LAS int* te = (LAS int*)(lds + 131072);
          SchedM2 S{{}, (const char*)p.Hbuf, (const char*)p.Wb_d, te, c, G}; EpiM2 E{p.Ys, p.lists, te}; ge::gemm_stream<EpiM2, SchedM2, false>(lds, EH, EH, EH, S, E); }
        GRID_BAR();
        { const P p = load_params(); ph_rows<2>(p, layer); }
        GRID_BAR();
        { const P p = load_params(); SchedT4 S{{}, (const char*)p.Xb, (const char*)p.Wb_pg, 256 * D * 2, 256 * D * 2, c, G}; EpiPle E{p.Db, p.Ub, p.b_pg + layer * D}; ge::gemm_stream<EpiPle, SchedT4, false>(lds, D, D, D, S, E); }
        GRID_BAR();
        { const P p = load_params(); ph_rows<3>(p, layer); }
        if (layer + 1 < DEPTH) { { const P p = load_params(); ph_convert(lds, p, layer + 1); } GRID_BAR(); }
    }
#undef c
}

template <int PH> static void launch_ph(const P& p, int layer, hipStream_t st) {
    static bool set = false;
    if (!set) { (void)hipFuncSetAttribute((const void*)k_ph<PH>, hipFuncAttributeMaxDynamicSharedMemorySize, LDS_BYTES); set = true; }
    hipLaunchKernelGGL((k_ph<PH>), dim3(NBLK), dim3(NTHR), LDS_BYTES, st, p, layer);
}
extern "C" void kernel_launch(void* const* d_in, const int* in_sizes, int n_in, void* d_out, int out_size, void* d_ws, size_t ws_size, hipStream_t st) {
    (void)in_sizes; (void)n_in; (void)out_size;
    P p{};
    p.x = (const float*)d_in[0]; p.pin = (const float*)d_in[1]; p.pos = (const int*)d_in[2]; p.ln0_g = (const float*)d_in[3]; p.ln0_b = (const float*)d_in[4];
    p.w_in = (const float*)d_in[5]; p.w_conv = (const float*)d_in[6]; p.w_gg = (const float*)d_in[7]; p.b_gg = (const float*)d_in[8]; p.gla_ng = (const float*)d_in[9];
    p.qn_g = (const float*)d_in[10]; p.kvn_g = (const float*)d_in[11]; p.w_uq = (const float*)d_in[12]; p.w_ukv = (const float*)d_in[13]; p.w_br = (const float*)d_in[14]; p.w_o = (const float*)d_in[15];
    p.ln1_g = (const float*)d_in[16]; p.ln1_b = (const float*)d_in[17]; p.w_grp = (const float*)d_in[18]; p.b_grp = (const float*)d_in[19]; p.w_exp = (const float*)d_in[20]; p.b_exp = (const float*)d_in[21];
    p.w_gate = (const float*)d_in[22]; p.w_up = (const float*)d_in[23]; p.w_down = (const float*)d_in[24]; p.ln2_g = (const float*)d_in[25]; p.ln2_b = (const float*)d_in[26];
    p.w_pg = (const float*)d_in[27]; p.b_pg = (const float*)d_in[28]; p.w_pu = (const float*)d_in[29]; p.ln3_g = (const float*)d_in[30]; p.ln3_b = (const float*)d_in[31];
    p.out = (float*)d_out;
    char* w = (char*)d_ws; size_t off = 0;
    auto alloc = [&](size_t bytes) { void* r = w + off; off += (bytes + 255) & ~(size_t)255; return r; };
    p.bar = (unsigned*)alloc(16384); p.cnt = (int*)alloc(DEPTH * 64 * 4);
    const size_t zero_bytes = off;
    p.X = (float*)alloc((size_t)T * D * 4); p.Z = (float*)alloc((size_t)T * D * 4); p.Xb = (bf16_t*)alloc((size_t)T * D * 2); p.Db = (bf16_t*)alloc((size_t)T * D * 2);
    p.cs = (float*)alloc((size_t)T * 32 * 4); p.sn = (float*)alloc((size_t)T * 32 * 4); p.ssq_q = (float*)alloc((size_t)4 * T * 4); p.ssq_kv = (float*)alloc((size_t)4 * T * 4);
    p.Hp = (bf16_t*)alloc((size_t)T * HW * 2); p.GVt = (bf16_t*)alloc((size_t)T * 512 * 2);
    p.Qb = (bf16_t*)alloc((size_t)T * 768 * 2); p.KnImg = (bf16_t*)alloc((size_t)T * 512 * 2); p.VtImg = (bf16_t*)alloc((size_t)T * 512 * 2); p.KrImg = (bf16_t*)alloc((size_t)T * 64 * 2);
    p.MLpart = (float*)alloc((size_t)512 * 256 * 2 * 4);
    p.QE = (bf16_t*)alloc((size_t)T * 256 * 2); p.OI = (float*)alloc((size_t)T * 512 * 4); p.kvT = (float*)alloc((size_t)1024 * 8192 * 4); p.decay = (float*)alloc((size_t)1024 * 64 * 4); p.spT = (bf16_t*)alloc((size_t)1024 * 8192 * 2);
    p.Yab = (bf16_t*)alloc((size_t)T * 512 * 2); p.Ybb = (bf16_t*)alloc((size_t)T * 512 * 2); p.Ycb = (bf16_t*)alloc((size_t)T * 512 * 2); p.Mgb = (bf16_t*)alloc((size_t)T * D * 2);
    p.ew = (float*)alloc((size_t)T * 2 * 4); p.lists = (int*)alloc((size_t)NE * LCAP * 4);
    p.Hbuf = (bf16_t*)alloc((size_t)192 * 256 * EH * 2); p.Ys = (bf16_t*)alloc((size_t)2 * T * D * 2); p.Ub = (bf16_t*)alloc((size_t)T * D * 2); p.Pb = (bf16_t*)alloc((size_t)DEPTH * T * PLE * 2);
    p.Wb_in = (bf16_t*)alloc((size_t)HW * D * 2); p.Wb_gv = (bf16_t*)alloc((size_t)512 * D * 2); p.Wb_uq = (bf16_t*)alloc((size_t)768 * 256 * 2); p.Wb_uk = (bf16_t*)alloc((size_t)512 * 256 * 2); p.Wb_uv = (bf16_t*)alloc((size_t)512 * 256 * 2);
    p.Wb_br = (bf16_t*)alloc((size_t)3 * D * 512 * 2); p.Wb_o = (bf16_t*)alloc((size_t)D * D * 2); p.Wb_gu = (bf16_t*)alloc((size_t)NE * 512 * D * 2); p.Wb_d = (bf16_t*)alloc((size_t)NE * D * EH * 2);
    p.Wb_pg = (bf16_t*)alloc((size_t)D * D * 2); p.Wb_pu = (bf16_t*)alloc((size_t)D * PLE * 2);
    if (off > ws_size) return;
    (void)hipMemsetAsync(d_ws, 0, zero_bytes, st);
#if defined(MULTI_LAUNCH)
    launch_ph<PH_PRO>(p, 0, st);
    for (int i = 0; i < DEPTH; ++i) {
        launch_ph<PH_CONV>(p, i, st); launch_ph<PH_IN>(p, i, st);
        launch_ph<PH_PREP_Q>(p, i, st); launch_ph<PH_PREP_K>(p, i, st); launch_ph<PH_PREP_V>(p, i, st); launch_ph<PH_PREP_G>(p, i, st);
        launch_ph<PH_ATT>(p, i, st); launch_ph<PH_FIN>(p, i, st); launch_ph<PH_BR>(p, i, st); launch_ph<PH_WO>(p, i, st); launch_ph<PH_LN1>(p, i, st);
        launch_ph<PH_M1>(p, i, st); launch_ph<PH_M2>(p, i, st); launch_ph<PH_LN2>(p, i, st); launch_ph<PH_PLE>(p, i, st); launch_ph<PH_LN3>(p, i, st);
    }
#else
    static bool set = false;
    if (!set) { (void)hipFuncSetAttribute((const void*)k_mega, hipFuncAttributeMaxDynamicSharedMemorySize, LDS_BYTES); set = true; }
    hipLaunchKernelGGL(k_mega, dim3(NBLK), dim3(NTHR), LDS_BYTES, st, p);
#endif
}
```

```cpp
#include <hip/hip_runtime.h>
#include <hip/hip_bf16.h>
#include <stdint.h>

constexpr int T = 16384, D = 1024, DEPTH = 4, PLE = 256;
constexpr int NE = 64, EH = 256;
constexpr int INW = 6608;
constexpr int O_GV = 2048;
constexpr float DN_ALPHA = 1.681792830507429f;
constexpr int LCAP = 32768;
#define LAS __attribute__((address_space(3)))
typedef unsigned short bf16_t;
typedef short bf16x8 __attribute__((ext_vector_type(8)));
typedef float f32x4 __attribute__((ext_vector_type(4)));
typedef float f32x16 __attribute__((ext_vector_type(16)));
typedef unsigned u32x4 __attribute__((ext_vector_type(4)));
typedef unsigned u32x2 __attribute__((ext_vector_type(2)));
typedef float f32x2 __attribute__((ext_vector_type(2)));
constexpr int NBLK = 256, NTHR = 512;
constexpr int STAGE_BYTES = 131072, LDS_BYTES = 147456 + 512, XBW_OFF = 147456 + 256;
constexpr int HW = 6144;
constexpr int H_AB = 0, H_AC = 512, H_AX = 1024, H_GQ = 1536, H_GK = 1792, H_GR = 2048, H_CQ = 2560, H_CKV = 2816, H_KR = 2944, H_GLR = 3008, H_GTA = 3072, H_GTB = 4096, H_GTC = 5120;

__device__ __forceinline__ unsigned cvt_pk_bf16(float lo, float hi) { unsigned r; asm volatile("v_cvt_pk_bf16_f32 %0, %1, %2" : "=v"(r) : "v"(lo), "v"(hi)); return r; }
constexpr int WTAB_OFF = 147456;
__device__ __forceinline__ int tid_now() {
    const unsigned hw = (unsigned)__builtin_amdgcn_s_getreg((5 << 11) | 4) & 63u;
    extern __shared__ __attribute__((aligned(16))) unsigned char smem_tid[];
    const int w = __builtin_amdgcn_readfirstlane(*(volatile LAS int*)((LAS unsigned char*)smem_tid + WTAB_OFF + 4 * hw));
    int l = (int)__builtin_amdgcn_mbcnt_hi(~0u, __builtin_amdgcn_mbcnt_lo(~0u, 0u));
    asm volatile("" : "+v"(l));
    return w * 64 + l; }
__device__ __forceinline__ void tid_setup() {
    const unsigned hw = (unsigned)__builtin_amdgcn_s_getreg((5 << 11) | 4) & 63u;
    extern __shared__ __attribute__((aligned(16))) unsigned char smem_tid[];
    if ((threadIdx.x & 63) == 0) *(volatile LAS int*)((LAS unsigned char*)smem_tid + WTAB_OFF + 4 * hw) = (int)(threadIdx.x >> 6);
    __syncthreads(); }
__device__ __forceinline__ int sgpr_now(int v) { asm volatile("" : "+s"(v)); return v; }
__device__ __forceinline__ float shx(float v, int mask, int lane) { return __int_as_float(__builtin_amdgcn_ds_bpermute((lane ^ mask) << 2, __float_as_int(v))); }
__device__ __forceinline__ float frcp(float x) { return __builtin_amdgcn_rcpf(x); }
__device__ __forceinline__ float bf2f(bf16_t b) { return __uint_as_float(((unsigned)b) << 16); }
__device__ __forceinline__ float bflo(unsigned w) { return __uint_as_float(w << 16); }
__device__ __forceinline__ float bfhi(unsigned w) { return __uint_as_float(w & 0xffff0000u); }

namespace ge {
constexpr int BM = 256, BK = 64, HALF = 128, HTB = HALF * BK * 2;
__device__ __forceinline__ int lds_byte(int r, int c) { const int st = (r >> 4) * 2 + (c >> 5), rr = r & 15, cc = c & 31, ob = rr * 64 + cc * 2; return st * 1024 + (ob ^ (((ob >> 9) & 1) << 5)); }
__device__ __forceinline__ void stage_rc(int b, int& R, int& C) { const int st = b / 1024, sb = b % 1024, swz = sb ^ (((sb >> 9) & 1) << 5); R = (st >> 1) * 16 + swz / 64; C = (st & 1) * 32 + (swz % 64) / 2; }
__device__ __forceinline__ int perm32(int rho) { const int n = rho >> 4, i = rho & 15; return 8 * (i >> 2) + 4 * n + (i & 3); }
struct Unit { int pm, pn, g; };
typedef f32x4 Acc[2][2][4][2];
struct NoCarry { __device__ __forceinline__ bool carry(const struct Unit&) const { return false; } };

template <class Epi, class Sched, bool GATHER>
__device__ __forceinline__ void gemm_stream(LAS unsigned char* lds, const int K, const int lda, const int ldb, const Sched& S, const Epi& E) {
    const int tid = tid_now(), wid = __builtin_amdgcn_readfirstlane(tid >> 6), lane = tid & 63, wr = wid >> 2, wc = wid & 3, fr = lane & 15, fq = lane >> 4;
    const int nt = K / BK;
    Unit cur, nxt; int ui = 0;
    if (!S.next(0, cur)) return;
    unsigned voffA[2][2], nvoffA[2][2], voffB[2][2];
#pragma unroll
    for (int i = 0; i < 2; ++i) { int R, C; stage_rc(tid * 16 + i * 8192, R, C); const int Rb = (R & ~31) + perm32(R & 31);
        voffB[0][i] = (unsigned)(Rb * ldb + C) * 2u; voffB[1][i] = (unsigned)((Rb + 128) * ldb + C) * 2u;
        if constexpr (GATHER) { voffA[0][i] = (unsigned)(S.arow(cur, R) * lda + C) * 2u; voffA[1][i] = (unsigned)(S.arow(cur, R + 128) * lda + C) * 2u; }
        else { voffA[0][i] = (unsigned)(R * lda + C) * 2u; voffA[1][i] = (unsigned)((R + 128) * lda + C) * 2u; }
        nvoffA[0][i] = voffA[0][i]; nvoffA[1][i] = voffA[1][i]; }
    const size_t kstep = (size_t)(BK * 2);
    const unsigned ldsw = (unsigned)wid * 1024u;
    const int aoff = lds_byte(wr * 64 + fr, fq * 8), boff = lds_byte(wc * 32 + fr, fq * 8);
#define GE_SA(b, h) (((b) * 2 + (h)) * HTB)
#define GE_SB(b, h) ((4 + (b) * 2 + (h)) * HTB)
#define GE_STAGE(bufoff, gbase, voff) do { _Pragma("unroll") for (int _i = 0; _i < 2; ++_i) \
        __builtin_amdgcn_global_load_lds((const unsigned*)((const char*)(gbase) + (voff)[_i]), (LAS unsigned*)(lds + (bufoff) + ldsw + _i * 8192), 16, 0, 0); } while (0)
#define GE_LDA(dst, b, h) do { _Pragma("unroll") for (int m = 0; m < 4; ++m) _Pragma("unroll") for (int k = 0; k < 2; ++k) dst[m][k] = *(const LAS bf16x8*)(lds + GE_SA(b, h) + aoff + m * 2048 + k * 1024); } while (0)
#define GE_LDB(dst, b, h) do { _Pragma("unroll") for (int n = 0; n < 2; ++n) _Pragma("unroll") for (int k = 0; k < 2; ++k) dst[n][k] = *(const LAS bf16x8*)(lds + GE_SB(b, h) + boff + n * 2048 + k * 1024); } while (0)
#define GE_MMA(ai, bj, At, Bt) do { __builtin_amdgcn_s_setprio(1); _Pragma("unroll") for (int m = 0; m < 4; ++m) _Pragma("unroll") for (int n = 0; n < 2; ++n) _Pragma("unroll") for (int k = 0; k < 2; ++k) \
        acc[ai][bj][m][n] = __builtin_amdgcn_mfma_f32_16x16x32_bf16(Bt[n][k], At[m][k], acc[ai][bj][m][n], 0, 0, 0); __builtin_amdgcn_s_setprio(0); } while (0)
#define GE_WAIT_V(n) asm volatile("s_waitcnt vmcnt(" #n ")" ::: "memory")
#define GE_WAIT_L(n) asm volatile("s_waitcnt lgkmcnt(" #n ")" ::: "memory")
#define GE_BAR __builtin_amdgcn_s_barrier()
#define GE_SCHED __builtin_amdgcn_sched_barrier(0)
    Acc acc;
#pragma unroll
    for (int a = 0; a < 2; ++a)
#pragma unroll
        for (int b = 0; b < 2; ++b)
#pragma unroll
            for (int m = 0; m < 4; ++m)
#pragma unroll
                for (int n = 0; n < 2; ++n) acc[a][b][m][n] = (f32x4){0.f, 0.f, 0.f, 0.f};
    bf16x8 At[4][2], B0[2][2], B1[2][2];
    const char* cA = S.aptr(cur); const char* cB = S.bptr(cur);
    GE_STAGE(GE_SB(0, 0), cB, voffB[0]); GE_STAGE(GE_SA(0, 0), cA, voffA[0]); GE_STAGE(GE_SB(0, 1), cB, voffB[1]); GE_STAGE(GE_SA(0, 1), cA, voffA[1]);
    if (wr == 1) GE_BAR;
    GE_WAIT_V(4); GE_BAR;
    GE_STAGE(GE_SB(1, 0), cB + kstep, voffB[0]); GE_STAGE(GE_SA(1, 0), cA + kstep, voffA[0]); GE_STAGE(GE_SB(1, 1), cB + kstep, voffB[1]);
    GE_WAIT_V(6); GE_BAR;
    for (;;) {
        const bool has_next = S.next(ui + 1, nxt);
        const char* nA = has_next ? S.aptr(nxt) : cA; const char* nB = has_next ? S.bptr(nxt) : cB;
#pragma unroll 1
        for (int t = 0; t < nt; t += 2) {
            const bool last = (t == nt - 2);
            const char* a1 = cA + (size_t)(t + 1) * kstep;
            const char* a2 = last ? nA : cA + (size_t)(t + 2) * kstep; const char* b2 = last ? nB : cB + (size_t)(t + 2) * kstep;
            const char* a3 = a2 + kstep; const char* b3 = b2 + kstep;
            if constexpr (GATHER) { if (last && has_next) {
#pragma unroll
                for (int i = 0; i < 2; ++i) { int R, C; stage_rc(tid * 16 + i * 8192, R, C);
                    nvoffA[0][i] = (unsigned)(S.arow(nxt, R) * lda + C) * 2u; nvoffA[1][i] = (unsigned)(S.arow(nxt, R + 128) * lda + C) * 2u; } } }
            unsigned va2[2][2];
#pragma unroll
            for (int h = 0; h < 2; ++h)
#pragma unroll
                for (int i = 0; i < 2; ++i) va2[h][i] = (GATHER && last) ? nvoffA[h][i] : voffA[h][i];
            GE_LDB(B0, 0, 0); GE_SCHED; GE_LDA(At, 0, 0); GE_STAGE(GE_SA(1, 1), a1, voffA[1]);
            GE_WAIT_L(8); GE_BAR; GE_WAIT_L(0); GE_MMA(0, 0, At, B0); GE_BAR; GE_SCHED;
            GE_LDB(B1, 0, 1); GE_STAGE(GE_SB(0, 0), b2, voffB[0]);
            GE_BAR; GE_WAIT_L(0); GE_MMA(0, 1, At, B1); GE_BAR;
            GE_LDA(At, 0, 1); GE_STAGE(GE_SA(0, 0), a2, va2[0]);
            GE_BAR; GE_WAIT_L(0); GE_MMA(1, 0, At, B0); GE_BAR; GE_SCHED;
            GE_STAGE(GE_SB(0, 1), b2, voffB[1]);
            GE_WAIT_V(6); GE_BAR; GE_MMA(1, 1, At, B1); GE_BAR;
            GE_LDB(B0, 1, 0); GE_SCHED; GE_LDA(At, 1, 0); GE_STAGE(GE_SA(0, 1), a2, va2[1]);
            GE_WAIT_L(8); GE_BAR; GE_WAIT_L(0); GE_MMA(0, 0, At, B0); GE_BAR; GE_SCHED;
            GE_LDB(B1, 1, 1); GE_STAGE(GE_SB(1, 0), b3, voffB[0]);
            GE_BAR; GE_WAIT_L(0); GE_MMA(0, 1, At, B1); GE_BAR;
            GE_LDA(At, 1, 1); GE_STAGE(GE_SA(1, 0), a3, va2[0]);
            GE_BAR; GE_WAIT_L(0); GE_MMA(1, 0, At, B0); GE_BAR; GE_SCHED;
            GE_STAGE(GE_SB(1, 1), b3, voffB[1]);
            GE_WAIT_V(6); GE_BAR; GE_MMA(1, 1, At, B1); GE_BAR;
        }
        { int tz = tid; asm volatile("" : "+v"(tz));
          const int wid2 = tz >> 6, lane2 = tz & 63; E(acc, cur, wid2 >> 2, wid2 & 3, lane2 & 15, lane2 >> 4); }
        if (!has_next) break;
        if (!S.carry(cur)) {
#pragma unroll
        for (int a = 0; a < 2; ++a)
#pragma unroll
            for (int b = 0; b < 2; ++b)
#pragma unroll
                for (int m = 0; m < 4; ++m)
#pragma unroll
                    for (int n = 0; n < 2; ++n) acc[a][b][m][n] = (f32x4){0.f, 0.f, 0.f, 0.f}; }
        cur = nxt; cA = nA; cB = nB; ++ui;
        if (GATHER) {
#pragma unroll
            for (int h = 0; h < 2; ++h)
#pragma unroll
                for (int i = 0; i < 2; ++i) voffA[h][i] = nvoffA[h][i]; }
    }
    GE_WAIT_V(0);
    if (wr == 0) GE_BAR;
    GE_BAR;
#undef GE_SA
#undef GE_SB
#undef GE_STAGE
#undef GE_LDA
#undef GE_LDB
#undef GE_MMA
#undef GE_WAIT_V
#undef GE_WAIT_L
#undef GE_BAR
#undef GE_SCHED
}
__device__ __forceinline__ void tile_order(int L, int nM, int nN, int& pm, int& pn) {
    const int nwg = nM * nN; int wgid = L;
    { const int q = nwg / 8, r = nwg % 8, xcd = wgid % 8, off = wgid / 8; wgid = (xcd < r ? xcd * (q + 1) : r * (q + 1) + (xcd - r) * q) + off; }
    const int nig = 8 * nN, gid = wgid / nig, fm = gid * 8, gsz = (nM - fm) < 8 ? (nM - fm) : 8;
    pm = fm + ((wgid % nig) % gsz); pn = (wgid % nig) / gsz;
}
}
struct MapInMain { __device__ __forceinline__ int operator()(int s) const {
    if (s < 2048) return s;
    if (s < 2560) return 2576 + (s - 2048);
    if (s < 2816) return 3088 + (s - 2560);
    if (s < 2944) return 3344 + (s - 2816);
    if (s < 3008) return 3472 + (s - 2944);
    if (s < 3024) return 2560 + (s - 3008);
    if (s < 3072) return -1;
    return 3536 + (s - 3072); } };
struct MapOff { int off; __device__ __forceinline__ int operator()(int s) const { return off + s; } };struct MegaP {
    const float* w_in; bf16_t* Wb_in; bf16_t* Wb_gv; const bf16_t* Xb; bf16_t* Hp; bf16_t* GVt; float* ssq_q; float* ssq_kv;
};
struct SchedIn : ge::NoCarry {
    const char* Xb; const char* Wm; const char* Wg; int c, G, gv;
    __device__ __forceinline__ bool next(int i, ge::Unit& u) const {
        const int L = i * G + c;
        if (gv) { if (L >= 128) return false; u.g = 0; u.pm = L >> 1; u.pn = 8 + (L & 1); return true; }
        if (L >= 1536) return false;
        if (L < 1408) { u.g = 0; ge::tile_order(L, 64, 22, u.pm, u.pn); if (u.pn >= 8) u.pn += 2; } else { u.g = 1; const int l = L - 1408; u.pm = l & 1; u.pn = l >> 1; }
        return true; }
    __device__ __forceinline__ const char* aptr(const ge::Unit& u) const { return u.g == 0 ? Xb + (size_t)u.pm * 256 * D * 2 : Wg + (size_t)u.pm * 256 * D * 2; }
    __device__ __forceinline__ const char* bptr(const ge::Unit& u) const { return u.g == 0 ? Wm + (size_t)u.pn * 256 * D * 2 : Xb + (size_t)u.pn * 256 * D * 2; }
};
template <int GV> struct EpiIn {
    bf16_t* Hp; bf16_t* GVt; float* ssq_q; float* ssq_kv;
    __device__ __forceinline__ void operator()(ge::Acc& acc, const ge::Unit& u, int wr, int wc, int fr, int fq) const {
        if (GV == 0 || (GV == 2 && u.g == 0)) {
            const int row0 = u.pm * 256 + wr * 64 + fr, col0 = u.pn * 256 + wc * 32 + 8 * fq;
            const bool sg = u.pn >= 12;
#pragma unroll
            for (int ai = 0; ai < 2; ++ai)
#pragma unroll
                for (int m = 0; m < 4; ++m) { const int row = row0 + ai * 128 + m * 16; bf16_t* rp = Hp + (size_t)row * HW + col0;
                    float sq0 = 0.f, sq1 = 0.f;
#pragma unroll
                    for (int bj = 0; bj < 2; ++bj) { f32x4 v0 = acc[ai][bj][m][0], v1 = acc[ai][bj][m][1];
                        if (sg) {
#pragma unroll
                            for (int j = 0; j < 4; ++j) { v0[j] = frcp(1.f + __expf(-v0[j])); v1[j] = frcp(1.f + __expf(-v1[j])); } }
                        const float s = v0[0] * v0[0] + v0[1] * v0[1] + v0[2] * v0[2] + v0[3] * v0[3] + v1[0] * v1[0] + v1[1] * v1[1] + v1[2] * v1[2] + v1[3] * v1[3];
                        if (bj == 0) sq0 = s; else sq1 = s;
                        u32x4 o = {cvt_pk_bf16(v0[0], v0[1]), cvt_pk_bf16(v0[2], v0[3]), cvt_pk_bf16(v1[0], v1[1]), cvt_pk_bf16(v1[2], v1[3])};
                        *(u32x4*)(rp + bj * 128) = o; }
                    if (u.pn == 10 || u.pn == 11) {
                        float s = (u.pn == 10) ? (sq0 + sq1) : sq0;
                        { const int ln = fq * 16 + fr; s += shx(s, 16, ln); s += shx(s, 32, ln); }
                        if (fq == 0) { float* dst = (u.pn == 10 ? ssq_q : ssq_kv); dst[(size_t)wc * T + row] = s; } } }
        } else {
#pragma unroll
            for (int ai = 0; ai < 2; ++ai)
#pragma unroll
                for (int m = 0; m < 4; ++m) { const int r = u.pm * 256 + ai * 128 + wr * 64 + m * 16 + fr, h = r >> 7, e = r & 127;
#pragma unroll
                    for (int bj = 0; bj < 2; ++bj) { const int t0 = u.pn * 256 + bj * 128 + wc * 32 + 8 * fq;
                        const int chunk = t0 >> 6, p0 = (t0 & 48) + ((t0 & 8) >> 1);
                        bf16_t* base = GVt + ((size_t)(chunk * 4 + h) * 128 + e) * 64;
                        const f32x4 v0 = acc[ai][bj][m][0], v1 = acc[ai][bj][m][1];
                        u32x2 o0 = {cvt_pk_bf16(v0[0], v0[1]), cvt_pk_bf16(v0[2], v0[3])}, o1 = {cvt_pk_bf16(v1[0], v1[1]), cvt_pk_bf16(v1[2], v1[3])};
                        *(u32x2*)(base + p0) = o0; *(u32x2*)(base + p0 + 8) = o1; } }
        }
    }
};
constexpr float QSCALE = 0.07216878364870322f * 1.4426950408889634f;
struct MapQ { __device__ __forceinline__ int operator()(int s) const {
    if (s < 512) return (s >> 7) * 192 + (s & 127);
    const int s2 = s - 512, bj = s2 >> 7, w = s2 & 127; return (w >> 5) * 192 + 128 + bj * 32 + (w & 31); } };
struct MapKV { int voff; __device__ __forceinline__ int operator()(int s) const { return (s >> 7) * 256 + voff + (s & 127); } };

struct MlaP {
    const float* w_uq; const float* w_ukv; const float* qn_g; const float* kvn_g;
    bf16_t* Wb_uq; bf16_t* Wb_uk; bf16_t* Wb_uv;
    const bf16_t* Hp; const float* ssq_q; const float* ssq_kv; const float* cs; const float* sn;
    bf16_t* Qb; bf16_t* KnImg; bf16_t* VtImg; bf16_t* KrImg; float* Opart; float* MLpart; float* Yc;
};
__device__ __forceinline__ float rstd4(const float* ssq, int row, float invw) {
    const float s = (ssq[row] + ssq[T + row]) + (ssq[2 * T + row] + ssq[3 * T + row]); return rsqrtf(s * invw + 1e-6f); }

template <int mode> struct SchedMla : ge::NoCarry { const char* A; const char* B; int c, G;
    __device__ __forceinline__ bool next(int i, ge::Unit& u) const {
        if (c < 0) return false;
        const int L = i * G + c; u.g = mode;
        if (mode == 0) { if (L >= 192) return false; u.pm = L / 3; u.pn = L % 3; }
        else if (mode == 1) { if (L >= 128) return false; u.pm = L >> 1; u.pn = L & 1; }
        else { if (L >= 128) return false; u.pm = L & 1; u.pn = L >> 1; }
        return true; }
    __device__ __forceinline__ const char* aptr(const ge::Unit& u) const { return mode == 2 ? A + (size_t)u.pm * 256 * 256 * 2 : A + (size_t)u.pm * 256 * HW * 2; }
    __device__ __forceinline__ const char* bptr(const ge::Unit& u) const { return mode == 2 ? B + (size_t)u.pn * 256 * HW * 2 : B + (size_t)u.pn * 256 * 256 * 2; }
};
template <int MODE> struct EpiMla { MlaP p;
    __device__ __forceinline__ void operator()(ge::Acc& acc, const ge::Unit& u, int wr, int wc, int fr, int fq) const {
        if constexpr (MODE == 0) {
            float rsv[2][4];
#pragma unroll
            for (int ai = 0; ai < 2; ++ai)
#pragma unroll
                for (int m = 0; m < 4; ++m) rsv[ai][m] = rstd4(p.ssq_q, u.pm * 256 + ai * 128 + wr * 64 + m * 16 + fr, 1.f / 256.f) * QSCALE;
#pragma unroll
            for (int ai = 0; ai < 2; ++ai) {
#pragma unroll
                for (int m = 0; m < 4; ++m) { const int t = u.pm * 256 + ai * 128 + wr * 64 + m * 16 + fr; const float rs = rsv[ai][m];
                    if (u.pn < 2) {
#pragma unroll
                        for (int bj = 0; bj < 2; ++bj) { const int c0 = u.pn * 256 + bj * 128 + wc * 32 + 8 * fq, head = c0 >> 7, dim = c0 & 127;
                            const f32x4 v0 = acc[ai][bj][m][0] * rs, v1 = acc[ai][bj][m][1] * rs;
                            u32x4 o = {cvt_pk_bf16(v0[0], v0[1]), cvt_pk_bf16(v0[2], v0[3]), cvt_pk_bf16(v1[0], v1[1]), cvt_pk_bf16(v1[2], v1[3])};
                            *(u32x4*)(p.Qb + (size_t)t * 768 + head * 192 + dim) = o; }
                    } else { const int head = wc, i0 = 8 * fq;
                        float o1[8], o2[8];
#pragma unroll
                        for (int n = 0; n < 2; ++n) { const f32x4 c4 = *(const f32x4*)(p.cs + (size_t)t * 32 + i0 + 4 * n), s4 = *(const f32x4*)(p.sn + (size_t)t * 32 + i0 + 4 * n);
#pragma unroll
                            for (int j = 0; j < 4; ++j) { const float x1 = acc[ai][0][m][n][j] * rs, x2 = acc[ai][1][m][n][j] * rs; o1[4 * n + j] = x1 * c4[j] - x2 * s4[j]; o2[4 * n + j] = x1 * s4[j] + x2 * c4[j]; } }
                        u32x4 a = {cvt_pk_bf16(o1[0], o1[1]), cvt_pk_bf16(o1[2], o1[3]), cvt_pk_bf16(o1[4], o1[5]), cvt_pk_bf16(o1[6], o1[7])};
                        u32x4 b = {cvt_pk_bf16(o2[0], o2[1]), cvt_pk_bf16(o2[2], o2[3]), cvt_pk_bf16(o2[4], o2[5]), cvt_pk_bf16(o2[6], o2[7])};
                        *(u32x4*)(p.Qb + (size_t)t * 768 + head * 192 + 128 + i0) = a; *(u32x4*)(p.Qb + (size_t)t * 768 + head * 192 + 160 + i0) = b; } } }
        } else if constexpr (MODE == 1) {
            float rsv[2][4];
#pragma unroll
            for (int ai = 0; ai < 2; ++ai)
#pragma unroll
                for (int m = 0; m < 4; ++m) rsv[ai][m] = rstd4(p.ssq_kv, u.pm * 256 + ai * 128 + wr * 64 + m * 16 + fr, 1.f / 128.f);
            asm volatile("" ::: "memory");
#pragma unroll
            for (int ai = 0; ai < 2; ++ai)
#pragma unroll
                for (int m = 0; m < 4; ++m) { const int t = u.pm * 256 + ai * 128 + wr * 64 + m * 16 + fr; const float rs = rsv[ai][m];
                    const int tile = t >> 6, key = t & 63;
#pragma unroll
                    for (int bj = 0; bj < 2; ++bj) { const int c0 = u.pn * 256 + bj * 128 + wc * 32 + 8 * fq, head = c0 >> 7, chunk = (c0 & 127) >> 3;
                        const f32x4 v0 = acc[ai][bj][m][0] * rs, v1 = acc[ai][bj][m][1] * rs;
                        u32x4 o = {cvt_pk_bf16(v0[0], v0[1]), cvt_pk_bf16(v0[2], v0[3]), cvt_pk_bf16(v1[0], v1[1]), cvt_pk_bf16(v1[2], v1[3])};
                        *(u32x4*)((char*)p.KnImg + ((size_t)(head * 256 + tile) * 16384) + key * 256 + ((chunk ^ (key & 15)) << 4)) = o; } }
        } else {
#pragma unroll
            for (int bj = 0; bj < 2; ++bj) { const int t0 = u.pn * 256 + bj * 128 + wc * 32 + 8 * fq;
                float rs[8];
#pragma unroll
                for (int j = 0; j < 8; ++j) rs[j] = rstd4(p.ssq_kv, t0 + j, 1.f / 128.f);
                const int tile = t0 >> 6, p0 = (t0 & 48) + ((t0 & 8) >> 1);
#pragma unroll
                for (int ai = 0; ai < 2; ++ai)
#pragma unroll
                    for (int m = 0; m < 4; ++m) { asm volatile("" ::: "memory"); const int r = u.pm * 256 + ai * 128 + wr * 64 + m * 16 + fr, head = r >> 7, d = r & 127;
                        char* base = (char*)p.VtImg + ((size_t)(head * 256 + tile) * 16384) + d * 128;
                        const f32x4 v0 = acc[ai][bj][m][0], v1 = acc[ai][bj][m][1];
                        u32x2 o0 = {cvt_pk_bf16(v0[0] * rs[0], v0[1] * rs[1]), cvt_pk_bf16(v0[2] * rs[2], v0[3] * rs[3])};
                        u32x2 o1 = {cvt_pk_bf16(v1[0] * rs[4], v1[1] * rs[5]), cvt_pk_bf16(v1[2] * rs[6], v1[3] * rs[7])};
                        const int sw = (d >> 1) & 7, pa = p0, pb = p0 + 8;
                        *(u32x2*)(base + (((pa >> 3) ^ sw) << 4) + (pa & 7) * 2) = o0;
                        *(u32x2*)(base + (((pb >> 3) ^ sw) << 4) + (pb & 7) * 2) = o1; } }
        }
    }
};
__device__ __forceinline__ void kr_phase(const MlaP& p, int gtid, int gthreads) {
    for (int idx = gtid; idx < T * 4; idx += gthreads) { const int t = idx >> 2, c = idx & 3, i0 = 8 * c;
        const u32x4 a = *(const u32x4*)(p.Hp + (size_t)t * HW + H_KR + i0), b = *(const u32x4*)(p.Hp + (size_t)t * HW + H_KR + 32 + i0);
        float o1[8], o2[8];
#pragma unroll
        for (int n = 0; n < 2; ++n) { const f32x4 c4 = *(const f32x4*)(p.cs + (size_t)t * 32 + i0 + 4 * n), s4 = *(const f32x4*)(p.sn + (size_t)t * 32 + i0 + 4 * n);
#pragma unroll
            for (int j = 0; j < 4; ++j) { const int e = 4 * n + j; const unsigned wa = a[e >> 1], wb = b[e >> 1];
                const float x1 = (e & 1) ? bfhi(wa) : bflo(wa), x2 = (e & 1) ? bfhi(wb) : bflo(wb);
                o1[e] = x1 * c4[j] - x2 * s4[j]; o2[e] = x1 * s4[j] + x2 * c4[j]; } }
        u32x4 oa = {cvt_pk_bf16(o1[0], o1[1]), cvt_pk_bf16(o1[2], o1[3]), cvt_pk_bf16(o1[4], o1[5]), cvt_pk_bf16(o1[6], o1[7])};
        u32x4 ob = {cvt_pk_bf16(o2[0], o2[1]), cvt_pk_bf16(o2[2], o2[3]), cvt_pk_bf16(o2[4], o2[5]), cvt_pk_bf16(o2[6], o2[7])};
        const int tile = t >> 6, key = t & 63, sw = (key >> 1) & 7;
        char* base = (char*)p.KrImg + (size_t)tile * 8192 + key * 128;
        *(u32x4*)(base + ((c ^ sw) << 4)) = oa; *(u32x4*)(base + (((c + 4) ^ sw) << 4)) = ob; }
}
constexpr int ATT_STEPS = 130;
__device__ __forceinline__ void attn_item(LAS unsigned char* lds, const MlaP& p, int head, int b, int j0, int j1, int slot) {
    const int tid = tid_now(), wid = __builtin_amdgcn_readfirstlane(tid >> 6), lane = tid & 63, q = lane & 31, hh = lane >> 5;
    const int grp = wid >> 2, n = j1 - j0;
    const int trow = b * 256 + wid * 32 + q;
    bf16x8 qf[12];
    { const bf16_t* qp = p.Qb + (size_t)trow * 768 + head * 192 + 8 * hh;
#pragma unroll
      for (int s = 0; s < 12; ++s) qf[s] = *(const bf16x8*)(qp + 16 * s); }
    f32x16 O[4];
#pragma unroll
    for (int d = 0; d < 4; ++d)
#pragma unroll
        for (int r = 0; r < 16; ++r) O[d][r] = 0.f;
    float m_run = -1e30f, l_run = 0.f;
    const char* knb = (const char*)p.KnImg + (size_t)head * 256 * 16384; const char* vtb = (const char*)p.VtImg + (size_t)head * 256 * 16384; const char* krb = (const char*)p.KrImg;
    const unsigned lo = (unsigned)lane * 16u;
    constexpr int KB = 24576, VOFF = 3 * KB, VB = 16384;
#define AT_ISSUE(k) do { const unsigned _ko = (unsigned)((k) % 3) * KB, _vo = VOFF + (unsigned)((k) & 3) * VB; const size_t _j = (size_t)(j0 + (k)); \
        __builtin_amdgcn_global_load_lds((const unsigned*)(knb + _j * 16384 + (wid * 2) * 1024 + lo), (LAS unsigned*)(lds + _ko + (wid * 2) * 1024), 16, 0, 0); \
        __builtin_amdgcn_global_load_lds((const unsigned*)(knb + _j * 16384 + (wid * 2 + 1) * 1024 + lo), (LAS unsigned*)(lds + _ko + (wid * 2 + 1) * 1024), 16, 0, 0); \
        __builtin_amdgcn_global_load_lds((const unsigned*)(krb + _j * 8192 + wid * 1024 + lo), (LAS unsigned*)(lds + _ko + 16384 + wid * 1024), 16, 0, 0); \
        __builtin_amdgcn_global_load_lds((const unsigned*)(vtb + _j * 16384 + (wid * 2) * 1024 + lo), (LAS unsigned*)(lds + _vo + (wid * 2) * 1024), 16, 0, 0); \
        __builtin_amdgcn_global_load_lds((const unsigned*)(vtb + _j * 16384 + (wid * 2 + 1) * 1024 + lo), (LAS unsigned*)(lds + _vo + (wid * 2 + 1) * 1024), 16, 0, 0); } while (0)
#define AT_TOP(k) do { if ((k) + 1 < n) asm volatile("s_waitcnt vmcnt(5)" ::: "memory"); else asm volatile("s_waitcnt vmcnt(0)" ::: "memory"); \
        __builtin_amdgcn_s_barrier(); asm volatile("" ::: "memory"); if ((k) + 2 < n) AT_ISSUE((k) + 2); } while (0)
    const int kn_off0 = q * 256, kn_sw = q & 15, kr_off0 = q * 128, kr_sw = (q >> 1) & 7, vt_sw = (q >> 1) & 7;
    constexpr float THR = 8.f;
    f32x16 S0, S1; bool sval = false, first = true; int sjj = 0, sk = 0;
    auto QK = [&](int k) __attribute__((always_inline)) {
        const int jj = j0 + k - 4 * b; sjj = jj; sk = k; sval = !(jj >= 0 && 64 * jj > 32 * wid + 31);
        if (sval) {
            LAS unsigned char* bb = lds + (k % 3) * KB;
            const float mref = first ? 0.f : m_run;
#pragma unroll
            for (int r = 0; r < 16; ++r) { S0[r] = -mref; S1[r] = -mref; }
#pragma unroll
            for (int s = 0; s < 8; ++s) {
                const bf16x8 k0 = *(const LAS bf16x8*)(bb + kn_off0 + (((2 * s + hh) ^ kn_sw) << 4));
                const bf16x8 k1 = *(const LAS bf16x8*)(bb + 8192 + kn_off0 + (((2 * s + hh) ^ kn_sw) << 4));
                S0 = __builtin_amdgcn_mfma_f32_32x32x16_bf16(k0, qf[s], S0, 0, 0, 0);
                S1 = __builtin_amdgcn_mfma_f32_32x32x16_bf16(k1, qf[s], S1, 0, 0, 0); }
#pragma unroll
            for (int s = 0; s < 4; ++s) {
                const bf16x8 k0 = *(const LAS bf16x8*)(bb + 16384 + kr_off0 + (((2 * s + hh) ^ kr_sw) << 4));
                const bf16x8 k1 = *(const LAS bf16x8*)(bb + 16384 + 4096 + kr_off0 + (((2 * s + hh) ^ kr_sw) << 4));
                S0 = __builtin_amdgcn_mfma_f32_32x32x16_bf16(k0, qf[8 + s], S0, 0, 0, 0);
                S1 = __builtin_amdgcn_mfma_f32_32x32x16_bf16(k1, qf[8 + s], S1, 0, 0, 0); } }
    };
    auto SMPV = [&]() __attribute__((always_inline)) {
        if (sval) {
            LAS unsigned char* vb = lds + VOFF + (sk & 3) * VB;
            const float mref = first ? 0.f : m_run;
            if (sjj >= 0) {
                const int dq = wid * 32 + q - 64 * sjj - 4 * hh;
                const float NEG = -__builtin_inff();
#pragma unroll
                for (int r = 0; r < 16; ++r) { const int c = (r & 3) + 8 * (r >> 2);
                    if (c > dq) S0[r] = NEG;
                    if (c + 32 > dq) S1[r] = NEG; } }
            float mx = S0[0];
#pragma unroll
            for (int r = 1; r < 16; ++r) mx = fmaxf(mx, S0[r]);
#pragma unroll
            for (int r = 0; r < 16; ++r) mx = fmaxf(mx, S1[r]);
            { auto rr = __builtin_amdgcn_permlane32_swap(__float_as_uint(mx), __float_as_uint(mx), false, false); mx = fmaxf(__uint_as_float(rr[0]), __uint_as_float(rr[1])); }
            float alpha = 1.f;
            if (first || !__all(mx <= THR)) {
                const float mn = fmaxf(m_run, mref + mx), sh = mn - mref;
                alpha = __builtin_amdgcn_exp2f(m_run - mn); m_run = mn;
#pragma unroll
                for (int r = 0; r < 16; ++r) { S0[r] -= sh; S1[r] -= sh; }
#pragma unroll
                for (int d = 0; d < 4; ++d)
#pragma unroll
                    for (int r = 0; r < 16; ++r) O[d][r] *= alpha;
                first = false;
            }
            float sum = 0.f;
#pragma unroll
            for (int r = 0; r < 16; ++r) { S0[r] = __builtin_amdgcn_exp2f(S0[r]); S1[r] = __builtin_amdgcn_exp2f(S1[r]); sum += S0[r] + S1[r]; }
            l_run = l_run * alpha + sum;
            bf16x8 pf[4];
#pragma unroll
            for (int h2 = 0; h2 < 2; ++h2) {
                u32x4 a = {cvt_pk_bf16(S0[8 * h2 + 0], S0[8 * h2 + 1]), cvt_pk_bf16(S0[8 * h2 + 2], S0[8 * h2 + 3]), cvt_pk_bf16(S0[8 * h2 + 4], S0[8 * h2 + 5]), cvt_pk_bf16(S0[8 * h2 + 6], S0[8 * h2 + 7])};
                u32x4 c = {cvt_pk_bf16(S1[8 * h2 + 0], S1[8 * h2 + 1]), cvt_pk_bf16(S1[8 * h2 + 2], S1[8 * h2 + 3]), cvt_pk_bf16(S1[8 * h2 + 4], S1[8 * h2 + 5]), cvt_pk_bf16(S1[8 * h2 + 6], S1[8 * h2 + 7])};
                pf[h2] = *(bf16x8*)&a; pf[2 + h2] = *(bf16x8*)&c; }
#pragma unroll
            for (int d = 0; d < 4; ++d) {
#pragma unroll
                for (int s2 = 0; s2 < 4; ++s2) {
                    const bf16x8 vf = *(const LAS bf16x8*)(vb + (d * 32 + q) * 128 + (((2 * s2 + hh) ^ vt_sw) << 4));
                    O[d] = __builtin_amdgcn_mfma_f32_32x32x16_bf16(vf, pf[s2], O[d], 0, 0, 0); } }
        }
    };
    AT_ISSUE(0);
    if (n > 1) AT_ISSUE(1);
    if (grp == 0) {
#pragma unroll 1
        for (int k = 0; k < n; ++k) { AT_TOP(k); QK(k); SMPV(); }
    } else {
#pragma unroll 1
        for (int k = 0; k < n; ++k) { AT_TOP(k); SMPV(); QK(k); }
        SMPV();
    }
    asm volatile("" ::: "memory"); __builtin_amdgcn_s_barrier(); asm volatile("" ::: "memory");
#undef AT_ISSUE
#undef AT_TOP
    { auto rr = __builtin_amdgcn_permlane32_swap(__float_as_uint(l_run), __float_as_uint(l_run), false, false); l_run = __uint_as_float(rr[0]) + __uint_as_float(rr[1]); }
    bf16_t* op = (bf16_t*)p.Opart + ((size_t)slot * 256 + wid * 32 + q) * 128 + 4 * hh;
#pragma unroll
    for (int d = 0; d < 4; ++d)
#pragma unroll
        for (int g = 0; g < 4; ++g) { u32x2 v = {cvt_pk_bf16(O[d][4 * g], O[d][4 * g + 1]), cvt_pk_bf16(O[d][4 * g + 2], O[d][4 * g + 3])}; *(u32x2*)(op + d * 32 + g * 8) = v; }
    if (hh == 0) { float* ml = p.MLpart + ((size_t)slot * 256 + wid * 32 + q) * 2; ml[0] = m_run; ml[1] = l_run; }
}
__device__ __forceinline__ void attn_phase(LAS unsigned char* lds, const MlaP& p, int c) {
    const int head = c >> 6, cc = c & 63, pp = cc >> 1, bl = 63 - pp, nl = 4 * (64 - pp);
    if ((cc & 1) == 0) attn_item(lds, p, head, bl, 0, ATT_STEPS, 2 * c);
    else { attn_item(lds, p, head, bl, ATT_STEPS, nl, 2 * c); attn_item(lds, p, head, pp, 0, 4 * (pp + 1), 2 * c + 1); }
}
struct GlaP {
    const bf16_t* Hp; const bf16_t* GVt; const float* wg; const float* bg; const float* ng; const float* wconv;
    bf16_t* QE; float* OI; float* kvT; float* decay; bf16_t* spT; bf16_t* Yab; bf16_t* Ybb; bf16_t* Ycb;
    const float* Opart; const float* MLpart;
};
__device__ __forceinline__ int pos16(int i) { return (i & 48) | ((i & 4) << 1) | ((i & 8) >> 1) | (i & 3); }
__device__ __forceinline__ void gla_g1(LAS unsigned char* lds, const GlaP& p, int c, int G) {
    const int tid = tid_now(), wid = __builtin_amdgcn_readfirstlane(tid >> 6), lane = tid & 63, l31 = lane & 31, hh = lane >> 5;
    LAS float* bsm = (LAS float*)lds; LAS float* gtot = (LAS float*)(lds + 17408); LAS float* blast = (LAS float*)(lds + 19456);
    LAS unsigned char* qeL = lds + 20480; LAS unsigned char* keL = lds + 28672; LAS unsigned char* ktL = lds + 36864;
    const int eb = wid & 3, hb = wid >> 2;
    struct G1In { bf16x8 vf[4]; u32x4 ga[8], gb[8], qv, kv; };
    auto g1_load = [&](int u, G1In& I) {
        const int n = u >> 2, h = u & 3;
        const bf16_t* vp = p.GVt + ((size_t)u * 128 + eb * 32 + l31) * 64 + 8 * hh;
#pragma unroll
        for (int s4 = 0; s4 < 4; ++s4) I.vf[s4] = *(const bf16x8*)(vp + 16 * s4);
        const int g = tid >> 6;
#pragma unroll
        for (int k = 0; k < 8; ++k) { const bf16_t* gp = p.Hp + (size_t)(64 * n + 8 * g + k) * HW + H_GLR; I.ga[k] = *(const u32x4*)gp; I.gb[k] = *(const u32x4*)(gp + 8); }
        const int i = tid >> 3, d0 = 8 * (tid & 7); const size_t t = (size_t)64 * n + i;
        I.qv = *(const u32x4*)(p.Hp + t * HW + H_GQ + h * 64 + d0); I.kv = *(const u32x4*)(p.Hp + t * HW + H_GK + h * 64 + d0); };
    G1In cur;
    if (c < 1024) g1_load(c, cur);
    for (int u = c; u < 1024; u += G) {
        const int n = u >> 2, h = u & 3;
        { const int d = tid & 63, g = tid >> 6;
          float w[16];
#pragma unroll
          for (int r = 0; r < 16; ++r) w[r] = p.wg[r * 256 + h * 64 + d];
          const float bias = p.bg[h * 64 + d];
          float cs[8]; float run = 0.f;
#pragma unroll
          for (int k = 0; k < 8; ++k) {
              const u32x4 g0 = cur.ga[k], g1 = cur.gb[k];
              float la = bias;
#pragma unroll
              for (int r = 0; r < 4; ++r) { la += bflo(g0[r]) * w[2 * r] + bfhi(g0[r]) * w[2 * r + 1]; la += bflo(g1[r]) * w[8 + 2 * r] + bfhi(g1[r]) * w[8 + 2 * r + 1]; }
              const float ls = (fminf(la, 0.f) - __logf(1.f + __expf(-fabsf(la)))) * (1.f / 16.f);
              run += ls; cs[k] = run; }
          gtot[g * 64 + d] = run;
          __syncthreads();
          float pre = 0.f, tot = 0.f;
#pragma unroll
          for (int gg = 0; gg < 8; ++gg) { const float v = gtot[gg * 64 + d]; tot += v; if (gg < g) pre += v; }
#pragma unroll
          for (int k = 0; k < 8; ++k) bsm[(8 * g + k) * 68 + d] = pre + cs[k];
          if (g == 0) { blast[d] = tot; p.decay[(size_t)u * 64 + d] = __expf(tot); } }
        __syncthreads();
        { const int i = tid >> 3, cc = tid & 7, d0 = 8 * cc; const size_t t = (size_t)64 * n + i;
          const u32x4 qv = cur.qv, kv = cur.kv;
          float b[8], bl[8];
          { const f32x4 b0 = *(const LAS f32x4*)(bsm + i * 68 + d0), b1 = *(const LAS f32x4*)(bsm + i * 68 + d0 + 4), l0 = *(const LAS f32x4*)(blast + d0), l1 = *(const LAS f32x4*)(blast + d0 + 4);
#pragma unroll
            for (int j = 0; j < 4; ++j) { b[j] = b0[j]; b[4 + j] = b1[j]; bl[j] = l0[j]; bl[4 + j] = l1[j]; } }
          float qe[8], ke[8], kt[8];
#pragma unroll
          for (int j = 0; j < 8; ++j) { const float qq = (j & 1) ? bfhi(qv[j >> 1]) : bflo(qv[j >> 1]), kk = (j & 1) ? bfhi(kv[j >> 1]) : bflo(kv[j >> 1]);
              qe[j] = qq * 0.125f * __expf(b[j]); ke[j] = kk * __expf(-b[j]); kt[j] = kk * __expf(bl[j] - b[j]); }
          const u32x4 qo = {cvt_pk_bf16(qe[0], qe[1]), cvt_pk_bf16(qe[2], qe[3]), cvt_pk_bf16(qe[4], qe[5]), cvt_pk_bf16(qe[6], qe[7])};
          const u32x4 ko = {cvt_pk_bf16(ke[0], ke[1]), cvt_pk_bf16(ke[2], ke[3]), cvt_pk_bf16(ke[4], ke[5]), cvt_pk_bf16(ke[6], ke[7])};
          const int sw = (i >> 1) & 7;
          *(LAS u32x4*)(qeL + i * 128 + ((cc ^ sw) << 4)) = qo; *(LAS u32x4*)(keL + i * 128 + ((cc ^ sw) << 4)) = ko;
          *(u32x4*)(p.QE + t * 256 + h * 64 + d0) = qo;
          const int pi = pos16(i);
#pragma unroll
          for (int j = 0; j < 8; ++j) { const int d = d0 + j; const unsigned pk = cvt_pk_bf16(kt[j], 0.f);
              *(LAS unsigned short*)(ktL + d * 128 + (((pi >> 3) ^ ((d >> 1) & 7)) << 4) + (pi & 7) * 2) = (unsigned short)pk; } }
        __syncthreads();
        G1In nxt = cur;
        if (u + G < 1024) g1_load(u + G, nxt);
        { f32x16 OT, KV;
#pragma unroll
          for (int r = 0; r < 16; ++r) { OT[r] = 0.f; KV[r] = 0.f; }
          const int sw = (l31 >> 1) & 7;
#pragma unroll
          for (int jb = 0; jb < 2; ++jb) {
              if (jb <= hb) {
                  f32x16 Sc;
#pragma unroll
                  for (int r = 0; r < 16; ++r) Sc[r] = 0.f;
#pragma unroll
                  for (int s = 0; s < 4; ++s) {
                      const bf16x8 ka = *(const LAS bf16x8*)(keL + (32 * jb + l31) * 128 + (((2 * s + hh) ^ sw) << 4));
                      const bf16x8 qb = *(const LAS bf16x8*)(qeL + (32 * hb + l31) * 128 + (((2 * s + hh) ^ sw) << 4));
                      Sc = __builtin_amdgcn_mfma_f32_32x32x16_bf16(ka, qb, Sc, 0, 0, 0); }
                  if (jb == hb) {
#pragma unroll
                      for (int r = 0; r < 16; ++r) { const int j = (r & 3) + 8 * (r >> 2) + 4 * hh; if (j > l31) Sc[r] = 0.f; } }
#pragma unroll
                  for (int h2 = 0; h2 < 2; ++h2) {
                      u32x4 a = {cvt_pk_bf16(Sc[8 * h2 + 0], Sc[8 * h2 + 1]), cvt_pk_bf16(Sc[8 * h2 + 2], Sc[8 * h2 + 3]), cvt_pk_bf16(Sc[8 * h2 + 4], Sc[8 * h2 + 5]), cvt_pk_bf16(Sc[8 * h2 + 6], Sc[8 * h2 + 7])};
                      OT = __builtin_amdgcn_mfma_f32_32x32x16_bf16(cur.vf[2 * jb + h2], *(bf16x8*)&a, OT, 0, 0, 0); } } }
#pragma unroll
          for (int s4 = 0; s4 < 4; ++s4) {
              const bf16x8 kb = *(const LAS bf16x8*)(ktL + (32 * hb + l31) * 128 + (((2 * s4 + hh) ^ sw) << 4));
              KV = __builtin_amdgcn_mfma_f32_32x32x16_bf16(cur.vf[s4], kb, KV, 0, 0, 0); }
          float* oi = p.OI + ((size_t)u * 8 + wid) * 1024 + lane;
#pragma unroll
          for (int r = 0; r < 16; ++r) oi[r * 64] = OT[r];
          float* kp = p.kvT + (size_t)u * 8192 + 32 * hb + l31;
#pragma unroll
          for (int r = 0; r < 16; ++r) { const int e = 32 * eb + (r & 3) + 8 * (r >> 2) + 4 * hh; kp[e * 64] = KV[r]; } }
        __syncthreads();
        cur = nxt;
    }
}
__device__ __forceinline__ void gla_g2(LAS unsigned char* lds, const GlaP& p, int c) {
    const int tid = tid_now(), el = tid & 127, seg = tid >> 7;
    const int idx = c * 128 + el, h = idx >> 13, ed = idx & 8191, d = idx & 63;
    LAS float* segS = (LAS float*)lds; LAS float* segD = (LAS float*)(lds + 2048);
    float st = 0.f, dp = 1.f;
    for (int n0 = seg * 64; n0 < seg * 64 + 64; n0 += 16) {
        float kv[16], dc[16];
#pragma unroll
        for (int k = 0; k < 16; ++k) { const size_t u = (size_t)(n0 + k) * 4 + h; kv[k] = p.kvT[u * 8192 + ed]; dc[k] = p.decay[u * 64 + d]; }
#pragma unroll
        for (int k = 0; k < 16; ++k) { st = fmaf(dc[k], st, kv[k]); dp *= dc[k]; }
    }
    __syncthreads();
    segS[seg * 128 + el] = st; segD[seg * 128 + el] = dp;
    __syncthreads();
    st = 0.f;
    for (int s2 = 0; s2 < seg; ++s2) st = fmaf(segD[s2 * 128 + el], st, segS[s2 * 128 + el]);
    for (int n0 = seg * 64; n0 < seg * 64 + 64; n0 += 16) {
        float kv[16], dc[16];
#pragma unroll
        for (int k = 0; k < 16; ++k) { const size_t u = (size_t)(n0 + k) * 4 + h; kv[k] = p.kvT[u * 8192 + ed]; dc[k] = p.decay[u * 64 + d]; }
#pragma unroll
        for (int k = 0; k < 16; ++k) { const size_t u = (size_t)(n0 + k) * 4 + h; p.spT[u * 8192 + ed] = (bf16_t)(cvt_pk_bf16(st, 0.f) & 0xffffu); st = fmaf(dc[k], st, kv[k]); }
    }
    __syncthreads();
}
__device__ __forceinline__ void gla_g3(LAS unsigned char* lds, const GlaP& p, int c, int G) {
    const int tid = tid_now(), wid = __builtin_amdgcn_readfirstlane(tid >> 6), lane = tid & 63, l31 = lane & 31, hh = lane >> 5;
    LAS float* red = (LAS float*)lds;
    const int eb = wid & 3, ib = wid >> 2;
    struct In { f32x16 oi; bf16x8 sp[4], qe[4]; u32x2 rv[4]; };
    auto load = [&](int u, In& x) __attribute__((always_inline)) {
        const int n = u >> 2, h = u & 3; const size_t t = (size_t)64 * n + 32 * ib + l31;
        const float* oi = p.OI + ((size_t)u * 8 + wid) * 1024 + lane;
#pragma unroll
        for (int r = 0; r < 16; ++r) x.oi[r] = oi[r * 64];
        const bf16_t* sp = p.spT + ((size_t)u * 128 + 32 * eb + l31) * 64 + 8 * hh; const bf16_t* qp = p.QE + t * 256 + h * 64 + 8 * hh;
#pragma unroll
        for (int s = 0; s < 4; ++s) { x.sp[s] = *(const bf16x8*)(sp + 16 * s); x.qe[s] = *(const bf16x8*)(qp + 16 * s); }
#pragma unroll
        for (int g = 0; g < 4; ++g) x.rv[g] = *(const u32x2*)(p.Hp + t * HW + H_GR + h * 128 + 32 * eb + 8 * g + 4 * hh);
    };
    In cur, nxt;
    if (c < 1024) load(c, cur);
    for (int u = c; u < 1024; u += G) {
        const int n = u >> 2, h = u & 3;
        const bool hn = u + G < 1024;
        if (hn) load(u + G, nxt);
        f32x16 O = cur.oi;
        const size_t t = (size_t)64 * n + 32 * ib + l31;
#pragma unroll
        for (int s = 0; s < 4; ++s) O = __builtin_amdgcn_mfma_f32_32x32x16_bf16(cur.sp[s], cur.qe[s], O, 0, 0, 0);
        float ss = 0.f;
#pragma unroll
        for (int r = 0; r < 16; ++r) ss += O[r] * O[r];
        { auto rr = __builtin_amdgcn_permlane32_swap(__float_as_uint(ss), __float_as_uint(ss), false, false); ss = __uint_as_float(rr[0]) + __uint_as_float(rr[1]); }
        __syncthreads();
        if (hh == 0) red[eb * 64 + 32 * ib + l31] = ss;
        __syncthreads();
        const int ti = 32 * ib + l31;
        const float tot = (red[ti] + red[64 + ti]) + (red[128 + ti] + red[192 + ti]);
        const float rs = rsqrtf(tot * (1.f / 128.f) + 1e-6f);
#pragma unroll
        for (int g = 0; g < 4; ++g) { const int e0 = 32 * eb + 8 * g + 4 * hh;
            const u32x2 rv = cur.rv[g]; const f32x4 gn = *(const f32x4*)(p.ng + e0);
            float y[4];
#pragma unroll
            for (int j = 0; j < 4; ++j) { const float r_ = (j & 1) ? bfhi(rv[j >> 1]) : bflo(rv[j >> 1]); y[j] = O[4 * g + j] * rs * gn[j] * (r_ * frcp(1.f + __expf(-r_))); }
            u32x2 o = {cvt_pk_bf16(y[0], y[1]), cvt_pk_bf16(y[2], y[3])};
            *(u32x2*)(p.Ybb + t * 512 + h * 128 + e0) = o; }
        if (hn) cur = nxt;
    }
}
__device__ __forceinline__ void conv_phase(const GlaP& p, int gtid, int gthreads) {
    constexpr int NT = T * 64;
    for (int idx0 = gtid; idx0 < NT; idx0 += 2 * gthreads) {
        u32x4 av[2][3], xv[2][3], bv[2]; int tt[2], cc[2];
#pragma unroll
        for (int u = 0; u < 2; ++u) { const int idx = min(idx0 + u * gthreads, NT - 1); const int t = idx >> 6, c0 = (idx & 63) * 8; tt[u] = t; cc[u] = c0;
#pragma unroll
            for (int k = 0; k < 3; ++k) { const int ts = max(t - 2 + k, 0);
                av[u][k] = *(const u32x4*)(p.Hp + (size_t)ts * HW + H_AC + c0); xv[u][k] = *(const u32x4*)(p.Hp + (size_t)ts * HW + H_AX + c0); }
            bv[u] = *(const u32x4*)(p.Hp + (size_t)t * HW + H_AB + c0); }
#pragma unroll
        for (int u = 0; u < 2; ++u) { if (idx0 + u * gthreads < NT) { const int t = tt[u], c0 = cc[u];
            float y[8];
#pragma unroll
            for (int j = 0; j < 8; ++j) y[j] = 0.f;
#pragma unroll
            for (int k = 0; k < 3; ++k) { if (t - 2 + k >= 0) {
                const f32x4 w0 = *(const f32x4*)(p.wconv + k * 512 + c0), w1 = *(const f32x4*)(p.wconv + k * 512 + c0 + 4);
#pragma unroll
                for (int j = 0; j < 4; ++j) { y[2 * j] += (j < 2 ? w0[2 * j] : w1[2 * j - 4]) * (bflo(av[u][k][j]) * bflo(xv[u][k][j])); y[2 * j + 1] += (j < 2 ? w0[2 * j + 1] : w1[2 * j - 3]) * (bfhi(av[u][k][j]) * bfhi(xv[u][k][j])); } } }
            u32x4 o;
#pragma unroll
            for (int j = 0; j < 4; ++j) o[j] = cvt_pk_bf16(bflo(bv[u][j]) * y[2 * j], bfhi(bv[u][j]) * y[2 * j + 1]);
            *(u32x4*)(p.Yab + (size_t)t * 512 + c0) = o; } }
    }
}
__device__ __forceinline__ void attn_combine_bf16(const GlaP& p, int gtid, int gthreads) {
    constexpr int NT = 256 * 256 * 32;
    for (int idx0 = gtid; idx0 < NT; idx0 += 2 * gthreads) {
        float mv[2][2], lv[2][2]; u32x2 ov[2][2]; int nval[2]; size_t orow[2]; int ocol[2];
#pragma unroll
        for (int u = 0; u < 2; ++u) { const int idx = min(idx0 + u * gthreads, NT - 1);
            const int dq = idx & 31, row = (idx >> 5) & 255, g = idx >> 13, head = g >> 6, b = g & 63;
            const int s0 = b >= 32 ? 2 * (head * 64 + 2 * (63 - b)) : 2 * (head * 64 + 2 * b + 1) + 1;
            nval[u] = b >= 32 ? 2 : 1; orow[u] = (size_t)(b * 256 + row) * 512 + head * 128; ocol[u] = dq * 4;
#pragma unroll
            for (int k = 0; k < 2; ++k) { const size_t sl = (size_t)(s0 + (b >= 32 ? 2 * k : 0)) * 256 + row;
                const f32x2 ml = *(const f32x2*)(p.MLpart + sl * 2); mv[u][k] = ml[0]; lv[u][k] = ml[1];
                ov[u][k] = *(const u32x2*)((const bf16_t*)p.Opart + sl * 128 + dq * 4); } }
#pragma unroll
        for (int u = 0; u < 2; ++u) { if (idx0 + u * gthreads < NT) {
            float M = mv[u][0];
#pragma unroll
            for (int k = 1; k < 2; ++k) if (k < nval[u]) M = fmaxf(M, mv[u][k]);
            f32x4 acc = {0.f, 0.f, 0.f, 0.f}; float l = 0.f;
#pragma unroll
            for (int k = 0; k < 2; ++k) { const float w = k < nval[u] ? __builtin_amdgcn_exp2f(mv[u][k] - M) : 0.f;
                l += w * lv[u][k]; const f32x4 o = {bflo(ov[u][k][0]), bfhi(ov[u][k][0]), bflo(ov[u][k][1]), bfhi(ov[u][k][1])}; acc += o * w; }
            const float il = frcp(l);
            u32x2 o = {cvt_pk_bf16(acc[0] * il, acc[1] * il), cvt_pk_bf16(acc[2] * il, acc[3] * il)};
            *(u32x2*)(p.Ycb + orow[u] + ocol[u]) = o; } }
    }
}
struct P {
    const float *x, *pin; const int* pos;
    const float *ln0_g, *ln0_b, *w_in, *w_conv, *w_gg, *b_gg, *gla_ng, *qn_g, *kvn_g, *w_uq, *w_ukv, *w_br, *w_o, *ln1_g, *ln1_b, *w_grp, *b_grp, *w_exp, *b_exp,
                *w_gate, *w_up, *w_down, *ln2_g, *ln2_b, *w_pg, *b_pg, *w_pu, *ln3_g, *ln3_b;
    float* out;
    float *X, *Z, *cs, *sn, *ssq_q, *ssq_kv, *OI, *kvT, *decay, *MLpart, *ew;
    bf16_t *Db, *Xb, *Hp, *GVt, *Qb, *KnImg, *VtImg, *KrImg, *QE, *spT, *Yab, *Ybb, *Ycb, *Mgb, *Hbuf, *Ys, *Ub, *Pb;
    bf16_t *Wb_in, *Wb_gv, *Wb_uq, *Wb_uk, *Wb_uv, *Wb_br, *Wb_o, *Wb_gu, *Wb_d, *Wb_pg, *Wb_pu;
    int *cnt, *lists; unsigned* bar;
};
__device__ __forceinline__ MegaP mk_mega(const P& p) { MegaP m; m.w_in = p.w_in; m.Wb_in = p.Wb_in; m.Wb_gv = p.Wb_gv; m.Xb = p.Xb; m.Hp = p.Hp; m.GVt = p.GVt; m.ssq_q = p.ssq_q; m.ssq_kv = p.ssq_kv; return m; }
__device__ __forceinline__ MlaP mk_mla(const P& p) { MlaP q; q.w_uq = p.w_uq; q.w_ukv = p.w_ukv; q.qn_g = p.qn_g; q.kvn_g = p.kvn_g; q.Wb_uq = p.Wb_uq; q.Wb_uk = p.Wb_uk; q.Wb_uv = p.Wb_uv; q.Hp = p.Hp;
    q.ssq_q = p.ssq_q; q.ssq_kv = p.ssq_kv; q.cs = p.cs; q.sn = p.sn; q.Qb = p.Qb; q.KnImg = p.KnImg; q.VtImg = p.VtImg; q.KrImg = p.KrImg; q.Opart = p.Z; q.MLpart = p.MLpart; q.Yc = nullptr; return q; }
__device__ __forceinline__ GlaP mk_gla(const P& p, int layer) { GlaP g; g.Hp = p.Hp; g.GVt = p.GVt; g.wg = p.w_gg + layer * 16 * 256; g.bg = p.b_gg + layer * 256; g.ng = p.gla_ng + layer * 128; g.wconv = p.w_conv + layer * 3 * 512;
    g.QE = p.QE; g.OI = p.OI; g.kvT = p.kvT; g.decay = p.decay; g.spT = p.spT; g.Yab = p.Yab; g.Ybb = p.Ybb; g.Ycb = p.Ycb; g.Opart = p.Z; g.MLpart = p.MLpart; return g; }

struct CvJob { const float* W; bf16_t* Bt; const float* rs; int ldw, Ksrc, ldbt, n0, k0, kind, aux; };
struct MapId { __device__ __forceinline__ int operator()(int s) const { return s; } };
__device__ __forceinline__ int cv_map(int kind, int aux, int n) {
    if (kind == 0) return MapInMain{}(n);
    if (kind == 1) return aux + n;
    if (kind == 2) return MapQ{}(n);
    if (kind == 3) return MapKV{aux}(n);
    return n; }
__device__ __forceinline__ int cv_omap(int kind, int aux, int n) { return kind == 4 ? (n >> 7) * 256 + aux * 128 + (n & 127) : n; }
__device__ __forceinline__ bool cv_job(const P& p, int layer, int t, CvJob& j) {
    constexpr int S0 = 384, S1 = S0 + 32, S2 = S1 + 12, S3 = S2 + 8, S4 = S3 + 8, S5 = S4 + 96, S6 = S5 + 64, S7 = S6 + 64, S8 = S7 + 16, S9 = S8 + 1024, S10 = S9 + 1024, S11 = S10 + 1024;
    if (t >= S11) return false;
    j.rs = nullptr; j.aux = 0; j.kind = 5;
    if (t < S0) { j.W = p.w_in + (size_t)layer * D * INW; j.ldw = INW; j.Ksrc = D; j.Bt = p.Wb_in; j.ldbt = D; j.n0 = (t >> 2) * 64; j.k0 = (t & 3) * 256; j.kind = 0; }
    else if (t < S1) { const int u = t - S0; j.W = p.w_in + (size_t)layer * D * INW; j.ldw = INW; j.Ksrc = D; j.Bt = p.Wb_gv; j.ldbt = D; j.n0 = (u >> 2) * 64; j.k0 = (u & 3) * 256; j.kind = 1; j.aux = O_GV; }
    else if (t < S2) { const int u = t - S1; j.W = p.w_uq + (size_t)layer * 256 * 768; j.ldw = 768; j.Ksrc = 256; j.Bt = p.Wb_uq; j.ldbt = 256; j.n0 = u * 64; j.k0 = 0; j.kind = 2; j.rs = p.qn_g + layer * 256; }
    else if (t < S3) { const int u = t - S2; j.W = p.w_ukv + (size_t)layer * 128 * 1024; j.ldw = 1024; j.Ksrc = 128; j.Bt = p.Wb_uk; j.ldbt = 256; j.n0 = u * 64; j.k0 = 0; j.kind = 3; j.aux = 0; j.rs = p.kvn_g + layer * 128; }
    else if (t < S4) { const int u = t - S3; j.W = p.w_ukv + (size_t)layer * 128 * 1024; j.ldw = 1024; j.Ksrc = 128; j.Bt = p.Wb_uv; j.ldbt = 256; j.n0 = u * 64; j.k0 = 0; j.kind = 3; j.aux = 128; j.rs = p.kvn_g + layer * 128; }
    else if (t < S5) { const int u = t - S4, br = u >> 5, v = u & 31; j.W = p.w_br + (size_t)layer * 1536 * D + (size_t)br * 512 * D; j.ldw = D; j.Ksrc = 512; j.Bt = p.Wb_br + (size_t)br * 1024 * 512; j.ldbt = 512; j.n0 = (v >> 1) * 64; j.k0 = (v & 1) * 256; }
    else if (t < S6) { const int u = t - S5; j.W = p.w_o + (size_t)layer * D * D; j.ldw = D; j.Ksrc = D; j.Bt = p.Wb_o; j.ldbt = D; j.n0 = (u >> 2) * 64; j.k0 = (u & 3) * 256; }
    else if (t < S7) { const int u = t - S6; j.W = p.w_pg + (size_t)layer * D * D; j.ldw = D; j.Ksrc = D; j.Bt = p.Wb_pg; j.ldbt = D; j.n0 = (u >> 2) * 64; j.k0 = (u & 3) * 256; }
    else if (t < S8) { const int u = t - S7; j.W = p.w_pu + (size_t)layer * PLE * D; j.ldw = D; j.Ksrc = PLE; j.Bt = p.Wb_pu; j.ldbt = PLE; j.n0 = u * 64; j.k0 = 0; }
    else if (t < S9) { const int u = t - S8, e = u >> 4, v = u & 15; j.W = p.w_gate + ((size_t)layer * NE + e) * D * EH; j.ldw = EH; j.Ksrc = D; j.Bt = p.Wb_gu + (size_t)e * 512 * D; j.ldbt = D; j.n0 = (v >> 2) * 64; j.k0 = (v & 3) * 256; j.kind = 4; j.aux = 0; }
    else if (t < S10) { const int u = t - S9, e = u >> 4, v = u & 15; j.W = p.w_up + ((size_t)layer * NE + e) * D * EH; j.ldw = EH; j.Ksrc = D; j.Bt = p.Wb_gu + (size_t)e * 512 * D; j.ldbt = D; j.n0 = (v >> 2) * 64; j.k0 = (v & 3) * 256; j.kind = 4; j.aux = 1; }
    else { const int u = t - S10, e = u >> 4, v = u & 15; j.W = p.w_down + ((size_t)layer * NE + e) * EH * D; j.ldw = D; j.Ksrc = EH; j.Bt = p.Wb_d + (size_t)e * D * EH; j.ldbt = EH; j.n0 = v * 64; j.k0 = 0; }
    return true; }
__device__ __forceinline__ void cv_load(const CvJob& j, int tid, f32x4 (&v)[8]) {
    const int n4 = tid & 15, kr = tid >> 4; const int col = cv_map(j.kind, j.aux, j.n0 + 4 * n4);
#pragma unroll
    for (int r = 0; r < 8; ++r) { const int k = j.k0 + kr + 32 * r; v[r] = (f32x4){0.f, 0.f, 0.f, 0.f};
        if (col >= 0 && k < j.Ksrc) { v[r] = *(const f32x4*)(j.W + (size_t)k * j.ldw + col); if (j.rs) v[r] = v[r] * j.rs[k]; } }
}
__device__ __forceinline__ void ph_convert(LAS unsigned char* ldsl, const P& p, int layer) {
    LAS float* tile = (LAS float*)ldsl;
    const int tid = tid_now(), c = sgpr_now((int)blockIdx.x), G = gridDim.x;
    CvJob cur, nxt; f32x4 v[8], w[8];
    bool have = cv_job(p, layer, c, cur);
    if (have) cv_load(cur, tid, v);
    for (int t = c; have; t += G) {
        const bool hn = cv_job(p, layer, t + G, nxt);
        if (hn) cv_load(nxt, tid, w);
        __syncthreads();
        { const int n4 = tid & 15, kr = tid >> 4;
#pragma unroll
          for (int r = 0; r < 8; ++r) { LAS float* d = tile + (kr + 32 * r) * 65 + 4 * n4; d[0] = v[r][0]; d[1] = v[r][1]; d[2] = v[r][2]; d[3] = v[r][3]; } }
        __syncthreads();
        { const int kk = (tid & 127) * 2, nn = tid >> 7;
#pragma unroll
          for (int r = 0; r < 16; ++r) { const int n = nn + 4 * r;
              *(unsigned*)(cur.Bt + (size_t)cv_omap(cur.kind, cur.aux, cur.n0 + n) * cur.ldbt + cur.k0 + kk) = cvt_pk_bf16(tile[kk * 65 + n], tile[(kk + 1) * 65 + n]); } }
        have = hn; cur = nxt;
#pragma unroll
        for (int r = 0; r < 8; ++r) v[r] = w[r];
    }
    __syncthreads();
}

__device__ __forceinline__ float wsum(float v, int lane) {
#pragma unroll
    for (int o = 32; o > 0; o >>= 1) v += shx(v, o, lane);
    return v; }
template <int MODE>
__device__ __forceinline__ void ph_rows(const P& p, int layer) {
    const int lane = tid_now() & 63, gw = blockIdx.x * 8 + (tid_now() >> 6), nw = gridDim.x * 8;
    const float* gp = MODE == 0 ? p.ln0_g : MODE == 1 ? p.ln1_g + layer * D : MODE == 2 ? p.ln2_g + layer * D : p.ln3_g + layer * D;
    const float* bp = MODE == 0 ? p.ln0_b : MODE == 1 ? p.ln1_b + layer * D : MODE == 2 ? p.ln2_b + layer * D : p.ln3_b + layer * D;
    f32x4 gg[4], bb[4];
#pragma unroll
    for (int i = 0; i < 4; ++i) { gg[i] = *(const f32x4*)(gp + 256 * i + 4 * lane); bb[i] = *(const f32x4*)(bp + 256 * i + 4 * lane); }
    const float* in = MODE == 0 ? p.x : p.X;
    float* outf = (MODE == 3 && layer == DEPTH - 1) ? p.out : p.X;
    for (int row = gw; row < T; row += nw) {
        f32x4 v[4];
#pragma unroll
        for (int i = 0; i < 4; ++i) {
            if constexpr (MODE == 2 || MODE == 3) {
                const u32x2 xx = *(const u32x2*)(p.Xb + (size_t)row * D + 256 * i + 4 * lane); v[i] = (f32x4){bflo(xx[0]), bfhi(xx[0]), bflo(xx[1]), bfhi(xx[1])}; }
            else v[i] = *(const f32x4*)(in + (size_t)row * D + 256 * i + 4 * lane); }
        if constexpr (MODE == 3) {
#pragma unroll
            for (int i = 0; i < 4; ++i) { const u32x2 dd = *(const u32x2*)(p.Db + (size_t)row * D + 256 * i + 4 * lane);
                v[i][0] = DN_ALPHA * v[i][0] + bflo(dd[0]); v[i][1] = DN_ALPHA * v[i][1] + bfhi(dd[0]); v[i][2] = DN_ALPHA * v[i][2] + bflo(dd[1]); v[i][3] = DN_ALPHA * v[i][3] + bfhi(dd[1]); } }
        if constexpr (MODE == 2) { const float w0 = p.ew[2 * row], w1 = p.ew[2 * row + 1];
#pragma unroll
            for (int i = 0; i < 4; ++i) { const u32x2 y0 = *(const u32x2*)(p.Ys + (size_t)(2 * row) * D + 256 * i + 4 * lane), y1 = *(const u32x2*)(p.Ys + (size_t)(2 * row + 1) * D + 256 * i + 4 * lane);
                v[i][0] = DN_ALPHA * v[i][0] + (w0 * bflo(y0[0]) + w1 * bflo(y1[0])); v[i][1] = DN_ALPHA * v[i][1] + (w0 * bfhi(y0[0]) + w1 * bfhi(y1[0]));
                v[i][2] = DN_ALPHA * v[i][2] + (w0 * bflo(y0[1]) + w1 * bflo(y1[1])); v[i][3] = DN_ALPHA * v[i][3] + (w0 * bfhi(y0[1]) + w1 * bfhi(y1[1])); } }
        float s = 0.f;
#pragma unroll
        for (int i = 0; i < 4; ++i) s += (v[i][0] + v[i][1]) + (v[i][2] + v[i][3]);
        const float mu = wsum(s, lane) * (1.f / D);
        float q = 0.f;
#pragma unroll
        for (int i = 0; i < 4; ++i) { v[i] = v[i] - mu; q += (v[i][0] * v[i][0] + v[i][1] * v[i][1]) + (v[i][2] * v[i][2] + v[i][3] * v[i][3]); }
        const float rs = rsqrtf(wsum(q, lane) * (1.f / D) + 1e-5f);
#pragma unroll
        for (int i = 0; i < 4; ++i) { v[i] = v[i] * rs * gg[i] + bb[i];
            if constexpr (MODE != 2) *(f32x4*)(outf + (size_t)row * D + 256 * i + 4 * lane) = v[i];
            u32x2 o = {cvt_pk_bf16(v[i][0], v[i][1]), cvt_pk_bf16(v[i][2], v[i][3])};
            *(u32x2*)(p.Xb + (size_t)row * D + 256 * i + 4 * lane) = o; }
        if constexpr (MODE == 1) {
            const float* wg = p.w_grp + (size_t)layer * D * 8; const float* we = p.w_exp + (size_t)layer * D * 64;
            float gl[8];
#pragma unroll
            for (int g = 0; g < 8; ++g) gl[g] = 0.f;
#pragma unroll
            for (int i = 0; i < 4; ++i)
#pragma unroll
                for (int j = 0; j < 4; ++j) { const int k = 256 * i + 4 * lane + j; const f32x4 a = *(const f32x4*)(wg + k * 8), b = *(const f32x4*)(wg + k * 8 + 4); const float xv = v[i][j];
                    gl[0] = fmaf(xv, a[0], gl[0]); gl[1] = fmaf(xv, a[1], gl[1]); gl[2] = fmaf(xv, a[2], gl[2]); gl[3] = fmaf(xv, a[3], gl[3]);
                    gl[4] = fmaf(xv, b[0], gl[4]); gl[5] = fmaf(xv, b[1], gl[5]); gl[6] = fmaf(xv, b[2], gl[6]); gl[7] = fmaf(xv, b[3], gl[7]); }
            float mx = -INFINITY; int gt = 0;
#pragma unroll
            for (int g = 0; g < 8; ++g) { gl[g] = wsum(gl[g], lane) + p.b_grp[layer * 8 + g]; if (gl[g] > mx) { mx = gl[g]; gt = g; } }
            gt = __builtin_amdgcn_readfirstlane(gt);
            float sum = 0.f;
#pragma unroll
            for (int g = 0; g < 8; ++g) sum += expf(gl[g] - mx);
            const float pg = 1.f / sum;
            float el[8];
#pragma unroll
            for (int e = 0; e < 8; ++e) el[e] = 0.f;
#pragma unroll
            for (int i = 0; i < 4; ++i)
#pragma unroll
                for (int j = 0; j < 4; ++j) { const int k = 256 * i + 4 * lane + j; const f32x4 a = *(const f32x4*)(we + k * 64 + gt * 8), b = *(const f32x4*)(we + k * 64 + gt * 8 + 4); const float xv = v[i][j];
                    el[0] = fmaf(xv, a[0], el[0]); el[1] = fmaf(xv, a[1], el[1]); el[2] = fmaf(xv, a[2], el[2]); el[3] = fmaf(xv, a[3], el[3]);
                    el[4] = fmaf(xv, b[0], el[4]); el[5] = fmaf(xv, b[1], el[5]); el[6] = fmaf(xv, b[2], el[6]); el[7] = fmaf(xv, b[3], el[7]); }
            float v1 = -INFINITY, v2 = -INFINITY; int i1 = 0, i2 = 0;
#pragma unroll
            for (int e = 0; e < 8; ++e) { const float vv = wsum(el[e], lane) + p.b_exp[layer * 64 + gt * 8 + e];
                if (vv > v1) { v2 = v1; i2 = i1; v1 = vv; i1 = e; } else if (vv > v2) { v2 = vv; i2 = e; } }
            if (lane == 0) { const float e2 = expf(v2 - v1), w1 = pg / (1.f + e2), w2 = pg * e2 / (1.f + e2);
                const int ea = gt * 8 + i1, eb = gt * 8 + i2; int* cn = p.cnt + layer * 64;
                p.ew[2 * row] = w1; p.ew[2 * row + 1] = w2;
                const int pa = atomicAdd(&cn[ea], 1); p.lists[ea * LCAP + pa] = 2 * row;
                const int pb = atomicAdd(&cn[eb], 1); p.lists[eb * LCAP + pb] = 2 * row + 1; }
        }
    }
}

__device__ __forceinline__ void wsum8(float (&x)[8], int lane) {
    float y[4], z[2], w;
#pragma unroll
    for (int k = 0; k < 4; ++k) { const bool hi = lane & 32; const float snd = hi ? x[k] : x[k + 4], keep = hi ? x[k + 4] : x[k]; y[k] = keep + shx(snd, 32, lane); }
#pragma unroll
    for (int k = 0; k < 2; ++k) { const bool hi = lane & 16; const float snd = hi ? y[k] : y[k + 2], keep = hi ? y[k + 2] : y[k]; z[k] = keep + shx(snd, 16, lane); }
    { const bool hi = lane & 8; const float snd = hi ? z[0] : z[1], keep = hi ? z[1] : z[0]; w = keep + shx(snd, 8, lane); }
    w += shx(w, 4, lane); w += shx(w, 2, lane); w += shx(w, 1, lane);
#pragma unroll
    for (int k = 0; k < 8; ++k) x[k] = __int_as_float(__builtin_amdgcn_readlane(__float_as_int(w), (k >> 2) * 32 + ((k >> 1) & 1) * 16 + (k & 1) * 8));
}
__device__ __forceinline__ void ph_ln1_router(const P& p, int layer) {
    constexpr int RR = 2;
    const int tid = tid_now(), lane0 = tid & 63, gw = sgpr_now((int)blockIdx.x) * 8 + (tid >> 6), nw = gridDim.x * 8;
    const float* gp = p.ln1_g + layer * D; const float* bp = p.ln1_b + layer * D;
    const float* wg = p.w_grp + (size_t)layer * D * 8; const float* we = p.w_exp + (size_t)layer * D * 64;
    for (int row0 = gw * RR; row0 < T; row0 += nw * RR) {
        int lane = lane0; asm volatile("" : "+v"(lane));
        f32x4 v[RR][4];
#pragma unroll
        for (int r = 0; r < RR; ++r)
#pragma unroll
            for (int i = 0; i < 4; ++i) { v[r][i] = *(const f32x4*)(p.X + (size_t)(row0 + r) * D + 256 * i + 4 * lane);
                const u32x2 dd = *(const u32x2*)(p.Db + (size_t)(row0 + r) * D + 256 * i + 4 * lane);
                v[r][i][0] = DN_ALPHA * v[r][i][0] + bflo(dd[0]); v[r][i][1] = DN_ALPHA * v[r][i][1] + bfhi(dd[0]); v[r][i][2] = DN_ALPHA * v[r][i][2] + bflo(dd[1]); v[r][i][3] = DN_ALPHA * v[r][i][3] + bfhi(dd[1]); }
#pragma unroll
        for (int r = 0; r < RR; ++r) {
            float s = 0.f;
#pragma unroll
            for (int i = 0; i < 4; ++i) s += (v[r][i][0] + v[r][i][1]) + (v[r][i][2] + v[r][i][3]);
            const float mu = wsum(s, lane) * (1.f / D);
            float q = 0.f;
#pragma unroll
            for (int i = 0; i < 4; ++i) { v[r][i] = v[r][i] - mu; q += (v[r][i][0] * v[r][i][0] + v[r][i][1] * v[r][i][1]) + (v[r][i][2] * v[r][i][2] + v[r][i][3] * v[r][i][3]); }
            const float rs = rsqrtf(wsum(q, lane) * (1.f / D) + 1e-5f);
#pragma unroll
            for (int i = 0; i < 4; ++i) { const f32x4 gg = *(const f32x4*)(gp + 256 * i + 4 * lane), bb = *(const f32x4*)(bp + 256 * i + 4 * lane);
                v[r][i] = v[r][i] * rs * gg + bb;
                u32x2 o = {cvt_pk_bf16(v[r][i][0], v[r][i][1]), cvt_pk_bf16(v[r][i][2], v[r][i][3])};
                *(u32x2*)(p.Xb + (size_t)(row0 + r) * D + 256 * i + 4 * lane) = o; } }
        float gl[RR][8];
#pragma unroll
        for (int r = 0; r < RR; ++r)
#pragma unroll
            for (int g = 0; g < 8; ++g) gl[r][g] = 0.f;
        {
            f32x4 wa[2][4], wb[2][4];
            asm volatile("" : "+v"(lane));
#pragma unroll
            for (int j = 0; j < 4; ++j) { const int k = 4 * lane + j; wa[0][j] = *(const f32x4*)(wg + k * 8); wb[0][j] = *(const f32x4*)(wg + k * 8 + 4); }
#pragma unroll
            for (int i = 0; i < 4; ++i) {
                if (i + 1 < 4) { asm volatile("" : "+v"(lane));
#pragma unroll
                    for (int j = 0; j < 4; ++j) { const int k = 256 * (i + 1) + 4 * lane + j; wa[(i + 1) & 1][j] = *(const f32x4*)(wg + k * 8); wb[(i + 1) & 1][j] = *(const f32x4*)(wg + k * 8 + 4); } }
                asm volatile("" ::: "memory");
#pragma unroll
                for (int j = 0; j < 4; ++j) { const f32x4 a = wa[i & 1][j], b = wb[i & 1][j];
#pragma unroll
                    for (int r = 0; r < RR; ++r) { const float xv = v[r][i][j];
                        gl[r][0] = fmaf(xv, a[0], gl[r][0]); gl[r][1] = fmaf(xv, a[1], gl[r][1]); gl[r][2] = fmaf(xv, a[2], gl[r][2]); gl[r][3] = fmaf(xv, a[3], gl[r][3]);
                        gl[r][4] = fmaf(xv, b[0], gl[r][4]); gl[r][5] = fmaf(xv, b[1], gl[r][5]); gl[r][6] = fmaf(xv, b[2], gl[r][6]); gl[r][7] = fmaf(xv, b[3], gl[r][7]); } } } }
        int gt[RR]; float pg[RR];
#pragma unroll
        for (int r = 0; r < RR; ++r) { wsum8(gl[r], lane);
            float mx = -INFINITY; int gi = 0;
#pragma unroll
            for (int g = 0; g < 8; ++g) { gl[r][g] += p.b_grp[layer * 8 + g]; if (gl[r][g] > mx) { mx = gl[r][g]; gi = g; } }
            float sum = 0.f;
#pragma unroll
            for (int g = 0; g < 8; ++g) sum += expf(gl[r][g] - mx);
            gt[r] = __builtin_amdgcn_readfirstlane(gi); pg[r] = 1.f / sum; }
        float el[RR][8];
#pragma unroll
        for (int r = 0; r < RR; ++r) {
#pragma unroll
            for (int e = 0; e < 8; ++e) el[r][e] = 0.f;
            f32x4 wa[2][4], wb[2][4];
            const float* wr_ = we + gt[r] * 8;
            asm volatile("" : "+v"(lane));
#pragma unroll
            for (int j = 0; j < 4; ++j) { const int k = 4 * lane + j; wa[0][j] = *(const f32x4*)(wr_ + k * 64); wb[0][j] = *(const f32x4*)(wr_ + k * 64 + 4); }
#pragma unroll
            for (int i = 0; i < 4; ++i) {
                if (i + 1 < 4) { asm volatile("" : "+v"(lane));
#pragma unroll
                    for (int j = 0; j < 4; ++j) { const int k = 256 * (i + 1) + 4 * lane + j; wa[(i + 1) & 1][j] = *(const f32x4*)(wr_ + k * 64); wb[(i + 1) & 1][j] = *(const f32x4*)(wr_ + k * 64 + 4); } }
                asm volatile("" ::: "memory");
#pragma unroll
                for (int j = 0; j < 4; ++j) { const f32x4 a = wa[i & 1][j], b = wb[i & 1][j]; const float xv = v[r][i][j];
                    el[r][0] = fmaf(xv, a[0], el[r][0]); el[r][1] = fmaf(xv, a[1], el[r][1]); el[r][2] = fmaf(xv, a[2], el[r][2]); el[r][3] = fmaf(xv, a[3], el[r][3]);
                    el[r][4] = fmaf(xv, b[0], el[r][4]); el[r][5] = fmaf(xv, b[1], el[r][5]); el[r][6] = fmaf(xv, b[2], el[r][6]); el[r][7] = fmaf(xv, b[3], el[r][7]); } } }
#pragma unroll
        for (int r = 0; r < RR; ++r) { wsum8(el[r], lane);
            float v1 = -INFINITY, v2 = -INFINITY; int i1 = 0, i2 = 0;
#pragma unroll
            for (int e = 0; e < 8; ++e) { const float vv = el[r][e] + p.b_exp[layer * 64 + gt[r] * 8 + e];
                if (vv > v1) { v2 = v1; i2 = i1; v1 = vv; i1 = e; } else if (vv > v2) { v2 = vv; i2 = e; } }
            if (lane == 0) { const int row = row0 + r; const float e2 = expf(v2 - v1), w1 = pg[r] / (1.f + e2), w2 = pg[r] * e2 / (1.f + e2);
                const int ea = gt[r] * 8 + i1, eb = gt[r] * 8 + i2; int* cn = p.cnt + layer * 64;
                p.ew[2 * row] = w1; p.ew[2 * row + 1] = w2;
                const int pa = atomicAdd(&cn[ea], 1); p.lists[ea * LCAP + pa] = 2 * row;
                const int pb = atomicAdd(&cn[eb], 1); p.lists[eb * LCAP + pb] = 2 * row + 1; } }
    }
}
__device__ __forceinline__ void ph_prologue(const P& p) {
    const int gtid = blockIdx.x * NTHR + tid_now(), gth = gridDim.x * NTHR;
    for (int idx = gtid; idx < T * 32; idx += gth) { const int t = idx >> 5, i = idx & 31;
        const float inv = (float)(1.0 / pow(10000.0, (double)(2 * i) / 64.0)); const float ang = (float)p.pos[t] * inv;
        p.cs[idx] = (float)cos((double)ang); p.sn[idx] = (float)sin((double)ang); }
    for (size_t i = gtid; i < (size_t)DEPTH * T * PLE / 4; i += gth) { const f32x4 v = ((const f32x4*)p.pin)[i]; u32x2 o = {cvt_pk_bf16(v[0], v[1]), cvt_pk_bf16(v[2], v[3])}; ((u32x2*)p.Pb)[i] = o; }
    ph_rows<0>(p, 0);
}

struct SchedBr { __device__ __forceinline__ bool carry(const ge::Unit& u) const { return u.g < 2; }
    const char* Ya; const char* Yb; const char* Yc; const char* W; int c, G;
    __device__ __forceinline__ bool next(int i, ge::Unit& u) const { const int tile = (i / 3) * G + c; if (tile >= 256) return false; u.g = i % 3; ge::tile_order(tile, 64, 4, u.pm, u.pn); return true; }
    __device__ __forceinline__ const char* aptr(const ge::Unit& u) const { return (u.g == 0 ? Ya : u.g == 1 ? Yb : Yc) + (size_t)u.pm * 256 * 512 * 2; }
    __device__ __forceinline__ const char* bptr(const ge::Unit& u) const { return W + ((size_t)u.g * 1024 + u.pn * 256) * 512 * 2; } };
struct EpiBr { const bf16_t* Hp; bf16_t* Mgb;
    __device__ __forceinline__ void operator()(ge::Acc& acc, const ge::Unit& u, int wr, int wc, int fr, int fq) const {
        const int row0 = u.pm * 256 + wr * 64 + fr, col0 = u.pn * 256 + wc * 32 + 8 * fq;
        const bool ratio = u.g < 2;
#pragma unroll
        for (int ai = 0; ai < 2; ++ai) {
            u32x4 gt[4][2], gn[4][2];
#pragma unroll
            for (int m = 0; m < 4; ++m)
#pragma unroll
                for (int bj = 0; bj < 2; ++bj) { const bf16_t* gp = Hp + (size_t)(row0 + ai * 128 + m * 16) * HW + H_GTA + u.g * 1024 + col0 + bj * 128;
                    gt[m][bj] = *(const u32x4*)gp; gn[m][bj] = ratio ? *(const u32x4*)(gp + 1024) : gt[m][bj]; }
            asm volatile("" ::: "memory");
#pragma unroll
            for (int m = 0; m < 4; ++m) { const int row = row0 + ai * 128 + m * 16;
#pragma unroll
                for (int bj = 0; bj < 2; ++bj) { const int col = col0 + bj * 128; const u32x4 g = gt[m][bj], d = gn[m][bj];
                    f32x4 s0 = {bflo(g[0]), bfhi(g[0]), bflo(g[1]), bfhi(g[1])}, s1 = {bflo(g[2]), bfhi(g[2]), bflo(g[3]), bfhi(g[3])};
                    if (ratio) { const f32x4 d0 = {bflo(d[0]), bfhi(d[0]), bflo(d[1]), bfhi(d[1])}, d1 = {bflo(d[2]), bfhi(d[2]), bflo(d[3]), bfhi(d[3])};
#pragma unroll
                        for (int j = 0; j < 4; ++j) { s0[j] = s0[j] * frcp(d0[j]); s1[j] = s1[j] * frcp(d1[j]); } }
                    acc[ai][bj][m][0] = acc[ai][bj][m][0] * s0; acc[ai][bj][m][1] = acc[ai][bj][m][1] * s1;
                    if (u.g == 2) { const f32x4 v0 = acc[ai][bj][m][0], v1 = acc[ai][bj][m][1];
                        u32x4 o = {cvt_pk_bf16(v0[0], v0[1]), cvt_pk_bf16(v0[2], v0[3]), cvt_pk_bf16(v1[0], v1[1]), cvt_pk_bf16(v1[2], v1[3])}; *(u32x4*)(Mgb + (size_t)row * D + col) = o; } } }
        }
    } };
struct SchedT4 : ge::NoCarry { const char* A; const char* B; int lda2, ldb2, c, G;
    __device__ __forceinline__ bool next(int i, ge::Unit& u) const { const int L = i * G + c; if (L >= 256) return false; u.g = 0; ge::tile_order(L, 64, 4, u.pm, u.pn); return true; }
    __device__ __forceinline__ const char* aptr(const ge::Unit& u) const { return A + (size_t)u.pm * lda2; }
    __device__ __forceinline__ const char* bptr(const ge::Unit& u) const { return B + (size_t)u.pn * ldb2; } };
struct EpiRes { bf16_t* Db;
    __device__ __forceinline__ void operator()(ge::Acc& acc, const ge::Unit& u, int wr, int wc, int fr, int fq) const {
        const int row0 = u.pm * 256 + wr * 64 + fr, col0 = u.pn * 256 + wc * 32 + 8 * fq;
#pragma unroll
        for (int ai = 0; ai < 2; ++ai)
#pragma unroll
            for (int m = 0; m < 4; ++m) { const size_t o = (size_t)(row0 + ai * 128 + m * 16) * D + col0;
#pragma unroll
                for (int bj = 0; bj < 2; ++bj) { const f32x4 v0 = acc[ai][bj][m][0], v1 = acc[ai][bj][m][1];
                    u32x4 w = {cvt_pk_bf16(v0[0], v0[1]), cvt_pk_bf16(v0[2], v0[3]), cvt_pk_bf16(v1[0], v1[1]), cvt_pk_bf16(v1[2], v1[3])}; *(u32x4*)(Db + o + bj * 128) = w; } }
    } };
struct EpiU { bf16_t* Ub;
    __device__ __forceinline__ void operator()(ge::Acc& acc, const ge::Unit& u, int wr, int wc, int fr, int fq) const {
        const int row0 = u.pm * 256 + wr * 64 + fr, col0 = u.pn * 256 + wc * 32 + 8 * fq;
#pragma unroll
        for (int ai = 0; ai < 2; ++ai)
#pragma unroll
            for (int m = 0; m < 4; ++m) { const size_t o = (size_t)(row0 + ai * 128 + m * 16) * D + col0;
#pragma unroll
                for (int bj = 0; bj < 2; ++bj) { const f32x4 v0 = acc[ai][bj][m][0], v1 = acc[ai][bj][m][1];
                    u32x4 w = {cvt_pk_bf16(v0[0], v0[1]), cvt_pk_bf16(v0[2], v0[3]), cvt_pk_bf16(v1[0], v1[1]), cvt_pk_bf16(v1[2], v1[3])}; *(u32x4*)(Ub + o + bj * 128) = w; } }
    } };
struct EpiPle { bf16_t* Db; const bf16_t* Ub; const float* bias;
    __device__ __forceinline__ void operator()(ge::Acc& acc, const ge::Unit& u, int wr, int wc, int fr, int fq) const {
        const int row0 = u.pm * 256 + wr * 64 + fr, col0 = u.pn * 256 + wc * 32 + 8 * fq;
        f32x4 bv[2][2];
#pragma unroll
        for (int bj = 0; bj < 2; ++bj) { bv[bj][0] = *(const f32x4*)(bias + col0 + bj * 128); bv[bj][1] = *(const f32x4*)(bias + col0 + bj * 128 + 4); }
#pragma unroll
        for (int ai = 0; ai < 2; ++ai) {
            u32x4 uv[4][2];
#pragma unroll
            for (int m = 0; m < 4; ++m)
#pragma unroll
                for (int bj = 0; bj < 2; ++bj) uv[m][bj] = *(const u32x4*)(Ub + (size_t)(row0 + ai * 128 + m * 16) * D + col0 + bj * 128);
            asm volatile("" ::: "memory");
#pragma unroll
            for (int m = 0; m < 4; ++m) { const size_t o = (size_t)(row0 + ai * 128 + m * 16) * D + col0;
#pragma unroll
                for (int bj = 0; bj < 2; ++bj) { const u32x4 uu = uv[m][bj];
                    f32x4 g0 = acc[ai][bj][m][0] + bv[bj][0], g1 = acc[ai][bj][m][1] + bv[bj][1];
#pragma unroll
                    for (int j = 0; j < 4; ++j) { g0[j] = frcp(1.f + __expf(-g0[j])); g1[j] = frcp(1.f + __expf(-g1[j])); }
                    const f32x4 u0 = {bflo(uu[0]), bfhi(uu[0]), bflo(uu[1]), bfhi(uu[1])}, u1 = {bflo(uu[2]), bfhi(uu[2]), bflo(uu[3]), bfhi(uu[3])};
                    g0 = g0 * u0; g1 = g1 * u1;
                    u32x4 w = {cvt_pk_bf16(g0[0], g0[1]), cvt_pk_bf16(g0[2], g0[3]), cvt_pk_bf16(g1[0], g1[1]), cvt_pk_bf16(g1[2], g1[3])}; *(u32x4*)(Db + o + bj * 128) = w; } } }
    } };

__device__ __forceinline__ void moe_table(LAS unsigned char* lds, const int* cnt) {
    LAS int* te = (LAS int*)(lds + 131072); LAS int* tr = te + 256; LAS int* cl = tr + 256; LAS int* nt = cl + 64;
    __syncthreads();
    const int tid = tid_now();
    if (tid < 64) {
        const int ce = cnt[tid], ne = (ce + 255) >> 8;
        int pre = ne;
#pragma unroll
        for (int o = 1; o < 64; o <<= 1) { const int t = __builtin_amdgcn_ds_bpermute(((tid - o) & 63) << 2, pre); if (tid >= o) pre += t; }
        const int base = pre - ne;
        cl[tid] = ce;
        for (int j = 0; j < ne; ++j) { te[base + j] = tid; tr[base + j] = 256 * j; }
        if (tid == 63) nt[0] = pre;
    }
    __syncthreads();
}
struct SchedM1 : ge::NoCarry { const char* Xb; const char* W; const int* lists; LAS int* te; int c, G;
    __device__ __forceinline__ bool next(int i, ge::Unit& u) const { const int L = i * G + c; if (L >= 2 * te[576]) return false; u.pm = L >> 1; u.pn = L & 1; u.g = te[u.pm]; return true; }
    __device__ __forceinline__ int arow(const ge::Unit& u, int r) const { const int n = te[512 + u.g], idx = min(te[256 + u.pm] + r, n - 1); return lists[u.g * LCAP + idx] >> 1; }
    __device__ __forceinline__ const char* aptr(const ge::Unit&) const { return Xb; }
    __device__ __forceinline__ const char* bptr(const ge::Unit& u) const { return W + ((size_t)u.g * 512 + u.pn * 256) * D * 2; } };
struct EpiM1 { bf16_t* Hbuf;
    __device__ __forceinline__ void operator()(ge::Acc& acc, const ge::Unit& u, int wr, int wc, int fr, int fq) const {
#pragma unroll
        for (int ai = 0; ai < 2; ++ai)
#pragma unroll
            for (int m = 0; m < 4; ++m) { const int row = ai * 128 + wr * 64 + m * 16 + fr;
                float h[8];
#pragma unroll
                for (int n = 0; n < 2; ++n)
#pragma unroll
                    for (int j = 0; j < 4; ++j) { const float g = acc[ai][0][m][n][j], uu = acc[ai][1][m][n][j]; h[4 * n + j] = g * frcp(1.f + __expf(-g)) * uu; }
                u32x4 o = {cvt_pk_bf16(h[0], h[1]), cvt_pk_bf16(h[2], h[3]), cvt_pk_bf16(h[4], h[5]), cvt_pk_bf16(h[6], h[7])};
                *(u32x4*)(Hbuf + ((size_t)u.pm * 256 + row) * EH + u.pn * 128 + wc * 32 + 8 * fq) = o; }
    } };
struct SchedM2 : ge::NoCarry { const char* Hb; const char* W; LAS int* te; int c, G;
    __device__ __forceinline__ bool next(int i, ge::Unit& u) const { const int L = i * G + c; if (L >= 4 * te[576]) return false; u.pm = L >> 2; u.pn = L & 3; u.g = te[u.pm]; return true; }
    __device__ __forceinline__ const char* aptr(const ge::Unit& u) const { return Hb + (size_t)u.pm * 256 * EH * 2; }
    __device__ __forceinline__ const char* bptr(const ge::Unit& u) const { return W + ((size_t)u.g * D + u.pn * 256) * EH * 2; } };
struct EpiM2 { bf16_t* Ys; const int* lists; LAS int* te;
    __device__ __forceinline__ void operator()(ge::Acc& acc, const ge::Unit& u, int wr, int wc, int fr, int fq) const {
        const int r0 = te[256 + u.pm], n = te[512 + u.g];
        int av[2][4];
#pragma unroll
        for (int ai = 0; ai < 2; ++ai)
#pragma unroll
            for (int m = 0; m < 4; ++m) { const int row = r0 + ai * 128 + wr * 64 + m * 16 + fr; av[ai][m] = row < n ? lists[u.g * LCAP + row] : -1; }
#pragma unroll
        for (int ai = 0; ai < 2; ++ai)
#pragma unroll
            for (int m = 0; m < 4; ++m) { const int a = av[ai][m];
                if (a >= 0) {
#pragma unroll
                    for (int bj = 0; bj < 2; ++bj) { const f32x4 v0 = acc[ai][bj][m][0], v1 = acc[ai][bj][m][1];
                        u32x4 o = {cvt_pk_bf16(v0[0], v0[1]), cvt_pk_bf16(v0[2], v0[3]), cvt_pk_bf16(v1[0], v1[1]), cvt_pk_bf16(v1[2], v1[3])};
                        *(u32x4*)(Ys + (size_t)a * D + u.pn * 256 + bj * 128 + wc * 32 + 8 * fq) = o; } } }
    } };

#define XB_TMO      128
#define XB_XCNT(j)  (256  + 64 * (j))
#define XB_XSUB(j)  (1280 + 64 * (j))
#define XB_XGEN(j)  (2304 + 64 * (j))
#define XB_TOP      3328
#define XB_TOPGEN   3392
#define XCD_BAR_WORDS 3456
#define XB_SPIN_CAP (1u << 18)

__device__ __forceinline__ unsigned xb_ld(unsigned* p)              { return __hip_atomic_load(p, __ATOMIC_RELAXED, __HIP_MEMORY_SCOPE_AGENT); }
__device__ __forceinline__ unsigned xb_add(unsigned* p, unsigned v) { return __hip_atomic_fetch_add(p, v, __ATOMIC_RELAXED, __HIP_MEMORY_SCOPE_AGENT); }
__device__ __forceinline__ unsigned xb_xcc_id() { return (unsigned)__builtin_amdgcn_s_getreg((3 << 11) | 20) & 0xFu; }
#define XB_SPIN(cond, bar) do { unsigned _sp = 0; while (cond) { __builtin_amdgcn_s_sleep(1); \
    if ((++_sp & 255u) == 0u) { if (xb_ld(&(bar)[XB_TMO])) break; if (_sp > XB_SPIN_CAP) { atomicAdd(&(bar)[XB_TMO], 1u); break; } } } } while (0)

struct XcdBarrier {
    unsigned* bar; unsigned x;
    volatile LAS unsigned* st;
};

__device__ __forceinline__ XcdBarrier xcd_barrier_post(unsigned* bar, volatile LAS unsigned* st) {
    XcdBarrier b; b.bar = bar; b.x = xb_xcc_id(); b.st = st;
    if (threadIdx.x == 0) (void)xb_add(&bar[XB_XCNT(b.x)], 1u);
    return b;
}
__device__ __forceinline__ void xcd_barrier_complete(unsigned* bar, unsigned x, unsigned& nloc, unsigned& nx) {
    const unsigned G = gridDim.x * gridDim.y * gridDim.z;
    unsigned sum, cnt, mine, sp = 0u;
    for (;;) {
        sum = 0u; cnt = 0u; mine = 0u;
#pragma unroll
        for (unsigned j = 0; j < 16; ++j) { const unsigned c = xb_ld(&bar[XB_XCNT(j)]); sum += c; cnt += (c > 0u) ? 1u : 0u; mine = (j == x) ? c : mine; }
        if (sum == G) break;
        __builtin_amdgcn_s_sleep(1);
        if ((++sp & 255u) == 0u) { if (xb_ld(&bar[XB_TMO])) break; if (sp > XB_SPIN_CAP) { atomicAdd(&bar[XB_TMO], 1u); break; } }
    }
    nloc = mine > 0u ? mine : 1u; nx = cnt > 0u ? cnt : 1u;
}

__device__ __forceinline__ void xcd_barrier(const XcdBarrier& b) {
    asm volatile("s_waitcnt vmcnt(0)" ::: "memory");
    __syncthreads();
    if (threadIdx.x == 0) {
        unsigned* bar = b.bar;
        __builtin_amdgcn_s_waitcnt(0);
        unsigned nloc = b.st[0], nx = b.st[1];
        if (nloc == 0u) { xcd_barrier_complete(bar, b.x, nloc, nx); b.st[0] = nloc; b.st[1] = nx; }
        const unsigned old = xb_add(&bar[XB_XSUB(b.x)], 1u);
        const unsigned gen = old / nloc;
        if (old + 1u == (gen + 1u) * nloc) {
            __builtin_amdgcn_fence(__ATOMIC_RELEASE, "agent");
            asm volatile("s_waitcnt vmcnt(0)" ::: "memory");
            const unsigned og = xb_add(&bar[XB_TOP], 1u);
            const unsigned tg = og / nx;
            if (og + 1u == (tg + 1u) * nx) xb_add(&bar[XB_TOPGEN], 1u);
            else XB_SPIN(xb_ld(&bar[XB_TOPGEN]) == tg, bar);
            __builtin_amdgcn_fence(__ATOMIC_ACQUIRE, "agent");
            xb_add(&bar[XB_XGEN(b.x)], 1u);
            asm volatile("s_waitcnt vmcnt(0)" ::: "memory");
        } else {
            XB_SPIN(xb_ld(&bar[XB_XGEN(b.x)]) == gen, bar);
            __builtin_amdgcn_fence(__ATOMIC_ACQUIRE, "agent");
            asm volatile("s_waitcnt vmcnt(0)" ::: "memory");
        }
    }
    __syncthreads();
}

enum { PH_PRO = 0, PH_CONV, PH_IN, PH_PREP_Q, PH_PREP_K, PH_PREP_V, PH_PREP_G, PH_ATT, PH_FIN, PH_BR, PH_WO, PH_LN1, PH_M1, PH_M2, PH_LN2, PH_PLE, PH_LN3 };
template <int PH> __global__ __launch_bounds__(NTHR, 2) void k_ph(P p, int layer) {
    extern __shared__ __attribute__((aligned(16))) unsigned char smem[];
    LAS unsigned char* lds = (LAS unsigned char*)smem;
    tid_setup();
    const int c = blockIdx.x, G = gridDim.x;
    if constexpr (PH == PH_PRO) ph_prologue(p);
    if constexpr (PH == PH_CONV) ph_convert(lds, p, layer);
    if constexpr (PH == PH_IN) { const MegaP m = mk_mega(p); SchedIn S{{}, (const char*)m.Xb, (const char*)m.Wb_in, (const char*)m.Wb_gv, c, G, 0}; EpiIn<2> E{m.Hp, m.GVt, m.ssq_q, m.ssq_kv}; ge::gemm_stream<EpiIn<2>, SchedIn, false>(lds, D, D, D, S, E); }
    if constexpr (PH == PH_PREP_Q) { const MlaP q = mk_mla(p); SchedMla<0> S{{}, (const char*)(q.Hp + H_CQ), (const char*)q.Wb_uq, c, G}; EpiMla<0> E{q}; ge::gemm_stream<EpiMla<0>, SchedMla<0>, false>(lds, 256, HW, 256, S, E); }
    if constexpr (PH == PH_PREP_K) { const MlaP q = mk_mla(p); SchedMla<1> S{{}, (const char*)(q.Hp + H_CKV), (const char*)q.Wb_uk, (c + 64) % G, G}; EpiMla<1> E{q}; ge::gemm_stream<EpiMla<1>, SchedMla<1>, false>(lds, 256, HW, 256, S, E); }
    if constexpr (PH == PH_PREP_V) { const MlaP q = mk_mla(p); SchedMla<2> S{{}, (const char*)q.Wb_uv, (const char*)(q.Hp + H_CKV), (c + 192) % G, G}; EpiMla<2> E{q}; ge::gemm_stream<EpiMla<2>, SchedMla<2>, false>(lds, 256, 256, HW, S, E); }
    if constexpr (PH == PH_PREP_G) { { const MegaP m = mk_mega(p); SchedIn S{{}, (const char*)m.Xb, (const char*)m.Wb_in, (const char*)m.Wb_gv, (c + 128) % G, G, 1}; EpiIn<0> E{m.Hp, m.GVt, m.ssq_q, m.ssq_kv}; ge::gemm_stream<EpiIn<0>, SchedIn, false>(lds, D, D, D, S, E); } const MlaP q = mk_mla(p); kr_phase(q, c * NTHR + tid_now(), G * NTHR); const GlaP g = mk_gla(p, layer); gla_g1(lds, g, c, G); }
    if constexpr (PH == PH_ATT) { const GlaP g = mk_gla(p, layer); gla_g2(lds, g, c); const MlaP q = mk_mla(p); attn_phase(lds, q, c); }
    if constexpr (PH == PH_FIN) { const GlaP g = mk_gla(p, layer); gla_g3(lds, g, c, G); conv_phase(g, c * NTHR + tid_now(), G * NTHR); attn_combine_bf16(g, c * NTHR + tid_now(), G * NTHR); }
    if constexpr (PH == PH_BR) { SchedBr S{(const char*)p.Yab, (const char*)p.Ybb, (const char*)p.Ycb, (const char*)p.Wb_br, c, G}; EpiBr E{p.Hp, p.Mgb}; ge::gemm_stream<EpiBr, SchedBr, false>(lds, 512, 512, 512, S, E); }
    if constexpr (PH == PH_WO) { SchedT4 S{{}, (const char*)p.Mgb, (const char*)p.Wb_o, 256 * D * 2, 256 * D * 2, c, G}; EpiRes E{p.Db}; ge::gemm_stream<EpiRes, SchedT4, false>(lds, D, D, D, S, E); }
    if constexpr (PH == PH_LN1) ph_ln1_router(p, layer);
    if constexpr (PH == PH_M1) { moe_table(lds, p.cnt + layer * 64); LAS int* te = (LAS int*)(lds + 131072);
        SchedM1 S{{}, (const char*)p.Xb, (const char*)p.Wb_gu, p.lists, te, c, G}; EpiM1 E{p.Hbuf}; ge::gemm_stream<EpiM1, SchedM1, true>(lds, D, D, D, S, E); }
    if constexpr (PH == PH_M2) { moe_table(lds, p.cnt + layer * 64); LAS int* te = (LAS int*)(lds + 131072);
        SchedM2 S{{}, (const char*)p.Hbuf, (const char*)p.Wb_d, te, c, G}; EpiM2 E{p.Ys, p.lists, te}; ge::gemm_stream<EpiM2, SchedM2, false>(lds, EH, EH, EH, S, E); }
    if constexpr (PH == PH_LN2) ph_rows<2>(p, layer);
    if constexpr (PH == PH_PLE) {
        { SchedT4 S{{}, (const char*)(p.Pb + (size_t)layer * T * PLE), (const char*)p.Wb_pu, 256 * PLE * 2, 256 * PLE * 2, c, G}; EpiU E{p.Ub}; ge::gemm_stream<EpiU, SchedT4, false>(lds, PLE, PLE, PLE, S, E); }
        { SchedT4 S{{}, (const char*)p.Xb, (const char*)p.Wb_pg, 256 * D * 2, 256 * D * 2, c, G}; EpiPle E{p.Db, p.Ub, p.b_pg + layer * D}; ge::gemm_stream<EpiPle, SchedT4, false>(lds, D, D, D, S, E); } }
    if constexpr (PH == PH_LN3) ph_rows<3>(p, layer);
}


typedef const P __attribute__((address_space(4))) CP;
__device__ __forceinline__ P load_params() { CP* q = (CP*)__builtin_amdgcn_kernarg_segment_ptr(); asm volatile("" : "+s"(q)); return *(const P*)q; }
#define GRID_BAR() do { XcdBarrier b_; b_.bar = load_params().bar; b_.x = xb_xcc_id(); b_.st = xbw; xcd_barrier(b_); } while (0)
__global__ __launch_bounds__(NTHR, 2) void k_mega(P p_arg) {
    extern __shared__ __attribute__((aligned(16))) unsigned char smem[];
    LAS unsigned char* lds = (LAS unsigned char*)smem;
    const int G = NBLK;
#define c sgpr_now((int)blockIdx.x)
    volatile LAS unsigned* xbw = (volatile LAS unsigned*)(lds + XBW_OFF);
    tid_setup();
    if (tid_now() < 4) xbw[tid_now()] = 0u;
    __syncthreads();
    (void)xcd_barrier_post(p_arg.bar, xbw);
    { const P p = load_params(); ph_prologue(p); }
    { const P p = load_params(); ph_convert(lds, p, 0); }
    GRID_BAR();
    for (int layer = 0; layer < DEPTH; ++layer) {
        { const P p = load_params(); const MegaP m = mk_mega(p); SchedIn S{{}, (const char*)m.Xb, (const char*)m.Wb_in, (const char*)m.Wb_gv, c, G, 0}; EpiIn<2> E{m.Hp, m.GVt, m.ssq_q, m.ssq_kv}; ge::gemm_stream<EpiIn<2>, SchedIn, false>(lds, D, D, D, S, E); }
        GRID_BAR();
        { const P p = load_params(); const MlaP q = mk_mla(p);
          { SchedMla<0> S{{}, (const char*)(q.Hp + H_CQ), (const char*)q.Wb_uq, (c >= 128 ? c - 128 : c < 64 ? c + 128 : -1), 256}; EpiMla<0> E{q}; ge::gemm_stream<EpiMla<0>, SchedMla<0>, false>(lds, 256, HW, 256, S, E); }
          { SchedMla<1> S{{}, (const char*)(q.Hp + H_CKV), (const char*)q.Wb_uk, (c >= 128 ? c - 128 : -1), 128}; EpiMla<1> E{q}; ge::gemm_stream<EpiMla<1>, SchedMla<1>, false>(lds, 256, HW, 256, S, E); }
          { SchedMla<2> S{{}, (const char*)q.Wb_uv, (const char*)(q.Hp + H_CKV), (c >= 128 ? c - 128 : -1), 128}; EpiMla<2> E{q}; ge::gemm_stream<EpiMla<2>, SchedMla<2>, false>(lds, 256, 256, HW, S, E); }
          { const MegaP m = mk_mega(p); SchedIn S{{}, (const char*)m.Xb, (const char*)m.Wb_in, (const char*)m.Wb_gv, c, G, 1}; EpiIn<0> E{m.Hp, m.GVt, m.ssq_q, m.ssq_kv}; ge::gemm_stream<EpiIn<0>, SchedIn, false>(lds, D, D, D, S, E); }
          kr_phase(q, c * NTHR + tid_now(), G * NTHR);
          const GlaP g = mk_gla(p, layer); gla_g1(lds, g, c, G); }
        GRID_BAR();
        { const P p = load_params(); const GlaP g = mk_gla(p, layer); gla_g2(lds, g, c); const MlaP q = mk_mla(p); attn_phase(lds, q, c); }
        GRID_BAR();
        { const P p = load_params(); const GlaP g = mk_gla(p, layer); gla_g3(lds, g, c, G); conv_phase(g, c * NTHR + tid_now(), G * NTHR); attn_combine_bf16(g, c * NTHR + tid_now(), G * NTHR); }
        GRID_BAR();
        { const P p = load_params(); SchedBr S{(const char*)p.Yab, (const char*)p.Ybb, (const char*)p.Ycb, (const char*)p.Wb_br, c, G}; EpiBr E{p.Hp, p.Mgb}; ge::gemm_stream<EpiBr, SchedBr, false>(lds, 512, 512, 512, S, E); }
        GRID_BAR();
        { const P p = load_params(); SchedT4 S{{}, (const char*)p.Mgb, (const char*)p.Wb_o, 256 * D * 2, 256 * D * 2, c, G}; EpiRes E{p.Db}; ge::gemm_stream<EpiRes, SchedT4, false>(lds, D, D, D, S, E); }
        GRID_BAR();
        { const P p = load_params(); ph_ln1_router(p, layer); }
        GRID_BAR();
        { const P p = load_params(); moe_table(lds, p.cnt + layer * 64); LAS int* te = (LAS int*)(lds + 131072);
          SchedM1 S{{}, (const char*)p.Xb, (const char*)p.Wb_gu, p.lists, te, c, G}; EpiM1 E{p.Hbuf}; ge::gemm_stream<EpiM1, SchedM1, true>(lds, D, D, D, S, E);
          const int extra = max(0, 2 * te[576] - NBLK), cu = c - extra;
          SchedT4 SU{{}, (const char*)(p.Pb + (size_t)layer * T * PLE), (const char*)p.Wb_pu, 256 * PLE * 2, 256 * PLE * 2, cu >= 0 ? cu : 256, NBLK - extra}; EpiU EU{p.Ub};
          ge::gemm_stream<EpiU, SchedT4, false>(lds, PLE, PLE, PLE, SU, EU); }
        GRID_BAR();
        { const P p = load_params(); LAS int* te = (LAS int*)(lds + 131072);
          SchedM2 S{{}, (const char*)p.Hbuf, (const char*)p.Wb_d, te, c, G}; EpiM2 E{p.Ys, p.lists, te}; ge::gemm_stream<EpiM2, SchedM2, false>(lds, EH, EH, EH, S, E); }
        GRID_BAR();
        { const P p = load_params(); ph_rows<2>(p, layer); }
        GRID_BAR();
        { const P p = load_params(); SchedT4 S{{}, (const char*)p.Xb, (const char*)p.Wb_pg, 256 * D * 2, 256 * D * 2, c, G}; EpiPle E{p.Db, p.Ub, p.b_pg + layer * D}; ge::gemm_stream<EpiPle, SchedT4, false>(lds, D, D, D, S, E); }
        GRID_BAR();
        { const P p = load_params(); ph_rows<3>(p, layer); }
        if (layer + 1 < DEPTH) { { const P p = load_params(); ph_convert(lds, p, layer + 1); } GRID_BAR(); }
    }
#undef c
}

template <int PH> static void launch_ph(const P& p, int layer, hipStream_t st) {
    static bool set = false;
    if (!set) { (void)hipFuncSetAttribute((const void*)k_ph<PH>, hipFuncAttributeMaxDynamicSharedMemorySize, LDS_BYTES); set = true; }
    hipLaunchKernelGGL((k_ph<PH>), dim3(NBLK), dim3(NTHR), LDS_BYTES, st, p, layer);
}
extern "C" void kernel_launch(void* const* d_in, const int* in_sizes, int n_in, void* d_out, int out_size, void* d_ws, size_t ws_size, hipStream_t st) {
    (void)in_sizes; (void)n_in; (void)out_size;
    P p{};
    p.x = (const float*)d_in[0]; p.pin = (const float*)d_in[1]; p.pos = (const int*)d_in[2]; p.ln0_g = (const float*)d_in[3]; p.ln0_b = (const float*)d_in[4];
    p.w_in = (const float*)d_in[5]; p.w_conv = (const float*)d_in[6]; p.w_gg = (const float*)d_in[7]; p.b_gg = (const float*)d_in[8]; p.gla_ng = (const float*)d_in[9];
    p.qn_g = (const float*)d_in[10]; p.kvn_g = (const float*)d_in[11]; p.w_uq = (const float*)d_in[12]; p.w_ukv = (const float*)d_in[13]; p.w_br = (const float*)d_in[14]; p.w_o = (const float*)d_in[15];
    p.ln1_g = (const float*)d_in[16]; p.ln1_b = (const float*)d_in[17]; p.w_grp = (const float*)d_in[18]; p.b_grp = (const float*)d_in[19]; p.w_exp = (const float*)d_in[20]; p.b_exp = (const float*)d_in[21];
    p.w_gate = (const float*)d_in[22]; p.w_up = (const float*)d_in[23]; p.w_down = (const float*)d_in[24]; p.ln2_g = (const float*)d_in[25]; p.ln2_b = (const float*)d_in[26];
    p.w_pg = (const float*)d_in[27]; p.b_pg = (const float*)d_in[28]; p.w_pu = (const float*)d_in[29]; p.ln3_g = (const float*)d_in[30]; p.ln3_b = (const float*)d_in[31];
    p.out = (float*)d_out;
    char* w = (char*)d_ws; size_t off = 0;
    auto alloc = [&](size_t bytes) { void* r = w + off; off += (bytes + 255) & ~(size_t)255; return r; };
    p.bar = (unsigned*)alloc(16384); p.cnt = (int*)alloc(DEPTH * 64 * 4);
    const size_t zero_bytes = off;
    p.X = (float*)alloc((size_t)T * D * 4); p.Z = (float*)alloc((size_t)T * D * 4); p.Xb = (bf16_t*)alloc((size_t)T * D * 2); p.Db = (bf16_t*)alloc((size_t)T * D * 2);
    p.cs = (float*)alloc((size_t)T * 32 * 4); p.sn = (float*)alloc((size_t)T * 32 * 4); p.ssq_q = (float*)alloc((size_t)4 * T * 4); p.ssq_kv = (float*)alloc((size_t)4 * T * 4);
    p.Hp = (bf16_t*)alloc((size_t)T * HW * 2); p.GVt = (bf16_t*)alloc((size_t)T * 512 * 2);
    p.Qb = (bf16_t*)alloc((size_t)T * 768 * 2); p.KnImg = (bf16_t*)alloc((size_t)T * 512 * 2); p.VtImg = (bf16_t*)alloc((size_t)T * 512 * 2); p.KrImg = (bf16_t*)alloc((size_t)T * 64 * 2);
    p.MLpart = (float*)alloc((size_t)512 * 256 * 2 * 4);
    p.QE = (bf16_t*)alloc((size_t)T * 256 * 2); p.OI = (float*)alloc((size_t)T * 512 * 4); p.kvT = (float*)alloc((size_t)1024 * 8192 * 4); p.decay = (float*)alloc((size_t)1024 * 64 * 4); p.spT = (bf16_t*)alloc((size_t)1024 * 8192 * 2);
    p.Yab = (bf16_t*)alloc((size_t)T * 512 * 2); p.Ybb = (bf16_t*)alloc((size_t)T * 512 * 2); p.Ycb = (bf16_t*)alloc((size_t)T * 512 * 2); p.Mgb = (bf16_t*)alloc((size_t)T * D * 2);
    p.ew = (float*)alloc((size_t)T * 2 * 4); p.lists = (int*)alloc((size_t)NE * LCAP * 4);
    p.Hbuf = (bf16_t*)alloc((size_t)192 * 256 * EH * 2); p.Ys = (bf16_t*)alloc((size_t)2 * T * D * 2); p.Ub = (bf16_t*)alloc((size_t)T * D * 2); p.Pb = (bf16_t*)alloc((size_t)DEPTH * T * PLE * 2);
    p.Wb_in = (bf16_t*)alloc((size_t)HW * D * 2); p.Wb_gv = (bf16_t*)alloc((size_t)512 * D * 2); p.Wb_uq = (bf16_t*)alloc((size_t)768 * 256 * 2); p.Wb_uk = (bf16_t*)alloc((size_t)512 * 256 * 2); p.Wb_uv = (bf16_t*)alloc((size_t)512 * 256 * 2);
    p.Wb_br = (bf16_t*)alloc((size_t)3 * D * 512 * 2); p.Wb_o = (bf16_t*)alloc((size_t)D * D * 2); p.Wb_gu = (bf16_t*)alloc((size_t)NE * 512 * D * 2); p.Wb_d = (bf16_t*)alloc((size_t)NE * D * EH * 2);
    p.Wb_pg = (bf16_t*)alloc((size_t)D * D * 2); p.Wb_pu = (bf16_t*)alloc((size_t)D * PLE * 2);
    if (off > ws_size) return;
    (void)hipMemsetAsync(d_ws, 0, zero_bytes, st);
#if defined(MULTI_LAUNCH)
    launch_ph<PH_PRO>(p, 0, st);
    for (int i = 0; i < DEPTH; ++i) {
        launch_ph<PH_CONV>(p, i, st); launch_ph<PH_IN>(p, i, st);
        launch_ph<PH_PREP_Q>(p, i, st); launch_ph<PH_PREP_K>(p, i, st); launch_ph<PH_PREP_V>(p, i, st); launch_ph<PH_PREP_G>(p, i, st);
        launch_ph<PH_ATT>(p, i, st); launch_ph<PH_FIN>(p, i, st); launch_ph<PH_BR>(p, i, st); launch_ph<PH_WO>(p, i, st); launch_ph<PH_LN1>(p, i, st);
        launch_ph<PH_M1>(p, i, st); launch_ph<PH_M2>(p, i, st); launch_ph<PH_LN2>(p, i, st); launch_ph<PH_PLE>(p, i, st); launch_ph<PH_LN3>(p, i, st);
    }
#else
    static bool set = false;
    if (!set) { (void)hipFuncSetAttribute((const void*)k_mega, hipFuncAttributeMaxDynamicSharedMemorySize, LDS_BYTES); set = true; }
    hipLaunchKernelGGL(k_mega, dim3(NBLK), dim3(NTHR), LDS_BYTES, st, p);
#endif
}
```

```cpp
#include <hip/hip_runtime.h>
#include <hip/hip_bf16.h>
#include <stdint.h>

constexpr int T = 16384, D = 1024, DEPTH = 4, PLE = 256;
constexpr int NE = 64, EH = 256;
constexpr int INW = 6608;
constexpr int O_GV = 2048;
constexpr float DN_ALPHA = 1.681792830507429f;
constexpr int LCAP = 32768;
#define LAS __attribute__((address_space(3)))
typedef unsigned short bf16_t;
typedef short bf16x8 __attribute__((ext_vector_type(8)));
typedef float f32x4 __attribute__((ext_vector_type(4)));
typedef float f32x16 __attribute__((ext_vector_type(16)));
typedef unsigned u32x4 __attribute__((ext_vector_type(4)));
typedef unsigned u32x2 __attribute__((ext_vector_type(2)));
typedef float f32x2 __attribute__((ext_vector_type(2)));
constexpr int NBLK = 256, NTHR = 512;
constexpr int STAGE_BYTES = 131072, LDS_BYTES = 147456 + 512, XBW_OFF = 147456 + 256;
constexpr int HW = 6144;
constexpr int H_AB = 0, H_AC = 512, H_AX = 1024, H_GQ = 1536, H_GK = 1792, H_GR = 2048, H_CQ = 2560, H_CKV = 2816, H_KR = 2944, H_GLR = 3008, H_GTA = 3072, H_GTB = 4096, H_GTC = 5120;

__device__ __forceinline__ unsigned cvt_pk_bf16(float lo, float hi) { unsigned r; asm volatile("v_cvt_pk_bf16_f32 %0, %1, %2" : "=v"(r) : "v"(lo), "v"(hi)); return r; }
constexpr int WTAB_OFF = 147456;
__device__ __forceinline__ int tid_now() {
    const unsigned hw = (unsigned)__builtin_amdgcn_s_getreg((5 << 11) | 4) & 63u;
    extern __shared__ __attribute__((aligned(16))) unsigned char smem_tid[];
    const int w = __builtin_amdgcn_readfirstlane(*(volatile LAS int*)((LAS unsigned char*)smem_tid + WTAB_OFF + 4 * hw));
    int l = (int)__builtin_amdgcn_mbcnt_hi(~0u, __builtin_amdgcn_mbcnt_lo(~0u, 0u));
    asm volatile("" : "+v"(l));
    return w * 64 + l; }
__device__ __forceinline__ void tid_setup() {
    const unsigned hw = (unsigned)__builtin_amdgcn_s_getreg((5 << 11) | 4) & 63u;
    extern __shared__ __attribute__((aligned(16))) unsigned char smem_tid[];
    if ((threadIdx.x & 63) == 0) *(volatile LAS int*)((LAS unsigned char*)smem_tid + WTAB_OFF + 4 * hw) = (int)(threadIdx.x >> 6);
    __syncthreads(); }
__device__ __forceinline__ int sgpr_now(int v) { asm volatile("" : "+s"(v)); return v; }
__device__ __forceinline__ float shx(float v, int mask, int lane) { return __int_as_float(__builtin_amdgcn_ds_bpermute((lane ^ mask) << 2, __float_as_int(v))); }
__device__ __forceinline__ float frcp(float x) { return __builtin_amdgcn_rcpf(x); }
__device__ __forceinline__ float bf2f(bf16_t b) { return __uint_as_float(((unsigned)b) << 16); }
__device__ __forceinline__ float bflo(unsigned w) { return __uint_as_float(w << 16); }
__device__ __forceinline__ float bfhi(unsigned w) { return __uint_as_float(w & 0xffff0000u); }

namespace ge {
constexpr int BM = 256, BK = 64, HALF = 128, HTB = HALF * BK * 2;
__device__ __forceinline__ int lds_byte(int r, int c) { const int st = (r >> 4) * 2 + (c >> 5), rr = r & 15, cc = c & 31, ob = rr * 64 + cc * 2; return st * 1024 + (ob ^ (((ob >> 9) & 1) << 5)); }
__device__ __forceinline__ void stage_rc(int b, int& R, int& C) { const int st = b / 1024, sb = b % 1024, swz = sb ^ (((sb >> 9) & 1) << 5); R = (st >> 1) * 16 + swz / 64; C = (st & 1) * 32 + (swz % 64) / 2; }
__device__ __forceinline__ int perm32(int rho) { const int n = rho >> 4, i = rho & 15; return 8 * (i >> 2) + 4 * n + (i & 3); }
struct Unit { int pm, pn, g; };
typedef f32x4 Acc[2][2][4][2];
struct NoCarry { __device__ __forceinline__ bool carry(const struct Unit&) const { return false; } };

struct NoHook { __device__ __forceinline__ void operator()(int) const {} };
template <class Epi, class Sched, bool GATHER, class Hook = NoHook>
__device__ __forceinline__ void gemm_stream(LAS unsigned char* lds, const int K, const int lda, const int ldb, const Sched& S, const Epi& E, const Hook& H = Hook{}) {
    const int tid = tid_now(), wid = __builtin_amdgcn_readfirstlane(tid >> 6), lane = tid & 63, wr = wid >> 2, wc = wid & 3, fr = lane & 15, fq = lane >> 4;
    const int nt = K / BK;
    Unit cur, nxt; int ui = 0;
    if (!S.next(0, cur)) return;
    unsigned voffA[2][2], nvoffA[2][2], voffB[2][2];
#pragma unroll
    for (int i = 0; i < 2; ++i) { int R, C; stage_rc(tid * 16 + i * 8192, R, C); const int Rb = (R & ~31) + perm32(R & 31);
        voffB[0][i] = (unsigned)(Rb * ldb + C) * 2u; voffB[1][i] = (unsigned)((Rb + 128) * ldb + C) * 2u;
        if constexpr (GATHER) { voffA[0][i] = (unsigned)(S.arow(cur, R) * lda + C) * 2u; voffA[1][i] = (unsigned)(S.arow(cur, R + 128) * lda + C) * 2u; }
        else { voffA[0][i] = (unsigned)(R * lda + C) * 2u; voffA[1][i] = (unsigned)((R + 128) * lda + C) * 2u; }
        nvoffA[0][i] = voffA[0][i]; nvoffA[1][i] = voffA[1][i]; }
    const size_t kstep = (size_t)(BK * 2);
    const unsigned ldsw = (unsigned)wid * 1024u;
    const int aoff = lds_byte(wr * 64 + fr, fq * 8), boff = lds_byte(wc * 32 + fr, fq * 8);
#define GE_SA(b, h) (((b) * 2 + (h)) * HTB)
#define GE_SB(b, h) ((4 + (b) * 2 + (h)) * HTB)
#define GE_STAGE(bufoff, gbase, voff) do { _Pragma("unroll") for (int _i = 0; _i < 2; ++_i) \
        __builtin_amdgcn_global_load_lds((const unsigned*)((const char*)(gbase) + (voff)[_i]), (LAS unsigned*)(lds + (bufoff) + ldsw + _i * 8192), 16, 0, 0); } while (0)
#define GE_LDA(dst, b, h) do { _Pragma("unroll") for (int m = 0; m < 4; ++m) _Pragma("unroll") for (int k = 0; k < 2; ++k) dst[m][k] = *(const LAS bf16x8*)(lds + GE_SA(b, h) + aoff + m * 2048 + k * 1024); } while (0)
#define GE_LDB(dst, b, h) do { _Pragma("unroll") for (int n = 0; n < 2; ++n) _Pragma("unroll") for (int k = 0; k < 2; ++k) dst[n][k] = *(const LAS bf16x8*)(lds + GE_SB(b, h) + boff + n * 2048 + k * 1024); } while (0)
#define GE_MMA(ai, bj, At, Bt) do { __builtin_amdgcn_s_setprio(1); _Pragma("unroll") for (int m = 0; m < 4; ++m) _Pragma("unroll") for (int n = 0; n < 2; ++n) _Pragma("unroll") for (int k = 0; k < 2; ++k) \
        acc[ai][bj][m][n] = __builtin_amdgcn_mfma_f32_16x16x32_bf16(Bt[n][k], At[m][k], acc[ai][bj][m][n], 0, 0, 0); __builtin_amdgcn_s_setprio(0); } while (0)
#define GE_WAIT_V(n) asm volatile("s_waitcnt vmcnt(" #n ")" ::: "memory")
#define GE_WAIT_L(n) asm volatile("s_waitcnt lgkmcnt(" #n ")" ::: "memory")
#define GE_BAR __builtin_amdgcn_s_barrier()
#define GE_SCHED __builtin_amdgcn_sched_barrier(0)
    Acc acc;
#pragma unroll
    for (int a = 0; a < 2; ++a)
#pragma unroll
        for (int b = 0; b < 2; ++b)
#pragma unroll
            for (int m = 0; m < 4; ++m)
#pragma unroll
                for (int n = 0; n < 2; ++n) acc[a][b][m][n] = (f32x4){0.f, 0.f, 0.f, 0.f};
    bf16x8 At[4][2], B0[2][2], B1[2][2];
    const char* cA = S.aptr(cur); const char* cB = S.bptr(cur);
    GE_STAGE(GE_SB(0, 0), cB, voffB[0]); GE_STAGE(GE_SA(0, 0), cA, voffA[0]); GE_STAGE(GE_SB(0, 1), cB, voffB[1]); GE_STAGE(GE_SA(0, 1), cA, voffA[1]);
    if (wr == 1) GE_BAR;
    GE_WAIT_V(4); GE_BAR;
    GE_STAGE(GE_SB(1, 0), cB + kstep, voffB[0]); GE_STAGE(GE_SA(1, 0), cA + kstep, voffA[0]); GE_STAGE(GE_SB(1, 1), cB + kstep, voffB[1]);
    GE_WAIT_V(6); GE_BAR;
    for (;;) {
        const bool has_next = S.next(ui + 1, nxt);
        const char* nA = has_next ? S.aptr(nxt) : cA; const char* nB = has_next ? S.bptr(nxt) : cB;
#pragma unroll 1
        for (int t = 0; t < nt; t += 2) {
            const bool last = (t == nt - 2);
            const char* a1 = cA + (size_t)(t + 1) * kstep;
            const char* a2 = last ? nA : cA + (size_t)(t + 2) * kstep; const char* b2 = last ? nB : cB + (size_t)(t + 2) * kstep;
            const char* a3 = a2 + kstep; const char* b3 = b2 + kstep;
            if constexpr (GATHER) { if (last && has_next) {
#pragma unroll
                for (int i = 0; i < 2; ++i) { int R, C; stage_rc(tid * 16 + i * 8192, R, C);
                    nvoffA[0][i] = (unsigned)(S.arow(nxt, R) * lda + C) * 2u; nvoffA[1][i] = (unsigned)(S.arow(nxt, R + 128) * lda + C) * 2u; } } }
            unsigned va2[2][2];
#pragma unroll
            for (int h = 0; h < 2; ++h)
#pragma unroll
                for (int i = 0; i < 2; ++i) va2[h][i] = (GATHER && last) ? nvoffA[h][i] : voffA[h][i];
            GE_LDB(B0, 0, 0); GE_SCHED; GE_LDA(At, 0, 0); GE_STAGE(GE_SA(1, 1), a1, voffA[1]);
            GE_WAIT_L(8); GE_BAR; GE_WAIT_L(0); GE_MMA(0, 0, At, B0); GE_BAR; GE_SCHED;
            GE_LDB(B1, 0, 1); GE_STAGE(GE_SB(0, 0), b2, voffB[0]);
            GE_BAR; GE_WAIT_L(0); GE_MMA(0, 1, At, B1); GE_BAR;
            GE_LDA(At, 0, 1); GE_STAGE(GE_SA(0, 0), a2, va2[0]);
            GE_BAR; GE_WAIT_L(0); GE_MMA(1, 0, At, B0); GE_BAR; GE_SCHED;
            GE_STAGE(GE_SB(0, 1), b2, voffB[1]);
            GE_WAIT_V(6); GE_BAR; GE_MMA(1, 1, At, B1); GE_BAR;
            GE_LDB(B0, 1, 0); GE_SCHED; GE_LDA(At, 1, 0); GE_STAGE(GE_SA(0, 1), a2, va2[1]);
            GE_WAIT_L(8); GE_BAR; GE_WAIT_L(0); GE_MMA(0, 0, At, B0); GE_BAR; GE_SCHED;
            GE_LDB(B1, 1, 1); GE_STAGE(GE_SB(1, 0), b3, voffB[0]);
            GE_BAR; GE_WAIT_L(0); GE_MMA(0, 1, At, B1); GE_BAR;
            GE_LDA(At, 1, 1); GE_STAGE(GE_SA(1, 0), a3, va2[0]);
            GE_BAR; GE_WAIT_L(0); GE_MMA(1, 0, At, B0); GE_BAR; GE_SCHED;
            GE_STAGE(GE_SB(1, 1), b3, voffB[1]);
            GE_WAIT_V(6); GE_BAR; GE_MMA(1, 1, At, B1); GE_BAR;
        }
        { int tz = tid; asm volatile("" : "+v"(tz));
          const int wid2 = tz >> 6, lane2 = tz & 63; E(acc, cur, wid2 >> 2, wid2 & 3, lane2 & 15, lane2 >> 4); }
        if (!has_next) break;
        H(ui);
        if (!S.carry(cur)) {
#pragma unroll
        for (int a = 0; a < 2; ++a)
#pragma unroll
            for (int b = 0; b < 2; ++b)
#pragma unroll
                for (int m = 0; m < 4; ++m)
#pragma unroll
                    for (int n = 0; n < 2; ++n) acc[a][b][m][n] = (f32x4){0.f, 0.f, 0.f, 0.f}; }
        cur = nxt; cA = nA; cB = nB; ++ui;
        if (GATHER) {
#pragma unroll
            for (int h = 0; h < 2; ++h)
#pragma unroll
                for (int i = 0; i < 2; ++i) voffA[h][i] = nvoffA[h][i]; }
    }
    GE_WAIT_V(0);
    if (wr == 0) GE_BAR;
    GE_BAR;
#undef GE_SA
#undef GE_SB
#undef GE_STAGE
#undef GE_LDA
#undef GE_LDB
#undef GE_MMA
#undef GE_WAIT_V
#undef GE_WAIT_L
#undef GE_BAR
#undef GE_SCHED
}
__device__ __forceinline__ void tile_order(int L, int nM, int nN, int& pm, int& pn) {
    const int nwg = nM * nN; int wgid = L;
    { const int q = nwg / 8, r = nwg % 8, xcd = wgid % 8, off = wgid / 8; wgid = (xcd < r ? xcd * (q + 1) : r * (q + 1) + (xcd - r) * q) + off; }
    const int nig = 8 * nN, gid = wgid / nig, fm = gid * 8, gsz = (nM - fm) < 8 ? (nM - fm) : 8;
    pm = fm + ((wgid % nig) % gsz); pn = (wgid % nig) / gsz;
}
}
struct MapInMain { __device__ __forceinline__ int operator()(int s) const {
    if (s < 2048) return s;
    if (s < 2560) return 2576 + (s - 2048);
    if (s < 2816) return 3088 + (s - 2560);
    if (s < 2944) return 3344 + (s - 2816);
    if (s < 3008) return 3472 + (s - 2944);
    if (s < 3024) return 2560 + (s - 3008);
    if (s < 3072) return -1;
    return 3536 + (s - 3072); } };
struct MapOff { int off; __device__ __forceinline__ int operator()(int s) const { return off + s; } };struct MegaP {
    const float* w_in; bf16_t* Wb_in; bf16_t* Wb_gv; const bf16_t* Xb; bf16_t* Hp; bf16_t* GVt; float* ssq_q; float* ssq_kv;
};
struct SchedIn : ge::NoCarry {
    const char* Xb; const char* Wm; const char* Wg; int c, G, gv;
    __device__ __forceinline__ bool next(int i, ge::Unit& u) const {
        const int L = i * G + c;
        if (gv) { if (L >= 128) return false; u.g = 0; u.pm = L >> 1; u.pn = 8 + (L & 1); return true; }
        if (L >= 1536) return false;
        if (L < 1408) { u.g = 0; ge::tile_order(L, 64, 22, u.pm, u.pn); if (u.pn >= 8) u.pn += 2; } else { u.g = 1; const int l = L - 1408; u.pm = l & 1; u.pn = l >> 1; }
        return true; }
    __device__ __forceinline__ const char* aptr(const ge::Unit& u) const { return u.g == 0 ? Xb + (size_t)u.pm * 256 * D * 2 : Wg + (size_t)u.pm * 256 * D * 2; }
    __device__ __forceinline__ const char* bptr(const ge::Unit& u) const { return u.g == 0 ? Wm + (size_t)u.pn * 256 * D * 2 : Xb + (size_t)u.pn * 256 * D * 2; }
};
template <int GV> struct EpiIn {
    bf16_t* Hp; bf16_t* GVt; float* ssq_q; float* ssq_kv;
    __device__ __forceinline__ void operator()(ge::Acc& acc, const ge::Unit& u, int wr, int wc, int fr, int fq) const {
        if (GV == 0 || (GV == 2 && u.g == 0)) {
            const int row0 = u.pm * 256 + wr * 64 + fr, col0 = u.pn * 256 + wc * 32 + 8 * fq;
            const bool sg = u.pn >= 12;
#pragma unroll
            for (int ai = 0; ai < 2; ++ai)
#pragma unroll
                for (int m = 0; m < 4; ++m) { const int row = row0 + ai * 128 + m * 16; bf16_t* rp = Hp + (size_t)row * HW + col0;
                    float sq0 = 0.f, sq1 = 0.f;
#pragma unroll
                    for (int bj = 0; bj < 2; ++bj) { f32x4 v0 = acc[ai][bj][m][0], v1 = acc[ai][bj][m][1];
                        if (sg) {
#pragma unroll
                            for (int j = 0; j < 4; ++j) { v0[j] = frcp(1.f + __expf(-v0[j])); v1[j] = frcp(1.f + __expf(-v1[j])); } }
                        const float s = v0[0] * v0[0] + v0[1] * v0[1] + v0[2] * v0[2] + v0[3] * v0[3] + v1[0] * v1[0] + v1[1] * v1[1] + v1[2] * v1[2] + v1[3] * v1[3];
                        if (bj == 0) sq0 = s; else sq1 = s;
                        u32x4 o = {cvt_pk_bf16(v0[0], v0[1]), cvt_pk_bf16(v0[2], v0[3]), cvt_pk_bf16(v1[0], v1[1]), cvt_pk_bf16(v1[2], v1[3])};
                        *(u32x4*)(rp + bj * 128) = o; }
                    if (u.pn == 10 || u.pn == 11) {
                        float s = (u.pn == 10) ? (sq0 + sq1) : sq0;
                        { const int ln = fq * 16 + fr; s += shx(s, 16, ln); s += shx(s, 32, ln); }
                        if (fq == 0) { float* dst = (u.pn == 10 ? ssq_q : ssq_kv); dst[(size_t)wc * T + row] = s; } } }
        } else {
#pragma unroll
            for (int ai = 0; ai < 2; ++ai)
#pragma unroll
                for (int m = 0; m < 4; ++m) { const int r = u.pm * 256 + ai * 128 + wr * 64 + m * 16 + fr, h = r >> 7, e = r & 127;
#pragma unroll
                    for (int bj = 0; bj < 2; ++bj) { const int t0 = u.pn * 256 + bj * 128 + wc * 32 + 8 * fq;
                        const int chunk = t0 >> 6, p0 = (t0 & 48) + ((t0 & 8) >> 1);
                        bf16_t* base = GVt + ((size_t)(chunk * 4 + h) * 128 + e) * 64;
                        const f32x4 v0 = acc[ai][bj][m][0], v1 = acc[ai][bj][m][1];
                        u32x2 o0 = {cvt_pk_bf16(v0[0], v0[1]), cvt_pk_bf16(v0[2], v0[3])}, o1 = {cvt_pk_bf16(v1[0], v1[1]), cvt_pk_bf16(v1[2], v1[3])};
                        *(u32x2*)(base + p0) = o0; *(u32x2*)(base + p0 + 8) = o1; } }
        }
    }
};
constexpr float QSCALE = 0.07216878364870322f * 1.4426950408889634f;
struct MapQ { __device__ __forceinline__ int operator()(int s) const {
    if (s < 512) return (s >> 7) * 192 + (s & 127);
    const int s2 = s - 512, bj = s2 >> 7, w = s2 & 127; return (w >> 5) * 192 + 128 + bj * 32 + (w & 31); } };
struct MapKV { int voff; __device__ __forceinline__ int operator()(int s) const { return (s >> 7) * 256 + voff + (s & 127); } };

struct MlaP {
    const float* w_uq; const float* w_ukv; const float* qn_g; const float* kvn_g;
    bf16_t* Wb_uq; bf16_t* Wb_uk; bf16_t* Wb_uv;
    const bf16_t* Hp; const float* ssq_q; const float* ssq_kv; const float* cs; const float* sn;
    bf16_t* Qb; bf16_t* KnImg; bf16_t* VtImg; bf16_t* KrImg; float* Opart; float* MLpart; float* Yc;
};
__device__ __forceinline__ float rstd4(const float* ssq, int row, float invw) {
    const float s = (ssq[row] + ssq[T + row]) + (ssq[2 * T + row] + ssq[3 * T + row]); return rsqrtf(s * invw + 1e-6f); }

template <int mode> struct SchedMla : ge::NoCarry { const char* A; const char* B; int c, G;
    __device__ __forceinline__ bool next(int i, ge::Unit& u) const {
        if (c < 0) return false;
        const int L = i * G + c; u.g = mode;
        if (mode == 0) { if (L >= 192) return false; u.pm = L / 3; u.pn = L % 3; }
        else if (mode == 1) { if (L >= 128) return false; u.pm = L >> 1; u.pn = L & 1; }
        else { if (L >= 128) return false; u.pm = L & 1; u.pn = L >> 1; }
        return true; }
    __device__ __forceinline__ const char* aptr(const ge::Unit& u) const { return mode == 2 ? A + (size_t)u.pm * 256 * 256 * 2 : A + (size_t)u.pm * 256 * HW * 2; }
    __device__ __forceinline__ const char* bptr(const ge::Unit& u) const { return mode == 2 ? B + (size_t)u.pn * 256 * HW * 2 : B + (size_t)u.pn * 256 * 256 * 2; }
};
template <int MODE> struct EpiMla { MlaP p;
    __device__ __forceinline__ void operator()(ge::Acc& acc, const ge::Unit& u, int wr, int wc, int fr, int fq) const {
        if constexpr (MODE == 0) {
            float rsv[2][4];
#pragma unroll
            for (int ai = 0; ai < 2; ++ai)
#pragma unroll
                for (int m = 0; m < 4; ++m) rsv[ai][m] = rstd4(p.ssq_q, u.pm * 256 + ai * 128 + wr * 64 + m * 16 + fr, 1.f / 256.f) * QSCALE;
#pragma unroll
            for (int ai = 0; ai < 2; ++ai) {
#pragma unroll
                for (int m = 0; m < 4; ++m) { const int t = u.pm * 256 + ai * 128 + wr * 64 + m * 16 + fr; const float rs = rsv[ai][m];
                    if (u.pn < 2) {
#pragma unroll
                        for (int bj = 0; bj < 2; ++bj) { const int c0 = u.pn * 256 + bj * 128 + wc * 32 + 8 * fq, head = c0 >> 7, dim = c0 & 127;
                            const f32x4 v0 = acc[ai][bj][m][0] * rs, v1 = acc[ai][bj][m][1] * rs;
                            u32x4 o = {cvt_pk_bf16(v0[0], v0[1]), cvt_pk_bf16(v0[2], v0[3]), cvt_pk_bf16(v1[0], v1[1]), cvt_pk_bf16(v1[2], v1[3])};
                            *(u32x4*)(p.Qb + (size_t)t * 768 + head * 192 + dim) = o; }
                    } else { const int head = wc, i0 = 8 * fq;
                        float o1[8], o2[8];
#pragma unroll
                        for (int n = 0; n < 2; ++n) { const f32x4 c4 = *(const f32x4*)(p.cs + (size_t)t * 32 + i0 + 4 * n), s4 = *(const f32x4*)(p.sn + (size_t)t * 32 + i0 + 4 * n);
#pragma unroll
                            for (int j = 0; j < 4; ++j) { const float x1 = acc[ai][0][m][n][j] * rs, x2 = acc[ai][1][m][n][j] * rs; o1[4 * n + j] = x1 * c4[j] - x2 * s4[j]; o2[4 * n + j] = x1 * s4[j] + x2 * c4[j]; } }
                        u32x4 a = {cvt_pk_bf16(o1[0], o1[1]), cvt_pk_bf16(o1[2], o1[3]), cvt_pk_bf16(o1[4], o1[5]), cvt_pk_bf16(o1[6], o1[7])};
                        u32x4 b = {cvt_pk_bf16(o2[0], o2[1]), cvt_pk_bf16(o2[2], o2[3]), cvt_pk_bf16(o2[4], o2[5]), cvt_pk_bf16(o2[6], o2[7])};
                        *(u32x4*)(p.Qb + (size_t)t * 768 + head * 192 + 128 + i0) = a; *(u32x4*)(p.Qb + (size_t)t * 768 + head * 192 + 160 + i0) = b; } } }
        } else if constexpr (MODE == 1) {
            float rsv[2][4];
#pragma unroll
            for (int ai = 0; ai < 2; ++ai)
#pragma unroll
                for (int m = 0; m < 4; ++m) rsv[ai][m] = rstd4(p.ssq_kv, u.pm * 256 + ai * 128 + wr * 64 + m * 16 + fr, 1.f / 128.f);
            asm volatile("" ::: "memory");
#pragma unroll
            for (int ai = 0; ai < 2; ++ai)
#pragma unroll
                for (int m = 0; m < 4; ++m) { const int t = u.pm * 256 + ai * 128 + wr * 64 + m * 16 + fr; const float rs = rsv[ai][m];
                    const int tile = t >> 6, key = t & 63;
#pragma unroll
                    for (int bj = 0; bj < 2; ++bj) { const int c0 = u.pn * 256 + bj * 128 + wc * 32 + 8 * fq, head = c0 >> 7, chunk = (c0 & 127) >> 3;
                        const f32x4 v0 = acc[ai][bj][m][0] * rs, v1 = acc[ai][bj][m][1] * rs;
                        u32x4 o = {cvt_pk_bf16(v0[0], v0[1]), cvt_pk_bf16(v0[2], v0[3]), cvt_pk_bf16(v1[0], v1[1]), cvt_pk_bf16(v1[2], v1[3])};
                        *(u32x4*)((char*)p.KnImg + ((size_t)(head * 256 + tile) * 16384) + key * 256 + ((chunk ^ (key & 15)) << 4)) = o; } }
        } else {
#pragma unroll
            for (int bj = 0; bj < 2; ++bj) { const int t0 = u.pn * 256 + bj * 128 + wc * 32 + 8 * fq;
                float rs[8];
#pragma unroll
                for (int j = 0; j < 8; ++j) rs[j] = rstd4(p.ssq_kv, t0 + j, 1.f / 128.f);
                const int tile = t0 >> 6, p0 = (t0 & 48) + ((t0 & 8) >> 1);
#pragma unroll
                for (int ai = 0; ai < 2; ++ai)
#pragma unroll
                    for (int m = 0; m < 4; ++m) { asm volatile("" ::: "memory"); const int r = u.pm * 256 + ai * 128 + wr * 64 + m * 16 + fr, head = r >> 7, d = r & 127;
                        char* base = (char*)p.VtImg + ((size_t)(head * 256 + tile) * 16384) + d * 128;
                        const f32x4 v0 = acc[ai][bj][m][0], v1 = acc[ai][bj][m][1];
                        u32x2 o0 = {cvt_pk_bf16(v0[0] * rs[0], v0[1] * rs[1]), cvt_pk_bf16(v0[2] * rs[2], v0[3] * rs[3])};
                        u32x2 o1 = {cvt_pk_bf16(v1[0] * rs[4], v1[1] * rs[5]), cvt_pk_bf16(v1[2] * rs[6], v1[3] * rs[7])};
                        const int sw = (d >> 1) & 7, pa = p0, pb = p0 + 8;
                        *(u32x2*)(base + (((pa >> 3) ^ sw) << 4) + (pa & 7) * 2) = o0;
                        *(u32x2*)(base + (((pb >> 3) ^ sw) << 4) + (pb & 7) * 2) = o1; } }
        }
    }
};
__device__ __forceinline__ void kr_phase(const MlaP& p, int gtid, int gthreads) {
    for (int idx = gtid; idx < T * 4; idx += gthreads) { const int t = idx >> 2, c = idx & 3, i0 = 8 * c;
        const u32x4 a = *(const u32x4*)(p.Hp + (size_t)t * HW + H_KR + i0), b = *(const u32x4*)(p.Hp + (size_t)t * HW + H_KR + 32 + i0);
        float o1[8], o2[8];
#pragma unroll
        for (int n = 0; n < 2; ++n) { const f32x4 c4 = *(const f32x4*)(p.cs + (size_t)t * 32 + i0 + 4 * n), s4 = *(const f32x4*)(p.sn + (size_t)t * 32 + i0 + 4 * n);
#pragma unroll
            for (int j = 0; j < 4; ++j) { const int e = 4 * n + j; const unsigned wa = a[e >> 1], wb = b[e >> 1];
                const float x1 = (e & 1) ? bfhi(wa) : bflo(wa), x2 = (e & 1) ? bfhi(wb) : bflo(wb);
                o1[e] = x1 * c4[j] - x2 * s4[j]; o2[e] = x1 * s4[j] + x2 * c4[j]; } }
        u32x4 oa = {cvt_pk_bf16(o1[0], o1[1]), cvt_pk_bf16(o1[2], o1[3]), cvt_pk_bf16(o1[4], o1[5]), cvt_pk_bf16(o1[6], o1[7])};
        u32x4 ob = {cvt_pk_bf16(o2[0], o2[1]), cvt_pk_bf16(o2[2], o2[3]), cvt_pk_bf16(o2[4], o2[5]), cvt_pk_bf16(o2[6], o2[7])};
        const int tile = t >> 6, key = t & 63, sw = (key >> 1) & 7;
        char* base = (char*)p.KrImg + (size_t)tile * 8192 + key * 128;
        *(u32x4*)(base + ((c ^ sw) << 4)) = oa; *(u32x4*)(base + (((c + 4) ^ sw) << 4)) = ob; }
}
constexpr int ATT_STEPS = 130;
__device__ __forceinline__ void attn_item(LAS unsigned char* lds, const MlaP& p, int head, int b, int j0, int j1, int slot) {
    const int tid = tid_now(), wid = __builtin_amdgcn_readfirstlane(tid >> 6), lane = tid & 63, q = lane & 31, hh = lane >> 5;
    const int grp = wid >> 2, n = j1 - j0;
    const int trow = b * 256 + wid * 32 + q;
    bf16x8 qf[12];
    { const bf16_t* qp = p.Qb + (size_t)trow * 768 + head * 192 + 8 * hh;
#pragma unroll
      for (int s = 0; s < 12; ++s) qf[s] = *(const bf16x8*)(qp + 16 * s); }
    f32x16 O[4];
#pragma unroll
    for (int d = 0; d < 4; ++d)
#pragma unroll
        for (int r = 0; r < 16; ++r) O[d][r] = 0.f;
    float m_run = -1e30f, l_run = 0.f;
    const char* knb = (const char*)p.KnImg + (size_t)head * 256 * 16384; const char* vtb = (const char*)p.VtImg + (size_t)head * 256 * 16384; const char* krb = (const char*)p.KrImg;
    const unsigned lo = (unsigned)lane * 16u;
    constexpr int KB = 24576, VOFF = 3 * KB, VB = 16384;
#define AT_ISSUE(k) do { const unsigned _ko = (unsigned)((k) % 3) * KB, _vo = VOFF + (unsigned)((k) & 3) * VB; const size_t _j = (size_t)(j0 + (k)); \
        __builtin_amdgcn_global_load_lds((const unsigned*)(knb + _j * 16384 + (wid * 2) * 1024 + lo), (LAS unsigned*)(lds + _ko + (wid * 2) * 1024), 16, 0, 0); \
        __builtin_amdgcn_global_load_lds((const unsigned*)(knb + _j * 16384 + (wid * 2 + 1) * 1024 + lo), (LAS unsigned*)(lds + _ko + (wid * 2 + 1) * 1024), 16, 0, 0); \
        __builtin_amdgcn_global_load_lds((const unsigned*)(krb + _j * 8192 + wid * 1024 + lo), (LAS unsigned*)(lds + _ko + 16384 + wid * 1024), 16, 0, 0); \
        __builtin_amdgcn_global_load_lds((const unsigned*)(vtb + _j * 16384 + (wid * 2) * 1024 + lo), (LAS unsigned*)(lds + _vo + (wid * 2) * 1024), 16, 0, 0); \
        __builtin_amdgcn_global_load_lds((const unsigned*)(vtb + _j * 16384 + (wid * 2 + 1) * 1024 + lo), (LAS unsigned*)(lds + _vo + (wid * 2 + 1) * 1024), 16, 0, 0); } while (0)
#define AT_TOP(k) do { if ((k) + 1 < n) asm volatile("s_waitcnt vmcnt(5)" ::: "memory"); else asm volatile("s_waitcnt vmcnt(0)" ::: "memory"); \
        __builtin_amdgcn_s_barrier(); asm volatile("" ::: "memory"); if ((k) + 2 < n) AT_ISSUE((k) + 2); } while (0)
    const int kn_off0 = q * 256, kn_sw = q & 15, kr_off0 = q * 128, kr_sw = (q >> 1) & 7, vt_sw = (q >> 1) & 7;
    constexpr float THR = 8.f;
    f32x16 S0, S1; bool sval = false, first = true; int sjj = 0, sk = 0;
    auto QK = [&](int k) __attribute__((always_inline)) {
        const int jj = j0 + k - 4 * b; sjj = jj; sk = k; sval = !(jj >= 0 && 64 * jj > 32 * wid + 31);
        if (sval) {
            LAS unsigned char* bb = lds + (k % 3) * KB;
            const float mref = first ? 0.f : m_run;
#pragma unroll
            for (int r = 0; r < 16; ++r) { S0[r] = -mref; S1[r] = -mref; }
#pragma unroll
            for (int s = 0; s < 8; ++s) {
                const bf16x8 k0 = *(const LAS bf16x8*)(bb + kn_off0 + (((2 * s + hh) ^ kn_sw) << 4));
                const bf16x8 k1 = *(const LAS bf16x8*)(bb + 8192 + kn_off0 + (((2 * s + hh) ^ kn_sw) << 4));
                S0 = __builtin_amdgcn_mfma_f32_32x32x16_bf16(k0, qf[s], S0, 0, 0, 0);
                S1 = __builtin_amdgcn_mfma_f32_32x32x16_bf16(k1, qf[s], S1, 0, 0, 0); }
#pragma unroll
            for (int s = 0; s < 4; ++s) {
                const bf16x8 k0 = *(const LAS bf16x8*)(bb + 16384 + kr_off0 + (((2 * s + hh) ^ kr_sw) << 4));
                const bf16x8 k1 = *(const LAS bf16x8*)(bb + 16384 + 4096 + kr_off0 + (((2 * s + hh) ^ kr_sw) << 4));
                S0 = __builtin_amdgcn_mfma_f32_32x32x16_bf16(k0, qf[8 + s], S0, 0, 0, 0);
                S1 = __builtin_amdgcn_mfma_f32_32x32x16_bf16(k1, qf[8 + s], S1, 0, 0, 0); } }
    };
    auto SMPV = [&]() __attribute__((always_inline)) {
        if (sval) {
            LAS unsigned char* vb = lds + VOFF + (sk & 3) * VB;
            const float mref = first ? 0.f : m_run;
            if (sjj >= 0) {
                const int dq = wid * 32 + q - 64 * sjj - 4 * hh;
                const float NEG = -__builtin_inff();
#pragma unroll
                for (int r = 0; r < 16; ++r) { const int c = (r & 3) + 8 * (r >> 2);
                    if (c > dq) S0[r] = NEG;
                    if (c + 32 > dq) S1[r] = NEG; } }
            float mx = S0[0];
#pragma unroll
            for (int r = 1; r < 16; ++r) mx = fmaxf(mx, S0[r]);
#pragma unroll
            for (int r = 0; r < 16; ++r) mx = fmaxf(mx, S1[r]);
            { auto rr = __builtin_amdgcn_permlane32_swap(__float_as_uint(mx), __float_as_uint(mx), false, false); mx = fmaxf(__uint_as_float(rr[0]), __uint_as_float(rr[1])); }
            float alpha = 1.f;
            if (first || !__all(mx <= THR)) {
                const float mn = fmaxf(m_run, mref + mx), sh = mn - mref;
                alpha = __builtin_amdgcn_exp2f(m_run - mn); m_run = mn;
#pragma unroll
                for (int r = 0; r < 16; ++r) { S0[r] -= sh; S1[r] -= sh; }
#pragma unroll
                for (int d = 0; d < 4; ++d)
#pragma unroll
                    for (int r = 0; r < 16; ++r) O[d][r] *= alpha;
                first = false;
            }
            float sum = 0.f;
#pragma unroll
            for (int r = 0; r < 16; ++r) { S0[r] = __builtin_amdgcn_exp2f(S0[r]); S1[r] = __builtin_amdgcn_exp2f(S1[r]); sum += S0[r] + S1[r]; }
            l_run = l_run * alpha + sum;
            bf16x8 pf[4];
#pragma unroll
            for (int h2 = 0; h2 < 2; ++h2) {
                u32x4 a = {cvt_pk_bf16(S0[8 * h2 + 0], S0[8 * h2 + 1]), cvt_pk_bf16(S0[8 * h2 + 2], S0[8 * h2 + 3]), cvt_pk_bf16(S0[8 * h2 + 4], S0[8 * h2 + 5]), cvt_pk_bf16(S0[8 * h2 + 6], S0[8 * h2 + 7])};
                u32x4 c = {cvt_pk_bf16(S1[8 * h2 + 0], S1[8 * h2 + 1]), cvt_pk_bf16(S1[8 * h2 + 2], S1[8 * h2 + 3]), cvt_pk_bf16(S1[8 * h2 + 4], S1[8 * h2 + 5]), cvt_pk_bf16(S1[8 * h2 + 6], S1[8 * h2 + 7])};
                pf[h2] = *(bf16x8*)&a; pf[2 + h2] = *(bf16x8*)&c; }
#pragma unroll
            for (int d = 0; d < 4; ++d) {
#pragma unroll
                for (int s2 = 0; s2 < 4; ++s2) {
                    const bf16x8 vf = *(const LAS bf16x8*)(vb + (d * 32 + q) * 128 + (((2 * s2 + hh) ^ vt_sw) << 4));
                    O[d] = __builtin_amdgcn_mfma_f32_32x32x16_bf16(vf, pf[s2], O[d], 0, 0, 0); } }
        }
    };
    AT_ISSUE(0);
    if (n > 1) AT_ISSUE(1);
    if (grp == 0) {
#pragma unroll 1
        for (int k = 0; k < n; ++k) { AT_TOP(k); QK(k); SMPV(); }
    } else {
#pragma unroll 1
        for (int k = 0; k < n; ++k) { AT_TOP(k); SMPV(); QK(k); }
        SMPV();
    }
    asm volatile("" ::: "memory"); __builtin_amdgcn_s_barrier(); asm volatile("" ::: "memory");
#undef AT_ISSUE
#undef AT_TOP
    { auto rr = __builtin_amdgcn_permlane32_swap(__float_as_uint(l_run), __float_as_uint(l_run), false, false); l_run = __uint_as_float(rr[0]) + __uint_as_float(rr[1]); }
    bf16_t* op = (bf16_t*)p.Opart + ((size_t)slot * 256 + wid * 32 + q) * 128 + 4 * hh;
#pragma unroll
    for (int d = 0; d < 4; ++d)
#pragma unroll
        for (int g = 0; g < 4; ++g) { u32x2 v = {cvt_pk_bf16(O[d][4 * g], O[d][4 * g + 1]), cvt_pk_bf16(O[d][4 * g + 2], O[d][4 * g + 3])}; *(u32x2*)(op + d * 32 + g * 8) = v; }
    if (hh == 0) { float* ml = p.MLpart + ((size_t)slot * 256 + wid * 32 + q) * 2; ml[0] = m_run; ml[1] = l_run; }
}
__device__ __forceinline__ void attn_phase(LAS unsigned char* lds, const MlaP& p, int c) {
    const int head = c >> 6, cc = c & 63, pp = cc >> 1, bl = 63 - pp, nl = 4 * (64 - pp);
    if ((cc & 1) == 0) attn_item(lds, p, head, bl, 0, ATT_STEPS, 2 * c);
    else { attn_item(lds, p, head, bl, ATT_STEPS, nl, 2 * c); attn_item(lds, p, head, pp, 0, 4 * (pp + 1), 2 * c + 1); }
}
struct GlaP {
    const bf16_t* Hp; const bf16_t* GVt; const float* wg; const float* bg; const float* ng; const float* wconv;
    bf16_t* QE; float* OI; float* kvT; float* decay; bf16_t* spT; bf16_t* Yab; bf16_t* Ybb; bf16_t* Ycb;
    const float* Opart; const float* MLpart;
};
__device__ __forceinline__ int pos16(int i) { return (i & 48) | ((i & 4) << 1) | ((i & 8) >> 1) | (i & 3); }
__device__ __forceinline__ void gla_g1(LAS unsigned char* lds, const GlaP& p, int c, int G) {
    const int tid = tid_now(), wid = __builtin_amdgcn_readfirstlane(tid >> 6), lane = tid & 63, l31 = lane & 31, hh = lane >> 5;
    LAS float* bsm = (LAS float*)lds; LAS float* gtot = (LAS float*)(lds + 17408); LAS float* blast = (LAS float*)(lds + 19456);
    LAS unsigned char* qeL = lds + 20480; LAS unsigned char* keL = lds + 28672; LAS unsigned char* ktL = lds + 36864;
    const int eb = wid & 3, hb = wid >> 2;
    struct G1In { bf16x8 vf[4]; u32x4 ga[8], gb[8], qv, kv; };
    auto g1_load = [&](int u, G1In& I) {
        const int n = u >> 2, h = u & 3;
        const bf16_t* vp = p.GVt + ((size_t)u * 128 + eb * 32 + l31) * 64 + 8 * hh;
#pragma unroll
        for (int s4 = 0; s4 < 4; ++s4) I.vf[s4] = *(const bf16x8*)(vp + 16 * s4);
        const int g = tid >> 6;
#pragma unroll
        for (int k = 0; k < 8; ++k) { const bf16_t* gp = p.Hp + (size_t)(64 * n + 8 * g + k) * HW + H_GLR; I.ga[k] = *(const u32x4*)gp; I.gb[k] = *(const u32x4*)(gp + 8); }
        const int i = tid >> 3, d0 = 8 * (tid & 7); const size_t t = (size_t)64 * n + i;
        I.qv = *(const u32x4*)(p.Hp + t * HW + H_GQ + h * 64 + d0); I.kv = *(const u32x4*)(p.Hp + t * HW + H_GK + h * 64 + d0); };
    G1In cur;
    if (c < 1024) g1_load(c, cur);
    for (int u = c; u < 1024; u += G) {
        const int n = u >> 2, h = u & 3;
        { const int d = tid & 63, g = tid >> 6;
          float w[16];
#pragma unroll
          for (int r = 0; r < 16; ++r) w[r] = p.wg[r * 256 + h * 64 + d];
          const float bias = p.bg[h * 64 + d];
          float cs[8]; float run = 0.f;
#pragma unroll
          for (int k = 0; k < 8; ++k) {
              const u32x4 g0 = cur.ga[k], g1 = cur.gb[k];
              float la = bias;
#pragma unroll
              for (int r = 0; r < 4; ++r) { la += bflo(g0[r]) * w[2 * r] + bfhi(g0[r]) * w[2 * r + 1]; la += bflo(g1[r]) * w[8 + 2 * r] + bfhi(g1[r]) * w[8 + 2 * r + 1]; }
              const float ls = (fminf(la, 0.f) - __logf(1.f + __expf(-fabsf(la)))) * (1.f / 16.f);
              run += ls; cs[k] = run; }
          gtot[g * 64 + d] = run;
          __syncthreads();
          float pre = 0.f, tot = 0.f;
#pragma unroll
          for (int gg = 0; gg < 8; ++gg) { const float v = gtot[gg * 64 + d]; tot += v; if (gg < g) pre += v; }
#pragma unroll
          for (int k = 0; k < 8; ++k) bsm[(8 * g + k) * 68 + d] = pre + cs[k];
          if (g == 0) { blast[d] = tot; p.decay[(size_t)u * 64 + d] = __expf(tot); } }
        __syncthreads();
        { const int i = tid >> 3, cc = tid & 7, d0 = 8 * cc; const size_t t = (size_t)64 * n + i;
          const u32x4 qv = cur.qv, kv = cur.kv;
          float b[8], bl[8];
          { const f32x4 b0 = *(const LAS f32x4*)(bsm + i * 68 + d0), b1 = *(const LAS f32x4*)(bsm + i * 68 + d0 + 4), l0 = *(const LAS f32x4*)(blast + d0), l1 = *(const LAS f32x4*)(blast + d0 + 4);
#pragma unroll
            for (int j = 0; j < 4; ++j) { b[j] = b0[j]; b[4 + j] = b1[j]; bl[j] = l0[j]; bl[4 + j] = l1[j]; } }
          float qe[8], ke[8], kt[8];
#pragma unroll
          for (int j = 0; j < 8; ++j) { const float qq = (j & 1) ? bfhi(qv[j >> 1]) : bflo(qv[j >> 1]), kk = (j & 1) ? bfhi(kv[j >> 1]) : bflo(kv[j >> 1]);
              qe[j] = qq * 0.125f * __expf(b[j]); ke[j] = kk * __expf(-b[j]); kt[j] = kk * __expf(bl[j] - b[j]); }
          const u32x4 qo = {cvt_pk_bf16(qe[0], qe[1]), cvt_pk_bf16(qe[2], qe[3]), cvt_pk_bf16(qe[4], qe[5]), cvt_pk_bf16(qe[6], qe[7])};
          const u32x4 ko = {cvt_pk_bf16(ke[0], ke[1]), cvt_pk_bf16(ke[2], ke[3]), cvt_pk_bf16(ke[4], ke[5]), cvt_pk_bf16(ke[6], ke[7])};
          const int sw = (i >> 1) & 7;
          *(LAS u32x4*)(qeL + i * 128 + ((cc ^ sw) << 4)) = qo; *(LAS u32x4*)(keL + i * 128 + ((cc ^ sw) << 4)) = ko;
          *(u32x4*)(p.QE + t * 256 + h * 64 + d0) = qo;
          const int pi = pos16(i);
#pragma unroll
          for (int j = 0; j < 8; ++j) { const int d = d0 + j; const unsigned pk = cvt_pk_bf16(kt[j], 0.f);
              *(LAS unsigned short*)(ktL + d * 128 + (((pi >> 3) ^ ((d >> 1) & 7)) << 4) + (pi & 7) * 2) = (unsigned short)pk; } }
        __syncthreads();
        G1In nxt = cur;
        if (u + G < 1024) g1_load(u + G, nxt);
        { f32x16 OT, KV;
#pragma unroll
          for (int r = 0; r < 16; ++r) { OT[r] = 0.f; KV[r] = 0.f; }
          const int sw = (l31 >> 1) & 7;
#pragma unroll
          for (int jb = 0; jb < 2; ++jb) {
              if (jb <= hb) {
                  f32x16 Sc;
#pragma unroll
                  for (int r = 0; r < 16; ++r) Sc[r] = 0.f;
#pragma unroll
                  for (int s = 0; s < 4; ++s) {
                      const bf16x8 ka = *(const LAS bf16x8*)(keL + (32 * jb + l31) * 128 + (((2 * s + hh) ^ sw) << 4));
                      const bf16x8 qb = *(const LAS bf16x8*)(qeL + (32 * hb + l31) * 128 + (((2 * s + hh) ^ sw) << 4));
                      Sc = __builtin_amdgcn_mfma_f32_32x32x16_bf16(ka, qb, Sc, 0, 0, 0); }
                  if (jb == hb) {
#pragma unroll
                      for (int r = 0; r < 16; ++r) { const int j = (r & 3) + 8 * (r >> 2) + 4 * hh; if (j > l31) Sc[r] = 0.f; } }
#pragma unroll
                  for (int h2 = 0; h2 < 2; ++h2) {
                      u32x4 a = {cvt_pk_bf16(Sc[8 * h2 + 0], Sc[8 * h2 + 1]), cvt_pk_bf16(Sc[8 * h2 + 2], Sc[8 * h2 + 3]), cvt_pk_bf16(Sc[8 * h2 + 4], Sc[8 * h2 + 5]), cvt_pk_bf16(Sc[8 * h2 + 6], Sc[8 * h2 + 7])};
                      OT = __builtin_amdgcn_mfma_f32_32x32x16_bf16(cur.vf[2 * jb + h2], *(bf16x8*)&a, OT, 0, 0, 0); } } }
#pragma unroll
          for (int s4 = 0; s4 < 4; ++s4) {
              const bf16x8 kb = *(const LAS bf16x8*)(ktL + (32 * hb + l31) * 128 + (((2 * s4 + hh) ^ sw) << 4));
              KV = __builtin_amdgcn_mfma_f32_32x32x16_bf16(cur.vf[s4], kb, KV, 0, 0, 0); }
          float* oi = p.OI + ((size_t)u * 8 + wid) * 1024 + lane;
#pragma unroll
          for (int r = 0; r < 16; ++r) oi[r * 64] = OT[r];
          float* kp = p.kvT + (size_t)u * 8192 + 32 * hb + l31;
#pragma unroll
          for (int r = 0; r < 16; ++r) { const int e = 32 * eb + (r & 3) + 8 * (r >> 2) + 4 * hh; kp[e * 64] = KV[r]; } }
        __syncthreads();
        cur = nxt;
    }
}
__device__ __forceinline__ void gla_g2(LAS unsigned char* lds, const GlaP& p, int c) {
    const int tid = tid_now(), el = tid & 127, seg = tid >> 7;
    const int idx = c * 128 + el, h = idx >> 13, ed = idx & 8191, d = idx & 63;
    LAS float* segS = (LAS float*)lds; LAS float* segD = (LAS float*)(lds + 2048);
    float st = 0.f, dp = 1.f;
    for (int n0 = seg * 64; n0 < seg * 64 + 64; n0 += 16) {
        float kv[16], dc[16];
#pragma unroll
        for (int k = 0; k < 16; ++k) { const size_t u = (size_t)(n0 + k) * 4 + h; kv[k] = p.kvT[u * 8192 + ed]; dc[k] = p.decay[u * 64 + d]; }
#pragma unroll
        for (int k = 0; k < 16; ++k) { st = fmaf(dc[k], st, kv[k]); dp *= dc[k]; }
    }
    __syncthreads();
    segS[seg * 128 + el] = st; segD[seg * 128 + el] = dp;
    __syncthreads();
    st = 0.f;
    for (int s2 = 0; s2 < seg; ++s2) st = fmaf(segD[s2 * 128 + el], st, segS[s2 * 128 + el]);
    for (int n0 = seg * 64; n0 < seg * 64 + 64; n0 += 16) {
        float kv[16], dc[16];
#pragma unroll
        for (int k = 0; k < 16; ++k) { const size_t u = (size_t)(n0 + k) * 4 + h; kv[k] = p.kvT[u * 8192 + ed]; dc[k] = p.decay[u * 64 + d]; }
#pragma unroll
        for (int k = 0; k < 16; ++k) { const size_t u = (size_t)(n0 + k) * 4 + h; p.spT[u * 8192 + ed] = (bf16_t)(cvt_pk_bf16(st, 0.f) & 0xffffu); st = fmaf(dc[k], st, kv[k]); }
    }
    __syncthreads();
}
__device__ __forceinline__ void gla_g3(LAS unsigned char* lds, const GlaP& p, int c, int G) {
    const int tid = tid_now(), wid = __builtin_amdgcn_readfirstlane(tid >> 6), lane = tid & 63, l31 = lane & 31, hh = lane >> 5;
    LAS float* red = (LAS float*)lds;
    const int eb = wid & 3, ib = wid >> 2;
    struct In { f32x16 oi; bf16x8 sp[4], qe[4]; u32x2 rv[4]; };
    auto load = [&](int u, In& x) __attribute__((always_inline)) {
        const int n = u >> 2, h = u & 3; const size_t t = (size_t)64 * n + 32 * ib + l31;
        const float* oi = p.OI + ((size_t)u * 8 + wid) * 1024 + lane;
#pragma unroll
        for (int r = 0; r < 16; ++r) x.oi[r] = oi[r * 64];
        const bf16_t* sp = p.spT + ((size_t)u * 128 + 32 * eb + l31) * 64 + 8 * hh; const bf16_t* qp = p.QE + t * 256 + h * 64 + 8 * hh;
#pragma unroll
        for (int s = 0; s < 4; ++s) { x.sp[s] = *(const bf16x8*)(sp + 16 * s); x.qe[s] = *(const bf16x8*)(qp + 16 * s); }
#pragma unroll
        for (int g = 0; g < 4; ++g) x.rv[g] = *(const u32x2*)(p.Hp + t * HW + H_GR + h * 128 + 32 * eb + 8 * g + 4 * hh);
    };
    In cur, nxt;
    if (c < 1024) load(c, cur);
    for (int u = c; u < 1024; u += G) {
        const int n = u >> 2, h = u & 3;
        const bool hn = u + G < 1024;
        if (hn) load(u + G, nxt);
        f32x16 O = cur.oi;
        const size_t t = (size_t)64 * n + 32 * ib + l31;
#pragma unroll
        for (int s = 0; s < 4; ++s) O = __builtin_amdgcn_mfma_f32_32x32x16_bf16(cur.sp[s], cur.qe[s], O, 0, 0, 0);
        float ss = 0.f;
#pragma unroll
        for (int r = 0; r < 16; ++r) ss += O[r] * O[r];
        { auto rr = __builtin_amdgcn_permlane32_swap(__float_as_uint(ss), __float_as_uint(ss), false, false); ss = __uint_as_float(rr[0]) + __uint_as_float(rr[1]); }
        __syncthreads();
        if (hh == 0) red[eb * 64 + 32 * ib + l31] = ss;
        __syncthreads();
        const int ti = 32 * ib + l31;
        const float tot = (red[ti] + red[64 + ti]) + (red[128 + ti] + red[192 + ti]);
        const float rs = rsqrtf(tot * (1.f / 128.f) + 1e-6f);
#pragma unroll
        for (int g = 0; g < 4; ++g) { const int e0 = 32 * eb + 8 * g + 4 * hh;
            const u32x2 rv = cur.rv[g]; const f32x4 gn = *(const f32x4*)(p.ng + e0);
            float y[4];
#pragma unroll
            for (int j = 0; j < 4; ++j) { const float r_ = (j & 1) ? bfhi(rv[j >> 1]) : bflo(rv[j >> 1]); y[j] = O[4 * g + j] * rs * gn[j] * (r_ * frcp(1.f + __expf(-r_))); }
            u32x2 o = {cvt_pk_bf16(y[0], y[1]), cvt_pk_bf16(y[2], y[3])};
            *(u32x2*)(p.Ybb + t * 512 + h * 128 + e0) = o; }
        if (hn) cur = nxt;
    }
}
__device__ __forceinline__ void conv_phase(const GlaP& p, int gtid, int gthreads) {
    constexpr int NT = T * 64;
    for (int idx0 = gtid; idx0 < NT; idx0 += 2 * gthreads) {
        u32x4 av[2][3], xv[2][3], bv[2]; int tt[2], cc[2];
#pragma unroll
        for (int u = 0; u < 2; ++u) { const int idx = min(idx0 + u * gthreads, NT - 1); const int t = idx >> 6, c0 = (idx & 63) * 8; tt[u] = t; cc[u] = c0;
#pragma unroll
            for (int k = 0; k < 3; ++k) { const int ts = max(t - 2 + k, 0);
                av[u][k] = *(const u32x4*)(p.Hp + (size_t)ts * HW + H_AC + c0); xv[u][k] = *(const u32x4*)(p.Hp + (size_t)ts * HW + H_AX + c0); }
            bv[u] = *(const u32x4*)(p.Hp + (size_t)t * HW + H_AB + c0); }
#pragma unroll
        for (int u = 0; u < 2; ++u) { if (idx0 + u * gthreads < NT) { const int t = tt[u], c0 = cc[u];
            float y[8];
#pragma unroll
            for (int j = 0; j < 8; ++j) y[j] = 0.f;
#pragma unroll
            for (int k = 0; k < 3; ++k) { if (t - 2 + k >= 0) {
                const f32x4 w0 = *(const f32x4*)(p.wconv + k * 512 + c0), w1 = *(const f32x4*)(p.wconv + k * 512 + c0 + 4);
#pragma unroll
                for (int j = 0; j < 4; ++j) { y[2 * j] += (j < 2 ? w0[2 * j] : w1[2 * j - 4]) * (bflo(av[u][k][j]) * bflo(xv[u][k][j])); y[2 * j + 1] += (j < 2 ? w0[2 * j + 1] : w1[2 * j - 3]) * (bfhi(av[u][k][j]) * bfhi(xv[u][k][j])); } } }
            u32x4 o;
#pragma unroll
            for (int j = 0; j < 4; ++j) o[j] = cvt_pk_bf16(bflo(bv[u][j]) * y[2 * j], bfhi(bv[u][j]) * y[2 * j + 1]);
            *(u32x4*)(p.Yab + (size_t)t * 512 + c0) = o; } }
    }
}
__device__ __forceinline__ void attn_combine_bf16(const GlaP& p, int gtid, int gthreads) {
    constexpr int NT = 256 * 256 * 32;
    for (int idx0 = gtid; idx0 < NT; idx0 += 2 * gthreads) {
        float mv[2][2], lv[2][2]; u32x2 ov[2][2]; int nval[2]; size_t orow[2]; int ocol[2];
#pragma unroll
        for (int u = 0; u < 2; ++u) { const int idx = min(idx0 + u * gthreads, NT - 1);
            const int dq = idx & 31, row = (idx >> 5) & 255, g = idx >> 13, head = g >> 6, b = g & 63;
            const int s0 = b >= 32 ? 2 * (head * 64 + 2 * (63 - b)) : 2 * (head * 64 + 2 * b + 1) + 1;
            nval[u] = b >= 32 ? 2 : 1; orow[u] = (size_t)(b * 256 + row) * 512 + head * 128; ocol[u] = dq * 4;
#pragma unroll
            for (int k = 0; k < 2; ++k) { const size_t sl = (size_t)(s0 + (b >= 32 ? 2 * k : 0)) * 256 + row;
                const f32x2 ml = *(const f32x2*)(p.MLpart + sl * 2); mv[u][k] = ml[0]; lv[u][k] = ml[1];
                ov[u][k] = *(const u32x2*)((const bf16_t*)p.Opart + sl * 128 + dq * 4); } }
#pragma unroll
        for (int u = 0; u < 2; ++u) { if (idx0 + u * gthreads < NT) {
            float M = mv[u][0];
#pragma unroll
            for (int k = 1; k < 2; ++k) if (k < nval[u]) M = fmaxf(M, mv[u][k]);
            f32x4 acc = {0.f, 0.f, 0.f, 0.f}; float l = 0.f;
#pragma unroll
            for (int k = 0; k < 2; ++k) { const float w = k < nval[u] ? __builtin_amdgcn_exp2f(mv[u][k] - M) : 0.f;
                l += w * lv[u][k]; const f32x4 o = {bflo(ov[u][k][0]), bfhi(ov[u][k][0]), bflo(ov[u][k][1]), bfhi(ov[u][k][1])}; acc += o * w; }
            const float il = frcp(l);
            u32x2 o = {cvt_pk_bf16(acc[0] * il, acc[1] * il), cvt_pk_bf16(acc[2] * il, acc[3] * il)};
            *(u32x2*)(p.Ycb + orow[u] + ocol[u]) = o; } }
    }
}
struct P {
    const float *x, *pin; const int* pos;
    const float *ln0_g, *ln0_b, *w_in, *w_conv, *w_gg, *b_gg, *gla_ng, *qn_g, *kvn_g, *w_uq, *w_ukv, *w_br, *w_o, *ln1_g, *ln1_b, *w_grp, *b_grp, *w_exp, *b_exp,
                *w_gate, *w_up, *w_down, *ln2_g, *ln2_b, *w_pg, *b_pg, *w_pu, *ln3_g, *ln3_b;
    float* out;
    float *X, *Z, *cs, *sn, *ssq_q, *ssq_kv, *OI, *kvT, *decay, *MLpart, *ew;
    bf16_t *Db, *Xb, *Hp, *GVt, *Qb, *KnImg, *VtImg, *KrImg, *QE, *spT, *Yab, *Ybb, *Ycb, *Mgb, *Hbuf, *Ys, *Ub, *Pb;
    bf16_t *Wb_in, *Wb_gv, *Wb_uq, *Wb_uk, *Wb_uv, *Wb_br, *Wb_o, *Wb_gu, *Wb_d, *Wb_pg, *Wb_pu;
    int *cnt, *lists; unsigned* bar;
};
__device__ __forceinline__ MegaP mk_mega(const P& p) { MegaP m; m.w_in = p.w_in; m.Wb_in = p.Wb_in; m.Wb_gv = p.Wb_gv; m.Xb = p.Xb; m.Hp = p.Hp; m.GVt = p.GVt; m.ssq_q = p.ssq_q; m.ssq_kv = p.ssq_kv; return m; }
__device__ __forceinline__ MlaP mk_mla(const P& p) { MlaP q; q.w_uq = p.w_uq; q.w_ukv = p.w_ukv; q.qn_g = p.qn_g; q.kvn_g = p.kvn_g; q.Wb_uq = p.Wb_uq; q.Wb_uk = p.Wb_uk; q.Wb_uv = p.Wb_uv; q.Hp = p.Hp;
    q.ssq_q = p.ssq_q; q.ssq_kv = p.ssq_kv; q.cs = p.cs; q.sn = p.sn; q.Qb = p.Qb; q.KnImg = p.KnImg; q.VtImg = p.VtImg; q.KrImg = p.KrImg; q.Opart = p.Z; q.MLpart = p.MLpart; q.Yc = nullptr; return q; }
__device__ __forceinline__ GlaP mk_gla(const P& p, int layer) { GlaP g; g.Hp = p.Hp; g.GVt = p.GVt; g.wg = p.w_gg + layer * 16 * 256; g.bg = p.b_gg + layer * 256; g.ng = p.gla_ng + layer * 128; g.wconv = p.w_conv + layer * 3 * 512;
    g.QE = p.QE; g.OI = p.OI; g.kvT = p.kvT; g.decay = p.decay; g.spT = p.spT; g.Yab = p.Yab; g.Ybb = p.Ybb; g.Ycb = p.Ycb; g.Opart = p.Z; g.MLpart = p.MLpart; return g; }

struct CvJob { const float* W; bf16_t* Bt; const float* rs; int ldw, Ksrc, ldbt, n0, k0, kind, aux; };
struct MapId { __device__ __forceinline__ int operator()(int s) const { return s; } };
__device__ __forceinline__ int cv_map(int kind, int aux, int n) {
    if (kind == 0) return MapInMain{}(n);
    if (kind == 1) return aux + n;
    if (kind == 2) return MapQ{}(n);
    if (kind == 3) return MapKV{aux}(n);
    return n; }
__device__ __forceinline__ int cv_omap(int kind, int aux, int n) { return kind == 4 ? (n >> 7) * 256 + aux * 128 + (n & 127) : n; }
__device__ __forceinline__ bool cv_job(const P& p, int layer, int t, CvJob& j) {
    constexpr int S0 = 384, S1 = S0 + 32, S2 = S1 + 12, S3 = S2 + 8, S4 = S3 + 8, S5 = S4 + 96, S6 = S5 + 64, S7 = S6 + 64, S8 = S7 + 16, S9 = S8 + 1024, S10 = S9 + 1024, S11 = S10 + 1024;
    if (t >= S11) return false;
    j.rs = nullptr; j.aux = 0; j.kind = 5;
    if (t < S0) { j.W = p.w_in + (size_t)layer * D * INW; j.ldw = INW; j.Ksrc = D; j.Bt = p.Wb_in; j.ldbt = D; j.n0 = (t >> 2) * 64; j.k0 = (t & 3) * 256; j.kind = 0; }
    else if (t < S1) { const int u = t - S0; j.W = p.w_in + (size_t)layer * D * INW; j.ldw = INW; j.Ksrc = D; j.Bt = p.Wb_gv; j.ldbt = D; j.n0 = (u >> 2) * 64; j.k0 = (u & 3) * 256; j.kind = 1; j.aux = O_GV; }
    else if (t < S2) { const int u = t - S1; j.W = p.w_uq + (size_t)layer * 256 * 768; j.ldw = 768; j.Ksrc = 256; j.Bt = p.Wb_uq; j.ldbt = 256; j.n0 = u * 64; j.k0 = 0; j.kind = 2; j.rs = p.qn_g + layer * 256; }
    else if (t < S3) { const int u = t - S2; j.W = p.w_ukv + (size_t)layer * 128 * 1024; j.ldw = 1024; j.Ksrc = 128; j.Bt = p.Wb_uk; j.ldbt = 256; j.n0 = u * 64; j.k0 = 0; j.kind = 3; j.aux = 0; j.rs = p.kvn_g + layer * 128; }
    else if (t < S4) { const int u = t - S3; j.W = p.w_ukv + (size_t)layer * 128 * 1024; j.ldw = 1024; j.Ksrc = 128; j.Bt = p.Wb_uv; j.ldbt = 256; j.n0 = u * 64; j.k0 = 0; j.kind = 3; j.aux = 128; j.rs = p.kvn_g + layer * 128; }
    else if (t < S5) { const int u = t - S4, br = u >> 5, v = u & 31; j.W = p.w_br + (size_t)layer * 1536 * D + (size_t)br * 512 * D; j.ldw = D; j.Ksrc = 512; j.Bt = p.Wb_br + (size_t)br * 1024 * 512; j.ldbt = 512; j.n0 = (v >> 1) * 64; j.k0 = (v & 1) * 256; }
    else if (t < S6) { const int u = t - S5; j.W = p.w_o + (size_t)layer * D * D; j.ldw = D; j.Ksrc = D; j.Bt = p.Wb_o; j.ldbt = D; j.n0 = (u >> 2) * 64; j.k0 = (u & 3) * 256; }
    else if (t < S7) { const int u = t - S6; j.W = p.w_pg + (size_t)layer * D * D; j.ldw = D; j.Ksrc = D; j.Bt = p.Wb_pg; j.ldbt = D; j.n0 = (u >> 2) * 64; j.k0 = (u & 3) * 256; }
    else if (t < S8) { const int u = t - S7; j.W = p.w_pu + (size_t)layer * PLE * D; j.ldw = D; j.Ksrc = PLE; j.Bt = p.Wb_pu; j.ldbt = PLE; j.n0 = u * 64; j.k0 = 0; }
    else if (t < S9) { const int u = t - S8, e = u >> 4, v = u & 15; j.W = p.w_gate + ((size_t)layer * NE + e) * D * EH; j.ldw = EH; j.Ksrc = D; j.Bt = p.Wb_gu + (size_t)e * 512 * D; j.ldbt = D; j.n0 = (v >> 2) * 64; j.k0 = (v & 3) * 256; j.kind = 4; j.aux = 0; }
    else if (t < S10) { const int u = t - S9, e = u >> 4, v = u & 15; j.W = p.w_up + ((size_t)layer * NE + e) * D * EH; j.ldw = EH; j.Ksrc = D; j.Bt = p.Wb_gu + (size_t)e * 512 * D; j.ldbt = D; j.n0 = (v >> 2) * 64; j.k0 = (v & 3) * 256; j.kind = 4; j.aux = 1; }
    else { const int u = t - S10, e = u >> 4, v = u & 15; j.W = p.w_down + ((size_t)layer * NE + e) * EH * D; j.ldw = D; j.Ksrc = EH; j.Bt = p.Wb_d + (size_t)e * D * EH; j.ldbt = EH; j.n0 = v * 64; j.k0 = 0; }
    return true; }
__device__ __forceinline__ void cv_load(const CvJob& j, int tid, f32x4 (&v)[8]) {
    const int n4 = tid & 15, kr = tid >> 4; const int col = cv_map(j.kind, j.aux, j.n0 + 4 * n4);
#pragma unroll
    for (int r = 0; r < 8; ++r) { const int k = j.k0 + kr + 32 * r; v[r] = (f32x4){0.f, 0.f, 0.f, 0.f};
        if (col >= 0 && k < j.Ksrc) { v[r] = *(const f32x4*)(j.W + (size_t)k * j.ldw + col); if (j.rs) v[r] = v[r] * j.rs[k]; } }
}
constexpr int CV_DENSE = 684, CV_MOE = 3072;
__device__ __forceinline__ void ph_convert(LAS unsigned char* ldsl, const P& p, int layer) {
    LAS float* tile = (LAS float*)ldsl;
    const int tid = tid_now(), c = sgpr_now((int)blockIdx.x), G = gridDim.x;
    CvJob cur, nxt; f32x4 v[8], w[8];
    bool have = c < CV_DENSE && cv_job(p, layer, c, cur);
    if (have) cv_load(cur, tid, v);
    for (int t = c; have; t += G) {
        const bool hn = t + G < CV_DENSE && cv_job(p, layer, t + G, nxt);
        if (hn) cv_load(nxt, tid, w);
        __syncthreads();
        { const int n4 = tid & 15, kr = tid >> 4;
#pragma unroll
          for (int r = 0; r < 8; ++r) { LAS float* d = tile + (kr + 32 * r) * 65 + 4 * n4; d[0] = v[r][0]; d[1] = v[r][1]; d[2] = v[r][2]; d[3] = v[r][3]; } }
        __syncthreads();
        { const int kk = (tid & 127) * 2, nn = tid >> 7;
#pragma unroll
          for (int r = 0; r < 16; ++r) { const int n = nn + 4 * r;
              *(unsigned*)(cur.Bt + (size_t)cv_omap(cur.kind, cur.aux, cur.n0 + n) * cur.ldbt + cur.k0 + kk) = cvt_pk_bf16(tile[kk * 65 + n], tile[(kk + 1) * 65 + n]); } }
        have = hn; cur = nxt;
#pragma unroll
        for (int r = 0; r < 8; ++r) v[r] = w[r];
    }
    __syncthreads();
}

__device__ __forceinline__ float wsum(float v, int lane) {
#pragma unroll
    for (int o = 32; o > 0; o >>= 1) v += shx(v, o, lane);
    return v; }
template <int MODE>
__device__ __forceinline__ void ph_rows(const P& p, int layer) {
    const int lane = tid_now() & 63, gw = blockIdx.x * 8 + (tid_now() >> 6), nw = gridDim.x * 8;
    const float* gp = MODE == 0 ? p.ln0_g : MODE == 1 ? p.ln1_g + layer * D : MODE == 2 ? p.ln2_g + layer * D : p.ln3_g + layer * D;
    const float* bp = MODE == 0 ? p.ln0_b : MODE == 1 ? p.ln1_b + layer * D : MODE == 2 ? p.ln2_b + layer * D : p.ln3_b + layer * D;
    f32x4 gg[4], bb[4];
#pragma unroll
    for (int i = 0; i < 4; ++i) { gg[i] = *(const f32x4*)(gp + 256 * i + 4 * lane); bb[i] = *(const f32x4*)(bp + 256 * i + 4 * lane); }
    const float* in = MODE == 0 ? p.x : p.X;
    float* outf = (MODE == 3 && layer == DEPTH - 1) ? p.out : p.X;
    for (int row = gw; row < T; row += nw) {
        f32x4 v[4];
#pragma unroll
        for (int i = 0; i < 4; ++i) {
            if constexpr (MODE == 2 || MODE == 3) {
                const u32x2 xx = *(const u32x2*)(p.Xb + (size_t)row * D + 256 * i + 4 * lane); v[i] = (f32x4){bflo(xx[0]), bfhi(xx[0]), bflo(xx[1]), bfhi(xx[1])}; }
            else v[i] = *(const f32x4*)(in + (size_t)row * D + 256 * i + 4 * lane); }
        if constexpr (MODE == 3) {
#pragma unroll
            for (int i = 0; i < 4; ++i) { const u32x2 dd = *(const u32x2*)(p.Db + (size_t)row * D + 256 * i + 4 * lane);
                v[i][0] = DN_ALPHA * v[i][0] + bflo(dd[0]); v[i][1] = DN_ALPHA * v[i][1] + bfhi(dd[0]); v[i][2] = DN_ALPHA * v[i][2] + bflo(dd[1]); v[i][3] = DN_ALPHA * v[i][3] + bfhi(dd[1]); } }
        if constexpr (MODE == 2) { const float w0 = p.ew[2 * row], w1 = p.ew[2 * row + 1];
#pragma unroll
            for (int i = 0; i < 4; ++i) { const u32x2 y0 = *(const u32x2*)(p.Ys + (size_t)(2 * row) * D + 256 * i + 4 * lane), y1 = *(const u32x2*)(p.Ys + (size_t)(2 * row + 1) * D + 256 * i + 4 * lane);
                v[i][0] = DN_ALPHA * v[i][0] + (w0 * bflo(y0[0]) + w1 * bflo(y1[0])); v[i][1] = DN_ALPHA * v[i][1] + (w0 * bfhi(y0[0]) + w1 * bfhi(y1[0]));
                v[i][2] = DN_ALPHA * v[i][2] + (w0 * bflo(y0[1]) + w1 * bflo(y1[1])); v[i][3] = DN_ALPHA * v[i][3] + (w0 * bfhi(y0[1]) + w1 * bfhi(y1[1])); } }
        float s = 0.f;
#pragma unroll
        for (int i = 0; i < 4; ++i) s += (v[i][0] + v[i][1]) + (v[i][2] + v[i][3]);
        const float mu = wsum(s, lane) * (1.f / D);
        float q = 0.f;
#pragma unroll
        for (int i = 0; i < 4; ++i) { v[i] = v[i] - mu; q += (v[i][0] * v[i][0] + v[i][1] * v[i][1]) + (v[i][2] * v[i][2] + v[i][3] * v[i][3]); }
        const float rs = rsqrtf(wsum(q, lane) * (1.f / D) + 1e-5f);
#pragma unroll
        for (int i = 0; i < 4; ++i) { v[i] = v[i] * rs * gg[i] + bb[i];
            if constexpr (MODE != 2) *(f32x4*)(outf + (size_t)row * D + 256 * i + 4 * lane) = v[i];
            u32x2 o = {cvt_pk_bf16(v[i][0], v[i][1]), cvt_pk_bf16(v[i][2], v[i][3])};
            *(u32x2*)(p.Xb + (size_t)row * D + 256 * i + 4 * lane) = o; }
        if constexpr (MODE == 1) {
            const float* wg = p.w_grp + (size_t)layer * D * 8; const float* we = p.w_exp + (size_t)layer * D * 64;
            float gl[8];
#pragma unroll
            for (int g = 0; g < 8; ++g) gl[g] = 0.f;
#pragma unroll
            for (int i = 0; i < 4; ++i)
#pragma unroll
                for (int j = 0; j < 4; ++j) { const int k = 256 * i + 4 * lane + j; const f32x4 a = *(const f32x4*)(wg + k * 8), b = *(const f32x4*)(wg + k * 8 + 4); const float xv = v[i][j];
                    gl[0] = fmaf(xv, a[0], gl[0]); gl[1] = fmaf(xv, a[1], gl[1]); gl[2] = fmaf(xv, a[2], gl[2]); gl[3] = fmaf(xv, a[3], gl[3]);
                    gl[4] = fmaf(xv, b[0], gl[4]); gl[5] = fmaf(xv, b[1], gl[5]); gl[6] = fmaf(xv, b[2], gl[6]); gl[7] = fmaf(xv, b[3], gl[7]); }
            float mx = -INFINITY; int gt = 0;
#pragma unroll
            for (int g = 0; g < 8; ++g) { gl[g] = wsum(gl[g], lane) + p.b_grp[layer * 8 + g]; if (gl[g] > mx) { mx = gl[g]; gt = g; } }
            gt = __builtin_amdgcn_readfirstlane(gt);
            float sum = 0.f;
#pragma unroll
            for (int g = 0; g < 8; ++g) sum += expf(gl[g] - mx);
            const float pg = 1.f / sum;
            float el[8];
#pragma unroll
            for (int e = 0; e < 8; ++e) el[e] = 0.f;
#pragma unroll
            for (int i = 0; i < 4; ++i)
#pragma unroll
                for (int j = 0; j < 4; ++j) { const int k = 256 * i + 4 * lane + j; const f32x4 a = *(const f32x4*)(we + k * 64 + gt * 8), b = *(const f32x4*)(we + k * 64 + gt * 8 + 4); const float xv = v[i][j];
                    el[0] = fmaf(xv, a[0], el[0]); el[1] = fmaf(xv, a[1], el[1]); el[2] = fmaf(xv, a[2], el[2]); el[3] = fmaf(xv, a[3], el[3]);
                    el[4] = fmaf(xv, b[0], el[4]); el[5] = fmaf(xv, b[1], el[5]); el[6] = fmaf(xv, b[2], el[6]); el[7] = fmaf(xv, b[3], el[7]); }
            float v1 = -INFINITY, v2 = -INFINITY; int i1 = 0, i2 = 0;
#pragma unroll
            for (int e = 0; e < 8; ++e) { const float vv = wsum(el[e], lane) + p.b_exp[layer * 64 + gt * 8 + e];
                if (vv > v1) { v2 = v1; i2 = i1; v1 = vv; i1 = e; } else if (vv > v2) { v2 = vv; i2 = e; } }
            if (lane == 0) { const float e2 = expf(v2 - v1), w1 = pg / (1.f + e2), w2 = pg * e2 / (1.f + e2);
                const int ea = gt * 8 + i1, eb = gt * 8 + i2; int* cn = p.cnt + layer * 64;
                p.ew[2 * row] = w1; p.ew[2 * row + 1] = w2;
                const int pa = atomicAdd(&cn[ea], 1); p.lists[ea * LCAP + pa] = 2 * row;
                const int pb = atomicAdd(&cn[eb], 1); p.lists[eb * LCAP + pb] = 2 * row + 1; }
        }
    }
}

__device__ __forceinline__ void wsum8(float (&x)[8], int lane) {
    float y[4], z[2], w;
#pragma unroll
    for (int k = 0; k < 4; ++k) { const bool hi = lane & 32; const float snd = hi ? x[k] : x[k + 4], keep = hi ? x[k + 4] : x[k]; y[k] = keep + shx(snd, 32, lane); }
#pragma unroll
    for (int k = 0; k < 2; ++k) { const bool hi = lane & 16; const float snd = hi ? y[k] : y[k + 2], keep = hi ? y[k + 2] : y[k]; z[k] = keep + shx(snd, 16, lane); }
    { const bool hi = lane & 8; const float snd = hi ? z[0] : z[1], keep = hi ? z[1] : z[0]; w = keep + shx(snd, 8, lane); }
    w += shx(w, 4, lane); w += shx(w, 2, lane); w += shx(w, 1, lane);
#pragma unroll
    for (int k = 0; k < 8; ++k) x[k] = __int_as_float(__builtin_amdgcn_readlane(__float_as_int(w), (k >> 2) * 32 + ((k >> 1) & 1) * 16 + (k & 1) * 8));
}
__device__ __forceinline__ void ph_ln1_router(const P& p, int layer) {
    constexpr int RR = 2;
    const int tid = tid_now(), lane0 = tid & 63, gw = sgpr_now((int)blockIdx.x) * 8 + (tid >> 6), nw = gridDim.x * 8;
    const float* gp = p.ln1_g + layer * D; const float* bp = p.ln1_b + layer * D;
    const float* wg = p.w_grp + (size_t)layer * D * 8; const float* we = p.w_exp + (size_t)layer * D * 64;
    for (int row0 = gw * RR; row0 < T; row0 += nw * RR) {
        int lane = lane0; asm volatile("" : "+v"(lane));
        f32x4 v[RR][4];
#pragma unroll
        for (int r = 0; r < RR; ++r)
#pragma unroll
            for (int i = 0; i < 4; ++i) { v[r][i] = *(const f32x4*)(p.X + (size_t)(row0 + r) * D + 256 * i + 4 * lane);
                const u32x2 dd = *(const u32x2*)(p.Db + (size_t)(row0 + r) * D + 256 * i + 4 * lane);
                v[r][i][0] = DN_ALPHA * v[r][i][0] + bflo(dd[0]); v[r][i][1] = DN_ALPHA * v[r][i][1] + bfhi(dd[0]); v[r][i][2] = DN_ALPHA * v[r][i][2] + bflo(dd[1]); v[r][i][3] = DN_ALPHA * v[r][i][3] + bfhi(dd[1]); }
#pragma unroll
        for (int r = 0; r < RR; ++r) {
            float s = 0.f;
#pragma unroll
            for (int i = 0; i < 4; ++i) s += (v[r][i][0] + v[r][i][1]) + (v[r][i][2] + v[r][i][3]);
            const float mu = wsum(s, lane) * (1.f / D);
            float q = 0.f;
#pragma unroll
            for (int i = 0; i < 4; ++i) { v[r][i] = v[r][i] - mu; q += (v[r][i][0] * v[r][i][0] + v[r][i][1] * v[r][i][1]) + (v[r][i][2] * v[r][i][2] + v[r][i][3] * v[r][i][3]); }
            const float rs = rsqrtf(wsum(q, lane) * (1.f / D) + 1e-5f);
#pragma unroll
            for (int i = 0; i < 4; ++i) { const f32x4 gg = *(const f32x4*)(gp + 256 * i + 4 * lane), bb = *(const f32x4*)(bp + 256 * i + 4 * lane);
                v[r][i] = v[r][i] * rs * gg + bb;
                u32x2 o = {cvt_pk_bf16(v[r][i][0], v[r][i][1]), cvt_pk_bf16(v[r][i][2], v[r][i][3])};
                *(u32x2*)(p.Xb + (size_t)(row0 + r) * D + 256 * i + 4 * lane) = o; } }
        float gl[RR][8];
#pragma unroll
        for (int r = 0; r < RR; ++r)
#pragma unroll
            for (int g = 0; g < 8; ++g) gl[r][g] = 0.f;
        {
            f32x4 wa[2][4], wb[2][4];
            asm volatile("" : "+v"(lane));
#pragma unroll
            for (int j = 0; j < 4; ++j) { const int k = 4 * lane + j; wa[0][j] = *(const f32x4*)(wg + k * 8); wb[0][j] = *(const f32x4*)(wg + k * 8 + 4); }
#pragma unroll
            for (int i = 0; i < 4; ++i) {
                if (i + 1 < 4) { asm volatile("" : "+v"(lane));
#pragma unroll
                    for (int j = 0; j < 4; ++j) { const int k = 256 * (i + 1) + 4 * lane + j; wa[(i + 1) & 1][j] = *(const f32x4*)(wg + k * 8); wb[(i + 1) & 1][j] = *(const f32x4*)(wg + k * 8 + 4); } }
                asm volatile("" ::: "memory");
#pragma unroll
                for (int j = 0; j < 4; ++j) { const f32x4 a = wa[i & 1][j], b = wb[i & 1][j];
#pragma unroll
                    for (int r = 0; r < RR; ++r) { const float xv = v[r][i][j];
                        gl[r][0] = fmaf(xv, a[0], gl[r][0]); gl[r][1] = fmaf(xv, a[1], gl[r][1]); gl[r][2] = fmaf(xv, a[2], gl[r][2]); gl[r][3] = fmaf(xv, a[3], gl[r][3]);
                        gl[r][4] = fmaf(xv, b[0], gl[r][4]); gl[r][5] = fmaf(xv, b[1], gl[r][5]); gl[r][6] = fmaf(xv, b[2], gl[r][6]); gl[r][7] = fmaf(xv, b[3], gl[r][7]); } } } }
        int gt[RR]; float pg[RR];
#pragma unroll
        for (int r = 0; r < RR; ++r) { wsum8(gl[r], lane);
            float mx = -INFINITY; int gi = 0;
#pragma unroll
            for (int g = 0; g < 8; ++g) { gl[r][g] += p.b_grp[layer * 8 + g]; if (gl[r][g] > mx) { mx = gl[r][g]; gi = g; } }
            float sum = 0.f;
#pragma unroll
            for (int g = 0; g < 8; ++g) sum += expf(gl[r][g] - mx);
            gt[r] = __builtin_amdgcn_readfirstlane(gi); pg[r] = 1.f / sum; }
        float el[RR][8];
#pragma unroll
        for (int r = 0; r < RR; ++r) {
#pragma unroll
            for (int e = 0; e < 8; ++e) el[r][e] = 0.f;
            f32x4 wa[2][4], wb[2][4];
            const float* wr_ = we + gt[r] * 8;
            asm volatile("" : "+v"(lane));
#pragma unroll
            for (int j = 0; j < 4; ++j) { const int k = 4 * lane + j; wa[0][j] = *(const f32x4*)(wr_ + k * 64); wb[0][j] = *(const f32x4*)(wr_ + k * 64 + 4); }
#pragma unroll
            for (int i = 0; i < 4; ++i) {
                if (i + 1 < 4) { asm volatile("" : "+v"(lane));
#pragma unroll
                    for (int j = 0; j < 4; ++j) { const int k = 256 * (i + 1) + 4 * lane + j; wa[(i + 1) & 1][j] = *(const f32x4*)(wr_ + k * 64); wb[(i + 1) & 1][j] = *(const f32x4*)(wr_ + k * 64 + 4); } }
                asm volatile("" ::: "memory");
#pragma unroll
                for (int j = 0; j < 4; ++j) { const f32x4 a = wa[i & 1][j], b = wb[i & 1][j]; const float xv = v[r][i][j];
                    el[r][0] = fmaf(xv, a[0], el[r][0]); el[r][1] = fmaf(xv, a[1], el[r][1]); el[r][2] = fmaf(xv, a[2], el[r][2]); el[r][3] = fmaf(xv, a[3], el[r][3]);
                    el[r][4] = fmaf(xv, b[0], el[r][4]); el[r][5] = fmaf(xv, b[1], el[r][5]); el[r][6] = fmaf(xv, b[2], el[r][6]); el[r][7] = fmaf(xv, b[3], el[r][7]); } } }
#pragma unroll
        for (int r = 0; r < RR; ++r) { wsum8(el[r], lane);
            float v1 = -INFINITY, v2 = -INFINITY; int i1 = 0, i2 = 0;
#pragma unroll
            for (int e = 0; e < 8; ++e) { const float vv = el[r][e] + p.b_exp[layer * 64 + gt[r] * 8 + e];
                if (vv > v1) { v2 = v1; i2 = i1; v1 = vv; i1 = e; } else if (vv > v2) { v2 = vv; i2 = e; } }
            if (lane == 0) { const int row = row0 + r; const float e2 = expf(v2 - v1), w1 = pg[r] / (1.f + e2), w2 = pg[r] * e2 / (1.f + e2);
                const int ea = gt[r] * 8 + i1, eb = gt[r] * 8 + i2; int* cn = p.cnt + layer * 64;
                p.ew[2 * row] = w1; p.ew[2 * row + 1] = w2;
                const int pa = atomicAdd(&cn[ea], 1); p.lists[ea * LCAP + pa] = 2 * row;
                const int pb = atomicAdd(&cn[eb], 1); p.lists[eb * LCAP + pb] = 2 * row + 1; } }
    }
}
__device__ __forceinline__ void ph_prologue(const P& p) {
    const int gtid = blockIdx.x * NTHR + tid_now(), gth = gridDim.x * NTHR;
    for (int idx = gtid; idx < T * 32; idx += gth) { const int t = idx >> 5, i = idx & 31;
        const float inv = (float)(1.0 / pow(10000.0, (double)(2 * i) / 64.0)); const float ang = (float)p.pos[t] * inv;
        p.cs[idx] = (float)cos((double)ang); p.sn[idx] = (float)sin((double)ang); }
    for (size_t i = gtid; i < (size_t)DEPTH * T * PLE / 4; i += gth) { const f32x4 v = ((const f32x4*)p.pin)[i]; u32x2 o = {cvt_pk_bf16(v[0], v[1]), cvt_pk_bf16(v[2], v[3])}; ((u32x2*)p.Pb)[i] = o; }
    ph_rows<0>(p, 0);
}

struct SchedBr { __device__ __forceinline__ bool carry(const ge::Unit& u) const { return u.g < 2; }
    const char* Ya; const char* Yb; const char* Yc; const char* W; int c, G;
    __device__ __forceinline__ bool next(int i, ge::Unit& u) const { const int tile = (i / 3) * G + c; if (tile >= 256) return false; u.g = i % 3; ge::tile_order(tile, 64, 4, u.pm, u.pn); return true; }
    __device__ __forceinline__ const char* aptr(const ge::Unit& u) const { return (u.g == 0 ? Ya : u.g == 1 ? Yb : Yc) + (size_t)u.pm * 256 * 512 * 2; }
    __device__ __forceinline__ const char* bptr(const ge::Unit& u) const { return W + ((size_t)u.g * 1024 + u.pn * 256) * 512 * 2; } };
struct EpiBr { const bf16_t* Hp; bf16_t* Mgb;
    __device__ __forceinline__ void operator()(ge::Acc& acc, const ge::Unit& u, int wr, int wc, int fr, int fq) const {
        const int row0 = u.pm * 256 + wr * 64 + fr, col0 = u.pn * 256 + wc * 32 + 8 * fq;
        const bool ratio = u.g < 2;
#pragma unroll
        for (int ai = 0; ai < 2; ++ai) {
            u32x4 gt[4][2], gn[4][2];
#pragma unroll
            for (int m = 0; m < 4; ++m)
#pragma unroll
                for (int bj = 0; bj < 2; ++bj) { const bf16_t* gp = Hp + (size_t)(row0 + ai * 128 + m * 16) * HW + H_GTA + u.g * 1024 + col0 + bj * 128;
                    gt[m][bj] = *(const u32x4*)gp; gn[m][bj] = ratio ? *(const u32x4*)(gp + 1024) : gt[m][bj]; }
            asm volatile("" ::: "memory");
#pragma unroll
            for (int m = 0; m < 4; ++m) { const int row = row0 + ai * 128 + m * 16;
#pragma unroll
                for (int bj = 0; bj < 2; ++bj) { const int col = col0 + bj * 128; const u32x4 g = gt[m][bj], d = gn[m][bj];
                    f32x4 s0 = {bflo(g[0]), bfhi(g[0]), bflo(g[1]), bfhi(g[1])}, s1 = {bflo(g[2]), bfhi(g[2]), bflo(g[3]), bfhi(g[3])};
                    if (ratio) { const f32x4 d0 = {bflo(d[0]), bfhi(d[0]), bflo(d[1]), bfhi(d[1])}, d1 = {bflo(d[2]), bfhi(d[2]), bflo(d[3]), bfhi(d[3])};
#pragma unroll
                        for (int j = 0; j < 4; ++j) { s0[j] = s0[j] * frcp(d0[j]); s1[j] = s1[j] * frcp(d1[j]); } }
                    acc[ai][bj][m][0] = acc[ai][bj][m][0] * s0; acc[ai][bj][m][1] = acc[ai][bj][m][1] * s1;
                    if (u.g == 2) { const f32x4 v0 = acc[ai][bj][m][0], v1 = acc[ai][bj][m][1];
                        u32x4 o = {cvt_pk_bf16(v0[0], v0[1]), cvt_pk_bf16(v0[2], v0[3]), cvt_pk_bf16(v1[0], v1[1]), cvt_pk_bf16(v1[2], v1[3])}; *(u32x4*)(Mgb + (size_t)row * D + col) = o; } } }
        }
    } };
struct SchedT4 : ge::NoCarry { const char* A; const char* B; int lda2, ldb2, c, G;
    __device__ __forceinline__ bool next(int i, ge::Unit& u) const { const int L = i * G + c; if (L >= 256) return false; u.g = 0; ge::tile_order(L, 64, 4, u.pm, u.pn); return true; }
    __device__ __forceinline__ const char* aptr(const ge::Unit& u) const { return A + (size_t)u.pm * lda2; }
    __device__ __forceinline__ const char* bptr(const ge::Unit& u) const { return B + (size_t)u.pn * ldb2; } };
struct EpiRes { bf16_t* Db;
    __device__ __forceinline__ void operator()(ge::Acc& acc, const ge::Unit& u, int wr, int wc, int fr, int fq) const {
        const int row0 = u.pm * 256 + wr * 64 + fr, col0 = u.pn * 256 + wc * 32 + 8 * fq;
#pragma unroll
        for (int ai = 0; ai < 2; ++ai)
#pragma unroll
            for (int m = 0; m < 4; ++m) { const size_t o = (size_t)(row0 + ai * 128 + m * 16) * D + col0;
#pragma unroll
                for (int bj = 0; bj < 2; ++bj) { const f32x4 v0 = acc[ai][bj][m][0], v1 = acc[ai][bj][m][1];
                    u32x4 w = {cvt_pk_bf16(v0[0], v0[1]), cvt_pk_bf16(v0[2], v0[3]), cvt_pk_bf16(v1[0], v1[1]), cvt_pk_bf16(v1[2], v1[3])}; *(u32x4*)(Db + o + bj * 128) = w; } }
    } };
struct EpiU { bf16_t* Ub;
    __device__ __forceinline__ void operator()(ge::Acc& acc, const ge::Unit& u, int wr, int wc, int fr, int fq) const {
        const int row0 = u.pm * 256 + wr * 64 + fr, col0 = u.pn * 256 + wc * 32 + 8 * fq;
#pragma unroll
        for (int ai = 0; ai < 2; ++ai)
#pragma unroll
            for (int m = 0; m < 4; ++m) { const size_t o = (size_t)(row0 + ai * 128 + m * 16) * D + col0;
#pragma unroll
                for (int bj = 0; bj < 2; ++bj) { const f32x4 v0 = acc[ai][bj][m][0], v1 = acc[ai][bj][m][1];
                    u32x4 w = {cvt_pk_bf16(v0[0], v0[1]), cvt_pk_bf16(v0[2], v0[3]), cvt_pk_bf16(v1[0], v1[1]), cvt_pk_bf16(v1[2], v1[3])}; *(u32x4*)(Ub + o + bj * 128) = w; } }
    } };
struct EpiPle { bf16_t* Db; const bf16_t* Ub; const float* bias;
    __device__ __forceinline__ void operator()(ge::Acc& acc, const ge::Unit& u, int wr, int wc, int fr, int fq) const {
        const int row0 = u.pm * 256 + wr * 64 + fr, col0 = u.pn * 256 + wc * 32 + 8 * fq;
        f32x4 bv[2][2];
#pragma unroll
        for (int bj = 0; bj < 2; ++bj) { bv[bj][0] = *(const f32x4*)(bias + col0 + bj * 128); bv[bj][1] = *(const f32x4*)(bias + col0 + bj * 128 + 4); }
#pragma unroll
        for (int ai = 0; ai < 2; ++ai) {
            u32x4 uv[4][2];
#pragma unroll
            for (int m = 0; m < 4; ++m)
#pragma unroll
                for (int bj = 0; bj < 2; ++bj) uv[m][bj] = *(const u32x4*)(Ub + (size_t)(row0 + ai * 128 + m * 16) * D + col0 + bj * 128);
            asm volatile("" ::: "memory");
#pragma unroll
            for (int m = 0; m < 4; ++m) { const size_t o = (size_t)(row0 + ai * 128 + m * 16) * D + col0;
#pragma unroll
                for (int bj = 0; bj < 2; ++bj) { const u32x4 uu = uv[m][bj];
                    f32x4 g0 = acc[ai][bj][m][0] + bv[bj][0], g1 = acc[ai][bj][m][1] + bv[bj][1];
#pragma unroll
                    for (int j = 0; j < 4; ++j) { g0[j] = frcp(1.f + __expf(-g0[j])); g1[j] = frcp(1.f + __expf(-g1[j])); }
                    const f32x4 u0 = {bflo(uu[0]), bfhi(uu[0]), bflo(uu[1]), bfhi(uu[1])}, u1 = {bflo(uu[2]), bfhi(uu[2]), bflo(uu[3]), bfhi(uu[3])};
                    g0 = g0 * u0; g1 = g1 * u1;
                    u32x4 w = {cvt_pk_bf16(g0[0], g0[1]), cvt_pk_bf16(g0[2], g0[3]), cvt_pk_bf16(g1[0], g1[1]), cvt_pk_bf16(g1[2], g1[3])}; *(u32x4*)(Db + o + bj * 128) = w; } } }
    } };

__device__ __forceinline__ void moe_table(LAS unsigned char* lds, const int* cnt) {
    LAS int* te = (LAS int*)(lds + 131072); LAS int* tr = te + 256; LAS int* cl = tr + 256; LAS int* nt = cl + 64;
    __syncthreads();
    const int tid = tid_now();
    if (tid < 64) {
        const int ce = cnt[tid], ne = (ce + 255) >> 8;
        int pre = ne;
#pragma unroll
        for (int o = 1; o < 64; o <<= 1) { const int t = __builtin_amdgcn_ds_bpermute(((tid - o) & 63) << 2, pre); if (tid >= o) pre += t; }
        const int base = pre - ne;
        cl[tid] = ce;
        for (int j = 0; j < ne; ++j) { te[base + j] = tid; tr[base + j] = 256 * j; }
        if (tid == 63) nt[0] = pre;
    }
    __syncthreads();
}
struct SchedM1 : ge::NoCarry { const char* Xb; const char* W; const int* lists; LAS int* te; int c, G;
    __device__ __forceinline__ bool next(int i, ge::Unit& u) const { const int L = i * G + c; if (L >= 2 * te[576]) return false; u.pm = L >> 1; u.pn = L & 1; u.g = te[u.pm]; return true; }
    __device__ __forceinline__ int arow(const ge::Unit& u, int r) const { const int n = te[512 + u.g], idx = min(te[256 + u.pm] + r, n - 1); return lists[u.g * LCAP + idx] >> 1; }
    __device__ __forceinline__ const char* aptr(const ge::Unit&) const { return Xb; }
    __device__ __forceinline__ const char* bptr(const ge::Unit& u) const { return W + ((size_t)u.g * 512 + u.pn * 256) * D * 2; } };
struct EpiM1 { bf16_t* Hbuf;
    __device__ __forceinline__ void operator()(ge::Acc& acc, const ge::Unit& u, int wr, int wc, int fr, int fq) const {
#pragma unroll
        for (int ai = 0; ai < 2; ++ai)
#pragma unroll
            for (int m = 0; m < 4; ++m) { const int row = ai * 128 + wr * 64 + m * 16 + fr;
                float h[8];
#pragma unroll
                for (int n = 0; n < 2; ++n)
#pragma unroll
                    for (int j = 0; j < 4; ++j) { const float g = acc[ai][0][m][n][j], uu = acc[ai][1][m][n][j]; h[4 * n + j] = g * frcp(1.f + __expf(-g)) * uu; }
                u32x4 o = {cvt_pk_bf16(h[0], h[1]), cvt_pk_bf16(h[2], h[3]), cvt_pk_bf16(h[4], h[5]), cvt_pk_bf16(h[6], h[7])};
                *(u32x4*)(Hbuf + ((size_t)u.pm * 256 + row) * EH + u.pn * 128 + wc * 32 + 8 * fq) = o; }
    } };
struct SchedM2 : ge::NoCarry { const char* Hb; const char* W; LAS int* te; int c, G;
    __device__ __forceinline__ bool next(int i, ge::Unit& u) const { const int L = i * G + c; if (L >= 4 * te[576]) return false; u.pm = L >> 2; u.pn = L & 3; u.g = te[u.pm]; return true; }
    __device__ __forceinline__ const char* aptr(const ge::Unit& u) const { return Hb + (size_t)u.pm * 256 * EH * 2; }
    __device__ __forceinline__ const char* bptr(const ge::Unit& u) const { return W + ((size_t)u.g * D + u.pn * 256) * EH * 2; } };
struct EpiM2 { bf16_t* Ys; const int* lists; LAS int* te;
    __device__ __forceinline__ void operator()(ge::Acc& acc, const ge::Unit& u, int wr, int wc, int fr, int fq) const {
        const int r0 = te[256 + u.pm], n = te[512 + u.g];
        int av[2][4];
#pragma unroll
        for (int ai = 0; ai < 2; ++ai)
#pragma unroll
            for (int m = 0; m < 4; ++m) { const int row = r0 + ai * 128 + wr * 64 + m * 16 + fr; av[ai][m] = row < n ? lists[u.g * LCAP + row] : -1; }
#pragma unroll
        for (int ai = 0; ai < 2; ++ai)
#pragma unroll
            for (int m = 0; m < 4; ++m) { const int a = av[ai][m];
                if (a >= 0) {
#pragma unroll
                    for (int bj = 0; bj < 2; ++bj) { const f32x4 v0 = acc[ai][bj][m][0], v1 = acc[ai][bj][m][1];
                        u32x4 o = {cvt_pk_bf16(v0[0], v0[1]), cvt_pk_bf16(v0[2], v0[3]), cvt_pk_bf16(v1[0], v1[1]), cvt_pk_bf16(v1[2], v1[3])};
                        *(u32x4*)(Ys + (size_t)a * D + u.pn * 256 + bj * 128 + wc * 32 + 8 * fq) = o; } } }
    } };

#define XB_TMO      128
#define XB_XCNT(j)  (256  + 64 * (j))
#define XB_XSUB(j)  (1280 + 64 * (j))
#define XB_XGEN(j)  (2304 + 64 * (j))
#define XB_TOP      3328
#define XB_TOPGEN   3392
#define XCD_BAR_WORDS 3456
#define XB_SPIN_CAP (1u << 18)

__device__ __forceinline__ unsigned xb_ld(unsigned* p)              { return __hip_atomic_load(p, __ATOMIC_RELAXED, __HIP_MEMORY_SCOPE_AGENT); }
__device__ __forceinline__ unsigned xb_add(unsigned* p, unsigned v) { return __hip_atomic_fetch_add(p, v, __ATOMIC_RELAXED, __HIP_MEMORY_SCOPE_AGENT); }
__device__ __forceinline__ unsigned xb_xcc_id() { return (unsigned)__builtin_amdgcn_s_getreg((3 << 11) | 20) & 0xFu; }
#define XB_SPIN(cond, bar) do { unsigned _sp = 0; while (cond) { __builtin_amdgcn_s_sleep(1); \
    if ((++_sp & 255u) == 0u) { if (xb_ld(&(bar)[XB_TMO])) break; if (_sp > XB_SPIN_CAP) { atomicAdd(&(bar)[XB_TMO], 1u); break; } } } } while (0)

struct XcdBarrier {
    unsigned* bar; unsigned x;
    volatile LAS unsigned* st;
};

__device__ __forceinline__ XcdBarrier xcd_barrier_post(unsigned* bar, volatile LAS unsigned* st) {
    XcdBarrier b; b.bar = bar; b.x = xb_xcc_id(); b.st = st;
    if (threadIdx.x == 0) (void)xb_add(&bar[XB_XCNT(b.x)], 1u);
    return b;
}
__device__ __forceinline__ void xcd_barrier_complete(unsigned* bar, unsigned x, unsigned& nloc, unsigned& nx) {
    const unsigned G = gridDim.x * gridDim.y * gridDim.z;
    unsigned sum, cnt, mine, sp = 0u;
    for (;;) {
        sum = 0u; cnt = 0u; mine = 0u;
#pragma unroll
        for (unsigned j = 0; j < 16; ++j) { const unsigned c = xb_ld(&bar[XB_XCNT(j)]); sum += c; cnt += (c > 0u) ? 1u : 0u; mine = (j == x) ? c : mine; }
        if (sum == G) break;
        __builtin_amdgcn_s_sleep(1);
        if ((++sp & 255u) == 0u) { if (xb_ld(&bar[XB_TMO])) break; if (sp > XB_SPIN_CAP) { atomicAdd(&bar[XB_TMO], 1u); break; } }
    }
    nloc = mine > 0u ? mine : 1u; nx = cnt > 0u ? cnt : 1u;
}

__device__ __forceinline__ void xcd_barrier(const XcdBarrier& b) {
    asm volatile("s_waitcnt vmcnt(0)" ::: "memory");
    __syncthreads();
    if (threadIdx.x == 0) {
        unsigned* bar = b.bar;
        __builtin_amdgcn_s_waitcnt(0);
        unsigned nloc = b.st[0], nx = b.st[1];
        if (nloc == 0u) { xcd_barrier_complete(bar, b.x, nloc, nx); b.st[0] = nloc; b.st[1] = nx; }
        const unsigned old = xb_add(&bar[XB_XSUB(b.x)], 1u);
        const unsigned gen = old / nloc;
        if (old + 1u == (gen + 1u) * nloc) {
            __builtin_amdgcn_fence(__ATOMIC_RELEASE, "agent");
            asm volatile("s_waitcnt vmcnt(0)" ::: "memory");
            const unsigned og = xb_add(&bar[XB_TOP], 1u);
            const unsigned tg = og / nx;
            if (og + 1u == (tg + 1u) * nx) xb_add(&bar[XB_TOPGEN], 1u);
            else XB_SPIN(xb_ld(&bar[XB_TOPGEN]) == tg, bar);
            __builtin_amdgcn_fence(__ATOMIC_ACQUIRE, "agent");
            xb_add(&bar[XB_XGEN(b.x)], 1u);
            asm volatile("s_waitcnt vmcnt(0)" ::: "memory");
        } else {
            XB_SPIN(xb_ld(&bar[XB_XGEN(b.x)]) == gen, bar);
            __builtin_amdgcn_fence(__ATOMIC_ACQUIRE, "agent");
            asm volatile("s_waitcnt vmcnt(0)" ::: "memory");
        }
    }
    __syncthreads();
}

enum { PH_PRO = 0, PH_CONV, PH_IN, PH_PREP_Q, PH_PREP_K, PH_PREP_V, PH_PREP_G, PH_ATT, PH_FIN, PH_BR, PH_WO, PH_LN1, PH_M1, PH_M2, PH_LN2, PH_PLE, PH_LN3 };
template <int PH> __global__ __launch_bounds__(NTHR, 2) void k_ph(P p, int layer) {
    extern __shared__ __attribute__((aligned(16))) unsigned char smem[];
    LAS unsigned char* lds = (LAS unsigned char*)smem;
    tid_setup();
    const int c = blockIdx.x, G = gridDim.x;
    if constexpr (PH == PH_PRO) ph_prologue(p);
    if constexpr (PH == PH_CONV) ph_convert(lds, p, layer);
    if constexpr (PH == PH_IN) { const MegaP m = mk_mega(p); SchedIn S{{}, (const char*)m.Xb, (const char*)m.Wb_in, (const char*)m.Wb_gv, c, G, 0}; EpiIn<2> E{m.Hp, m.GVt, m.ssq_q, m.ssq_kv}; ge::gemm_stream<EpiIn<2>, SchedIn, false>(lds, D, D, D, S, E); }
    if constexpr (PH == PH_PREP_Q) { const MlaP q = mk_mla(p); SchedMla<0> S{{}, (const char*)(q.Hp + H_CQ), (const char*)q.Wb_uq, c, G}; EpiMla<0> E{q}; ge::gemm_stream<EpiMla<0>, SchedMla<0>, false>(lds, 256, HW, 256, S, E); }
    if constexpr (PH == PH_PREP_K) { const MlaP q = mk_mla(p); SchedMla<1> S{{}, (const char*)(q.Hp + H_CKV), (const char*)q.Wb_uk, (c + 64) % G, G}; EpiMla<1> E{q}; ge::gemm_stream<EpiMla<1>, SchedMla<1>, false>(lds, 256, HW, 256, S, E); }
    if constexpr (PH == PH_PREP_V) { const MlaP q = mk_mla(p); SchedMla<2> S{{}, (const char*)q.Wb_uv, (const char*)(q.Hp + H_CKV), (c + 192) % G, G}; EpiMla<2> E{q}; ge::gemm_stream<EpiMla<2>, SchedMla<2>, false>(lds, 256, 256, HW, S, E); }
    if constexpr (PH == PH_PREP_G) { { const MegaP m = mk_mega(p); SchedIn S{{}, (const char*)m.Xb, (const char*)m.Wb_in, (const char*)m.Wb_gv, (c + 128) % G, G, 1}; EpiIn<0> E{m.Hp, m.GVt, m.ssq_q, m.ssq_kv}; ge::gemm_stream<EpiIn<0>, SchedIn, false>(lds, D, D, D, S, E); } const MlaP q = mk_mla(p); kr_phase(q, c * NTHR + tid_now(), G * NTHR); const GlaP g = mk_gla(p, layer); gla_g1(lds, g, c, G); }
    if constexpr (PH == PH_ATT) { const GlaP g = mk_gla(p, layer); gla_g2(lds, g, c); const MlaP q = mk_mla(p); attn_phase(lds, q, c); }
    if constexpr (PH == PH_FIN) { const GlaP g = mk_gla(p, layer); gla_g3(lds, g, c, G); conv_phase(g, c * NTHR + tid_now(), G * NTHR); attn_combine_bf16(g, c * NTHR + tid_now(), G * NTHR); }
    if constexpr (PH == PH_BR) { SchedBr S{(const char*)p.Yab, (const char*)p.Ybb, (const char*)p.Ycb, (const char*)p.Wb_br, c, G}; EpiBr E{p.Hp, p.Mgb}; ge::gemm_stream<EpiBr, SchedBr, false>(lds, 512, 512, 512, S, E); }
    if constexpr (PH == PH_WO) { SchedT4 S{{}, (const char*)p.Mgb, (const char*)p.Wb_o, 256 * D * 2, 256 * D * 2, c, G}; EpiRes E{p.Db}; ge::gemm_stream<EpiRes, SchedT4, false>(lds, D, D, D, S, E); }
    if constexpr (PH == PH_LN1) ph_ln1_router(p, layer);
    if constexpr (PH == PH_M1) { moe_table(lds, p.cnt + layer * 64); LAS int* te = (LAS int*)(lds + 131072);
        SchedM1 S{{}, (const char*)p.Xb, (const char*)p.Wb_gu, p.lists, te, c, G}; EpiM1 E{p.Hbuf}; ge::gemm_stream<EpiM1, SchedM1, true>(lds, D, D, D, S, E); }
    if constexpr (PH == PH_M2) { moe_table(lds, p.cnt + layer * 64); LAS int* te = (LAS int*)(lds + 131072);
        SchedM2 S{{}, (const char*)p.Hbuf, (const char*)p.Wb_d, te, c, G}; EpiM2 E{p.Ys, p.lists, te}; ge::gemm_stream<EpiM2, SchedM2, false>(lds, EH, EH, EH, S, E); }
    if constexpr (PH == PH_LN2) ph_rows<2>(p, layer);
    if constexpr (PH == PH_PLE) {
        { SchedT4 S{{}, (const char*)(p.Pb + (size_t)layer * T * PLE), (const char*)p.Wb_pu, 256 * PLE * 2, 256 * PLE * 2, c, G}; EpiU E{p.Ub}; ge::gemm_stream<EpiU, SchedT4, false>(lds, PLE, PLE, PLE, S, E); }
        { SchedT4 S{{}, (const char*)p.Xb, (const char*)p.Wb_pg, 256 * D * 2, 256 * D * 2, c, G}; EpiPle E{p.Db, p.Ub, p.b_pg + layer * D}; ge::gemm_stream<EpiPle, SchedT4, false>(lds, D, D, D, S, E); } }
    if constexpr (PH == PH_LN3) ph_rows<3>(p, layer);
}


typedef const P __attribute__((address_space(4))) CP;
__device__ __forceinline__ P load_params() { CP* q = (CP*)__builtin_amdgcn_kernarg_segment_ptr(); asm volatile("" : "+s"(q)); return *(const P*)q; }
struct CvTile { const float* src; bf16_t* dst; int ldw, ldbt; };
__device__ __forceinline__ CvTile cv_moe_tile(const P& p, int layer, int m, int tid) {
    const int seg = m >> 10, u = m & 1023, e = u >> 4, v = u & 15;
    const int w = tid >> 6, lane = tid & 63, nh = w & 1, kq = w >> 1, n4 = lane & 7, kg = lane >> 3;
    CvTile t;
    if (seg < 2) { const int n = (v >> 2) * 64 + nh * 32 + n4 * 4, k = (v & 3) * 256 + kq * 64 + kg * 8, on = (n >> 7) * 256 + seg * 128 + (n & 127);
        t.ldw = EH; t.ldbt = D; t.src = (seg == 0 ? p.w_gate : p.w_up) + ((size_t)layer * NE + e) * D * EH + (size_t)k * EH + n; t.dst = p.Wb_gu + (size_t)e * 512 * D + (size_t)on * D + k; }
    else { const int n = v * 64 + nh * 32 + n4 * 4, k = kq * 64 + kg * 8;
        t.ldw = D; t.ldbt = EH; t.src = p.w_down + ((size_t)layer * NE + e) * EH * D + (size_t)k * D + n; t.dst = p.Wb_d + (size_t)e * D * EH + (size_t)n * EH + k; }
    return t; }
struct CvHook { int layer;
    __device__ __forceinline__ void run(int h) const {
        const P p = load_params(); const int tid = tid_now(), c = sgpr_now((int)blockIdx.x);
        f32x4 a[6][8];
#pragma unroll
        for (int j = 0; j < 6; ++j) { const CvTile t = cv_moe_tile(p, layer, (6 * h + j) * NBLK + c, tid);
#pragma unroll
            for (int r = 0; r < 8; ++r) a[j][r] = __builtin_nontemporal_load((const f32x4*)(t.src + (size_t)r * t.ldw)); }
#pragma unroll
        for (int j = 0; j < 6; ++j) { const CvTile t = cv_moe_tile(p, layer, (6 * h + j) * NBLK + c, tid);
#pragma unroll
            for (int q = 0; q < 4; ++q) { const u32x4 o = {cvt_pk_bf16(a[j][0][q], a[j][1][q]), cvt_pk_bf16(a[j][2][q], a[j][3][q]), cvt_pk_bf16(a[j][4][q], a[j][5][q]), cvt_pk_bf16(a[j][6][q], a[j][7][q])};
                __builtin_nontemporal_store(o, (u32x4*)(t.dst + (size_t)q * t.ldbt)); } } }
    __device__ __forceinline__ void operator()(int ui) const { const int k = (sgpr_now((int)blockIdx.x) >> 4) % 3; if (ui == k - 1) run(0); else if (ui == k + 2) run(1); }
};
#define GRID_BAR() do { XcdBarrier b_; b_.bar = load_params().bar; b_.x = xb_xcc_id(); b_.st = xbw; xcd_barrier(b_); } while (0)
__global__ __launch_bounds__(NTHR, 2) void k_mega(P p_arg) {
    extern __shared__ __attribute__((aligned(16))) unsigned char smem[];
    LAS unsigned char* lds = (LAS unsigned char*)smem;
    const int G = NBLK;
#define c sgpr_now((int)blockIdx.x)
    volatile LAS unsigned* xbw = (volatile LAS unsigned*)(lds + XBW_OFF);
    tid_setup();
    if (tid_now() < 4) xbw[tid_now()] = 0u;
    __syncthreads();
    (void)xcd_barrier_post(p_arg.bar, xbw);
    { const P p = load_params(); ph_prologue(p); }
    { const P p = load_params(); ph_convert(lds, p, 0); }
    GRID_BAR();
    for (int layer = 0; layer < DEPTH; ++layer) {
        { const P p = load_params(); const MegaP m = mk_mega(p); SchedIn S{{}, (const char*)m.Xb, (const char*)m.Wb_in, (const char*)m.Wb_gv, c, G, 0}; EpiIn<2> E{m.Hp, m.GVt, m.ssq_q, m.ssq_kv}; const CvHook Hk{layer}; Hk(-1); ge::gemm_stream<EpiIn<2>, SchedIn, false, CvHook>(lds, D, D, D, S, E, Hk); }
        GRID_BAR();
        { const P p = load_params(); const MlaP q = mk_mla(p);
          { SchedMla<0> S{{}, (const char*)(q.Hp + H_CQ), (const char*)q.Wb_uq, (c >= 128 ? c - 128 : c < 64 ? c + 128 : -1), 256}; EpiMla<0> E{q}; ge::gemm_stream<EpiMla<0>, SchedMla<0>, false>(lds, 256, HW, 256, S, E); }
          { SchedMla<1> S{{}, (const char*)(q.Hp + H_CKV), (const char*)q.Wb_uk, (c >= 128 ? c - 128 : -1), 128}; EpiMla<1> E{q}; ge::gemm_stream<EpiMla<1>, SchedMla<1>, false>(lds, 256, HW, 256, S, E); }
          { SchedMla<2> S{{}, (const char*)q.Wb_uv, (const char*)(q.Hp + H_CKV), (c >= 128 ? c - 128 : -1), 128}; EpiMla<2> E{q}; ge::gemm_stream<EpiMla<2>, SchedMla<2>, false>(lds, 256, 256, HW, S, E); }
          { const MegaP m = mk_mega(p); SchedIn S{{}, (const char*)m.Xb, (const char*)m.Wb_in, (const char*)m.Wb_gv, c, G, 1}; EpiIn<0> E{m.Hp, m.GVt, m.ssq_q, m.ssq_kv}; ge::gemm_stream<EpiIn<0>, SchedIn, false>(lds, D, D, D, S, E); }
          kr_phase(q, c * NTHR + tid_now(), G * NTHR);
          const GlaP g = mk_gla(p, layer); gla_g1(lds, g, c, G); }
        GRID_BAR();
        { const P p = load_params(); const GlaP g = mk_gla(p, layer); gla_g2(lds, g, c); const MlaP q = mk_mla(p); attn_phase(lds, q, c); }
        GRID_BAR();
        { const P p = load_params(); const GlaP g = mk_gla(p, layer); gla_g3(lds, g, c, G); conv_phase(g, c * NTHR + tid_now(), G * NTHR); attn_combine_bf16(g, c * NTHR + tid_now(), G * NTHR); }
        GRID_BAR();
        { const P p = load_params(); SchedBr S{(const char*)p.Yab, (const char*)p.Ybb, (const char*)p.Ycb, (const char*)p.Wb_br, c, G}; EpiBr E{p.Hp, p.Mgb}; ge::gemm_stream<EpiBr, SchedBr, false>(lds, 512, 512, 512, S, E); }
        GRID_BAR();
        { const P p = load_params(); SchedT4 S{{}, (const char*)p.Mgb, (const char*)p.Wb_o, 256 * D * 2, 256 * D * 2, c, G}; EpiRes E{p.Db}; ge::gemm_stream<EpiRes, SchedT4, false>(lds, D, D, D, S, E); }
        GRID_BAR();
        { const P p = load_params(); ph_ln1_router(p, layer); }
        GRID_BAR();
        { const P p = load_params(); moe_table(lds, p.cnt + layer * 64); LAS int* te = (LAS int*)(lds + 131072);
          SchedM1 S{{}, (const char*)p.Xb, (const char*)p.Wb_gu, p.lists, te, c, G}; EpiM1 E{p.Hbuf}; ge::gemm_stream<EpiM1, SchedM1, true>(lds, D, D, D, S, E);
          const int extra = max(0, 2 * te[576] - NBLK), cu = c - extra;
          SchedT4 SU{{}, (const char*)(p.Pb + (size_t)layer * T * PLE), (const char*)p.Wb_pu, 256 * PLE * 2, 256 * PLE * 2, cu >= 0 ? cu : 256, NBLK - extra}; EpiU EU{p.Ub};
          ge::gemm_stream<EpiU, SchedT4, false>(lds, PLE, PLE, PLE, SU, EU); }
        GRID_BAR();
        { const P p = load_params(); LAS int* te = (LAS int*)(lds + 131072);
          SchedM2 S{{}, (const char*)p.Hbuf, (const char*)p.Wb_d, te, c, G}; EpiM2 E{p.Ys, p.lists, te}; ge::gemm_stream<EpiM2, SchedM2, false>(lds, EH, EH, EH, S, E); }
        GRID_BAR();
        { const P p = load_params(); ph_rows<2>(p, layer); }
        GRID_BAR();
        { const P p = load_params(); SchedT4 S{{}, (const char*)p.Xb, (const char*)p.Wb_pg, 256 * D * 2, 256 * D * 2, c, G}; EpiPle E{p.Db, p.Ub, p.b_pg + layer * D}; ge::gemm_stream<EpiPle, SchedT4, false>(lds, D, D, D, S, E); }
        GRID_BAR();
        { const P p = load_params(); ph_rows<3>(p, layer); }
        if (layer + 1 < DEPTH) { { const P p = load_params(); ph_convert(lds, p, layer + 1); } GRID_BAR(); }
    }
#undef c
}

template <int PH> static void launch_ph(const P& p, int layer, hipStream_t st) {
    static bool set = false;
    if (!set) { (void)hipFuncSetAttribute((const void*)k_ph<PH>, hipFuncAttributeMaxDynamicSharedMemorySize, LDS_BYTES); set = true; }
    hipLaunchKernelGGL((k_ph<PH>), dim3(NBLK), dim3(NTHR), LDS_BYTES, st, p, layer);
}
extern "C" void kernel_launch(void* const* d_in, const int* in_sizes, int n_in, void* d_out, int out_size, void* d_ws, size_t ws_size, hipStream_t st) {
    (void)in_sizes; (void)n_in; (void)out_size;
    P p{};
    p.x = (const float*)d_in[0]; p.pin = (const float*)d_in[1]; p.pos = (const int*)d_in[2]; p.ln0_g = (const float*)d_in[3]; p.ln0_b = (const float*)d_in[4];
    p.w_in = (const float*)d_in[5]; p.w_conv = (const float*)d_in[6]; p.w_gg = (const float*)d_in[7]; p.b_gg = (const float*)d_in[8]; p.gla_ng = (const float*)d_in[9];
    p.qn_g = (const float*)d_in[10]; p.kvn_g = (const float*)d_in[11]; p.w_uq = (const float*)d_in[12]; p.w_ukv = (const float*)d_in[13]; p.w_br = (const float*)d_in[14]; p.w_o = (const float*)d_in[15];
    p.ln1_g = (const float*)d_in[16]; p.ln1_b = (const float*)d_in[17]; p.w_grp = (const float*)d_in[18]; p.b_grp = (const float*)d_in[19]; p.w_exp = (const float*)d_in[20]; p.b_exp = (const float*)d_in[21];
    p.w_gate = (const float*)d_in[22]; p.w_up = (const float*)d_in[23]; p.w_down = (const float*)d_in[24]; p.ln2_g = (const float*)d_in[25]; p.ln2_b = (const float*)d_in[26];
    p.w_pg = (const float*)d_in[27]; p.b_pg = (const float*)d_in[28]; p.w_pu = (const float*)d_in[29]; p.ln3_g = (const float*)d_in[30]; p.ln3_b = (const float*)d_in[31];
    p.out = (float*)d_out;
    char* w = (char*)d_ws; size_t off = 0;
    auto alloc = [&](size_t bytes) { void* r = w + off; off += (bytes + 255) & ~(size_t)255; return r; };
    p.bar = (unsigned*)alloc(16384); p.cnt = (int*)alloc(DEPTH * 64 * 4);
    const size_t zero_bytes = off;
    p.X = (float*)alloc((size_t)T * D * 4); p.Z = (float*)alloc((size_t)T * D * 4); p.Xb = (bf16_t*)alloc((size_t)T * D * 2); p.Db = (bf16_t*)alloc((size_t)T * D * 2);
    p.cs = (float*)alloc((size_t)T * 32 * 4); p.sn = (float*)alloc((size_t)T * 32 * 4); p.ssq_q = (float*)alloc((size_t)4 * T * 4); p.ssq_kv = (float*)alloc((size_t)4 * T * 4);
    p.Hp = (bf16_t*)alloc((size_t)T * HW * 2); p.GVt = (bf16_t*)alloc((size_t)T * 512 * 2);
    p.Qb = (bf16_t*)alloc((size_t)T * 768 * 2); p.KnImg = (bf16_t*)alloc((size_t)T * 512 * 2); p.VtImg = (bf16_t*)alloc((size_t)T * 512 * 2); p.KrImg = (bf16_t*)alloc((size_t)T * 64 * 2);
    p.MLpart = (float*)alloc((size_t)512 * 256 * 2 * 4);
    p.QE = (bf16_t*)alloc((size_t)T * 256 * 2); p.OI = (float*)alloc((size_t)T * 512 * 4); p.kvT = (float*)alloc((size_t)1024 * 8192 * 4); p.decay = (float*)alloc((size_t)1024 * 64 * 4); p.spT = (bf16_t*)alloc((size_t)1024 * 8192 * 2);
    p.Yab = (bf16_t*)alloc((size_t)T * 512 * 2); p.Ybb = (bf16_t*)alloc((size_t)T * 512 * 2); p.Ycb = (bf16_t*)alloc((size_t)T * 512 * 2); p.Mgb = (bf16_t*)alloc((size_t)T * D * 2);
    p.ew = (float*)alloc((size_t)T * 2 * 4); p.lists = (int*)alloc((size_t)NE * LCAP * 4);
    p.Hbuf = (bf16_t*)alloc((size_t)192 * 256 * EH * 2); p.Ys = (bf16_t*)alloc((size_t)2 * T * D * 2); p.Ub = (bf16_t*)alloc((size_t)T * D * 2); p.Pb = (bf16_t*)alloc((size_t)DEPTH * T * PLE * 2);
    p.Wb_in = (bf16_t*)alloc((size_t)HW * D * 2); p.Wb_gv = (bf16_t*)alloc((size_t)512 * D * 2); p.Wb_uq = (bf16_t*)alloc((size_t)768 * 256 * 2); p.Wb_uk = (bf16_t*)alloc((size_t)512 * 256 * 2); p.Wb_uv = (bf16_t*)alloc((size_t)512 * 256 * 2);
    p.Wb_br = (bf16_t*)alloc((size_t)3 * D * 512 * 2); p.Wb_o = (bf16_t*)alloc((size_t)D * D * 2); p.Wb_gu = (bf16_t*)alloc((size_t)NE * 512 * D * 2); p.Wb_d = (bf16_t*)alloc((size_t)NE * D * EH * 2);
    p.Wb_pg = (bf16_t*)alloc((size_t)D * D * 2); p.Wb_pu = (bf16_t*)alloc((size_t)D * PLE * 2);
    if (off > ws_size) return;
    (void)hipMemsetAsync(d_ws, 0, zero_bytes, st);
#if defined(MULTI_LAUNCH)
    launch_ph<PH_PRO>(p, 0, st);
    for (int i = 0; i < DEPTH; ++i) {
        launch_ph<PH_CONV>(p, i, st); launch_ph<PH_IN>(p, i, st);
        launch_ph<PH_PREP_Q>(p, i, st); launch_ph<PH_PREP_K>(p, i, st); launch_ph<PH_PREP_V>(p, i, st); launch_ph<PH_PREP_G>(p, i, st);
        launch_ph<PH_ATT>(p, i, st); launch_ph<PH_FIN>(p, i, st); launch_ph<PH_BR>(p, i, st); launch_ph<PH_WO>(p, i, st); launch_ph<PH_LN1>(p, i, st);
        launch_ph<PH_M1>(p, i, st); launch_ph<PH_M2>(p, i, st); launch_ph<PH_LN2>(p, i, st); launch_ph<PH_PLE>(p, i, st); launch_ph<PH_LN3>(p, i, st);
    }
#else
    static bool set = false;
    if (!set) { (void)hipFuncSetAttribute((const void*)k_mega, hipFuncAttributeMaxDynamicSharedMemorySize, LDS_BYTES); set = true; }
    hipLaunchKernelGGL(k_mega, dim3(NBLK), dim3(NTHR), LDS_BYTES, st, p);
#endif
}
```
